# Optimizing an MI355X kernel written in HIP

```python
import jax, jax.numpy as jnp
from jax import lax
import numpy as np

D_MODEL = 1024
BATCH = 4
SEQ = 4096
DEPTH = 2

RWKV_HEADS = 8
RWKV_HEAD_DIM = 64
RWKV_DIM = RWKV_HEADS * RWKV_HEAD_DIM
DECAY_LORA = 64
ICLR_LORA = 64
GATE_LORA = 128
LNX_EPS = 64e-5
MLA_HEADS = 8
QK_NOPE_DIM = 64
QK_ROPE_DIM = 32
V_HEAD_DIM = 64
Q_LORA_RANK = 256
KV_LORA_RANK = 128
ROPE_THETA = 10000.0
Q_BLOCK = 128
NEG_INF = -1e30
FFN_DIM = 2816
CONV_WIDTH = 3
NORM_EPS = 1e-6
MAX_POS_OFFSET = 1024

SHIFT_COLS = 3 * RWKV_DIM + DECAY_LORA + ICLR_LORA + GATE_LORA
MLA_COLS = Q_LORA_RANK + KV_LORA_RANK + QK_ROPE_DIM
GATE_COLS = 2 * D_MODEL
IN_COLS = SHIFT_COLS + MLA_COLS + GATE_COLS

kernel_name = 'hybrid_rwkv7_mla_convffn'


def _rmsnorm(x, g, eps=NORM_EPS):
    xf = x.astype(jnp.float32)
    xf = xf * lax.rsqrt(jnp.mean(xf * xf, axis=-1, keepdims=True) + eps)
    return xf.astype(x.dtype) * g


def _token_shift(x):
    return jnp.pad(x, ((0, 0), (1, 0), (0, 0)))[:, :-1]


def _rope_tables(positions, dtype):
    inv_freq = jnp.power(ROPE_THETA, -jnp.arange(0, QK_ROPE_DIM, 2, dtype=jnp.float32) / QK_ROPE_DIM)
    ang = positions.astype(jnp.float32)[..., None] * inv_freq
    return jnp.cos(ang).astype(dtype), jnp.sin(ang).astype(dtype)


def _rope(x, cos, sin):
    half = x.shape[-1] // 2
    x1, x2 = x[..., :half], x[..., half:]
    return jnp.concatenate([x1 * cos - x2 * sin, x1 * sin + x2 * cos], axis=-1)


def _wkv7_scan(r, w, k, v, a, b):
    B, S, H, N = r.shape

    def step(state, inp):
        r_t, w_t, k_t, v_t, a_t, b_t = inp
        sa = jnp.einsum('bhij,bhj->bhi', state, a_t)
        state = (state * w_t[:, :, None, :]
                 + sa[..., None] * b_t[:, :, None, :]
                 + v_t[..., None] * k_t[:, :, None, :])
        y_t = jnp.einsum('bhij,bhj->bhi', state, r_t)
        return state, y_t

    xs = tuple(jnp.moveaxis(t, 1, 0) for t in (r, w, k, v, a, b))
    s0 = jnp.zeros((B, H, N, N), jnp.float32)
    _, y = lax.scan(step, s0, xs)
    return jnp.moveaxis(y, 0, 1)


def _rwkv7_time_mix(p_r, p_k, p_v, p_w, p_a, p_g, decay_base, w_decay_up, iclr_base,
                    w_iclr_up, w_gate_up, k_k, k_a, r_k, lnx_w, lnx_b):
    B, S, _ = p_r.shape
    H, N = RWKV_HEADS, RWKV_HEAD_DIM
    dt = p_r.dtype

    def heads(t):
        return t.reshape(B, S, H, N)

    log_w = -jax.nn.softplus(-(decay_base + jnp.tanh(p_w) @ w_decay_up)) - 0.5
    decay = jnp.exp(-jnp.exp(log_w.astype(jnp.float32)))
    iclr = jax.nn.sigmoid(iclr_base + p_a @ w_iclr_up)
    gate = jax.nn.sigmoid(p_g) @ w_gate_up
    kk = heads((p_k * k_k).astype(jnp.float32))
    kk = kk * lax.rsqrt(jnp.sum(kk * kk, axis=-1, keepdims=True) + 1e-12)
    k = p_k * (1.0 + (iclr - 1.0) * k_a)
    r_h, k_h, v_h = heads(p_r), heads(k), heads(p_v)
    a_h = heads(iclr).astype(jnp.float32)
    y = _wkv7_scan(r_h.astype(jnp.float32), heads(decay), k_h.astype(jnp.float32),
                   v_h.astype(jnp.float32), -kk, kk * a_h)
    mu = jnp.mean(y, axis=-1, keepdims=True)
    var = jnp.mean(jnp.square(y - mu), axis=-1, keepdims=True)
    y = ((y - mu) * lax.rsqrt(var + LNX_EPS)).reshape(B, S, RWKV_DIM).astype(dt) * lnx_w + lnx_b
    bonus = (jnp.sum(r_h * k_h * r_k, axis=-1, keepdims=True) * v_h).reshape(B, S, RWKV_DIM)
    return (y + bonus) * gate


def _mla(q_lat, kv_lat, k_pe, cos, sin, q_norm, w_q_up, kv_norm, w_kv_up):
    B, S, _ = q_lat.shape
    H = MLA_HEADS
    q = (_rmsnorm(q_lat, q_norm) @ w_q_up).reshape(B, S, H, QK_NOPE_DIM + QK_ROPE_DIM)
    q_nope, q_pe = q[..., :QK_NOPE_DIM], q[..., QK_NOPE_DIM:]
    q_pe = _rope(q_pe, cos[:, :, None, :], sin[:, :, None, :])
    k_pe = _rope(k_pe, cos, sin)
    kv = (_rmsnorm(kv_lat, kv_norm) @ w_kv_up).reshape(B, S, H, QK_NOPE_DIM + V_HEAD_DIM)
    k_nope, v = kv[..., :QK_NOPE_DIM], kv[..., QK_NOPE_DIM:]

    n_blocks = S // Q_BLOCK
    qn_blocks = jnp.moveaxis(q_nope.reshape(B, n_blocks, Q_BLOCK, H, QK_NOPE_DIM), 1, 0)
    qr_blocks = jnp.moveaxis(q_pe.reshape(B, n_blocks, Q_BLOCK, H, QK_ROPE_DIM), 1, 0)
    starts = jnp.arange(n_blocks, dtype=jnp.int32) * Q_BLOCK
    key_pos = jnp.arange(S, dtype=jnp.int32)
    scale = (QK_NOPE_DIM + QK_ROPE_DIM) ** -0.5

    def attend(args):
        qn, qr, q0 = args
        s = (jnp.einsum('bqhd,bkhd->bhqk', qn, k_nope)
             + jnp.einsum('bqhr,bkr->bhqk', qr, k_pe)).astype(jnp.float32) * scale
        q_pos = q0 + jnp.arange(Q_BLOCK, dtype=jnp.int32)
        s = jnp.where(key_pos[None, :] <= q_pos[:, None], s, NEG_INF)
        p = jax.nn.softmax(s, axis=-1).astype(v.dtype)
        return jnp.einsum('bhqk,bkhd->bqhd', p, v)

    o = lax.map(attend, (qn_blocks, qr_blocks, starts))
    return jnp.moveaxis(o, 0, 1).reshape(B, S, H * V_HEAD_DIM)


def _mixer_block(n, cos, sin, w_in, mu_shift, decay_base, w_decay_up, iclr_base, w_iclr_up,
                 w_gate_up, k_k, k_a, r_k, lnx_w, lnx_b, w_out_rwkv, q_norm, w_q_up, kv_norm,
                 w_kv_up, w_out_mla, w_out):
    p = n @ w_in
    p_rw = p[..., :SHIFT_COLS]
    p_rw = p_rw + (_token_shift(p_rw) - p_rw) * mu_shift
    rw_splits = [RWKV_DIM, 2 * RWKV_DIM, 3 * RWKV_DIM, 3 * RWKV_DIM + DECAY_LORA,
                 3 * RWKV_DIM + DECAY_LORA + ICLR_LORA]
    p_r, p_k, p_v, p_w, p_a, p_g = jnp.split(p_rw, rw_splits, axis=-1)
    p_mla = p[..., SHIFT_COLS:SHIFT_COLS + MLA_COLS]
    q_lat, kv_lat, k_pe = jnp.split(p_mla, [Q_LORA_RANK, Q_LORA_RANK + KV_LORA_RANK], axis=-1)
    gate_a, gate_b = jnp.split(p[..., SHIFT_COLS + MLA_COLS:], 2, axis=-1)

    y_a = _rwkv7_time_mix(p_r, p_k, p_v, p_w, p_a, p_g, decay_base, w_decay_up, iclr_base,
                          w_iclr_up, w_gate_up, k_k, k_a, r_k, lnx_w, lnx_b) @ w_out_rwkv
    y_b = _mla(q_lat, kv_lat, k_pe, cos, sin, q_norm, w_q_up, kv_norm, w_kv_up) @ w_out_mla
    merged = jax.nn.sigmoid(gate_a) * y_a + jax.nn.sigmoid(gate_b) * y_b
    return merged @ w_out


def _conv_ffn(n, w_ffn_up, conv_w, conv_b, w_ffn_down):
    S = n.shape[1]
    u_gate, u_val = jnp.split(n @ w_ffn_up, 2, axis=-1)
    up = jnp.pad(u_gate, ((0, 0), (CONV_WIDTH - 1, 0), (0, 0)))
    c = conv_b
    for j in range(CONV_WIDTH):
        c = c + conv_w[j] * up[:, j:j + S]
    return (jax.nn.gelu(c, approximate=False) * u_val) @ w_ffn_down


def setup_inputs(seed: int = 0) -> dict:
    key = jax.random.key(seed)
    ks = jax.random.split(key, 32)
    f32 = jnp.float32

    def nrm(k, shape, fan_in, s=1.0):
        return jax.random.normal(k, shape, f32) * (s * fan_in ** -0.5)

    def gain(k, shape):
        return 1.0 + 0.02 * jax.random.normal(k, shape, f32)

    H, N = RWKV_HEADS, RWKV_HEAD_DIM
    offs = jax.random.randint(ks[1], (BATCH, 1), 0, MAX_POS_OFFSET, dtype=jnp.int32)
    positions = offs + jnp.arange(SEQ, dtype=jnp.int32)[None, :]
    return {
        'x': jax.random.normal(ks[0], (BATCH, SEQ, D_MODEL), f32),
        'positions': positions,
        'attn_norm': gain(ks[2], (DEPTH, D_MODEL)),
        'w_in': nrm(ks[3], (DEPTH, D_MODEL, IN_COLS), D_MODEL),
        'mu_shift': jax.random.uniform(ks[4], (DEPTH, SHIFT_COLS), f32),
        'decay_base': jax.random.uniform(ks[5], (DEPTH, RWKV_DIM), f32, minval=-4.0, maxval=1.0),
        'w_decay_up': nrm(ks[6], (DEPTH, DECAY_LORA, RWKV_DIM), DECAY_LORA),
        'iclr_base': 0.1 * jax.random.normal(ks[7], (DEPTH, RWKV_DIM), f32),
        'w_iclr_up': nrm(ks[8], (DEPTH, ICLR_LORA, RWKV_DIM), ICLR_LORA),
        'w_gate_up': nrm(ks[9], (DEPTH, GATE_LORA, RWKV_DIM), GATE_LORA),
        'k_k': 0.85 + 0.05 * jax.random.normal(ks[10], (DEPTH, RWKV_DIM), f32),
        'k_a': 1.0 + 0.05 * jax.random.normal(ks[11], (DEPTH, RWKV_DIM), f32),
        'r_k': 0.1 * jax.random.normal(ks[12], (DEPTH, H, N), f32),
        'lnx_w': gain(ks[13], (DEPTH, RWKV_DIM)),
        'lnx_b': 0.02 * jax.random.normal(ks[14], (DEPTH, RWKV_DIM), f32),
        'w_out_rwkv': nrm(ks[15], (DEPTH, RWKV_DIM, D_MODEL), RWKV_DIM),
        'q_norm': gain(ks[16], (DEPTH, Q_LORA_RANK)),
        'w_q_up': nrm(ks[17], (DEPTH, Q_LORA_RANK, MLA_HEADS * (QK_NOPE_DIM + QK_ROPE_DIM)), Q_LORA_RANK),
        'kv_norm': gain(ks[18], (DEPTH, KV_LORA_RANK)),
        'w_kv_up': nrm(ks[19], (DEPTH, KV_LORA_RANK, MLA_HEADS * (QK_NOPE_DIM + V_HEAD_DIM)), KV_LORA_RANK),
        'w_out_mla': nrm(ks[20], (DEPTH, MLA_HEADS * V_HEAD_DIM, D_MODEL), MLA_HEADS * V_HEAD_DIM),
        'w_out': nrm(ks[21], (DEPTH, D_MODEL, D_MODEL), D_MODEL),
        'ffn_norm': gain(ks[22], (DEPTH, D_MODEL)),
        'w_ffn_up': nrm(ks[23], (DEPTH, D_MODEL, 2 * FFN_DIM), D_MODEL),
        'conv_w': nrm(ks[24], (DEPTH, CONV_WIDTH, FFN_DIM), CONV_WIDTH),
        'conv_b': 0.02 * jax.random.normal(ks[25], (DEPTH, FFN_DIM), f32),
        'w_ffn_down': nrm(ks[26], (DEPTH, FFN_DIM, D_MODEL), FFN_DIM),
        'final_norm': gain(ks[27], (D_MODEL,)),
    }


def reference(x, positions, attn_norm, w_in, mu_shift, decay_base, w_decay_up, iclr_base,
              w_iclr_up, w_gate_up, k_k, k_a, r_k, lnx_w, lnx_b, w_out_rwkv, q_norm, w_q_up,
              kv_norm, w_kv_up, w_out_mla, w_out, ffn_norm, w_ffn_up, conv_w, conv_b,
              w_ffn_down, final_norm):
    cos, sin = _rope_tables(positions, x.dtype)
    h = x
    for l in range(DEPTH):
        n = _rmsnorm(h, attn_norm[l])
        h = h + _mixer_block(n, cos, sin, w_in[l], mu_shift[l], decay_base[l], w_decay_up[l],
                             iclr_base[l], w_iclr_up[l], w_gate_up[l], k_k[l], k_a[l], r_k[l],
                             lnx_w[l], lnx_b[l], w_out_rwkv[l], q_norm[l], w_q_up[l], kv_norm[l],
                             w_kv_up[l], w_out_mla[l], w_out[l])
        n = _rmsnorm(h, ffn_norm[l])
        h = h + _conv_ffn(n, w_ffn_up[l], conv_w[l], conv_b[l], w_ffn_down[l])
    return _rmsnorm(h, final_norm)
```

```cpp
#include <hip/hip_runtime.h>
#include <hip/hip_cooperative_groups.h>
#include <cstdio>
#include <cstdint>
#include <cmath>
namespace cg = cooperative_groups;

#ifndef MK_MULTI
#define MK_MULTI 1
#endif

constexpr int BATCH = 4, SEQ = 4096, DM = 1024, M = BATCH * SEQ, DEPTH = 2;
constexpr int NH = 8, RD = 512;
constexpr int IN_COLS = 4256, PC = 4352;
constexpr int FF = 2816;
constexpr float NORM_EPS = 1e-6f, LNX_EPS = 64e-5f;
constexpr float C2 = 0.10206207261596577f * 1.4426950408889634f;

namespace pg8 {
#define PG8_LAS __attribute__((address_space(3)))
typedef unsigned short bf16_t;
typedef short bf16x8 __attribute__((ext_vector_type(8)));
typedef float f32x4 __attribute__((ext_vector_type(4)));
typedef unsigned u32x4 __attribute__((ext_vector_type(4)));
constexpr int BM = 256, BK = 64, HALF = 128, HTB = HALF * BK * 2  , STAGE_BYTES = 8 * HTB, NXCD = 8, WGM = 8;

__host__ __device__ __forceinline__ int lds_byte(int r, int c) { const int st = (r >> 4) * 2 + (c >> 5), rr = r & 15, cc = c & 31, ob = rr * 64 + cc * 2; return st * 1024 + (ob ^ (((ob >> 9) & 1) << 5)); }
__host__ __device__ __forceinline__ void stage_rc(int b, int& R, int& C) { const int st = b / 1024, sb = b % 1024, swz = sb ^ (((sb >> 9) & 1) << 5); R = (st >> 1) * 16 + swz / 64; C = (st & 1) * 32 + (swz % 64) / 2; }
__host__ __device__ __forceinline__ int perm32(int rho) { const int n = rho >> 4, i = rho & 15; return 8 * (i >> 2) + 4 * n + (i & 3); }

struct Unit { int pm, pn; };
struct Gemm { const bf16_t* A; const bf16_t* Bt; int M, N, K, lda; };

struct StaticOrder {
    int nM, nN, nwg, G, c;
    __host__ __device__ void init(int M, int N, int G_, int c_) { nM = M / BM; nN = N / BM; nwg = nM * nN; G = G_; c = c_; }
    __host__ __device__ bool next(int i, Unit& u) const {
        const long L = (long)i * G + c; if (L >= nwg) return false;
        int wgid = (int)L; { const int q = nwg / NXCD, r = nwg % NXCD, xcd = wgid % NXCD, off = wgid / NXCD; wgid = (xcd < r ? xcd * (q + 1) : r * (q + 1) + (xcd - r) * q) + off; }
        const int nig = WGM * nN, gid = wgid / nig, fm = gid * WGM, gsz = (nM - fm) < WGM ? (nM - fm) : WGM;
        u.pm = fm + ((wgid % nig) % gsz); u.pn = (wgid % nig) / gsz; return true;
    }
    __device__ __forceinline__ void a_ready(const Unit&) const {}
    __device__ __forceinline__ void done(const Unit&) const {}
};

__device__ __forceinline__ unsigned cvt_pk_bf16(float lo, float hi) { unsigned r; asm volatile("v_cvt_pk_bf16_f32 %0, %1, %2" : "=v"(r) : "v"(lo), "v"(hi)); return r; }
template <class Epi, class Sched, bool ALIGN_EPI = false, bool SP2 = false>
__device__ __forceinline__ void gemm_phase(PG8_LAS unsigned char* lds, const Gemm g, const Sched& S, const Epi& E) {
    int tid_ = threadIdx.x; asm volatile("" : "+v"(tid_)); const int tid = tid_, wid = __builtin_amdgcn_readfirstlane(tid >> 6), lane = tid & 63, wr = wid >> 2, wc = wid & 3, fr = lane & 15, fq = lane >> 4;
    int Kx_ = g.K; asm volatile("" : "+s"(Kx_)); const int K = Kx_, nt = K / BK;
    unsigned voffA[2], voffB[2];
#pragma unroll
    for (int i = 0; i < 2; ++i) { int R, C; stage_rc(tid * 16 + i * 8192, R, C); const int Rb = Epi::PERM ? ((R & ~31) + perm32(R & 31)) : R;
        voffA[i] = (unsigned)(R * g.lda + C) * 2u; voffB[i] = (unsigned)(Rb * K + C) * 2u; }
    const size_t kstep = (size_t)(BK * 2);
    const size_t hstep = (size_t)HALF * K * 2, hstepA = (size_t)HALF * g.lda * 2;
    const size_t tstep = 2 * hstep, tstepA = 2 * hstepA;
    const unsigned ldsw = (unsigned)wid * 1024u;
    const int aoff = lds_byte(wr * 64 + fr, fq * 8), boff = lds_byte(wc * 32 + fr, fq * 8);
#define PG8_SA(b, h) (((b) * 2 + (h)) * HTB)
#define PG8_SB(b, h) ((4 + (b) * 2 + (h)) * HTB)
#define PG8_STAGE(bufoff, gbase, voff) do { _Pragma("unroll") for (int _i = 0; _i < 2; ++_i) \
        __builtin_amdgcn_global_load_lds((const unsigned*)((const char*)(gbase) + (voff)[_i]), (PG8_LAS unsigned*)(lds + (bufoff) + ldsw + _i * 8192), 16, 0, 0); } while (0)
#define PG8_LDA(dst, b, h) do { _Pragma("unroll") for (int m = 0; m < 4; ++m) _Pragma("unroll") for (int k = 0; k < 2; ++k) dst[m][k] = *(const PG8_LAS bf16x8*)(lds + PG8_SA(b, h) + aoff + m * 2048 + k * 1024); } while (0)
#define PG8_LDB(dst, b, h) do { _Pragma("unroll") for (int n = 0; n < 2; ++n) _Pragma("unroll") for (int k = 0; k < 2; ++k) dst[n][k] = *(const PG8_LAS bf16x8*)(lds + PG8_SB(b, h) + boff + n * 2048 + k * 1024); } while (0)
#define PG8_MMA(ai, bj, At, Bt) do { __builtin_amdgcn_s_setprio(1); _Pragma("unroll") for (int m = 0; m < 4; ++m) _Pragma("unroll") for (int n = 0; n < 2; ++n) _Pragma("unroll") for (int k = 0; k < 2; ++k) \
        acc[ai][bj][m][n] = __builtin_amdgcn_mfma_f32_16x16x32_bf16(Bt[n][k], At[m][k], acc[ai][bj][m][n], 0, 0, 0); __builtin_amdgcn_s_setprio(0); } while (0)
#define PG8_WAIT_V(n) asm volatile("s_waitcnt vmcnt(" #n ")" ::: "memory")
#define PG8_WAIT_L(n) asm volatile("s_waitcnt lgkmcnt(" #n ")" ::: "memory")
#define PG8_BAR __builtin_amdgcn_s_barrier()
#define PG8_SCHED __builtin_amdgcn_sched_barrier(0)
    Unit cur, nxt; int ui = 0;
    if (!S.next(0, cur)) return;
    f32x4 acc[2][2][4][2];
#pragma unroll
    for (int a = 0; a < 2; ++a)
#pragma unroll
        for (int b = 0; b < 2; ++b)
#pragma unroll
            for (int m = 0; m < 4; ++m)
#pragma unroll
                for (int n = 0; n < 2; ++n) acc[a][b][m][n] = (f32x4){0.f, 0.f, 0.f, 0.f};
    bf16x8 At[4][2], B0[2][2], B1[2][2];
    const char* cA = (const char*)g.A + (size_t)cur.pm * tstepA; const char* cB = (const char*)g.Bt + (size_t)cur.pn * tstep;
    S.a_ready(cur);
    if constexpr (SP2) {
        PG8_STAGE(PG8_SB(0, 0), cB, voffB); PG8_STAGE(PG8_SB(0, 1), cB + hstep, voffB); PG8_STAGE(PG8_SA(0, 0), cA, voffA); PG8_STAGE(PG8_SA(0, 1), cA + hstepA, voffA);
        if (wr == 1) PG8_BAR;
        PG8_WAIT_V(2); PG8_BAR;
        PG8_STAGE(PG8_SB(1, 0), cB + kstep, voffB); PG8_STAGE(PG8_SA(1, 0), cA + kstep, voffA); PG8_STAGE(PG8_SB(1, 1), cB + hstep + kstep, voffB);
        PG8_WAIT_V(6); PG8_BAR;
    } else {
        PG8_STAGE(PG8_SB(0, 0), cB, voffB); PG8_STAGE(PG8_SA(0, 0), cA, voffA); PG8_STAGE(PG8_SB(0, 1), cB + hstep, voffB); PG8_STAGE(PG8_SA(0, 1), cA + hstepA, voffA);
        if (wr == 1) PG8_BAR;
        PG8_WAIT_V(4); PG8_BAR;
        PG8_STAGE(PG8_SB(1, 0), cB + kstep, voffB); PG8_STAGE(PG8_SA(1, 0), cA + kstep, voffA); PG8_STAGE(PG8_SB(1, 1), cB + hstep + kstep, voffB);
        PG8_WAIT_V(6); PG8_BAR;
    }
    for (;;) {
        const bool has_next = S.next(ui + 1, nxt);
        const char* nA = has_next ? (const char*)g.A + (size_t)nxt.pm * tstepA : cA; const char* nB = has_next ? (const char*)g.Bt + (size_t)nxt.pn * tstep : cB;
#pragma unroll 1
        for (int t = 0; t < nt; t += 2) {
            const bool last = (t == nt - 2);
            const char* a1 = cA + (size_t)(t + 1) * kstep;
            const char* a2 = last ? nA : cA + (size_t)(t + 2) * kstep; const char* b2 = last ? nB : cB + (size_t)(t + 2) * kstep;
            const char* a3 = a2 + kstep; const char* b3 = b2 + kstep;
            if (last && has_next) S.a_ready(nxt);
            if constexpr (SP2) {
            PG8_LDB(B0, 0, 0); PG8_LDB(B1, 0, 1); PG8_SCHED; PG8_LDA(At, 0, 0); PG8_STAGE(PG8_SA(1, 1), a1 + hstepA, voffA);
            PG8_WAIT_V(8); PG8_WAIT_L(0); PG8_BAR; PG8_MMA(0, 0, At, B0); PG8_MMA(0, 1, At, B1); PG8_BAR; PG8_SCHED;
            PG8_LDA(At, 0, 1); PG8_STAGE(PG8_SB(0, 0), b2, voffB); PG8_STAGE(PG8_SB(0, 1), b2 + hstep, voffB); PG8_STAGE(PG8_SA(0, 0), a2, voffA);
            PG8_WAIT_V(8); PG8_WAIT_L(0); PG8_BAR; PG8_MMA(1, 0, At, B0); PG8_MMA(1, 1, At, B1); PG8_BAR; PG8_SCHED;
            PG8_LDB(B0, 1, 0); PG8_LDB(B1, 1, 1); PG8_SCHED; PG8_LDA(At, 1, 0); PG8_STAGE(PG8_SA(0, 1), a2 + hstepA, voffA);
            PG8_WAIT_V(8); PG8_WAIT_L(0); PG8_BAR; PG8_MMA(0, 0, At, B0); PG8_MMA(0, 1, At, B1); PG8_BAR; PG8_SCHED;
            PG8_LDA(At, 1, 1); PG8_STAGE(PG8_SB(1, 0), b3, voffB); PG8_STAGE(PG8_SB(1, 1), b3 + hstep, voffB); PG8_STAGE(PG8_SA(1, 0), a3, voffA);
            PG8_WAIT_V(8); PG8_WAIT_L(0); PG8_BAR; PG8_MMA(1, 0, At, B0); PG8_MMA(1, 1, At, B1); PG8_BAR; PG8_SCHED;
            } else {
            PG8_LDB(B0, 0, 0); PG8_SCHED; PG8_LDA(At, 0, 0); PG8_STAGE(PG8_SA(1, 1), a1 + hstepA, voffA);
            PG8_WAIT_L(8); PG8_BAR; PG8_WAIT_L(0); PG8_MMA(0, 0, At, B0); PG8_BAR; PG8_SCHED;
            PG8_LDB(B1, 0, 1); PG8_STAGE(PG8_SB(0, 0), b2, voffB);
            PG8_BAR; PG8_WAIT_L(0); PG8_MMA(0, 1, At, B1); PG8_BAR;
            PG8_LDA(At, 0, 1); PG8_STAGE(PG8_SA(0, 0), a2, voffA);
            PG8_BAR; PG8_WAIT_L(0); PG8_MMA(1, 0, At, B0); PG8_BAR; PG8_SCHED;
            PG8_STAGE(PG8_SB(0, 1), b2 + hstep, voffB);
            PG8_WAIT_V(6); PG8_BAR; PG8_MMA(1, 1, At, B1); PG8_BAR;
            PG8_LDB(B0, 1, 0); PG8_SCHED; PG8_LDA(At, 1, 0); PG8_STAGE(PG8_SA(0, 1), a2 + hstepA, voffA);
            PG8_WAIT_L(8); PG8_BAR; PG8_WAIT_L(0); PG8_MMA(0, 0, At, B0); PG8_BAR; PG8_SCHED;
            PG8_LDB(B1, 1, 1); PG8_STAGE(PG8_SB(1, 0), b3, voffB);
            PG8_BAR; PG8_WAIT_L(0); PG8_MMA(0, 1, At, B1); PG8_BAR;
            PG8_LDA(At, 1, 1); PG8_STAGE(PG8_SA(1, 0), a3, voffA);
            PG8_BAR; PG8_WAIT_L(0); PG8_MMA(1, 0, At, B0); PG8_BAR; PG8_SCHED;
            PG8_STAGE(PG8_SB(1, 1), b3 + hstep, voffB);
            PG8_WAIT_V(6); PG8_BAR; PG8_MMA(1, 1, At, B1); PG8_BAR;
            }
        }
        if constexpr (ALIGN_EPI) { if (wr == 0) PG8_BAR; }
        if constexpr (!Epi::AFTER_DRAIN) { E(acc, cur, wr, wc, fr, fq); S.done(cur); }
        if (!has_next) break;
#pragma unroll
        for (int a = 0; a < 2; ++a)
#pragma unroll
            for (int b = 0; b < 2; ++b)
#pragma unroll
                for (int m = 0; m < 4; ++m)
#pragma unroll
                    for (int n = 0; n < 2; ++n) acc[a][b][m][n] = (f32x4){0.f, 0.f, 0.f, 0.f};
        cur = nxt; cA = nA; cB = nB; ++ui;
        if constexpr (ALIGN_EPI) { if (wr == 1) PG8_BAR; }
    }
    PG8_WAIT_V(0);
    if constexpr (!ALIGN_EPI) { if (wr == 0) PG8_BAR; }
    PG8_BAR;
    if constexpr (Epi::AFTER_DRAIN) { E.fused(acc, cur, wr, wc, fr, fq, lds, wid, lane); S.done(cur); }
#undef PG8_SA
#undef PG8_SB
#undef PG8_STAGE
#undef PG8_LDA
#undef PG8_LDB
#undef PG8_MMA
#undef PG8_WAIT_V
#undef PG8_WAIT_L
#undef PG8_BAR
#undef PG8_SCHED
}
}

#define LAS __attribute__((address_space(3)))
typedef unsigned short bf16_t;
typedef short bf16x8 __attribute__((ext_vector_type(8)));
typedef short s16x4 __attribute__((ext_vector_type(4)));
typedef float f32x4 __attribute__((ext_vector_type(4)));
typedef float f32x16 __attribute__((ext_vector_type(16)));
typedef unsigned u32x4 __attribute__((ext_vector_type(4)));
typedef unsigned u32x2 __attribute__((ext_vector_type(2)));

__device__ __forceinline__ float bf2f(unsigned b) { return __uint_as_float(b << 16); }
__device__ __forceinline__ unsigned f2bf(float f) { unsigned u = __float_as_uint(f); return (u + 0x7fffu + ((u >> 16) & 1u)) >> 16; }
__device__ __forceinline__ unsigned pk2(float lo, float hi) { return pg8::cvt_pk_bf16(lo, hi); }
__device__ __forceinline__ float sigm(float x) { return 1.0f / (1.0f + __expf(-x)); }
__device__ __forceinline__ f32x4 up4(u32x2 v) { return (f32x4){__uint_as_float(v.x << 16), __uint_as_float(v.x & 0xffff0000u), __uint_as_float(v.y << 16), __uint_as_float(v.y & 0xffff0000u)}; }
__device__ __forceinline__ u32x2 dn4(f32x4 v) { u32x2 r; r.x = pk2(v.x, v.y); r.y = pk2(v.z, v.w); return r; }
__device__ __forceinline__ float dot4(f32x4 a, f32x4 b) { return (a.x * b.x + a.y * b.y) + (a.z * b.z + a.w * b.w); }

constexpr size_t MiB = 1u << 20;
constexpr size_t WS_CTL = 0, CTL_ZERO_BYTES = 2 * MiB;
constexpr size_t WS_STAT = 1 * MiB;
constexpr size_t WS_CS = 2 * MiB;
constexpr size_t WS_W = 4 * MiB;
constexpr size_t W_IN = 0, W_LORA = W_IN + (size_t)PC * 1024 * 2, W_Q = W_LORA + 1536 * 256 * 2, W_KV = W_Q + 768 * 256 * 2,
                 W_OA = W_KV + 1024 * 256 * 2, W_OB = W_OA + 1024 * 512 * 2, W_OUT = W_OB + 1024 * 512 * 2,
                 W_UP = W_OUT + 1024 * 1024 * 2, W_DOWN = W_UP + (size_t)2 * FF * 1024 * 2, W_END = W_DOWN + (size_t)1024 * FF * 2;
static_assert(W_END <= 31 * MiB, "weights region");
constexpr size_t WS_ACT = 35 * MiB;
constexpr size_t A_RKV = WS_ACT + 0 * MiB;
constexpr size_t A_LORAC = WS_ACT + 48 * MiB;
constexpr size_t A_QP = A_LORAC;
constexpr size_t A_PM = WS_ACT + 56 * MiB;
constexpr size_t A_Y = A_PM;
constexpr size_t A_G8 = WS_ACT + 72 * MiB;
constexpr size_t A_LIN = WS_ACT + 104 * MiB;
constexpr size_t A_KPE = WS_ACT + 112 * MiB;
constexpr size_t WS_SCAL = WS_ACT + 113 * MiB;
constexpr size_t A_LW = WS_ACT + 114 * MiB;
constexpr size_t A_YA = A_LW;
constexpr size_t A_ICLR = WS_ACT + 130 * MiB;
constexpr size_t A_GATE = WS_ACT + 146 * MiB;
constexpr size_t A_MERGED = A_ICLR;
constexpr size_t A_QN = WS_ACT + 162 * MiB;
constexpr size_t A_KN = WS_ACT + 178 * MiB;
constexpr size_t A_VT = WS_ACT + 194 * MiB;
constexpr size_t A_HB = A_KN;
constexpr size_t A_TMP = WS_ACT + 0 * MiB;
constexpr size_t A_ACT = WS_ACT + 0 * MiB;
constexpr size_t A_UG = WS_ACT + 88 * MiB;
constexpr size_t WS_SSP = WS_ACT + 210 * MiB;
constexpr size_t WS_SSQP = WS_SSP + 5 * MiB;
constexpr size_t WS_END = WS_SSQP + 1 * MiB;
static_assert(A_UG + (size_t)M * FF * 2 <= A_HB && WS_END <= 256 * MiB, "workspace map");
static_assert(A_ICLR == A_LW + (size_t)M * 512 * 2 && A_GATE == A_ICLR + (size_t)M * 512 * 2, "LW | ICLR | GATE consecutive");
constexpr int CW_BAR = 4096;

#define XB_TMO      128
#define XB_XCNT(j)  (256  + 64 * (j))
#define XB_XSUB(j)  (1280 + 64 * (j))
#define XB_XGEN(j)  (2304 + 64 * (j))
#define XB_TOP      3328
#define XB_TOPGEN   3392
#define XCD_BAR_WORDS 3456
#define XB_SPIN_CAP (1u << 18)
__device__ __forceinline__ unsigned xb_ld(unsigned* p)              { return __hip_atomic_load(p, __ATOMIC_RELAXED, __HIP_MEMORY_SCOPE_AGENT); }
__device__ __forceinline__ unsigned xb_add(unsigned* p, unsigned v) { return __hip_atomic_fetch_add(p, v, __ATOMIC_RELAXED, __HIP_MEMORY_SCOPE_AGENT); }
__device__ __forceinline__ unsigned xb_xcc_id() { return (unsigned)__builtin_amdgcn_s_getreg((3 << 11) | 20) & 0xFu; }
#define XB_SPIN(cond, bar) do { unsigned _sp = 0; while (cond) { __builtin_amdgcn_s_sleep(1); \
    if ((++_sp & 255u) == 0u) { if (xb_ld(&(bar)[XB_TMO])) break; if (_sp > XB_SPIN_CAP) { atomicAdd(&(bar)[XB_TMO], 1u); break; } } } } while (0)
struct XcdBarrier { unsigned* bar; unsigned x; volatile LAS unsigned* st; };
__device__ __forceinline__ XcdBarrier xcd_barrier_post(unsigned* bar, volatile LAS unsigned* st) {
    XcdBarrier b; b.bar = bar; b.x = xb_xcc_id(); b.st = st;
    if (threadIdx.x == 0) (void)xb_add(&bar[XB_XCNT(b.x)], 1u);
    return b;
}
__device__ __forceinline__ void xcd_barrier_complete(unsigned* bar, unsigned x, unsigned& nloc, unsigned& nx) {
    const unsigned G = gridDim.x * gridDim.y * gridDim.z;
    unsigned sum, cnt, mine, sp = 0u;
    for (;;) {
        sum = 0u; cnt = 0u; mine = 0u;
#pragma unroll
        for (unsigned j = 0; j < 16; ++j) { const unsigned c = xb_ld(&bar[XB_XCNT(j)]); sum += c; cnt += (c > 0u) ? 1u : 0u; mine = (j == x) ? c : mine; }
        if (sum == G) break;
        __builtin_amdgcn_s_sleep(1);
        if ((++sp & 255u) == 0u) { if (xb_ld(&bar[XB_TMO])) break; if (sp > XB_SPIN_CAP) { atomicAdd(&bar[XB_TMO], 1u); break; } }
    }
    nloc = mine > 0u ? mine : 1u; nx = cnt > 0u ? cnt : 1u;
}
__device__ __forceinline__ void xcd_barrier(const XcdBarrier& b) {
    asm volatile("s_waitcnt vmcnt(0)" ::: "memory");
    __syncthreads();
    if (threadIdx.x == 0) {
        unsigned* bar = b.bar;
        __builtin_amdgcn_s_waitcnt(0);
        unsigned nloc = b.st[0], nx = b.st[1];
        if (nloc == 0u) { xcd_barrier_complete(bar, b.x, nloc, nx); b.st[0] = nloc; b.st[1] = nx; }
        const unsigned old = xb_add(&bar[XB_XSUB(b.x)], 1u);
        const unsigned gen = old / nloc;
        if (old + 1u == (gen + 1u) * nloc) {
            __builtin_amdgcn_fence(__ATOMIC_RELEASE, "agent");
            asm volatile("s_waitcnt vmcnt(0)" ::: "memory");
            const unsigned og = xb_add(&bar[XB_TOP], 1u);
            const unsigned tg = og / nx;
            if (og + 1u == (tg + 1u) * nx) xb_add(&bar[XB_TOPGEN], 1u);
            else XB_SPIN(xb_ld(&bar[XB_TOPGEN]) == tg, bar);
            __builtin_amdgcn_fence(__ATOMIC_ACQUIRE, "agent");
            xb_add(&bar[XB_XGEN(b.x)], 1u);
            asm volatile("s_waitcnt vmcnt(0)" ::: "memory");
        } else {
            XB_SPIN(xb_ld(&bar[XB_XGEN(b.x)]) == gen, bar);
            __builtin_amdgcn_fence(__ATOMIC_ACQUIRE, "agent");
            asm volatile("s_waitcnt vmcnt(0)" ::: "memory");
        }
    }
    __syncthreads();
}

namespace pg8 {
__device__ __forceinline__ float sum16(const float* p) { const f32x4 a = *(const f32x4*)p, b = *(const f32x4*)(p + 4), c = *(const f32x4*)(p + 8), d = *(const f32x4*)(p + 12);
    return (((a.x + a.y) + (a.z + a.w)) + ((b.x + b.y) + (b.z + b.w))) + (((c.x + c.y) + (c.z + c.w)) + ((d.x + d.y) + (d.z + d.w))); }
__device__ __forceinline__ float sum4(const float* p) { const f32x4 a = *(const f32x4*)p; return (a.x + a.y) + (a.z + a.w); }
__device__ __forceinline__ u32x4 pack8(f32x4 a, f32x4 b) { u32x4 w; w.x = cvt_pk_bf16(a[0], a[1]); w.y = cvt_pk_bf16(a[2], a[3]); w.z = cvt_pk_bf16(b[0], b[1]); w.w = cvt_pk_bf16(b[2], b[3]); return w; }
__device__ __forceinline__ unsigned q8(float s) { return (unsigned)(s * 255.0f + 0.5f); }
__device__ __forceinline__ unsigned sig8x4(f32x4 v) { return q8(sigm(v[0])) | (q8(sigm(v[1])) << 8) | (q8(sigm(v[2])) << 16) | (q8(sigm(v[3])) << 24); }

struct EpiP {
    static constexpr bool PERM = true, AFTER_DRAIN = false;
    bf16_t* RKV; bf16_t* LORAC; bf16_t* PMb; unsigned char* G8; const float* ss; float* ssq; float* sskv;
    __device__ __forceinline__ void operator()(const f32x4 (&acc)[2][2][4][2], const Unit& u, int wr, int wc, int fr, int fq) const {
        const int row0 = u.pm * BM + wr * 64 + fr, pn = u.pn;
#pragma unroll
        for (int ai = 0; ai < 2; ++ai)
#pragma unroll
            for (int m = 0; m < 4; ++m) {
                const int row = row0 + ai * HALF + m * 16;
                const float rs = rsqrtf(sum16(ss + (size_t)row * 16) * (1.0f / 1024.0f) + NORM_EPS);
                float sq = 0.f;
#pragma unroll
                for (int bj = 0; bj < 2; ++bj) {
                    const f32x4 v0 = acc[ai][bj][m][0] * rs, v1 = acc[ai][bj][m][1] * rs;
                    const int ct = bj * HALF + wc * 32 + 8 * fq;
                    if (pn < 6) *(u32x4*)(RKV + (size_t)row * 1536 + pn * 256 + ct) = pack8(v0, v1);
                    else if (pn == 6) *(u32x4*)(LORAC + (size_t)row * 256 + ct) = pack8(v0, v1);
                    else if (pn < 9) { *(u32x4*)(PMb + (size_t)row * 512 + (pn - 7) * 256 + ct) = pack8(v0, v1);
                        if (pn == 7 || bj == 0) sq += dot4(v0, v0) + dot4(v1, v1); }
                    else { u32x2 w; w.x = sig8x4(v0); w.y = sig8x4(v1); *(u32x2*)(G8 + (size_t)row * 2048 + (pn - 9) * 256 + ct) = w; }
                }
                if (pn == 7 || pn == 8) { sq += __shfl_xor(sq, 16); sq += __shfl_xor(sq, 32); if (fq == 0) (pn == 7 ? ssq : sskv)[(size_t)row * 4 + wc] = sq; }
            }
    }
};
struct EpiLora {
    static constexpr bool PERM = true, AFTER_DRAIN = false;
    bf16_t* LW; bf16_t* ICLR; bf16_t* GATE; const float* dbase; const float* ibase;
    __device__ __forceinline__ void operator()(const f32x4 (&acc)[2][2][4][2], const Unit& u, int wr, int wc, int fr, int fq) const {
        const int pn = u.pn, kind = pn >> 1;
        bf16_t* dst = LW + (size_t)kind * ((size_t)M * 512);
        const float* bias = kind == 0 ? dbase : ibase;
        const unsigned c0 = (pn & 1) * 256 + wc * 32 + 8 * fq;
        const unsigned off0 = (unsigned)(u.pm * BM + wr * 64 + fr) * 512u + c0;
#pragma unroll
        for (int bj = 0; bj < 2; ++bj) {
            f32x4 b0 = (f32x4){0.f, 0.f, 0.f, 0.f}, b1 = b0;
            if (kind < 2) { b0 = *(const f32x4*)(bias + c0 + bj * HALF); b1 = *(const f32x4*)(bias + c0 + bj * HALF + 4); }
#pragma unroll
            for (int ai = 0; ai < 2; ++ai)
#pragma unroll
                for (int m = 0; m < 4; ++m) {
                    f32x4 v0 = acc[ai][bj][m][0] + b0, v1 = acc[ai][bj][m][1] + b1;
                    if (kind == 0) { for (int e = 0; e < 4; ++e) { v0[e] = -0.6065306597126334f * sigm(v0[e]); v1[e] = -0.6065306597126334f * sigm(v1[e]); } }
                    else if (kind == 1) { for (int e = 0; e < 4; ++e) { v0[e] = sigm(v0[e]); v1[e] = sigm(v1[e]); } }
                    *(u32x4*)(dst + off0 + (unsigned)((ai * HALF + m * 16) * 512 + bj * HALF)) = pack8(v0, v1);
                    asm volatile("" ::: "memory");
                }
        }
    }
};
struct EpiQ {
    static constexpr bool PERM = false, AFTER_DRAIN = false;
    bf16_t* Qn; bf16_t* Qp; const float* ssq; const float* CS;
    __device__ __forceinline__ void operator()(const f32x4 (&acc)[2][2][4][2], const Unit& u, int wr, int wc, int fr, int fq) const {
        const int row0 = u.pm * BM + wr * 64 + fr, pn = u.pn;
#pragma unroll
        for (int ai = 0; ai < 2; ++ai)
#pragma unroll
            for (int m = 0; m < 4; ++m) {
                const int row = row0 + ai * HALF + m * 16;
                const float rs = rsqrtf(sum4(ssq + (size_t)row * 4) * (1.0f / 256.0f) + NORM_EPS) * C2;
                if (pn < 2) {
#pragma unroll
                    for (int bj = 0; bj < 2; ++bj)
#pragma unroll
                        for (int n = 0; n < 2; ++n) *(u32x2*)(Qn + (size_t)row * 512 + pn * 256 + bj * HALF + wc * 32 + n * 16 + 4 * fq) = dn4(acc[ai][bj][m][n] * rs);
                } else {
                    const f32x4 cs = *(const f32x4*)(CS + (size_t)row * 32 + 4 * fq), sn = *(const f32x4*)(CS + (size_t)row * 32 + 16 + 4 * fq);
#pragma unroll
                    for (int bj = 0; bj < 2; ++bj) {
                        const f32x4 x1 = acc[ai][bj][m][0] * rs, x2 = acc[ai][bj][m][1] * rs;
                        bf16_t* d = Qp + (size_t)row * 256 + (4 * bj + wc) * 32 + 4 * fq;
                        *(u32x2*)d = dn4(x1 * cs - x2 * sn); *(u32x2*)(d + 16) = dn4(x1 * sn + x2 * cs);
                    }
                }
            }
    }
};
struct EpiKV {
    static constexpr bool PERM = false, AFTER_DRAIN = false;
    bf16_t* Kn; bf16_t* Vt; const float* sskv;
    __device__ __forceinline__ void operator()(const f32x4 (&acc)[2][2][4][2], const Unit& u, int wr, int wc, int fr, int fq) const {
        const int row0 = u.pm * BM + wr * 64 + fr, pn = u.pn;
#pragma unroll
        for (int ai = 0; ai < 2; ++ai)
#pragma unroll
            for (int m = 0; m < 4; ++m) {
                const int row = row0 + ai * HALF + m * 16;
                const float rs = rsqrtf(sum4(sskv + (size_t)row * 4) * (1.0f / 128.0f) + NORM_EPS);
                if (pn < 2) {
#pragma unroll
                    for (int bj = 0; bj < 2; ++bj)
#pragma unroll
                        for (int n = 0; n < 2; ++n) *(u32x2*)(Kn + (size_t)row * 512 + pn * 256 + bj * HALF + wc * 32 + n * 16 + 4 * fq) = dn4(acc[ai][bj][m][n] * rs);
                } else {
                    const int b = row >> 12, s = row & 4095;
#pragma unroll
                    for (int bj = 0; bj < 2; ++bj)
#pragma unroll
                        for (int n = 0; n < 2; ++n) {
                            const int hd = (pn - 2) * 4 + 2 * bj + (wc >> 1), d = 32 * (wc & 1) + 16 * n + 4 * fq;
                            const f32x4 v = acc[ai][bj][m][n] * rs;
                            bf16_t* dst = Vt + ((size_t)((b * 8 + hd) * 64 + d) << 12) + s;
#pragma unroll
                            for (int j = 0; j < 4; ++j) dst[(size_t)j << 12] = (bf16_t)f2bf(v[j]);
                        }
                }
            }
    }
};
template <int PASS> struct EpiMix {
    static constexpr bool PERM = false, AFTER_DRAIN = false;
    float* TMP; bf16_t* MERGED; const unsigned char* G8;
    __device__ __forceinline__ void operator()(const f32x4 (&acc)[2][2][4][2], const Unit& u, int wr, int wc, int fr, int fq) const {
        const int row0 = u.pm * BM + wr * 64 + fr;
#pragma unroll
        for (int ai = 0; ai < 2; ++ai)
#pragma unroll
            for (int m = 0; m < 4; ++m) {
                const int row = row0 + ai * HALF + m * 16;
#pragma unroll
                for (int bj = 0; bj < 2; ++bj)
#pragma unroll
                    for (int n = 0; n < 2; ++n) {
                        const int c = u.pn * BM + bj * HALF + wc * 32 + n * 16 + 4 * fq;
                        const unsigned g = *(const unsigned*)(G8 + (size_t)row * 2048 + (PASS - 1) * 1024 + c);
                        const f32x4 s = (f32x4){(float)(g & 255u), (float)((g >> 8) & 255u), (float)((g >> 16) & 255u), (float)(g >> 24)} * (1.0f / 255.0f);
                        if (PASS == 1) *(f32x4*)(TMP + (size_t)row * 1024 + c) = acc[ai][bj][m][n] * s;
                        else { const f32x4 t = *(const f32x4*)(TMP + (size_t)row * 1024 + c); *(u32x2*)(MERGED + (size_t)row * 1024 + c) = dn4(t + acc[ai][bj][m][n] * s); }
                    }
            }
    }
};
struct EpiRes {
    static constexpr bool PERM = false, AFTER_DRAIN = false;
    const float* base; float* out; bf16_t* HB; float* ssacc;
    __device__ __forceinline__ void operator()(const f32x4 (&acc)[2][2][4][2], const Unit& u, int wr, int wc, int fr, int fq) const {
        const int row0 = u.pm * BM + wr * 64 + fr;
#pragma unroll
        for (int ai = 0; ai < 2; ++ai)
#pragma unroll
            for (int m = 0; m < 4; ++m) {
                const int row = row0 + ai * HALF + m * 16; float sq = 0.f;
#pragma unroll
                for (int bj = 0; bj < 2; ++bj)
#pragma unroll
                    for (int n = 0; n < 2; ++n) {
                        const size_t off = (size_t)row * 1024 + u.pn * BM + bj * HALF + wc * 32 + n * 16 + 4 * fq;
                        const f32x4 v = *(const f32x4*)(base + off) + acc[ai][bj][m][n];
                        *(f32x4*)(out + off) = v; *(u32x2*)(HB + off) = dn4(v); sq += dot4(v, v);
                    }
                sq += __shfl_xor(sq, 16); sq += __shfl_xor(sq, 32);
                if (fq == 0) ssacc[(size_t)row * 16 + u.pn * 4 + wc] = sq;
            }
    }
};
struct EpiUpG {
    static constexpr bool PERM = true, AFTER_DRAIN = false;
    bf16_t* UG; const float* ss;
    __device__ __forceinline__ void operator()(const f32x4 (&acc)[2][2][4][2], const Unit& u, int wr, int wc, int fr, int fq) const {
        const int row0 = u.pm * BM + wr * 64 + fr;
#pragma unroll
        for (int ai = 0; ai < 2; ++ai)
#pragma unroll
            for (int m = 0; m < 4; ++m) {
                const int row = row0 + ai * HALF + m * 16;
                const float rs = rsqrtf(sum16(ss + (size_t)row * 16) * (1.0f / 1024.0f) + NORM_EPS);
#pragma unroll
                for (int bj = 0; bj < 2; ++bj) *(u32x4*)(UG + (size_t)row * FF + u.pn * BM + bj * HALF + wc * 32 + 8 * fq) = pack8(acc[ai][bj][m][0] * rs, acc[ai][bj][m][1] * rs);
            }
    }
};
typedef float f32x2 __attribute__((ext_vector_type(2)));
__device__ __forceinline__ float gelu1(float v) {
    const float av = fabsf(v), t = __builtin_amdgcn_rcpf(av * 0.2316418882f + 1.0f);
    float q = t * 0.5307027145f + (-0.7265760135f); q = q * t + 0.7107068705f; q = q * t + (-0.142248368f); q = q * t + 0.127414796f; q = q * t;
    const float e = __builtin_amdgcn_exp2f((v * v) * (-0.72134752044f)), m = v * (q * e);
    return v < 0.f ? m : v - m;
}
struct EpiUpV {
    static constexpr bool PERM = true, AFTER_DRAIN = false;
    const bf16_t* UG; bf16_t* ACT; const float* ss; const float* cw; const float* cb;
    __device__ __forceinline__ void operator()(const f32x4 (&acc)[2][2][4][2], const Unit& u, int wr, int wc, int fr, int fq) const {
        const int row0 = u.pm * BM + wr * 64 + fr;
#pragma unroll
        for (int ai = 0; ai < 2; ++ai)
#pragma unroll
            for (int m = 0; m < 4; ++m) {
                const int row = row0 + ai * HALF + m * 16, t = row & 4095;
                const float rs = rsqrtf(sum16(ss + (size_t)row * 16) * (1.0f / 1024.0f) + NORM_EPS);
#pragma unroll
                for (int bj = 0; bj < 2; ++bj)
#pragma unroll
                    for (int n = 0; n < 2; ++n) {
                        const int c = u.pn * BM + bj * HALF + wc * 32 + 8 * fq + 4 * n;
                        const f32x4 w0 = *(const f32x4*)(cw + c), w1 = *(const f32x4*)(cw + FF + c), w2 = *(const f32x4*)(cw + 2 * FF + c), bb = *(const f32x4*)(cb + c);
                        const u32x2 z = (u32x2){0u, 0u};
                        const f32x4 x2 = up4(*(const u32x2*)(UG + (size_t)row * FF + c));
                        const f32x4 x1 = up4(t >= 1 ? *(const u32x2*)(UG + (size_t)(row - 1) * FF + c) : z);
                        const f32x4 x0 = up4(t >= 2 ? *(const u32x2*)(UG + (size_t)(row - 2) * FF + c) : z);
                        const f32x4 cv = bb + w0 * x0 + w1 * x1 + w2 * x2, uv = acc[ai][bj][m][n] * rs;
                        f32x4 o; o.x = gelu1(cv.x) * uv.x; o.y = gelu1(cv.y) * uv.y; o.z = gelu1(cv.z) * uv.z; o.w = gelu1(cv.w) * uv.w;
                        *(u32x2*)(ACT + (size_t)row * FF + c) = dn4(o);
                    }
                asm volatile("" ::: "memory");
            }
    }
};
}


#ifndef NAIVE_GEMM
#define NAIVE_GEMM 0
#endif
#ifndef NAIVE_ATTN
#define NAIVE_ATTN 0
#endif
#ifndef SHFL_SCAN
#define SHFL_SCAN 0
#endif
namespace pg8 {
template <class Epi, class Sched>
__device__ __forceinline__ void gemm_phase_naive(const Gemm g, const Sched& S, const Epi& E) {
    const int tid = threadIdx.x, wid = tid >> 6, lane = tid & 63, wr = wid >> 2, wc = wid & 3, fr = lane & 15, fq = lane >> 4;
    Unit u;
    for (int i = 0; S.next(i, u); ++i) {
        f32x4 acc[2][2][4][2];
        _Pragma("unroll") for (int a = 0; a < 2; ++a) _Pragma("unroll") for (int b = 0; b < 2; ++b) _Pragma("unroll") for (int m = 0; m < 4; ++m) _Pragma("unroll") for (int n = 0; n < 2; ++n) {
            const int row = u.pm * BM + a * HALF + wr * 64 + m * 16 + fr;
            _Pragma("unroll") for (int j = 0; j < 4; ++j) {
                const int col = u.pn * BM + b * HALF + wc * 32 + (Epi::PERM ? 8 * fq + 4 * n + j : 16 * n + 4 * fq + j);
                const bf16_t* ap = g.A + (size_t)row * g.lda; const bf16_t* bp = g.Bt + (size_t)col * g.K;
                float s = 0.f;
                _Pragma("unroll 1") for (int k = 0; k < g.K; k += 8) {
                    const u32x4 av = *(const u32x4*)(ap + k), bv = *(const u32x4*)(bp + k);
                    for (int e = 0; e < 4; ++e) { s += __uint_as_float(av[e] << 16) * __uint_as_float(bv[e] << 16); s += __uint_as_float(av[e] & 0xffff0000u) * __uint_as_float(bv[e] & 0xffff0000u); }
                }
                acc[a][b][m][n][j] = s;
            }
        }
        E(acc, u, wr, wc, fr, fq);
    }
}
}
#if NAIVE_GEMM
#define GEMM_PHASE(EPI, lds, g, S, E) pg8::gemm_phase_naive<EPI, pg8::StaticOrder>(g, S, E)
#else
#define GEMM_PHASE(EPI, lds, g, S, E) pg8::gemm_phase<EPI, pg8::StaticOrder, true, true>(lds, g, S, E)
#endif
struct Args {
    const float* in[28]; float* out; unsigned char* ws; int ph_lo, ph_hi;
};
enum { I_X = 0, I_POS, I_ATTN_NORM, I_W_IN, I_MU, I_DBASE, I_W_DEC, I_IBASE, I_W_ICLR, I_W_GATE, I_KK, I_KA, I_RK, I_LNXW, I_LNXB, I_W_ORWKV, I_QNORM, I_W_QUP,
       I_KVNORM, I_W_KVUP, I_W_OMLA, I_W_OUT, I_FFN_NORM, I_W_UP, I_CONVW, I_CONVB, I_W_DOWN, I_FINAL };

typedef const __attribute__((address_space(4))) Args* ArgsP;
__device__ __forceinline__ ArgsP args_ptr() { ArgsP p = (ArgsP)__builtin_amdgcn_kernarg_segment_ptr(); asm volatile("" : "+s"(p)); return p; }
__device__ __forceinline__ int ltid() { int t = threadIdx.x; asm volatile("" : "+v"(t)); return t; }
constexpr int NWAVES = 8, NTHREADS = 512;
constexpr int RING_BYTES = 131072, MISC_OFF = RING_BYTES + 320, LDS_BYTES = 147456;

__device__ __forceinline__ void tr_item(const float* W, int N, int k0, int n0, bf16_t* dst, int drow, int ldk, int koff, const float* scale, LAS float* scr, int lane) {
#pragma unroll 8
    for (int i = 0; i < 32; ++i) { const int kk = 2 * i + (lane >> 5); float v = W[(size_t)(k0 + kk) * N + n0 + (lane & 31)]; if (scale) v *= scale[k0 + kk]; scr[kk * 33 + (lane & 31)] = v; }
    asm volatile("s_waitcnt lgkmcnt(0)" ::: "memory");
    const int c = lane & 7;
#pragma unroll
    for (int j = 0; j < 4; ++j) { const int n = (lane >> 3) + 8 * j; const LAS float* s = scr + (8 * c) * 33 + n;
        u32x4 o; o.x = pk2(s[0 * 33], s[1 * 33]); o.y = pk2(s[2 * 33], s[3 * 33]); o.z = pk2(s[4 * 33], s[5 * 33]); o.w = pk2(s[6 * 33], s[7 * 33]);
        *(u32x4*)(dst + (size_t)(drow + n) * ldk + koff + k0 + 8 * c) = o; }
    asm volatile("s_waitcnt lgkmcnt(0)" ::: "memory");
}
__device__ __forceinline__ void phase_weights(ArgsP a, int l, LAS unsigned char* lds) {
    a = args_ptr();
    const int tid = ltid(), lane = tid & 63, wave = tid >> 6;
    const int gw = blockIdx.x * NWAVES + wave, NGW = gridDim.x * NWAVES;
    LAS float* scr = (LAS float*)(lds + wave * 16384);
    unsigned char* wb = a->ws + WS_W;
    bf16_t* Wt_in = (bf16_t*)(wb + W_IN); bf16_t* Wt_lora = (bf16_t*)(wb + W_LORA); bf16_t* Wt_q = (bf16_t*)(wb + W_Q); bf16_t* Wt_kv = (bf16_t*)(wb + W_KV);
    bf16_t* Wt_oa = (bf16_t*)(wb + W_OA); bf16_t* Wt_ob = (bf16_t*)(wb + W_OB); bf16_t* Wt_out = (bf16_t*)(wb + W_OUT); bf16_t* Wt_up = (bf16_t*)(wb + W_UP); bf16_t* Wt_down = (bf16_t*)(wb + W_DOWN);
    constexpr int I_IN = 16 * 133, I_DEC = 1 * 16, I_ICL = 1 * 16, I_GAT = 2 * 16, I_Q = 4 * 24, I_KV = 2 * 32, I_OA = 8 * 32, I_OB = 8 * 32, I_OUT = 16 * 32, I_UP = 16 * 176, I_DN = 44 * 32;
    constexpr int NITEMS = I_IN + I_DEC + I_ICL + I_GAT + I_Q + I_KV + I_OA + I_OB + I_OUT + I_UP + I_DN;
    for (int it = gw; it < NITEMS; it += NGW) {
        int r = it;
        const float* W; const float* scale = nullptr; bf16_t* dst; int N, kb, nb, drow, ldk, koff = 0;
        if (r < I_IN) { kb = r / 133; nb = r % 133; W = a->in[I_W_IN] + (size_t)l * 1024 * IN_COLS; N = IN_COLS; dst = Wt_in; drow = nb * 32 < 2208 ? nb * 32 : nb * 32 + 96; ldk = 1024; scale = a->in[I_ATTN_NORM] + l * 1024; }
        else if ((r -= I_IN) < I_DEC) { kb = 0; nb = r; W = a->in[I_W_DEC] + (size_t)l * 64 * 512; N = 512; dst = Wt_lora; drow = r * 32; ldk = 256; }
        else if ((r -= I_DEC) < I_ICL) { kb = 0; nb = r; W = a->in[I_W_ICLR] + (size_t)l * 64 * 512; N = 512; dst = Wt_lora; drow = 512 + r * 32; ldk = 256; koff = 64; }
        else if ((r -= I_ICL) < I_GAT) { kb = r / 16; nb = r % 16; W = a->in[I_W_GATE] + (size_t)l * 128 * 512; N = 512; dst = Wt_lora; drow = 1024 + nb * 32; ldk = 256; koff = 128; }
        else if ((r -= I_GAT) < I_Q) { kb = r / 24; nb = r % 24; const int n0 = nb * 32, h = n0 / 96, j = n0 % 96; W = a->in[I_W_QUP] + (size_t)l * 256 * 768; N = 768; dst = Wt_q; drow = j < 64 ? h * 64 + j : 512 + h * 32; ldk = 256; scale = a->in[I_QNORM] + l * 256; }
        else if ((r -= I_Q) < I_KV) { kb = r / 32; nb = r % 32; const int n0 = nb * 32, h = n0 / 128, j = n0 % 128; W = a->in[I_W_KVUP] + (size_t)l * 128 * 1024; N = 1024; dst = Wt_kv; drow = j < 64 ? h * 64 + j : 512 + h * 64 + (j - 64); ldk = 256; scale = a->in[I_KVNORM] + l * 128; }
        else if ((r -= I_KV) < I_OA) { kb = r / 32; nb = r % 32; W = a->in[I_W_ORWKV] + (size_t)l * 512 * 1024; N = 1024; dst = Wt_oa; drow = nb * 32; ldk = 512; }
        else if ((r -= I_OA) < I_OB) { kb = r / 32; nb = r % 32; W = a->in[I_W_OMLA] + (size_t)l * 512 * 1024; N = 1024; dst = Wt_ob; drow = nb * 32; ldk = 512; }
        else if ((r -= I_OB) < I_OUT) { kb = r / 32; nb = r % 32; W = a->in[I_W_OUT] + (size_t)l * 1024 * 1024; N = 1024; dst = Wt_out; drow = nb * 32; ldk = 1024; }
        else if ((r -= I_OUT) < I_UP) { kb = r / 176; nb = r % 176; W = a->in[I_W_UP] + (size_t)l * 1024 * 2 * FF; N = 2 * FF; dst = Wt_up; drow = nb * 32; ldk = 1024; scale = a->in[I_FFN_NORM] + l * 1024; }
        else { r -= I_UP; kb = r / 32; nb = r % 32; W = a->in[I_W_DOWN] + (size_t)l * FF * 1024; N = 1024; dst = Wt_down; drow = nb * 32; ldk = FF; }
        tr_item(W, N, kb * 64, nb * 32, dst, drow, ldk, koff, scale, scr, lane);
    }
    const int gt = blockIdx.x * NTHREADS + tid, NGT = gridDim.x * NTHREADS;
    const u32x4 z = (u32x4){0u, 0u, 0u, 0u};
    for (int i = gt; i < 96 * 128; i += NGT) *(u32x4*)(Wt_in + (size_t)(2208 + i / 128) * 1024 + (i % 128) * 8) = z;
    for (int i = gt; i < 1536 * 32; i += NGT) { const int row = i / 32, k8 = (i % 32) * 8, kind = row >> 9; const bool live = kind == 0 ? (k8 < 64) : (kind == 1 ? (k8 >= 64 && k8 < 128) : (k8 >= 128)); if (!live) *(u32x4*)(Wt_lora + (size_t)row * 256 + k8) = z; }
    for (int i = gt; i < 1024 * 16; i += NGT) *(u32x4*)(Wt_kv + (size_t)(i / 16) * 256 + 128 + (i % 16) * 8) = z;
#ifdef SCRIBBLE
    if (l == 0) { u32x4* p = (u32x4*)(a->ws + WS_ACT); const u32x4 pz = (u32x4){0xAAAAAAAAu, 0xAAAAAAAAu, 0xAAAAAAAAu, 0xAAAAAAAAu};
        for (unsigned i = gt; i < 178u * 65536u; i += NGT) p[i] = pz; }
#endif
    if (l == 0) {
        float* SS0 = (float*)(a->ws + WS_SSP); bf16_t* HB = (bf16_t*)(a->ws + A_HB);
        for (int m = gw; m < M; m += NGW) {
            const f32x4* xr = (const f32x4*)(a->in[I_X] + (size_t)m * DM) + lane; float s = 0.f;
            u32x2* o = (u32x2*)(HB + (size_t)m * DM) + lane;
#pragma unroll
            for (int j = 0; j < 4; ++j) { const f32x4 v = xr[64 * j]; s += dot4(v, v); o[64 * j] = dn4(v); }
#pragma unroll
            for (int o2 = 1; o2 < 64; o2 <<= 1) s += __shfl_xor(s, o2);
            if (lane < 16) SS0[(size_t)m * 16 + lane] = lane == 0 ? s : 0.f;
        }
        float* CS = (float*)(a->ws + WS_CS); const int* pos = (const int*)a->in[I_POS];
        for (int i = gt; i < M * 16; i += NGT) { const int row = i >> 4, f = i & 15;
            const float invf = exp2f(-0.830482023721841f * (float)f);
            const float ang = (float)pos[row] * invf;
            const float k = rintf(ang * 0.15915494309189535f);
            float rr = fmaf(-k, 6.2831854820251465f, ang); rr = fmaf(-k, -1.7484555314695172e-07f, rr);
            CS[(size_t)row * 32 + f] = cosf(rr); CS[(size_t)row * 32 + 16 + f] = sinf(rr); }
    }
}

__device__ __forceinline__ void phase_prep(ArgsP a, int l) {
    a = args_ptr();
    const int gt = blockIdx.x * NTHREADS + ltid(), NGT = gridDim.x * NTHREADS;
    const bf16_t* LORAC = (const bf16_t*)(a->ws + A_LORAC); bf16_t* LIN = (bf16_t*)(a->ws + A_LIN);
    const float* mu = a->in[I_MU] + (size_t)l * 1792 + 1536;
    for (int i = gt; i < M * 64; i += NGT) { const int row = i >> 6, j = (i & 63) * 4, t = row & 4095;
        const f32x4 cur = up4(*(const u32x2*)(LORAC + (size_t)row * 256 + j));
        const f32x4 prv = t ? up4(*(const u32x2*)(LORAC + (size_t)(row - 1) * 256 + j)) : (f32x4){0.f, 0.f, 0.f, 0.f};
        const f32x4 m4 = *(const f32x4*)(mu + j); f32x4 s = cur + (prv - cur) * m4;
        if (j < 64) { for (int e = 0; e < 4; ++e) s[e] = tanhf(s[e]); } else if (j >= 128) { for (int e = 0; e < 4; ++e) s[e] = sigm(s[e]); }
        *(u32x2*)(LIN + (size_t)row * 256 + j) = dn4(s); }
    const bf16_t* PMb = (const bf16_t*)(a->ws + A_PM); bf16_t* KPE = (bf16_t*)(a->ws + A_KPE); const float* CS = (const float*)(a->ws + WS_CS);
    for (int i = gt; i < M * 16; i += NGT) { const int row = i >> 4, f = i & 15;
        const float x1 = bf2f(PMb[(size_t)row * 512 + 384 + f]), x2 = bf2f(PMb[(size_t)row * 512 + 400 + f]), cs = CS[(size_t)row * 32 + f], sn = CS[(size_t)row * 32 + 16 + f];
        KPE[(size_t)row * 32 + f] = (bf16_t)f2bf(x1 * cs - x2 * sn); KPE[(size_t)row * 32 + 16 + f] = (bf16_t)f2bf(x1 * sn + x2 * cs); }
}

template <int CTRL> __device__ __forceinline__ float dppf(float x) { return __builtin_bit_cast(float, __builtin_amdgcn_update_dpp(0, __builtin_bit_cast(int, x), CTRL, 0xf, 0xf, false)); }
#if SHFL_SCAN
__device__ __forceinline__ float rr16(float x) { x += __shfl_xor(x, 8); x += __shfl_xor(x, 4); x += __shfl_xor(x, 2); x += __shfl_xor(x, 1); return x; }
#else
__device__ __forceinline__ float rr16(float x) { x += dppf<0x128>(x); x += dppf<0x124>(x); x += dppf<0x122>(x); x += dppf<0x121>(x); return x; }
#endif

constexpr int SC_BUF = 49152, SC_R = 0, SC_W = 8192, SC_K = 16384, SC_A = 24576, SC_B = 32768, SC_V = 40960, SC_Y = 98304;
__device__ __forceinline__ void scan_unit(ArgsP a, int l, int bh, int half, LAS unsigned char* lds) {
    a = args_ptr();
    const int tid = ltid(), lane = tid & 63, wid = tid >> 6;
    const int b = bh >> 3, h = bh & 7, i0 = half * 32;
    const int rloc = wid * 4 + (lane >> 4), cgp = lane & 15;
    const bf16_t* RKV = (const bf16_t*)(a->ws + A_RKV); const bf16_t* LW = (const bf16_t*)(a->ws + A_LW); const bf16_t* ICLR = (const bf16_t*)(a->ws + A_ICLR);
    bf16_t* Y = (bf16_t*)(a->ws + A_Y); float* SCAL = (float*)(a->ws + WS_SCAL);
    const int tau = tid >> 4, pcg = tid & 15, ch = h * 64 + 4 * pcg;
    const float* mu = a->in[I_MU] + (size_t)l * 1792;
    const f32x4 mu_r = *(const f32x4*)(mu + ch), mu_k = *(const f32x4*)(mu + 512 + ch), mu_v = *(const f32x4*)(mu + 1024 + ch);
    const f32x4 kk_c = *(const f32x4*)(a->in[I_KK] + l * 512 + ch), ka_c = *(const f32x4*)(a->in[I_KA] + l * 512 + ch), rk_c = *(const f32x4*)(a->in[I_RK] + l * 512 + ch);
    u32x2 gr2, gr1, gk2, gk1, gv2, gv1, glw, gic;
    const u32x2 z2 = (u32x2){0u, 0u};
#define SC_LOAD(c) do { const int t_ = (c) * 32 + tau; const size_t row_ = (size_t)b * SEQ + t_; \
        gr2 = *(const u32x2*)(RKV + row_ * 1536 + ch); gk2 = *(const u32x2*)(RKV + row_ * 1536 + 512 + ch); gv2 = *(const u32x2*)(RKV + row_ * 1536 + 1024 + ch); \
        if (t_) { gr1 = *(const u32x2*)(RKV + (row_ - 1) * 1536 + ch); gk1 = *(const u32x2*)(RKV + (row_ - 1) * 1536 + 512 + ch); gv1 = *(const u32x2*)(RKV + (row_ - 1) * 1536 + 1024 + ch); } \
        else { gr1 = z2; gk1 = z2; gv1 = z2; } \
        glw = *(const u32x2*)(LW + row_ * 512 + ch); gic = *(const u32x2*)(ICLR + row_ * 512 + ch); } while (0)
#define SC_STORE(c, p) do { LAS unsigned char* base_ = lds + (p) * SC_BUF + tau * 256 + pcg * 16; \
        const f32x4 r2 = up4(gr2), k2 = up4(gk2), v2 = up4(gv2); \
        const f32x4 r = r2 + (up4(gr1) - r2) * mu_r, k = k2 + (up4(gk1) - k2) * mu_k, v = v2 + (up4(gv1) - v2) * mu_v; \
        const f32x4 ic = up4(gic), lw = up4(glw); \
        f32x4 kk = k * kk_c; float ssum = dot4(kk, kk); ssum += __shfl_xor(ssum, 1); ssum += __shfl_xor(ssum, 2); ssum += __shfl_xor(ssum, 4); ssum += __shfl_xor(ssum, 8); \
        kk = kk * rsqrtf(ssum + 1e-12f); \
        const f32x4 kp = k * (1.0f + (ic - 1.0f) * ka_c); \
        float sc = dot4(r * kp, rk_c); sc += __shfl_xor(sc, 1); sc += __shfl_xor(sc, 2); sc += __shfl_xor(sc, 4); sc += __shfl_xor(sc, 8); \
        if (half == 0 && pcg == 0) SCAL[((size_t)b * SEQ + (c) * 32 + tau) * 8 + h] = sc; \
        f32x4 w; w.x = __expf(lw.x); w.y = __expf(lw.y); w.z = __expf(lw.z); w.w = __expf(lw.w); \
        *(LAS f32x4*)(base_ + SC_R) = r; *(LAS f32x4*)(base_ + SC_W) = w; *(LAS f32x4*)(base_ + SC_K) = kp; *(LAS f32x4*)(base_ + SC_A) = -kk; *(LAS f32x4*)(base_ + SC_B) = kk * ic; *(LAS f32x4*)(base_ + SC_V) = v; } while (0)
    SC_LOAD(0); SC_STORE(0, 0);
    __syncthreads();
    float s0 = 0.f, s1 = 0.f, s2 = 0.f, s3 = 0.f;
    for (int c = 0; c < SEQ / 32; ++c) {
        const int p = c & 1;
        if (c + 1 < SEQ / 32) SC_LOAD(c + 1);
        const LAS unsigned char* bp = lds + p * SC_BUF + cgp * 16;
        const LAS unsigned char* vp = lds + p * SC_BUF + SC_V + (i0 + rloc) * 4;
        LAS float* yst = (LAS float*)(lds + SC_Y + p * 4096) + rloc;
#pragma unroll 4
        for (int t = 0; t < 32; ++t) {
            const f32x4 a4 = *(const LAS f32x4*)(bp + SC_A + t * 256), w4 = *(const LAS f32x4*)(bp + SC_W + t * 256), b4 = *(const LAS f32x4*)(bp + SC_B + t * 256),
                        k4 = *(const LAS f32x4*)(bp + SC_K + t * 256), r4 = *(const LAS f32x4*)(bp + SC_R + t * 256);
            const float vi = *(const LAS float*)(vp + t * 256);
            const float sa = rr16((s0 * a4.x + s1 * a4.y) + (s2 * a4.z + s3 * a4.w));
            s0 = s0 * w4.x + (sa * b4.x + vi * k4.x); s1 = s1 * w4.y + (sa * b4.y + vi * k4.y); s2 = s2 * w4.z + (sa * b4.z + vi * k4.z); s3 = s3 * w4.w + (sa * b4.w + vi * k4.w);
            const float y = rr16((s0 * r4.x + s1 * r4.y) + (s2 * r4.z + s3 * r4.w));
            if (cgp == 0) yst[t * 32] = y;
        }
        if (c + 1 < SEQ / 32) SC_STORE(c + 1, p ^ 1);
        __syncthreads();
        { const LAS float* ys = (const LAS float*)(lds + SC_Y + p * 4096) + tau * 32 + 2 * pcg;
          *(unsigned*)(Y + ((size_t)b * SEQ + c * 32 + tau) * 512 + h * 64 + i0 + 2 * pcg) = pk2(ys[0], ys[1]); }
    }
    __syncthreads();
#undef SC_LOAD
#undef SC_STORE
}

__device__ __forceinline__ int crow(int r, int hi) { return (r & 3) + 8 * (r >> 2) + 4 * hi; }
constexpr int AT_KROW = 208, AT_VROW = 136, AT_KBUF = 64 * AT_KROW, AT_VBUF = 64 * AT_VROW, AT_V0 = 2 * AT_KBUF;
__device__ __forceinline__ void attn_unit(ArgsP a, int bh, int qb, LAS unsigned char* lds) {
    a = args_ptr();
    const int tid = ltid(), lane = tid & 63, wid = tid >> 6, r32 = lane & 31, hi = lane >> 5;
    const int b = bh >> 3, h = bh & 7, q0 = qb * 256, qw0 = q0 + wid * 32;
    const size_t rowb = (size_t)b * SEQ;
    const bf16_t* Qn = (const bf16_t*)(a->ws + A_QN); const bf16_t* Qp = (const bf16_t*)(a->ws + A_QP); const bf16_t* Kn = (const bf16_t*)(a->ws + A_KN);
    const bf16_t* KPE = (const bf16_t*)(a->ws + A_KPE); const bf16_t* Vt = (const bf16_t*)(a->ws + A_VT); bf16_t* O = (bf16_t*)(a->ws + A_QN);
    bf16x8 qf[6];
    { const size_t qrow = rowb + qw0 + r32;
#pragma unroll
      for (int ds = 0; ds < 4; ++ds) qf[ds] = *(const bf16x8*)(Qn + qrow * 512 + h * 64 + ds * 16 + hi * 8);
#pragma unroll
      for (int ds = 0; ds < 2; ++ds) qf[4 + ds] = *(const bf16x8*)(Qp + qrow * 256 + h * 32 + ds * 16 + hi * 8); }
    const int NT = 4 * qb + 4;
    const bf16_t* ksrc = Kn + (rowb + (tid >> 3)) * 512 + h * 64 + (tid & 7) * 8;
    const bf16_t* psrc = KPE + (rowb + ((tid & 255) >> 2)) * 32 + (tid & 3) * 8;
    const bf16_t* vsrc = Vt + ((size_t)(bh * 64 + (tid >> 3)) << 12) + (tid & 7) * 8;
    const int kdst = (tid >> 3) * AT_KROW + (tid & 7) * 16, pdst = ((tid & 255) >> 2) * AT_KROW + 128 + (tid & 3) * 16, vdst = AT_V0 + (tid >> 3) * AT_VROW + (tid & 7) * 16;
    u32x4 rk, rp = (u32x4){0u, 0u, 0u, 0u}, rv;
    rk = *(const u32x4*)ksrc; if (tid < 256) rp = *(const u32x4*)psrc; rv = *(const u32x4*)vsrc;
#define AT_WRITE(p) do { *(LAS u32x4*)(lds + (p) * AT_KBUF + kdst) = rk; if (tid < 256) *(LAS u32x4*)(lds + (p) * AT_KBUF + pdst) = rp; \
        *(LAS u32x2*)(lds + (p) * AT_VBUF + vdst) = (u32x2){rv.x, rv.y}; *(LAS u32x2*)(lds + (p) * AT_VBUF + vdst + 8) = (u32x2){rv.z, rv.w}; } while (0)
    AT_WRITE(0);
    __syncthreads();
    float mrun = -INFINITY, lrun = 0.f;
    f32x16 o0, o1;
#pragma unroll
    for (int r = 0; r < 16; ++r) { o0[r] = 0.f; o1[r] = 0.f; }
    for (int t = 0; t < NT; ++t) {
        const int cur = t & 1;
        if (t + 1 < NT) { rk = *(const u32x4*)(ksrc + (size_t)(t + 1) * 64 * 512); if (tid < 256) rp = *(const u32x4*)(psrc + (size_t)(t + 1) * 64 * 32); rv = *(const u32x4*)(vsrc + (t + 1) * 64); }
        if (64 * t <= qw0 + 31) {
            const LAS unsigned char* Kb = lds + cur * AT_KBUF + r32 * AT_KROW + hi * 16;
            f32x16 p0, p1;
#pragma unroll
            for (int r = 0; r < 16; ++r) { p0[r] = 0.f; p1[r] = 0.f; }
#pragma unroll
            for (int ds = 0; ds < 6; ++ds) {
                const bf16x8 k0 = *(const LAS bf16x8*)(Kb + ds * 32), k1 = *(const LAS bf16x8*)(Kb + 32 * AT_KROW + ds * 32);
                p0 = __builtin_amdgcn_mfma_f32_32x32x16_bf16(k0, qf[ds], p0, 0, 0, 0);
                p1 = __builtin_amdgcn_mfma_f32_32x32x16_bf16(k1, qf[ds], p1, 0, 0, 0);
            }
            if (64 * t + 63 > qw0) {
                const int q = qw0 + r32;
#pragma unroll
                for (int r = 0; r < 16; ++r) { const int kv = 64 * t + crow(r, hi); if (kv > q) p0[r] = -INFINITY; if (kv + 32 > q) p1[r] = -INFINITY; }
            }
            float mx = fmaxf(p0[0], p1[0]);
#pragma unroll
            for (int r = 1; r < 16; ++r) mx = fmaxf(mx, fmaxf(p0[r], p1[r]));
            mx = fmaxf(mx, __shfl_xor(mx, 32));
            const float mnew = fmaxf(mrun, mx), alpha = __builtin_amdgcn_exp2f(mrun - mnew);
            mrun = mnew;
            float ps = 0.f;
#pragma unroll
            for (int r = 0; r < 16; ++r) { p0[r] = __builtin_amdgcn_exp2f(p0[r] - mnew); p1[r] = __builtin_amdgcn_exp2f(p1[r] - mnew); ps += p0[r] + p1[r]; }
            lrun = lrun * alpha + ps;
#pragma unroll
            for (int r = 0; r < 16; ++r) { o0[r] *= alpha; o1[r] *= alpha; }
            bf16x8 pf[4];
#pragma unroll
            for (int ks = 0; ks < 4; ++ks) {
                u32x4 w;
                if (ks < 2) { w.x = pk2(p0[8 * ks + 0], p0[8 * ks + 1]); w.y = pk2(p0[8 * ks + 2], p0[8 * ks + 3]); w.z = pk2(p0[8 * ks + 4], p0[8 * ks + 5]); w.w = pk2(p0[8 * ks + 6], p0[8 * ks + 7]); }
                else { const int k2 = ks - 2; w.x = pk2(p1[8 * k2 + 0], p1[8 * k2 + 1]); w.y = pk2(p1[8 * k2 + 2], p1[8 * k2 + 3]); w.z = pk2(p1[8 * k2 + 4], p1[8 * k2 + 5]); w.w = pk2(p1[8 * k2 + 6], p1[8 * k2 + 7]); }
                pf[ks] = __builtin_bit_cast(bf16x8, w);
            }
            const LAS unsigned char* Vb = lds + AT_V0 + cur * AT_VBUF + r32 * AT_VROW + hi * 8;
#pragma unroll
            for (int ks = 0; ks < 4; ++ks) {
                const s16x4 a0 = *(const LAS s16x4*)(Vb + ks * 32), a1 = *(const LAS s16x4*)(Vb + ks * 32 + 16);
                const s16x4 c0 = *(const LAS s16x4*)(Vb + 32 * AT_VROW + ks * 32), c1 = *(const LAS s16x4*)(Vb + 32 * AT_VROW + ks * 32 + 16);
                const bf16x8 vf0 = (bf16x8){a0[0], a0[1], a0[2], a0[3], a1[0], a1[1], a1[2], a1[3]}, vf1 = (bf16x8){c0[0], c0[1], c0[2], c0[3], c1[0], c1[1], c1[2], c1[3]};
                o0 = __builtin_amdgcn_mfma_f32_32x32x16_bf16(vf0, pf[ks], o0, 0, 0, 0);
                o1 = __builtin_amdgcn_mfma_f32_32x32x16_bf16(vf1, pf[ks], o1, 0, 0, 0);
            }
        }
        if (t + 1 < NT) AT_WRITE(cur ^ 1);
        __syncthreads();
    }
#undef AT_WRITE
    const float ltot = lrun + __shfl_xor(lrun, 32), inv = 1.0f / ltot;
    bf16_t* orow = O + (rowb + qw0 + r32) * 512 + h * 64 + 4 * hi;
#pragma unroll
    for (int g = 0; g < 4; ++g) {
        *(u32x2*)(orow + 8 * g) = (u32x2){pk2(o0[4 * g] * inv, o0[4 * g + 1] * inv), pk2(o0[4 * g + 2] * inv, o0[4 * g + 3] * inv)};
        *(u32x2*)(orow + 32 + 8 * g) = (u32x2){pk2(o1[4 * g] * inv, o1[4 * g + 1] * inv), pk2(o1[4 * g + 2] * inv, o1[4 * g + 3] * inv)};
    }
}


__device__ __forceinline__ void attn_unit_naive(ArgsP a, int bh, int qb, LAS unsigned char* lds) {
    a = args_ptr();
    const int tid = threadIdx.x, lane = tid & 63, wid = tid >> 6;
    const int b = bh >> 3, h = bh & 7; const size_t rowb = (size_t)b * SEQ;
    const bf16_t* Qn = (const bf16_t*)(a->ws + A_QN); const bf16_t* Qp = (const bf16_t*)(a->ws + A_QP); const bf16_t* Kn = (const bf16_t*)(a->ws + A_KN);
    const bf16_t* KPE = (const bf16_t*)(a->ws + A_KPE); const bf16_t* Vt = (const bf16_t*)(a->ws + A_VT); bf16_t* O = (bf16_t*)(a->ws + A_QN);
    LAS float* sc = (LAS float*)(lds + wid * 16384);
    for (int i = 0; i < 32; ++i) {
        const int q = qb * 256 + wid * 32 + i; const size_t qrow = rowb + q;
        float mx = -INFINITY;
        for (int k0 = 0; k0 <= q; k0 += 64) {
            const int key = k0 + lane; float sv = -INFINITY;
            if (key <= q) { sv = 0.f;
                for (int d = 0; d < 64; ++d) sv += bf2f(Qn[qrow * 512 + h * 64 + d]) * bf2f(Kn[(rowb + key) * 512 + h * 64 + d]);
                for (int d = 0; d < 32; ++d) sv += bf2f(Qp[qrow * 256 + h * 32 + d]) * bf2f(KPE[(rowb + key) * 32 + d]); }
            sc[key] = sv; mx = fmaxf(mx, sv);
        }
        for (int o = 1; o < 64; o <<= 1) mx = fmaxf(mx, __shfl_xor(mx, o));
        float sum = 0.f;
        for (int k0 = 0; k0 <= q; k0 += 64) { const int key = k0 + lane; const float p = key <= q ? exp2f(sc[key] - mx) : 0.f; sc[key] = p; sum += p; }
        for (int o = 1; o < 64; o <<= 1) sum += __shfl_xor(sum, o);
        asm volatile("s_waitcnt lgkmcnt(0)" ::: "memory");
        float acc = 0.f;
        const bf16_t* vp = Vt + ((size_t)(bh * 64 + lane) << 12);
        for (int key = 0; key <= q; ++key) acc += sc[key] * bf2f(vp[key]);
        asm volatile("s_waitcnt lgkmcnt(0)" ::: "memory");
        O[qrow * 512 + h * 64 + lane] = (bf16_t)f2bf(acc / sum);
    }
}
#if NAIVE_ATTN
#define ATTN_UNIT attn_unit_naive
#else
#define ATTN_UNIT attn_unit
#endif
__device__ __forceinline__ void phase_ya(ArgsP a, int l) {
    a = args_ptr();
    const int tid = ltid(), lane = tid & 63, gw = blockIdx.x * NWAVES + (tid >> 6), NGW = gridDim.x * NWAVES;
    const bf16_t* Y = (const bf16_t*)(a->ws + A_Y); const bf16_t* RKV = (const bf16_t*)(a->ws + A_RKV); const bf16_t* GATE = (const bf16_t*)(a->ws + A_GATE);
    const float* SCAL = (const float*)(a->ws + WS_SCAL); bf16_t* YA = (bf16_t*)(a->ws + A_YA);
    const float* mu_v = a->in[I_MU] + (size_t)l * 1792 + 1024; const float* lw = a->in[I_LNXW] + l * 512; const float* lb = a->in[I_LNXB] + l * 512;
    for (int it = gw; it < M * 8; it += NGW) {
        const int row = it >> 3, h = it & 7, c = h * 64 + lane, t = row & 4095;
        const float y = bf2f(Y[(size_t)row * 512 + c]);
        float s = y;
#pragma unroll
        for (int o = 1; o < 64; o <<= 1) s += __shfl_xor(s, o);
        const float mean = s * (1.0f / 64.0f), d = y - mean;
        float q = d * d;
#pragma unroll
        for (int o = 1; o < 64; o <<= 1) q += __shfl_xor(q, o);
        const float yn = d * rsqrtf(q * (1.0f / 64.0f) + LNX_EPS) * lw[c] + lb[c];
        const float v2 = bf2f(RKV[(size_t)row * 1536 + 1024 + c]), v1 = t ? bf2f(RKV[(size_t)(row - 1) * 1536 + 1024 + c]) : 0.f;
        const float v = v2 + (v1 - v2) * mu_v[c];
        const float bonus = SCAL[(size_t)row * 8 + h] * v;
        YA[(size_t)row * 512 + c] = (bf16_t)f2bf((yn + bonus) * bf2f(GATE[(size_t)row * 512 + c]));
    }
}

__device__ __forceinline__ void phase_final(ArgsP a) {
    a = args_ptr();
    const int tid = ltid(), lane = tid & 63, gw = blockIdx.x * NWAVES + (tid >> 6), NGW = gridDim.x * NWAVES;
    const float* SS4 = (const float*)(a->ws + WS_SSP) + (size_t)4 * M * 16; const f32x4* g = (const f32x4*)a->in[I_FINAL] + lane;
    for (int m = gw; m < M; m += NGW) {
        const float rs = rsqrtf(pg8::sum16(SS4 + (size_t)m * 16) * (1.0f / 1024.0f) + NORM_EPS);
        f32x4* o = (f32x4*)(a->out + (size_t)m * DM) + lane;
#pragma unroll
        for (int j = 0; j < 4; ++j) o[64 * j] = o[64 * j] * rs * g[64 * j];
    }
}


#ifndef DUMP_MIB
#define DUMP_MIB 0
#endif
#ifndef DUMP_OFF_MIB
#define DUMP_OFF_MIB 0
#endif
__device__ __forceinline__ void phase_dump(ArgsP a) {
    a = args_ptr();
    const size_t n16 = (size_t)DUMP_MIB * 1024 * 512, nout = (size_t)M * DM;
    const unsigned short* src = (const unsigned short*)(a->ws + (size_t)DUMP_OFF_MIB * 1024 * 1024);
    for (size_t i = (size_t)blockIdx.x * NTHREADS + threadIdx.x; i < nout; i += (size_t)gridDim.x * NTHREADS) {
        float sacc = 0.f; for (size_t j = i; j < n16; j += nout) sacc += (float)src[j] * (1.0f / 65536.0f);
        a->out[i] = sacc; }
}
constexpr int PH_PER_LAYER = 12, N_PHASES = 2 * PH_PER_LAYER + 1;
__global__ void __launch_bounds__(NTHREADS, 2) mk_fwd(Args a_unused) {
    extern __shared__ __attribute__((aligned(16))) unsigned char lds_raw[];
    LAS unsigned char* lds = (LAS unsigned char*)lds_raw;
#if !MK_MULTI
    volatile LAS unsigned* MISC = (volatile LAS unsigned*)(lds + MISC_OFF);
    if (threadIdx.x < 32) MISC[threadIdx.x] = 0u;
    __syncthreads();
    XcdBarrier bar = xcd_barrier_post((unsigned*)(args_ptr()->ws + WS_CTL) + CW_BAR, MISC + 8);
#endif
    const int lo = args_ptr()->ph_lo, hi = args_ptr()->ph_hi;
    int ph = 0;
#if MK_MULTI
#define SEAM() do {} while (0)
#else
#define SEAM() do { if (ph + 1 < hi) xcd_barrier(bar); } while (0)
#endif
#ifndef PH3SUB
#define PH3SUB 7
#endif
#ifndef PHMASK
#define PHMASK 0xFFFF
#endif
#define RUN(K, ...) do { if (((PHMASK >> (K)) & 1) && lo <= ph && ph < hi) { __VA_ARGS__; SEAM(); } ++ph; } while (0)
#define LOCALS() ArgsP a = args_ptr(); unsigned char* ws = a->ws; unsigned char* wb = ws + WS_W; float* SSP = (float*)(ws + WS_SSP); float* SSQP = (float*)(ws + WS_SSQP); bf16_t* HB = (bf16_t*)(ws + A_HB); \
    const int G = gridDim.x, bid = blockIdx.x; (void)wb; (void)SSP; (void)SSQP; (void)HB; (void)G; (void)bid
#define WT(off) ((const pg8::bf16_t*)(wb + (off)))
    for (int l = 0; l < DEPTH; ++l) {
        RUN(0, phase_weights(nullptr, l, lds));
        RUN(1, { LOCALS(); pg8::Gemm g{HB, WT(W_IN), M, PC, 1024, 1024}; pg8::StaticOrder S; S.init(M, PC, G, bid);
              pg8::EpiP E{(bf16_t*)(ws + A_RKV), (bf16_t*)(ws + A_LORAC), (bf16_t*)(ws + A_PM), ws + A_G8, SSP + (size_t)(2 * l) * M * 16, SSQP + (size_t)l * M * 4, SSQP + (size_t)(2 + l) * M * 4};
              GEMM_PHASE(pg8::EpiP, lds, g, S, E); });
        RUN(2, phase_prep(nullptr, l));
        RUN(3, { if (PH3SUB & 1) { LOCALS(); pg8::Gemm g{(const bf16_t*)(ws + A_LIN), WT(W_LORA), M, 1536, 256, 256}; pg8::StaticOrder S; S.init(M, 1536, G, bid);
                pg8::EpiLora E{(bf16_t*)(ws + A_LW), (bf16_t*)(ws + A_ICLR), (bf16_t*)(ws + A_GATE), a->in[I_DBASE] + l * 512, a->in[I_IBASE] + l * 512};
                GEMM_PHASE(pg8::EpiLora, lds, g, S, E); }
              if (PH3SUB & 2) { LOCALS(); pg8::Gemm g{(const bf16_t*)(ws + A_PM), WT(W_Q), M, 768, 256, 512}; pg8::StaticOrder S; S.init(M, 768, G, bid);
                pg8::EpiQ E{(bf16_t*)(ws + A_QN), (bf16_t*)(ws + A_QP), SSQP + (size_t)l * M * 4, (const float*)(ws + WS_CS)};
                GEMM_PHASE(pg8::EpiQ, lds, g, S, E); }
              if (PH3SUB & 4) { LOCALS(); pg8::Gemm g{(const bf16_t*)(ws + A_PM) + 256, WT(W_KV), M, 1024, 256, 512}; pg8::StaticOrder S; S.init(M, 1024, G, bid);
                pg8::EpiKV E{(bf16_t*)(ws + A_KN), (bf16_t*)(ws + A_VT), SSQP + (size_t)(2 + l) * M * 4};
                GEMM_PHASE(pg8::EpiKV, lds, g, S, E); } });
        RUN(4, { for (int u = blockIdx.x; u < 64; u += gridDim.x) scan_unit(nullptr, l, u >> 1, u & 1, lds); });
        RUN(5, { for (int c = blockIdx.x; c < 256; c += gridDim.x) { ATTN_UNIT(nullptr, c >> 3, 15 - (c & 7), lds); ATTN_UNIT(nullptr, c >> 3, c & 7, lds); } });
        RUN(6, phase_ya(nullptr, l));
        RUN(7, { { LOCALS(); pg8::Gemm g{(const bf16_t*)(ws + A_YA), WT(W_OA), M, 1024, 512, 512}; pg8::StaticOrder S; S.init(M, 1024, G, bid);
                pg8::EpiMix<1> E{(float*)(ws + A_TMP), (bf16_t*)(ws + A_MERGED), ws + A_G8};
                GEMM_PHASE(pg8::EpiMix<1>, lds, g, S, E); }
              asm volatile("s_waitcnt vmcnt(0)" ::: "memory"); __syncthreads();
              { LOCALS(); pg8::Gemm g{(const bf16_t*)(ws + A_QN), WT(W_OB), M, 1024, 512, 512}; pg8::StaticOrder S; S.init(M, 1024, G, bid);
                pg8::EpiMix<2> E{(float*)(ws + A_TMP), (bf16_t*)(ws + A_MERGED), ws + A_G8};
                GEMM_PHASE(pg8::EpiMix<2>, lds, g, S, E); } });
        RUN(8, { LOCALS(); pg8::Gemm g{(const bf16_t*)(ws + A_MERGED), WT(W_OUT), M, 1024, 1024, 1024}; pg8::StaticOrder S; S.init(M, 1024, G, bid);
              pg8::EpiRes E{l == 0 ? a->in[I_X] : a->out, a->out, HB, SSP + (size_t)(2 * l + 1) * M * 16};
              GEMM_PHASE(pg8::EpiRes, lds, g, S, E); });
        RUN(9, { LOCALS(); pg8::Gemm g{HB, WT(W_UP), M, FF, 1024, 1024}; pg8::StaticOrder S; S.init(M, FF, G, bid);
              pg8::EpiUpG E{(bf16_t*)(ws + A_UG), SSP + (size_t)(2 * l + 1) * M * 16};
              GEMM_PHASE(pg8::EpiUpG, lds, g, S, E); });
        RUN(10, { LOCALS(); pg8::Gemm g{HB, WT(W_UP) + (size_t)FF * 1024, M, FF, 1024, 1024}; pg8::StaticOrder S; S.init(M, FF, G, bid);
              pg8::EpiUpV E{(const bf16_t*)(ws + A_UG), (bf16_t*)(ws + A_ACT), SSP + (size_t)(2 * l + 1) * M * 16, a->in[I_CONVW] + (size_t)l * 3 * FF, a->in[I_CONVB] + (size_t)l * FF};
              GEMM_PHASE(pg8::EpiUpV, lds, g, S, E); });
        RUN(11, { LOCALS(); pg8::Gemm g{(const bf16_t*)(ws + A_ACT), WT(W_DOWN), M, 1024, FF, FF}; pg8::StaticOrder S; S.init(M, 1024, G, bid);
              pg8::EpiRes E{a->out, a->out, HB, SSP + (size_t)(2 * l + 2) * M * 16};
              GEMM_PHASE(pg8::EpiRes, lds, g, S, E); });
    }
    RUN(12, phase_final(nullptr));
#if DUMP_MIB
    if (lo == 100) phase_dump(nullptr);
#endif
#ifdef CLOCKJUNK
    if (lo == 103 && blockIdx.x == 0) { args_ptr()->out[threadIdx.x] += (float)(__builtin_amdgcn_s_memrealtime() & 1023); }
#endif
#if !MK_MULTI
    if (lo > 1000000) cg::this_grid().sync();
#endif
}

extern "C" void kernel_launch(void* const* d_in, const int* in_sizes, int n_in, void* d_out, int out_size, void* d_ws, size_t ws_size, hipStream_t stream) {
    static int grid = 0;
    if (grid == 0) {
        if (n_in != 28 || out_size != M * DM || ws_size < WS_END) { fprintf(stderr, "kernel_launch: unexpected shapes: n_in %d out %d ws %zu (need %zu)\n", n_in, out_size, ws_size, (size_t)WS_END); grid = -1; return; }
        int dev = 0, cus = 0, per_cu = 0;
        if (hipGetDevice(&dev) != hipSuccess || hipDeviceGetAttribute(&cus, hipDeviceAttributeMultiprocessorCount, dev) != hipSuccess) { grid = -1; return; }
        if (hipFuncSetAttribute((const void*)mk_fwd, hipFuncAttributeMaxDynamicSharedMemorySize, LDS_BYTES) != hipSuccess) { fprintf(stderr, "kernel_launch: hipFuncSetAttribute failed\n"); grid = -1; return; }
        if (hipOccupancyMaxActiveBlocksPerMultiprocessor(&per_cu, (const void*)mk_fwd, NTHREADS, LDS_BYTES) != hipSuccess || per_cu < 1) { fprintf(stderr, "kernel_launch: occupancy query says %d\n", per_cu); per_cu = 1; }
        (void)hipGetLastError();
        grid = cus * 1;
        if (grid > cus * per_cu) grid = cus * per_cu;
    }
    if (grid < 0) return;
    if (hipMemsetAsync((char*)d_ws + WS_CTL, 0, CTL_ZERO_BYTES, stream) != hipSuccess) { fprintf(stderr, "kernel_launch: memset failed\n"); return; }
    Args a{};
    for (int i = 0; i < 28; ++i) a.in[i] = (const float*)d_in[i];
    a.out = (float*)d_out; a.ws = (unsigned char*)d_ws;
#if MK_MULTI
#ifndef STOP_AFTER
#define STOP_AFTER (N_PHASES - 1)
#endif
    for (int p = 0; p <= STOP_AFTER; ++p) {
        a.ph_lo = p; a.ph_hi = p + 1;
        hipLaunchKernelGGL(mk_fwd, dim3(grid), dim3(NTHREADS), LDS_BYTES, stream, a);
    }
#ifdef CLOCKJUNK
    a.ph_lo = 103; a.ph_hi = 104;
    hipLaunchKernelGGL(mk_fwd, dim3(grid), dim3(NTHREADS), LDS_BYTES, stream, a);
#endif
#if DUMP_MIB
    a.ph_lo = 100; a.ph_hi = 101;
    hipLaunchKernelGGL(mk_fwd, dim3(grid), dim3(NTHREADS), LDS_BYTES, stream, a);
#endif
#else
    a.ph_lo = 0; a.ph_hi = N_PHASES;
    void* kargs[] = {&a};
    hipError_t e = hipLaunchCooperativeKernel((const void*)mk_fwd, dim3(grid), dim3(NTHREADS), kargs, LDS_BYTES, stream);
    if (e != hipSuccess) fprintf(stderr, "kernel_launch: cooperative launch failed: %s (grid %d)\n", hipGetErrorString(e), grid);
#endif
}
```

```cpp
#include <hip/hip_runtime.h>
#include <hip/hip_cooperative_groups.h>
#include <cstdio>
#include <cstdint>
#include <cmath>
namespace cg = cooperative_groups;

#ifndef MK_MULTI
#define MK_MULTI 0
#endif

#ifndef SCAN_CHUNKED
#define SCAN_CHUNKED 1
#endif
#define LW_CUM SCAN_CHUNKED
#ifndef WKV_STREAM
#define WKV_STREAM 1
#endif
#ifndef CK_LWZ
#define CK_LWZ 1.0f
#endif
#ifndef CK_NOSTATE
#define CK_NOSTATE 0
#endif
#ifndef CK_AB
#define CK_AB 1.0f
#endif
constexpr int BATCH = 4, SEQ = 4096, DM = 1024, M = BATCH * SEQ, DEPTH = 2;
constexpr int NH = 8, RD = 512;
constexpr int IN_COLS = 4256, PC = 4352;
constexpr int FF = 2816;
constexpr float NORM_EPS = 1e-6f, LNX_EPS = 64e-5f;
constexpr float C2 = 0.10206207261596577f * 1.4426950408889634f;

namespace pg8 {
#define PG8_LAS __attribute__((address_space(3)))
}
extern __shared__ __attribute__((aligned(16))) unsigned char lds_raw[];
constexpr int WTAB_OFF = 131072 + 448;
__device__ __forceinline__ unsigned hw_wave_key() { return (unsigned)__builtin_amdgcn_s_getreg((5 << 11) | 4) & 63u; }
__device__ __forceinline__ int vtid() {
    const int wv = __builtin_amdgcn_readfirstlane((int)*(volatile PG8_LAS unsigned*)((PG8_LAS unsigned char*)lds_raw + WTAB_OFF + hw_wave_key() * 4u));
    int t_ = (wv << 6) | (int)__builtin_amdgcn_mbcnt_hi(~0u, __builtin_amdgcn_mbcnt_lo(~0u, 0u));
    asm volatile("" : "+v"(t_));
    return t_;
}
__device__ __forceinline__ float shx(float v, int m) {
    int l_ = (int)__builtin_amdgcn_mbcnt_hi(~0u, __builtin_amdgcn_mbcnt_lo(~0u, 0u)); asm volatile("" : "+v"(l_));
    return __builtin_bit_cast(float, __builtin_amdgcn_ds_bpermute((l_ ^ m) << 2, __builtin_bit_cast(int, v)));
}
namespace pg8 {
typedef unsigned short bf16_t;
typedef short bf16x8 __attribute__((ext_vector_type(8)));
typedef float f32x4 __attribute__((ext_vector_type(4)));
typedef unsigned u32x4 __attribute__((ext_vector_type(4)));
constexpr int BM = 256, BK = 64, HALF = 128, HTB = HALF * BK * 2  , STAGE_BYTES = 8 * HTB, NXCD = 8, WGM = 8;

__host__ __device__ __forceinline__ int lds_byte(int r, int c) { const int st = (r >> 4) * 2 + (c >> 5), rr = r & 15, cc = c & 31, ob = rr * 64 + cc * 2; return st * 1024 + (ob ^ (((ob >> 9) & 1) << 5)); }
__host__ __device__ __forceinline__ void stage_rc(int b, int& R, int& C) { const int st = b / 1024, sb = b % 1024, swz = sb ^ (((sb >> 9) & 1) << 5); R = (st >> 1) * 16 + swz / 64; C = (st & 1) * 32 + (swz % 64) / 2; }
__host__ __device__ __forceinline__ int perm32(int rho) { const int n = rho >> 4, i = rho & 15; return 8 * (i >> 2) + 4 * n + (i & 3); }

struct Unit { int pm, pn; };
struct Gemm { const bf16_t* A; const bf16_t* Bt; int M, N, K, lda; unsigned long long* ts = nullptr; };

struct StaticOrder {
    int nM, nN, nwg, G, c;
    __host__ __device__ void init(int M, int N, int G_, int c_) { nM = M / BM; nN = N / BM; nwg = nM * nN; G = G_; c = c_; }
    __host__ __device__ __forceinline__ bool next(int i, Unit& u) const {
        const long L = (long)i * G + c; if (L >= nwg) return false;
        int wgid = (int)L; { const int q = nwg / NXCD, r = nwg % NXCD, xcd = wgid % NXCD, off = wgid / NXCD; wgid = (xcd < r ? xcd * (q + 1) : r * (q + 1) + (xcd - r) * q) + off; }
        const int nig = WGM * nN, gid = wgid / nig, fm = gid * WGM, gsz = (nM - fm) < WGM ? (nM - fm) : WGM;
        u.pm = fm + ((wgid % nig) % gsz); u.pn = (wgid % nig) / gsz; return true;
    }
    __device__ __forceinline__ void a_ready(const Unit&) const {}
    __device__ __forceinline__ void done(const Unit&) const {}
};

__device__ __forceinline__ unsigned cvt_pk_bf16(float lo, float hi) { unsigned r; asm volatile("v_cvt_pk_bf16_f32 %0, %1, %2" : "=v"(r) : "v"(lo), "v"(hi)); return r; }
template <class Epi, class Sched, bool ALIGN_EPI = false, bool SP2 = false>
__device__ __forceinline__ void gemm_phase(PG8_LAS unsigned char* lds, const Gemm g, const Sched& S, const Epi& E) {
    int tid_ = vtid(); asm volatile("" : "+v"(tid_)); const int tid = tid_, wid = __builtin_amdgcn_readfirstlane(tid >> 6), lane = tid & 63, wr = wid >> 2, wc = wid & 3, fr = lane & 15, fq = lane >> 4;
    int Kx_ = g.K; asm volatile("" : "+s"(Kx_)); const int K = Kx_, nt = K / BK;
    unsigned voffA[2], voffB[2];
#pragma unroll
    for (int i = 0; i < 2; ++i) { int R, C; stage_rc(tid * 16 + i * 8192, R, C); const int Rb = Epi::PERM ? ((R & ~31) + perm32(R & 31)) : R;
        voffA[i] = (unsigned)(R * g.lda + C) * 2u; voffB[i] = (unsigned)(Rb * K + C) * 2u; }
    const size_t kstep = (size_t)(BK * 2);
    const size_t hstep = (size_t)HALF * K * 2, hstepA = (size_t)HALF * g.lda * 2;
    const size_t tstep = 2 * hstep, tstepA = 2 * hstepA;
    const unsigned ldsw = (unsigned)wid * 1024u;
    const int aoff = lds_byte(wr * 64 + fr, fq * 8), boff = lds_byte(wc * 32 + fr, fq * 8);
#define PG8_SA(b, h) (((b) * 2 + (h)) * HTB)
#define PG8_SB(b, h) ((4 + (b) * 2 + (h)) * HTB)
#define PG8_STAGE(bufoff, gbase, voff) do { _Pragma("unroll") for (int _i = 0; _i < 2; ++_i) \
        __builtin_amdgcn_global_load_lds((const unsigned*)((const char*)(gbase) + (voff)[_i]), (PG8_LAS unsigned*)(lds + (bufoff) + ldsw + _i * 8192), 16, 0, 0); } while (0)
#define PG8_LDA(dst, b, h) do { _Pragma("unroll") for (int m = 0; m < 4; ++m) _Pragma("unroll") for (int k = 0; k < 2; ++k) dst[m][k] = *(const PG8_LAS bf16x8*)(lds + PG8_SA(b, h) + aoff + m * 2048 + k * 1024); } while (0)
#define PG8_LDB(dst, b, h) do { _Pragma("unroll") for (int n = 0; n < 2; ++n) _Pragma("unroll") for (int k = 0; k < 2; ++k) dst[n][k] = *(const PG8_LAS bf16x8*)(lds + PG8_SB(b, h) + boff + n * 2048 + k * 1024); } while (0)
#define PG8_MMA(ai, bj, At, Bt) do { __builtin_amdgcn_s_setprio(1); _Pragma("unroll") for (int m = 0; m < 4; ++m) _Pragma("unroll") for (int n = 0; n < 2; ++n) _Pragma("unroll") for (int k = 0; k < 2; ++k) \
        acc[ai][bj][m][n] = __builtin_amdgcn_mfma_f32_16x16x32_bf16(Bt[n][k], At[m][k], acc[ai][bj][m][n], 0, 0, 0); __builtin_amdgcn_s_setprio(0); } while (0)
#define PG8_WAIT_V(n) asm volatile("s_waitcnt vmcnt(" #n ")" ::: "memory")
#define PG8_WAIT_L(n) asm volatile("s_waitcnt lgkmcnt(" #n ")" ::: "memory")
#define PG8_BAR __builtin_amdgcn_s_barrier()
#define PG8_SCHED __builtin_amdgcn_sched_barrier(0)
    Unit cur, nxt; int ui = 0;
    if (!S.next(0, cur)) return;
#ifdef PH_SUB
#define PG8_TS(i) do { if (blockIdx.x == 0 && tid == 0) g.ts[i] = __builtin_amdgcn_s_memrealtime(); } while (0)
#else
#define PG8_TS(i) do {} while (0)
#endif
    PG8_TS(0);
    f32x4 acc[2][2][4][2];
#pragma unroll
    for (int a = 0; a < 2; ++a)
#pragma unroll
        for (int b = 0; b < 2; ++b)
#pragma unroll
            for (int m = 0; m < 4; ++m)
#pragma unroll
                for (int n = 0; n < 2; ++n) acc[a][b][m][n] = (f32x4){0.f, 0.f, 0.f, 0.f};
    bf16x8 At[4][2], B0[2][2], B1[2][2];
    const char* cA = (const char*)g.A + (size_t)cur.pm * tstepA; const char* cB = (const char*)g.Bt + (size_t)cur.pn * tstep;
    S.a_ready(cur);
    if constexpr (SP2) {
        PG8_STAGE(PG8_SB(0, 0), cB, voffB); PG8_STAGE(PG8_SB(0, 1), cB + hstep, voffB); PG8_STAGE(PG8_SA(0, 0), cA, voffA); PG8_STAGE(PG8_SA(0, 1), cA + hstepA, voffA);
        if (wr == 1) PG8_BAR;
        PG8_WAIT_V(2); PG8_BAR;
        PG8_STAGE(PG8_SB(1, 0), cB + kstep, voffB); PG8_STAGE(PG8_SA(1, 0), cA + kstep, voffA); PG8_STAGE(PG8_SB(1, 1), cB + hstep + kstep, voffB);
        PG8_WAIT_V(6); PG8_BAR;
    } else {
        PG8_STAGE(PG8_SB(0, 0), cB, voffB); PG8_STAGE(PG8_SA(0, 0), cA, voffA); PG8_STAGE(PG8_SB(0, 1), cB + hstep, voffB); PG8_STAGE(PG8_SA(0, 1), cA + hstepA, voffA);
        if (wr == 1) PG8_BAR;
        PG8_WAIT_V(4); PG8_BAR;
        PG8_STAGE(PG8_SB(1, 0), cB + kstep, voffB); PG8_STAGE(PG8_SA(1, 0), cA + kstep, voffA); PG8_STAGE(PG8_SB(1, 1), cB + hstep + kstep, voffB);
        PG8_WAIT_V(6); PG8_BAR;
    }
    for (;;) {
        const bool has_next = S.next(ui + 1, nxt);
        const char* nA = has_next ? (const char*)g.A + (size_t)nxt.pm * tstepA : cA; const char* nB = has_next ? (const char*)g.Bt + (size_t)nxt.pn * tstep : cB;
#pragma unroll 1
        for (int t = 0; t < nt; t += 2) {
            const bool last = (t == nt - 2);
            const char* a1 = cA + (size_t)(t + 1) * kstep;
            const char* a2 = last ? nA : cA + (size_t)(t + 2) * kstep; const char* b2 = last ? nB : cB + (size_t)(t + 2) * kstep;
            const char* a3 = a2 + kstep; const char* b3 = b2 + kstep;
            if (last && has_next) S.a_ready(nxt);
            if constexpr (SP2) {
            PG8_LDB(B0, 0, 0); PG8_LDB(B1, 0, 1); PG8_SCHED; PG8_LDA(At, 0, 0); PG8_STAGE(PG8_SA(1, 1), a1 + hstepA, voffA);
            PG8_WAIT_V(8); PG8_WAIT_L(0); PG8_BAR; PG8_MMA(0, 0, At, B0); PG8_MMA(0, 1, At, B1); PG8_BAR; PG8_SCHED;
            PG8_LDA(At, 0, 1); PG8_STAGE(PG8_SB(0, 0), b2, voffB); PG8_STAGE(PG8_SB(0, 1), b2 + hstep, voffB); PG8_STAGE(PG8_SA(0, 0), a2, voffA);
            PG8_WAIT_V(8); PG8_WAIT_L(0); PG8_BAR; PG8_MMA(1, 0, At, B0); PG8_MMA(1, 1, At, B1); PG8_BAR; PG8_SCHED;
            PG8_LDB(B0, 1, 0); PG8_LDB(B1, 1, 1); PG8_SCHED; PG8_LDA(At, 1, 0); PG8_STAGE(PG8_SA(0, 1), a2 + hstepA, voffA);
            PG8_WAIT_V(8); PG8_WAIT_L(0); PG8_BAR; PG8_MMA(0, 0, At, B0); PG8_MMA(0, 1, At, B1); PG8_BAR; PG8_SCHED;
            PG8_LDA(At, 1, 1); PG8_STAGE(PG8_SB(1, 0), b3, voffB); PG8_STAGE(PG8_SB(1, 1), b3 + hstep, voffB); PG8_STAGE(PG8_SA(1, 0), a3, voffA);
            PG8_WAIT_V(8); PG8_WAIT_L(0); PG8_BAR; PG8_MMA(1, 0, At, B0); PG8_MMA(1, 1, At, B1); PG8_BAR; PG8_SCHED;
            } else {
            PG8_LDB(B0, 0, 0); PG8_SCHED; PG8_LDA(At, 0, 0); PG8_STAGE(PG8_SA(1, 1), a1 + hstepA, voffA);
            PG8_WAIT_L(8); PG8_BAR; PG8_WAIT_L(0); PG8_MMA(0, 0, At, B0); PG8_BAR; PG8_SCHED;
            PG8_LDB(B1, 0, 1); PG8_STAGE(PG8_SB(0, 0), b2, voffB);
            PG8_BAR; PG8_WAIT_L(0); PG8_MMA(0, 1, At, B1); PG8_BAR;
            PG8_LDA(At, 0, 1); PG8_STAGE(PG8_SA(0, 0), a2, voffA);
            PG8_BAR; PG8_WAIT_L(0); PG8_MMA(1, 0, At, B0); PG8_BAR; PG8_SCHED;
            PG8_STAGE(PG8_SB(0, 1), b2 + hstep, voffB);
            PG8_WAIT_V(6); PG8_BAR; PG8_MMA(1, 1, At, B1); PG8_BAR;
            PG8_LDB(B0, 1, 0); PG8_SCHED; PG8_LDA(At, 1, 0); PG8_STAGE(PG8_SA(0, 1), a2 + hstepA, voffA);
            PG8_WAIT_L(8); PG8_BAR; PG8_WAIT_L(0); PG8_MMA(0, 0, At, B0); PG8_BAR; PG8_SCHED;
            PG8_LDB(B1, 1, 1); PG8_STAGE(PG8_SB(1, 0), b3, voffB);
            PG8_BAR; PG8_WAIT_L(0); PG8_MMA(0, 1, At, B1); PG8_BAR;
            PG8_LDA(At, 1, 1); PG8_STAGE(PG8_SA(1, 0), a3, voffA);
            PG8_BAR; PG8_WAIT_L(0); PG8_MMA(1, 0, At, B0); PG8_BAR; PG8_SCHED;
            PG8_STAGE(PG8_SB(1, 1), b3 + hstep, voffB);
            PG8_WAIT_V(6); PG8_BAR; PG8_MMA(1, 1, At, B1); PG8_BAR;
            }
        }
        if constexpr (ALIGN_EPI) { if (wr == 0) PG8_BAR; }
        PG8_TS(1);
        if constexpr (!Epi::AFTER_DRAIN) { E(acc, cur, wr, wc, fr, fq); S.done(cur); }
        asm volatile("" ::: "memory"); PG8_TS(2);
        if (!has_next) break;
#pragma unroll
        for (int a = 0; a < 2; ++a)
#pragma unroll
            for (int b = 0; b < 2; ++b)
#pragma unroll
                for (int m = 0; m < 4; ++m)
#pragma unroll
                    for (int n = 0; n < 2; ++n) acc[a][b][m][n] = (f32x4){0.f, 0.f, 0.f, 0.f};
        cur = nxt; cA = nA; cB = nB; ++ui;
        if constexpr (ALIGN_EPI) { if (wr == 1) PG8_BAR; }
    }
    PG8_WAIT_V(0);
    if constexpr (!ALIGN_EPI) { if (wr == 0) PG8_BAR; }
    PG8_BAR;
    if constexpr (Epi::AFTER_DRAIN) { E.fused(acc, cur, wr, wc, fr, fq, lds, wid, lane); S.done(cur); }
#undef PG8_SA
#undef PG8_SB
#undef PG8_STAGE
#undef PG8_LDA
#undef PG8_LDB
#undef PG8_MMA
#undef PG8_WAIT_V
#undef PG8_WAIT_L
#undef PG8_BAR
#undef PG8_SCHED
}
}

#define LAS __attribute__((address_space(3)))
typedef unsigned short bf16_t;
typedef short bf16x8 __attribute__((ext_vector_type(8)));
typedef short s16x4 __attribute__((ext_vector_type(4)));
typedef float f32x4 __attribute__((ext_vector_type(4)));
typedef float f32x16 __attribute__((ext_vector_type(16)));
typedef unsigned u32x4 __attribute__((ext_vector_type(4)));
typedef unsigned u32x2 __attribute__((ext_vector_type(2)));

__device__ __forceinline__ float bf2f(unsigned b) { return __uint_as_float(b << 16); }
__device__ __forceinline__ unsigned f2bf(float f) { unsigned u = __float_as_uint(f); return (u + 0x7fffu + ((u >> 16) & 1u)) >> 16; }
typedef float f32x2_t __attribute__((ext_vector_type(2))); typedef __bf16 bf16x2_t __attribute__((ext_vector_type(2)));
__device__ __forceinline__ unsigned pk2(float lo, float hi) { const f32x2_t v = {lo, hi}; const bf16x2_t b = __builtin_convertvector(v, bf16x2_t); return __builtin_bit_cast(unsigned, b); }
__device__ __forceinline__ float sigm(float x) { return 1.0f / (1.0f + __expf(-x)); }
__device__ __forceinline__ f32x4 up4(u32x2 v) { return (f32x4){__uint_as_float(v.x << 16), __uint_as_float(v.x & 0xffff0000u), __uint_as_float(v.y << 16), __uint_as_float(v.y & 0xffff0000u)}; }
__device__ __forceinline__ u32x2 dn4(f32x4 v) { u32x2 r; r.x = pk2(v.x, v.y); r.y = pk2(v.z, v.w); return r; }
__device__ __forceinline__ float dot4(f32x4 a, f32x4 b) { return (a.x * b.x + a.y * b.y) + (a.z * b.z + a.w * b.w); }

constexpr size_t MiB = 1u << 20;
constexpr size_t WS_CTL = 0, CTL_ZERO_BYTES = 2 * MiB;
constexpr size_t WS_STAT = 1 * MiB;
constexpr size_t WS_CS = 2 * MiB;
constexpr size_t WS_W = 4 * MiB;
constexpr size_t W_IN = 0, W_LORA = W_IN + (size_t)PC * 1024 * 2, W_Q = W_LORA + 1536 * 256 * 2, W_KV = W_Q + 768 * 256 * 2,
                 W_OA = W_KV + 1024 * 256 * 2, W_OB = W_OA + 1024 * 512 * 2, W_OUT = W_OB + 1024 * 512 * 2,
                 W_UP = W_OUT + 1024 * 1024 * 2, W_DOWN = W_UP + (size_t)2 * FF * 1024 * 2, W_END = W_DOWN + (size_t)1024 * FF * 2;
static_assert(W_END <= 31 * MiB, "weights region");
constexpr size_t WS_ACT = 35 * MiB;
constexpr size_t A_HB = WS_ACT + 0 * MiB;
constexpr size_t A_RKV = WS_ACT + 32 * MiB;
constexpr size_t A_LORAC = WS_ACT + 80 * MiB;
constexpr size_t A_QP = A_LORAC;
constexpr size_t A_PM = WS_ACT + 88 * MiB;
constexpr size_t A_Y = A_PM;
constexpr size_t A_LIN = WS_ACT + 104 * MiB;
constexpr size_t A_KPE = WS_ACT + 112 * MiB;
constexpr size_t WS_SCAL = WS_ACT + 113 * MiB;
constexpr size_t A_LW = WS_ACT + 114 * MiB;
constexpr size_t A_YA = A_LW;
constexpr size_t A_ICLR = WS_ACT + 130 * MiB;
constexpr size_t A_GATE = WS_ACT + 146 * MiB;
constexpr size_t A_MERGED = A_ICLR;
constexpr size_t A_QN = WS_ACT + 162 * MiB;
constexpr size_t A_KN = WS_ACT + 178 * MiB;
constexpr size_t A_VT = WS_ACT + 194 * MiB;
constexpr size_t A_TMP = WS_ACT + 32 * MiB;
constexpr size_t A_UG = WS_ACT + 32 * MiB;
constexpr size_t A_ACT = WS_ACT + 120 * MiB;
constexpr size_t DO_MTREC = 32 * MiB, MTREC_B = 2304, DO_HALO = DO_MTREC + (size_t)8192 * MTREC_B;
static_assert(DO_HALO + (size_t)(M / 16) * 1536 * 2 <= 64 * MiB, "d_out scratch map");
constexpr size_t WS_SSP = WS_ACT + 210 * MiB;
constexpr size_t WS_SSQP = WS_SSP + 5 * MiB;
constexpr size_t WS_END = WS_SSQP + 1 * MiB;
static_assert(A_UG + (size_t)M * FF * 2 <= A_ACT && A_ACT + (size_t)M * FF * 2 <= WS_SSP && WS_END <= 256 * MiB, "workspace map");
static_assert(A_ICLR == A_LW + (size_t)M * 512 * 2 && A_GATE == A_ICLR + (size_t)M * 512 * 2, "LW | ICLR | GATE consecutive");
constexpr int CW_BAR = 4096, CW_QUEUE = 16384;

#define XB_TMO      128
#define XB_XCNT(j)  (256  + 64 * (j))
#define XB_XSUB(j)  (1280 + 64 * (j))
#define XB_XGEN(j)  (2304 + 64 * (j))
#define XB_TOP      3328
#define XB_TOPGEN   3392
#define XCD_BAR_WORDS 3456
#define XB_SPIN_CAP (1u << 18)
__device__ __forceinline__ unsigned xb_ld(unsigned* p)              { return __hip_atomic_load(p, __ATOMIC_RELAXED, __HIP_MEMORY_SCOPE_AGENT); }
__device__ __forceinline__ unsigned xb_add(unsigned* p, unsigned v) { return __hip_atomic_fetch_add(p, v, __ATOMIC_RELAXED, __HIP_MEMORY_SCOPE_AGENT); }
__device__ __forceinline__ unsigned xb_xcc_id() { return (unsigned)__builtin_amdgcn_s_getreg((3 << 11) | 20) & 0xFu; }
#define XB_SPIN(cond, bar) do { unsigned _sp = 0; while (cond) { __builtin_amdgcn_s_sleep(1); \
    if ((++_sp & 255u) == 0u) { if (xb_ld(&(bar)[XB_TMO])) break; if (_sp > XB_SPIN_CAP) { atomicAdd(&(bar)[XB_TMO], 1u); break; } } } } while (0)
struct XcdBarrier { unsigned* bar; unsigned x; volatile LAS unsigned* st; };
__device__ __forceinline__ XcdBarrier xcd_barrier_post(unsigned* bar, volatile LAS unsigned* st) {
    XcdBarrier b; b.bar = bar; b.x = xb_xcc_id(); b.st = st;
    if (vtid() == 0) (void)xb_add(&bar[XB_XCNT(b.x)], 1u);
    return b;
}
__device__ __forceinline__ void xcd_barrier_complete(unsigned* bar, unsigned x, unsigned& nloc, unsigned& nx) {
    const unsigned G = gridDim.x * gridDim.y * gridDim.z;
    unsigned sum, cnt, mine, sp = 0u;
    for (;;) {
        sum = 0u; cnt = 0u; mine = 0u;
#pragma unroll
        for (unsigned j = 0; j < 16; ++j) { const unsigned c = xb_ld(&bar[XB_XCNT(j)]); sum += c; cnt += (c > 0u) ? 1u : 0u; mine = (j == x) ? c : mine; }
        if (sum == G) break;
        __builtin_amdgcn_s_sleep(1);
        if ((++sp & 255u) == 0u) { if (xb_ld(&bar[XB_TMO])) break; if (sp > XB_SPIN_CAP) { atomicAdd(&bar[XB_TMO], 1u); break; } }
    }
    nloc = mine > 0u ? mine : 1u; nx = cnt > 0u ? cnt : 1u;
}
__device__ __forceinline__ void xcd_barrier(const XcdBarrier& b) {
    asm volatile("s_waitcnt vmcnt(0)" ::: "memory");
    __syncthreads();
    if (vtid() == 0) {
        unsigned* bar = b.bar;
        __builtin_amdgcn_s_waitcnt(0);
        unsigned nloc = b.st[0], nx = b.st[1];
        if (nloc == 0u) { xcd_barrier_complete(bar, b.x, nloc, nx); b.st[0] = nloc; b.st[1] = nx; }
        const unsigned old = xb_add(&bar[XB_XSUB(b.x)], 1u);
        const unsigned gen = old / nloc;
        if (old + 1u == (gen + 1u) * nloc) {
            __builtin_amdgcn_fence(__ATOMIC_RELEASE, "agent");
            asm volatile("s_waitcnt vmcnt(0)" ::: "memory");
            const unsigned og = xb_add(&bar[XB_TOP], 1u);
            const unsigned tg = og / nx;
            if (og + 1u == (tg + 1u) * nx) xb_add(&bar[XB_TOPGEN], 1u);
            else XB_SPIN(xb_ld(&bar[XB_TOPGEN]) == tg, bar);
            __builtin_amdgcn_fence(__ATOMIC_ACQUIRE, "agent");
            xb_add(&bar[XB_XGEN(b.x)], 1u);
            asm volatile("s_waitcnt vmcnt(0)" ::: "memory");
        } else {
            XB_SPIN(xb_ld(&bar[XB_XGEN(b.x)]) == gen, bar);
            __builtin_amdgcn_fence(__ATOMIC_ACQUIRE, "agent");
            asm volatile("s_waitcnt vmcnt(0)" ::: "memory");
        }
    }
    __syncthreads();
}

namespace pg8 {
__device__ __forceinline__ float sum16(const float* p) { const f32x4 a = *(const f32x4*)p, b = *(const f32x4*)(p + 4), c = *(const f32x4*)(p + 8), d = *(const f32x4*)(p + 12);
    return (((a.x + a.y) + (a.z + a.w)) + ((b.x + b.y) + (b.z + b.w))) + (((c.x + c.y) + (c.z + c.w)) + ((d.x + d.y) + (d.z + d.w))); }
__device__ __forceinline__ float sum4(const float* p) { const f32x4 a = *(const f32x4*)p; return (a.x + a.y) + (a.z + a.w); }
__device__ __forceinline__ u32x4 pack8(f32x4 a, f32x4 b) { u32x4 w; w.x = cvt_pk_bf16(a[0], a[1]); w.y = cvt_pk_bf16(a[2], a[3]); w.z = cvt_pk_bf16(b[0], b[1]); w.w = cvt_pk_bf16(b[2], b[3]); return w; }
__device__ __forceinline__ unsigned q8(float s) { return (unsigned)(s * 255.0f + 0.5f); }
__device__ __forceinline__ unsigned sig8x4(f32x4 v) { return q8(sigm(v[0])) | (q8(sigm(v[1])) << 8) | (q8(sigm(v[2])) << 16) | (q8(sigm(v[3])) << 24); }

constexpr int RS_OFF = 131072 + 1024;
#ifndef NT_STORES
#define NT_STORES 0
#endif
#ifndef NT_STORES8
#define NT_STORES8 0
#endif
__device__ __forceinline__ void ST16(bf16_t* p, u32x4 v) {
    if (NT_STORES == 1) __builtin_nontemporal_store(v, (u32x4*)p);
    else if (NT_STORES == 2) asm volatile("global_store_dwordx4 %0, %1, off sc1\n\ts_nop 1" :: "v"(p), "v"(v) : "memory");
    else if (NT_STORES == 3) asm volatile("global_store_dwordx4 %0, %1, off sc0 sc1\n\ts_nop 1" :: "v"(p), "v"(v) : "memory");
    else *(u32x4*)p = v; }
#ifndef NT_UP
#define NT_UP 1
#endif
__device__ __forceinline__ void ST16W(bf16_t* p, u32x4 v) { if (NT_UP) asm volatile("global_store_dwordx4 %0, %1, off sc1\n\ts_nop 1" :: "v"(p), "v"(v) : "memory"); else *(u32x4*)p = v; }
__device__ __forceinline__ void ST8W(void* p, u32x2 v) { asm volatile("global_store_dwordx2 %0, %1, off sc1\n\ts_nop 1" :: "v"(p), "v"(v) : "memory"); }
#ifndef SC1_MIX
#define SC1_MIX 0
#endif
#ifndef SC1_RES
#define SC1_RES 0
#endif
#ifndef SC1_QKV
#define SC1_QKV 0
#endif
template <int W> __device__ __forceinline__ void ST16S(bf16_t* p, u32x4 v) { if (W) asm volatile("global_store_dwordx4 %0, %1, off sc1\n\ts_nop 1" :: "v"(p), "v"(v) : "memory"); else *(u32x4*)p = v; }
template <int W> __device__ __forceinline__ void ST8S(bf16_t* p, u32x2 v) { if (W) asm volatile("global_store_dwordx2 %0, %1, off sc1\n\ts_nop 1" :: "v"(p), "v"(v) : "memory"); else *(u32x2*)p = v; }
__device__ __forceinline__ void ST8(bf16_t* p, u32x2 v) {
    if (NT_STORES8 == 2) asm volatile("global_store_dwordx2 %0, %1, off sc1\n\ts_nop 1" :: "v"(p), "v"(v) : "memory");
    else *(u32x2*)p = v; }
template <int NS> __device__ __forceinline__ void rs_to_lds(PG8_LAS float* rsl, const float* ss, int pm, float inv_n, float mul, int tid) {
    if (tid < 256) { const float* p = ss + (size_t)(pm * BM + tid) * NS; const float s_ = NS == 16 ? sum16(p) : sum4(p); rsl[tid] = rsqrtf(s_ * inv_n + NORM_EPS) * mul; }
    asm volatile("s_waitcnt lgkmcnt(0)" ::: "memory"); __builtin_amdgcn_s_barrier();
}
struct EpiP {
    static constexpr bool PERM = true, AFTER_DRAIN = false;
    bf16_t* RKV; bf16_t* LORAC; bf16_t* PMb; unsigned char* G8; const float* ss; float* ssq; float* sskv; bf16_t* HALO; PG8_LAS float* rsl; int pn0;
    __device__ __forceinline__ void operator()(const f32x4 (&acc)[2][2][4][2], const Unit& u, int wr, int wc, int fr, int fq) const {
        const int row0 = u.pm * BM + wr * 64 + fr, pn = u.pn + pn0;
        rs_to_lds<16>(rsl, ss, u.pm, 1.0f / 1024.0f, 1.0f, (wr * 4 + wc) * 64 + fq * 16 + fr);
#pragma unroll
        for (int ai = 0; ai < 2; ++ai)
#pragma unroll
            for (int m = 0; m < 4; ++m) {
                const int row = row0 + ai * HALF + m * 16;
                const float rs = rsl[wr * 64 + ai * HALF + m * 16 + fr];
                float sq = 0.f;
#pragma unroll
                for (int bj = 0; bj < 2; ++bj) {
                    const f32x4 v0 = acc[ai][bj][m][0] * rs, v1 = acc[ai][bj][m][1] * rs;
                    const int ct = bj * HALF + wc * 32 + 8 * fq;
                    if (pn < 6) { const u32x4 pk_ = pack8(v0, v1); ST16(RKV + (size_t)row * 1536 + pn * 256 + ct, pk_); if (fr == 15) *(u32x4*)(HALO + (size_t)(row >> 4) * 1536 + pn * 256 + ct) = pk_; }
                    else if (pn == 6) ST16(LORAC + (size_t)row * 256 + ct, pack8(v0, v1));
                    else if (pn < 9) { ST16(PMb + (size_t)row * 512 + (pn - 7) * 256 + ct, pack8(v0, v1));
                        if (pn == 7 || bj == 0) sq += dot4(v0, v0) + dot4(v1, v1); }
                    else { u32x2 w; w.x = sig8x4(v0); w.y = sig8x4(v1); ST8((bf16_t*)(G8 + (size_t)row * 2048 + (pn - 9) * 256 + ct), w); }
                }
                if (pn == 7 || pn == 8) { sq += shx(sq, 16); sq += shx(sq, 32); if (fq == 0) (pn == 7 ? ssq : sskv)[(size_t)row * 4 + wc] = sq; }
            }
    }
};
#ifndef LW_CUM
#define LW_CUM 1
#endif
template <int CTRL> __device__ __forceinline__ float dppz(float x) { return __builtin_bit_cast(float, __builtin_amdgcn_update_dpp(0, __builtin_bit_cast(int, x), CTRL, 0xf, 0xf, true)); }
__device__ __forceinline__ float pfx16(float x) { x += dppz<0x111>(x); x += dppz<0x112>(x); x += dppz<0x114>(x); x += dppz<0x118>(x); return x; }
struct EpiLora {
    static constexpr bool PERM = true, AFTER_DRAIN = false;
    bf16_t* LW; bf16_t* ICLR; bf16_t* GATE; const float* dbase; const float* ibase;
    __device__ __forceinline__ void operator()(const f32x4 (&acc)[2][2][4][2], const Unit& u, int wr, int wc, int fr, int fq) const {
        const int pn = u.pn, kind = pn >> 1;
        bf16_t* dst = LW + (size_t)kind * ((size_t)M * 512);
        const float* bias = kind == 0 ? dbase : ibase;
        const unsigned c0 = (pn & 1) * 256 + wc * 32 + 8 * fq;
        const unsigned off0 = (unsigned)(u.pm * BM + wr * 64 + fr) * 512u + c0;
#pragma unroll
        for (int bj = 0; bj < 2; ++bj) {
            f32x4 b0 = (f32x4){0.f, 0.f, 0.f, 0.f}, b1 = b0;
            if (kind < 2) { b0 = *(const f32x4*)(bias + c0 + bj * HALF); b1 = *(const f32x4*)(bias + c0 + bj * HALF + 4); }
#pragma unroll
            for (int ai = 0; ai < 2; ++ai)
#pragma unroll
                for (int m = 0; m < 4; ++m) {
                    f32x4 v0 = acc[ai][bj][m][0] + b0, v1 = acc[ai][bj][m][1] + b1;
                    if (kind == 0) { for (int e = 0; e < 4; ++e) { v0[e] = -0.6065306597126334f * sigm(v0[e]); v1[e] = -0.6065306597126334f * sigm(v1[e]); }
                        if (LW_CUM) { for (int e = 0; e < 4; ++e) { v0[e] = __expf(pfx16(v0[e])); v1[e] = __expf(pfx16(v1[e])); } } }
                    else if (kind == 1) { for (int e = 0; e < 4; ++e) { v0[e] = sigm(v0[e]); v1[e] = sigm(v1[e]); } }
                    ST16(dst + off0 + (unsigned)((ai * HALF + m * 16) * 512 + bj * HALF), pack8(v0, v1));
                    asm volatile("" ::: "memory");
                }
        }
    }
};
struct EpiQ {
    static constexpr bool PERM = false, AFTER_DRAIN = false;
    bf16_t* Qn; bf16_t* Qp; const float* ssq; const float* CS; PG8_LAS float* rsl;
    __device__ __forceinline__ void operator()(const f32x4 (&acc)[2][2][4][2], const Unit& u, int wr, int wc, int fr, int fq) const {
        const int row0 = u.pm * BM + wr * 64 + fr, pn = u.pn;
        if (pn < 2) {
            rs_to_lds<4>(rsl, ssq, u.pm, 1.0f / 256.0f, C2, (wr * 4 + wc) * 64 + fq * 16 + fr);
#pragma unroll
            for (int ai = 0; ai < 2; ++ai)
#pragma unroll
                for (int m = 0; m < 4; ++m) {
                    const int row = row0 + ai * HALF + m * 16;
                    const float rs = rsl[wr * 64 + ai * HALF + m * 16 + fr];
#pragma unroll
                    for (int bj = 0; bj < 2; ++bj)
#pragma unroll
                        for (int n = 0; n < 2; ++n) ST8S<SC1_QKV>(Qn + (size_t)row * 512 + pn * 256 + bj * HALF + wc * 32 + n * 16 + 4 * fq, dn4(acc[ai][bj][m][n] * rs));
                }
        } else {
            f32x4 cs[2][4], sn[2][4];
#pragma unroll
            for (int ai = 0; ai < 2; ++ai)
#pragma unroll
                for (int m = 0; m < 4; ++m) { const int row = row0 + ai * HALF + m * 16; cs[ai][m] = *(const f32x4*)(CS + (size_t)row * 32 + 4 * fq); sn[ai][m] = *(const f32x4*)(CS + (size_t)row * 32 + 16 + 4 * fq); }
            rs_to_lds<4>(rsl, ssq, u.pm, 1.0f / 256.0f, C2, (wr * 4 + wc) * 64 + fq * 16 + fr);
#pragma unroll
            for (int ai = 0; ai < 2; ++ai)
#pragma unroll
                for (int m = 0; m < 4; ++m) {
                    const int row = row0 + ai * HALF + m * 16;
                    const float rs = rsl[wr * 64 + ai * HALF + m * 16 + fr];
#pragma unroll
                    for (int bj = 0; bj < 2; ++bj) {
                        const f32x4 x1 = acc[ai][bj][m][0] * rs, x2 = acc[ai][bj][m][1] * rs;
                        bf16_t* d = Qp + (size_t)row * 256 + (4 * bj + wc) * 32 + 4 * fq;
                        ST8S<SC1_QKV>(d, dn4(x1 * cs[ai][m] - x2 * sn[ai][m])); ST8S<SC1_QKV>(d + 16, dn4(x1 * sn[ai][m] + x2 * cs[ai][m]));
                    }
                }
        }
    }
};
struct EpiKV {
    static constexpr bool PERM = false, AFTER_DRAIN = false;
    bf16_t* Kn; bf16_t* Vt; const float* sskv; PG8_LAS float* rsl;
    __device__ __forceinline__ void operator()(const f32x4 (&acc)[2][2][4][2], const Unit& u, int wr, int wc, int fr, int fq) const {
        const int row0 = u.pm * BM + wr * 64 + fr, pn = u.pn;
        rs_to_lds<4>(rsl, sskv, u.pm, 1.0f / 128.0f, 1.0f, (wr * 4 + wc) * 64 + fq * 16 + fr);
#pragma unroll
        for (int ai = 0; ai < 2; ++ai)
#pragma unroll
            for (int m = 0; m < 4; ++m) {
                const int row = row0 + ai * HALF + m * 16;
                const float rs = rsl[wr * 64 + ai * HALF + m * 16 + fr];
                if (pn < 2) {
#pragma unroll
                    for (int bj = 0; bj < 2; ++bj)
#pragma unroll
                        for (int n = 0; n < 2; ++n) ST8S<SC1_QKV>(Kn + (size_t)row * 512 + pn * 256 + bj * HALF + wc * 32 + n * 16 + 4 * fq, dn4(acc[ai][bj][m][n] * rs));
                } else {
                    const int b = row >> 12, s = row & 4095;
#pragma unroll
                    for (int bj = 0; bj < 2; ++bj)
#pragma unroll
                        for (int n = 0; n < 2; ++n) {
                            const int hd = (pn - 2) * 4 + 2 * bj + (wc >> 1), d = 32 * (wc & 1) + 16 * n + 4 * fq;
                            const f32x4 v = acc[ai][bj][m][n] * rs;
                            bf16_t* dst = Vt + ((size_t)((b * 8 + hd) * 64 + d) << 12) + s;
#pragma unroll
                            for (int j = 0; j < 4; ++j) dst[(size_t)j << 12] = (bf16_t)f2bf(v[j]);
                        }
                }
            }
    }
};
template <int PASS> struct EpiMix {
    static constexpr bool PERM = true, AFTER_DRAIN = false;
    float* TMP; bf16_t* MERGED; const unsigned char* G8;
    template <int AI> __device__ __forceinline__ void load(u32x2 (&g)[4][2], u32x4 (&t)[4][2], int row0, int c0) const {
#pragma unroll
        for (int m = 0; m < 4; ++m)
#pragma unroll
            for (int bj = 0; bj < 2; ++bj) { const size_t row = (size_t)(row0 + AI * HALF + m * 16); const int c = c0 + bj * HALF;
                g[m][bj] = *(const u32x2*)(G8 + row * 2048 + (PASS - 1) * 1024 + c);
                if (PASS == 2) t[m][bj] = *(const u32x4*)(MERGED + row * 1024 + c); }
    }
    template <int AI> __device__ __forceinline__ void calc(const f32x4 (&acc)[2][2][4][2], const u32x2 (&g)[4][2], u32x4 (&t)[4][2]) const {
#pragma unroll
        for (int m = 0; m < 4; ++m)
#pragma unroll
            for (int bj = 0; bj < 2; ++bj) { const unsigned ga = g[m][bj].x, gb = g[m][bj].y;
                const f32x4 sa = (f32x4){(float)(ga & 255u), (float)((ga >> 8) & 255u), (float)((ga >> 16) & 255u), (float)(ga >> 24)} * (1.0f / 255.0f);
                const f32x4 sb = (f32x4){(float)(gb & 255u), (float)((gb >> 8) & 255u), (float)((gb >> 16) & 255u), (float)(gb >> 24)} * (1.0f / 255.0f);
                f32x4 oa = acc[AI][bj][m][0] * sa, ob = acc[AI][bj][m][1] * sb;
                if (PASS == 2) { oa = oa + up4((u32x2){t[m][bj].x, t[m][bj].y}); ob = ob + up4((u32x2){t[m][bj].z, t[m][bj].w}); }
                const u32x2 pa = dn4(oa), pb = dn4(ob); t[m][bj] = (u32x4){pa.x, pa.y, pb.x, pb.y}; }
    }
    template <int AI> __device__ __forceinline__ void store(const u32x4 (&o)[4][2], int row0, int c0) const {
#pragma unroll
        for (int m = 0; m < 4; ++m)
#pragma unroll
            for (int bj = 0; bj < 2; ++bj) ST16S<SC1_MIX>(MERGED + (size_t)(row0 + AI * HALF + m * 16) * 1024 + c0 + bj * HALF, o[m][bj]);
    }
    __device__ __forceinline__ void operator()(const f32x4 (&acc)[2][2][4][2], const Unit& u, int wr, int wc, int fr, int fq) const {
        const int row0 = u.pm * BM + wr * 64 + fr, c0 = u.pn * BM + wc * 32 + 8 * fq;
        u32x2 g0[4][2], g1[4][2]; u32x4 t0[4][2], t1[4][2];
        load<0>(g0, t0, row0, c0); calc<0>(acc, g0, t0);
        load<1>(g1, t1, row0, c0);
        store<0>(t0, row0, c0);
        calc<1>(acc, g1, t1); store<1>(t1, row0, c0);
    }
};
struct EpiRes {
    static constexpr bool PERM = false, AFTER_DRAIN = false;
    bf16_t* HB; float* ssacc;
    __device__ __forceinline__ void operator()(const f32x4 (&acc)[2][2][4][2], const Unit& u, int wr, int wc, int fr, int fq) const {
        const int row0 = u.pm * BM + wr * 64 + fr, c0 = u.pn * BM + wc * 32 + 4 * fq;
        u32x2 b[2][4][2][2];
#pragma unroll
        for (int ai = 0; ai < 2; ++ai)
#pragma unroll
            for (int m = 0; m < 4; ++m)
#pragma unroll
                for (int bj = 0; bj < 2; ++bj)
#pragma unroll
                    for (int n = 0; n < 2; ++n) b[ai][m][bj][n] = *(const u32x2*)(HB + (size_t)(row0 + ai * HALF + m * 16) * 1024 + c0 + bj * HALF + n * 16);
#pragma unroll
        for (int ai = 0; ai < 2; ++ai)
#pragma unroll
            for (int m = 0; m < 4; ++m) {
                const int row = row0 + ai * HALF + m * 16; float sq = 0.f;
#pragma unroll
                for (int bj = 0; bj < 2; ++bj)
#pragma unroll
                    for (int n = 0; n < 2; ++n) {
                        const u32x2 p = dn4(up4(b[ai][m][bj][n]) + acc[ai][bj][m][n]); const f32x4 v = up4(p);
                        ST8S<SC1_RES>(HB + (size_t)row * 1024 + c0 + bj * HALF + n * 16, p); sq += dot4(v, v);
                    }
                sq += shx(sq, 16); sq += shx(sq, 32);
                if (fq == 0) ssacc[(size_t)row * 16 + u.pn * 4 + wc] = sq;
            }
    }
};
typedef float f32x2 __attribute__((ext_vector_type(2)));
__device__ __forceinline__ f32x2 gelu_pk2(f32x2 v) {
    const f32x2 av = __builtin_elementwise_abs(v), d = av * 0.2316418882f + 1.0f;
    f32x2 t; t.x = __builtin_amdgcn_rcpf(d.x); t.y = __builtin_amdgcn_rcpf(d.y);
    f32x2 q = t * 0.5307027145f + (-0.7265760135f); q = q * t + 0.7107068705f; q = q * t + (-0.142248368f); q = q * t + 0.127414796f; q = q * t;
    const f32x2 s2 = (v * v) * (-0.72134752044f);
    f32x2 e; e.x = __builtin_amdgcn_exp2f(s2.x); e.y = __builtin_amdgcn_exp2f(s2.y);
    const f32x2 m = v * (q * e), r = v - m;
    f32x2 o; o.x = v.x < 0.f ? m.x : r.x; o.y = v.y < 0.f ? m.y : r.y; return o;
}
__device__ __forceinline__ f32x4 gelu4(f32x4 c) { const f32x2 g0 = gelu_pk2((f32x2){c.x, c.y}), g1 = gelu_pk2((f32x2){c.z, c.w}); return (f32x4){g0.x, g0.y, g1.x, g1.y}; }
template <int CTRL> __device__ __forceinline__ f32x4 ror4(f32x4 x) { f32x4 r;
#pragma unroll
    for (int e = 0; e < 4; ++e) { const float xe = x[e]; const int xi = __builtin_bit_cast(int, xe); r[e] = __builtin_bit_cast(float, __builtin_amdgcn_update_dpp(xi, xi, CTRL, 0xf, 0xf, false)); }
    return r; }
struct EpiUp {
    static constexpr bool PERM = true, AFTER_DRAIN = false;
    bf16_t* ACT; bf16_t* RAWH; const float* ss; const float* cw; const float* cb; PG8_LAS float* rsl;
    __device__ __forceinline__ void operator()(const f32x4 (&acc)[2][2][4][2], const Unit& u, int wr, int wc, int fr, int fq) const {
        const int tid = (wr * 4 + wc) * 64 + fq * 16 + fr, row0 = u.pm * BM + wr * 64 + fr;
        PG8_LAS float* wl = rsl + 256;
        if (tid >= 256 && tid < 384) { const int j = tid - 256, cg = u.pn * HALF + j; wl[j] = cw[cg]; wl[128 + j] = cw[FF + cg]; wl[256 + j] = cw[2 * FF + cg]; wl[384 + j] = cb[cg]; }
        rs_to_lds<16>(rsl, ss, u.pm, 1.0f / 1024.0f, 1.0f, tid);
        const int cl = wc * 32 + 8 * fq, cgl = u.pn * HALF + cl;
#pragma unroll
        for (int ai = 0; ai < 2; ++ai) {
            f32x4 q1a, q1b, q2a, q2b;
#pragma unroll
            for (int m = 0; m < 4; ++m) {
                const int row = row0 + ai * HALF + m * 16;
                const float rs = rsl[wr * 64 + ai * HALF + m * 16 + fr];
                const PG8_LAS float* wp = wl + cl; asm volatile("" : "+v"(wp));
                const f32x4 w0a = *(const PG8_LAS f32x4*)(wp), w0b = *(const PG8_LAS f32x4*)(wp + 4), w1a = *(const PG8_LAS f32x4*)(wp + 128), w1b = *(const PG8_LAS f32x4*)(wp + 128 + 4);
                const f32x4 w2a = *(const PG8_LAS f32x4*)(wp + 256), w2b = *(const PG8_LAS f32x4*)(wp + 256 + 4), ba = *(const PG8_LAS f32x4*)(wp + 384), bb = *(const PG8_LAS f32x4*)(wp + 384 + 4);
                const f32x4 xa = acc[ai][0][m][0] * rs, xb = acc[ai][0][m][1] * rs, va = acc[ai][1][m][0] * rs, vb = acc[ai][1][m][1] * rs;
                const f32x4 r1a = ror4<0x121>(xa), r1b = ror4<0x121>(xb), r2a = ror4<0x122>(xa), r2b = ror4<0x122>(xb);
                f32x4 p1a = r1a, p1b = r1b, p2a = r2a, p2b = r2b;
                if (m > 0) { if (fr < 1) { p1a = q1a; p1b = q1b; } if (fr < 2) { p2a = q2a; p2b = q2b; } }
                const f32x4 ga = gelu4(ba + w0a * p2a + w1a * p1a + w2a * xa), gb = gelu4(bb + w0b * p2b + w1b * p1b + w2b * xb);
                if (m > 0 || fr >= 2) ST16W(ACT + (size_t)row * FF + cgl, pack8(ga * va, gb * vb));
                if (m == 0) { if (fr < 2) { bf16_t* hp = RAWH + ((size_t)(row >> 6) * 6 + 2 + fr) * FF + cgl; *(u32x4*)hp = pack8(xa, xb); *(u32x4*)(hp + 2 * FF) = pack8(va, vb); } }
                if (m == 3) { if (fr >= 14) *(u32x4*)(RAWH + ((size_t)(row >> 6) * 6 + (fr - 14)) * FF + cgl) = pack8(xa, xb); }
                q1a = r1a; q1b = r1b; q2a = r2a; q2b = r2b;
            }
        }
    }
};
struct EpiUpG {
    static constexpr bool PERM = true, AFTER_DRAIN = false;
    bf16_t* UG; const float* ss; PG8_LAS float* rsl;
    __device__ __forceinline__ void operator()(const f32x4 (&acc)[2][2][4][2], const Unit& u, int wr, int wc, int fr, int fq) const {
        const int row0 = u.pm * BM + wr * 64 + fr;
        rs_to_lds<16>(rsl, ss, u.pm, 1.0f / 1024.0f, 1.0f, (wr * 4 + wc) * 64 + fq * 16 + fr);
#pragma unroll
        for (int ai = 0; ai < 2; ++ai)
#pragma unroll
            for (int m = 0; m < 4; ++m) {
                const int row = row0 + ai * HALF + m * 16;
                const float rs = rsl[wr * 64 + ai * HALF + m * 16 + fr];
#pragma unroll
                for (int bj = 0; bj < 2; ++bj) ST16(UG + (size_t)row * FF + u.pn * BM + bj * HALF + wc * 32 + 8 * fq, pack8(acc[ai][bj][m][0] * rs, acc[ai][bj][m][1] * rs));
            }
    }
};
struct EpiUpV {
    static constexpr bool PERM = true, AFTER_DRAIN = false;
    bf16_t* ACT; const float* ss; PG8_LAS float* rsl;
    __device__ __forceinline__ void operator()(const f32x4 (&acc)[2][2][4][2], const Unit& u, int wr, int wc, int fr, int fq) const {
        const int row0 = u.pm * BM + wr * 64 + fr, c0 = u.pn * BM + wc * 32 + 8 * fq;
        u32x4 gc[2][4][2];
#pragma unroll
        for (int ai = 0; ai < 2; ++ai)
#pragma unroll
            for (int m = 0; m < 4; ++m)
#pragma unroll
                for (int bj = 0; bj < 2; ++bj) gc[ai][m][bj] = *(const u32x4*)(ACT + (size_t)(row0 + ai * HALF + m * 16) * FF + c0 + bj * HALF);
        rs_to_lds<16>(rsl, ss, u.pm, 1.0f / 1024.0f, 1.0f, (wr * 4 + wc) * 64 + fq * 16 + fr);
#pragma unroll
        for (int ai = 0; ai < 2; ++ai)
#pragma unroll
            for (int m = 0; m < 4; ++m) {
                const int row = row0 + ai * HALF + m * 16;
                const float rs = rsl[wr * 64 + ai * HALF + m * 16 + fr];
#pragma unroll
                for (int bj = 0; bj < 2; ++bj) { const u32x4 g = gc[ai][m][bj];
                    *(u32x4*)(ACT + (size_t)row * FF + c0 + bj * HALF) = pack8(up4((u32x2){g.x, g.y}) * (acc[ai][bj][m][0] * rs), up4((u32x2){g.z, g.w}) * (acc[ai][bj][m][1] * rs)); }
            }
    }
};
}


#ifndef NAIVE_GEMM
#define NAIVE_GEMM 0
#endif
#ifndef NAIVE_ATTN
#define NAIVE_ATTN 0
#endif
#ifndef SHFL_SCAN
#define SHFL_SCAN 0
#endif
namespace pg8 {
template <class Epi, class Sched>
__device__ __forceinline__ void gemm_phase_naive(const Gemm g, const Sched& S, const Epi& E) {
    const int tid = vtid(), wid = tid >> 6, lane = tid & 63, wr = wid >> 2, wc = wid & 3, fr = lane & 15, fq = lane >> 4;
    Unit u;
    for (int i = 0; S.next(i, u); ++i) {
        f32x4 acc[2][2][4][2];
        _Pragma("unroll") for (int a = 0; a < 2; ++a) _Pragma("unroll") for (int b = 0; b < 2; ++b) _Pragma("unroll") for (int m = 0; m < 4; ++m) _Pragma("unroll") for (int n = 0; n < 2; ++n) {
            const int row = u.pm * BM + a * HALF + wr * 64 + m * 16 + fr;
            _Pragma("unroll") for (int j = 0; j < 4; ++j) {
                const int col = u.pn * BM + b * HALF + wc * 32 + (Epi::PERM ? 8 * fq + 4 * n + j : 16 * n + 4 * fq + j);
                const bf16_t* ap = g.A + (size_t)row * g.lda; const bf16_t* bp = g.Bt + (size_t)col * g.K;
                float s = 0.f;
                _Pragma("unroll 1") for (int k = 0; k < g.K; k += 8) {
                    const u32x4 av = *(const u32x4*)(ap + k), bv = *(const u32x4*)(bp + k);
                    for (int e = 0; e < 4; ++e) { s += __uint_as_float(av[e] << 16) * __uint_as_float(bv[e] << 16); s += __uint_as_float(av[e] & 0xffff0000u) * __uint_as_float(bv[e] & 0xffff0000u); }
                }
                acc[a][b][m][n][j] = s;
            }
        }
        E(acc, u, wr, wc, fr, fq);
    }
}
}
#if NAIVE_GEMM
#define GEMM_PHASE(EPI, lds, g, S, E) pg8::gemm_phase_naive<EPI, pg8::StaticOrder>(g, S, E)
#else
#define GEMM_PHASE(EPI, lds, g, S, E) pg8::gemm_phase<EPI, pg8::StaticOrder, true, true>(lds, g, S, E)
#endif
struct Args {
    const float* in[28]; float* out; unsigned char* ws; int ph_lo, ph_hi;
};
enum { I_X = 0, I_POS, I_ATTN_NORM, I_W_IN, I_MU, I_DBASE, I_W_DEC, I_IBASE, I_W_ICLR, I_W_GATE, I_KK, I_KA, I_RK, I_LNXW, I_LNXB, I_W_ORWKV, I_QNORM, I_W_QUP,
       I_KVNORM, I_W_KVUP, I_W_OMLA, I_W_OUT, I_FFN_NORM, I_W_UP, I_CONVW, I_CONVB, I_W_DOWN, I_FINAL };

typedef const __attribute__((address_space(4))) Args* ArgsP;
__device__ __forceinline__ ArgsP args_ptr() { ArgsP p = (ArgsP)__builtin_amdgcn_kernarg_segment_ptr(); asm volatile("" : "+s"(p)); return p; }
__device__ __forceinline__ int ltid() { int t = vtid(); asm volatile("" : "+v"(t)); return t; }
constexpr int NWAVES = 8, NTHREADS = 512;
constexpr int RING_BYTES = 131072, MISC_OFF = RING_BYTES + 320, LDS_BYTES = 147456;

__device__ __forceinline__ void tr_item(const float* W, int N, int k0, int n0, bf16_t* dst, int mode, int roff, int ldk, int koff, const float* scale, LAS float* scr, int lane) {
    const int kq = lane >> 4, n4 = (lane & 15) * 4;
    f32x4 v[8];
#pragma unroll
    for (int i = 0; i < 8; ++i) v[i] = (n0 + n4 < N) ? *(const f32x4*)(W + (size_t)(k0 + kq + 4 * i) * N + n0 + n4) : (f32x4){0.f, 0.f, 0.f, 0.f};
#pragma unroll
    for (int i = 0; i < 8; ++i) { const int kk = kq + 4 * i; f32x4 x = v[i]; if (scale) x = x * scale[k0 + kk];
        LAS float* p = scr + kk * 65 + n4; p[0] = x.x; p[1] = x.y; p[2] = x.z; p[3] = x.w; }
    asm volatile("s_waitcnt lgkmcnt(0)" ::: "memory");
    const LAS float* s = scr + lane;
    const int n = n0 + lane;
    int drow = n;
    if (mode == 1) drow = n < 2208 ? n : n + 96;
    else if (mode == 2) { const int h = n / 96, j = n % 96; drow = j < 64 ? h * 64 + j : 512 + h * 32 + (j - 64); }
    else if (mode == 3) { const int h = n >> 7, j = n & 127; drow = j < 64 ? h * 64 + j : 512 + h * 64 + (j - 64); }
    else if (mode == 4) { const int v = n < FF ? n : n - FF; drow = (v >> 7) * 256 + (n < FF ? 0 : 128) + (v & 127); }
    bf16_t* d = dst + (size_t)(drow + roff) * ldk + koff + k0;
    if (n < N)
#pragma unroll
    for (int c = 0; c < 4; ++c) { u32x4 o; o.x = pk2(s[(8 * c + 0) * 65], s[(8 * c + 1) * 65]); o.y = pk2(s[(8 * c + 2) * 65], s[(8 * c + 3) * 65]); o.z = pk2(s[(8 * c + 4) * 65], s[(8 * c + 5) * 65]); o.w = pk2(s[(8 * c + 6) * 65], s[(8 * c + 7) * 65]);
        *(u32x4*)(d + 8 * c) = o; }
    asm volatile("s_waitcnt lgkmcnt(0)" ::: "memory");
}
__device__ __forceinline__ void phase_weights(ArgsP a, int l, LAS unsigned char* lds) {
    a = args_ptr();
    const int tid = ltid(), lane = tid & 63, wave = tid >> 6;
    const int gw = blockIdx.x * NWAVES + wave, NGW = gridDim.x * NWAVES;
    LAS float* scr = (LAS float*)(lds + wave * 16384);
    unsigned char* wb = a->ws + WS_W;
    bf16_t* Wt_in = (bf16_t*)(wb + W_IN); bf16_t* Wt_lora = (bf16_t*)(wb + W_LORA); bf16_t* Wt_q = (bf16_t*)(wb + W_Q); bf16_t* Wt_kv = (bf16_t*)(wb + W_KV);
    bf16_t* Wt_oa = (bf16_t*)(wb + W_OA); bf16_t* Wt_ob = (bf16_t*)(wb + W_OB); bf16_t* Wt_out = (bf16_t*)(wb + W_OUT); bf16_t* Wt_up = (bf16_t*)(wb + W_UP); bf16_t* Wt_down = (bf16_t*)(wb + W_DOWN);
    constexpr int I_IN = 32 * 67, I_DEC = 2 * 8, I_ICL = 2 * 8, I_GAT = 4 * 8, I_Q = 8 * 12, I_KV = 4 * 16, I_OA = 16 * 16, I_OB = 16 * 16, I_OUT = 32 * 16, I_UP = 32 * 88, I_DN = 88 * 16;
    constexpr int NITEMS = I_IN + I_DEC + I_ICL + I_GAT + I_Q + I_KV + I_OA + I_OB + I_OUT + I_UP + I_DN;
    for (int it = gw; it < NITEMS; it += NGW) {
        int r = it;
        const float* W; const float* scale = nullptr; bf16_t* dst; int N, kb, nb, mode = 0, roff = 0, ldk, koff = 0;
        if (r < I_IN) { kb = r / 67; nb = r % 67; W = a->in[I_W_IN] + (size_t)l * 1024 * IN_COLS; N = IN_COLS; dst = Wt_in; mode = 1; ldk = 1024; scale = a->in[I_ATTN_NORM] + l * 1024; }
        else if ((r -= I_IN) < I_DEC) { kb = r / 8; nb = r % 8; W = a->in[I_W_DEC] + (size_t)l * 64 * 512; N = 512; dst = Wt_lora; ldk = 256; }
        else if ((r -= I_DEC) < I_ICL) { kb = r / 8; nb = r % 8; W = a->in[I_W_ICLR] + (size_t)l * 64 * 512; N = 512; dst = Wt_lora; roff = 512; ldk = 256; koff = 64; }
        else if ((r -= I_ICL) < I_GAT) { kb = r / 8; nb = r % 8; W = a->in[I_W_GATE] + (size_t)l * 128 * 512; N = 512; dst = Wt_lora; roff = 1024; ldk = 256; koff = 128; }
        else if ((r -= I_GAT) < I_Q) { kb = r / 12; nb = r % 12; W = a->in[I_W_QUP] + (size_t)l * 256 * 768; N = 768; dst = Wt_q; mode = 2; ldk = 256; scale = a->in[I_QNORM] + l * 256; }
        else if ((r -= I_Q) < I_KV) { kb = r / 16; nb = r % 16; W = a->in[I_W_KVUP] + (size_t)l * 128 * 1024; N = 1024; dst = Wt_kv; mode = 3; ldk = 256; scale = a->in[I_KVNORM] + l * 128; }
        else if ((r -= I_KV) < I_OA) { kb = r / 16; nb = r % 16; W = a->in[I_W_ORWKV] + (size_t)l * 512 * 1024; N = 1024; dst = Wt_oa; ldk = 512; }
        else if ((r -= I_OA) < I_OB) { kb = r / 16; nb = r % 16; W = a->in[I_W_OMLA] + (size_t)l * 512 * 1024; N = 1024; dst = Wt_ob; ldk = 512; }
        else if ((r -= I_OB) < I_OUT) { kb = r / 16; nb = r % 16; W = a->in[I_W_OUT] + (size_t)l * 1024 * 1024; N = 1024; dst = Wt_out; ldk = 1024; }
        else if ((r -= I_OUT) < I_UP) { kb = r / 88; nb = r % 88; W = a->in[I_W_UP] + (size_t)l * 1024 * 2 * FF; N = 2 * FF; dst = Wt_up; mode = 4; ldk = 1024; scale = a->in[I_FFN_NORM] + l * 1024; }
        else { r -= I_UP; kb = r / 16; nb = r % 16; W = a->in[I_W_DOWN] + (size_t)l * FF * 1024; N = 1024; dst = Wt_down; ldk = FF; }
        tr_item(W, N, kb * 32, nb * 64, dst, mode, roff, ldk, koff, scale, scr, lane);
    }
    const int gt = blockIdx.x * NTHREADS + tid, NGT = gridDim.x * NTHREADS;
    unsigned z0_ = 0u; asm volatile("" : "+v"(z0_));
    const u32x4 z = (u32x4){z0_, z0_, z0_, z0_};
    for (int i = gt; i < 96 * 128; i += NGT) *(u32x4*)(Wt_in + (size_t)(2208 + i / 128) * 1024 + (i % 128) * 8) = z;
    for (int i = gt; i < 1536 * 32; i += NGT) { const int row = i / 32, k8 = (i % 32) * 8, kind = row >> 9; const bool live = kind == 0 ? (k8 < 64) : (kind == 1 ? (k8 >= 64 && k8 < 128) : (k8 >= 128)); if (!live) *(u32x4*)(Wt_lora + (size_t)row * 256 + k8) = z; }
    for (int i = gt; i < 1024 * 16; i += NGT) *(u32x4*)(Wt_kv + (size_t)(i / 16) * 256 + 128 + (i % 16) * 8) = z;
#ifdef SCRIBBLE
    if (l == 0) { u32x4* p = (u32x4*)(a->ws + WS_ACT); const u32x4 pz = (u32x4){0xAAAAAAAAu, 0xAAAAAAAAu, 0xAAAAAAAAu, 0xAAAAAAAAu};
        for (unsigned i = gt; i < 178u * 65536u; i += NGT) p[i] = pz; }
#endif
    if (l == 0) {
        float* SS0 = (float*)(a->ws + WS_SSP); bf16_t* HB = (bf16_t*)(a->ws + A_HB);
        for (int m = gw; m < M; m += NGW) {
            const f32x4* xr = (const f32x4*)(a->in[I_X] + (size_t)m * DM) + lane; float s = 0.f;
            u32x2* o = (u32x2*)(HB + (size_t)m * DM) + lane;
#pragma unroll
            for (int j = 0; j < 4; ++j) { const f32x4 v = xr[64 * j]; s += dot4(v, v); o[64 * j] = dn4(v); }
#pragma unroll
            for (int o2 = 1; o2 < 64; o2 <<= 1) s += shx(s, o2);
            if (lane < 16) SS0[(size_t)m * 16 + lane] = lane == 0 ? s : 0.f;
        }
        float* CS = (float*)(a->ws + WS_CS); const int* pos = (const int*)a->in[I_POS];
        for (int i = gt; i < M * 16; i += NGT) { const int row = i >> 4, f = i & 15;
            const float invf = exp2f(-0.830482023721841f * (float)f);
            const float ang = (float)pos[row] * invf;
            const float k = rintf(ang * 0.15915494309189535f);
            float rr = fmaf(-k, 6.2831854820251465f, ang); rr = fmaf(-k, -1.7484555314695172e-07f, rr);
            CS[(size_t)row * 32 + f] = cosf(rr); CS[(size_t)row * 32 + 16 + f] = sinf(rr); }
    }
}

__device__ __forceinline__ void phase_prep(ArgsP a, int l) {
    a = args_ptr();
    const unsigned gt = blockIdx.x * NTHREADS + ltid(), NGT = gridDim.x * NTHREADS;
    const bf16_t* LORAC = (const bf16_t*)(a->ws + A_LORAC); bf16_t* LIN = (bf16_t*)(a->ws + A_LIN);
    {
        const int j = (gt & 31) * 8; const float* mu = a->in[I_MU] + (size_t)l * 1792 + 1536 + j;
        const f32x4 m0 = *(const f32x4*)mu, m1 = *(const f32x4*)(mu + 4);
        for (unsigned i = gt; i < (unsigned)M * 32; i += NGT) { const unsigned row = i >> 5; const int t = row & 4095;
            const u32x4 cu = *(const u32x4*)(LORAC + (size_t)row * 256 + j); const u32x4 pv = t ? *(const u32x4*)(LORAC + (size_t)(row - 1) * 256 + j) : (u32x4){0u, 0u, 0u, 0u};
            const f32x4 c0 = up4((u32x2){cu.x, cu.y}), c1 = up4((u32x2){cu.z, cu.w}), q0 = up4((u32x2){pv.x, pv.y}), q1 = up4((u32x2){pv.z, pv.w});
            f32x4 s0 = c0 + (q0 - c0) * m0, s1 = c1 + (q1 - c1) * m1;
            if (j < 64) { for (int e = 0; e < 4; ++e) { s0[e] = tanhf(s0[e]); s1[e] = tanhf(s1[e]); } } else if (j >= 128) { for (int e = 0; e < 4; ++e) { s0[e] = sigm(s0[e]); s1[e] = sigm(s1[e]); } }
            const u32x2 o0 = dn4(s0), o1 = dn4(s1); *(u32x4*)(LIN + (size_t)row * 256 + j) = (u32x4){o0.x, o0.y, o1.x, o1.y}; }
    }
    const bf16_t* PMb = (const bf16_t*)(a->ws + A_PM); bf16_t* KPE = (bf16_t*)(a->ws + A_KPE); const float* CS = (const float*)(a->ws + WS_CS);
    for (unsigned i = gt; i < (unsigned)M * 4; i += NGT) { const unsigned row = i >> 2; const int f = (i & 3) * 4;
        const f32x4 x1 = up4(*(const u32x2*)(PMb + (size_t)row * 512 + 384 + f)), x2 = up4(*(const u32x2*)(PMb + (size_t)row * 512 + 400 + f));
        const f32x4 cs = *(const f32x4*)(CS + (size_t)row * 32 + f), sn = *(const f32x4*)(CS + (size_t)row * 32 + 16 + f);
        *(u32x2*)(KPE + (size_t)row * 32 + f) = dn4(x1 * cs - x2 * sn); *(u32x2*)(KPE + (size_t)row * 32 + 16 + f) = dn4(x1 * sn + x2 * cs); }
}

template <int CTRL> __device__ __forceinline__ float dppf(float x) { return __builtin_bit_cast(float, __builtin_amdgcn_update_dpp(0, __builtin_bit_cast(int, x), CTRL, 0xf, 0xf, false)); }
#if SHFL_SCAN
__device__ __forceinline__ float rr16(float x) { x += shx(x, 8); x += shx(x, 4); x += shx(x, 2); x += shx(x, 1); return x; }
#else
__device__ __forceinline__ float rr16(float x) { x += dppf<0x128>(x); x += dppf<0x124>(x); x += dppf<0x122>(x); x += dppf<0x121>(x); return x; }
#endif

typedef float f32x2 __attribute__((ext_vector_type(2)));
constexpr int SC_BUF = 43008, SC_R = 0, SC_W = 8192, SC_K = 16384, SC_A = 24576, SC_B = 32768, SC_V = 40960, SC_YP = 2 * SC_BUF, SC_YPB = 8192;
struct ScOps { f32x4 a, w, b, k, r; float v; };
__device__ __forceinline__ void sc_ld(ScOps& o, const LAS unsigned char* bp, const LAS unsigned char* vp, int t) {
    o.a = *(const LAS f32x4*)(bp + SC_A + t * 256); o.w = *(const LAS f32x4*)(bp + SC_W + t * 256); o.b = *(const LAS f32x4*)(bp + SC_B + t * 256);
    o.k = *(const LAS f32x4*)(bp + SC_K + t * 256); o.r = *(const LAS f32x4*)(bp + SC_R + t * 256); o.v = *(const LAS float*)(vp + t * 64);
}
__device__ __forceinline__ void scan_unit(ArgsP a, int l, int bh, int q4, LAS unsigned char* lds, size_t y_off = A_Y) {
    a = args_ptr();
    const int tid = ltid(), lane = tid & 63, wid = __builtin_amdgcn_readfirstlane(tid >> 6);
    const int b = bh >> 3, h = bh & 7, i0 = q4 * 16;
    const bf16_t* RKV = (const bf16_t*)(a->ws + A_RKV); const bf16_t* LW = (const bf16_t*)(a->ws + A_LW); const bf16_t* ICLR = (const bf16_t*)(a->ws + A_ICLR);
    bf16_t* Y = (bf16_t*)(a->ws + y_off); float* SCAL = (float*)(a->ws + WS_SCAL);
    constexpr int NCH = SEQ / 32;
    if (wid >= 4) {
        const int ht = tid - 256, pcg = ht & 15, tau0 = ht >> 4, ch = h * 64 + 4 * pcg;
        const float* mu = a->in[I_MU] + (size_t)l * 1792;
        const f32x4 mu_r = *(const f32x4*)(mu + ch), mu_k = *(const f32x4*)(mu + 512 + ch), mu_v = *(const f32x4*)(mu + 1024 + ch);
        const f32x4 kk_c = *(const f32x4*)(a->in[I_KK] + l * 512 + ch), ka_c = *(const f32x4*)(a->in[I_KA] + l * 512 + ch), rk_c = *(const f32x4*)(a->in[I_RK] + l * 512 + ch);
        u32x2 g[2][8];
        const u32x2 z2 = (u32x2){0u, 0u};
#define SC_LOAD(c) do { _Pragma("unroll") for (int k_ = 0; k_ < 2; ++k_) { const int t_ = (c) * 32 + tau0 + 16 * k_; const size_t row_ = (size_t)b * SEQ + t_; \
            g[k_][0] = *(const u32x2*)(RKV + row_ * 1536 + ch); g[k_][1] = *(const u32x2*)(RKV + row_ * 1536 + 512 + ch); g[k_][2] = *(const u32x2*)(RKV + row_ * 1536 + 1024 + ch); \
            if (t_) { g[k_][3] = *(const u32x2*)(RKV + (row_ - 1) * 1536 + ch); g[k_][4] = *(const u32x2*)(RKV + (row_ - 1) * 1536 + 512 + ch); g[k_][5] = *(const u32x2*)(RKV + (row_ - 1) * 1536 + 1024 + ch); } \
            else { g[k_][3] = z2; g[k_][4] = z2; g[k_][5] = z2; } \
            g[k_][6] = *(const u32x2*)(LW + row_ * 512 + ch); g[k_][7] = *(const u32x2*)(ICLR + row_ * 512 + ch); } } while (0)
#define SC_STORE(c, p) do { _Pragma("unroll") for (int k_ = 0; k_ < 2; ++k_) { const int tau_ = tau0 + 16 * k_; LAS unsigned char* base_ = lds + (p) * SC_BUF + tau_ * 256 + pcg * 16; \
            const f32x4 r2 = up4(g[k_][0]), k2 = up4(g[k_][1]), v2 = up4(g[k_][2]); \
            const f32x4 r = r2 + (up4(g[k_][3]) - r2) * mu_r, k = k2 + (up4(g[k_][4]) - k2) * mu_k, v = v2 + (up4(g[k_][5]) - v2) * mu_v; \
            const f32x4 lw = up4(g[k_][6]), ic = up4(g[k_][7]); \
            f32x4 kk = k * kk_c; float ssum = dot4(kk, kk); ssum += shx(ssum, 1); ssum += shx(ssum, 2); ssum += shx(ssum, 4); ssum += shx(ssum, 8); \
            kk = kk * rsqrtf(ssum + 1e-12f); \
            const f32x4 kp = k * (1.0f + (ic - 1.0f) * ka_c); \
            float sc = dot4(r * kp, rk_c); sc += shx(sc, 1); sc += shx(sc, 2); sc += shx(sc, 4); sc += shx(sc, 8); \
            if (q4 == 0 && pcg == 0) SCAL[((size_t)b * SEQ + (c) * 32 + tau_) * 8 + h] = sc; \
            f32x4 w; w.x = __expf(lw.x * CK_LWZ); w.y = __expf(lw.y * CK_LWZ); w.z = __expf(lw.z * CK_LWZ); w.w = __expf(lw.w * CK_LWZ); \
            *(LAS f32x4*)(base_ + SC_R) = r; *(LAS f32x4*)(base_ + SC_W) = w; *(LAS f32x4*)(base_ + SC_K) = kp; *(LAS f32x4*)(base_ + SC_A) = -kk * CK_AB; *(LAS f32x4*)(base_ + SC_B) = kk * ic * CK_AB; \
            if ((pcg >> 2) == q4) *(LAS f32x4*)(lds + (p) * SC_BUF + SC_V + tau_ * 64 + (pcg & 3) * 16) = v; } } while (0)
        SC_LOAD(0); SC_STORE(0, 0); SC_LOAD(1);
        __syncthreads();
        for (int c = 0; c < NCH; ++c) {
            if (c + 1 < NCH) { SC_STORE(c + 1, (c + 1) & 1); if (c + 2 < NCH) SC_LOAD(c + 2); }
            if (c > 0) {
                const LAS f32x4* yp = (const LAS f32x4*)(lds + SC_YP + ((c - 1) & 1) * SC_YPB + (ht >> 3) * 256 + (ht & 7) * 32);
                const f32x4 y0 = yp[0], y1 = yp[1];
                *(unsigned*)(Y + ((size_t)b * SEQ + (c - 1) * 32 + (ht >> 3)) * 512 + h * 64 + i0 + 2 * (ht & 7)) = pk2((y0.x + y0.y) + (y0.z + y0.w), (y1.x + y1.y) + (y1.z + y1.w));
            }
            __syncthreads();
        }
        { const int c = NCH;
          const LAS f32x4* yp = (const LAS f32x4*)(lds + SC_YP + ((c - 1) & 1) * SC_YPB + (ht >> 3) * 256 + (ht & 7) * 32);
          const f32x4 y0 = yp[0], y1 = yp[1];
          *(unsigned*)(Y + ((size_t)b * SEQ + (c - 1) * 32 + (ht >> 3)) * 512 + h * 64 + i0 + 2 * (ht & 7)) = pk2((y0.x + y0.y) + (y0.z + y0.w), (y1.x + y1.y) + (y1.z + y1.w)); }
#undef SC_LOAD
#undef SC_STORE
    } else {
        const int rloc = wid * 4 + (lane >> 4), cgp = lane & 15;
        __syncthreads();
        f32x2 s01 = (f32x2){0.f, 0.f}, s23 = s01;
        for (int c = 0; c < NCH; ++c) {
            const int p = c & 1;
            const LAS unsigned char* bp = lds + p * SC_BUF + cgp * 16;
            const LAS unsigned char* vp = lds + p * SC_BUF + SC_V + rloc * 4;
            LAS float* ypw = (LAS float*)(lds + SC_YP + p * SC_YPB) + rloc * 4 + cgp;
            ScOps oa, ob;
            sc_ld(oa, bp, vp, 0);
#define SC_STEP(cur, nxt, t) do { if ((t) + 1 < 32) sc_ld(nxt, bp, vp, (t) + 1); if (CK_NOSTATE && ((t) & 15) == 0) { s01 = (f32x2){0.f, 0.f}; s23 = s01; } \
                const f32x2 vk0 = (f32x2){cur.k.x, cur.k.y} * cur.v, vk1 = (f32x2){cur.k.z, cur.k.w} * cur.v; \
                const f32x2 t0 = s01 * (f32x2){cur.w.x, cur.w.y} + vk0, t1 = s23 * (f32x2){cur.w.z, cur.w.w} + vk1; \
                f32x2 pd = s01 * (f32x2){cur.a.x, cur.a.y}; pd = s23 * (f32x2){cur.a.z, cur.a.w} + pd; \
                const float d = rr16(pd.x + pd.y); \
                s01 = (f32x2){cur.b.x, cur.b.y} * d + t0; s23 = (f32x2){cur.b.z, cur.b.w} * d + t1; \
                f32x2 qd = s01 * (f32x2){cur.r.x, cur.r.y}; qd = s23 * (f32x2){cur.r.z, cur.r.w} + qd; \
                float y = qd.x + qd.y; y += dppf<0x128>(y); y += dppf<0x124>(y); \
                if (cgp < 4) ypw[(t) * 64] = y; } while (0)
#pragma unroll 1
            for (int t = 0; t < 32; t += 2) { SC_STEP(oa, ob, t); SC_STEP(ob, oa, t + 1); }
#undef SC_STEP
            __syncthreads();
        }
    }
    __syncthreads();
}

typedef short s16x4v __attribute__((ext_vector_type(4)));
constexpr int CK_ROW = 144;
constexpr int CK_AT = 0, CK_RT = 2304, CK_BT = 4608, CK_KT = 6912, CK_VT = 9216, CK_GL = 11520, CK_OPB = 11776, CK_NOP = 5;
constexpr int CK_MT0 = CK_NOP * CK_OPB, CK_MAK = 0, CK_MRB = 512, CK_MRK = 1024, CK_TT = 1536, CK_MAB = 2048, CK_MTB = 2048 + 16 * 80, CK_NMT = 4;
constexpr int CK_YT0 = CK_MT0 + CK_NMT * CK_MTB, CK_YTB = 1024;
typedef short v4i16_t __attribute__((ext_vector_type(4)));
__device__ __forceinline__ s16x4v ldtr(const LAS unsigned char* p) { return __builtin_bit_cast(s16x4v, __builtin_amdgcn_ds_read_tr16_b64_v4i16((LAS v4i16_t*)p)); }
__device__ __forceinline__ s16x4v pk4(f32x4 v) { const u32x2 p = dn4(v); return __builtin_bit_cast(s16x4v, p); }
__device__ __forceinline__ void scan_unit_chunked(ArgsP a, int l, int bh, int q4, LAS unsigned char* lds, size_t y_off = A_Y) {
    a = args_ptr();
    const int tid = ltid(), lane = tid & 63, wid = __builtin_amdgcn_readfirstlane(tid >> 6);
    const int b = bh >> 3, h = bh & 7, i0 = q4 * 16, q = lane >> 4, l15 = lane & 15;
    const bf16_t* RKV = (const bf16_t*)(a->ws + A_RKV); const bf16_t* EG = (const bf16_t*)(a->ws + A_LW); const bf16_t* ICLR = (const bf16_t*)(a->ws + A_ICLR);
    bf16_t* Y = (bf16_t*)(a->ws + y_off); float* SCAL = (float*)(a->ws + WS_SCAL);
    constexpr int NCH = SEQ / 16;
    const int ht = tid - 256, t_h = (ht >> 4) & 15, jg = ht & 15, ch = h * 64 + 4 * jg;
    f32x4 mu_r, mu_k, mu_v, kk_c, ka_c, rk_c;
    u32x2 g[10], g1[10], g2[10];
    if (wid >= 4) {
        const float* mu = a->in[I_MU] + (size_t)l * 1792;
        mu_r = *(const f32x4*)(mu + ch); mu_k = *(const f32x4*)(mu + 512 + ch); mu_v = *(const f32x4*)(mu + 1024 + ch);
        kk_c = *(const f32x4*)(a->in[I_KK] + l * 512 + ch); ka_c = *(const f32x4*)(a->in[I_KA] + l * 512 + ch); rk_c = *(const f32x4*)(a->in[I_RK] + l * 512 + ch);
    }
#define CK_LOAD(G_, c) do { const int t_ = (c) * 16 + t_h; const size_t row_ = (size_t)b * SEQ + t_; const size_t rp_ = t_ ? row_ - 1 : row_; \
        G_[0] = *(const u32x2*)(RKV + row_ * 1536 + ch); G_[1] = *(const u32x2*)(RKV + row_ * 1536 + 512 + ch); G_[2] = *(const u32x2*)(RKV + row_ * 1536 + 1024 + ch); \
        G_[3] = *(const u32x2*)(RKV + rp_ * 1536 + ch); G_[4] = *(const u32x2*)(RKV + rp_ * 1536 + 512 + ch); G_[5] = *(const u32x2*)(RKV + rp_ * 1536 + 1024 + ch); \
        G_[6] = *(const u32x2*)(ICLR + row_ * 512 + ch); G_[7] = *(const u32x2*)(EG + row_ * 512 + ch); \
        G_[8] = *(const u32x2*)(EG + (row_ - (t_h ? 1 : 0)) * 512 + ch); G_[9] = *(const u32x2*)(EG + ((size_t)b * SEQ + (c) * 16 + 15) * 512 + ch); } while (0)
    f32x4 accS[4];
#pragma unroll
    for (int jt = 0; jt < 4; ++jt) accS[jt] = (f32x4){0.f, 0.f, 0.f, 0.f};
    float x[16];
#pragma unroll
    for (int t_ = 0; t_ < 16; ++t_) x[t_] = 0.f;
#define CK_OPSTAGE(G_, it) do { \
            if (it < NCH) { \
                LAS unsigned char* op = lds + (it % CK_NOP) * CK_OPB; \
                const f32x4 r2 = up4(G_[0]), k2 = up4(G_[1]), v2 = up4(G_[2]); \
                const float pz_ = (it * 16 + t_h) ? 1.0f : 0.0f; \
                const f32x4 r = r2 + (up4(G_[3]) * pz_ - r2) * mu_r, k = k2 + (up4(G_[4]) * pz_ - k2) * mu_k, v = v2 + (up4(G_[5]) * pz_ - v2) * mu_v, ic = up4(G_[6]); \
                const f32x4 eG = up4(G_[7]), eGL = up4(G_[9]); \
                f32x4 eGx = up4(G_[8]); if (t_h == 0) eGx = (f32x4){1.f, 1.f, 1.f, 1.f}; \
                f32x4 enG; \
_Pragma("unroll") \
                for (int e = 0; e < 4; ++e) enG[e] = __builtin_amdgcn_rcpf(eG[e]); \
                f32x4 kk = k * kk_c; const float ssum = rr16(dot4(kk, kk)); \
                kk = kk * rsqrtf(ssum + 1e-12f); \
                const f32x4 kp = k * (1.0f + (ic - 1.0f) * ka_c), bb = kk * ic; \
                const float sc = rr16(dot4(r * kp, rk_c)); \
                if (q4 == 0 && jg == 0) SCAL[((size_t)b * SEQ + it * 16 + t_h) * 8 + h] = sc; \
                *(LAS u32x2*)(op + CK_AT + t_h * CK_ROW + jg * 8) = dn4(-(kk * eGx)); \
                *(LAS u32x2*)(op + CK_RT + t_h * CK_ROW + jg * 8) = dn4(r * eG); \
                *(LAS u32x2*)(op + CK_BT + t_h * CK_ROW + jg * 8) = dn4(bb * enG); \
                *(LAS u32x2*)(op + CK_KT + t_h * CK_ROW + jg * 8) = dn4(kp * enG); \
                *(LAS u32x2*)(op + CK_VT + t_h * CK_ROW + jg * 8) = dn4(v); \
                if (t_h == 0) *(LAS f32x4*)(op + CK_GL + jg * 16) = eGL; \
            } \
            if (it + 3 < NCH) CK_LOAD(G_, it + 3); \
        } while (0)
    if (wid >= 4) { CK_LOAD(g, 0); CK_LOAD(g1, 1); CK_LOAD(g2, 2); }
#ifdef CK_TIME
    unsigned long long tb_ = 0, t0_ = 0; const unsigned long long tstart_ = __builtin_readcyclecounter();
#define CK_T0() (t0_ = __builtin_readcyclecounter())
#define CK_T1() (tb_ += __builtin_readcyclecounter() - t0_)
#else
#define CK_T0() do {} while (0)
#define CK_T1() do {} while (0)
#endif
    constexpr int NIT = ((NCH + 6 + 2) / 3) * 3;
    if (wid >= 4) {
#define CK_YSTORE(it) do { if (wid == 4 && (it) >= 5 && (it) - 5 < NCH) { \
            const LAS float* yt = (const LAS float*)(lds + CK_YT0 + (((it) - 5) & 1) * CK_YTB); const int t_ = lane >> 2, ip = (lane & 3) * 4; \
            const f32x4 yv = *(const LAS f32x4*)(yt + t_ * 16 + ip); \
            *(u32x2*)(Y + ((size_t)b * SEQ + ((it) - 5) * 16 + t_) * 512 + h * 64 + i0 + ip) = dn4(yv); } } while (0)
        for (int it3 = 0; it3 < NIT; it3 += 3) {
            CK_T0(); CK_OPSTAGE(g, it3); CK_YSTORE(it3); CK_T1(); __syncthreads();
            CK_T0(); CK_OPSTAGE(g1, (it3 + 1)); CK_YSTORE((it3 + 1)); CK_T1(); __syncthreads();
            CK_T0(); CK_OPSTAGE(g2, (it3 + 2)); CK_YSTORE((it3 + 2)); CK_T1(); __syncthreads();
        }
#undef CK_YSTORE
    } else
    for (int it = 0; it < NIT; ++it) {
        CK_T0();
        if (wid >= 1) {
            const int ph3 = (it + 3 - wid) % 3;
            const int c = it - 1 - ph3;
            if (c >= 0 && c < NCH) {
                const LAS unsigned char* op = lds + (c % CK_NOP) * CK_OPB; LAS unsigned char* mt = lds + CK_MT0 + (c % CK_NMT) * CK_MTB;
                if (ph3 == 0) {
                    const int ro = l15 * CK_ROW + q * 16;
                    const bf16x8 at0 = *(const LAS bf16x8*)(op + CK_AT + ro), at1 = *(const LAS bf16x8*)(op + CK_AT + ro + 64), rt0 = *(const LAS bf16x8*)(op + CK_RT + ro), rt1 = *(const LAS bf16x8*)(op + CK_RT + ro + 64);
                    const bf16x8 bt0 = *(const LAS bf16x8*)(op + CK_BT + ro), bt1 = *(const LAS bf16x8*)(op + CK_BT + ro + 64), kt0 = *(const LAS bf16x8*)(op + CK_KT + ro), kt1 = *(const LAS bf16x8*)(op + CK_KT + ro + 64);
                    const f32x4 z = (f32x4){0.f, 0.f, 0.f, 0.f};
                    f32x4 mab = __builtin_amdgcn_mfma_f32_16x16x32_bf16(at0, bt0, z, 0, 0, 0); mab = __builtin_amdgcn_mfma_f32_16x16x32_bf16(at1, bt1, mab, 0, 0, 0);
                    f32x4 mak = __builtin_amdgcn_mfma_f32_16x16x32_bf16(at0, kt0, z, 0, 0, 0); mak = __builtin_amdgcn_mfma_f32_16x16x32_bf16(at1, kt1, mak, 0, 0, 0);
                    f32x4 mrb = __builtin_amdgcn_mfma_f32_16x16x32_bf16(rt0, bt0, z, 0, 0, 0); mrb = __builtin_amdgcn_mfma_f32_16x16x32_bf16(rt1, bt1, mrb, 0, 0, 0);
                    f32x4 mrk = __builtin_amdgcn_mfma_f32_16x16x32_bf16(rt0, kt0, z, 0, 0, 0); mrk = __builtin_amdgcn_mfma_f32_16x16x32_bf16(rt1, kt1, mrk, 0, 0, 0);
#pragma unroll
                    for (int r = 0; r < 4; ++r) { const int t_ = 4 * q + r; const bool lo_ = l15 < t_, le_ = l15 <= t_;
                        *(LAS float*)(mt + CK_MAB + t_ * 80 + l15 * 4) = lo_ ? mab[r] : 0.f;
                        *(LAS bf16_t*)(mt + CK_MAK + t_ * 32 + l15 * 2) = (bf16_t)f2bf(lo_ ? mak[r] : 0.f);
                        *(LAS bf16_t*)(mt + CK_MRB + t_ * 32 + l15 * 2) = (bf16_t)f2bf(le_ ? mrb[r] : 0.f);
                        *(LAS bf16_t*)(mt + CK_MRK + t_ * 32 + l15 * 2) = (bf16_t)f2bf(le_ ? mrk[r] : 0.f); }
                } else {
#define CK_MLD(t_) f32x4 m_##t_[4]; _Pragma("unroll") for (int s4 = 0; s4 < (t_); s4 += 4) m_##t_[s4 >> 2] = *(const LAS f32x4*)(mt + CK_MAB + (t_) * 80 + s4 * 4)
#define CK_TROW(t_) do { float acc_ = (l15 == (t_)) ? 1.f : 0.f; \
                        _Pragma("unroll") for (int s4 = 0; s4 < (t_); s4 += 4) { \
                            _Pragma("unroll") for (int e = 0; e < 4; ++e) if (s4 + e < (t_)) acc_ += m_##t_[s4 >> 2][e] * x[s4 + e]; } \
                        x[t_] = acc_; } while (0)
                    if (ph3 == 1) { CK_MLD(1); CK_MLD(2); CK_MLD(3); CK_MLD(4); CK_MLD(5); CK_MLD(6); CK_MLD(7); CK_MLD(8); CK_MLD(9); CK_MLD(10);
                        x[0] = (l15 == 0) ? 1.f : 0.f; CK_TROW(1); CK_TROW(2); CK_TROW(3); CK_TROW(4); CK_TROW(5); CK_TROW(6); CK_TROW(7); CK_TROW(8); CK_TROW(9); CK_TROW(10); }
                    else { CK_MLD(11); CK_MLD(12); CK_MLD(13); CK_MLD(14); CK_MLD(15); CK_TROW(11); CK_TROW(12); CK_TROW(13); CK_TROW(14); CK_TROW(15);
                        if (q == 0) {
#pragma unroll
                            for (int t_ = 0; t_ < 16; ++t_) *(LAS bf16_t*)(mt + CK_TT + t_ * 32 + l15 * 2) = (bf16_t)f2bf(x[t_]); } }
#undef CK_TROW
#undef CK_MLD
                }
            }
        } else {
            const int c = it - 4;
            if (c >= 0 && c < NCH) {
                const LAS unsigned char* op = lds + (c % CK_NOP) * CK_OPB; const LAS unsigned char* mt = lds + CK_MT0 + (c % CK_NMT) * CK_MTB;
                s16x4v sb[4];
#pragma unroll
                for (int jt = 0; jt < 4; ++jt) { if (CK_NOSTATE) accS[jt] = (f32x4){0.f, 0.f, 0.f, 0.f}; sb[jt] = pk4(accS[jt]); }
                const int ao = l15 * CK_ROW + q * 8;
                const int tro = (4 * q + (l15 >> 2)) * CK_ROW + (l15 & 3) * 8;
                const s16x4v vb = ldtr(op + CK_VT + tro + i0 * 2);
                f32x4 x1 = (f32x4){0.f, 0.f, 0.f, 0.f}, x2 = x1;
#pragma unroll
                for (int jt = 0; jt < 4; ++jt) {
                    const s16x4v a0 = *(const LAS s16x4v*)(op + CK_AT + ao + jt * 32), r0 = *(const LAS s16x4v*)(op + CK_RT + ao + jt * 32);
                    x1 = __builtin_amdgcn_mfma_f32_16x16x16bf16_1k(a0, sb[jt], x1, 0, 0, 0);
                    x2 = __builtin_amdgcn_mfma_f32_16x16x16bf16_1k(r0, sb[jt], x2, 0, 0, 0);
                }
                const s16x4v mak = *(const LAS s16x4v*)(mt + CK_MAK + l15 * 32 + q * 8), mrb = *(const LAS s16x4v*)(mt + CK_MRB + l15 * 32 + q * 8);
                const s16x4v mrk = *(const LAS s16x4v*)(mt + CK_MRK + l15 * 32 + q * 8), tt = *(const LAS s16x4v*)(mt + CK_TT + l15 * 32 + q * 8);
                x1 = __builtin_amdgcn_mfma_f32_16x16x16bf16_1k(mak, vb, x1, 0, 0, 0);
                x2 = __builtin_amdgcn_mfma_f32_16x16x16bf16_1k(mrk, vb, x2, 0, 0, 0);
                const f32x4 u = __builtin_amdgcn_mfma_f32_16x16x16bf16_1k(tt, pk4(x1), (f32x4){0.f, 0.f, 0.f, 0.f}, 0, 0, 0);
                const s16x4v ub = pk4(u);
                const f32x4 yv = __builtin_amdgcn_mfma_f32_16x16x16bf16_1k(mrb, ub, x2, 0, 0, 0);
                const bf16x8 uv = (bf16x8){ub[0], ub[1], ub[2], ub[3], vb[0], vb[1], vb[2], vb[3]};
#pragma unroll
                for (int jt = 0; jt < 4; ++jt) {
                    const f32x4 gl = *(const LAS f32x4*)(op + CK_GL + (16 * jt + 4 * q) * 4);
                    const s16x4v b0 = ldtr(op + CK_BT + tro + jt * 32), k0 = ldtr(op + CK_KT + tro + jt * 32);
                    accS[jt] = __builtin_amdgcn_mfma_f32_16x16x32_bf16((bf16x8){b0[0], b0[1], b0[2], b0[3], k0[0], k0[1], k0[2], k0[3]}, uv, accS[jt], 0, 0, 0) * gl;
                }
                LAS float* yt = (LAS float*)(lds + CK_YT0 + (c & 1) * CK_YTB);
#pragma unroll
                for (int r = 0; r < 4; ++r) yt[(4 * q + r) * 16 + l15] = yv[r];
            }
        }
        CK_T1();
        __syncthreads();
    }
#ifdef CK_TIME
    if (blockIdx.x == 0 && l == 0 && lane == 0) { unsigned long long* tw = (unsigned long long*)(a->ws + WS_CTL) + 24000; tw[wid] = tb_; if (wid == 0) tw[8] = __builtin_readcyclecounter() - tstart_; }
#endif
#undef CK_LOAD
#undef CK_OPSTAGE
}

constexpr int WP_SUB = 4 * 2304 + 1280;
constexpr int CW_WPFLAG = 65536;
__device__ __forceinline__ void ST2W(bf16_t* p, unsigned v) { asm volatile("global_store_short %0, %1, off sc1\n\ts_nop 1" :: "v"(p), "v"(v) : "memory"); }
__device__ __forceinline__ void phase_wkvprep(ArgsP a, int l, LAS unsigned char* lds, int first, int stride) {
    a = args_ptr(); first = __builtin_amdgcn_readfirstlane(first); stride = __builtin_amdgcn_readfirstlane(stride); asm volatile("" : "+s"(first), "+s"(stride));
    const int tid = ltid(), lane = tid & 63, wid = __builtin_amdgcn_readfirstlane(tid >> 6), sub = tid >> 8, ht = tid & 255, t_h = ht >> 4, jg = ht & 15, q = lane >> 4, l15 = lane & 15;
    bf16_t* RKV = (bf16_t*)(a->ws + A_RKV); bf16_t* EG = (bf16_t*)(a->ws + A_LW); bf16_t* ICLR = (bf16_t*)(a->ws + A_ICLR); float* SCAL = (float*)(a->ws + WS_SCAL);
    const bf16_t* HALO = (const bf16_t*)((const unsigned char*)a->out + DO_HALO); unsigned char* MTR = (unsigned char*)a->out + DO_MTREC;
    const float* mu = a->in[I_MU] + (size_t)l * 1792;
    u32x2 grA, gkA, gvA, prA, pkA, pvA, gicA, geA, gexA, gelA, grB, gkB, gvB, prB, pkB, pvB, gicB, geB, gexB, gelB;
#define WP_LOAD(S, idxx) do { const int idx_ = (idxx), bh_ = idx_ >> 8, c_ = idx_ & 255, ch_ = (bh_ & 7) * 64 + 4 * jg, t_ = c_ * 16 + t_h; const size_t row_ = (size_t)(bh_ >> 3) * SEQ + t_; const u32x2 z2_ = (u32x2){0u, 0u}; \
        gr##S = *(const u32x2*)(RKV + row_ * 1536 + ch_); gk##S = *(const u32x2*)(RKV + row_ * 1536 + 512 + ch_); gv##S = *(const u32x2*)(RKV + row_ * 1536 + 1024 + ch_); \
        pr##S = z2_; pk##S = z2_; pv##S = z2_; \
        if (t_h) { pr##S = *(const u32x2*)(RKV + (row_ - 1) * 1536 + ch_); pk##S = *(const u32x2*)(RKV + (row_ - 1) * 1536 + 512 + ch_); pv##S = *(const u32x2*)(RKV + (row_ - 1) * 1536 + 1024 + ch_); } \
        else if (t_) { const bf16_t* hp_ = HALO + ((row_ >> 4) - 1) * 1536; pr##S = *(const u32x2*)(hp_ + ch_); pk##S = *(const u32x2*)(hp_ + 512 + ch_); pv##S = *(const u32x2*)(hp_ + 1024 + ch_); } \
        gic##S = *(const u32x2*)(ICLR + row_ * 512 + ch_); ge##S = *(const u32x2*)(EG + row_ * 512 + ch_); gex##S = *(const u32x2*)(EG + (row_ - (t_h ? 1 : 0)) * 512 + ch_); gel##S = *(const u32x2*)(EG + (row_ - t_h + 15) * 512 + ch_); } while (0)
#ifndef WP_SC1
#define WP_SC1 1
#endif
#if WP_SC1
#define WPST(p_, v_) pg8::ST8W((p_), (v_))
#else
#define WPST(p_, v_) (*(u32x2*)(p_) = (v_))
#endif
#define WP_PASS(S, SN, ps) do { \
            const int idx = 8 * tr + 2 * (ps) + sub, bh = idx >> 8, c = idx & 255, b = bh >> 3, h = bh & 7, ch = h * 64 + 4 * jg; \
            const int t = c * 16 + t_h; const size_t row = (size_t)b * SEQ + t; \
            { const int qn_ = qq + stride; const int nidx = ((ps) < 3) ? idx + 2 : (qn_ < 1024 ? 8 * ((qn_ & 31) * 32 + (qn_ >> 5)) + sub : 8192); if (nidx < 8192) WP_LOAD(SN, nidx); }         \
            LAS unsigned char* op = lds + (2 * (ps) + sub) * WP_SUB; \
            const f32x4 mu_r = *(const f32x4*)(mu + ch), mu_k = *(const f32x4*)(mu + 512 + ch), mu_v = *(const f32x4*)(mu + 1024 + ch); \
            const f32x4 kk_c = *(const f32x4*)(a->in[I_KK] + l * 512 + ch), ka_c = *(const f32x4*)(a->in[I_KA] + l * 512 + ch), rk_c = *(const f32x4*)(a->in[I_RK] + l * 512 + ch); \
            const f32x4 r2 = up4(gr##S), k2 = up4(gk##S), v2 = up4(gv##S); \
            const f32x4 r = r2 + (up4(pr##S) - r2) * mu_r, k = k2 + (up4(pk##S) - k2) * mu_k, v = v2 + (up4(pv##S) - v2) * mu_v, ic = up4(gic##S); \
            const f32x4 eG = up4(ge##S), eGL = up4(gel##S); \
            f32x4 eGx = up4(gex##S); if (t_h == 0) eGx = (f32x4){1.f, 1.f, 1.f, 1.f}; \
            f32x4 enG; \
            _Pragma("unroll") for (int e = 0; e < 4; ++e) enG[e] = __builtin_amdgcn_rcpf(eG[e]); \
            f32x4 kk = k * kk_c; const float ssum = rr16(dot4(kk, kk)); \
            kk = kk * rsqrtf(ssum + 1e-12f); \
            const f32x4 kp = k * (1.0f + (ic - 1.0f) * ka_c), bb = kk * ic; \
            const float sc = rr16(dot4(r * kp, rk_c)); \
            const u32x2 oa = dn4(-(kk * eGx)), orr = dn4(r * eG), ob = dn4(bb * enG), ok = dn4(kp * enG), ov = dn4(v); \
            if ((ps) == 1) asm volatile("s_waitcnt vmcnt(12)" ::: "memory");     \
            __syncthreads();                                         \
            if ((ps) == 1 && pend >= 0 && tid == 0) __hip_atomic_store(wpflag + pend, 1u, __ATOMIC_RELAXED, __HIP_MEMORY_SCOPE_AGENT);     \
            *(LAS u32x2*)(op + CK_AT + t_h * CK_ROW + jg * 8) = oa; *(LAS u32x2*)(op + CK_RT + t_h * CK_ROW + jg * 8) = orr; \
            *(LAS u32x2*)(op + CK_BT + t_h * CK_ROW + jg * 8) = ob; *(LAS u32x2*)(op + CK_KT + t_h * CK_ROW + jg * 8) = ok; \
            WPST(RKV + row * 1536 + ch, oa); WPST(RKV + row * 1536 + 512 + ch, orr); WPST(RKV + row * 1536 + 1024 + ch, ov); \
            WPST(EG + row * 512 + ch, ob); WPST(ICLR + row * 512 + ch, ok); \
            if (jg == 0) SCAL[row * 8 + h] = sc; \
            if (t_h == 0) pg8::ST16W((bf16_t*)(MTR + (size_t)idx * MTREC_B + 2048 + jg * 16), __builtin_bit_cast(u32x4, eGL)); \
        } while (0)
    unsigned* wpflag = (unsigned*)(a->ws + WS_CTL) + CW_WPFLAG + l * 1024;
    if (first < 1024) WP_LOAD(A, 8 * ((first & 31) * 32 + (first >> 5)) + sub);
    int pend = -1;
    for (int qq = first; qq < 1024; qq += stride) {
        const int tr = (qq & 31) * 32 + (qq >> 5);
#pragma unroll 1
        for (int ps = 0; ps < 4; ps += 2) { WP_PASS(A, B, ps); WP_PASS(B, A, ps + 1); }
        __syncthreads();
        {
            const int idx = 8 * tr + wid;
            const LAS unsigned char* op = lds + wid * WP_SUB; LAS unsigned char* mt = lds + wid * WP_SUB + 4 * 2304;
            const int ro = l15 * CK_ROW + q * 16;
            const bf16x8 at0 = *(const LAS bf16x8*)(op + CK_AT + ro), at1 = *(const LAS bf16x8*)(op + CK_AT + ro + 64), rt0 = *(const LAS bf16x8*)(op + CK_RT + ro), rt1 = *(const LAS bf16x8*)(op + CK_RT + ro + 64);
            const bf16x8 bt0 = *(const LAS bf16x8*)(op + CK_BT + ro), bt1 = *(const LAS bf16x8*)(op + CK_BT + ro + 64), kt0 = *(const LAS bf16x8*)(op + CK_KT + ro), kt1 = *(const LAS bf16x8*)(op + CK_KT + ro + 64);
            const f32x4 z = (f32x4){0.f, 0.f, 0.f, 0.f};
            f32x4 mab = __builtin_amdgcn_mfma_f32_16x16x32_bf16(at0, bt0, z, 0, 0, 0); mab = __builtin_amdgcn_mfma_f32_16x16x32_bf16(at1, bt1, mab, 0, 0, 0);
            f32x4 mak = __builtin_amdgcn_mfma_f32_16x16x32_bf16(at0, kt0, z, 0, 0, 0); mak = __builtin_amdgcn_mfma_f32_16x16x32_bf16(at1, kt1, mak, 0, 0, 0);
            f32x4 mrb = __builtin_amdgcn_mfma_f32_16x16x32_bf16(rt0, bt0, z, 0, 0, 0); mrb = __builtin_amdgcn_mfma_f32_16x16x32_bf16(rt1, bt1, mrb, 0, 0, 0);
            f32x4 mrk = __builtin_amdgcn_mfma_f32_16x16x32_bf16(rt0, kt0, z, 0, 0, 0); mrk = __builtin_amdgcn_mfma_f32_16x16x32_bf16(rt1, kt1, mrk, 0, 0, 0);
            bf16_t* rec = (bf16_t*)(MTR + (size_t)idx * MTREC_B);
            LAS bf16_t* stg = (LAS bf16_t*)(lds + wid * WP_SUB);
            asm volatile("s_waitcnt lgkmcnt(0)" ::: "memory");
#pragma unroll
            for (int rr = 0; rr < 4; ++rr) { const int t_ = 4 * q + rr; const bool lo_ = l15 < t_, le_ = l15 <= t_;
                *(LAS float*)(mt + t_ * 80 + l15 * 4) = lo_ ? mab[rr] : 0.f;
                stg[t_ * 16 + l15] = (bf16_t)f2bf(lo_ ? mak[rr] : 0.f);
                stg[256 + t_ * 16 + l15] = (bf16_t)f2bf(le_ ? mrb[rr] : 0.f);
                stg[512 + t_ * 16 + l15] = (bf16_t)f2bf(le_ ? mrk[rr] : 0.f); }
            asm volatile("s_waitcnt lgkmcnt(0)" ::: "memory");
            float x[16];
#define WP_MLD(t_) f32x4 m_##t_[4]; _Pragma("unroll") for (int s4 = 0; s4 < (t_); s4 += 4) m_##t_[s4 >> 2] = *(const LAS f32x4*)(mt + (t_) * 80 + s4 * 4)
#define WP_TROW(t_) do { float acc_ = (l15 == (t_)) ? 1.f : 0.f; \
                _Pragma("unroll") for (int s4 = 0; s4 < (t_); s4 += 4) { _Pragma("unroll") for (int e = 0; e < 4; ++e) if (s4 + e < (t_)) acc_ += m_##t_[s4 >> 2][e] * x[s4 + e]; } \
                x[t_] = acc_; } while (0)
            x[0] = (l15 == 0) ? 1.f : 0.f;
            { WP_MLD(1); WP_MLD(2); WP_MLD(3); WP_MLD(4); WP_MLD(5); WP_MLD(6); WP_MLD(7); WP_TROW(1); WP_TROW(2); WP_TROW(3); WP_TROW(4); WP_TROW(5); WP_TROW(6); WP_TROW(7); }
            { WP_MLD(8); WP_MLD(9); WP_MLD(10); WP_MLD(11); WP_TROW(8); WP_TROW(9); WP_TROW(10); WP_TROW(11); }
            { WP_MLD(12); WP_MLD(13); WP_MLD(14); WP_MLD(15); WP_TROW(12); WP_TROW(13); WP_TROW(14); WP_TROW(15); }
#undef WP_TROW
#undef WP_MLD
            if (q == 0) {
#pragma unroll
                for (int t_ = 0; t_ < 16; ++t_) stg[768 + t_ * 16 + l15] = (bf16_t)f2bf(x[t_]); }
            asm volatile("s_waitcnt lgkmcnt(0)" ::: "memory");
            pg8::ST16W(rec + lane * 8, *(const LAS u32x4*)((const LAS unsigned char*)stg + lane * 16));
            pg8::ST16W(rec + 512 + lane * 8, *(const LAS u32x4*)((const LAS unsigned char*)stg + 1024 + lane * 16));
        }
        __syncthreads();
        pend = tr;
    }
    asm volatile("s_waitcnt vmcnt(0)" ::: "memory");
    __syncthreads();
    if (pend >= 0 && tid == 0) __hip_atomic_store(wpflag + pend, 1u, __ATOMIC_RELAXED, __HIP_MEMORY_SCOPE_AGENT);
#undef WP_LOAD
#undef WP_PASS
}

constexpr int WS_SLOT = 5 * 2048 + 3 * 1024, WS_NSLOT = 8, WS_DEPTH = 7, WS_YT = WS_NSLOT * WS_SLOT;
__device__ __forceinline__ void glds16(const void* gsrc, unsigned lds_dst) { unsigned keep;
    asm volatile("s_mov_b32 %0, m0\n\ts_mov_b32 m0, %2\n\ts_nop 0\n\tglobal_load_lds_dwordx4 %1, off\n\ts_mov_b32 m0, %0" : "=&s"(keep) : "v"(gsrc), "s"(lds_dst) : "memory"); }
__device__ __forceinline__ void scan_unit_stream(ArgsP a, int l, int bh, LAS unsigned char* lds) {
    a = args_ptr();
    const int tid = ltid(), lane = tid & 63, wid = __builtin_amdgcn_readfirstlane(tid >> 6), q = lane >> 4, l15 = lane & 15;
    const int b = bh >> 3, h = bh & 7;
    const unsigned char* RKVb = a->ws + A_RKV; const unsigned char* EGb = a->ws + A_LW; const unsigned char* ICb = a->ws + A_ICLR;
    const unsigned char* MTR = (const unsigned char*)a->out + DO_MTREC + (size_t)bh * 256 * MTREC_B;
    bf16_t* Y = (bf16_t*)(a->ws + A_Y);
    constexpr int NCH = SEQ / 16;
    const unsigned lds0 = (unsigned)(uintptr_t)lds;
    if (wid >= 4) {
        const int w = wid - 4, rw = lane >> 3, c16 = ((lane & 7) ^ rw) * 16;
        const int np = (w == 0) ? 4 : 3;
#define WS_ISSUE(cc) do { const size_t row0_ = (size_t)b * SEQ + (size_t)(cc) * 16; const unsigned slot_ = lds0 + (unsigned)(((cc) % WS_NSLOT) * WS_SLOT); \
            _Pragma("unroll") for (int k_ = 0; k_ < 4; ++k_) { const int p_ = w + 4 * k_; if (p_ < 13) { const void* src_; \
                if (p_ < 10) { const int tl_ = p_ >> 1; const size_t r_ = row0_ + 8 * (p_ & 1) + rw; \
                    src_ = tl_ < 3 ? (const void*)(RKVb + (r_ * 1536 + tl_ * 512 + h * 64) * 2 + c16) : (tl_ == 3 ? (const void*)(EGb + (r_ * 512 + h * 64) * 2 + c16) : (const void*)(ICb + (r_ * 512 + h * 64) * 2 + c16)); } \
                else src_ = (const void*)(MTR + (size_t)(cc) * MTREC_B + (p_ - 10) * 1024 + lane * 16); \
                glds16(src_, (unsigned)__builtin_amdgcn_readfirstlane(slot_ + (unsigned)(p_ < 10 ? (p_ >> 1) * 2048 + (p_ & 1) * 1024 : 10240 + (p_ - 10) * 1024))); } } } while (0)
        unsigned* wpflag = (unsigned*)(a->ws + WS_CTL) + CW_WPFLAG + l * 1024 + bh * 32;
        unsigned* tmo = (unsigned*)(a->ws + WS_CTL) + CW_BAR + XB_TMO;
#define WS_GATE(cc) do { if (((cc) & 7) == 0) { unsigned sp_ = 0; \
            while ((unsigned)__builtin_amdgcn_readfirstlane(__hip_atomic_load(wpflag + ((cc) >> 3), __ATOMIC_RELAXED, __HIP_MEMORY_SCOPE_AGENT)) == 0u) { __builtin_amdgcn_s_sleep(2); \
                if ((++sp_ & 255u) == 0u) { if (xb_ld(tmo)) break; if (sp_ > XB_SPIN_CAP) { atomicAdd(tmo, 1u); break; } } } \
            __builtin_amdgcn_fence(__ATOMIC_ACQUIRE, "agent"); } } while (0)
        WS_GATE(0);
#pragma unroll
        for (int cc = 0; cc < WS_DEPTH; ++cc) WS_ISSUE(cc);
        if (w == 0) asm volatile("s_waitcnt vmcnt(24)" ::: "memory"); else asm volatile("s_waitcnt vmcnt(18)" ::: "memory");
        __syncthreads();
        for (int it = 0; it < NCH; ++it) {
            if (it + WS_DEPTH < NCH) { WS_GATE(it + WS_DEPTH); WS_ISSUE(it + WS_DEPTH); if (w == 0) asm volatile("s_waitcnt vmcnt(24)" ::: "memory"); else asm volatile("s_waitcnt vmcnt(18)" ::: "memory"); }
            else asm volatile("s_waitcnt vmcnt(0)" ::: "memory");
            __syncthreads();
        }
#undef WS_ISSUE
#undef WS_GATE
        (void)np;
    } else {
        f32x4 accS[4];
#pragma unroll
        for (int jt = 0; jt < 4; ++jt) accS[jt] = (f32x4){0.f, 0.f, 0.f, 0.f};
        __syncthreads();
        for (int it = 0; it < NCH; ++it) {
            const LAS unsigned char* op = lds + (it % WS_NSLOT) * WS_SLOT; const LAS unsigned char* mt = op + 10240;
            s16x4v sb[4];
#pragma unroll
            for (int jt = 0; jt < 4; ++jt) sb[jt] = pk4(accS[jt]);
#define WS_SW(row, p8) ((row) * 128 + ((((p8) >> 1) ^ ((row) & 7)) << 4) + ((p8) & 1) * 8)
            const int trow = 4 * q + (l15 >> 2);
            const s16x4v vb = ldtr(op + 4096 + WS_SW(trow, (l15 & 3) + 4 * wid));
            f32x4 x1 = (f32x4){0.f, 0.f, 0.f, 0.f}, x2 = x1;
#pragma unroll
            for (int jt = 0; jt < 4; ++jt) {
                const s16x4v a0 = *(const LAS s16x4v*)(op + 0 + WS_SW(l15, q + 4 * jt)), r0 = *(const LAS s16x4v*)(op + 2048 + WS_SW(l15, q + 4 * jt));
                x1 = __builtin_amdgcn_mfma_f32_16x16x16bf16_1k(a0, sb[jt], x1, 0, 0, 0);
                x2 = __builtin_amdgcn_mfma_f32_16x16x16bf16_1k(r0, sb[jt], x2, 0, 0, 0);
            }
            const s16x4v mak = *(const LAS s16x4v*)(mt + 0 + l15 * 32 + q * 8), mrb = *(const LAS s16x4v*)(mt + 512 + l15 * 32 + q * 8);
            const s16x4v mrk = *(const LAS s16x4v*)(mt + 1024 + l15 * 32 + q * 8), tt = *(const LAS s16x4v*)(mt + 1536 + l15 * 32 + q * 8);
            x1 = __builtin_amdgcn_mfma_f32_16x16x16bf16_1k(mak, vb, x1, 0, 0, 0);
            x2 = __builtin_amdgcn_mfma_f32_16x16x16bf16_1k(mrk, vb, x2, 0, 0, 0);
            const f32x4 u = __builtin_amdgcn_mfma_f32_16x16x16bf16_1k(tt, pk4(x1), (f32x4){0.f, 0.f, 0.f, 0.f}, 0, 0, 0);
            const s16x4v ub = pk4(u);
            const f32x4 yv = __builtin_amdgcn_mfma_f32_16x16x16bf16_1k(mrb, ub, x2, 0, 0, 0);
            const bf16x8 uv = (bf16x8){ub[0], ub[1], ub[2], ub[3], vb[0], vb[1], vb[2], vb[3]};
#pragma unroll
            for (int jt = 0; jt < 4; ++jt) {
                const f32x4 gl = *(const LAS f32x4*)(mt + 2048 + (16 * jt + 4 * q) * 4);
                const s16x4v b0 = ldtr(op + 6144 + WS_SW(trow, (l15 & 3) + 4 * jt)), k0 = ldtr(op + 8192 + WS_SW(trow, (l15 & 3) + 4 * jt));
                accS[jt] = __builtin_amdgcn_mfma_f32_16x16x32_bf16((bf16x8){b0[0], b0[1], b0[2], b0[3], k0[0], k0[1], k0[2], k0[3]}, uv, accS[jt], 0, 0, 0) * gl;
            }
            LAS float* yt = (LAS float*)(lds + WS_YT + wid * 1024);
#pragma unroll
            for (int rr = 0; rr < 4; ++rr) yt[(4 * q + rr) * 16 + l15] = yv[rr];
            asm volatile("s_waitcnt lgkmcnt(0)" ::: "memory");
            { const int t_ = lane >> 2, ip = (lane & 3) * 4; const f32x4 yr = *(const LAS f32x4*)(yt + t_ * 16 + ip);
              *(u32x2*)(Y + ((size_t)b * SEQ + it * 16 + t_) * 512 + h * 64 + 16 * wid + ip) = dn4(yr); }
            __syncthreads();
        }
#undef WS_SW
    }
}

__device__ __forceinline__ int crow(int r, int hi) { return (r & 3) + 8 * (r >> 2) + 4 * hi; }
constexpr int AT_KROW = 208, AT_VROW = 136, AT_KBUF = 64 * AT_KROW, AT_VBUF = 64 * AT_VROW, AT_V0 = 2 * AT_KBUF;
__device__ __forceinline__ void attn_unit(ArgsP a, int bh, int qb, LAS unsigned char* lds, size_t o_off = A_QN) {
    a = args_ptr();
    const int tid = ltid(), lane = tid & 63, wid = tid >> 6, r32 = lane & 31, hi = lane >> 5;
    const int b = bh >> 3, h = bh & 7, q0 = qb * 256, qw0 = q0 + wid * 32;
    const size_t rowb = (size_t)b * SEQ;
    const bf16_t* Qn = (const bf16_t*)(a->ws + A_QN); const bf16_t* Qp = (const bf16_t*)(a->ws + A_QP); const bf16_t* Kn = (const bf16_t*)(a->ws + A_KN);
    const bf16_t* KPE = (const bf16_t*)(a->ws + A_KPE); const bf16_t* Vt = (const bf16_t*)(a->ws + A_VT); bf16_t* O = (bf16_t*)(a->ws + o_off);
    bf16x8 qf[6];
    { const size_t qrow = rowb + qw0 + r32;
#pragma unroll
      for (int ds = 0; ds < 4; ++ds) qf[ds] = *(const bf16x8*)(Qn + qrow * 512 + h * 64 + ds * 16 + hi * 8);
#pragma unroll
      for (int ds = 0; ds < 2; ++ds) qf[4 + ds] = *(const bf16x8*)(Qp + qrow * 256 + h * 32 + ds * 16 + hi * 8); }
    const int NT = 4 * qb + 4;
    const bf16_t* ksrc = Kn + (rowb + (tid >> 3)) * 512 + h * 64 + (tid & 7) * 8;
    const bf16_t* psrc = KPE + (rowb + ((tid & 255) >> 2)) * 32 + (tid & 3) * 8;
    const bf16_t* vsrc = Vt + ((size_t)(bh * 64 + (tid >> 3)) << 12) + (tid & 7) * 8;
    const int kdst = (tid >> 3) * AT_KROW + (tid & 7) * 16, pdst = ((tid & 255) >> 2) * AT_KROW + 128 + (tid & 3) * 16, vdst = AT_V0 + (tid >> 3) * AT_VROW + (tid & 7) * 16;
    u32x4 rk0, rp0 = (u32x4){0u, 0u, 0u, 0u}, rv0, rk1, rp1 = rp0, rv1;
#define AT_LOAD(S, tt) do { rk##S = *(const u32x4*)(ksrc + (size_t)(tt) * 64 * 512); if (tid < 256) rp##S = *(const u32x4*)(psrc + (size_t)(tt) * 64 * 32); rv##S = *(const u32x4*)(vsrc + (tt) * 64); } while (0)
#define AT_WRITE(S, p) do { *(LAS u32x4*)(lds + (p) * AT_KBUF + kdst) = rk##S; if (tid < 256) *(LAS u32x4*)(lds + (p) * AT_KBUF + pdst) = rp##S; \
        *(LAS u32x2*)(lds + (p) * AT_VBUF + vdst) = (u32x2){rv##S.x, rv##S.y}; *(LAS u32x2*)(lds + (p) * AT_VBUF + vdst + 8) = (u32x2){rv##S.z, rv##S.w}; } while (0)
    AT_LOAD(0, 0); AT_WRITE(0, 0); AT_LOAD(0, 1);
    __syncthreads();
    float mrun = -INFINITY, lrun = 0.f;
    f32x16 o0, o1;
#pragma unroll
    for (int r = 0; r < 16; ++r) { o0[r] = 0.f; o1[r] = 0.f; }
    for (int t2 = 0; t2 < NT; t2 += 2)
#pragma unroll
    for (int tp = 0; tp < 2; ++tp) {
        const int t = t2 + tp, cur = tp;
        if (t + 2 < NT) { if (tp == 0) AT_LOAD(1, t + 2); else AT_LOAD(0, t + 2); }
        if (64 * t <= qw0 + 31) {
            const LAS unsigned char* Kb = lds + cur * AT_KBUF + r32 * AT_KROW + hi * 16;
            f32x16 p0, p1;
#pragma unroll
            for (int r = 0; r < 16; ++r) { p0[r] = 0.f; p1[r] = 0.f; }
#pragma unroll
            for (int ds = 0; ds < 6; ++ds) {
                const bf16x8 k0 = *(const LAS bf16x8*)(Kb + ds * 32), k1 = *(const LAS bf16x8*)(Kb + 32 * AT_KROW + ds * 32);
                p0 = __builtin_amdgcn_mfma_f32_32x32x16_bf16(k0, qf[ds], p0, 0, 0, 0);
                p1 = __builtin_amdgcn_mfma_f32_32x32x16_bf16(k1, qf[ds], p1, 0, 0, 0);
            }
            if (64 * t + 63 > qw0) {
                const int q = qw0 + r32;
#pragma unroll
                for (int r = 0; r < 16; ++r) { const int kv = 64 * t + crow(r, hi); if (kv > q) p0[r] = -INFINITY; if (kv + 32 > q) p1[r] = -INFINITY; }
            }
            float mx = fmaxf(p0[0], p1[0]);
#pragma unroll
            for (int r = 1; r < 16; ++r) mx = fmaxf(mx, fmaxf(p0[r], p1[r]));
            mx = fmaxf(mx, shx(mx, 32));
            const float mnew = fmaxf(mrun, mx);
            if (__builtin_amdgcn_ballot_w64(mx > mrun) != 0ull) {
                const float alpha = __builtin_amdgcn_exp2f(mrun - mnew);
                lrun *= alpha;
#pragma unroll
                for (int r = 0; r < 16; ++r) { o0[r] *= alpha; o1[r] *= alpha; }
            }
            mrun = mnew;
            float ps = 0.f;
#pragma unroll
            for (int r = 0; r < 16; ++r) { p0[r] = __builtin_amdgcn_exp2f(p0[r] - mnew); p1[r] = __builtin_amdgcn_exp2f(p1[r] - mnew); ps += p0[r] + p1[r]; }
            lrun += ps;
            bf16x8 pf[4];
#pragma unroll
            for (int ks = 0; ks < 4; ++ks) {
                u32x4 w;
                if (ks < 2) { w.x = pk2(p0[8 * ks + 0], p0[8 * ks + 1]); w.y = pk2(p0[8 * ks + 2], p0[8 * ks + 3]); w.z = pk2(p0[8 * ks + 4], p0[8 * ks + 5]); w.w = pk2(p0[8 * ks + 6], p0[8 * ks + 7]); }
                else { const int k2 = ks - 2; w.x = pk2(p1[8 * k2 + 0], p1[8 * k2 + 1]); w.y = pk2(p1[8 * k2 + 2], p1[8 * k2 + 3]); w.z = pk2(p1[8 * k2 + 4], p1[8 * k2 + 5]); w.w = pk2(p1[8 * k2 + 6], p1[8 * k2 + 7]); }
                pf[ks] = __builtin_bit_cast(bf16x8, w);
            }
            const LAS unsigned char* Vb = lds + AT_V0 + cur * AT_VBUF + r32 * AT_VROW + hi * 8;
#pragma unroll
            for (int ks = 0; ks < 4; ++ks) {
                const s16x4 a0 = *(const LAS s16x4*)(Vb + ks * 32), a1 = *(const LAS s16x4*)(Vb + ks * 32 + 16);
                const s16x4 c0 = *(const LAS s16x4*)(Vb + 32 * AT_VROW + ks * 32), c1 = *(const LAS s16x4*)(Vb + 32 * AT_VROW + ks * 32 + 16);
                const bf16x8 vf0 = (bf16x8){a0[0], a0[1], a0[2], a0[3], a1[0], a1[1], a1[2], a1[3]}, vf1 = (bf16x8){c0[0], c0[1], c0[2], c0[3], c1[0], c1[1], c1[2], c1[3]};
                o0 = __builtin_amdgcn_mfma_f32_32x32x16_bf16(vf0, pf[ks], o0, 0, 0, 0);
                o1 = __builtin_amdgcn_mfma_f32_32x32x16_bf16(vf1, pf[ks], o1, 0, 0, 0);
            }
        }
        if (t + 1 < NT) { if (tp == 0) AT_WRITE(0, 1); else AT_WRITE(1, 0); }
        __syncthreads();
    }
#undef AT_WRITE
#undef AT_LOAD
    const float ltot = lrun + shx(lrun, 32), inv = 1.0f / ltot;
    bf16_t* orow = O + (rowb + qw0 + r32) * 512 + h * 64 + 4 * hi;
#pragma unroll
    for (int g = 0; g < 4; ++g) {
        *(u32x2*)(orow + 8 * g) = (u32x2){pk2(o0[4 * g] * inv, o0[4 * g + 1] * inv), pk2(o0[4 * g + 2] * inv, o0[4 * g + 3] * inv)};
        *(u32x2*)(orow + 32 + 8 * g) = (u32x2){pk2(o1[4 * g] * inv, o1[4 * g + 1] * inv), pk2(o1[4 * g + 2] * inv, o1[4 * g + 3] * inv)};
    }
}


__device__ __forceinline__ void attn_unit_naive(ArgsP a, int bh, int qb, LAS unsigned char* lds) {
    a = args_ptr();
    const int tid = vtid(), lane = tid & 63, wid = tid >> 6;
    const int b = bh >> 3, h = bh & 7; const size_t rowb = (size_t)b * SEQ;
    const bf16_t* Qn = (const bf16_t*)(a->ws + A_QN); const bf16_t* Qp = (const bf16_t*)(a->ws + A_QP); const bf16_t* Kn = (const bf16_t*)(a->ws + A_KN);
    const bf16_t* KPE = (const bf16_t*)(a->ws + A_KPE); const bf16_t* Vt = (const bf16_t*)(a->ws + A_VT); bf16_t* O = (bf16_t*)(a->ws + A_QN);
    LAS float* sc = (LAS float*)(lds + wid * 16384);
    for (int i = 0; i < 32; ++i) {
        const int q = qb * 256 + wid * 32 + i; const size_t qrow = rowb + q;
        float mx = -INFINITY;
        for (int k0 = 0; k0 <= q; k0 += 64) {
            const int key = k0 + lane; float sv = -INFINITY;
            if (key <= q) { sv = 0.f;
                for (int d = 0; d < 64; ++d) sv += bf2f(Qn[qrow * 512 + h * 64 + d]) * bf2f(Kn[(rowb + key) * 512 + h * 64 + d]);
                for (int d = 0; d < 32; ++d) sv += bf2f(Qp[qrow * 256 + h * 32 + d]) * bf2f(KPE[(rowb + key) * 32 + d]); }
            sc[key] = sv; mx = fmaxf(mx, sv);
        }
        for (int o = 1; o < 64; o <<= 1) mx = fmaxf(mx, shx(mx, o));
        float sum = 0.f;
        for (int k0 = 0; k0 <= q; k0 += 64) { const int key = k0 + lane; const float p = key <= q ? exp2f(sc[key] - mx) : 0.f; sc[key] = p; sum += p; }
        for (int o = 1; o < 64; o <<= 1) sum += shx(sum, o);
        asm volatile("s_waitcnt lgkmcnt(0)" ::: "memory");
        float acc = 0.f;
        const bf16_t* vp = Vt + ((size_t)(bh * 64 + lane) << 12);
        for (int key = 0; key <= q; ++key) acc += sc[key] * bf2f(vp[key]);
        asm volatile("s_waitcnt lgkmcnt(0)" ::: "memory");
        O[qrow * 512 + h * 64 + lane] = (bf16_t)f2bf(acc / sum);
    }
}
#if NAIVE_ATTN
#define ATTN_UNIT attn_unit_naive
#else
#define ATTN_UNIT attn_unit
#endif
__device__ __forceinline__ void phase_ya(ArgsP a, int l) {
    a = args_ptr();
    const unsigned gt = blockIdx.x * NTHREADS + ltid(), NGT = gridDim.x * NTHREADS;
    const bf16_t* Y = (const bf16_t*)(a->ws + A_Y); const bf16_t* RKV = (const bf16_t*)(a->ws + A_RKV); const bf16_t* GATE = (const bf16_t*)(a->ws + A_GATE);
    const float* SCAL = (const float*)(a->ws + WS_SCAL); bf16_t* YA = (bf16_t*)(a->ws + A_YA);
    const int c = (gt & 63) * 8, h = c >> 6;
    const float* muv = a->in[I_MU] + (size_t)l * 1792 + 1024 + c; const float* lw = a->in[I_LNXW] + l * 512 + c; const float* lb = a->in[I_LNXB] + l * 512 + c;
    const f32x4 m0 = *(const f32x4*)muv, m1 = *(const f32x4*)(muv + 4), w0 = *(const f32x4*)lw, w1 = *(const f32x4*)(lw + 4), b0 = *(const f32x4*)lb, b1 = *(const f32x4*)(lb + 4);
    for (unsigned i = gt; i < (unsigned)M * 64; i += 2 * NGT) {
        u32x4 yu[2], v2u[2], v1u[2], gu[2]; float sc[2]; unsigned rowv[2];
#pragma unroll
        for (int k = 0; k < 2; ++k) { const unsigned row = (i + k * NGT) >> 6; const int t = row & 4095; rowv[k] = row;
            yu[k] = *(const u32x4*)(Y + (size_t)row * 512 + c); v2u[k] = *(const u32x4*)(RKV + (size_t)row * 1536 + 1024 + c);
            v1u[k] = WKV_STREAM ? v2u[k] : (t ? *(const u32x4*)(RKV + (size_t)(row - 1) * 1536 + 1024 + c) : (u32x4){0u, 0u, 0u, 0u});
            gu[k] = *(const u32x4*)(GATE + (size_t)row * 512 + c); sc[k] = SCAL[(size_t)row * 8 + h]; }
#pragma unroll
        for (int k = 0; k < 2; ++k) {
            const f32x4 ya0 = up4((u32x2){yu[k].x, yu[k].y}), ya1 = up4((u32x2){yu[k].z, yu[k].w});
            float sm = ((ya0.x + ya0.y) + (ya0.z + ya0.w)) + ((ya1.x + ya1.y) + (ya1.z + ya1.w));
            sm += shx(sm, 1); sm += shx(sm, 2); sm += shx(sm, 4);
            const float mean = sm * (1.0f / 64.0f);
            const f32x4 d0 = ya0 - mean, d1 = ya1 - mean;
            float qv = dot4(d0, d0) + dot4(d1, d1);
            qv += shx(qv, 1); qv += shx(qv, 2); qv += shx(qv, 4);
            const float rstd = rsqrtf(qv * (1.0f / 64.0f) + LNX_EPS);
            const f32x4 v20 = up4((u32x2){v2u[k].x, v2u[k].y}), v21 = up4((u32x2){v2u[k].z, v2u[k].w}), v10 = up4((u32x2){v1u[k].x, v1u[k].y}), v11 = up4((u32x2){v1u[k].z, v1u[k].w});
            const f32x4 vv0 = v20 + (v10 - v20) * m0, vv1 = v21 + (v11 - v21) * m1;
            const f32x4 g0 = up4((u32x2){gu[k].x, gu[k].y}), g1 = up4((u32x2){gu[k].z, gu[k].w});
            const f32x4 o0 = (d0 * rstd * w0 + b0 + vv0 * sc[k]) * g0, o1 = (d1 * rstd * w1 + b1 + vv1 * sc[k]) * g1;
            const u32x2 p0 = dn4(o0), p1 = dn4(o1);
            *(u32x4*)(YA + (size_t)rowv[k] * 512 + c) = (u32x4){p0.x, p0.y, p1.x, p1.y};
        }
    }
}


__device__ __forceinline__ void phase_gconv(ArgsP a, int l) {
    a = args_ptr();
    const unsigned gt = blockIdx.x * NTHREADS + ltid();
    constexpr unsigned NCHK = FF / 8, NSEG = 372, SEGR = (M + NSEG - 1) / NSEG;
    if (gt >= NCHK * NSEG) return;
    const unsigned chk = gt % NCHK, seg = gt / NCHK; const int c = chk * 8;
    const bf16_t* UG = (const bf16_t*)(a->ws + A_UG); bf16_t* GC = (bf16_t*)(a->ws + A_ACT);
    const float* cw = a->in[I_CONVW] + (size_t)l * 3 * FF + c; const float* cb = a->in[I_CONVB] + (size_t)l * FF + c;
    const f32x4 w0a = *(const f32x4*)cw, w0b = *(const f32x4*)(cw + 4), w1a = *(const f32x4*)(cw + FF), w1b = *(const f32x4*)(cw + FF + 4), w2a = *(const f32x4*)(cw + 2 * FF), w2b = *(const f32x4*)(cw + 2 * FF + 4);
    const f32x4 ba = *(const f32x4*)cb, bb = *(const f32x4*)(cb + 4);
    const unsigned r0 = seg * SEGR, r1 = (r0 + SEGR < (unsigned)M) ? r0 + SEGR : (unsigned)M;
    const u32x4 z = (u32x4){0u, 0u, 0u, 0u};
    u32x4 p1 = ((r0 & 4095u) >= 1u) ? *(const u32x4*)(UG + (size_t)(r0 - 1) * FF + c) : z, p2 = ((r0 & 4095u) >= 2u) ? *(const u32x4*)(UG + (size_t)(r0 - 2) * FF + c) : z;
    u32x4 nx = *(const u32x4*)(UG + (size_t)r0 * FF + c);
    for (unsigned r = r0; r < r1; ++r) {
        const u32x4 cur = nx;
        if (r + 1 < r1) nx = *(const u32x4*)(UG + (size_t)(r + 1) * FF + c);
        if ((r & 4095u) == 0u) { p1 = z; p2 = z; }
        const f32x4 x2a = up4((u32x2){cur.x, cur.y}), x2b = up4((u32x2){cur.z, cur.w}), x1a = up4((u32x2){p1.x, p1.y}), x1b = up4((u32x2){p1.z, p1.w}), x0a = up4((u32x2){p2.x, p2.y}), x0b = up4((u32x2){p2.z, p2.w});
        const f32x4 ca = ba + w0a * x0a + w1a * x1a + w2a * x2a, cc = bb + w0b * x0b + w1b * x1b + w2b * x2b;
        const pg8::f32x2 g0 = pg8::gelu_pk2((pg8::f32x2){ca.x, ca.y}), g1 = pg8::gelu_pk2((pg8::f32x2){ca.z, ca.w}), g2 = pg8::gelu_pk2((pg8::f32x2){cc.x, cc.y}), g3 = pg8::gelu_pk2((pg8::f32x2){cc.z, cc.w});
        *(u32x4*)(GC + (size_t)r * FF + c) = (u32x4){pk2(g0.x, g0.y), pk2(g1.x, g1.y), pk2(g2.x, g2.y), pk2(g3.x, g3.y)};
        p2 = p1; p1 = cur;
    }
}
__device__ __forceinline__ void ffn_halo_fix(ArgsP a, int l, int pm) {
    a = args_ptr();
    const int tid = ltid();
    const bf16_t* RAWH = (const bf16_t*)(a->ws + A_UG); bf16_t* ACT = (bf16_t*)(a->ws + A_ACT);
    const float* cw = a->in[I_CONVW] + (size_t)l * 3 * FF; const float* cb = a->in[I_CONVB] + (size_t)l * FF;
    for (int i = tid; i < 8 * (FF / 8); i += NTHREADS) {
        const int hr = i / (FF / 8), c = (i % (FF / 8)) * 8, blk = pm * 4 + (hr >> 1), fr = hr & 1, row = blk * 64 + fr;
        const bool first = (row & 4095) < 2; const bf16_t* hb = RAWH + (size_t)blk * 6 * FF + c; const u32x4 z = (u32x4){0u, 0u, 0u, 0u};
        const u32x4 cur = *(const u32x4*)(hb + (2 + fr) * FF), val = *(const u32x4*)(hb + (4 + fr) * FF);
        const u32x4 p1 = (fr == 0) ? (first ? z : *(const u32x4*)(hb - 5 * FF)) : *(const u32x4*)(hb + 2 * FF);
        const u32x4 p2 = first ? z : *(const u32x4*)(hb - (fr == 0 ? 6 : 5) * FF);
        const f32x4 w0a = *(const f32x4*)(cw + c), w0b = *(const f32x4*)(cw + c + 4), w1a = *(const f32x4*)(cw + FF + c), w1b = *(const f32x4*)(cw + FF + c + 4);
        const f32x4 w2a = *(const f32x4*)(cw + 2 * FF + c), w2b = *(const f32x4*)(cw + 2 * FF + c + 4), ba = *(const f32x4*)(cb + c), bb = *(const f32x4*)(cb + c + 4);
        const f32x4 ga = pg8::gelu4(ba + w0a * up4((u32x2){p2.x, p2.y}) + w1a * up4((u32x2){p1.x, p1.y}) + w2a * up4((u32x2){cur.x, cur.y}));
        const f32x4 gb = pg8::gelu4(bb + w0b * up4((u32x2){p2.z, p2.w}) + w1b * up4((u32x2){p1.z, p1.w}) + w2b * up4((u32x2){cur.z, cur.w}));
        *(u32x4*)(ACT + (size_t)row * FF + c) = pg8::pack8(ga * up4((u32x2){val.x, val.y}), gb * up4((u32x2){val.z, val.w}));
    }
    asm volatile("s_waitcnt vmcnt(0)" ::: "memory");
    __syncthreads();
}
__device__ __forceinline__ void phase_final(ArgsP a) {
    a = args_ptr();
    const int tid = ltid(), lane = tid & 63, gw = blockIdx.x * NWAVES + (tid >> 6), NGW = gridDim.x * NWAVES;
    const float* SS4 = (const float*)(a->ws + WS_SSP) + (size_t)4 * M * 16; const f32x4* g = (const f32x4*)a->in[I_FINAL] + lane; const bf16_t* HB = (const bf16_t*)(a->ws + A_HB);
    for (int m = gw; m < M; m += NGW) {
        const float rs = rsqrtf(pg8::sum16(SS4 + (size_t)m * 16) * (1.0f / 1024.0f) + NORM_EPS);
        f32x4* o = (f32x4*)(a->out + (size_t)m * DM) + lane; const u32x2* hb = (const u32x2*)(HB + (size_t)m * DM) + lane;
#pragma unroll
        for (int j = 0; j < 4; ++j) o[64 * j] = up4(hb[64 * j]) * rs * g[64 * j];
    }
}


#ifndef DUMP_MIB
#define DUMP_MIB 0
#endif
#ifndef DUMP_OFF_MIB
#define DUMP_OFF_MIB 0
#endif
__device__ __forceinline__ void phase_dump(ArgsP a) {
    a = args_ptr();
    const size_t n16 = (size_t)DUMP_MIB * 1024 * 512, nout = (size_t)M * DM;
    const unsigned short* src = (const unsigned short*)(a->ws + (size_t)DUMP_OFF_MIB * 1024 * 1024);
    for (size_t i = (size_t)blockIdx.x * NTHREADS + vtid(); i < nout; i += (size_t)gridDim.x * NTHREADS) {
        float sacc = 0.f; for (size_t j = i; j < n16; j += nout) sacc += (float)src[j] * (1.0f / 65536.0f);
        a->out[i] = sacc; }
}

#ifndef CHK_ONLY
#define CHK_ONLY 0
#endif
#ifdef CHKSUM_PROBE
__device__ __forceinline__ void phase_chk_sum(ArgsP a) {
    a = args_ptr(); unsigned* ctl = (unsigned*)(a->ws + WS_CTL) + 32768;
    const size_t offs[4] = {A_Y, A_QN, WS_SCAL, A_YA}; const unsigned n16[4] = {(unsigned)M * 512u, (unsigned)M * 512u, (unsigned)M * 16u, 0u};
    for (int k = 0; k < 3; ++k) { const unsigned short* p = (const unsigned short*)(a->ws + offs[k]); unsigned acc = 0;
        for (unsigned i = blockIdx.x * NTHREADS + vtid(); i < n16[k]; i += gridDim.x * NTHREADS) acc += p[i];
        for (int o = 1; o < 64; o <<= 1) acc += shx(acc, o);
        if ((vtid() & 63) == 0) atomicAdd(ctl + 64 * k, acc); }
}
__device__ __forceinline__ void phase_chk_out(ArgsP a) {
    a = args_ptr(); const unsigned* ctl = (const unsigned*)(a->ws + WS_CTL) + 32768;
    for (unsigned i = blockIdx.x * NTHREADS + vtid(); i < (unsigned)(M * DM); i += gridDim.x * NTHREADS) {
        float v = 0.f; if (i == CHK_ONLY) v = (float)(__hip_atomic_load(ctl + 64 * i, __ATOMIC_RELAXED, __HIP_MEMORY_SCOPE_AGENT) % CHKSUM_PROBE) * 100.0f; a->out[i] = v; }
}
#endif

#ifdef CMPY_PROBE
__device__ __forceinline__ void phase_cmp_y(ArgsP a) {
    a = args_ptr(); unsigned long long* ctl = (unsigned long long*)(a->ws + WS_CTL) + 20000;
    const unsigned short* y1 = (const unsigned short*)(a->ws + A_Y); const unsigned short* y2 = (const unsigned short*)(a->ws + A_GATE);
    float sd = 0.f, sy = 0.f;
    for (unsigned i = blockIdx.x * NTHREADS + vtid(); i < (unsigned)M * 512u; i += gridDim.x * NTHREADS) { const float p = bf2f(y1[i]), r = bf2f(y2[i]); sd += (p - r) * (p - r); sy += r * r; }
    atomicAdd(ctl, (unsigned long long)(sd * 1024.0f)); atomicAdd(ctl + 8, (unsigned long long)(sy * 1024.0f));
}
__device__ __forceinline__ void phase_cmp_out(ArgsP a) {
    a = args_ptr(); const unsigned long long* ctl = (const unsigned long long*)(a->ws + WS_CTL) + 20000;
    const float rel = sqrtf((float)__hip_atomic_load(ctl, __ATOMIC_RELAXED, __HIP_MEMORY_SCOPE_AGENT) / (float)__hip_atomic_load(ctl + 8, __ATOMIC_RELAXED, __HIP_MEMORY_SCOPE_AGENT));
    for (unsigned i = blockIdx.x * NTHREADS + vtid(); i < (unsigned)(M * DM); i += gridDim.x * NTHREADS) a->out[i] = (i == 0) ? floorf(rel * 10000.0f) : 0.f;
}
#endif

#ifdef CK_TIME
__device__ __forceinline__ void phase_time_out(ArgsP a) {
    a = args_ptr(); const unsigned long long* tw = (const unsigned long long*)(a->ws + WS_CTL) + 24000;
#ifdef CK_TIME_TOTAL
    const float frac = (float)__hip_atomic_load(tw + 8, __ATOMIC_RELAXED, __HIP_MEMORY_SCOPE_AGENT) * (1.0f / 100000.0f);
    for (unsigned i = blockIdx.x * NTHREADS + vtid(); i < (unsigned)(M * DM); i += gridDim.x * NTHREADS) a->out[i] = (i == 0) ? floorf(frac) * 100.0f : 0.f;
#else
    const float frac = (float)__hip_atomic_load(tw + CK_TIME, __ATOMIC_RELAXED, __HIP_MEMORY_SCOPE_AGENT) / (float)__hip_atomic_load(tw + 8, __ATOMIC_RELAXED, __HIP_MEMORY_SCOPE_AGENT);
    for (unsigned i = blockIdx.x * NTHREADS + vtid(); i < (unsigned)(M * DM); i += gridDim.x * NTHREADS) a->out[i] = (i == 0) ? floorf(frac * 8.0f + 0.5f) * 1000.0f : 0.f;
#endif
}
#endif

#ifdef PH_TIME
__device__ __forceinline__ void phase_phtime_out(ArgsP a) {
    a = args_ptr(); const unsigned long long* tw = (const unsigned long long*)(a->ws + WS_CTL) + 26000;
    const float us = (float)(__hip_atomic_load(tw + PH_TIME + 1, __ATOMIC_RELAXED, __HIP_MEMORY_SCOPE_AGENT) - __hip_atomic_load(tw + PH_TIME, __ATOMIC_RELAXED, __HIP_MEMORY_SCOPE_AGENT)) * 0.01f;
    for (unsigned i = blockIdx.x * NTHREADS + vtid(); i < (unsigned)(M * DM); i += gridDim.x * NTHREADS) a->out[i] = (i == 0) ? floorf(us / (float)PH_Q + 0.5f) * 100.0f : 0.f;
}
#endif
#ifdef SPLIT_SCAN_ATTN
constexpr int PH_EXTRA = 1;
#else
constexpr int PH_EXTRA = 0;
#endif
constexpr int PH_PER_LAYER = 10 + PH_EXTRA, N_PHASES = 2 * PH_PER_LAYER + 1;
__global__ void __launch_bounds__(NTHREADS, 2) mk_fwd(Args a_unused) {
    LAS unsigned char* lds = (LAS unsigned char*)lds_raw;
    { const unsigned t0_ = threadIdx.x; if ((t0_ & 63u) == 0u) *(volatile LAS unsigned*)(lds + WTAB_OFF + hw_wave_key() * 4u) = t0_ >> 6; }
    __syncthreads();
#if !MK_MULTI
    if (args_ptr()->ph_lo > 1000000) cg::this_grid().sync();
    volatile LAS unsigned* MISC = (volatile LAS unsigned*)(lds + MISC_OFF);
    if (vtid() < 32) MISC[vtid()] = 0u;
    __syncthreads();
    (void)xcd_barrier_post((unsigned*)(args_ptr()->ws + WS_CTL) + CW_BAR, MISC + 8);
#endif
    int ph = 0;
#ifdef PH_TIME
    if (blockIdx.x == 0 && vtid() == 0) ((unsigned long long*)(args_ptr()->ws + WS_CTL) + 26000)[0] = __builtin_amdgcn_s_memrealtime();
#endif
#define lo (args_ptr()->ph_lo)
#define hi (args_ptr()->ph_hi)
#if MK_MULTI
#define SEAM() do {} while (0)
#define SEAM1() do {} while (0)
#else
#define SEAM1() do { XcdBarrier b_; b_.bar = (unsigned*)(args_ptr()->ws + WS_CTL) + CW_BAR; b_.x = xb_xcc_id(); b_.st = (volatile LAS unsigned*)(lds + MISC_OFF) + 8; xcd_barrier(b_); } while (0)
#define SEAM() do { if (ph + 1 < hi) { XcdBarrier b_; b_.bar = (unsigned*)(args_ptr()->ws + WS_CTL) + CW_BAR; b_.x = xb_xcc_id(); b_.st = (volatile LAS unsigned*)(lds + MISC_OFF) + 8; xcd_barrier(b_); } } while (0)
#endif
#ifndef PH3SUB
#define PH3SUB 7
#endif
#ifndef PHMASK
#define PHMASK 0xFFFF
#endif
#ifndef SCAN_CHUNKED
#define SCAN_CHUNKED 1
#endif
#ifndef SCAN_REPS
#define SCAN_REPS 1
#endif
#ifndef REPEAT_PHASE
#define REPEAT_PHASE (-1)
#endif
#ifndef REPEAT_LAYER
#define REPEAT_LAYER (-1)
#endif
#ifdef PH_TIME
#define PH_STAMP() do { if (blockIdx.x == 0 && vtid() == 0) ((unsigned long long*)(args_ptr()->ws + WS_CTL) + 26000)[ph + 1] = __builtin_amdgcn_s_memrealtime(); } while (0)
#elif defined(PH_SPIN)
#ifdef PH_SUB
#define PH_SUBSEL() do { const unsigned long long* ts_ = st_ + 100; d_ = PH_SUB == 1 ? ts_[1] - ts_[0] : (PH_SUB == 2 ? ts_[2] - ts_[1] : (PH_SUB == 3 ? t1_ - ts_[2] : (PH_SUB == 4 ? __hip_atomic_load((unsigned long long*)ts_ + 4, __ATOMIC_RELAXED, __HIP_MEMORY_SCOPE_AGENT) - ts_[0] : ts_[0] - st_[ph]))); } while (0)
#else
#define PH_SUBSEL() do {} while (0)
#endif
#define PH_STAMP() do { if (ph + 1 == PH_SPIN || ph == PH_SPIN) { if (blockIdx.x == 0 && vtid() == 0) { unsigned long long* st_ = (unsigned long long*)(args_ptr()->ws + WS_CTL) + 26000; \
        const unsigned long long t1_ = __builtin_amdgcn_s_memrealtime(); st_[ph + 1] = t1_; st_[103] = t1_; \
        if (ph == PH_SPIN) { unsigned long long d_ = t1_ - st_[ph]; PH_SUBSEL(); if (d_ > 100000ull) d_ = 100000ull; while (__builtin_amdgcn_s_memrealtime() - t1_ < d_) __builtin_amdgcn_s_sleep(8); } } \
        if (ph == PH_SPIN) { SEAM1(); } } } while (0)
#else
#define PH_STAMP() do {} while (0)
#endif
#define RUN(K, ...) do { if (((PHMASK >> (K)) & 1) && lo <= ph && ph < hi) { const int nrep_ = ((K) == REPEAT_PHASE && (REPEAT_LAYER < 0 || REPEAT_LAYER == l_)) ? 2 : 1; \
    for (int rep_ = 0; rep_ < nrep_; ++rep_) { __VA_ARGS__; if (rep_ + 1 < nrep_) { SEAM1(); } } SEAM(); PH_STAMP(); } ++ph; } while (0)
#define LOCALS() ArgsP a = args_ptr(); unsigned char* ws = a->ws; unsigned char* wb = ws + WS_W; float* SSP = (float*)(ws + WS_SSP); float* SSQP = (float*)(ws + WS_SSQP); bf16_t* HB = (bf16_t*)(ws + A_HB); \
    const int G = gridDim.x, bid = blockIdx.x; (void)wb; (void)SSP; (void)SSQP; (void)HB; (void)G; (void)bid
#define WT(off) ((const pg8::bf16_t*)(wb + (off)))
    int l_ = 0;
    for (int l = 0; l < DEPTH; ++l) {
        l_ = l;
        RUN(0, phase_weights(nullptr, l, lds));
        RUN(1, { LOCALS(); pg8::Gemm g{HB, WT(W_IN), M, PC - 256, 1024, 1024}; pg8::StaticOrder S; S.init(M, PC - 256, G, bid);
              pg8::EpiP E{(bf16_t*)(ws + A_RKV), (bf16_t*)(ws + A_LORAC), (bf16_t*)(ws + A_PM), (unsigned char*)a->out, SSP + (size_t)(2 * l) * M * 16, SSQP + (size_t)l * M * 4, SSQP + (size_t)(2 + l) * M * 4, (bf16_t*)((unsigned char*)a->out + DO_HALO), (LAS float*)(lds + pg8::RS_OFF), 0};
              GEMM_PHASE(pg8::EpiP, lds, g, S, E); });
        RUN(2, phase_prep(nullptr, l));
        RUN(3, { if (PH3SUB & 1) { LOCALS(); pg8::Gemm g{(const bf16_t*)(ws + A_LIN), WT(W_LORA), M, 1536, 256, 256}; pg8::StaticOrder S; S.init(M, 1536, G, bid);
                pg8::EpiLora E{(bf16_t*)(ws + A_LW), (bf16_t*)(ws + A_ICLR), (bf16_t*)(ws + A_GATE), a->in[I_DBASE] + l * 512, a->in[I_IBASE] + l * 512};
                GEMM_PHASE(pg8::EpiLora, lds, g, S, E); }
              if (gridDim.x == 256 && blockIdx.x >= 192) {
                LOCALS(); pg8::Gemm g{HB, WT(W_IN) + (size_t)(PC - 256) * 1024, M, 256, 1024, 1024}; pg8::StaticOrder S; S.init(M, 256, 64, bid - 192);
                pg8::EpiP E{(bf16_t*)(ws + A_RKV), (bf16_t*)(ws + A_LORAC), (bf16_t*)(ws + A_PM), (unsigned char*)a->out, SSP + (size_t)(2 * l) * M * 16, SSQP + (size_t)l * M * 4, SSQP + (size_t)(2 + l) * M * 4, (bf16_t*)((unsigned char*)a->out + DO_HALO), (LAS float*)(lds + pg8::RS_OFF), 16};
                GEMM_PHASE(pg8::EpiP, lds, g, S, E); }
              else if (gridDim.x != 256) {
                LOCALS(); pg8::Gemm g{HB, WT(W_IN) + (size_t)(PC - 256) * 1024, M, 256, 1024, 1024}; pg8::StaticOrder S; S.init(M, 256, G, bid);
                pg8::EpiP E{(bf16_t*)(ws + A_RKV), (bf16_t*)(ws + A_LORAC), (bf16_t*)(ws + A_PM), (unsigned char*)a->out, SSP + (size_t)(2 * l) * M * 16, SSQP + (size_t)l * M * 4, SSQP + (size_t)(2 + l) * M * 4, (bf16_t*)((unsigned char*)a->out + DO_HALO), (LAS float*)(lds + pg8::RS_OFF), 16};
                GEMM_PHASE(pg8::EpiP, lds, g, S, E); }
              if (PH3SUB & 2) { LOCALS(); pg8::Gemm g{(const bf16_t*)(ws + A_PM), WT(W_Q), M, 768, 256, 512}; pg8::StaticOrder S; S.init(M, 768, G, bid);
                pg8::EpiQ E{(bf16_t*)(ws + A_QN), (bf16_t*)(ws + A_QP), SSQP + (size_t)l * M * 4, (const float*)(ws + WS_CS), (LAS float*)(lds + pg8::RS_OFF)};
                GEMM_PHASE(pg8::EpiQ, lds, g, S, E); }
              if (PH3SUB & 4) { LOCALS(); pg8::Gemm g{(const bf16_t*)(ws + A_PM) + 256, WT(W_KV), M, 1024, 256, 512}; pg8::StaticOrder S; S.init(M, 1024, G, bid);
                pg8::EpiKV E{(bf16_t*)(ws + A_KN), (bf16_t*)(ws + A_VT), SSQP + (size_t)(2 + l) * M * 4, (LAS float*)(lds + pg8::RS_OFF)};
                GEMM_PHASE(pg8::EpiKV, lds, g, S, E); } });
#if WKV_STREAM
        RUN(4, { if (gridDim.x >= 64) { if (blockIdx.x >= 32) phase_wkvprep(nullptr, l, lds, (int)blockIdx.x - 32, (int)gridDim.x - 32); }
                 else { phase_wkvprep(nullptr, l, lds, (int)blockIdx.x, (int)gridDim.x); SEAM1(); }
                 if (blockIdx.x < 32) { for (int sr_ = 0; sr_ < SCAN_REPS; ++sr_) scan_unit_stream(nullptr, l, blockIdx.x, lds); }
#ifdef PH_SUB
                 if (blockIdx.x == 0 && vtid() == 0) { unsigned long long* ts_ = (unsigned long long*)(args_ptr()->ws + WS_CTL) + 26100; ts_[0] = ts_[3]; ts_[1] = __builtin_amdgcn_s_memrealtime(); }
#endif
                 unsigned* qctr = (unsigned*)(args_ptr()->ws + WS_CTL) + CW_QUEUE + 64 * (2 * l);
                 volatile LAS unsigned* qslot = (volatile LAS unsigned*)(lds + MISC_OFF) + 16;
                 for (;;) { if (vtid() == 0) qslot[0] = __hip_atomic_fetch_add(qctr, 1u, __ATOMIC_RELAXED, __HIP_MEMORY_SCOPE_AGENT);
                            __syncthreads(); const unsigned u = qslot[0]; __syncthreads();
                            if (u >= 512u) break;
                            attn_unit(nullptr, (int)(u & 31u), 15 - (int)(u >> 5), lds, A_QN); }
#ifdef PH_SUB
                 if (blockIdx.x == 0 && vtid() == 0) { unsigned long long* ts_ = (unsigned long long*)(args_ptr()->ws + WS_CTL) + 26100; ts_[2] = __builtin_amdgcn_s_memrealtime(); }
                 if (blockIdx.x == 255 && vtid() == 0) { unsigned long long* ts_ = (unsigned long long*)(args_ptr()->ws + WS_CTL) + 26100; __hip_atomic_store(ts_ + 4, (unsigned long long)__builtin_amdgcn_s_memrealtime(), __ATOMIC_RELAXED, __HIP_MEMORY_SCOPE_AGENT); }
#endif
                 });
#else
#ifdef SPLIT_SCAN_ATTN
        RUN(4, { if (blockIdx.x < 128) scan_unit_chunked(nullptr, l, blockIdx.x >> 2, blockIdx.x & 3, lds); });
        RUN(5, { for (int c = blockIdx.x; c < 256; c += gridDim.x) { attn_unit(nullptr, c >> 3, 15 - (c & 7), lds); attn_unit(nullptr, c >> 3, c & 7, lds); } });
#else
        RUN(4, { if (blockIdx.x < 128) { for (int sr_ = 0; sr_ < SCAN_REPS; ++sr_) { if (SCAN_CHUNKED) scan_unit_chunked(nullptr, l, blockIdx.x >> 2, blockIdx.x & 3, lds); else scan_unit(nullptr, l, blockIdx.x >> 2, blockIdx.x & 3, lds); } }
                 const size_t oo_ = (rep_ + 1 < nrep_) ? A_LW : A_QN;
                 unsigned* qctr = (unsigned*)(args_ptr()->ws + WS_CTL) + CW_QUEUE + 64 * (2 * l + rep_);
                 volatile LAS unsigned* qslot = (volatile LAS unsigned*)(lds + MISC_OFF) + 16;
                 for (;;) { if (vtid() == 0) qslot[0] = __hip_atomic_fetch_add(qctr, 1u, __ATOMIC_RELAXED, __HIP_MEMORY_SCOPE_AGENT);
                            __syncthreads(); const unsigned u = qslot[0]; __syncthreads();
                            if (u >= 512u) break;
                            attn_unit(nullptr, (int)(u & 31u), 15 - (int)(u >> 5), lds, oo_); } });
#endif
#endif
#ifdef CK_TIME
        if (l == 0) { phase_time_out(nullptr); return; }
#endif
#ifdef CMPY_PROBE
        if (l == 0) { if (blockIdx.x < 128) scan_unit(nullptr, l, blockIdx.x >> 2, blockIdx.x & 3, lds, A_GATE); SEAM1(); phase_cmp_y(nullptr); SEAM1(); phase_cmp_out(nullptr); return; }
#endif
#ifdef CHKSUM_PROBE
        if (l == 0) { phase_chk_sum(nullptr); SEAM1(); phase_chk_out(nullptr); return; }
#endif
        RUN(6, phase_ya(nullptr, l));
        RUN(7, { { LOCALS(); pg8::Gemm g{(const bf16_t*)(ws + A_YA), WT(W_OA), M, 1024, 512, 512}; pg8::StaticOrder S; S.init(M, 1024, G, bid);
                pg8::EpiMix<1> E{(float*)(ws + A_TMP), (bf16_t*)(ws + A_MERGED), (const unsigned char*)a->out};
                GEMM_PHASE(pg8::EpiMix<1>, lds, g, S, E); }
              asm volatile("s_waitcnt vmcnt(0)" ::: "memory"); __syncthreads();
              { LOCALS(); pg8::Gemm g{(const bf16_t*)(ws + A_QN), WT(W_OB), M, 1024, 512, 512}; pg8::StaticOrder S; S.init(M, 1024, G, bid);
                pg8::EpiMix<2> E{(float*)(ws + A_TMP), (bf16_t*)(ws + A_MERGED), (const unsigned char*)a->out};
                GEMM_PHASE(pg8::EpiMix<2>, lds, g, S, E); } });
        RUN(8, { LOCALS(); pg8::Gemm g{(const bf16_t*)(ws + A_MERGED), WT(W_OUT), M, 1024, 1024, 1024}; pg8::StaticOrder S; S.init(M, 1024, G, bid);
#ifdef PH_SUB
              g.ts = (unsigned long long*)(ws + WS_CTL) + 26100;
#endif
              pg8::EpiRes E{HB, SSP + (size_t)(2 * l + 1) * M * 16};
              GEMM_PHASE(pg8::EpiRes, lds, g, S, E); });
        RUN(9, { LOCALS(); pg8::Gemm g{HB, WT(W_UP), M, 2 * FF, 1024, 1024}; pg8::StaticOrder S; S.init(M, 2 * FF, G, bid);
              pg8::EpiUp E{(bf16_t*)(ws + A_ACT), (bf16_t*)(ws + A_UG), SSP + (size_t)(2 * l + 1) * M * 16, a->in[I_CONVW] + (size_t)l * 3 * FF, a->in[I_CONVB] + (size_t)l * FF, (LAS float*)(lds + pg8::RS_OFF)};
              GEMM_PHASE(pg8::EpiUp, lds, g, S, E); });
        RUN(11, { LOCALS(); pg8::Gemm g{(const bf16_t*)(ws + A_ACT), WT(W_DOWN), M, 1024, FF, FF}; pg8::StaticOrder S; S.init(M, 1024, G, bid);
              { pg8::Unit hu_; for (int hi_ = 0; S.next(hi_, hu_); ++hi_) ffn_halo_fix(nullptr, l, hu_.pm); }
              pg8::EpiRes E{HB, SSP + (size_t)(2 * l + 2) * M * 16};
              GEMM_PHASE(pg8::EpiRes, lds, g, S, E); });
    }
    RUN(12, phase_final(nullptr));
#ifdef PH_TIME
    SEAM1(); phase_phtime_out(nullptr);
#endif
#if DUMP_MIB
    if (lo == 100) phase_dump(nullptr);
#endif
#ifdef CLOCKJUNK
    if (lo == 103 && blockIdx.x == 0) { args_ptr()->out[vtid()] += (float)(__builtin_amdgcn_s_memrealtime() & 1023); }
#endif
}

#undef lo
#undef hi
extern "C" void kernel_launch(void* const* d_in, const int* in_sizes, int n_in, void* d_out, int out_size, void* d_ws, size_t ws_size, hipStream_t stream) {
    static int grid = 0;
    if (grid == 0) {
        if (n_in != 28 || out_size != M * DM || ws_size < WS_END) { fprintf(stderr, "kernel_launch: unexpected shapes: n_in %d out %d ws %zu (need %zu)\n", n_in, out_size, ws_size, (size_t)WS_END); grid = -1; return; }
        int dev = 0, cus = 0, per_cu = 0;
        if (hipGetDevice(&dev) != hipSuccess || hipDeviceGetAttribute(&cus, hipDeviceAttributeMultiprocessorCount, dev) != hipSuccess) { grid = -1; return; }
        if (hipFuncSetAttribute((const void*)mk_fwd, hipFuncAttributeMaxDynamicSharedMemorySize, LDS_BYTES) != hipSuccess) { fprintf(stderr, "kernel_launch: hipFuncSetAttribute failed\n"); grid = -1; return; }
        if (hipOccupancyMaxActiveBlocksPerMultiprocessor(&per_cu, (const void*)mk_fwd, NTHREADS, LDS_BYTES) != hipSuccess || per_cu < 1) { fprintf(stderr, "kernel_launch: occupancy query says %d\n", per_cu); per_cu = 1; }
        (void)hipGetLastError();
        grid = cus * 1;
        if (grid > cus * per_cu) grid = cus * per_cu;
    }
    if (grid < 0) return;
    if (hipMemsetAsync((char*)d_ws + WS_CTL, 0, CTL_ZERO_BYTES, stream) != hipSuccess) { fprintf(stderr, "kernel_launch: memset failed\n"); return; }
    Args a{};
    for (int i = 0; i < 28; ++i) a.in[i] = (const float*)d_in[i];
    a.out = (float*)d_out; a.ws = (unsigned char*)d_ws;
#if MK_MULTI
#ifndef STOP_AFTER
#define STOP_AFTER (N_PHASES - 1)
#endif
    for (int p = 0; p <= STOP_AFTER; ++p) {
        a.ph_lo = p; a.ph_hi = p + 1;
        hipLaunchKernelGGL(mk_fwd, dim3(grid), dim3(NTHREADS), LDS_BYTES, stream, a);
    }
#ifdef CLOCKJUNK
    a.ph_lo = 103; a.ph_hi = 104;
    hipLaunchKernelGGL(mk_fwd, dim3(grid), dim3(NTHREADS), LDS_BYTES, stream, a);
#endif
#if DUMP_MIB
    a.ph_lo = 100; a.ph_hi = 101;
    hipLaunchKernelGGL(mk_fwd, dim3(grid), dim3(NTHREADS), LDS_BYTES, stream, a);
#endif
#else
    a.ph_lo = 0; a.ph_hi = N_PHASES;
    void* kargs[] = {&a};
    hipError_t e = hipLaunchCooperativeKernel((const void*)mk_fwd, dim3(grid), dim3(NTHREADS), kargs, LDS_BYTES, stream);
    if (e != hipSuccess) fprintf(stderr, "kernel_launch: cooperative launch failed: %s (grid %d)\n", hipGetErrorString(e), grid);
#endif
}
```

```cpp
#include <hip/hip_runtime.h>
#include <hip/hip_cooperative_groups.h>
#include <cstdio>
#include <cstdint>
#include <cmath>
namespace cg = cooperative_groups;

#ifndef MK_MULTI
#define MK_MULTI 0
#endif

#ifndef SCAN_CHUNKED
#define SCAN_CHUNKED 1
#endif
#define LW_CUM SCAN_CHUNKED
#ifndef WKV_STREAM
#define WKV_STREAM 1
#endif
#ifndef CK_LWZ
#define CK_LWZ 1.0f
#endif
#ifndef CK_NOSTATE
#define CK_NOSTATE 0
#endif
#ifndef CK_AB
#define CK_AB 1.0f
#endif
constexpr int BATCH = 4, SEQ = 4096, DM = 1024, M = BATCH * SEQ, DEPTH = 2;
constexpr int NH = 8, RD = 512;
constexpr int IN_COLS = 4256, PC = 4352;
constexpr int FF = 2816;
constexpr float NORM_EPS = 1e-6f, LNX_EPS = 64e-5f;
constexpr float C2 = 0.10206207261596577f * 1.4426950408889634f;

namespace pg8 {
#define PG8_LAS __attribute__((address_space(3)))
}
extern __shared__ __attribute__((aligned(16))) unsigned char lds_raw[];
constexpr int WTAB_OFF = 131072 + 448;
__device__ __forceinline__ unsigned hw_wave_key() { return (unsigned)__builtin_amdgcn_s_getreg((5 << 11) | 4) & 63u; }
__device__ __forceinline__ int vtid() {
    const int wv = __builtin_amdgcn_readfirstlane((int)*(volatile PG8_LAS unsigned*)((PG8_LAS unsigned char*)lds_raw + WTAB_OFF + hw_wave_key() * 4u));
    int t_ = (wv << 6) | (int)__builtin_amdgcn_mbcnt_hi(~0u, __builtin_amdgcn_mbcnt_lo(~0u, 0u));
    asm volatile("" : "+v"(t_));
    return t_;
}
__device__ __forceinline__ float shx(float v, int m) {
    int l_ = (int)__builtin_amdgcn_mbcnt_hi(~0u, __builtin_amdgcn_mbcnt_lo(~0u, 0u)); asm volatile("" : "+v"(l_));
    return __builtin_bit_cast(float, __builtin_amdgcn_ds_bpermute((l_ ^ m) << 2, __builtin_bit_cast(int, v)));
}
namespace pg8 {
typedef unsigned short bf16_t;
typedef short bf16x8 __attribute__((ext_vector_type(8)));
typedef float f32x4 __attribute__((ext_vector_type(4)));
typedef unsigned u32x4 __attribute__((ext_vector_type(4)));
constexpr int BM = 256, BK = 64, HALF = 128, HTB = HALF * BK * 2  , STAGE_BYTES = 8 * HTB, NXCD = 8, WGM = 8;

__host__ __device__ __forceinline__ int lds_byte(int r, int c) { const int st = (r >> 4) * 2 + (c >> 5), rr = r & 15, cc = c & 31, ob = rr * 64 + cc * 2; return st * 1024 + (ob ^ (((ob >> 9) & 1) << 5)); }
__host__ __device__ __forceinline__ void stage_rc(int b, int& R, int& C) { const int st = b / 1024, sb = b % 1024, swz = sb ^ (((sb >> 9) & 1) << 5); R = (st >> 1) * 16 + swz / 64; C = (st & 1) * 32 + (swz % 64) / 2; }
__host__ __device__ __forceinline__ int perm32(int rho) { const int n = rho >> 4, i = rho & 15; return 8 * (i >> 2) + 4 * n + (i & 3); }

struct Unit { int pm, pn; };
struct Gemm { const bf16_t* A; const bf16_t* Bt; int M, N, K, lda; unsigned long long* ts = nullptr; };

struct StaticOrder {
    int nM, nN, nwg, G, c;
    __host__ __device__ void init(int M, int N, int G_, int c_) { nM = M / BM; nN = N / BM; nwg = nM * nN; G = G_; c = c_; }
    __host__ __device__ __forceinline__ bool next(int i, Unit& u) const {
        const long L = (long)i * G + c; if (L >= nwg) return false;
        int wgid = (int)L; { const int q = nwg / NXCD, r = nwg % NXCD, xcd = wgid % NXCD, off = wgid / NXCD; wgid = (xcd < r ? xcd * (q + 1) : r * (q + 1) + (xcd - r) * q) + off; }
        const int nig = WGM * nN, gid = wgid / nig, fm = gid * WGM, gsz = (nM - fm) < WGM ? (nM - fm) : WGM;
        u.pm = fm + ((wgid % nig) % gsz); u.pn = (wgid % nig) / gsz; return true;
    }
    __device__ __forceinline__ void a_ready(const Unit&) const {}
    __device__ __forceinline__ void done(const Unit&) const {}
};

__device__ __forceinline__ unsigned cvt_pk_bf16(float lo, float hi) { unsigned r; asm volatile("v_cvt_pk_bf16_f32 %0, %1, %2" : "=v"(r) : "v"(lo), "v"(hi)); return r; }
template <class Epi, class Sched, bool ALIGN_EPI = false, bool SP2 = false>
__device__ __forceinline__ void gemm_phase(PG8_LAS unsigned char* lds, const Gemm g, const Sched& S, const Epi& E) {
    int tid_ = vtid(); asm volatile("" : "+v"(tid_)); const int tid = tid_, wid = __builtin_amdgcn_readfirstlane(tid >> 6), lane = tid & 63, wr = wid >> 2, wc = wid & 3, fr = lane & 15, fq = lane >> 4;
    int Kx_ = g.K; asm volatile("" : "+s"(Kx_)); const int K = Kx_, nt = K / BK;
    unsigned voffA[2], voffB[2];
#pragma unroll
    for (int i = 0; i < 2; ++i) { int R, C; stage_rc(tid * 16 + i * 8192, R, C); const int Rb = Epi::PERM ? ((R & ~31) + perm32(R & 31)) : R;
        voffA[i] = (unsigned)(R * g.lda + C) * 2u; voffB[i] = (unsigned)(Rb * K + C) * 2u; }
    const size_t kstep = (size_t)(BK * 2);
    const size_t hstep = (size_t)HALF * K * 2, hstepA = (size_t)HALF * g.lda * 2;
    const size_t tstep = 2 * hstep, tstepA = 2 * hstepA;
    const unsigned ldsw = (unsigned)wid * 1024u;
    const int aoff = lds_byte(wr * 64 + fr, fq * 8), boff = lds_byte(wc * 32 + fr, fq * 8);
#define PG8_SA(b, h) (((b) * 2 + (h)) * HTB)
#define PG8_SB(b, h) ((4 + (b) * 2 + (h)) * HTB)
#define PG8_STAGE(bufoff, gbase, voff) do { _Pragma("unroll") for (int _i = 0; _i < 2; ++_i) \
        __builtin_amdgcn_global_load_lds((const unsigned*)((const char*)(gbase) + (voff)[_i]), (PG8_LAS unsigned*)(lds + (bufoff) + ldsw + _i * 8192), 16, 0, 0); } while (0)
#define PG8_LDA(dst, b, h) do { _Pragma("unroll") for (int m = 0; m < 4; ++m) _Pragma("unroll") for (int k = 0; k < 2; ++k) dst[m][k] = *(const PG8_LAS bf16x8*)(lds + PG8_SA(b, h) + aoff + m * 2048 + k * 1024); } while (0)
#define PG8_LDB(dst, b, h) do { _Pragma("unroll") for (int n = 0; n < 2; ++n) _Pragma("unroll") for (int k = 0; k < 2; ++k) dst[n][k] = *(const PG8_LAS bf16x8*)(lds + PG8_SB(b, h) + boff + n * 2048 + k * 1024); } while (0)
#define PG8_MMA(ai, bj, At, Bt) do { __builtin_amdgcn_s_setprio(1); _Pragma("unroll") for (int m = 0; m < 4; ++m) _Pragma("unroll") for (int n = 0; n < 2; ++n) _Pragma("unroll") for (int k = 0; k < 2; ++k) \
        acc[ai][bj][m][n] = __builtin_amdgcn_mfma_f32_16x16x32_bf16(Bt[n][k], At[m][k], acc[ai][bj][m][n], 0, 0, 0); __builtin_amdgcn_s_setprio(0); } while (0)
#define PG8_WAIT_V(n) asm volatile("s_waitcnt vmcnt(" #n ")" ::: "memory")
#define PG8_WAIT_L(n) asm volatile("s_waitcnt lgkmcnt(" #n ")" ::: "memory")
#define PG8_BAR __builtin_amdgcn_s_barrier()
#define PG8_SCHED __builtin_amdgcn_sched_barrier(0)
    Unit cur, nxt; int ui = 0;
    if (!S.next(0, cur)) return;
#ifdef PH_SUB
#define PG8_TS(i) do { if (blockIdx.x == 0 && tid == 0) g.ts[i] = __builtin_amdgcn_s_memrealtime(); } while (0)
#else
#define PG8_TS(i) do {} while (0)
#endif
    PG8_TS(0);
    f32x4 acc[2][2][4][2];
#pragma unroll
    for (int a = 0; a < 2; ++a)
#pragma unroll
        for (int b = 0; b < 2; ++b)
#pragma unroll
            for (int m = 0; m < 4; ++m)
#pragma unroll
                for (int n = 0; n < 2; ++n) acc[a][b][m][n] = (f32x4){0.f, 0.f, 0.f, 0.f};
    bf16x8 At[4][2], B0[2][2], B1[2][2];
    const char* cA = (const char*)g.A + (size_t)cur.pm * tstepA; const char* cB = (const char*)g.Bt + (size_t)cur.pn * tstep;
    S.a_ready(cur);
    if constexpr (SP2) {
        PG8_STAGE(PG8_SB(0, 0), cB, voffB); PG8_STAGE(PG8_SB(0, 1), cB + hstep, voffB); PG8_STAGE(PG8_SA(0, 0), cA, voffA); PG8_STAGE(PG8_SA(0, 1), cA + hstepA, voffA);
        if (wr == 1) PG8_BAR;
        PG8_WAIT_V(2); PG8_BAR;
        PG8_STAGE(PG8_SB(1, 0), cB + kstep, voffB); PG8_STAGE(PG8_SA(1, 0), cA + kstep, voffA); PG8_STAGE(PG8_SB(1, 1), cB + hstep + kstep, voffB);
        PG8_WAIT_V(6); PG8_BAR;
    } else {
        PG8_STAGE(PG8_SB(0, 0), cB, voffB); PG8_STAGE(PG8_SA(0, 0), cA, voffA); PG8_STAGE(PG8_SB(0, 1), cB + hstep, voffB); PG8_STAGE(PG8_SA(0, 1), cA + hstepA, voffA);
        if (wr == 1) PG8_BAR;
        PG8_WAIT_V(4); PG8_BAR;
        PG8_STAGE(PG8_SB(1, 0), cB + kstep, voffB); PG8_STAGE(PG8_SA(1, 0), cA + kstep, voffA); PG8_STAGE(PG8_SB(1, 1), cB + hstep + kstep, voffB);
        PG8_WAIT_V(6); PG8_BAR;
    }
    for (;;) {
        const bool has_next = S.next(ui + 1, nxt);
        const char* nA = has_next ? (const char*)g.A + (size_t)nxt.pm * tstepA : cA; const char* nB = has_next ? (const char*)g.Bt + (size_t)nxt.pn * tstep : cB;
#pragma unroll 1
        for (int t = 0; t < nt; t += 2) {
            const bool last = (t == nt - 2);
            const char* a1 = cA + (size_t)(t + 1) * kstep;
            const char* a2 = last ? nA : cA + (size_t)(t + 2) * kstep; const char* b2 = last ? nB : cB + (size_t)(t + 2) * kstep;
            const char* a3 = a2 + kstep; const char* b3 = b2 + kstep;
            if (last && has_next) S.a_ready(nxt);
            if constexpr (SP2) {
            PG8_LDB(B0, 0, 0); PG8_LDB(B1, 0, 1); PG8_SCHED; PG8_LDA(At, 0, 0); PG8_STAGE(PG8_SA(1, 1), a1 + hstepA, voffA);
            PG8_WAIT_V(8); PG8_WAIT_L(0); PG8_BAR; PG8_MMA(0, 0, At, B0); PG8_MMA(0, 1, At, B1); PG8_BAR; PG8_SCHED;
            PG8_LDA(At, 0, 1); PG8_STAGE(PG8_SB(0, 0), b2, voffB); PG8_STAGE(PG8_SB(0, 1), b2 + hstep, voffB); PG8_STAGE(PG8_SA(0, 0), a2, voffA);
            PG8_WAIT_V(8); PG8_WAIT_L(0); PG8_BAR; PG8_MMA(1, 0, At, B0); PG8_MMA(1, 1, At, B1); PG8_BAR; PG8_SCHED;
            PG8_LDB(B0, 1, 0); PG8_LDB(B1, 1, 1); PG8_SCHED; PG8_LDA(At, 1, 0); PG8_STAGE(PG8_SA(0, 1), a2 + hstepA, voffA);
            PG8_WAIT_V(8); PG8_WAIT_L(0); PG8_BAR; PG8_MMA(0, 0, At, B0); PG8_MMA(0, 1, At, B1); PG8_BAR; PG8_SCHED;
            PG8_LDA(At, 1, 1); PG8_STAGE(PG8_SB(1, 0), b3, voffB); PG8_STAGE(PG8_SB(1, 1), b3 + hstep, voffB); PG8_STAGE(PG8_SA(1, 0), a3, voffA);
            PG8_WAIT_V(8); PG8_WAIT_L(0); PG8_BAR; PG8_MMA(1, 0, At, B0); PG8_MMA(1, 1, At, B1); PG8_BAR; PG8_SCHED;
            } else {
            PG8_LDB(B0, 0, 0); PG8_SCHED; PG8_LDA(At, 0, 0); PG8_STAGE(PG8_SA(1, 1), a1 + hstepA, voffA);
            PG8_WAIT_L(8); PG8_BAR; PG8_WAIT_L(0); PG8_MMA(0, 0, At, B0); PG8_BAR; PG8_SCHED;
            PG8_LDB(B1, 0, 1); PG8_STAGE(PG8_SB(0, 0), b2, voffB);
            PG8_BAR; PG8_WAIT_L(0); PG8_MMA(0, 1, At, B1); PG8_BAR;
            PG8_LDA(At, 0, 1); PG8_STAGE(PG8_SA(0, 0), a2, voffA);
            PG8_BAR; PG8_WAIT_L(0); PG8_MMA(1, 0, At, B0); PG8_BAR; PG8_SCHED;
            PG8_STAGE(PG8_SB(0, 1), b2 + hstep, voffB);
            PG8_WAIT_V(6); PG8_BAR; PG8_MMA(1, 1, At, B1); PG8_BAR;
            PG8_LDB(B0, 1, 0); PG8_SCHED; PG8_LDA(At, 1, 0); PG8_STAGE(PG8_SA(0, 1), a2 + hstepA, voffA);
            PG8_WAIT_L(8); PG8_BAR; PG8_WAIT_L(0); PG8_MMA(0, 0, At, B0); PG8_BAR; PG8_SCHED;
            PG8_LDB(B1, 1, 1); PG8_STAGE(PG8_SB(1, 0), b3, voffB);
            PG8_BAR; PG8_WAIT_L(0); PG8_MMA(0, 1, At, B1); PG8_BAR;
            PG8_LDA(At, 1, 1); PG8_STAGE(PG8_SA(1, 0), a3, voffA);
            PG8_BAR; PG8_WAIT_L(0); PG8_MMA(1, 0, At, B0); PG8_BAR; PG8_SCHED;
            PG8_STAGE(PG8_SB(1, 1), b3 + hstep, voffB);
            PG8_WAIT_V(6); PG8_BAR; PG8_MMA(1, 1, At, B1); PG8_BAR;
            }
        }
        if constexpr (ALIGN_EPI) { if (wr == 0) PG8_BAR; }
        PG8_TS(1);
        if constexpr (!Epi::AFTER_DRAIN) { E(acc, cur, wr, wc, fr, fq); S.done(cur); }
        asm volatile("" ::: "memory"); PG8_TS(2);
        if (!has_next) break;
#pragma unroll
        for (int a = 0; a < 2; ++a)
#pragma unroll
            for (int b = 0; b < 2; ++b)
#pragma unroll
                for (int m = 0; m < 4; ++m)
#pragma unroll
                    for (int n = 0; n < 2; ++n) acc[a][b][m][n] = (f32x4){0.f, 0.f, 0.f, 0.f};
        cur = nxt; cA = nA; cB = nB; ++ui;
        if constexpr (ALIGN_EPI) { if (wr == 1) PG8_BAR; }
    }
    PG8_WAIT_V(0);
    if constexpr (!ALIGN_EPI) { if (wr == 0) PG8_BAR; }
    PG8_BAR;
    if constexpr (Epi::AFTER_DRAIN) { E.fused(acc, cur, wr, wc, fr, fq, lds, wid, lane); S.done(cur); }
#undef PG8_SA
#undef PG8_SB
#undef PG8_STAGE
#undef PG8_LDA
#undef PG8_LDB
#undef PG8_MMA
#undef PG8_WAIT_V
#undef PG8_WAIT_L
#undef PG8_BAR
#undef PG8_SCHED
}
}

#define LAS __attribute__((address_space(3)))
typedef unsigned short bf16_t;
typedef short bf16x8 __attribute__((ext_vector_type(8)));
typedef short s16x4 __attribute__((ext_vector_type(4)));
typedef float f32x4 __attribute__((ext_vector_type(4)));
typedef float f32x16 __attribute__((ext_vector_type(16)));
typedef unsigned u32x4 __attribute__((ext_vector_type(4)));
typedef unsigned u32x2 __attribute__((ext_vector_type(2)));

__device__ __forceinline__ float bf2f(unsigned b) { return __uint_as_float(b << 16); }
__device__ __forceinline__ unsigned f2bf(float f) { unsigned u = __float_as_uint(f); return (u + 0x7fffu + ((u >> 16) & 1u)) >> 16; }
typedef float f32x2_t __attribute__((ext_vector_type(2))); typedef __bf16 bf16x2_t __attribute__((ext_vector_type(2)));
__device__ __forceinline__ unsigned pk2(float lo, float hi) { const f32x2_t v = {lo, hi}; const bf16x2_t b = __builtin_convertvector(v, bf16x2_t); return __builtin_bit_cast(unsigned, b); }
__device__ __forceinline__ float sigm(float x) { return 1.0f / (1.0f + __expf(-x)); }
__device__ __forceinline__ f32x4 up4(u32x2 v) { return (f32x4){__uint_as_float(v.x << 16), __uint_as_float(v.x & 0xffff0000u), __uint_as_float(v.y << 16), __uint_as_float(v.y & 0xffff0000u)}; }
__device__ __forceinline__ u32x2 dn4(f32x4 v) { u32x2 r; r.x = pk2(v.x, v.y); r.y = pk2(v.z, v.w); return r; }
__device__ __forceinline__ float dot4(f32x4 a, f32x4 b) { return (a.x * b.x + a.y * b.y) + (a.z * b.z + a.w * b.w); }

constexpr size_t MiB = 1u << 20;
constexpr size_t WS_CTL = 0, CTL_ZERO_BYTES = 2 * MiB;
constexpr size_t WS_STAT = 1 * MiB;
constexpr size_t WS_CS = 2 * MiB;
constexpr size_t WS_W = 4 * MiB;
constexpr size_t W_IN = 0, W_LORA = W_IN + (size_t)PC * 1024 * 2, W_Q = W_LORA + 1536 * 256 * 2, W_KV = W_Q + 768 * 256 * 2,
                 W_OA = W_KV + 1024 * 256 * 2, W_OB = W_OA + 1024 * 512 * 2, W_OUT = W_OB + 1024 * 512 * 2,
                 W_UP = W_OUT + 1024 * 1024 * 2, W_DOWN = W_UP + (size_t)2 * FF * 1024 * 2, W_END = W_DOWN + (size_t)1024 * FF * 2;
static_assert(W_END <= 31 * MiB, "weights region");
constexpr size_t WS_ACT = 35 * MiB;
constexpr size_t A_HB = WS_ACT + 0 * MiB;
constexpr size_t A_RKV = WS_ACT + 32 * MiB;
constexpr size_t A_LORAC = WS_ACT + 80 * MiB;
constexpr size_t A_QP = A_LORAC;
constexpr size_t A_PM = WS_ACT + 88 * MiB;
constexpr size_t A_Y = A_PM;
constexpr size_t A_LIN = WS_ACT + 104 * MiB;
constexpr size_t A_KPE = WS_ACT + 112 * MiB;
constexpr size_t WS_SCAL = WS_ACT + 113 * MiB;
constexpr size_t A_LW = WS_ACT + 114 * MiB;
constexpr size_t A_YA = A_LW;
constexpr size_t A_ICLR = WS_ACT + 130 * MiB;
constexpr size_t A_GATE = WS_ACT + 146 * MiB;
constexpr size_t A_MERGED = A_ICLR;
constexpr size_t A_QN = WS_ACT + 162 * MiB;
constexpr size_t A_KN = WS_ACT + 178 * MiB;
constexpr size_t A_VT = WS_ACT + 194 * MiB;
constexpr size_t A_TMP = WS_ACT + 32 * MiB;
constexpr size_t A_UG = WS_ACT + 32 * MiB;
constexpr size_t A_ACT = WS_ACT + 120 * MiB;
constexpr size_t DO_MTREC = 32 * MiB, MTREC_B = 2304, DO_HALO = DO_MTREC + (size_t)8192 * MTREC_B;
static_assert(DO_HALO + (size_t)(M / 16) * 1536 * 2 <= 64 * MiB, "d_out scratch map");
constexpr size_t WS_SSP = WS_ACT + 210 * MiB;
constexpr size_t WS_SSQP = WS_SSP + 5 * MiB;
constexpr size_t WS_END = WS_SSQP + 1 * MiB;
static_assert(A_UG + (size_t)M * FF * 2 <= A_ACT && A_ACT + (size_t)M * FF * 2 <= WS_SSP && WS_END <= 256 * MiB, "workspace map");
static_assert(A_ICLR == A_LW + (size_t)M * 512 * 2 && A_GATE == A_ICLR + (size_t)M * 512 * 2, "LW | ICLR | GATE consecutive");
constexpr int CW_BAR = 4096, CW_QUEUE = 16384;

#define XB_TMO      128
#define XB_XCNT(j)  (256  + 64 * (j))
#define XB_XSUB(j)  (1280 + 64 * (j))
#define XB_XGEN(j)  (2304 + 64 * (j))
#define XB_TOP      3328
#define XB_TOPGEN   3392
#define XCD_BAR_WORDS 3456
#define XB_SPIN_CAP (1u << 18)
__device__ __forceinline__ unsigned xb_ld(unsigned* p)              { return __hip_atomic_load(p, __ATOMIC_RELAXED, __HIP_MEMORY_SCOPE_AGENT); }
__device__ __forceinline__ unsigned xb_add(unsigned* p, unsigned v) { return __hip_atomic_fetch_add(p, v, __ATOMIC_RELAXED, __HIP_MEMORY_SCOPE_AGENT); }
__device__ __forceinline__ unsigned xb_xcc_id() { return (unsigned)__builtin_amdgcn_s_getreg((3 << 11) | 20) & 0xFu; }
#define XB_SPIN(cond, bar) do { unsigned _sp = 0; while (cond) { __builtin_amdgcn_s_sleep(1); \
    if ((++_sp & 255u) == 0u) { if (xb_ld(&(bar)[XB_TMO])) break; if (_sp > XB_SPIN_CAP) { atomicAdd(&(bar)[XB_TMO], 1u); break; } } } } while (0)
struct XcdBarrier { unsigned* bar; unsigned x; volatile LAS unsigned* st; };
__device__ __forceinline__ XcdBarrier xcd_barrier_post(unsigned* bar, volatile LAS unsigned* st) {
    XcdBarrier b; b.bar = bar; b.x = xb_xcc_id(); b.st = st;
    if (vtid() == 0) (void)xb_add(&bar[XB_XCNT(b.x)], 1u);
    return b;
}
__device__ __forceinline__ void xcd_barrier_complete(unsigned* bar, unsigned x, unsigned& nloc, unsigned& nx) {
    const unsigned G = gridDim.x * gridDim.y * gridDim.z;
    unsigned sum, cnt, mine, sp = 0u;
    for (;;) {
        sum = 0u; cnt = 0u; mine = 0u;
#pragma unroll
        for (unsigned j = 0; j < 16; ++j) { const unsigned c = xb_ld(&bar[XB_XCNT(j)]); sum += c; cnt += (c > 0u) ? 1u : 0u; mine = (j == x) ? c : mine; }
        if (sum == G) break;
        __builtin_amdgcn_s_sleep(1);
        if ((++sp & 255u) == 0u) { if (xb_ld(&bar[XB_TMO])) break; if (sp > XB_SPIN_CAP) { atomicAdd(&bar[XB_TMO], 1u); break; } }
    }
    nloc = mine > 0u ? mine : 1u; nx = cnt > 0u ? cnt : 1u;
}
__device__ __forceinline__ void xcd_barrier(const XcdBarrier& b) {
    asm volatile("s_waitcnt vmcnt(0)" ::: "memory");
    __syncthreads();
    if (vtid() == 0) {
        unsigned* bar = b.bar;
        __builtin_amdgcn_s_waitcnt(0);
        unsigned nloc = b.st[0], nx = b.st[1];
        if (nloc == 0u) { xcd_barrier_complete(bar, b.x, nloc, nx); b.st[0] = nloc; b.st[1] = nx; }
        const unsigned old = xb_add(&bar[XB_XSUB(b.x)], 1u);
        const unsigned gen = old / nloc;
        if (old + 1u == (gen + 1u) * nloc) {
            __builtin_amdgcn_fence(__ATOMIC_RELEASE, "agent");
            asm volatile("s_waitcnt vmcnt(0)" ::: "memory");
            const unsigned og = xb_add(&bar[XB_TOP], 1u);
            const unsigned tg = og / nx;
            if (og + 1u == (tg + 1u) * nx) xb_add(&bar[XB_TOPGEN], 1u);
            else XB_SPIN(xb_ld(&bar[XB_TOPGEN]) == tg, bar);
            __builtin_amdgcn_fence(__ATOMIC_ACQUIRE, "agent");
            xb_add(&bar[XB_XGEN(b.x)], 1u);
            asm volatile("s_waitcnt vmcnt(0)" ::: "memory");
        } else {
            XB_SPIN(xb_ld(&bar[XB_XGEN(b.x)]) == gen, bar);
            __builtin_amdgcn_fence(__ATOMIC_ACQUIRE, "agent");
            asm volatile("s_waitcnt vmcnt(0)" ::: "memory");
        }
    }
    __syncthreads();
}

namespace pg8 {
__device__ __forceinline__ float sum16(const float* p) { const f32x4 a = *(const f32x4*)p, b = *(const f32x4*)(p + 4), c = *(const f32x4*)(p + 8), d = *(const f32x4*)(p + 12);
    return (((a.x + a.y) + (a.z + a.w)) + ((b.x + b.y) + (b.z + b.w))) + (((c.x + c.y) + (c.z + c.w)) + ((d.x + d.y) + (d.z + d.w))); }
__device__ __forceinline__ float sum4(const float* p) { const f32x4 a = *(const f32x4*)p; return (a.x + a.y) + (a.z + a.w); }
__device__ __forceinline__ u32x4 pack8(f32x4 a, f32x4 b) { u32x4 w; w.x = cvt_pk_bf16(a[0], a[1]); w.y = cvt_pk_bf16(a[2], a[3]); w.z = cvt_pk_bf16(b[0], b[1]); w.w = cvt_pk_bf16(b[2], b[3]); return w; }
__device__ __forceinline__ unsigned q8(float s) { return (unsigned)(s * 255.0f + 0.5f); }
__device__ __forceinline__ unsigned sig8x4(f32x4 v) { return q8(sigm(v[0])) | (q8(sigm(v[1])) << 8) | (q8(sigm(v[2])) << 16) | (q8(sigm(v[3])) << 24); }

constexpr int RS_OFF = 131072 + 1024;
#ifndef NT_STORES
#define NT_STORES 0
#endif
#ifndef NT_STORES8
#define NT_STORES8 0
#endif
__device__ __forceinline__ void ST16(bf16_t* p, u32x4 v) {
    if (NT_STORES == 1) __builtin_nontemporal_store(v, (u32x4*)p);
    else if (NT_STORES == 2) asm volatile("global_store_dwordx4 %0, %1, off sc1\n\ts_nop 1" :: "v"(p), "v"(v) : "memory");
    else if (NT_STORES == 3) asm volatile("global_store_dwordx4 %0, %1, off sc0 sc1\n\ts_nop 1" :: "v"(p), "v"(v) : "memory");
    else *(u32x4*)p = v; }
#ifndef NT_UP
#define NT_UP 1
#endif
__device__ __forceinline__ void ST16W(bf16_t* p, u32x4 v) { if (NT_UP) asm volatile("global_store_dwordx4 %0, %1, off sc1\n\ts_nop 1" :: "v"(p), "v"(v) : "memory"); else *(u32x4*)p = v; }
__device__ __forceinline__ void ST8W(void* p, u32x2 v) { asm volatile("global_store_dwordx2 %0, %1, off sc1\n\ts_nop 1" :: "v"(p), "v"(v) : "memory"); }
#ifndef SC1_MIX
#define SC1_MIX 0
#endif
#ifndef SC1_RES
#define SC1_RES 0
#endif
#ifndef SC1_QKV
#define SC1_QKV 0
#endif
template <int W> __device__ __forceinline__ void ST16S(bf16_t* p, u32x4 v) { if (W) asm volatile("global_store_dwordx4 %0, %1, off sc1\n\ts_nop 1" :: "v"(p), "v"(v) : "memory"); else *(u32x4*)p = v; }
template <int W> __device__ __forceinline__ void ST8S(bf16_t* p, u32x2 v) { if (W) asm volatile("global_store_dwordx2 %0, %1, off sc1\n\ts_nop 1" :: "v"(p), "v"(v) : "memory"); else *(u32x2*)p = v; }
__device__ __forceinline__ void ST8(bf16_t* p, u32x2 v) {
    if (NT_STORES8 == 2) asm volatile("global_store_dwordx2 %0, %1, off sc1\n\ts_nop 1" :: "v"(p), "v"(v) : "memory");
    else *(u32x2*)p = v; }
template <int NS> __device__ __forceinline__ void rs_to_lds(PG8_LAS float* rsl, const float* ss, int pm, float inv_n, float mul, int tid) {
    if (tid < 256) { const float* p = ss + (size_t)(pm * BM + tid) * NS; const float s_ = NS == 16 ? sum16(p) : sum4(p); rsl[tid] = rsqrtf(s_ * inv_n + NORM_EPS) * mul; }
    asm volatile("s_waitcnt lgkmcnt(0)" ::: "memory"); __builtin_amdgcn_s_barrier();
}
struct EpiP {
    static constexpr bool PERM = true, AFTER_DRAIN = false;
    bf16_t* RKV; bf16_t* LORAC; bf16_t* PMb; unsigned char* G8; const float* ss; float* ssq; float* sskv; bf16_t* HALO; PG8_LAS float* rsl; int pn0;
    __device__ __forceinline__ void operator()(const f32x4 (&acc)[2][2][4][2], const Unit& u, int wr, int wc, int fr, int fq) const {
        const int row0 = u.pm * BM + wr * 64 + fr, pn = u.pn + pn0;
        rs_to_lds<16>(rsl, ss, u.pm, 1.0f / 1024.0f, 1.0f, (wr * 4 + wc) * 64 + fq * 16 + fr);
#pragma unroll
        for (int ai = 0; ai < 2; ++ai)
#pragma unroll
            for (int m = 0; m < 4; ++m) {
                const int row = row0 + ai * HALF + m * 16;
                const float rs = rsl[wr * 64 + ai * HALF + m * 16 + fr];
                float sq = 0.f;
#pragma unroll
                for (int bj = 0; bj < 2; ++bj) {
                    const f32x4 v0 = acc[ai][bj][m][0] * rs, v1 = acc[ai][bj][m][1] * rs;
                    const int ct = bj * HALF + wc * 32 + 8 * fq;
                    if (pn < 6) { const u32x4 pk_ = pack8(v0, v1); ST16(RKV + (size_t)row * 1536 + pn * 256 + ct, pk_); if (fr == 15) *(u32x4*)(HALO + (size_t)(row >> 4) * 1536 + pn * 256 + ct) = pk_; }
                    else if (pn == 6) ST16(LORAC + (size_t)row * 256 + ct, pack8(v0, v1));
                    else if (pn < 9) { ST16(PMb + (size_t)row * 512 + (pn - 7) * 256 + ct, pack8(v0, v1));
                        if (pn == 7 || bj == 0) sq += dot4(v0, v0) + dot4(v1, v1); }
                    else { u32x2 w; w.x = sig8x4(v0); w.y = sig8x4(v1); ST8((bf16_t*)(G8 + (size_t)row * 2048 + (pn - 9) * 256 + ct), w); }
                }
                if (pn == 7 || pn == 8) { sq += shx(sq, 16); sq += shx(sq, 32); if (fq == 0) (pn == 7 ? ssq : sskv)[(size_t)row * 4 + wc] = sq; }
            }
    }
};
#ifndef LW_CUM
#define LW_CUM 1
#endif
template <int CTRL> __device__ __forceinline__ float dppz(float x) { return __builtin_bit_cast(float, __builtin_amdgcn_update_dpp(0, __builtin_bit_cast(int, x), CTRL, 0xf, 0xf, true)); }
__device__ __forceinline__ float pfx16(float x) { x += dppz<0x111>(x); x += dppz<0x112>(x); x += dppz<0x114>(x); x += dppz<0x118>(x); return x; }
struct EpiLora {
    static constexpr bool PERM = true, AFTER_DRAIN = false;
    bf16_t* LW; bf16_t* ICLR; bf16_t* GATE; const float* dbase; const float* ibase;
    __device__ __forceinline__ void operator()(const f32x4 (&acc)[2][2][4][2], const Unit& u, int wr, int wc, int fr, int fq) const {
        const int pn = u.pn, kind = pn >> 1;
        bf16_t* dst = LW + (size_t)kind * ((size_t)M * 512);
        const float* bias = kind == 0 ? dbase : ibase;
        const unsigned c0 = (pn & 1) * 256 + wc * 32 + 8 * fq;
        const unsigned off0 = (unsigned)(u.pm * BM + wr * 64 + fr) * 512u + c0;
#pragma unroll
        for (int bj = 0; bj < 2; ++bj) {
            f32x4 b0 = (f32x4){0.f, 0.f, 0.f, 0.f}, b1 = b0;
            if (kind < 2) { b0 = *(const f32x4*)(bias + c0 + bj * HALF); b1 = *(const f32x4*)(bias + c0 + bj * HALF + 4); }
#pragma unroll
            for (int ai = 0; ai < 2; ++ai)
#pragma unroll
                for (int m = 0; m < 4; ++m) {
                    f32x4 v0 = acc[ai][bj][m][0] + b0, v1 = acc[ai][bj][m][1] + b1;
                    if (kind == 0) { for (int e = 0; e < 4; ++e) { v0[e] = -0.6065306597126334f * sigm(v0[e]); v1[e] = -0.6065306597126334f * sigm(v1[e]); }
                        if (LW_CUM) { for (int e = 0; e < 4; ++e) { v0[e] = __expf(pfx16(v0[e])); v1[e] = __expf(pfx16(v1[e])); } } }
                    else if (kind == 1) { for (int e = 0; e < 4; ++e) { v0[e] = sigm(v0[e]); v1[e] = sigm(v1[e]); } }
                    ST16(dst + off0 + (unsigned)((ai * HALF + m * 16) * 512 + bj * HALF), pack8(v0, v1));
                    asm volatile("" ::: "memory");
                }
        }
    }
};
struct EpiQ {
    static constexpr bool PERM = false, AFTER_DRAIN = false;
    bf16_t* Qn; bf16_t* Qp; const float* ssq; const float* CS; PG8_LAS float* rsl;
    __device__ __forceinline__ void operator()(const f32x4 (&acc)[2][2][4][2], const Unit& u, int wr, int wc, int fr, int fq) const {
        const int row0 = u.pm * BM + wr * 64 + fr, pn = u.pn;
        if (pn < 2) {
            rs_to_lds<4>(rsl, ssq, u.pm, 1.0f / 256.0f, C2, (wr * 4 + wc) * 64 + fq * 16 + fr);
#pragma unroll
            for (int ai = 0; ai < 2; ++ai)
#pragma unroll
                for (int m = 0; m < 4; ++m) {
                    const int row = row0 + ai * HALF + m * 16;
                    const float rs = rsl[wr * 64 + ai * HALF + m * 16 + fr];
#pragma unroll
                    for (int bj = 0; bj < 2; ++bj)
#pragma unroll
                        for (int n = 0; n < 2; ++n) ST8S<SC1_QKV>(Qn + (size_t)row * 512 + pn * 256 + bj * HALF + wc * 32 + n * 16 + 4 * fq, dn4(acc[ai][bj][m][n] * rs));
                }
        } else {
            f32x4 cs[2][4], sn[2][4];
#pragma unroll
            for (int ai = 0; ai < 2; ++ai)
#pragma unroll
                for (int m = 0; m < 4; ++m) { const int row = row0 + ai * HALF + m * 16; cs[ai][m] = *(const f32x4*)(CS + (size_t)row * 32 + 4 * fq); sn[ai][m] = *(const f32x4*)(CS + (size_t)row * 32 + 16 + 4 * fq); }
            rs_to_lds<4>(rsl, ssq, u.pm, 1.0f / 256.0f, C2, (wr * 4 + wc) * 64 + fq * 16 + fr);
#pragma unroll
            for (int ai = 0; ai < 2; ++ai)
#pragma unroll
                for (int m = 0; m < 4; ++m) {
                    const int row = row0 + ai * HALF + m * 16;
                    const float rs = rsl[wr * 64 + ai * HALF + m * 16 + fr];
#pragma unroll
                    for (int bj = 0; bj < 2; ++bj) {
                        const f32x4 x1 = acc[ai][bj][m][0] * rs, x2 = acc[ai][bj][m][1] * rs;
                        bf16_t* d = Qp + (size_t)row * 256 + (4 * bj + wc) * 32 + 4 * fq;
                        ST8S<SC1_QKV>(d, dn4(x1 * cs[ai][m] - x2 * sn[ai][m])); ST8S<SC1_QKV>(d + 16, dn4(x1 * sn[ai][m] + x2 * cs[ai][m]));
                    }
                }
        }
    }
};
struct EpiKV {
    static constexpr bool PERM = false, AFTER_DRAIN = false;
    bf16_t* Kn; bf16_t* Vt; const float* sskv; PG8_LAS float* rsl;
    __device__ __forceinline__ void operator()(const f32x4 (&acc)[2][2][4][2], const Unit& u, int wr, int wc, int fr, int fq) const {
        const int row0 = u.pm * BM + wr * 64 + fr, pn = u.pn;
        rs_to_lds<4>(rsl, sskv, u.pm, 1.0f / 128.0f, 1.0f, (wr * 4 + wc) * 64 + fq * 16 + fr);
#pragma unroll
        for (int ai = 0; ai < 2; ++ai)
#pragma unroll
            for (int m = 0; m < 4; ++m) {
                const int row = row0 + ai * HALF + m * 16;
                const float rs = rsl[wr * 64 + ai * HALF + m * 16 + fr];
                if (pn < 2) {
#pragma unroll
                    for (int bj = 0; bj < 2; ++bj)
#pragma unroll
                        for (int n = 0; n < 2; ++n) ST8S<SC1_QKV>(Kn + (size_t)row * 512 + pn * 256 + bj * HALF + wc * 32 + n * 16 + 4 * fq, dn4(acc[ai][bj][m][n] * rs));
                } else {
                    const int b = row >> 12, s = row & 4095;
#pragma unroll
                    for (int bj = 0; bj < 2; ++bj)
#pragma unroll
                        for (int n = 0; n < 2; ++n) {
                            const int hd = (pn - 2) * 4 + 2 * bj + (wc >> 1), d = 32 * (wc & 1) + 16 * n + 4 * fq;
                            const f32x4 v = acc[ai][bj][m][n] * rs;
                            bf16_t* dst = Vt + ((size_t)((b * 8 + hd) * 64 + d) << 12) + s;
#pragma unroll
                            for (int j = 0; j < 4; ++j) dst[(size_t)j << 12] = (bf16_t)f2bf(v[j]);
                        }
                }
            }
    }
};
template <int PASS> struct EpiMix {
    static constexpr bool PERM = true, AFTER_DRAIN = false;
    float* TMP; bf16_t* MERGED; const unsigned char* G8;
    template <int AI> __device__ __forceinline__ void load(u32x2 (&g)[4][2], u32x4 (&t)[4][2], int row0, int c0) const {
#pragma unroll
        for (int m = 0; m < 4; ++m)
#pragma unroll
            for (int bj = 0; bj < 2; ++bj) { const size_t row = (size_t)(row0 + AI * HALF + m * 16); const int c = c0 + bj * HALF;
                g[m][bj] = *(const u32x2*)(G8 + row * 2048 + (PASS - 1) * 1024 + c);
                if (PASS == 2) t[m][bj] = *(const u32x4*)(MERGED + row * 1024 + c); }
    }
    template <int AI> __device__ __forceinline__ void calc(const f32x4 (&acc)[2][2][4][2], const u32x2 (&g)[4][2], u32x4 (&t)[4][2]) const {
#pragma unroll
        for (int m = 0; m < 4; ++m)
#pragma unroll
            for (int bj = 0; bj < 2; ++bj) { const unsigned ga = g[m][bj].x, gb = g[m][bj].y;
                const f32x4 sa = (f32x4){(float)(ga & 255u), (float)((ga >> 8) & 255u), (float)((ga >> 16) & 255u), (float)(ga >> 24)} * (1.0f / 255.0f);
                const f32x4 sb = (f32x4){(float)(gb & 255u), (float)((gb >> 8) & 255u), (float)((gb >> 16) & 255u), (float)(gb >> 24)} * (1.0f / 255.0f);
                f32x4 oa = acc[AI][bj][m][0] * sa, ob = acc[AI][bj][m][1] * sb;
                if (PASS == 2) { oa = oa + up4((u32x2){t[m][bj].x, t[m][bj].y}); ob = ob + up4((u32x2){t[m][bj].z, t[m][bj].w}); }
                const u32x2 pa = dn4(oa), pb = dn4(ob); t[m][bj] = (u32x4){pa.x, pa.y, pb.x, pb.y}; }
    }
    template <int AI> __device__ __forceinline__ void store(const u32x4 (&o)[4][2], int row0, int c0) const {
#pragma unroll
        for (int m = 0; m < 4; ++m)
#pragma unroll
            for (int bj = 0; bj < 2; ++bj) ST16S<SC1_MIX>(MERGED + (size_t)(row0 + AI * HALF + m * 16) * 1024 + c0 + bj * HALF, o[m][bj]);
    }
    __device__ __forceinline__ void operator()(const f32x4 (&acc)[2][2][4][2], const Unit& u, int wr, int wc, int fr, int fq) const {
        const int row0 = u.pm * BM + wr * 64 + fr, c0 = u.pn * BM + wc * 32 + 8 * fq;
        u32x2 g0[4][2], g1[4][2]; u32x4 t0[4][2], t1[4][2];
        load<0>(g0, t0, row0, c0); calc<0>(acc, g0, t0);
        load<1>(g1, t1, row0, c0);
        store<0>(t0, row0, c0);
        calc<1>(acc, g1, t1); store<1>(t1, row0, c0);
    }
};
struct EpiRes {
    static constexpr bool PERM = false, AFTER_DRAIN = false;
    bf16_t* HB; float* ssacc;
    __device__ __forceinline__ void operator()(const f32x4 (&acc)[2][2][4][2], const Unit& u, int wr, int wc, int fr, int fq) const {
        const int row0 = u.pm * BM + wr * 64 + fr, c0 = u.pn * BM + wc * 32 + 4 * fq;
        u32x2 b[2][4][2][2];
#pragma unroll
        for (int ai = 0; ai < 2; ++ai)
#pragma unroll
            for (int m = 0; m < 4; ++m)
#pragma unroll
                for (int bj = 0; bj < 2; ++bj)
#pragma unroll
                    for (int n = 0; n < 2; ++n) b[ai][m][bj][n] = *(const u32x2*)(HB + (size_t)(row0 + ai * HALF + m * 16) * 1024 + c0 + bj * HALF + n * 16);
#pragma unroll
        for (int ai = 0; ai < 2; ++ai)
#pragma unroll
            for (int m = 0; m < 4; ++m) {
                const int row = row0 + ai * HALF + m * 16; float sq = 0.f;
#pragma unroll
                for (int bj = 0; bj < 2; ++bj)
#pragma unroll
                    for (int n = 0; n < 2; ++n) {
                        const u32x2 p = dn4(up4(b[ai][m][bj][n]) + acc[ai][bj][m][n]); const f32x4 v = up4(p);
                        ST8S<SC1_RES>(HB + (size_t)row * 1024 + c0 + bj * HALF + n * 16, p); sq += dot4(v, v);
                    }
                sq += shx(sq, 16); sq += shx(sq, 32);
                if (fq == 0) ssacc[(size_t)row * 16 + u.pn * 4 + wc] = sq;
            }
    }
};
typedef float f32x2 __attribute__((ext_vector_type(2)));
__device__ __forceinline__ f32x2 gelu_pk2(f32x2 v) {
    const f32x2 av = __builtin_elementwise_abs(v), d = av * 0.2316418882f + 1.0f;
    f32x2 t; t.x = __builtin_amdgcn_rcpf(d.x); t.y = __builtin_amdgcn_rcpf(d.y);
    f32x2 q = t * 0.5307027145f + (-0.7265760135f); q = q * t + 0.7107068705f; q = q * t + (-0.142248368f); q = q * t + 0.127414796f; q = q * t;
    const f32x2 s2 = (v * v) * (-0.72134752044f);
    f32x2 e; e.x = __builtin_amdgcn_exp2f(s2.x); e.y = __builtin_amdgcn_exp2f(s2.y);
    const f32x2 m = v * (q * e), r = v - m;
    f32x2 o; o.x = v.x < 0.f ? m.x : r.x; o.y = v.y < 0.f ? m.y : r.y; return o;
}
__device__ __forceinline__ f32x4 gelu4(f32x4 c) { const f32x2 g0 = gelu_pk2((f32x2){c.x, c.y}), g1 = gelu_pk2((f32x2){c.z, c.w}); return (f32x4){g0.x, g0.y, g1.x, g1.y}; }
template <int CTRL> __device__ __forceinline__ f32x4 ror4(f32x4 x) { f32x4 r;
#pragma unroll
    for (int e = 0; e < 4; ++e) { const float xe = x[e]; const int xi = __builtin_bit_cast(int, xe); r[e] = __builtin_bit_cast(float, __builtin_amdgcn_update_dpp(xi, xi, CTRL, 0xf, 0xf, false)); }
    return r; }
struct EpiUp {
    static constexpr bool PERM = true, AFTER_DRAIN = false;
    bf16_t* ACT; bf16_t* RAWH; const float* ss; const float* cw; const float* cb; PG8_LAS float* rsl;
    __device__ __forceinline__ void operator()(const f32x4 (&acc)[2][2][4][2], const Unit& u, int wr, int wc, int fr, int fq) const {
        const int tid = (wr * 4 + wc) * 64 + fq * 16 + fr, row0 = u.pm * BM + wr * 64 + fr;
        PG8_LAS float* wl = rsl + 256;
        if (tid >= 256 && tid < 384) { const int j = tid - 256, cg = u.pn * HALF + j; wl[j] = cw[cg]; wl[128 + j] = cw[FF + cg]; wl[256 + j] = cw[2 * FF + cg]; wl[384 + j] = cb[cg]; }
        rs_to_lds<16>(rsl, ss, u.pm, 1.0f / 1024.0f, 1.0f, tid);
        const int cl = wc * 32 + 8 * fq, cgl = u.pn * HALF + cl;
#pragma unroll
        for (int ai = 0; ai < 2; ++ai) {
            f32x4 q1a, q1b, q2a, q2b;
#pragma unroll
            for (int m = 0; m < 4; ++m) {
                const int row = row0 + ai * HALF + m * 16;
                const float rs = rsl[wr * 64 + ai * HALF + m * 16 + fr];
                const PG8_LAS float* wp = wl + cl; asm volatile("" : "+v"(wp));
                const f32x4 w0a = *(const PG8_LAS f32x4*)(wp), w0b = *(const PG8_LAS f32x4*)(wp + 4), w1a = *(const PG8_LAS f32x4*)(wp + 128), w1b = *(const PG8_LAS f32x4*)(wp + 128 + 4);
                const f32x4 w2a = *(const PG8_LAS f32x4*)(wp + 256), w2b = *(const PG8_LAS f32x4*)(wp + 256 + 4), ba = *(const PG8_LAS f32x4*)(wp + 384), bb = *(const PG8_LAS f32x4*)(wp + 384 + 4);
                const f32x4 xa = acc[ai][0][m][0] * rs, xb = acc[ai][0][m][1] * rs, va = acc[ai][1][m][0] * rs, vb = acc[ai][1][m][1] * rs;
                const f32x4 r1a = ror4<0x121>(xa), r1b = ror4<0x121>(xb), r2a = ror4<0x122>(xa), r2b = ror4<0x122>(xb);
                f32x4 p1a = r1a, p1b = r1b, p2a = r2a, p2b = r2b;
                if (m > 0) { if (fr < 1) { p1a = q1a; p1b = q1b; } if (fr < 2) { p2a = q2a; p2b = q2b; } }
                const f32x4 ga = gelu4(ba + w0a * p2a + w1a * p1a + w2a * xa), gb = gelu4(bb + w0b * p2b + w1b * p1b + w2b * xb);
                if (m > 0 || fr >= 2) ST16W(ACT + (size_t)row * FF + cgl, pack8(ga * va, gb * vb));
                if (m == 0) { if (fr < 2) { bf16_t* hp = RAWH + ((size_t)(row >> 6) * 6 + 2 + fr) * FF + cgl; *(u32x4*)hp = pack8(xa, xb); *(u32x4*)(hp + 2 * FF) = pack8(va, vb); } }
                if (m == 3) { if (fr >= 14) *(u32x4*)(RAWH + ((size_t)(row >> 6) * 6 + (fr - 14)) * FF + cgl) = pack8(xa, xb); }
                q1a = r1a; q1b = r1b; q2a = r2a; q2b = r2b;
            }
        }
    }
};
struct EpiUpG {
    static constexpr bool PERM = true, AFTER_DRAIN = false;
    bf16_t* UG; const float* ss; PG8_LAS float* rsl;
    __device__ __forceinline__ void operator()(const f32x4 (&acc)[2][2][4][2], const Unit& u, int wr, int wc, int fr, int fq) const {
        const int row0 = u.pm * BM + wr * 64 + fr;
        rs_to_lds<16>(rsl, ss, u.pm, 1.0f / 1024.0f, 1.0f, (wr * 4 + wc) * 64 + fq * 16 + fr);
#pragma unroll
        for (int ai = 0; ai < 2; ++ai)
#pragma unroll
            for (int m = 0; m < 4; ++m) {
                const int row = row0 + ai * HALF + m * 16;
                const float rs = rsl[wr * 64 + ai * HALF + m * 16 + fr];
#pragma unroll
                for (int bj = 0; bj < 2; ++bj) ST16(UG + (size_t)row * FF + u.pn * BM + bj * HALF + wc * 32 + 8 * fq, pack8(acc[ai][bj][m][0] * rs, acc[ai][bj][m][1] * rs));
            }
    }
};
struct EpiUpV {
    static constexpr bool PERM = true, AFTER_DRAIN = false;
    bf16_t* ACT; const float* ss; PG8_LAS float* rsl;
    __device__ __forceinline__ void operator()(const f32x4 (&acc)[2][2][4][2], const Unit& u, int wr, int wc, int fr, int fq) const {
        const int row0 = u.pm * BM + wr * 64 + fr, c0 = u.pn * BM + wc * 32 + 8 * fq;
        u32x4 gc[2][4][2];
#pragma unroll
        for (int ai = 0; ai < 2; ++ai)
#pragma unroll
            for (int m = 0; m < 4; ++m)
#pragma unroll
                for (int bj = 0; bj < 2; ++bj) gc[ai][m][bj] = *(const u32x4*)(ACT + (size_t)(row0 + ai * HALF + m * 16) * FF + c0 + bj * HALF);
        rs_to_lds<16>(rsl, ss, u.pm, 1.0f / 1024.0f, 1.0f, (wr * 4 + wc) * 64 + fq * 16 + fr);
#pragma unroll
        for (int ai = 0; ai < 2; ++ai)
#pragma unroll
            for (int m = 0; m < 4; ++m) {
                const int row = row0 + ai * HALF + m * 16;
                const float rs = rsl[wr * 64 + ai * HALF + m * 16 + fr];
#pragma unroll
                for (int bj = 0; bj < 2; ++bj) { const u32x4 g = gc[ai][m][bj];
                    *(u32x4*)(ACT + (size_t)row * FF + c0 + bj * HALF) = pack8(up4((u32x2){g.x, g.y}) * (acc[ai][bj][m][0] * rs), up4((u32x2){g.z, g.w}) * (acc[ai][bj][m][1] * rs)); }
            }
    }
};
}


#ifndef NAIVE_GEMM
#define NAIVE_GEMM 0
#endif
#ifndef NAIVE_ATTN
#define NAIVE_ATTN 0
#endif
#ifndef SHFL_SCAN
#define SHFL_SCAN 0
#endif
namespace pg8 {
template <class Epi, class Sched>
__device__ __forceinline__ void gemm_phase_naive(const Gemm g, const Sched& S, const Epi& E) {
    const int tid = vtid(), wid = tid >> 6, lane = tid & 63, wr = wid >> 2, wc = wid & 3, fr = lane & 15, fq = lane >> 4;
    Unit u;
    for (int i = 0; S.next(i, u); ++i) {
        f32x4 acc[2][2][4][2];
        _Pragma("unroll") for (int a = 0; a < 2; ++a) _Pragma("unroll") for (int b = 0; b < 2; ++b) _Pragma("unroll") for (int m = 0; m < 4; ++m) _Pragma("unroll") for (int n = 0; n < 2; ++n) {
            const int row = u.pm * BM + a * HALF + wr * 64 + m * 16 + fr;
            _Pragma("unroll") for (int j = 0; j < 4; ++j) {
                const int col = u.pn * BM + b * HALF + wc * 32 + (Epi::PERM ? 8 * fq + 4 * n + j : 16 * n + 4 * fq + j);
                const bf16_t* ap = g.A + (size_t)row * g.lda; const bf16_t* bp = g.Bt + (size_t)col * g.K;
                float s = 0.f;
                _Pragma("unroll 1") for (int k = 0; k < g.K; k += 8) {
                    const u32x4 av = *(const u32x4*)(ap + k), bv = *(const u32x4*)(bp + k);
                    for (int e = 0; e < 4; ++e) { s += __uint_as_float(av[e] << 16) * __uint_as_float(bv[e] << 16); s += __uint_as_float(av[e] & 0xffff0000u) * __uint_as_float(bv[e] & 0xffff0000u); }
                }
                acc[a][b][m][n][j] = s;
            }
        }
        E(acc, u, wr, wc, fr, fq);
    }
}
}
#if NAIVE_GEMM
#define GEMM_PHASE(EPI, lds, g, S, E) pg8::gemm_phase_naive<EPI, pg8::StaticOrder>(g, S, E)
#else
#define GEMM_PHASE(EPI, lds, g, S, E) pg8::gemm_phase<EPI, pg8::StaticOrder, true, true>(lds, g, S, E)
#endif
struct Args {
    const float* in[28]; float* out; unsigned char* ws; int ph_lo, ph_hi;
};
enum { I_X = 0, I_POS, I_ATTN_NORM, I_W_IN, I_MU, I_DBASE, I_W_DEC, I_IBASE, I_W_ICLR, I_W_GATE, I_KK, I_KA, I_RK, I_LNXW, I_LNXB, I_W_ORWKV, I_QNORM, I_W_QUP,
       I_KVNORM, I_W_KVUP, I_W_OMLA, I_W_OUT, I_FFN_NORM, I_W_UP, I_CONVW, I_CONVB, I_W_DOWN, I_FINAL };

typedef const __attribute__((address_space(4))) Args* ArgsP;
__device__ __forceinline__ ArgsP args_ptr() { ArgsP p = (ArgsP)__builtin_amdgcn_kernarg_segment_ptr(); asm volatile("" : "+s"(p)); return p; }
__device__ __forceinline__ int ltid() { int t = vtid(); asm volatile("" : "+v"(t)); return t; }
constexpr int NWAVES = 8, NTHREADS = 512;
constexpr int RING_BYTES = 131072, MISC_OFF = RING_BYTES + 320, LDS_BYTES = 147456;

__device__ __forceinline__ void tr_item(const float* W, int N, int k0, int n0, bf16_t* dst, int mode, int roff, int ldk, int koff, const float* scale, LAS float* scr, int lane) {
    const int kq = lane >> 4, n4 = (lane & 15) * 4;
    f32x4 v[8];
#pragma unroll
    for (int i = 0; i < 8; ++i) v[i] = (n0 + n4 < N) ? *(const f32x4*)(W + (size_t)(k0 + kq + 4 * i) * N + n0 + n4) : (f32x4){0.f, 0.f, 0.f, 0.f};
#pragma unroll
    for (int i = 0; i < 8; ++i) { const int kk = kq + 4 * i; f32x4 x = v[i]; if (scale) x = x * scale[k0 + kk];
        LAS float* p = scr + kk * 65 + n4; p[0] = x.x; p[1] = x.y; p[2] = x.z; p[3] = x.w; }
    asm volatile("s_waitcnt lgkmcnt(0)" ::: "memory");
    const LAS float* s = scr + lane;
    const int n = n0 + lane;
    int drow = n;
    if (mode == 1) drow = n < 2208 ? n : n + 96;
    else if (mode == 2) { const int h = n / 96, j = n % 96; drow = j < 64 ? h * 64 + j : 512 + h * 32 + (j - 64); }
    else if (mode == 3) { const int h = n >> 7, j = n & 127; drow = j < 64 ? h * 64 + j : 512 + h * 64 + (j - 64); }
    else if (mode == 4) { const int v = n < FF ? n : n - FF; drow = (v >> 7) * 256 + (n < FF ? 0 : 128) + (v & 127); }
    bf16_t* d = dst + (size_t)(drow + roff) * ldk + koff + k0;
    if (n < N)
#pragma unroll
    for (int c = 0; c < 4; ++c) { u32x4 o; o.x = pk2(s[(8 * c + 0) * 65], s[(8 * c + 1) * 65]); o.y = pk2(s[(8 * c + 2) * 65], s[(8 * c + 3) * 65]); o.z = pk2(s[(8 * c + 4) * 65], s[(8 * c + 5) * 65]); o.w = pk2(s[(8 * c + 6) * 65], s[(8 * c + 7) * 65]);
        *(u32x4*)(d + 8 * c) = o; }
    asm volatile("s_waitcnt lgkmcnt(0)" ::: "memory");
}
__device__ __forceinline__ void phase_weights(ArgsP a, int l, LAS unsigned char* lds) {
    a = args_ptr();
    const int tid = ltid(), lane = tid & 63, wave = tid >> 6;
    const int gw = blockIdx.x * NWAVES + wave, NGW = gridDim.x * NWAVES;
    LAS float* scr = (LAS float*)(lds + wave * 16384);
    unsigned char* wb = a->ws + WS_W;
    bf16_t* Wt_in = (bf16_t*)(wb + W_IN); bf16_t* Wt_lora = (bf16_t*)(wb + W_LORA); bf16_t* Wt_q = (bf16_t*)(wb + W_Q); bf16_t* Wt_kv = (bf16_t*)(wb + W_KV);
    bf16_t* Wt_oa = (bf16_t*)(wb + W_OA); bf16_t* Wt_ob = (bf16_t*)(wb + W_OB); bf16_t* Wt_out = (bf16_t*)(wb + W_OUT); bf16_t* Wt_up = (bf16_t*)(wb + W_UP); bf16_t* Wt_down = (bf16_t*)(wb + W_DOWN);
    constexpr int I_IN = 32 * 67, I_DEC = 2 * 8, I_ICL = 2 * 8, I_GAT = 4 * 8, I_Q = 8 * 12, I_KV = 4 * 16, I_OA = 16 * 16, I_OB = 16 * 16, I_OUT = 32 * 16, I_UP = 32 * 88, I_DN = 88 * 16;
    constexpr int NITEMS = I_IN + I_DEC + I_ICL + I_GAT + I_Q + I_KV + I_OA + I_OB + I_OUT + I_UP + I_DN;
    for (int it = gw; it < NITEMS; it += NGW) {
        int r = it;
        const float* W; const float* scale = nullptr; bf16_t* dst; int N, kb, nb, mode = 0, roff = 0, ldk, koff = 0;
        if (r < I_IN) { kb = r / 67; nb = r % 67; W = a->in[I_W_IN] + (size_t)l * 1024 * IN_COLS; N = IN_COLS; dst = Wt_in; mode = 1; ldk = 1024; scale = a->in[I_ATTN_NORM] + l * 1024; }
        else if ((r -= I_IN) < I_DEC) { kb = r / 8; nb = r % 8; W = a->in[I_W_DEC] + (size_t)l * 64 * 512; N = 512; dst = Wt_lora; ldk = 256; }
        else if ((r -= I_DEC) < I_ICL) { kb = r / 8; nb = r % 8; W = a->in[I_W_ICLR] + (size_t)l * 64 * 512; N = 512; dst = Wt_lora; roff = 512; ldk = 256; koff = 64; }
        else if ((r -= I_ICL) < I_GAT) { kb = r / 8; nb = r % 8; W = a->in[I_W_GATE] + (size_t)l * 128 * 512; N = 512; dst = Wt_lora; roff = 1024; ldk = 256; koff = 128; }
        else if ((r -= I_GAT) < I_Q) { kb = r / 12; nb = r % 12; W = a->in[I_W_QUP] + (size_t)l * 256 * 768; N = 768; dst = Wt_q; mode = 2; ldk = 256; scale = a->in[I_QNORM] + l * 256; }
        else if ((r -= I_Q) < I_KV) { kb = r / 16; nb = r % 16; W = a->in[I_W_KVUP] + (size_t)l * 128 * 1024; N = 1024; dst = Wt_kv; mode = 3; ldk = 256; scale = a->in[I_KVNORM] + l * 128; }
        else if ((r -= I_KV) < I_OA) { kb = r / 16; nb = r % 16; W = a->in[I_W_ORWKV] + (size_t)l * 512 * 1024; N = 1024; dst = Wt_oa; ldk = 512; }
        else if ((r -= I_OA) < I_OB) { kb = r / 16; nb = r % 16; W = a->in[I_W_OMLA] + (size_t)l * 512 * 1024; N = 1024; dst = Wt_ob; ldk = 512; }
        else if ((r -= I_OB) < I_OUT) { kb = r / 16; nb = r % 16; W = a->in[I_W_OUT] + (size_t)l * 1024 * 1024; N = 1024; dst = Wt_out; ldk = 1024; }
        else if ((r -= I_OUT) < I_UP) { kb = r / 88; nb = r % 88; W = a->in[I_W_UP] + (size_t)l * 1024 * 2 * FF; N = 2 * FF; dst = Wt_up; mode = 4; ldk = 1024; scale = a->in[I_FFN_NORM] + l * 1024; }
        else { r -= I_UP; kb = r / 16; nb = r % 16; W = a->in[I_W_DOWN] + (size_t)l * FF * 1024; N = 1024; dst = Wt_down; ldk = FF; }
        tr_item(W, N, kb * 32, nb * 64, dst, mode, roff, ldk, koff, scale, scr, lane);
    }
    const int gt = blockIdx.x * NTHREADS + tid, NGT = gridDim.x * NTHREADS;
    unsigned z0_ = 0u; asm volatile("" : "+v"(z0_));
    const u32x4 z = (u32x4){z0_, z0_, z0_, z0_};
    for (int i = gt; i < 96 * 128; i += NGT) *(u32x4*)(Wt_in + (size_t)(2208 + i / 128) * 1024 + (i % 128) * 8) = z;
    for (int i = gt; i < 1536 * 32; i += NGT) { const int row = i / 32, k8 = (i % 32) * 8, kind = row >> 9; const bool live = kind == 0 ? (k8 < 64) : (kind == 1 ? (k8 >= 64 && k8 < 128) : (k8 >= 128)); if (!live) *(u32x4*)(Wt_lora + (size_t)row * 256 + k8) = z; }
    for (int i = gt; i < 1024 * 16; i += NGT) *(u32x4*)(Wt_kv + (size_t)(i / 16) * 256 + 128 + (i % 16) * 8) = z;
#ifdef SCRIBBLE
    if (l == 0) { u32x4* p = (u32x4*)(a->ws + WS_ACT); const u32x4 pz = (u32x4){0xAAAAAAAAu, 0xAAAAAAAAu, 0xAAAAAAAAu, 0xAAAAAAAAu};
        for (unsigned i = gt; i < 178u * 65536u; i += NGT) p[i] = pz; }
#endif
    if (l == 0) {
        float* SS0 = (float*)(a->ws + WS_SSP); bf16_t* HB = (bf16_t*)(a->ws + A_HB);
        for (int m = gw; m < M; m += NGW) {
            const f32x4* xr = (const f32x4*)(a->in[I_X] + (size_t)m * DM) + lane; float s = 0.f;
            u32x2* o = (u32x2*)(HB + (size_t)m * DM) + lane;
#pragma unroll
            for (int j = 0; j < 4; ++j) { const f32x4 v = xr[64 * j]; s += dot4(v, v); o[64 * j] = dn4(v); }
#pragma unroll
            for (int o2 = 1; o2 < 64; o2 <<= 1) s += shx(s, o2);
            if (lane < 16) SS0[(size_t)m * 16 + lane] = lane == 0 ? s : 0.f;
        }
        float* CS = (float*)(a->ws + WS_CS); const int* pos = (const int*)a->in[I_POS];
        for (int i = gt; i < M * 16; i += NGT) { const int row = i >> 4, f = i & 15;
            const float invf = exp2f(-0.830482023721841f * (float)f);
            const float ang = (float)pos[row] * invf;
            const float k = rintf(ang * 0.15915494309189535f);
            float rr = fmaf(-k, 6.2831854820251465f, ang); rr = fmaf(-k, -1.7484555314695172e-07f, rr);
            CS[(size_t)row * 32 + f] = cosf(rr); CS[(size_t)row * 32 + 16 + f] = sinf(rr); }
    }
}

__device__ __forceinline__ void phase_prep(ArgsP a, int l) {
    a = args_ptr();
    const unsigned gt = blockIdx.x * NTHREADS + ltid(), NGT = gridDim.x * NTHREADS;
    const bf16_t* LORAC = (const bf16_t*)(a->ws + A_LORAC); bf16_t* LIN = (bf16_t*)(a->ws + A_LIN);
    {
        const int j = (gt & 31) * 8; const float* mu = a->in[I_MU] + (size_t)l * 1792 + 1536 + j;
        const f32x4 m0 = *(const f32x4*)mu, m1 = *(const f32x4*)(mu + 4);
        for (unsigned i = gt; i < (unsigned)M * 32; i += NGT) { const unsigned row = i >> 5; const int t = row & 4095;
            const u32x4 cu = *(const u32x4*)(LORAC + (size_t)row * 256 + j); const u32x4 pv = t ? *(const u32x4*)(LORAC + (size_t)(row - 1) * 256 + j) : (u32x4){0u, 0u, 0u, 0u};
            const f32x4 c0 = up4((u32x2){cu.x, cu.y}), c1 = up4((u32x2){cu.z, cu.w}), q0 = up4((u32x2){pv.x, pv.y}), q1 = up4((u32x2){pv.z, pv.w});
            f32x4 s0 = c0 + (q0 - c0) * m0, s1 = c1 + (q1 - c1) * m1;
            if (j < 64) { for (int e = 0; e < 4; ++e) { s0[e] = tanhf(s0[e]); s1[e] = tanhf(s1[e]); } } else if (j >= 128) { for (int e = 0; e < 4; ++e) { s0[e] = sigm(s0[e]); s1[e] = sigm(s1[e]); } }
            const u32x2 o0 = dn4(s0), o1 = dn4(s1); *(u32x4*)(LIN + (size_t)row * 256 + j) = (u32x4){o0.x, o0.y, o1.x, o1.y}; }
    }
    const bf16_t* PMb = (const bf16_t*)(a->ws + A_PM); bf16_t* KPE = (bf16_t*)(a->ws + A_KPE); const float* CS = (const float*)(a->ws + WS_CS);
    for (unsigned i = gt; i < (unsigned)M * 4; i += NGT) { const unsigned row = i >> 2; const int f = (i & 3) * 4;
        const f32x4 x1 = up4(*(const u32x2*)(PMb + (size_t)row * 512 + 384 + f)), x2 = up4(*(const u32x2*)(PMb + (size_t)row * 512 + 400 + f));
        const f32x4 cs = *(const f32x4*)(CS + (size_t)row * 32 + f), sn = *(const f32x4*)(CS + (size_t)row * 32 + 16 + f);
        *(u32x2*)(KPE + (size_t)row * 32 + f) = dn4(x1 * cs - x2 * sn); *(u32x2*)(KPE + (size_t)row * 32 + 16 + f) = dn4(x1 * sn + x2 * cs); }
}

template <int CTRL> __device__ __forceinline__ float dppf(float x) { return __builtin_bit_cast(float, __builtin_amdgcn_update_dpp(0, __builtin_bit_cast(int, x), CTRL, 0xf, 0xf, false)); }
#if SHFL_SCAN
__device__ __forceinline__ float rr16(float x) { x += shx(x, 8); x += shx(x, 4); x += shx(x, 2); x += shx(x, 1); return x; }
#else
__device__ __forceinline__ float rr16(float x) { x += dppf<0x128>(x); x += dppf<0x124>(x); x += dppf<0x122>(x); x += dppf<0x121>(x); return x; }
#endif

typedef float f32x2 __attribute__((ext_vector_type(2)));
constexpr int SC_BUF = 43008, SC_R = 0, SC_W = 8192, SC_K = 16384, SC_A = 24576, SC_B = 32768, SC_V = 40960, SC_YP = 2 * SC_BUF, SC_YPB = 8192;
struct ScOps { f32x4 a, w, b, k, r; float v; };
__device__ __forceinline__ void sc_ld(ScOps& o, const LAS unsigned char* bp, const LAS unsigned char* vp, int t) {
    o.a = *(const LAS f32x4*)(bp + SC_A + t * 256); o.w = *(const LAS f32x4*)(bp + SC_W + t * 256); o.b = *(const LAS f32x4*)(bp + SC_B + t * 256);
    o.k = *(const LAS f32x4*)(bp + SC_K + t * 256); o.r = *(const LAS f32x4*)(bp + SC_R + t * 256); o.v = *(const LAS float*)(vp + t * 64);
}
__device__ __forceinline__ void scan_unit(ArgsP a, int l, int bh, int q4, LAS unsigned char* lds, size_t y_off = A_Y) {
    a = args_ptr();
    const int tid = ltid(), lane = tid & 63, wid = __builtin_amdgcn_readfirstlane(tid >> 6);
    const int b = bh >> 3, h = bh & 7, i0 = q4 * 16;
    const bf16_t* RKV = (const bf16_t*)(a->ws + A_RKV); const bf16_t* LW = (const bf16_t*)(a->ws + A_LW); const bf16_t* ICLR = (const bf16_t*)(a->ws + A_ICLR);
    bf16_t* Y = (bf16_t*)(a->ws + y_off); float* SCAL = (float*)(a->ws + WS_SCAL);
    constexpr int NCH = SEQ / 32;
    if (wid >= 4) {
        const int ht = tid - 256, pcg = ht & 15, tau0 = ht >> 4, ch = h * 64 + 4 * pcg;
        const float* mu = a->in[I_MU] + (size_t)l * 1792;
        const f32x4 mu_r = *(const f32x4*)(mu + ch), mu_k = *(const f32x4*)(mu + 512 + ch), mu_v = *(const f32x4*)(mu + 1024 + ch);
        const f32x4 kk_c = *(const f32x4*)(a->in[I_KK] + l * 512 + ch), ka_c = *(const f32x4*)(a->in[I_KA] + l * 512 + ch), rk_c = *(const f32x4*)(a->in[I_RK] + l * 512 + ch);
        u32x2 g[2][8];
        const u32x2 z2 = (u32x2){0u, 0u};
#define SC_LOAD(c) do { _Pragma("unroll") for (int k_ = 0; k_ < 2; ++k_) { const int t_ = (c) * 32 + tau0 + 16 * k_; const size_t row_ = (size_t)b * SEQ + t_; \
            g[k_][0] = *(const u32x2*)(RKV + row_ * 1536 + ch); g[k_][1] = *(const u32x2*)(RKV + row_ * 1536 + 512 + ch); g[k_][2] = *(const u32x2*)(RKV + row_ * 1536 + 1024 + ch); \
            if (t_) { g[k_][3] = *(const u32x2*)(RKV + (row_ - 1) * 1536 + ch); g[k_][4] = *(const u32x2*)(RKV + (row_ - 1) * 1536 + 512 + ch); g[k_][5] = *(const u32x2*)(RKV + (row_ - 1) * 1536 + 1024 + ch); } \
            else { g[k_][3] = z2; g[k_][4] = z2; g[k_][5] = z2; } \
            g[k_][6] = *(const u32x2*)(LW + row_ * 512 + ch); g[k_][7] = *(const u32x2*)(ICLR + row_ * 512 + ch); } } while (0)
#define SC_STORE(c, p) do { _Pragma("unroll") for (int k_ = 0; k_ < 2; ++k_) { const int tau_ = tau0 + 16 * k_; LAS unsigned char* base_ = lds + (p) * SC_BUF + tau_ * 256 + pcg * 16; \
            const f32x4 r2 = up4(g[k_][0]), k2 = up4(g[k_][1]), v2 = up4(g[k_][2]); \
            const f32x4 r = r2 + (up4(g[k_][3]) - r2) * mu_r, k = k2 + (up4(g[k_][4]) - k2) * mu_k, v = v2 + (up4(g[k_][5]) - v2) * mu_v; \
            const f32x4 lw = up4(g[k_][6]), ic = up4(g[k_][7]); \
            f32x4 kk = k * kk_c; float ssum = dot4(kk, kk); ssum += shx(ssum, 1); ssum += shx(ssum, 2); ssum += shx(ssum, 4); ssum += shx(ssum, 8); \
            kk = kk * rsqrtf(ssum + 1e-12f); \
            const f32x4 kp = k * (1.0f + (ic - 1.0f) * ka_c); \
            float sc = dot4(r * kp, rk_c); sc += shx(sc, 1); sc += shx(sc, 2); sc += shx(sc, 4); sc += shx(sc, 8); \
            if (q4 == 0 && pcg == 0) SCAL[((size_t)b * SEQ + (c) * 32 + tau_) * 8 + h] = sc; \
            f32x4 w; w.x = __expf(lw.x * CK_LWZ); w.y = __expf(lw.y * CK_LWZ); w.z = __expf(lw.z * CK_LWZ); w.w = __expf(lw.w * CK_LWZ); \
            *(LAS f32x4*)(base_ + SC_R) = r; *(LAS f32x4*)(base_ + SC_W) = w; *(LAS f32x4*)(base_ + SC_K) = kp; *(LAS f32x4*)(base_ + SC_A) = -kk * CK_AB; *(LAS f32x4*)(base_ + SC_B) = kk * ic * CK_AB; \
            if ((pcg >> 2) == q4) *(LAS f32x4*)(lds + (p) * SC_BUF + SC_V + tau_ * 64 + (pcg & 3) * 16) = v; } } while (0)
        SC_LOAD(0); SC_STORE(0, 0); SC_LOAD(1);
        __syncthreads();
        for (int c = 0; c < NCH; ++c) {
            if (c + 1 < NCH) { SC_STORE(c + 1, (c + 1) & 1); if (c + 2 < NCH) SC_LOAD(c + 2); }
            if (c > 0) {
                const LAS f32x4* yp = (const LAS f32x4*)(lds + SC_YP + ((c - 1) & 1) * SC_YPB + (ht >> 3) * 256 + (ht & 7) * 32);
                const f32x4 y0 = yp[0], y1 = yp[1];
                *(unsigned*)(Y + ((size_t)b * SEQ + (c - 1) * 32 + (ht >> 3)) * 512 + h * 64 + i0 + 2 * (ht & 7)) = pk2((y0.x + y0.y) + (y0.z + y0.w), (y1.x + y1.y) + (y1.z + y1.w));
            }
            __syncthreads();
        }
        { const int c = NCH;
          const LAS f32x4* yp = (const LAS f32x4*)(lds + SC_YP + ((c - 1) & 1) * SC_YPB + (ht >> 3) * 256 + (ht & 7) * 32);
          const f32x4 y0 = yp[0], y1 = yp[1];
          *(unsigned*)(Y + ((size_t)b * SEQ + (c - 1) * 32 + (ht >> 3)) * 512 + h * 64 + i0 + 2 * (ht & 7)) = pk2((y0.x + y0.y) + (y0.z + y0.w), (y1.x + y1.y) + (y1.z + y1.w)); }
#undef SC_LOAD
#undef SC_STORE
    } else {
        const int rloc = wid * 4 + (lane >> 4), cgp = lane & 15;
        __syncthreads();
        f32x2 s01 = (f32x2){0.f, 0.f}, s23 = s01;
        for (int c = 0; c < NCH; ++c) {
            const int p = c & 1;
            const LAS unsigned char* bp = lds + p * SC_BUF + cgp * 16;
            const LAS unsigned char* vp = lds + p * SC_BUF + SC_V + rloc * 4;
            LAS float* ypw = (LAS float*)(lds + SC_YP + p * SC_YPB) + rloc * 4 + cgp;
            ScOps oa, ob;
            sc_ld(oa, bp, vp, 0);
#define SC_STEP(cur, nxt, t) do { if ((t) + 1 < 32) sc_ld(nxt, bp, vp, (t) + 1); if (CK_NOSTATE && ((t) & 15) == 0) { s01 = (f32x2){0.f, 0.f}; s23 = s01; } \
                const f32x2 vk0 = (f32x2){cur.k.x, cur.k.y} * cur.v, vk1 = (f32x2){cur.k.z, cur.k.w} * cur.v; \
                const f32x2 t0 = s01 * (f32x2){cur.w.x, cur.w.y} + vk0, t1 = s23 * (f32x2){cur.w.z, cur.w.w} + vk1; \
                f32x2 pd = s01 * (f32x2){cur.a.x, cur.a.y}; pd = s23 * (f32x2){cur.a.z, cur.a.w} + pd; \
                const float d = rr16(pd.x + pd.y); \
                s01 = (f32x2){cur.b.x, cur.b.y} * d + t0; s23 = (f32x2){cur.b.z, cur.b.w} * d + t1; \
                f32x2 qd = s01 * (f32x2){cur.r.x, cur.r.y}; qd = s23 * (f32x2){cur.r.z, cur.r.w} + qd; \
                float y = qd.x + qd.y; y += dppf<0x128>(y); y += dppf<0x124>(y); \
                if (cgp < 4) ypw[(t) * 64] = y; } while (0)
#pragma unroll 1
            for (int t = 0; t < 32; t += 2) { SC_STEP(oa, ob, t); SC_STEP(ob, oa, t + 1); }
#undef SC_STEP
            __syncthreads();
        }
    }
    __syncthreads();
}

typedef short s16x4v __attribute__((ext_vector_type(4)));
constexpr int CK_ROW = 144;
constexpr int CK_AT = 0, CK_RT = 2304, CK_BT = 4608, CK_KT = 6912, CK_VT = 9216, CK_GL = 11520, CK_OPB = 11776, CK_NOP = 5;
constexpr int CK_MT0 = CK_NOP * CK_OPB, CK_MAK = 0, CK_MRB = 512, CK_MRK = 1024, CK_TT = 1536, CK_MAB = 2048, CK_MTB = 2048 + 16 * 80, CK_NMT = 4;
constexpr int CK_YT0 = CK_MT0 + CK_NMT * CK_MTB, CK_YTB = 1024;
typedef short v4i16_t __attribute__((ext_vector_type(4)));
__device__ __forceinline__ s16x4v ldtr(const LAS unsigned char* p) { return __builtin_bit_cast(s16x4v, __builtin_amdgcn_ds_read_tr16_b64_v4i16((LAS v4i16_t*)p)); }
__device__ __forceinline__ s16x4v pk4(f32x4 v) { const u32x2 p = dn4(v); return __builtin_bit_cast(s16x4v, p); }
__device__ __forceinline__ void scan_unit_chunked(ArgsP a, int l, int bh, int q4, LAS unsigned char* lds, size_t y_off = A_Y) {
    a = args_ptr();
    const int tid = ltid(), lane = tid & 63, wid = __builtin_amdgcn_readfirstlane(tid >> 6);
    const int b = bh >> 3, h = bh & 7, i0 = q4 * 16, q = lane >> 4, l15 = lane & 15;
    const bf16_t* RKV = (const bf16_t*)(a->ws + A_RKV); const bf16_t* EG = (const bf16_t*)(a->ws + A_LW); const bf16_t* ICLR = (const bf16_t*)(a->ws + A_ICLR);
    bf16_t* Y = (bf16_t*)(a->ws + y_off); float* SCAL = (float*)(a->ws + WS_SCAL);
    constexpr int NCH = SEQ / 16;
    const int ht = tid - 256, t_h = (ht >> 4) & 15, jg = ht & 15, ch = h * 64 + 4 * jg;
    f32x4 mu_r, mu_k, mu_v, kk_c, ka_c, rk_c;
    u32x2 g[10], g1[10], g2[10];
    if (wid >= 4) {
        const float* mu = a->in[I_MU] + (size_t)l * 1792;
        mu_r = *(const f32x4*)(mu + ch); mu_k = *(const f32x4*)(mu + 512 + ch); mu_v = *(const f32x4*)(mu + 1024 + ch);
        kk_c = *(const f32x4*)(a->in[I_KK] + l * 512 + ch); ka_c = *(const f32x4*)(a->in[I_KA] + l * 512 + ch); rk_c = *(const f32x4*)(a->in[I_RK] + l * 512 + ch);
    }
#define CK_LOAD(G_, c) do { const int t_ = (c) * 16 + t_h; const size_t row_ = (size_t)b * SEQ + t_; const size_t rp_ = t_ ? row_ - 1 : row_; \
        G_[0] = *(const u32x2*)(RKV + row_ * 1536 + ch); G_[1] = *(const u32x2*)(RKV + row_ * 1536 + 512 + ch); G_[2] = *(const u32x2*)(RKV + row_ * 1536 + 1024 + ch); \
        G_[3] = *(const u32x2*)(RKV + rp_ * 1536 + ch); G_[4] = *(const u32x2*)(RKV + rp_ * 1536 + 512 + ch); G_[5] = *(const u32x2*)(RKV + rp_ * 1536 + 1024 + ch); \
        G_[6] = *(const u32x2*)(ICLR + row_ * 512 + ch); G_[7] = *(const u32x2*)(EG + row_ * 512 + ch); \
        G_[8] = *(const u32x2*)(EG + (row_ - (t_h ? 1 : 0)) * 512 + ch); G_[9] = *(const u32x2*)(EG + ((size_t)b * SEQ + (c) * 16 + 15) * 512 + ch); } while (0)
    f32x4 accS[4];
#pragma unroll
    for (int jt = 0; jt < 4; ++jt) accS[jt] = (f32x4){0.f, 0.f, 0.f, 0.f};
    float x[16];
#pragma unroll
    for (int t_ = 0; t_ < 16; ++t_) x[t_] = 0.f;
#define CK_OPSTAGE(G_, it) do { \
            if (it < NCH) { \
                LAS unsigned char* op = lds + (it % CK_NOP) * CK_OPB; \
                const f32x4 r2 = up4(G_[0]), k2 = up4(G_[1]), v2 = up4(G_[2]); \
                const float pz_ = (it * 16 + t_h) ? 1.0f : 0.0f; \
                const f32x4 r = r2 + (up4(G_[3]) * pz_ - r2) * mu_r, k = k2 + (up4(G_[4]) * pz_ - k2) * mu_k, v = v2 + (up4(G_[5]) * pz_ - v2) * mu_v, ic = up4(G_[6]); \
                const f32x4 eG = up4(G_[7]), eGL = up4(G_[9]); \
                f32x4 eGx = up4(G_[8]); if (t_h == 0) eGx = (f32x4){1.f, 1.f, 1.f, 1.f}; \
                f32x4 enG; \
_Pragma("unroll") \
                for (int e = 0; e < 4; ++e) enG[e] = __builtin_amdgcn_rcpf(eG[e]); \
                f32x4 kk = k * kk_c; const float ssum = rr16(dot4(kk, kk)); \
                kk = kk * rsqrtf(ssum + 1e-12f); \
                const f32x4 kp = k * (1.0f + (ic - 1.0f) * ka_c), bb = kk * ic; \
                const float sc = rr16(dot4(r * kp, rk_c)); \
                if (q4 == 0 && jg == 0) SCAL[((size_t)b * SEQ + it * 16 + t_h) * 8 + h] = sc; \
                *(LAS u32x2*)(op + CK_AT + t_h * CK_ROW + jg * 8) = dn4(-(kk * eGx)); \
                *(LAS u32x2*)(op + CK_RT + t_h * CK_ROW + jg * 8) = dn4(r * eG); \
                *(LAS u32x2*)(op + CK_BT + t_h * CK_ROW + jg * 8) = dn4(bb * enG); \
                *(LAS u32x2*)(op + CK_KT + t_h * CK_ROW + jg * 8) = dn4(kp * enG); \
                *(LAS u32x2*)(op + CK_VT + t_h * CK_ROW + jg * 8) = dn4(v); \
                if (t_h == 0) *(LAS f32x4*)(op + CK_GL + jg * 16) = eGL; \
            } \
            if (it + 3 < NCH) CK_LOAD(G_, it + 3); \
        } while (0)
    if (wid >= 4) { CK_LOAD(g, 0); CK_LOAD(g1, 1); CK_LOAD(g2, 2); }
#ifdef CK_TIME
    unsigned long long tb_ = 0, t0_ = 0; const unsigned long long tstart_ = __builtin_readcyclecounter();
#define CK_T0() (t0_ = __builtin_readcyclecounter())
#define CK_T1() (tb_ += __builtin_readcyclecounter() - t0_)
#else
#define CK_T0() do {} while (0)
#define CK_T1() do {} while (0)
#endif
    constexpr int NIT = ((NCH + 6 + 2) / 3) * 3;
    if (wid >= 4) {
#define CK_YSTORE(it) do { if (wid == 4 && (it) >= 5 && (it) - 5 < NCH) { \
            const LAS float* yt = (const LAS float*)(lds + CK_YT0 + (((it) - 5) & 1) * CK_YTB); const int t_ = lane >> 2, ip = (lane & 3) * 4; \
            const f32x4 yv = *(const LAS f32x4*)(yt + t_ * 16 + ip); \
            *(u32x2*)(Y + ((size_t)b * SEQ + ((it) - 5) * 16 + t_) * 512 + h * 64 + i0 + ip) = dn4(yv); } } while (0)
        for (int it3 = 0; it3 < NIT; it3 += 3) {
            CK_T0(); CK_OPSTAGE(g, it3); CK_YSTORE(it3); CK_T1(); __syncthreads();
            CK_T0(); CK_OPSTAGE(g1, (it3 + 1)); CK_YSTORE((it3 + 1)); CK_T1(); __syncthreads();
            CK_T0(); CK_OPSTAGE(g2, (it3 + 2)); CK_YSTORE((it3 + 2)); CK_T1(); __syncthreads();
        }
#undef CK_YSTORE
    } else
    for (int it = 0; it < NIT; ++it) {
        CK_T0();
        if (wid >= 1) {
            const int ph3 = (it + 3 - wid) % 3;
            const int c = it - 1 - ph3;
            if (c >= 0 && c < NCH) {
                const LAS unsigned char* op = lds + (c % CK_NOP) * CK_OPB; LAS unsigned char* mt = lds + CK_MT0 + (c % CK_NMT) * CK_MTB;
                if (ph3 == 0) {
                    const int ro = l15 * CK_ROW + q * 16;
                    const bf16x8 at0 = *(const LAS bf16x8*)(op + CK_AT + ro), at1 = *(const LAS bf16x8*)(op + CK_AT + ro + 64), rt0 = *(const LAS bf16x8*)(op + CK_RT + ro), rt1 = *(const LAS bf16x8*)(op + CK_RT + ro + 64);
                    const bf16x8 bt0 = *(const LAS bf16x8*)(op + CK_BT + ro), bt1 = *(const LAS bf16x8*)(op + CK_BT + ro + 64), kt0 = *(const LAS bf16x8*)(op + CK_KT + ro), kt1 = *(const LAS bf16x8*)(op + CK_KT + ro + 64);
                    const f32x4 z = (f32x4){0.f, 0.f, 0.f, 0.f};
                    f32x4 mab = __builtin_amdgcn_mfma_f32_16x16x32_bf16(at0, bt0, z, 0, 0, 0); mab = __builtin_amdgcn_mfma_f32_16x16x32_bf16(at1, bt1, mab, 0, 0, 0);
                    f32x4 mak = __builtin_amdgcn_mfma_f32_16x16x32_bf16(at0, kt0, z, 0, 0, 0); mak = __builtin_amdgcn_mfma_f32_16x16x32_bf16(at1, kt1, mak, 0, 0, 0);
                    f32x4 mrb = __builtin_amdgcn_mfma_f32_16x16x32_bf16(rt0, bt0, z, 0, 0, 0); mrb = __builtin_amdgcn_mfma_f32_16x16x32_bf16(rt1, bt1, mrb, 0, 0, 0);
                    f32x4 mrk = __builtin_amdgcn_mfma_f32_16x16x32_bf16(rt0, kt0, z, 0, 0, 0); mrk = __builtin_amdgcn_mfma_f32_16x16x32_bf16(rt1, kt1, mrk, 0, 0, 0);
#pragma unroll
                    for (int r = 0; r < 4; ++r) { const int t_ = 4 * q + r; const bool lo_ = l15 < t_, le_ = l15 <= t_;
                        *(LAS float*)(mt + CK_MAB + t_ * 80 + l15 * 4) = lo_ ? mab[r] : 0.f;
                        *(LAS bf16_t*)(mt + CK_MAK + t_ * 32 + l15 * 2) = (bf16_t)f2bf(lo_ ? mak[r] : 0.f);
                        *(LAS bf16_t*)(mt + CK_MRB + t_ * 32 + l15 * 2) = (bf16_t)f2bf(le_ ? mrb[r] : 0.f);
                        *(LAS bf16_t*)(mt + CK_MRK + t_ * 32 + l15 * 2) = (bf16_t)f2bf(le_ ? mrk[r] : 0.f); }
                } else {
#define CK_MLD(t_) f32x4 m_##t_[4]; _Pragma("unroll") for (int s4 = 0; s4 < (t_); s4 += 4) m_##t_[s4 >> 2] = *(const LAS f32x4*)(mt + CK_MAB + (t_) * 80 + s4 * 4)
#define CK_TROW(t_) do { float acc_ = (l15 == (t_)) ? 1.f : 0.f; \
                        _Pragma("unroll") for (int s4 = 0; s4 < (t_); s4 += 4) { \
                            _Pragma("unroll") for (int e = 0; e < 4; ++e) if (s4 + e < (t_)) acc_ += m_##t_[s4 >> 2][e] * x[s4 + e]; } \
                        x[t_] = acc_; } while (0)
                    if (ph3 == 1) { CK_MLD(1); CK_MLD(2); CK_MLD(3); CK_MLD(4); CK_MLD(5); CK_MLD(6); CK_MLD(7); CK_MLD(8); CK_MLD(9); CK_MLD(10);
                        x[0] = (l15 == 0) ? 1.f : 0.f; CK_TROW(1); CK_TROW(2); CK_TROW(3); CK_TROW(4); CK_TROW(5); CK_TROW(6); CK_TROW(7); CK_TROW(8); CK_TROW(9); CK_TROW(10); }
                    else { CK_MLD(11); CK_MLD(12); CK_MLD(13); CK_MLD(14); CK_MLD(15); CK_TROW(11); CK_TROW(12); CK_TROW(13); CK_TROW(14); CK_TROW(15);
                        if (q == 0) {
#pragma unroll
                            for (int t_ = 0; t_ < 16; ++t_) *(LAS bf16_t*)(mt + CK_TT + t_ * 32 + l15 * 2) = (bf16_t)f2bf(x[t_]); } }
#undef CK_TROW
#undef CK_MLD
                }
            }
        } else {
            const int c = it - 4;
            if (c >= 0 && c < NCH) {
                const LAS unsigned char* op = lds + (c % CK_NOP) * CK_OPB; const LAS unsigned char* mt = lds + CK_MT0 + (c % CK_NMT) * CK_MTB;
                s16x4v sb[4];
#pragma unroll
                for (int jt = 0; jt < 4; ++jt) { if (CK_NOSTATE) accS[jt] = (f32x4){0.f, 0.f, 0.f, 0.f}; sb[jt] = pk4(accS[jt]); }
                const int ao = l15 * CK_ROW + q * 8;
                const int tro = (4 * q + (l15 >> 2)) * CK_ROW + (l15 & 3) * 8;
                const s16x4v vb = ldtr(op + CK_VT + tro + i0 * 2);
                f32x4 x1 = (f32x4){0.f, 0.f, 0.f, 0.f}, x2 = x1;
#pragma unroll
                for (int jt = 0; jt < 4; ++jt) {
                    const s16x4v a0 = *(const LAS s16x4v*)(op + CK_AT + ao + jt * 32), r0 = *(const LAS s16x4v*)(op + CK_RT + ao + jt * 32);
                    x1 = __builtin_amdgcn_mfma_f32_16x16x16bf16_1k(a0, sb[jt], x1, 0, 0, 0);
                    x2 = __builtin_amdgcn_mfma_f32_16x16x16bf16_1k(r0, sb[jt], x2, 0, 0, 0);
                }
                const s16x4v mak = *(const LAS s16x4v*)(mt + CK_MAK + l15 * 32 + q * 8), mrb = *(const LAS s16x4v*)(mt + CK_MRB + l15 * 32 + q * 8);
                const s16x4v mrk = *(const LAS s16x4v*)(mt + CK_MRK + l15 * 32 + q * 8), tt = *(const LAS s16x4v*)(mt + CK_TT + l15 * 32 + q * 8);
                x1 = __builtin_amdgcn_mfma_f32_16x16x16bf16_1k(mak, vb, x1, 0, 0, 0);
                x2 = __builtin_amdgcn_mfma_f32_16x16x16bf16_1k(mrk, vb, x2, 0, 0, 0);
                const f32x4 u = __builtin_amdgcn_mfma_f32_16x16x16bf16_1k(tt, pk4(x1), (f32x4){0.f, 0.f, 0.f, 0.f}, 0, 0, 0);
                const s16x4v ub = pk4(u);
                const f32x4 yv = __builtin_amdgcn_mfma_f32_16x16x16bf16_1k(mrb, ub, x2, 0, 0, 0);
                const bf16x8 uv = (bf16x8){ub[0], ub[1], ub[2], ub[3], vb[0], vb[1], vb[2], vb[3]};
#pragma unroll
                for (int jt = 0; jt < 4; ++jt) {
                    const f32x4 gl = *(const LAS f32x4*)(op + CK_GL + (16 * jt + 4 * q) * 4);
                    const s16x4v b0 = ldtr(op + CK_BT + tro + jt * 32), k0 = ldtr(op + CK_KT + tro + jt * 32);
                    accS[jt] = __builtin_amdgcn_mfma_f32_16x16x32_bf16((bf16x8){b0[0], b0[1], b0[2], b0[3], k0[0], k0[1], k0[2], k0[3]}, uv, accS[jt], 0, 0, 0) * gl;
                }
                LAS float* yt = (LAS float*)(lds + CK_YT0 + (c & 1) * CK_YTB);
#pragma unroll
                for (int r = 0; r < 4; ++r) yt[(4 * q + r) * 16 + l15] = yv[r];
            }
        }
        CK_T1();
        __syncthreads();
    }
#ifdef CK_TIME
    if (blockIdx.x == 0 && l == 0 && lane == 0) { unsigned long long* tw = (unsigned long long*)(a->ws + WS_CTL) + 24000; tw[wid] = tb_; if (wid == 0) tw[8] = __builtin_readcyclecounter() - tstart_; }
#endif
#undef CK_LOAD
#undef CK_OPSTAGE
}

constexpr int WP_SUB = 4 * 2304 + 1280;
constexpr int CW_WPFLAG = 65536;
constexpr int CW_YFLAG = 72000;
__device__ __forceinline__ void ST2W(bf16_t* p, unsigned v) { asm volatile("global_store_short %0, %1, off sc1\n\ts_nop 1" :: "v"(p), "v"(v) : "memory"); }
__device__ __forceinline__ void phase_wkvprep(ArgsP a, int l, LAS unsigned char* lds, int first, int stride) {
    a = args_ptr(); first = __builtin_amdgcn_readfirstlane(first); stride = __builtin_amdgcn_readfirstlane(stride); asm volatile("" : "+s"(first), "+s"(stride));
    const int tid = ltid(), lane = tid & 63, wid = __builtin_amdgcn_readfirstlane(tid >> 6), sub = tid >> 8, ht = tid & 255, t_h = ht >> 4, jg = ht & 15, q = lane >> 4, l15 = lane & 15;
    bf16_t* RKV = (bf16_t*)(a->ws + A_RKV); bf16_t* EG = (bf16_t*)(a->ws + A_LW); bf16_t* ICLR = (bf16_t*)(a->ws + A_ICLR); float* SCAL = (float*)(a->ws + WS_SCAL);
    const bf16_t* HALO = (const bf16_t*)((const unsigned char*)a->out + DO_HALO); unsigned char* MTR = (unsigned char*)a->out + DO_MTREC;
    const float* mu = a->in[I_MU] + (size_t)l * 1792;
    u32x2 grA, gkA, gvA, prA, pkA, pvA, gicA, geA, gexA, gelA, grB, gkB, gvB, prB, pkB, pvB, gicB, geB, gexB, gelB;
#define WP_LOAD(S, idxx) do { const int idx_ = (idxx), bh_ = idx_ >> 8, c_ = idx_ & 255, ch_ = (bh_ & 7) * 64 + 4 * jg, t_ = c_ * 16 + t_h; const size_t row_ = (size_t)(bh_ >> 3) * SEQ + t_; const u32x2 z2_ = (u32x2){0u, 0u}; \
        gr##S = *(const u32x2*)(RKV + row_ * 1536 + ch_); gk##S = *(const u32x2*)(RKV + row_ * 1536 + 512 + ch_); gv##S = *(const u32x2*)(RKV + row_ * 1536 + 1024 + ch_); \
        pr##S = z2_; pk##S = z2_; pv##S = z2_; \
        if (t_h) { pr##S = *(const u32x2*)(RKV + (row_ - 1) * 1536 + ch_); pk##S = *(const u32x2*)(RKV + (row_ - 1) * 1536 + 512 + ch_); pv##S = *(const u32x2*)(RKV + (row_ - 1) * 1536 + 1024 + ch_); } \
        else if (t_) { const bf16_t* hp_ = HALO + ((row_ >> 4) - 1) * 1536; pr##S = *(const u32x2*)(hp_ + ch_); pk##S = *(const u32x2*)(hp_ + 512 + ch_); pv##S = *(const u32x2*)(hp_ + 1024 + ch_); } \
        gic##S = *(const u32x2*)(ICLR + row_ * 512 + ch_); ge##S = *(const u32x2*)(EG + row_ * 512 + ch_); gex##S = *(const u32x2*)(EG + (row_ - (t_h ? 1 : 0)) * 512 + ch_); gel##S = *(const u32x2*)(EG + (row_ - t_h + 15) * 512 + ch_); } while (0)
#ifndef WP_SC1
#define WP_SC1 1
#endif
#if WP_SC1
#define WPST(p_, v_) pg8::ST8W((p_), (v_))
#else
#define WPST(p_, v_) (*(u32x2*)(p_) = (v_))
#endif
#define WP_PASS(S, SN, ps) do { \
            const int idx = 8 * tr + 2 * (ps) + sub, bh = idx >> 8, c = idx & 255, b = bh >> 3, h = bh & 7, ch = h * 64 + 4 * jg; \
            const int t = c * 16 + t_h; const size_t row = (size_t)b * SEQ + t; \
            { const int qn_ = qq + stride; const int nidx = ((ps) < 3) ? idx + 2 : (qn_ < 1024 ? 8 * ((qn_ & 31) * 32 + (qn_ >> 5)) + sub : 8192); if (nidx < 8192) WP_LOAD(SN, nidx); }         \
            LAS unsigned char* op = lds + (2 * (ps) + sub) * WP_SUB; \
            const f32x4 mu_r = *(const f32x4*)(mu + ch), mu_k = *(const f32x4*)(mu + 512 + ch), mu_v = *(const f32x4*)(mu + 1024 + ch); \
            const f32x4 kk_c = *(const f32x4*)(a->in[I_KK] + l * 512 + ch), ka_c = *(const f32x4*)(a->in[I_KA] + l * 512 + ch), rk_c = *(const f32x4*)(a->in[I_RK] + l * 512 + ch); \
            const f32x4 r2 = up4(gr##S), k2 = up4(gk##S), v2 = up4(gv##S); \
            const f32x4 r = r2 + (up4(pr##S) - r2) * mu_r, k = k2 + (up4(pk##S) - k2) * mu_k, v = v2 + (up4(pv##S) - v2) * mu_v, ic = up4(gic##S); \
            const f32x4 eG = up4(ge##S), eGL = up4(gel##S); \
            f32x4 eGx = up4(gex##S); if (t_h == 0) eGx = (f32x4){1.f, 1.f, 1.f, 1.f}; \
            f32x4 enG; \
            _Pragma("unroll") for (int e = 0; e < 4; ++e) enG[e] = __builtin_amdgcn_rcpf(eG[e]); \
            f32x4 kk = k * kk_c; const float ssum = rr16(dot4(kk, kk)); \
            kk = kk * rsqrtf(ssum + 1e-12f); \
            const f32x4 kp = k * (1.0f + (ic - 1.0f) * ka_c), bb = kk * ic; \
            const float sc = rr16(dot4(r * kp, rk_c)); \
            const u32x2 oa = dn4(-(kk * eGx)), orr = dn4(r * eG), ob = dn4(bb * enG), ok = dn4(kp * enG), ov = dn4(v); \
            __syncthreads();                                         \
            *(LAS u32x2*)(op + CK_AT + t_h * CK_ROW + jg * 8) = oa; *(LAS u32x2*)(op + CK_RT + t_h * CK_ROW + jg * 8) = orr; \
            *(LAS u32x2*)(op + CK_BT + t_h * CK_ROW + jg * 8) = ob; *(LAS u32x2*)(op + CK_KT + t_h * CK_ROW + jg * 8) = ok; \
            WPST(RKV + row * 1536 + ch, oa); WPST(RKV + row * 1536 + 512 + ch, orr); WPST(RKV + row * 1536 + 1024 + ch, ov); \
            WPST(EG + row * 512 + ch, ob); WPST(ICLR + row * 512 + ch, ok); \
            if (jg == 0) __hip_atomic_store(SCAL + row * 8 + h, sc, __ATOMIC_RELAXED, __HIP_MEMORY_SCOPE_AGENT); \
            if (t_h == 0) pg8::ST16W((bf16_t*)(MTR + (size_t)idx * MTREC_B + 2048 + jg * 16), __builtin_bit_cast(u32x4, eGL)); \
        } while (0)
    unsigned* wpflag = (unsigned*)(a->ws + WS_CTL) + CW_WPFLAG + l * 1024;
    if (first < 1024) WP_LOAD(A, 8 * ((first & 31) * 32 + (first >> 5)) + sub);
    for (int qq = first; qq < 1024; qq += stride) {
        const int tr = (qq & 31) * 32 + (qq >> 5);
#pragma unroll 1
        for (int ps = 0; ps < 4; ps += 2) { WP_PASS(A, B, ps); WP_PASS(B, A, ps + 1); }
        __syncthreads();
        {
            const int idx = 8 * tr + wid;
            const LAS unsigned char* op = lds + wid * WP_SUB; LAS unsigned char* mt = lds + wid * WP_SUB + 4 * 2304;
            const int ro = l15 * CK_ROW + q * 16;
            const bf16x8 at0 = *(const LAS bf16x8*)(op + CK_AT + ro), at1 = *(const LAS bf16x8*)(op + CK_AT + ro + 64), rt0 = *(const LAS bf16x8*)(op + CK_RT + ro), rt1 = *(const LAS bf16x8*)(op + CK_RT + ro + 64);
            const bf16x8 bt0 = *(const LAS bf16x8*)(op + CK_BT + ro), bt1 = *(const LAS bf16x8*)(op + CK_BT + ro + 64), kt0 = *(const LAS bf16x8*)(op + CK_KT + ro), kt1 = *(const LAS bf16x8*)(op + CK_KT + ro + 64);
            const f32x4 z = (f32x4){0.f, 0.f, 0.f, 0.f};
            f32x4 mab = __builtin_amdgcn_mfma_f32_16x16x32_bf16(at0, bt0, z, 0, 0, 0); mab = __builtin_amdgcn_mfma_f32_16x16x32_bf16(at1, bt1, mab, 0, 0, 0);
            f32x4 mak = __builtin_amdgcn_mfma_f32_16x16x32_bf16(at0, kt0, z, 0, 0, 0); mak = __builtin_amdgcn_mfma_f32_16x16x32_bf16(at1, kt1, mak, 0, 0, 0);
            f32x4 mrb = __builtin_amdgcn_mfma_f32_16x16x32_bf16(rt0, bt0, z, 0, 0, 0); mrb = __builtin_amdgcn_mfma_f32_16x16x32_bf16(rt1, bt1, mrb, 0, 0, 0);
            f32x4 mrk = __builtin_amdgcn_mfma_f32_16x16x32_bf16(rt0, kt0, z, 0, 0, 0); mrk = __builtin_amdgcn_mfma_f32_16x16x32_bf16(rt1, kt1, mrk, 0, 0, 0);
            bf16_t* rec = (bf16_t*)(MTR + (size_t)idx * MTREC_B);
            LAS bf16_t* stg = (LAS bf16_t*)(lds + wid * WP_SUB);
            asm volatile("s_waitcnt lgkmcnt(0)" ::: "memory");
#pragma unroll
            for (int rr = 0; rr < 4; ++rr) { const int t_ = 4 * q + rr; const bool lo_ = l15 < t_, le_ = l15 <= t_;
                *(LAS float*)(mt + t_ * 80 + l15 * 4) = lo_ ? mab[rr] : 0.f;
                stg[t_ * 16 + l15] = (bf16_t)f2bf(lo_ ? mak[rr] : 0.f);
                stg[256 + t_ * 16 + l15] = (bf16_t)f2bf(le_ ? mrb[rr] : 0.f);
                stg[512 + t_ * 16 + l15] = (bf16_t)f2bf(le_ ? mrk[rr] : 0.f); }
            asm volatile("s_waitcnt lgkmcnt(0)" ::: "memory");
            float x[16];
#define WP_MLD(t_) f32x4 m_##t_[4]; _Pragma("unroll") for (int s4 = 0; s4 < (t_); s4 += 4) m_##t_[s4 >> 2] = *(const LAS f32x4*)(mt + (t_) * 80 + s4 * 4)
#define WP_TROW(t_) do { float acc_ = (l15 == (t_)) ? 1.f : 0.f; \
                _Pragma("unroll") for (int s4 = 0; s4 < (t_); s4 += 4) { _Pragma("unroll") for (int e = 0; e < 4; ++e) if (s4 + e < (t_)) acc_ += m_##t_[s4 >> 2][e] * x[s4 + e]; } \
                x[t_] = acc_; } while (0)
            x[0] = (l15 == 0) ? 1.f : 0.f;
            { WP_MLD(1); WP_MLD(2); WP_MLD(3); WP_MLD(4); WP_MLD(5); WP_MLD(6); WP_MLD(7); WP_TROW(1); WP_TROW(2); WP_TROW(3); WP_TROW(4); WP_TROW(5); WP_TROW(6); WP_TROW(7); }
            { WP_MLD(8); WP_MLD(9); WP_MLD(10); WP_MLD(11); WP_TROW(8); WP_TROW(9); WP_TROW(10); WP_TROW(11); }
            { WP_MLD(12); WP_MLD(13); WP_MLD(14); WP_MLD(15); WP_TROW(12); WP_TROW(13); WP_TROW(14); WP_TROW(15); }
#undef WP_TROW
#undef WP_MLD
            if (q == 0) {
#pragma unroll
                for (int t_ = 0; t_ < 16; ++t_) stg[768 + t_ * 16 + l15] = (bf16_t)f2bf(x[t_]); }
            asm volatile("s_waitcnt lgkmcnt(0)" ::: "memory");
            pg8::ST16W(rec + lane * 8, *(const LAS u32x4*)((const LAS unsigned char*)stg + lane * 16));
            pg8::ST16W(rec + 512 + lane * 8, *(const LAS u32x4*)((const LAS unsigned char*)stg + 1024 + lane * 16));
        }
        asm volatile("s_waitcnt vmcnt(0)" ::: "memory");
        __syncthreads();
        if (tid == 0) __hip_atomic_store(wpflag + tr, 1u, __ATOMIC_RELAXED, __HIP_MEMORY_SCOPE_AGENT);
    }
#undef WP_LOAD
#undef WP_PASS
}

constexpr int WS_SLOT = 5 * 2048 + 3 * 1024, WS_NSLOT = 8, WS_DEPTH = 7, WS_YT = WS_NSLOT * WS_SLOT;
__device__ __forceinline__ void glds16(const void* gsrc, unsigned lds_dst) { unsigned keep;
    asm volatile("s_mov_b32 %0, m0\n\ts_mov_b32 m0, %2\n\ts_nop 0\n\tglobal_load_lds_dwordx4 %1, off\n\ts_mov_b32 m0, %0" : "=&s"(keep) : "v"(gsrc), "s"(lds_dst) : "memory"); }
__device__ __forceinline__ void scan_unit_stream(ArgsP a, int l, int bh, LAS unsigned char* lds) {
    a = args_ptr();
    const int tid = ltid(), lane = tid & 63, wid = __builtin_amdgcn_readfirstlane(tid >> 6), q = lane >> 4, l15 = lane & 15;
    const int b = bh >> 3, h = bh & 7;
    const unsigned char* RKVb = a->ws + A_RKV; const unsigned char* EGb = a->ws + A_LW; const unsigned char* ICb = a->ws + A_ICLR;
    const unsigned char* MTR = (const unsigned char*)a->out + DO_MTREC + (size_t)bh * 256 * MTREC_B;
    bf16_t* Y = (bf16_t*)(a->ws + A_Y);
    unsigned* yflag = (unsigned*)(a->ws + WS_CTL) + CW_YFLAG + l * 1024 + bh * 32;
    constexpr int NCH = SEQ / 16;
    const unsigned lds0 = (unsigned)(uintptr_t)lds;
    if (wid >= 4) {
        const int w = wid - 4, rw = lane >> 3, c16 = ((lane & 7) ^ rw) * 16;
        const int np = (w == 0) ? 4 : 3;
#define WS_ISSUE(cc) do { const size_t row0_ = (size_t)b * SEQ + (size_t)(cc) * 16; const unsigned slot_ = lds0 + (unsigned)(((cc) % WS_NSLOT) * WS_SLOT); \
            _Pragma("unroll") for (int k_ = 0; k_ < 4; ++k_) { const int p_ = w + 4 * k_; if (p_ < 13) { const void* src_; \
                if (p_ < 10) { const int tl_ = p_ >> 1; const size_t r_ = row0_ + 8 * (p_ & 1) + rw; \
                    src_ = tl_ < 3 ? (const void*)(RKVb + (r_ * 1536 + tl_ * 512 + h * 64) * 2 + c16) : (tl_ == 3 ? (const void*)(EGb + (r_ * 512 + h * 64) * 2 + c16) : (const void*)(ICb + (r_ * 512 + h * 64) * 2 + c16)); } \
                else src_ = (const void*)(MTR + (size_t)(cc) * MTREC_B + (p_ - 10) * 1024 + lane * 16); \
                glds16(src_, (unsigned)__builtin_amdgcn_readfirstlane(slot_ + (unsigned)(p_ < 10 ? (p_ >> 1) * 2048 + (p_ & 1) * 1024 : 10240 + (p_ - 10) * 1024))); } } } while (0)
        unsigned* wpflag = (unsigned*)(a->ws + WS_CTL) + CW_WPFLAG + l * 1024 + bh * 32;
        unsigned* tmo = (unsigned*)(a->ws + WS_CTL) + CW_BAR + XB_TMO;
#define WS_GATE(cc) do { if (((cc) & 7) == 0) { unsigned sp_ = 0; \
            while ((unsigned)__builtin_amdgcn_readfirstlane(__hip_atomic_load(wpflag + ((cc) >> 3), __ATOMIC_RELAXED, __HIP_MEMORY_SCOPE_AGENT)) == 0u) { __builtin_amdgcn_s_sleep(2); \
                if ((++sp_ & 255u) == 0u) { if (xb_ld(tmo)) break; if (sp_ > XB_SPIN_CAP) { atomicAdd(tmo, 1u); break; } } } \
            __builtin_amdgcn_fence(__ATOMIC_ACQUIRE, "agent"); } } while (0)
        WS_GATE(0);
#pragma unroll
        for (int cc = 0; cc < WS_DEPTH; ++cc) WS_ISSUE(cc);
        if (w == 0) asm volatile("s_waitcnt vmcnt(24)" ::: "memory"); else asm volatile("s_waitcnt vmcnt(18)" ::: "memory");
        __syncthreads();
        for (int it = 0; it < NCH; ++it) {
            if (it + WS_DEPTH < NCH) { WS_GATE(it + WS_DEPTH); WS_ISSUE(it + WS_DEPTH); if (w == 0) asm volatile("s_waitcnt vmcnt(24)" ::: "memory"); else asm volatile("s_waitcnt vmcnt(18)" ::: "memory"); }
            else asm volatile("s_waitcnt vmcnt(0)" ::: "memory");
            __syncthreads();
        }
#undef WS_ISSUE
#undef WS_GATE
        (void)np;
    } else {
        f32x4 accS[4];
#pragma unroll
        for (int jt = 0; jt < 4; ++jt) accS[jt] = (f32x4){0.f, 0.f, 0.f, 0.f};
        __syncthreads();
        for (int it = 0; it < NCH; ++it) {
            const LAS unsigned char* op = lds + (it % WS_NSLOT) * WS_SLOT; const LAS unsigned char* mt = op + 10240;
            s16x4v sb[4];
#pragma unroll
            for (int jt = 0; jt < 4; ++jt) sb[jt] = pk4(accS[jt]);
#define WS_SW(row, p8) ((row) * 128 + ((((p8) >> 1) ^ ((row) & 7)) << 4) + ((p8) & 1) * 8)
            const int trow = 4 * q + (l15 >> 2);
            const s16x4v vb = ldtr(op + 4096 + WS_SW(trow, (l15 & 3) + 4 * wid));
            f32x4 x1 = (f32x4){0.f, 0.f, 0.f, 0.f}, x2 = x1;
#pragma unroll
            for (int jt = 0; jt < 4; ++jt) {
                const s16x4v a0 = *(const LAS s16x4v*)(op + 0 + WS_SW(l15, q + 4 * jt)), r0 = *(const LAS s16x4v*)(op + 2048 + WS_SW(l15, q + 4 * jt));
                x1 = __builtin_amdgcn_mfma_f32_16x16x16bf16_1k(a0, sb[jt], x1, 0, 0, 0);
                x2 = __builtin_amdgcn_mfma_f32_16x16x16bf16_1k(r0, sb[jt], x2, 0, 0, 0);
            }
            const s16x4v mak = *(const LAS s16x4v*)(mt + 0 + l15 * 32 + q * 8), mrb = *(const LAS s16x4v*)(mt + 512 + l15 * 32 + q * 8);
            const s16x4v mrk = *(const LAS s16x4v*)(mt + 1024 + l15 * 32 + q * 8), tt = *(const LAS s16x4v*)(mt + 1536 + l15 * 32 + q * 8);
            x1 = __builtin_amdgcn_mfma_f32_16x16x16bf16_1k(mak, vb, x1, 0, 0, 0);
            x2 = __builtin_amdgcn_mfma_f32_16x16x16bf16_1k(mrk, vb, x2, 0, 0, 0);
            const f32x4 u = __builtin_amdgcn_mfma_f32_16x16x16bf16_1k(tt, pk4(x1), (f32x4){0.f, 0.f, 0.f, 0.f}, 0, 0, 0);
            const s16x4v ub = pk4(u);
            const f32x4 yv = __builtin_amdgcn_mfma_f32_16x16x16bf16_1k(mrb, ub, x2, 0, 0, 0);
            const bf16x8 uv = (bf16x8){ub[0], ub[1], ub[2], ub[3], vb[0], vb[1], vb[2], vb[3]};
#pragma unroll
            for (int jt = 0; jt < 4; ++jt) {
                const f32x4 gl = *(const LAS f32x4*)(mt + 2048 + (16 * jt + 4 * q) * 4);
                const s16x4v b0 = ldtr(op + 6144 + WS_SW(trow, (l15 & 3) + 4 * jt)), k0 = ldtr(op + 8192 + WS_SW(trow, (l15 & 3) + 4 * jt));
                accS[jt] = __builtin_amdgcn_mfma_f32_16x16x32_bf16((bf16x8){b0[0], b0[1], b0[2], b0[3], k0[0], k0[1], k0[2], k0[3]}, uv, accS[jt], 0, 0, 0) * gl;
            }
            LAS float* yt = (LAS float*)(lds + WS_YT + wid * 1024);
#pragma unroll
            for (int rr = 0; rr < 4; ++rr) yt[(4 * q + rr) * 16 + l15] = yv[rr];
            asm volatile("s_waitcnt lgkmcnt(0)" ::: "memory");
            { const int t_ = lane >> 2, ip = (lane & 3) * 4; const f32x4 yr = *(const LAS f32x4*)(yt + t_ * 16 + ip);
              pg8::ST8W(Y + ((size_t)b * SEQ + it * 16 + t_) * 512 + h * 64 + 16 * wid + ip, dn4(yr)); }
            const bool pub_ = ((it & 7) == 7) && it >= 15;
            if (pub_) asm volatile("s_waitcnt vmcnt(8)" ::: "memory");
            __syncthreads();
            if (pub_ && tid == 0) __hip_atomic_store(yflag + ((it - 15) >> 3), 1u, __ATOMIC_RELAXED, __HIP_MEMORY_SCOPE_AGENT);
        }
        asm volatile("s_waitcnt vmcnt(0)" ::: "memory");
#undef WS_SW
    }
    __syncthreads();
    if (tid == 0) __hip_atomic_store(yflag + 31, 1u, __ATOMIC_RELAXED, __HIP_MEMORY_SCOPE_AGENT);
}

__device__ __forceinline__ int crow(int r, int hi) { return (r & 3) + 8 * (r >> 2) + 4 * hi; }
constexpr int AT_KROW = 208, AT_VROW = 136, AT_KBUF = 64 * AT_KROW, AT_VBUF = 64 * AT_VROW, AT_V0 = 2 * AT_KBUF;
__device__ __forceinline__ void attn_unit(ArgsP a, int bh, int qb, LAS unsigned char* lds, size_t o_off = A_QN) {
    a = args_ptr();
    const int tid = ltid(), lane = tid & 63, wid = tid >> 6, r32 = lane & 31, hi = lane >> 5;
    const int b = bh >> 3, h = bh & 7, q0 = qb * 256, qw0 = q0 + wid * 32;
    const size_t rowb = (size_t)b * SEQ;
    const bf16_t* Qn = (const bf16_t*)(a->ws + A_QN); const bf16_t* Qp = (const bf16_t*)(a->ws + A_QP); const bf16_t* Kn = (const bf16_t*)(a->ws + A_KN);
    const bf16_t* KPE = (const bf16_t*)(a->ws + A_KPE); const bf16_t* Vt = (const bf16_t*)(a->ws + A_VT); bf16_t* O = (bf16_t*)(a->ws + o_off);
    bf16x8 qf[6];
    { const size_t qrow = rowb + qw0 + r32;
#pragma unroll
      for (int ds = 0; ds < 4; ++ds) qf[ds] = *(const bf16x8*)(Qn + qrow * 512 + h * 64 + ds * 16 + hi * 8);
#pragma unroll
      for (int ds = 0; ds < 2; ++ds) qf[4 + ds] = *(const bf16x8*)(Qp + qrow * 256 + h * 32 + ds * 16 + hi * 8); }
    const int NT = 4 * qb + 4;
    const bf16_t* ksrc = Kn + (rowb + (tid >> 3)) * 512 + h * 64 + (tid & 7) * 8;
    const bf16_t* psrc = KPE + (rowb + ((tid & 255) >> 2)) * 32 + (tid & 3) * 8;
    const bf16_t* vsrc = Vt + ((size_t)(bh * 64 + (tid >> 3)) << 12) + (tid & 7) * 8;
    const int kdst = (tid >> 3) * AT_KROW + (tid & 7) * 16, pdst = ((tid & 255) >> 2) * AT_KROW + 128 + (tid & 3) * 16, vdst = AT_V0 + (tid >> 3) * AT_VROW + (tid & 7) * 16;
    u32x4 rk0, rp0 = (u32x4){0u, 0u, 0u, 0u}, rv0, rk1, rp1 = rp0, rv1;
#define AT_LOAD(S, tt) do { rk##S = *(const u32x4*)(ksrc + (size_t)(tt) * 64 * 512); if (tid < 256) rp##S = *(const u32x4*)(psrc + (size_t)(tt) * 64 * 32); rv##S = *(const u32x4*)(vsrc + (tt) * 64); } while (0)
#define AT_WRITE(S, p) do { *(LAS u32x4*)(lds + (p) * AT_KBUF + kdst) = rk##S; if (tid < 256) *(LAS u32x4*)(lds + (p) * AT_KBUF + pdst) = rp##S; \
        *(LAS u32x2*)(lds + (p) * AT_VBUF + vdst) = (u32x2){rv##S.x, rv##S.y}; *(LAS u32x2*)(lds + (p) * AT_VBUF + vdst + 8) = (u32x2){rv##S.z, rv##S.w}; } while (0)
    AT_LOAD(0, 0); AT_WRITE(0, 0); AT_LOAD(0, 1);
    __syncthreads();
    float mrun = -INFINITY, lrun = 0.f;
    f32x16 o0, o1;
#pragma unroll
    for (int r = 0; r < 16; ++r) { o0[r] = 0.f; o1[r] = 0.f; }
    for (int t2 = 0; t2 < NT; t2 += 2)
#pragma unroll
    for (int tp = 0; tp < 2; ++tp) {
        const int t = t2 + tp, cur = tp;
        if (t + 2 < NT) { if (tp == 0) AT_LOAD(1, t + 2); else AT_LOAD(0, t + 2); }
        if (64 * t <= qw0 + 31) {
            const LAS unsigned char* Kb = lds + cur * AT_KBUF + r32 * AT_KROW + hi * 16;
            f32x16 p0, p1;
#pragma unroll
            for (int r = 0; r < 16; ++r) { p0[r] = 0.f; p1[r] = 0.f; }
#pragma unroll
            for (int ds = 0; ds < 6; ++ds) {
                const bf16x8 k0 = *(const LAS bf16x8*)(Kb + ds * 32), k1 = *(const LAS bf16x8*)(Kb + 32 * AT_KROW + ds * 32);
                p0 = __builtin_amdgcn_mfma_f32_32x32x16_bf16(k0, qf[ds], p0, 0, 0, 0);
                p1 = __builtin_amdgcn_mfma_f32_32x32x16_bf16(k1, qf[ds], p1, 0, 0, 0);
            }
            if (64 * t + 63 > qw0) {
                const int q = qw0 + r32;
#pragma unroll
                for (int r = 0; r < 16; ++r) { const int kv = 64 * t + crow(r, hi); if (kv > q) p0[r] = -INFINITY; if (kv + 32 > q) p1[r] = -INFINITY; }
            }
            float mx = fmaxf(p0[0], p1[0]);
#pragma unroll
            for (int r = 1; r < 16; ++r) mx = fmaxf(mx, fmaxf(p0[r], p1[r]));
            mx = fmaxf(mx, shx(mx, 32));
            const float mnew = fmaxf(mrun, mx), alpha = __builtin_amdgcn_exp2f(mrun - mnew);
            mrun = mnew;
            float ps = 0.f;
#pragma unroll
            for (int r = 0; r < 16; ++r) { p0[r] = __builtin_amdgcn_exp2f(p0[r] - mnew); p1[r] = __builtin_amdgcn_exp2f(p1[r] - mnew); ps += p0[r] + p1[r]; }
            lrun = lrun * alpha + ps;
#pragma unroll
            for (int r = 0; r < 16; ++r) { o0[r] *= alpha; o1[r] *= alpha; }
            bf16x8 pf[4];
#pragma unroll
            for (int ks = 0; ks < 4; ++ks) {
                u32x4 w;
                if (ks < 2) { w.x = pk2(p0[8 * ks + 0], p0[8 * ks + 1]); w.y = pk2(p0[8 * ks + 2], p0[8 * ks + 3]); w.z = pk2(p0[8 * ks + 4], p0[8 * ks + 5]); w.w = pk2(p0[8 * ks + 6], p0[8 * ks + 7]); }
                else { const int k2 = ks - 2; w.x = pk2(p1[8 * k2 + 0], p1[8 * k2 + 1]); w.y = pk2(p1[8 * k2 + 2], p1[8 * k2 + 3]); w.z = pk2(p1[8 * k2 + 4], p1[8 * k2 + 5]); w.w = pk2(p1[8 * k2 + 6], p1[8 * k2 + 7]); }
                pf[ks] = __builtin_bit_cast(bf16x8, w);
            }
            const LAS unsigned char* Vb = lds + AT_V0 + cur * AT_VBUF + r32 * AT_VROW + hi * 8;
#pragma unroll
            for (int ks = 0; ks < 4; ++ks) {
                const s16x4 a0 = *(const LAS s16x4*)(Vb + ks * 32), a1 = *(const LAS s16x4*)(Vb + ks * 32 + 16);
                const s16x4 c0 = *(const LAS s16x4*)(Vb + 32 * AT_VROW + ks * 32), c1 = *(const LAS s16x4*)(Vb + 32 * AT_VROW + ks * 32 + 16);
                const bf16x8 vf0 = (bf16x8){a0[0], a0[1], a0[2], a0[3], a1[0], a1[1], a1[2], a1[3]}, vf1 = (bf16x8){c0[0], c0[1], c0[2], c0[3], c1[0], c1[1], c1[2], c1[3]};
                o0 = __builtin_amdgcn_mfma_f32_32x32x16_bf16(vf0, pf[ks], o0, 0, 0, 0);
                o1 = __builtin_amdgcn_mfma_f32_32x32x16_bf16(vf1, pf[ks], o1, 0, 0, 0);
            }
        }
        if (t + 1 < NT) { if (tp == 0) AT_WRITE(0, 1); else AT_WRITE(1, 0); }
        __syncthreads();
    }
#undef AT_WRITE
#undef AT_LOAD
    const float ltot = lrun + shx(lrun, 32), inv = 1.0f / ltot;
    bf16_t* orow = O + (rowb + qw0 + r32) * 512 + h * 64 + 4 * hi;
#pragma unroll
    for (int g = 0; g < 4; ++g) {
        *(u32x2*)(orow + 8 * g) = (u32x2){pk2(o0[4 * g] * inv, o0[4 * g + 1] * inv), pk2(o0[4 * g + 2] * inv, o0[4 * g + 3] * inv)};
        *(u32x2*)(orow + 32 + 8 * g) = (u32x2){pk2(o1[4 * g] * inv, o1[4 * g + 1] * inv), pk2(o1[4 * g + 2] * inv, o1[4 * g + 3] * inv)};
    }
}


__device__ __forceinline__ void attn_unit_naive(ArgsP a, int bh, int qb, LAS unsigned char* lds) {
    a = args_ptr();
    const int tid = vtid(), lane = tid & 63, wid = tid >> 6;
    const int b = bh >> 3, h = bh & 7; const size_t rowb = (size_t)b * SEQ;
    const bf16_t* Qn = (const bf16_t*)(a->ws + A_QN); const bf16_t* Qp = (const bf16_t*)(a->ws + A_QP); const bf16_t* Kn = (const bf16_t*)(a->ws + A_KN);
    const bf16_t* KPE = (const bf16_t*)(a->ws + A_KPE); const bf16_t* Vt = (const bf16_t*)(a->ws + A_VT); bf16_t* O = (bf16_t*)(a->ws + A_QN);
    LAS float* sc = (LAS float*)(lds + wid * 16384);
    for (int i = 0; i < 32; ++i) {
        const int q = qb * 256 + wid * 32 + i; const size_t qrow = rowb + q;
        float mx = -INFINITY;
        for (int k0 = 0; k0 <= q; k0 += 64) {
            const int key = k0 + lane; float sv = -INFINITY;
            if (key <= q) { sv = 0.f;
                for (int d = 0; d < 64; ++d) sv += bf2f(Qn[qrow * 512 + h * 64 + d]) * bf2f(Kn[(rowb + key) * 512 + h * 64 + d]);
                for (int d = 0; d < 32; ++d) sv += bf2f(Qp[qrow * 256 + h * 32 + d]) * bf2f(KPE[(rowb + key) * 32 + d]); }
            sc[key] = sv; mx = fmaxf(mx, sv);
        }
        for (int o = 1; o < 64; o <<= 1) mx = fmaxf(mx, shx(mx, o));
        float sum = 0.f;
        for (int k0 = 0; k0 <= q; k0 += 64) { const int key = k0 + lane; const float p = key <= q ? exp2f(sc[key] - mx) : 0.f; sc[key] = p; sum += p; }
        for (int o = 1; o < 64; o <<= 1) sum += shx(sum, o);
        asm volatile("s_waitcnt lgkmcnt(0)" ::: "memory");
        float acc = 0.f;
        const bf16_t* vp = Vt + ((size_t)(bh * 64 + lane) << 12);
        for (int key = 0; key <= q; ++key) acc += sc[key] * bf2f(vp[key]);
        asm volatile("s_waitcnt lgkmcnt(0)" ::: "memory");
        O[qrow * 512 + h * 64 + lane] = (bf16_t)f2bf(acc / sum);
    }
}
__device__ __forceinline__ void ya_item(ArgsP a, int l, int bh, int g) {
    a = args_ptr();
    const int tid = ltid();
    if (tid < 64) {
        unsigned* fl = (unsigned*)(a->ws + WS_CTL) + CW_YFLAG + l * 1024 + bh * 32 + g; unsigned* tmo = (unsigned*)(a->ws + WS_CTL) + CW_BAR + XB_TMO; unsigned sp_ = 0;
        while ((unsigned)__builtin_amdgcn_readfirstlane(__hip_atomic_load(fl, __ATOMIC_RELAXED, __HIP_MEMORY_SCOPE_AGENT)) == 0u) { __builtin_amdgcn_s_sleep(2);
            if ((++sp_ & 255u) == 0u) { if (xb_ld(tmo)) break; if (sp_ > XB_SPIN_CAP) { atomicAdd(tmo, 1u); break; } } }
        __builtin_amdgcn_fence(__ATOMIC_ACQUIRE, "agent");
    }
    __syncthreads();
    const int h = bh & 7, c = h * 64 + (tid & 7) * 8; const size_t r0 = (size_t)(bh >> 3) * SEQ + (size_t)g * 128 + (tid >> 3);
    const bf16_t* Y = (const bf16_t*)(a->ws + A_Y); const bf16_t* RKV = (const bf16_t*)(a->ws + A_RKV); const bf16_t* GATE = (const bf16_t*)(a->ws + A_GATE);
    const float* SCAL = (const float*)(a->ws + WS_SCAL); bf16_t* YA = (bf16_t*)(a->ws + A_YA);
    const float* lw = a->in[I_LNXW] + l * 512 + c; const float* lb = a->in[I_LNXB] + l * 512 + c;
    const f32x4 w0 = *(const f32x4*)lw, w1 = *(const f32x4*)(lw + 4), b0 = *(const f32x4*)lb, b1 = *(const f32x4*)(lb + 4);
    u32x4 yu[2], vu[2], gu[2]; float sc[2];
#pragma unroll
    for (int k = 0; k < 2; ++k) { const size_t row = r0 + 64 * k;
        yu[k] = *(const u32x4*)(Y + row * 512 + c); vu[k] = *(const u32x4*)(RKV + row * 1536 + 1024 + c);
        gu[k] = *(const u32x4*)(GATE + row * 512 + c); sc[k] = SCAL[row * 8 + h]; }
#pragma unroll
    for (int k = 0; k < 2; ++k) {
        const f32x4 ya0 = up4((u32x2){yu[k].x, yu[k].y}), ya1 = up4((u32x2){yu[k].z, yu[k].w});
        float sm = ((ya0.x + ya0.y) + (ya0.z + ya0.w)) + ((ya1.x + ya1.y) + (ya1.z + ya1.w));
        sm += shx(sm, 1); sm += shx(sm, 2); sm += shx(sm, 4);
        const float mean = sm * (1.0f / 64.0f);
        const f32x4 d0 = ya0 - mean, d1 = ya1 - mean;
        float qv = dot4(d0, d0) + dot4(d1, d1);
        qv += shx(qv, 1); qv += shx(qv, 2); qv += shx(qv, 4);
        const float rstd = rsqrtf(qv * (1.0f / 64.0f) + LNX_EPS);
        const f32x4 vv0 = up4((u32x2){vu[k].x, vu[k].y}), vv1 = up4((u32x2){vu[k].z, vu[k].w});
        const f32x4 g0 = up4((u32x2){gu[k].x, gu[k].y}), g1 = up4((u32x2){gu[k].z, gu[k].w});
        const f32x4 o0 = (d0 * rstd * w0 + b0 + vv0 * sc[k]) * g0, o1 = (d1 * rstd * w1 + b1 + vv1 * sc[k]) * g1;
        const u32x2 p0 = dn4(o0), p1 = dn4(o1);
        *(u32x4*)(YA + (r0 + 64 * k) * 512 + c) = (u32x4){p0.x, p0.y, p1.x, p1.y};
    }
}
#if NAIVE_ATTN
#define ATTN_UNIT attn_unit_naive
#else
#define ATTN_UNIT attn_unit
#endif
__device__ __forceinline__ void phase_ya(ArgsP a, int l) {
    a = args_ptr();
    const unsigned gt = blockIdx.x * NTHREADS + ltid(), NGT = gridDim.x * NTHREADS;
    const bf16_t* Y = (const bf16_t*)(a->ws + A_Y); const bf16_t* RKV = (const bf16_t*)(a->ws + A_RKV); const bf16_t* GATE = (const bf16_t*)(a->ws + A_GATE);
    const float* SCAL = (const float*)(a->ws + WS_SCAL); bf16_t* YA = (bf16_t*)(a->ws + A_YA);
    const int c = (gt & 63) * 8, h = c >> 6;
    const float* muv = a->in[I_MU] + (size_t)l * 1792 + 1024 + c; const float* lw = a->in[I_LNXW] + l * 512 + c; const float* lb = a->in[I_LNXB] + l * 512 + c;
    const f32x4 m0 = *(const f32x4*)muv, m1 = *(const f32x4*)(muv + 4), w0 = *(const f32x4*)lw, w1 = *(const f32x4*)(lw + 4), b0 = *(const f32x4*)lb, b1 = *(const f32x4*)(lb + 4);
    for (unsigned i = gt; i < (unsigned)M * 64; i += 2 * NGT) {
        u32x4 yu[2], v2u[2], v1u[2], gu[2]; float sc[2]; unsigned rowv[2];
#pragma unroll
        for (int k = 0; k < 2; ++k) { const unsigned row = (i + k * NGT) >> 6; const int t = row & 4095; rowv[k] = row;
            yu[k] = *(const u32x4*)(Y + (size_t)row * 512 + c); v2u[k] = *(const u32x4*)(RKV + (size_t)row * 1536 + 1024 + c);
            v1u[k] = WKV_STREAM ? v2u[k] : (t ? *(const u32x4*)(RKV + (size_t)(row - 1) * 1536 + 1024 + c) : (u32x4){0u, 0u, 0u, 0u});
            gu[k] = *(const u32x4*)(GATE + (size_t)row * 512 + c); sc[k] = SCAL[(size_t)row * 8 + h]; }
#pragma unroll
        for (int k = 0; k < 2; ++k) {
            const f32x4 ya0 = up4((u32x2){yu[k].x, yu[k].y}), ya1 = up4((u32x2){yu[k].z, yu[k].w});
            float sm = ((ya0.x + ya0.y) + (ya0.z + ya0.w)) + ((ya1.x + ya1.y) + (ya1.z + ya1.w));
            sm += shx(sm, 1); sm += shx(sm, 2); sm += shx(sm, 4);
            const float mean = sm * (1.0f / 64.0f);
            const f32x4 d0 = ya0 - mean, d1 = ya1 - mean;
            float qv = dot4(d0, d0) + dot4(d1, d1);
            qv += shx(qv, 1); qv += shx(qv, 2); qv += shx(qv, 4);
            const float rstd = rsqrtf(qv * (1.0f / 64.0f) + LNX_EPS);
            const f32x4 v20 = up4((u32x2){v2u[k].x, v2u[k].y}), v21 = up4((u32x2){v2u[k].z, v2u[k].w}), v10 = up4((u32x2){v1u[k].x, v1u[k].y}), v11 = up4((u32x2){v1u[k].z, v1u[k].w});
            const f32x4 vv0 = v20 + (v10 - v20) * m0, vv1 = v21 + (v11 - v21) * m1;
            const f32x4 g0 = up4((u32x2){gu[k].x, gu[k].y}), g1 = up4((u32x2){gu[k].z, gu[k].w});
            const f32x4 o0 = (d0 * rstd * w0 + b0 + vv0 * sc[k]) * g0, o1 = (d1 * rstd * w1 + b1 + vv1 * sc[k]) * g1;
            const u32x2 p0 = dn4(o0), p1 = dn4(o1);
            *(u32x4*)(YA + (size_t)rowv[k] * 512 + c) = (u32x4){p0.x, p0.y, p1.x, p1.y};
        }
    }
}


__device__ __forceinline__ void phase_gconv(ArgsP a, int l) {
    a = args_ptr();
    const unsigned gt = blockIdx.x * NTHREADS + ltid();
    constexpr unsigned NCHK = FF / 8, NSEG = 372, SEGR = (M + NSEG - 1) / NSEG;
    if (gt >= NCHK * NSEG) return;
    const unsigned chk = gt % NCHK, seg = gt / NCHK; const int c = chk * 8;
    const bf16_t* UG = (const bf16_t*)(a->ws + A_UG); bf16_t* GC = (bf16_t*)(a->ws + A_ACT);
    const float* cw = a->in[I_CONVW] + (size_t)l * 3 * FF + c; const float* cb = a->in[I_CONVB] + (size_t)l * FF + c;
    const f32x4 w0a = *(const f32x4*)cw, w0b = *(const f32x4*)(cw + 4), w1a = *(const f32x4*)(cw + FF), w1b = *(const f32x4*)(cw + FF + 4), w2a = *(const f32x4*)(cw + 2 * FF), w2b = *(const f32x4*)(cw + 2 * FF + 4);
    const f32x4 ba = *(const f32x4*)cb, bb = *(const f32x4*)(cb + 4);
    const unsigned r0 = seg * SEGR, r1 = (r0 + SEGR < (unsigned)M) ? r0 + SEGR : (unsigned)M;
    const u32x4 z = (u32x4){0u, 0u, 0u, 0u};
    u32x4 p1 = ((r0 & 4095u) >= 1u) ? *(const u32x4*)(UG + (size_t)(r0 - 1) * FF + c) : z, p2 = ((r0 & 4095u) >= 2u) ? *(const u32x4*)(UG + (size_t)(r0 - 2) * FF + c) : z;
    u32x4 nx = *(const u32x4*)(UG + (size_t)r0 * FF + c);
    for (unsigned r = r0; r < r1; ++r) {
        const u32x4 cur = nx;
        if (r + 1 < r1) nx = *(const u32x4*)(UG + (size_t)(r + 1) * FF + c);
        if ((r & 4095u) == 0u) { p1 = z; p2 = z; }
        const f32x4 x2a = up4((u32x2){cur.x, cur.y}), x2b = up4((u32x2){cur.z, cur.w}), x1a = up4((u32x2){p1.x, p1.y}), x1b = up4((u32x2){p1.z, p1.w}), x0a = up4((u32x2){p2.x, p2.y}), x0b = up4((u32x2){p2.z, p2.w});
        const f32x4 ca = ba + w0a * x0a + w1a * x1a + w2a * x2a, cc = bb + w0b * x0b + w1b * x1b + w2b * x2b;
        const pg8::f32x2 g0 = pg8::gelu_pk2((pg8::f32x2){ca.x, ca.y}), g1 = pg8::gelu_pk2((pg8::f32x2){ca.z, ca.w}), g2 = pg8::gelu_pk2((pg8::f32x2){cc.x, cc.y}), g3 = pg8::gelu_pk2((pg8::f32x2){cc.z, cc.w});
        *(u32x4*)(GC + (size_t)r * FF + c) = (u32x4){pk2(g0.x, g0.y), pk2(g1.x, g1.y), pk2(g2.x, g2.y), pk2(g3.x, g3.y)};
        p2 = p1; p1 = cur;
    }
}
__device__ __forceinline__ void ffn_halo_fix(ArgsP a, int l, int pm) {
    a = args_ptr();
    const int tid = ltid();
    const bf16_t* RAWH = (const bf16_t*)(a->ws + A_UG); bf16_t* ACT = (bf16_t*)(a->ws + A_ACT);
    const float* cw = a->in[I_CONVW] + (size_t)l * 3 * FF; const float* cb = a->in[I_CONVB] + (size_t)l * FF;
    for (int i = tid; i < 8 * (FF / 8); i += NTHREADS) {
        const int hr = i / (FF / 8), c = (i % (FF / 8)) * 8, blk = pm * 4 + (hr >> 1), fr = hr & 1, row = blk * 64 + fr;
        const bool first = (row & 4095) < 2; const bf16_t* hb = RAWH + (size_t)blk * 6 * FF + c; const u32x4 z = (u32x4){0u, 0u, 0u, 0u};
        const u32x4 cur = *(const u32x4*)(hb + (2 + fr) * FF), val = *(const u32x4*)(hb + (4 + fr) * FF);
        const u32x4 p1 = (fr == 0) ? (first ? z : *(const u32x4*)(hb - 5 * FF)) : *(const u32x4*)(hb + 2 * FF);
        const u32x4 p2 = first ? z : *(const u32x4*)(hb - (fr == 0 ? 6 : 5) * FF);
        const f32x4 w0a = *(const f32x4*)(cw + c), w0b = *(const f32x4*)(cw + c + 4), w1a = *(const f32x4*)(cw + FF + c), w1b = *(const f32x4*)(cw + FF + c + 4);
        const f32x4 w2a = *(const f32x4*)(cw + 2 * FF + c), w2b = *(const f32x4*)(cw + 2 * FF + c + 4), ba = *(const f32x4*)(cb + c), bb = *(const f32x4*)(cb + c + 4);
        const f32x4 ga = pg8::gelu4(ba + w0a * up4((u32x2){p2.x, p2.y}) + w1a * up4((u32x2){p1.x, p1.y}) + w2a * up4((u32x2){cur.x, cur.y}));
        const f32x4 gb = pg8::gelu4(bb + w0b * up4((u32x2){p2.z, p2.w}) + w1b * up4((u32x2){p1.z, p1.w}) + w2b * up4((u32x2){cur.z, cur.w}));
        *(u32x4*)(ACT + (size_t)row * FF + c) = pg8::pack8(ga * up4((u32x2){val.x, val.y}), gb * up4((u32x2){val.z, val.w}));
    }
    asm volatile("s_waitcnt vmcnt(0)" ::: "memory");
    __syncthreads();
}
__device__ __forceinline__ void phase_final(ArgsP a) {
    a = args_ptr();
    const int tid = ltid(), lane = tid & 63, gw = blockIdx.x * NWAVES + (tid >> 6), NGW = gridDim.x * NWAVES;
    const float* SS4 = (const float*)(a->ws + WS_SSP) + (size_t)4 * M * 16; const f32x4* g = (const f32x4*)a->in[I_FINAL] + lane; const bf16_t* HB = (const bf16_t*)(a->ws + A_HB);
    for (int m = gw; m < M; m += NGW) {
        const float rs = rsqrtf(pg8::sum16(SS4 + (size_t)m * 16) * (1.0f / 1024.0f) + NORM_EPS);
        f32x4* o = (f32x4*)(a->out + (size_t)m * DM) + lane; const u32x2* hb = (const u32x2*)(HB + (size_t)m * DM) + lane;
#pragma unroll
        for (int j = 0; j < 4; ++j) o[64 * j] = up4(hb[64 * j]) * rs * g[64 * j];
    }
}


#ifndef DUMP_MIB
#define DUMP_MIB 0
#endif
#ifndef DUMP_OFF_MIB
#define DUMP_OFF_MIB 0
#endif
__device__ __forceinline__ void phase_dump(ArgsP a) {
    a = args_ptr();
    const size_t n16 = (size_t)DUMP_MIB * 1024 * 512, nout = (size_t)M * DM;
    const unsigned short* src = (const unsigned short*)(a->ws + (size_t)DUMP_OFF_MIB * 1024 * 1024);
    for (size_t i = (size_t)blockIdx.x * NTHREADS + vtid(); i < nout; i += (size_t)gridDim.x * NTHREADS) {
        float sacc = 0.f; for (size_t j = i; j < n16; j += nout) sacc += (float)src[j] * (1.0f / 65536.0f);
        a->out[i] = sacc; }
}

#ifndef CHK_ONLY
#define CHK_ONLY 0
#endif
#ifdef CHKSUM_PROBE
__device__ __forceinline__ void phase_chk_sum(ArgsP a) {
    a = args_ptr(); unsigned* ctl = (unsigned*)(a->ws + WS_CTL) + 32768;
    const size_t offs[4] = {A_Y, A_QN, WS_SCAL, A_YA}; const unsigned n16[4] = {(unsigned)M * 512u, (unsigned)M * 512u, (unsigned)M * 16u, 0u};
    for (int k = 0; k < 3; ++k) { const unsigned short* p = (const unsigned short*)(a->ws + offs[k]); unsigned acc = 0;
        for (unsigned i = blockIdx.x * NTHREADS + vtid(); i < n16[k]; i += gridDim.x * NTHREADS) acc += p[i];
        for (int o = 1; o < 64; o <<= 1) acc += shx(acc, o);
        if ((vtid() & 63) == 0) atomicAdd(ctl + 64 * k, acc); }
}
__device__ __forceinline__ void phase_chk_out(ArgsP a) {
    a = args_ptr(); const unsigned* ctl = (const unsigned*)(a->ws + WS_CTL) + 32768;
    for (unsigned i = blockIdx.x * NTHREADS + vtid(); i < (unsigned)(M * DM); i += gridDim.x * NTHREADS) {
        float v = 0.f; if (i == CHK_ONLY) v = (float)(__hip_atomic_load(ctl + 64 * i, __ATOMIC_RELAXED, __HIP_MEMORY_SCOPE_AGENT) % CHKSUM_PROBE) * 100.0f; a->out[i] = v; }
}
#endif

#ifdef CMPY_PROBE
__device__ __forceinline__ void phase_cmp_y(ArgsP a) {
    a = args_ptr(); unsigned long long* ctl = (unsigned long long*)(a->ws + WS_CTL) + 20000;
    const unsigned short* y1 = (const unsigned short*)(a->ws + A_Y); const unsigned short* y2 = (const unsigned short*)(a->ws + A_GATE);
    float sd = 0.f, sy = 0.f;
    for (unsigned i = blockIdx.x * NTHREADS + vtid(); i < (unsigned)M * 512u; i += gridDim.x * NTHREADS) { const float p = bf2f(y1[i]), r = bf2f(y2[i]); sd += (p - r) * (p - r); sy += r * r; }
    atomicAdd(ctl, (unsigned long long)(sd * 1024.0f)); atomicAdd(ctl + 8, (unsigned long long)(sy * 1024.0f));
}
__device__ __forceinline__ void phase_cmp_out(ArgsP a) {
    a = args_ptr(); const unsigned long long* ctl = (const unsigned long long*)(a->ws + WS_CTL) + 20000;
    const float rel = sqrtf((float)__hip_atomic_load(ctl, __ATOMIC_RELAXED, __HIP_MEMORY_SCOPE_AGENT) / (float)__hip_atomic_load(ctl + 8, __ATOMIC_RELAXED, __HIP_MEMORY_SCOPE_AGENT));
    for (unsigned i = blockIdx.x * NTHREADS + vtid(); i < (unsigned)(M * DM); i += gridDim.x * NTHREADS) a->out[i] = (i == 0) ? floorf(rel * 10000.0f) : 0.f;
}
#endif

#ifdef CK_TIME
__device__ __forceinline__ void phase_time_out(ArgsP a) {
    a = args_ptr(); const unsigned long long* tw = (const unsigned long long*)(a->ws + WS_CTL) + 24000;
#ifdef CK_TIME_TOTAL
    const float frac = (float)__hip_atomic_load(tw + 8, __ATOMIC_RELAXED, __HIP_MEMORY_SCOPE_AGENT) * (1.0f / 100000.0f);
    for (unsigned i = blockIdx.x * NTHREADS + vtid(); i < (unsigned)(M * DM); i += gridDim.x * NTHREADS) a->out[i] = (i == 0) ? floorf(frac) * 100.0f : 0.f;
#else
    const float frac = (float)__hip_atomic_load(tw + CK_TIME, __ATOMIC_RELAXED, __HIP_MEMORY_SCOPE_AGENT) / (float)__hip_atomic_load(tw + 8, __ATOMIC_RELAXED, __HIP_MEMORY_SCOPE_AGENT);
    for (unsigned i = blockIdx.x * NTHREADS + vtid(); i < (unsigned)(M * DM); i += gridDim.x * NTHREADS) a->out[i] = (i == 0) ? floorf(frac * 8.0f + 0.5f) * 1000.0f : 0.f;
#endif
}
#endif

#ifdef PH_TIME
__device__ __forceinline__ void phase_phtime_out(ArgsP a) {
    a = args_ptr(); const unsigned long long* tw = (const unsigned long long*)(a->ws + WS_CTL) + 26000;
    const float us = (float)(__hip_atomic_load(tw + PH_TIME + 1, __ATOMIC_RELAXED, __HIP_MEMORY_SCOPE_AGENT) - __hip_atomic_load(tw + PH_TIME, __ATOMIC_RELAXED, __HIP_MEMORY_SCOPE_AGENT)) * 0.01f;
    for (unsigned i = blockIdx.x * NTHREADS + vtid(); i < (unsigned)(M * DM); i += gridDim.x * NTHREADS) a->out[i] = (i == 0) ? floorf(us / (float)PH_Q + 0.5f) * 100.0f : 0.f;
}
#endif
#ifdef SPLIT_SCAN_ATTN
constexpr int PH_EXTRA = 1;
#else
constexpr int PH_EXTRA = 0;
#endif
constexpr int PH_PER_LAYER = 9 + PH_EXTRA, N_PHASES = 2 * PH_PER_LAYER + 1;
__global__ void __launch_bounds__(NTHREADS, 2) mk_fwd(Args a_unused) {
    LAS unsigned char* lds = (LAS unsigned char*)lds_raw;
    { const unsigned t0_ = threadIdx.x; if ((t0_ & 63u) == 0u) *(volatile LAS unsigned*)(lds + WTAB_OFF + hw_wave_key() * 4u) = t0_ >> 6; }
    __syncthreads();
#if !MK_MULTI
    if (args_ptr()->ph_lo > 1000000) cg::this_grid().sync();
    volatile LAS unsigned* MISC = (volatile LAS unsigned*)(lds + MISC_OFF);
    if (vtid() < 32) MISC[vtid()] = 0u;
    __syncthreads();
    (void)xcd_barrier_post((unsigned*)(args_ptr()->ws + WS_CTL) + CW_BAR, MISC + 8);
#endif
    int ph = 0;
#ifdef PH_TIME
    if (blockIdx.x == 0 && vtid() == 0) ((unsigned long long*)(args_ptr()->ws + WS_CTL) + 26000)[0] = __builtin_amdgcn_s_memrealtime();
#endif
#define lo (args_ptr()->ph_lo)
#define hi (args_ptr()->ph_hi)
#if MK_MULTI
#define SEAM() do {} while (0)
#define SEAM1() do {} while (0)
#else
#define SEAM1() do { XcdBarrier b_; b_.bar = (unsigned*)(args_ptr()->ws + WS_CTL) + CW_BAR; b_.x = xb_xcc_id(); b_.st = (volatile LAS unsigned*)(lds + MISC_OFF) + 8; xcd_barrier(b_); } while (0)
#define SEAM() do { if (ph + 1 < hi) { XcdBarrier b_; b_.bar = (unsigned*)(args_ptr()->ws + WS_CTL) + CW_BAR; b_.x = xb_xcc_id(); b_.st = (volatile LAS unsigned*)(lds + MISC_OFF) + 8; xcd_barrier(b_); } } while (0)
#endif
#ifndef PH3SUB
#define PH3SUB 7
#endif
#ifndef PHMASK
#define PHMASK 0xFFFF
#endif
#ifndef SCAN_CHUNKED
#define SCAN_CHUNKED 1
#endif
#ifndef SCAN_REPS
#define SCAN_REPS 1
#endif
#ifndef REPEAT_PHASE
#define REPEAT_PHASE (-1)
#endif
#ifndef REPEAT_LAYER
#define REPEAT_LAYER (-1)
#endif
#ifdef PH_TIME
#define PH_STAMP() do { if (blockIdx.x == 0 && vtid() == 0) ((unsigned long long*)(args_ptr()->ws + WS_CTL) + 26000)[ph + 1] = __builtin_amdgcn_s_memrealtime(); } while (0)
#elif defined(PH_SPIN)
#ifdef PH_SUB
#define PH_SUBSEL() do { const unsigned long long* ts_ = st_ + 100; d_ = PH_SUB == 1 ? ts_[1] - ts_[0] : (PH_SUB == 2 ? ts_[2] - ts_[1] : (PH_SUB == 3 ? t1_ - ts_[2] : (PH_SUB == 4 ? __hip_atomic_load((unsigned long long*)ts_ + 4, __ATOMIC_RELAXED, __HIP_MEMORY_SCOPE_AGENT) - ts_[0] : ts_[0] - st_[ph]))); } while (0)
#else
#define PH_SUBSEL() do {} while (0)
#endif
#define PH_STAMP() do { if (ph + 1 == PH_SPIN || ph == PH_SPIN) { if (blockIdx.x == 0 && vtid() == 0) { unsigned long long* st_ = (unsigned long long*)(args_ptr()->ws + WS_CTL) + 26000; \
        const unsigned long long t1_ = __builtin_amdgcn_s_memrealtime(); st_[ph + 1] = t1_; st_[103] = t1_; \
        if (ph == PH_SPIN) { unsigned long long d_ = t1_ - st_[ph]; PH_SUBSEL(); if (d_ > 100000ull) d_ = 100000ull; while (__builtin_amdgcn_s_memrealtime() - t1_ < d_) __builtin_amdgcn_s_sleep(8); } } \
        if (ph == PH_SPIN) { SEAM1(); } } } while (0)
#else
#define PH_STAMP() do {} while (0)
#endif
#define RUN(K, ...) do { if (((PHMASK >> (K)) & 1) && lo <= ph && ph < hi) { const int nrep_ = ((K) == REPEAT_PHASE && (REPEAT_LAYER < 0 || REPEAT_LAYER == l_)) ? 2 : 1; \
    for (int rep_ = 0; rep_ < nrep_; ++rep_) { __VA_ARGS__; if (rep_ + 1 < nrep_) { SEAM1(); } } SEAM(); PH_STAMP(); } ++ph; } while (0)
#define LOCALS() ArgsP a = args_ptr(); unsigned char* ws = a->ws; unsigned char* wb = ws + WS_W; float* SSP = (float*)(ws + WS_SSP); float* SSQP = (float*)(ws + WS_SSQP); bf16_t* HB = (bf16_t*)(ws + A_HB); \
    const int G = gridDim.x, bid = blockIdx.x; (void)wb; (void)SSP; (void)SSQP; (void)HB; (void)G; (void)bid
#define WT(off) ((const pg8::bf16_t*)(wb + (off)))
    int l_ = 0;
    for (int l = 0; l < DEPTH; ++l) {
        l_ = l;
        RUN(0, phase_weights(nullptr, l, lds));
        RUN(1, { LOCALS(); pg8::Gemm g{HB, WT(W_IN), M, PC - 256, 1024, 1024}; pg8::StaticOrder S; S.init(M, PC - 256, G, bid);
              pg8::EpiP E{(bf16_t*)(ws + A_RKV), (bf16_t*)(ws + A_LORAC), (bf16_t*)(ws + A_PM), (unsigned char*)a->out, SSP + (size_t)(2 * l) * M * 16, SSQP + (size_t)l * M * 4, SSQP + (size_t)(2 + l) * M * 4, (bf16_t*)((unsigned char*)a->out + DO_HALO), (LAS float*)(lds + pg8::RS_OFF), 0};
              GEMM_PHASE(pg8::EpiP, lds, g, S, E); });
        RUN(2, phase_prep(nullptr, l));
        RUN(3, { if (PH3SUB & 1) { LOCALS(); pg8::Gemm g{(const bf16_t*)(ws + A_LIN), WT(W_LORA), M, 1536, 256, 256}; pg8::StaticOrder S; S.init(M, 1536, G, bid);
                pg8::EpiLora E{(bf16_t*)(ws + A_LW), (bf16_t*)(ws + A_ICLR), (bf16_t*)(ws + A_GATE), a->in[I_DBASE] + l * 512, a->in[I_IBASE] + l * 512};
                GEMM_PHASE(pg8::EpiLora, lds, g, S, E); }
              if (gridDim.x == 256 && blockIdx.x >= 192) {
                LOCALS(); pg8::Gemm g{HB, WT(W_IN) + (size_t)(PC - 256) * 1024, M, 256, 1024, 1024}; pg8::StaticOrder S; S.init(M, 256, 64, bid - 192);
                pg8::EpiP E{(bf16_t*)(ws + A_RKV), (bf16_t*)(ws + A_LORAC), (bf16_t*)(ws + A_PM), (unsigned char*)a->out, SSP + (size_t)(2 * l) * M * 16, SSQP + (size_t)l * M * 4, SSQP + (size_t)(2 + l) * M * 4, (bf16_t*)((unsigned char*)a->out + DO_HALO), (LAS float*)(lds + pg8::RS_OFF), 16};
                GEMM_PHASE(pg8::EpiP, lds, g, S, E); }
              else if (gridDim.x != 256) {
                LOCALS(); pg8::Gemm g{HB, WT(W_IN) + (size_t)(PC - 256) * 1024, M, 256, 1024, 1024}; pg8::StaticOrder S; S.init(M, 256, G, bid);
                pg8::EpiP E{(bf16_t*)(ws + A_RKV), (bf16_t*)(ws + A_LORAC), (bf16_t*)(ws + A_PM), (unsigned char*)a->out, SSP + (size_t)(2 * l) * M * 16, SSQP + (size_t)l * M * 4, SSQP + (size_t)(2 + l) * M * 4, (bf16_t*)((unsigned char*)a->out + DO_HALO), (LAS float*)(lds + pg8::RS_OFF), 16};
                GEMM_PHASE(pg8::EpiP, lds, g, S, E); }
              if (PH3SUB & 2) { LOCALS(); pg8::Gemm g{(const bf16_t*)(ws + A_PM), WT(W_Q), M, 768, 256, 512}; pg8::StaticOrder S; S.init(M, 768, G, bid);
                pg8::EpiQ E{(bf16_t*)(ws + A_QN), (bf16_t*)(ws + A_QP), SSQP + (size_t)l * M * 4, (const float*)(ws + WS_CS), (LAS float*)(lds + pg8::RS_OFF)};
                GEMM_PHASE(pg8::EpiQ, lds, g, S, E); }
              if (PH3SUB & 4) { LOCALS(); pg8::Gemm g{(const bf16_t*)(ws + A_PM) + 256, WT(W_KV), M, 1024, 256, 512}; pg8::StaticOrder S; S.init(M, 1024, G, bid);
                pg8::EpiKV E{(bf16_t*)(ws + A_KN), (bf16_t*)(ws + A_VT), SSQP + (size_t)(2 + l) * M * 4, (LAS float*)(lds + pg8::RS_OFF)};
                GEMM_PHASE(pg8::EpiKV, lds, g, S, E); } });
#if WKV_STREAM
        RUN(4, { if (gridDim.x >= 64) { if (blockIdx.x >= 32) phase_wkvprep(nullptr, l, lds, (int)blockIdx.x - 32, (int)gridDim.x - 32); }
                 else { phase_wkvprep(nullptr, l, lds, (int)blockIdx.x, (int)gridDim.x); SEAM1(); }
                 if (blockIdx.x < 32) { for (int sr_ = 0; sr_ < SCAN_REPS; ++sr_) scan_unit_stream(nullptr, l, blockIdx.x, lds); }
#ifdef PH_SUB
                 if (blockIdx.x == 0 && vtid() == 0) { unsigned long long* ts_ = (unsigned long long*)(args_ptr()->ws + WS_CTL) + 26100; ts_[0] = ts_[3]; ts_[1] = __builtin_amdgcn_s_memrealtime(); }
#endif
                 unsigned* qctr = (unsigned*)(args_ptr()->ws + WS_CTL) + CW_QUEUE + 64 * (2 * l);
                 volatile LAS unsigned* qslot = (volatile LAS unsigned*)(lds + MISC_OFF) + 16;
                 for (;;) { if (vtid() == 0) qslot[0] = __hip_atomic_fetch_add(qctr, 1u, __ATOMIC_RELAXED, __HIP_MEMORY_SCOPE_AGENT);
                            __syncthreads(); const unsigned u = qslot[0]; __syncthreads();
                            if (u >= 512u) break;
                            attn_unit(nullptr, (int)(u & 31u), 15 - (int)(u >> 5), lds, A_QN); }
                 { unsigned* yctr = (unsigned*)(args_ptr()->ws + WS_CTL) + CW_QUEUE + 64 * (2 * l + 1);
                   for (;;) { if (vtid() == 0) qslot[0] = __hip_atomic_fetch_add(yctr, 1u, __ATOMIC_RELAXED, __HIP_MEMORY_SCOPE_AGENT);
                              __syncthreads(); const unsigned u = qslot[0]; __syncthreads();
                              if (u >= 1024u) break;
                              ya_item(nullptr, l, (int)(u & 31u), (int)(u >> 5)); } }
#ifdef PH_SUB
                 if (blockIdx.x == 0 && vtid() == 0) { unsigned long long* ts_ = (unsigned long long*)(args_ptr()->ws + WS_CTL) + 26100; ts_[2] = __builtin_amdgcn_s_memrealtime(); }
                 if (blockIdx.x == 255 && vtid() == 0) { unsigned long long* ts_ = (unsigned long long*)(args_ptr()->ws + WS_CTL) + 26100; __hip_atomic_store(ts_ + 4, (unsigned long long)__builtin_amdgcn_s_memrealtime(), __ATOMIC_RELAXED, __HIP_MEMORY_SCOPE_AGENT); }
#endif
                 });
#else
#ifdef SPLIT_SCAN_ATTN
        RUN(4, { if (blockIdx.x < 128) scan_unit_chunked(nullptr, l, blockIdx.x >> 2, blockIdx.x & 3, lds); });
        RUN(5, { for (int c = blockIdx.x; c < 256; c += gridDim.x) { attn_unit(nullptr, c >> 3, 15 - (c & 7), lds); attn_unit(nullptr, c >> 3, c & 7, lds); } });
#else
        RUN(4, { if (blockIdx.x < 128) { for (int sr_ = 0; sr_ < SCAN_REPS; ++sr_) { if (SCAN_CHUNKED) scan_unit_chunked(nullptr, l, blockIdx.x >> 2, blockIdx.x & 3, lds); else scan_unit(nullptr, l, blockIdx.x >> 2, blockIdx.x & 3, lds); } }
                 const size_t oo_ = (rep_ + 1 < nrep_) ? A_LW : A_QN;
                 unsigned* qctr = (unsigned*)(args_ptr()->ws + WS_CTL) + CW_QUEUE + 64 * (2 * l + rep_);
                 volatile LAS unsigned* qslot = (volatile LAS unsigned*)(lds + MISC_OFF) + 16;
                 for (;;) { if (vtid() == 0) qslot[0] = __hip_atomic_fetch_add(qctr, 1u, __ATOMIC_RELAXED, __HIP_MEMORY_SCOPE_AGENT);
                            __syncthreads(); const unsigned u = qslot[0]; __syncthreads();
                            if (u >= 512u) break;
                            attn_unit(nullptr, (int)(u & 31u), 15 - (int)(u >> 5), lds, oo_); } });
#endif
#endif
#ifdef CK_TIME
        if (l == 0) { phase_time_out(nullptr); return; }
#endif
#ifdef CMPY_PROBE
        if (l == 0) { if (blockIdx.x < 128) scan_unit(nullptr, l, blockIdx.x >> 2, blockIdx.x & 3, lds, A_GATE); SEAM1(); phase_cmp_y(nullptr); SEAM1(); phase_cmp_out(nullptr); return; }
#endif
#ifdef CHKSUM_PROBE
        if (l == 0) { phase_chk_sum(nullptr); SEAM1(); phase_chk_out(nullptr); return; }
#endif
        RUN(7, { { LOCALS(); pg8::Gemm g{(const bf16_t*)(ws + A_YA), WT(W_OA), M, 1024, 512, 512}; pg8::StaticOrder S; S.init(M, 1024, G, bid);
                pg8::EpiMix<1> E{(float*)(ws + A_TMP), (bf16_t*)(ws + A_MERGED), (const unsigned char*)a->out};
                GEMM_PHASE(pg8::EpiMix<1>, lds, g, S, E); }
              asm volatile("s_waitcnt vmcnt(0)" ::: "memory"); __syncthreads();
              { LOCALS(); pg8::Gemm g{(const bf16_t*)(ws + A_QN), WT(W_OB), M, 1024, 512, 512}; pg8::StaticOrder S; S.init(M, 1024, G, bid);
                pg8::EpiMix<2> E{(float*)(ws + A_TMP), (bf16_t*)(ws + A_MERGED), (const unsigned char*)a->out};
                GEMM_PHASE(pg8::EpiMix<2>, lds, g, S, E); } });
        RUN(8, { LOCALS(); pg8::Gemm g{(const bf16_t*)(ws + A_MERGED), WT(W_OUT), M, 1024, 1024, 1024}; pg8::StaticOrder S; S.init(M, 1024, G, bid);
#ifdef PH_SUB
              g.ts = (unsigned long long*)(ws + WS_CTL) + 26100;
#endif
              pg8::EpiRes E{HB, SSP + (size_t)(2 * l + 1) * M * 16};
              GEMM_PHASE(pg8::EpiRes, lds, g, S, E); });
        RUN(9, { LOCALS(); pg8::Gemm g{HB, WT(W_UP), M, 2 * FF, 1024, 1024}; pg8::StaticOrder S; S.init(M, 2 * FF, G, bid);
              pg8::EpiUp E{(bf16_t*)(ws + A_ACT), (bf16_t*)(ws + A_UG), SSP + (size_t)(2 * l + 1) * M * 16, a->in[I_CONVW] + (size_t)l * 3 * FF, a->in[I_CONVB] + (size_t)l * FF, (LAS float*)(lds + pg8::RS_OFF)};
              GEMM_PHASE(pg8::EpiUp, lds, g, S, E); });
        RUN(11, { LOCALS(); pg8::Gemm g{(const bf16_t*)(ws + A_ACT), WT(W_DOWN), M, 1024, FF, FF}; pg8::StaticOrder S; S.init(M, 1024, G, bid);
              { pg8::Unit hu_; for (int hi_ = 0; S.next(hi_, hu_); ++hi_) ffn_halo_fix(nullptr, l, hu_.pm); }
              pg8::EpiRes E{HB, SSP + (size_t)(2 * l + 2) * M * 16};
              GEMM_PHASE(pg8::EpiRes, lds, g, S, E); });
    }
    RUN(12, phase_final(nullptr));
#ifdef PH_TIME
    SEAM1(); phase_phtime_out(nullptr);
#endif
#if DUMP_MIB
    if (lo == 100) phase_dump(nullptr);
#endif
#ifdef CLOCKJUNK
    if (lo == 103 && blockIdx.x == 0) { args_ptr()->out[vtid()] += (float)(__builtin_amdgcn_s_memrealtime() & 1023); }
#endif
}

#undef lo
#undef hi
extern "C" void kernel_launch(void* const* d_in, const int* in_sizes, int n_in, void* d_out, int out_size, void* d_ws, size_t ws_size, hipStream_t stream) {
    static int grid = 0;
    if (grid == 0) {
        if (n_in != 28 || out_size != M * DM || ws_size < WS_END) { fprintf(stderr, "kernel_launch: unexpected shapes: n_in %d out %d ws %zu (need %zu)\n", n_in, out_size, ws_size, (size_t)WS_END); grid = -1; return; }
        int dev = 0, cus = 0, per_cu = 0;
        if (hipGetDevice(&dev) != hipSuccess || hipDeviceGetAttribute(&cus, hipDeviceAttributeMultiprocessorCount, dev) != hipSuccess) { grid = -1; return; }
        if (hipFuncSetAttribute((const void*)mk_fwd, hipFuncAttributeMaxDynamicSharedMemorySize, LDS_BYTES) != hipSuccess) { fprintf(stderr, "kernel_launch: hipFuncSetAttribute failed\n"); grid = -1; return; }
        if (hipOccupancyMaxActiveBlocksPerMultiprocessor(&per_cu, (const void*)mk_fwd, NTHREADS, LDS_BYTES) != hipSuccess || per_cu < 1) { fprintf(stderr, "kernel_launch: occupancy query says %d\n", per_cu); per_cu = 1; }
        (void)hipGetLastError();
        grid = cus * 1;
        if (grid > cus * per_cu) grid = cus * per_cu;
    }
    if (grid < 0) return;
    if (hipMemsetAsync((char*)d_ws + WS_CTL, 0, CTL_ZERO_BYTES, stream) != hipSuccess) { fprintf(stderr, "kernel_launch: memset failed\n"); return; }
    Args a{};
    for (int i = 0; i < 28; ++i) a.in[i] = (const float*)d_in[i];
    a.out = (float*)d_out; a.ws = (unsigned char*)d_ws;
#if MK_MULTI
#ifndef STOP_AFTER
#define STOP_AFTER (N_PHASES - 1)
#endif
    for (int p = 0; p <= STOP_AFTER; ++p) {
        a.ph_lo = p; a.ph_hi = p + 1;
        hipLaunchKernelGGL(mk_fwd, dim3(grid), dim3(NTHREADS), LDS_BYTES, stream, a);
    }
#ifdef CLOCKJUNK
    a.ph_lo = 103; a.ph_hi = 104;
    hipLaunchKernelGGL(mk_fwd, dim3(grid), dim3(NTHREADS), LDS_BYTES, stream, a);
#endif
#if DUMP_MIB
    a.ph_lo = 100; a.ph_hi = 101;
    hipLaunchKernelGGL(mk_fwd, dim3(grid), dim3(NTHREADS), LDS_BYTES, stream, a);
#endif
#else
    a.ph_lo = 0; a.ph_hi = N_PHASES;
    void* kargs[] = {&a};
    hipError_t e = hipLaunchCooperativeKernel((const void*)mk_fwd, dim3(grid), dim3(NTHREADS), kargs, LDS_BYTES, stream);
    if (e != hipSuccess) fprintf(stderr, "kernel_launch: cooperative launch failed: %s (grid %d)\n", hipGetErrorString(e), grid);
#endif
}
```

```cpp
#include <hip/hip_runtime.h>
#include <hip/hip_cooperative_groups.h>
#include <cstdio>
#include <cstdint>
#include <cmath>
namespace cg = cooperative_groups;

#ifndef MK_MULTI
#define MK_MULTI 0
#endif

#ifndef SCAN_CHUNKED
#define SCAN_CHUNKED 1
#endif
#define LW_CUM SCAN_CHUNKED
#ifndef WKV_STREAM
#define WKV_STREAM 1
#endif
#ifndef CK_LWZ
#define CK_LWZ 1.0f
#endif
#ifndef CK_NOSTATE
#define CK_NOSTATE 0
#endif
#ifndef CK_AB
#define CK_AB 1.0f
#endif
constexpr int BATCH = 4, SEQ = 4096, DM = 1024, M = BATCH * SEQ, DEPTH = 2;
constexpr int NH = 8, RD = 512;
constexpr int IN_COLS = 4256, PC = 4352;
constexpr int FF = 2816;
constexpr float NORM_EPS = 1e-6f, LNX_EPS = 64e-5f;
constexpr float C2 = 0.10206207261596577f * 1.4426950408889634f;

namespace pg8 {
#define PG8_LAS __attribute__((address_space(3)))
}
extern __shared__ __attribute__((aligned(16))) unsigned char lds_raw[];
constexpr int WTAB_OFF = 131072 + 448;
__device__ __forceinline__ unsigned hw_wave_key() { return (unsigned)__builtin_amdgcn_s_getreg((5 << 11) | 4) & 63u; }
__device__ __forceinline__ int vtid() {
    const int wv = __builtin_amdgcn_readfirstlane((int)*(volatile PG8_LAS unsigned*)((PG8_LAS unsigned char*)lds_raw + WTAB_OFF + hw_wave_key() * 4u));
    int t_ = (wv << 6) | (int)__builtin_amdgcn_mbcnt_hi(~0u, __builtin_amdgcn_mbcnt_lo(~0u, 0u));
    asm volatile("" : "+v"(t_));
    return t_;
}
__device__ __forceinline__ float shx(float v, int m) {
    int l_ = (int)__builtin_amdgcn_mbcnt_hi(~0u, __builtin_amdgcn_mbcnt_lo(~0u, 0u)); asm volatile("" : "+v"(l_));
    return __builtin_bit_cast(float, __builtin_amdgcn_ds_bpermute((l_ ^ m) << 2, __builtin_bit_cast(int, v)));
}
namespace pg8 {
typedef unsigned short bf16_t;
typedef short bf16x8 __attribute__((ext_vector_type(8)));
typedef float f32x4 __attribute__((ext_vector_type(4)));
typedef unsigned u32x4 __attribute__((ext_vector_type(4)));
constexpr int BM = 256, BK = 64, HALF = 128, HTB = HALF * BK * 2  , STAGE_BYTES = 8 * HTB, NXCD = 8, WGM = 8;

__host__ __device__ __forceinline__ int lds_byte(int r, int c) { const int st = (r >> 4) * 2 + (c >> 5), rr = r & 15, cc = c & 31, ob = rr * 64 + cc * 2; return st * 1024 + (ob ^ (((ob >> 9) & 1) << 5)); }
__host__ __device__ __forceinline__ void stage_rc(int b, int& R, int& C) { const int st = b / 1024, sb = b % 1024, swz = sb ^ (((sb >> 9) & 1) << 5); R = (st >> 1) * 16 + swz / 64; C = (st & 1) * 32 + (swz % 64) / 2; }
__host__ __device__ __forceinline__ int perm32(int rho) { const int n = rho >> 4, i = rho & 15; return 8 * (i >> 2) + 4 * n + (i & 3); }

struct Unit { int pm, pn; };
struct Gemm { const bf16_t* A; const bf16_t* Bt; int M, N, K, lda; unsigned long long* ts = nullptr; };

struct StaticOrder {
    int nM, nN, nwg, G, c;
    __host__ __device__ void init(int M, int N, int G_, int c_) { nM = M / BM; nN = N / BM; nwg = nM * nN; G = G_; c = c_; }
    __host__ __device__ __forceinline__ bool next(int i, Unit& u) const {
        const long L = (long)i * G + c; if (L >= nwg) return false;
        int wgid = (int)L; { const int q = nwg / NXCD, r = nwg % NXCD, xcd = wgid % NXCD, off = wgid / NXCD; wgid = (xcd < r ? xcd * (q + 1) : r * (q + 1) + (xcd - r) * q) + off; }
        const int nig = WGM * nN, gid = wgid / nig, fm = gid * WGM, gsz = (nM - fm) < WGM ? (nM - fm) : WGM;
        u.pm = fm + ((wgid % nig) % gsz); u.pn = (wgid % nig) / gsz; return true;
    }
    __device__ __forceinline__ void a_ready(const Unit&) const {}
    __device__ __forceinline__ void done(const Unit&) const {}
};

__device__ __forceinline__ unsigned cvt_pk_bf16(float lo, float hi) { unsigned r; asm volatile("v_cvt_pk_bf16_f32 %0, %1, %2" : "=v"(r) : "v"(lo), "v"(hi)); return r; }
template <class Epi, class Sched, bool ALIGN_EPI = false, bool SP2 = false>
__device__ __forceinline__ void gemm_phase(PG8_LAS unsigned char* lds, const Gemm g, const Sched& S, const Epi& E) {
    int tid_ = vtid(); asm volatile("" : "+v"(tid_)); const int tid = tid_, wid = __builtin_amdgcn_readfirstlane(tid >> 6), lane = tid & 63, wr = wid >> 2, wc = wid & 3, fr = lane & 15, fq = lane >> 4;
    int Kx_ = g.K; asm volatile("" : "+s"(Kx_)); const int K = Kx_, nt = K / BK;
    unsigned voffA[2], voffB[2];
#pragma unroll
    for (int i = 0; i < 2; ++i) { int R, C; stage_rc(tid * 16 + i * 8192, R, C); const int Rb = Epi::PERM ? ((R & ~31) + perm32(R & 31)) : R;
        voffA[i] = (unsigned)(R * g.lda + C) * 2u; voffB[i] = (unsigned)(Rb * K + C) * 2u; }
    const size_t kstep = (size_t)(BK * 2);
    const size_t hstep = (size_t)HALF * K * 2, hstepA = (size_t)HALF * g.lda * 2;
    const size_t tstep = 2 * hstep, tstepA = 2 * hstepA;
    const unsigned ldsw = (unsigned)wid * 1024u;
    const int aoff = lds_byte(wr * 64 + fr, fq * 8), boff = lds_byte(wc * 32 + fr, fq * 8);
#define PG8_SA(b, h) (((b) * 2 + (h)) * HTB)
#define PG8_SB(b, h) ((4 + (b) * 2 + (h)) * HTB)
#define PG8_STAGE(bufoff, gbase, voff) do { _Pragma("unroll") for (int _i = 0; _i < 2; ++_i) \
        __builtin_amdgcn_global_load_lds((const unsigned*)((const char*)(gbase) + (voff)[_i]), (PG8_LAS unsigned*)(lds + (bufoff) + ldsw + _i * 8192), 16, 0, 0); } while (0)
#define PG8_LDA(dst, b, h) do { _Pragma("unroll") for (int m = 0; m < 4; ++m) _Pragma("unroll") for (int k = 0; k < 2; ++k) dst[m][k] = *(const PG8_LAS bf16x8*)(lds + PG8_SA(b, h) + aoff + m * 2048 + k * 1024); } while (0)
#define PG8_LDB(dst, b, h) do { _Pragma("unroll") for (int n = 0; n < 2; ++n) _Pragma("unroll") for (int k = 0; k < 2; ++k) dst[n][k] = *(const PG8_LAS bf16x8*)(lds + PG8_SB(b, h) + boff + n * 2048 + k * 1024); } while (0)
#define PG8_MMA(ai, bj, At, Bt) do { __builtin_amdgcn_s_setprio(1); _Pragma("unroll") for (int m = 0; m < 4; ++m) _Pragma("unroll") for (int n = 0; n < 2; ++n) _Pragma("unroll") for (int k = 0; k < 2; ++k) \
        acc[ai][bj][m][n] = __builtin_amdgcn_mfma_f32_16x16x32_bf16(Bt[n][k], At[m][k], acc[ai][bj][m][n], 0, 0, 0); __builtin_amdgcn_s_setprio(0); } while (0)
#define PG8_WAIT_V(n) asm volatile("s_waitcnt vmcnt(" #n ")" ::: "memory")
#define PG8_WAIT_L(n) asm volatile("s_waitcnt lgkmcnt(" #n ")" ::: "memory")
#define PG8_BAR __builtin_amdgcn_s_barrier()
#define PG8_SCHED __builtin_amdgcn_sched_barrier(0)
    Unit cur, nxt; int ui = 0;
    if (!S.next(0, cur)) return;
#ifdef PH_SUB
#define PG8_TS(i) do { if (blockIdx.x == 0 && tid == 0) g.ts[i] = __builtin_amdgcn_s_memrealtime(); } while (0)
#else
#define PG8_TS(i) do {} while (0)
#endif
    PG8_TS(0);
    f32x4 acc[2][2][4][2];
#pragma unroll
    for (int a = 0; a < 2; ++a)
#pragma unroll
        for (int b = 0; b < 2; ++b)
#pragma unroll
            for (int m = 0; m < 4; ++m)
#pragma unroll
                for (int n = 0; n < 2; ++n) acc[a][b][m][n] = (f32x4){0.f, 0.f, 0.f, 0.f};
    bf16x8 At[4][2], B0[2][2], B1[2][2];
    const char* cA = (const char*)g.A + (size_t)cur.pm * tstepA; const char* cB = (const char*)g.Bt + (size_t)cur.pn * tstep;
    S.a_ready(cur);
    if constexpr (SP2) {
        PG8_STAGE(PG8_SB(0, 0), cB, voffB); PG8_STAGE(PG8_SB(0, 1), cB + hstep, voffB); PG8_STAGE(PG8_SA(0, 0), cA, voffA); PG8_STAGE(PG8_SA(0, 1), cA + hstepA, voffA);
        if (wr == 1) PG8_BAR;
        PG8_WAIT_V(2); PG8_BAR;
        PG8_STAGE(PG8_SB(1, 0), cB + kstep, voffB); PG8_STAGE(PG8_SA(1, 0), cA + kstep, voffA); PG8_STAGE(PG8_SB(1, 1), cB + hstep + kstep, voffB);
        PG8_WAIT_V(6); PG8_BAR;
    } else {
        PG8_STAGE(PG8_SB(0, 0), cB, voffB); PG8_STAGE(PG8_SA(0, 0), cA, voffA); PG8_STAGE(PG8_SB(0, 1), cB + hstep, voffB); PG8_STAGE(PG8_SA(0, 1), cA + hstepA, voffA);
        if (wr == 1) PG8_BAR;
        PG8_WAIT_V(4); PG8_BAR;
        PG8_STAGE(PG8_SB(1, 0), cB + kstep, voffB); PG8_STAGE(PG8_SA(1, 0), cA + kstep, voffA); PG8_STAGE(PG8_SB(1, 1), cB + hstep + kstep, voffB);
        PG8_WAIT_V(6); PG8_BAR;
    }
    for (;;) {
        const bool has_next = S.next(ui + 1, nxt);
        const char* nA = has_next ? (const char*)g.A + (size_t)nxt.pm * tstepA : cA; const char* nB = has_next ? (const char*)g.Bt + (size_t)nxt.pn * tstep : cB;
#pragma unroll 1
        for (int t = 0; t < nt; t += 2) {
            const bool last = (t == nt - 2);
            const char* a1 = cA + (size_t)(t + 1) * kstep;
            const char* a2 = last ? nA : cA + (size_t)(t + 2) * kstep; const char* b2 = last ? nB : cB + (size_t)(t + 2) * kstep;
            const char* a3 = a2 + kstep; const char* b3 = b2 + kstep;
            if (last && has_next) S.a_ready(nxt);
            if constexpr (SP2) {
            PG8_LDB(B0, 0, 0); PG8_LDB(B1, 0, 1); PG8_SCHED; PG8_LDA(At, 0, 0); PG8_STAGE(PG8_SA(1, 1), a1 + hstepA, voffA);
            PG8_WAIT_V(8); PG8_WAIT_L(0); PG8_BAR; PG8_MMA(0, 0, At, B0); PG8_MMA(0, 1, At, B1); PG8_BAR; PG8_SCHED;
            PG8_LDA(At, 0, 1); PG8_STAGE(PG8_SB(0, 0), b2, voffB); PG8_STAGE(PG8_SB(0, 1), b2 + hstep, voffB); PG8_STAGE(PG8_SA(0, 0), a2, voffA);
            PG8_WAIT_V(8); PG8_WAIT_L(0); PG8_BAR; PG8_MMA(1, 0, At, B0); PG8_MMA(1, 1, At, B1); PG8_BAR; PG8_SCHED;
            PG8_LDB(B0, 1, 0); PG8_LDB(B1, 1, 1); PG8_SCHED; PG8_LDA(At, 1, 0); PG8_STAGE(PG8_SA(0, 1), a2 + hstepA, voffA);
            PG8_WAIT_V(8); PG8_WAIT_L(0); PG8_BAR; PG8_MMA(0, 0, At, B0); PG8_MMA(0, 1, At, B1); PG8_BAR; PG8_SCHED;
            PG8_LDA(At, 1, 1); PG8_STAGE(PG8_SB(1, 0), b3, voffB); PG8_STAGE(PG8_SB(1, 1), b3 + hstep, voffB); PG8_STAGE(PG8_SA(1, 0), a3, voffA);
            PG8_WAIT_V(8); PG8_WAIT_L(0); PG8_BAR; PG8_MMA(1, 0, At, B0); PG8_MMA(1, 1, At, B1); PG8_BAR; PG8_SCHED;
            } else {
            PG8_LDB(B0, 0, 0); PG8_SCHED; PG8_LDA(At, 0, 0); PG8_STAGE(PG8_SA(1, 1), a1 + hstepA, voffA);
            PG8_WAIT_L(8); PG8_BAR; PG8_WAIT_L(0); PG8_MMA(0, 0, At, B0); PG8_BAR; PG8_SCHED;
            PG8_LDB(B1, 0, 1); PG8_STAGE(PG8_SB(0, 0), b2, voffB);
            PG8_BAR; PG8_WAIT_L(0); PG8_MMA(0, 1, At, B1); PG8_BAR;
            PG8_LDA(At, 0, 1); PG8_STAGE(PG8_SA(0, 0), a2, voffA);
            PG8_BAR; PG8_WAIT_L(0); PG8_MMA(1, 0, At, B0); PG8_BAR; PG8_SCHED;
            PG8_STAGE(PG8_SB(0, 1), b2 + hstep, voffB);
            PG8_WAIT_V(6); PG8_BAR; PG8_MMA(1, 1, At, B1); PG8_BAR;
            PG8_LDB(B0, 1, 0); PG8_SCHED; PG8_LDA(At, 1, 0); PG8_STAGE(PG8_SA(0, 1), a2 + hstepA, voffA);
            PG8_WAIT_L(8); PG8_BAR; PG8_WAIT_L(0); PG8_MMA(0, 0, At, B0); PG8_BAR; PG8_SCHED;
            PG8_LDB(B1, 1, 1); PG8_STAGE(PG8_SB(1, 0), b3, voffB);
            PG8_BAR; PG8_WAIT_L(0); PG8_MMA(0, 1, At, B1); PG8_BAR;
            PG8_LDA(At, 1, 1); PG8_STAGE(PG8_SA(1, 0), a3, voffA);
            PG8_BAR; PG8_WAIT_L(0); PG8_MMA(1, 0, At, B0); PG8_BAR; PG8_SCHED;
            PG8_STAGE(PG8_SB(1, 1), b3 + hstep, voffB);
            PG8_WAIT_V(6); PG8_BAR; PG8_MMA(1, 1, At, B1); PG8_BAR;
            }
        }
        if constexpr (ALIGN_EPI) { if (wr == 0) PG8_BAR; }
        PG8_TS(1);
        if constexpr (!Epi::AFTER_DRAIN) { E(acc, cur, wr, wc, fr, fq); S.done(cur); }
        asm volatile("" ::: "memory"); PG8_TS(2);
        if (!has_next) break;
#pragma unroll
        for (int a = 0; a < 2; ++a)
#pragma unroll
            for (int b = 0; b < 2; ++b)
#pragma unroll
                for (int m = 0; m < 4; ++m)
#pragma unroll
                    for (int n = 0; n < 2; ++n) acc[a][b][m][n] = (f32x4){0.f, 0.f, 0.f, 0.f};
        cur = nxt; cA = nA; cB = nB; ++ui;
        if constexpr (ALIGN_EPI) { if (wr == 1) PG8_BAR; }
    }
    PG8_WAIT_V(0);
    if constexpr (!ALIGN_EPI) { if (wr == 0) PG8_BAR; }
    PG8_BAR;
    if constexpr (Epi::AFTER_DRAIN) { E.fused(acc, cur, wr, wc, fr, fq, lds, wid, lane); S.done(cur); }
#undef PG8_SA
#undef PG8_SB
#undef PG8_STAGE
#undef PG8_LDA
#undef PG8_LDB
#undef PG8_MMA
#undef PG8_WAIT_V
#undef PG8_WAIT_L
#undef PG8_BAR
#undef PG8_SCHED
}
}

#define LAS __attribute__((address_space(3)))
typedef unsigned short bf16_t;
typedef short bf16x8 __attribute__((ext_vector_type(8)));
typedef short s16x4 __attribute__((ext_vector_type(4)));
typedef float f32x4 __attribute__((ext_vector_type(4)));
typedef float f32x16 __attribute__((ext_vector_type(16)));
typedef unsigned u32x4 __attribute__((ext_vector_type(4)));
typedef unsigned u32x2 __attribute__((ext_vector_type(2)));

__device__ __forceinline__ float bf2f(unsigned b) { return __uint_as_float(b << 16); }
__device__ __forceinline__ unsigned f2bf(float f) { unsigned u = __float_as_uint(f); return (u + 0x7fffu + ((u >> 16) & 1u)) >> 16; }
typedef float f32x2_t __attribute__((ext_vector_type(2))); typedef __bf16 bf16x2_t __attribute__((ext_vector_type(2)));
__device__ __forceinline__ unsigned pk2(float lo, float hi) { const f32x2_t v = {lo, hi}; const bf16x2_t b = __builtin_convertvector(v, bf16x2_t); return __builtin_bit_cast(unsigned, b); }
__device__ __forceinline__ float sigm(float x) { return 1.0f / (1.0f + __expf(-x)); }
__device__ __forceinline__ f32x4 up4(u32x2 v) { return (f32x4){__uint_as_float(v.x << 16), __uint_as_float(v.x & 0xffff0000u), __uint_as_float(v.y << 16), __uint_as_float(v.y & 0xffff0000u)}; }
__device__ __forceinline__ u32x2 dn4(f32x4 v) { u32x2 r; r.x = pk2(v.x, v.y); r.y = pk2(v.z, v.w); return r; }
__device__ __forceinline__ float dot4(f32x4 a, f32x4 b) { return (a.x * b.x + a.y * b.y) + (a.z * b.z + a.w * b.w); }

constexpr size_t MiB = 1u << 20;
constexpr size_t WS_CTL = 0, CTL_ZERO_BYTES = 2 * MiB;
constexpr size_t WS_STAT = 1 * MiB;
constexpr size_t WS_CS = 2 * MiB;
constexpr size_t WS_W = 4 * MiB;
constexpr size_t W_IN = 0, W_LORA = W_IN + (size_t)PC * 1024 * 2, W_Q = W_LORA + 1536 * 256 * 2, W_KV = W_Q + 768 * 256 * 2,
                 W_OA = W_KV + 1024 * 256 * 2, W_OB = W_OA + 1024 * 512 * 2, W_OUT = W_OB + 1024 * 512 * 2,
                 W_UP = W_OUT + 1024 * 1024 * 2, W_DOWN = W_UP + (size_t)2 * FF * 1024 * 2, W_END = W_DOWN + (size_t)1024 * FF * 2;
static_assert(W_END <= 31 * MiB, "weights region");
constexpr size_t WS_ACT = 35 * MiB;
constexpr size_t A_HB = WS_ACT + 0 * MiB;
constexpr size_t A_RKV = WS_ACT + 32 * MiB;
constexpr size_t A_LORAC = WS_ACT + 80 * MiB;
constexpr size_t A_QP = A_LORAC;
constexpr size_t A_PM = WS_ACT + 88 * MiB;
constexpr size_t A_Y = A_PM;
constexpr size_t A_LIN = WS_ACT + 104 * MiB;
constexpr size_t A_KPE = WS_ACT + 112 * MiB;
constexpr size_t WS_SCAL = WS_ACT + 113 * MiB;
constexpr size_t A_LW = WS_ACT + 114 * MiB;
constexpr size_t A_YA = A_LW;
constexpr size_t A_ICLR = WS_ACT + 130 * MiB;
constexpr size_t A_GATE = WS_ACT + 146 * MiB;
constexpr size_t A_MERGED = A_ICLR;
constexpr size_t A_QN = WS_ACT + 162 * MiB;
constexpr size_t A_KN = WS_ACT + 178 * MiB;
constexpr size_t A_VT = WS_ACT + 194 * MiB;
constexpr size_t A_TMP = WS_ACT + 32 * MiB;
constexpr size_t A_UG = WS_ACT + 32 * MiB;
constexpr size_t A_ACT = WS_ACT + 120 * MiB;
constexpr size_t DO_MTREC = 32 * MiB, MTREC_B = 2304, DO_HALO = DO_MTREC + (size_t)8192 * MTREC_B;
static_assert(DO_HALO + (size_t)(M / 16) * 1536 * 2 <= 64 * MiB, "d_out scratch map");
constexpr size_t WS_SSP = WS_ACT + 210 * MiB;
constexpr size_t WS_SSQP = WS_SSP + 5 * MiB;
constexpr size_t WS_END = WS_SSQP + 1 * MiB;
static_assert(A_UG + (size_t)M * FF * 2 <= A_ACT && A_ACT + (size_t)M * FF * 2 <= WS_SSP && WS_END <= 256 * MiB, "workspace map");
static_assert(A_ICLR == A_LW + (size_t)M * 512 * 2 && A_GATE == A_ICLR + (size_t)M * 512 * 2, "LW | ICLR | GATE consecutive");
constexpr int CW_BAR = 4096, CW_QUEUE = 16384;

#define XB_TMO      128
#define XB_XCNT(j)  (256  + 64 * (j))
#define XB_XSUB(j)  (1280 + 64 * (j))
#define XB_XGEN(j)  (2304 + 64 * (j))
#define XB_TOP      3328
#define XB_TOPGEN   3392
#define XCD_BAR_WORDS 3456
#define XB_SPIN_CAP (1u << 18)
__device__ __forceinline__ unsigned xb_ld(unsigned* p)              { return __hip_atomic_load(p, __ATOMIC_RELAXED, __HIP_MEMORY_SCOPE_AGENT); }
__device__ __forceinline__ unsigned xb_add(unsigned* p, unsigned v) { return __hip_atomic_fetch_add(p, v, __ATOMIC_RELAXED, __HIP_MEMORY_SCOPE_AGENT); }
__device__ __forceinline__ unsigned xb_xcc_id() { return (unsigned)__builtin_amdgcn_s_getreg((3 << 11) | 20) & 0xFu; }
#define XB_SPIN(cond, bar) do { unsigned _sp = 0; while (cond) { __builtin_amdgcn_s_sleep(1); \
    if ((++_sp & 255u) == 0u) { if (xb_ld(&(bar)[XB_TMO])) break; if (_sp > XB_SPIN_CAP) { atomicAdd(&(bar)[XB_TMO], 1u); break; } } } } while (0)
struct XcdBarrier { unsigned* bar; unsigned x; volatile LAS unsigned* st; };
__device__ __forceinline__ XcdBarrier xcd_barrier_post(unsigned* bar, volatile LAS unsigned* st) {
    XcdBarrier b; b.bar = bar; b.x = xb_xcc_id(); b.st = st;
    if (vtid() == 0) (void)xb_add(&bar[XB_XCNT(b.x)], 1u);
    return b;
}
__device__ __forceinline__ void xcd_barrier_complete(unsigned* bar, unsigned x, unsigned& nloc, unsigned& nx) {
    const unsigned G = gridDim.x * gridDim.y * gridDim.z;
    unsigned sum, cnt, mine, sp = 0u;
    for (;;) {
        sum = 0u; cnt = 0u; mine = 0u;
#pragma unroll
        for (unsigned j = 0; j < 16; ++j) { const unsigned c = xb_ld(&bar[XB_XCNT(j)]); sum += c; cnt += (c > 0u) ? 1u : 0u; mine = (j == x) ? c : mine; }
        if (sum == G) break;
        __builtin_amdgcn_s_sleep(1);
        if ((++sp & 255u) == 0u) { if (xb_ld(&bar[XB_TMO])) break; if (sp > XB_SPIN_CAP) { atomicAdd(&bar[XB_TMO], 1u); break; } }
    }
    nloc = mine > 0u ? mine : 1u; nx = cnt > 0u ? cnt : 1u;
}
__device__ __forceinline__ void xcd_barrier(const XcdBarrier& b) {
    asm volatile("s_waitcnt vmcnt(0)" ::: "memory");
    __syncthreads();
    if (vtid() == 0) {
        unsigned* bar = b.bar;
        __builtin_amdgcn_s_waitcnt(0);
        unsigned nloc = b.st[0], nx = b.st[1];
        if (nloc == 0u) { xcd_barrier_complete(bar, b.x, nloc, nx); b.st[0] = nloc; b.st[1] = nx; }
        const unsigned old = xb_add(&bar[XB_XSUB(b.x)], 1u);
        const unsigned gen = old / nloc;
        if (old + 1u == (gen + 1u) * nloc) {
            __builtin_amdgcn_fence(__ATOMIC_RELEASE, "agent");
            asm volatile("s_waitcnt vmcnt(0)" ::: "memory");
            const unsigned og = xb_add(&bar[XB_TOP], 1u);
            const unsigned tg = og / nx;
            if (og + 1u == (tg + 1u) * nx) xb_add(&bar[XB_TOPGEN], 1u);
            else XB_SPIN(xb_ld(&bar[XB_TOPGEN]) == tg, bar);
            __builtin_amdgcn_fence(__ATOMIC_ACQUIRE, "agent");
            xb_add(&bar[XB_XGEN(b.x)], 1u);
            asm volatile("s_waitcnt vmcnt(0)" ::: "memory");
        } else {
            XB_SPIN(xb_ld(&bar[XB_XGEN(b.x)]) == gen, bar);
            __builtin_amdgcn_fence(__ATOMIC_ACQUIRE, "agent");
            asm volatile("s_waitcnt vmcnt(0)" ::: "memory");
        }
    }
    __syncthreads();
}

namespace pg8 {
__device__ __forceinline__ float sum16(const float* p) { const f32x4 a = *(const f32x4*)p, b = *(const f32x4*)(p + 4), c = *(const f32x4*)(p + 8), d = *(const f32x4*)(p + 12);
    return (((a.x + a.y) + (a.z + a.w)) + ((b.x + b.y) + (b.z + b.w))) + (((c.x + c.y) + (c.z + c.w)) + ((d.x + d.y) + (d.z + d.w))); }
__device__ __forceinline__ float sum4(const float* p) { const f32x4 a = *(const f32x4*)p; return (a.x + a.y) + (a.z + a.w); }
__device__ __forceinline__ u32x4 pack8(f32x4 a, f32x4 b) { u32x4 w; w.x = cvt_pk_bf16(a[0], a[1]); w.y = cvt_pk_bf16(a[2], a[3]); w.z = cvt_pk_bf16(b[0], b[1]); w.w = cvt_pk_bf16(b[2], b[3]); return w; }
__device__ __forceinline__ unsigned q8(float s) { return (unsigned)(s * 255.0f + 0.5f); }
__device__ __forceinline__ unsigned sig8x4(f32x4 v) { return q8(sigm(v[0])) | (q8(sigm(v[1])) << 8) | (q8(sigm(v[2])) << 16) | (q8(sigm(v[3])) << 24); }

constexpr int RS_OFF = 131072 + 1024;
#ifndef NT_STORES
#define NT_STORES 0
#endif
#ifndef NT_STORES8
#define NT_STORES8 0
#endif
__device__ __forceinline__ void ST16(bf16_t* p, u32x4 v) {
    if (NT_STORES == 1) __builtin_nontemporal_store(v, (u32x4*)p);
    else if (NT_STORES == 2) asm volatile("global_store_dwordx4 %0, %1, off sc1\n\ts_nop 1" :: "v"(p), "v"(v) : "memory");
    else if (NT_STORES == 3) asm volatile("global_store_dwordx4 %0, %1, off sc0 sc1\n\ts_nop 1" :: "v"(p), "v"(v) : "memory");
    else *(u32x4*)p = v; }
#ifndef NT_UP
#define NT_UP 1
#endif
__device__ __forceinline__ void ST16W(bf16_t* p, u32x4 v) { if (NT_UP) asm volatile("global_store_dwordx4 %0, %1, off sc1\n\ts_nop 1" :: "v"(p), "v"(v) : "memory"); else *(u32x4*)p = v; }
__device__ __forceinline__ void ST8W(void* p, u32x2 v) { asm volatile("global_store_dwordx2 %0, %1, off sc1\n\ts_nop 1" :: "v"(p), "v"(v) : "memory"); }
#ifndef SC1_MIX
#define SC1_MIX 0
#endif
#ifndef SC1_RES
#define SC1_RES 0
#endif
#ifndef SC1_QKV
#define SC1_QKV 0
#endif
template <int W> __device__ __forceinline__ void ST16S(bf16_t* p, u32x4 v) { if (W) asm volatile("global_store_dwordx4 %0, %1, off sc1\n\ts_nop 1" :: "v"(p), "v"(v) : "memory"); else *(u32x4*)p = v; }
template <int W> __device__ __forceinline__ void ST8S(bf16_t* p, u32x2 v) { if (W) asm volatile("global_store_dwordx2 %0, %1, off sc1\n\ts_nop 1" :: "v"(p), "v"(v) : "memory"); else *(u32x2*)p = v; }
__device__ __forceinline__ void ST8(bf16_t* p, u32x2 v) {
    if (NT_STORES8 == 2) asm volatile("global_store_dwordx2 %0, %1, off sc1\n\ts_nop 1" :: "v"(p), "v"(v) : "memory");
    else *(u32x2*)p = v; }
template <int NS> __device__ __forceinline__ void rs_to_lds(PG8_LAS float* rsl, const float* ss, int pm, float inv_n, float mul, int tid) {
    if (tid < 256) { const float* p = ss + (size_t)(pm * BM + tid) * NS; const float s_ = NS == 16 ? sum16(p) : sum4(p); rsl[tid] = rsqrtf(s_ * inv_n + NORM_EPS) * mul; }
    asm volatile("s_waitcnt lgkmcnt(0)" ::: "memory"); __builtin_amdgcn_s_barrier();
}
struct EpiP {
    static constexpr bool PERM = true, AFTER_DRAIN = false;
    bf16_t* RKV; bf16_t* LORAC; bf16_t* PMb; unsigned char* G8; const float* ss; float* ssq; float* sskv; bf16_t* HALO; PG8_LAS float* rsl; int pn0;
    __device__ __forceinline__ void operator()(const f32x4 (&acc)[2][2][4][2], const Unit& u, int wr, int wc, int fr, int fq) const {
        const int row0 = u.pm * BM + wr * 64 + fr, pn = u.pn + pn0;
        rs_to_lds<16>(rsl, ss, u.pm, 1.0f / 1024.0f, 1.0f, (wr * 4 + wc) * 64 + fq * 16 + fr);
#pragma unroll
        for (int ai = 0; ai < 2; ++ai)
#pragma unroll
            for (int m = 0; m < 4; ++m) {
                const int row = row0 + ai * HALF + m * 16;
                const float rs = rsl[wr * 64 + ai * HALF + m * 16 + fr];
                float sq = 0.f;
#pragma unroll
                for (int bj = 0; bj < 2; ++bj) {
                    const f32x4 v0 = acc[ai][bj][m][0] * rs, v1 = acc[ai][bj][m][1] * rs;
                    const int ct = bj * HALF + wc * 32 + 8 * fq;
                    if (pn < 6) { const u32x4 pk_ = pack8(v0, v1); ST16(RKV + (size_t)row * 1536 + pn * 256 + ct, pk_); if (fr == 15) *(u32x4*)(HALO + (size_t)(row >> 4) * 1536 + pn * 256 + ct) = pk_; }
                    else if (pn == 6) ST16(LORAC + (size_t)row * 256 + ct, pack8(v0, v1));
                    else if (pn < 9) { ST16(PMb + (size_t)row * 512 + (pn - 7) * 256 + ct, pack8(v0, v1));
                        if (pn == 7 || bj == 0) sq += dot4(v0, v0) + dot4(v1, v1); }
                    else { u32x2 w; w.x = sig8x4(v0); w.y = sig8x4(v1); ST8((bf16_t*)(G8 + (size_t)row * 2048 + (pn - 9) * 256 + ct), w); }
                }
                if (pn == 7 || pn == 8) { sq += shx(sq, 16); sq += shx(sq, 32); if (fq == 0) (pn == 7 ? ssq : sskv)[(size_t)row * 4 + wc] = sq; }
            }
    }
};
#ifndef LW_CUM
#define LW_CUM 1
#endif
template <int CTRL> __device__ __forceinline__ float dppz(float x) { return __builtin_bit_cast(float, __builtin_amdgcn_update_dpp(0, __builtin_bit_cast(int, x), CTRL, 0xf, 0xf, true)); }
__device__ __forceinline__ float pfx16(float x) { x += dppz<0x111>(x); x += dppz<0x112>(x); x += dppz<0x114>(x); x += dppz<0x118>(x); return x; }
struct EpiLora {
    static constexpr bool PERM = true, AFTER_DRAIN = false;
    bf16_t* LW; bf16_t* ICLR; bf16_t* GATE; const float* dbase; const float* ibase;
    __device__ __forceinline__ void operator()(const f32x4 (&acc)[2][2][4][2], const Unit& u, int wr, int wc, int fr, int fq) const {
        const int pn = u.pn, kind = pn >> 1;
        bf16_t* dst = LW + (size_t)kind * ((size_t)M * 512);
        const float* bias = kind == 0 ? dbase : ibase;
        const unsigned c0 = (pn & 1) * 256 + wc * 32 + 8 * fq;
        const unsigned off0 = (unsigned)(u.pm * BM + wr * 64 + fr) * 512u + c0;
#pragma unroll
        for (int bj = 0; bj < 2; ++bj) {
            f32x4 b0 = (f32x4){0.f, 0.f, 0.f, 0.f}, b1 = b0;
            if (kind < 2) { b0 = *(const f32x4*)(bias + c0 + bj * HALF); b1 = *(const f32x4*)(bias + c0 + bj * HALF + 4); }
#pragma unroll
            for (int ai = 0; ai < 2; ++ai)
#pragma unroll
                for (int m = 0; m < 4; ++m) {
                    f32x4 v0 = acc[ai][bj][m][0] + b0, v1 = acc[ai][bj][m][1] + b1;
                    if (kind == 0) { for (int e = 0; e < 4; ++e) { v0[e] = -0.6065306597126334f * sigm(v0[e]); v1[e] = -0.6065306597126334f * sigm(v1[e]); }
                        if (LW_CUM) { for (int e = 0; e < 4; ++e) { v0[e] = __expf(pfx16(v0[e])); v1[e] = __expf(pfx16(v1[e])); } } }
                    else if (kind == 1) { for (int e = 0; e < 4; ++e) { v0[e] = sigm(v0[e]); v1[e] = sigm(v1[e]); } }
                    ST16(dst + off0 + (unsigned)((ai * HALF + m * 16) * 512 + bj * HALF), pack8(v0, v1));
                    asm volatile("" ::: "memory");
                }
        }
    }
};
struct EpiQ {
    static constexpr bool PERM = false, AFTER_DRAIN = false;
    bf16_t* Qn; bf16_t* Qp; const float* ssq; const float* CS; PG8_LAS float* rsl;
    __device__ __forceinline__ void operator()(const f32x4 (&acc)[2][2][4][2], const Unit& u, int wr, int wc, int fr, int fq) const {
        const int row0 = u.pm * BM + wr * 64 + fr, pn = u.pn;
        if (pn < 2) {
            rs_to_lds<4>(rsl, ssq, u.pm, 1.0f / 256.0f, C2, (wr * 4 + wc) * 64 + fq * 16 + fr);
#pragma unroll
            for (int ai = 0; ai < 2; ++ai)
#pragma unroll
                for (int m = 0; m < 4; ++m) {
                    const int row = row0 + ai * HALF + m * 16;
                    const float rs = rsl[wr * 64 + ai * HALF + m * 16 + fr];
#pragma unroll
                    for (int bj = 0; bj < 2; ++bj)
#pragma unroll
                        for (int n = 0; n < 2; ++n) ST8S<SC1_QKV>(Qn + (size_t)row * 512 + pn * 256 + bj * HALF + wc * 32 + n * 16 + 4 * fq, dn4(acc[ai][bj][m][n] * rs));
                }
        } else {
            f32x4 cs[2][4], sn[2][4];
#pragma unroll
            for (int ai = 0; ai < 2; ++ai)
#pragma unroll
                for (int m = 0; m < 4; ++m) { const int row = row0 + ai * HALF + m * 16; cs[ai][m] = *(const f32x4*)(CS + (size_t)row * 32 + 4 * fq); sn[ai][m] = *(const f32x4*)(CS + (size_t)row * 32 + 16 + 4 * fq); }
            rs_to_lds<4>(rsl, ssq, u.pm, 1.0f / 256.0f, C2, (wr * 4 + wc) * 64 + fq * 16 + fr);
#pragma unroll
            for (int ai = 0; ai < 2; ++ai)
#pragma unroll
                for (int m = 0; m < 4; ++m) {
                    const int row = row0 + ai * HALF + m * 16;
                    const float rs = rsl[wr * 64 + ai * HALF + m * 16 + fr];
#pragma unroll
                    for (int bj = 0; bj < 2; ++bj) {
                        const f32x4 x1 = acc[ai][bj][m][0] * rs, x2 = acc[ai][bj][m][1] * rs;
                        bf16_t* d = Qp + (size_t)row * 256 + (4 * bj + wc) * 32 + 4 * fq;
                        ST8S<SC1_QKV>(d, dn4(x1 * cs[ai][m] - x2 * sn[ai][m])); ST8S<SC1_QKV>(d + 16, dn4(x1 * sn[ai][m] + x2 * cs[ai][m]));
                    }
                }
        }
    }
};
struct EpiKV {
    static constexpr bool PERM = false, AFTER_DRAIN = false;
    bf16_t* Kn; bf16_t* Vt; const float* sskv; PG8_LAS float* rsl;
    __device__ __forceinline__ void operator()(const f32x4 (&acc)[2][2][4][2], const Unit& u, int wr, int wc, int fr, int fq) const {
        const int row0 = u.pm * BM + wr * 64 + fr, pn = u.pn;
        rs_to_lds<4>(rsl, sskv, u.pm, 1.0f / 128.0f, 1.0f, (wr * 4 + wc) * 64 + fq * 16 + fr);
#pragma unroll
        for (int ai = 0; ai < 2; ++ai)
#pragma unroll
            for (int m = 0; m < 4; ++m) {
                const int row = row0 + ai * HALF + m * 16;
                const float rs = rsl[wr * 64 + ai * HALF + m * 16 + fr];
                if (pn < 2) {
#pragma unroll
                    for (int bj = 0; bj < 2; ++bj)
#pragma unroll
                        for (int n = 0; n < 2; ++n) ST8S<SC1_QKV>(Kn + (size_t)row * 512 + pn * 256 + bj * HALF + wc * 32 + n * 16 + 4 * fq, dn4(acc[ai][bj][m][n] * rs));
                } else {
                    const int b = row >> 12, s = row & 4095;
#pragma unroll
                    for (int bj = 0; bj < 2; ++bj)
#pragma unroll
                        for (int n = 0; n < 2; ++n) {
                            const int hd = (pn - 2) * 4 + 2 * bj + (wc >> 1), d = 32 * (wc & 1) + 16 * n + 4 * fq;
                            const f32x4 v = acc[ai][bj][m][n] * rs;
                            bf16_t* dst = Vt + ((size_t)((b * 8 + hd) * 64 + d) << 12) + s;
#pragma unroll
                            for (int j = 0; j < 4; ++j) dst[(size_t)j << 12] = (bf16_t)f2bf(v[j]);
                        }
                }
            }
    }
};
template <int PASS> struct EpiMix {
    static constexpr bool PERM = true, AFTER_DRAIN = false;
    float* TMP; bf16_t* MERGED; const unsigned char* G8;
    template <int AI> __device__ __forceinline__ void load(u32x2 (&g)[4][2], u32x4 (&t)[4][2], int row0, int c0) const {
#pragma unroll
        for (int m = 0; m < 4; ++m)
#pragma unroll
            for (int bj = 0; bj < 2; ++bj) { const size_t row = (size_t)(row0 + AI * HALF + m * 16); const int c = c0 + bj * HALF;
                g[m][bj] = *(const u32x2*)(G8 + row * 2048 + (PASS - 1) * 1024 + c);
                if (PASS == 2) t[m][bj] = *(const u32x4*)(MERGED + row * 1024 + c); }
    }
    template <int AI> __device__ __forceinline__ void calc(const f32x4 (&acc)[2][2][4][2], const u32x2 (&g)[4][2], u32x4 (&t)[4][2]) const {
#pragma unroll
        for (int m = 0; m < 4; ++m)
#pragma unroll
            for (int bj = 0; bj < 2; ++bj) { const unsigned ga = g[m][bj].x, gb = g[m][bj].y;
                const f32x4 sa = (f32x4){(float)(ga & 255u), (float)((ga >> 8) & 255u), (float)((ga >> 16) & 255u), (float)(ga >> 24)} * (1.0f / 255.0f);
                const f32x4 sb = (f32x4){(float)(gb & 255u), (float)((gb >> 8) & 255u), (float)((gb >> 16) & 255u), (float)(gb >> 24)} * (1.0f / 255.0f);
                f32x4 oa = acc[AI][bj][m][0] * sa, ob = acc[AI][bj][m][1] * sb;
                if (PASS == 2) { oa = oa + up4((u32x2){t[m][bj].x, t[m][bj].y}); ob = ob + up4((u32x2){t[m][bj].z, t[m][bj].w}); }
                const u32x2 pa = dn4(oa), pb = dn4(ob); t[m][bj] = (u32x4){pa.x, pa.y, pb.x, pb.y}; }
    }
    template <int AI> __device__ __forceinline__ void store(const u32x4 (&o)[4][2], int row0, int c0) const {
#pragma unroll
        for (int m = 0; m < 4; ++m)
#pragma unroll
            for (int bj = 0; bj < 2; ++bj) ST16S<SC1_MIX>(MERGED + (size_t)(row0 + AI * HALF + m * 16) * 1024 + c0 + bj * HALF, o[m][bj]);
    }
    __device__ __forceinline__ void operator()(const f32x4 (&acc)[2][2][4][2], const Unit& u, int wr, int wc, int fr, int fq) const {
        const int row0 = u.pm * BM + wr * 64 + fr, c0 = u.pn * BM + wc * 32 + 8 * fq;
        u32x2 g0[4][2], g1[4][2]; u32x4 t0[4][2], t1[4][2];
        load<0>(g0, t0, row0, c0); calc<0>(acc, g0, t0);
        load<1>(g1, t1, row0, c0);
        store<0>(t0, row0, c0);
        calc<1>(acc, g1, t1); store<1>(t1, row0, c0);
    }
};
struct EpiRes {
    static constexpr bool PERM = false, AFTER_DRAIN = false;
    bf16_t* HB; float* ssacc;
    __device__ __forceinline__ void operator()(const f32x4 (&acc)[2][2][4][2], const Unit& u, int wr, int wc, int fr, int fq) const {
        const int row0 = u.pm * BM + wr * 64 + fr, c0 = u.pn * BM + wc * 32 + 4 * fq;
        u32x2 b[2][4][2][2];
#pragma unroll
        for (int ai = 0; ai < 2; ++ai)
#pragma unroll
            for (int m = 0; m < 4; ++m)
#pragma unroll
                for (int bj = 0; bj < 2; ++bj)
#pragma unroll
                    for (int n = 0; n < 2; ++n) b[ai][m][bj][n] = *(const u32x2*)(HB + (size_t)(row0 + ai * HALF + m * 16) * 1024 + c0 + bj * HALF + n * 16);
#pragma unroll
        for (int ai = 0; ai < 2; ++ai)
#pragma unroll
            for (int m = 0; m < 4; ++m) {
                const int row = row0 + ai * HALF + m * 16; float sq = 0.f;
#pragma unroll
                for (int bj = 0; bj < 2; ++bj)
#pragma unroll
                    for (int n = 0; n < 2; ++n) {
                        const u32x2 p = dn4(up4(b[ai][m][bj][n]) + acc[ai][bj][m][n]); const f32x4 v = up4(p);
                        ST8S<SC1_RES>(HB + (size_t)row * 1024 + c0 + bj * HALF + n * 16, p); sq += dot4(v, v);
                    }
                sq += shx(sq, 16); sq += shx(sq, 32);
                if (fq == 0) ssacc[(size_t)row * 16 + u.pn * 4 + wc] = sq;
            }
    }
};
typedef float f32x2 __attribute__((ext_vector_type(2)));
__device__ __forceinline__ f32x2 gelu_pk2(f32x2 v) {
    const f32x2 av = __builtin_elementwise_abs(v), d = av * 0.2316418882f + 1.0f;
    f32x2 t; t.x = __builtin_amdgcn_rcpf(d.x); t.y = __builtin_amdgcn_rcpf(d.y);
    f32x2 q = t * 0.5307027145f + (-0.7265760135f); q = q * t + 0.7107068705f; q = q * t + (-0.142248368f); q = q * t + 0.127414796f; q = q * t;
    const f32x2 s2 = (v * v) * (-0.72134752044f);
    f32x2 e; e.x = __builtin_amdgcn_exp2f(s2.x); e.y = __builtin_amdgcn_exp2f(s2.y);
    const f32x2 m = v * (q * e), r = v - m;
    f32x2 o; o.x = v.x < 0.f ? m.x : r.x; o.y = v.y < 0.f ? m.y : r.y; return o;
}
__device__ __forceinline__ f32x4 gelu4(f32x4 c) { const f32x2 g0 = gelu_pk2((f32x2){c.x, c.y}), g1 = gelu_pk2((f32x2){c.z, c.w}); return (f32x4){g0.x, g0.y, g1.x, g1.y}; }
template <int CTRL> __device__ __forceinline__ f32x4 ror4(f32x4 x) { f32x4 r;
#pragma unroll
    for (int e = 0; e < 4; ++e) { const float xe = x[e]; const int xi = __builtin_bit_cast(int, xe); r[e] = __builtin_bit_cast(float, __builtin_amdgcn_update_dpp(xi, xi, CTRL, 0xf, 0xf, false)); }
    return r; }
struct EpiUp {
    static constexpr bool PERM = true, AFTER_DRAIN = false;
    bf16_t* ACT; bf16_t* RAWH; const float* ss; const float* cw; const float* cb; PG8_LAS float* rsl;
    __device__ __forceinline__ void operator()(const f32x4 (&acc)[2][2][4][2], const Unit& u, int wr, int wc, int fr, int fq) const {
        const int tid = (wr * 4 + wc) * 64 + fq * 16 + fr, row0 = u.pm * BM + wr * 64 + fr;
        PG8_LAS float* wl = rsl + 256;
        if (tid >= 256 && tid < 384) { const int j = tid - 256, cg = u.pn * HALF + j; wl[j] = cw[cg]; wl[128 + j] = cw[FF + cg]; wl[256 + j] = cw[2 * FF + cg]; wl[384 + j] = cb[cg]; }
        rs_to_lds<16>(rsl, ss, u.pm, 1.0f / 1024.0f, 1.0f, tid);
        const int cl = wc * 32 + 8 * fq, cgl = u.pn * HALF + cl;
#pragma unroll
        for (int ai = 0; ai < 2; ++ai) {
            f32x4 q1a, q1b, q2a, q2b;
#pragma unroll
            for (int m = 0; m < 4; ++m) {
                const int row = row0 + ai * HALF + m * 16;
                const float rs = rsl[wr * 64 + ai * HALF + m * 16 + fr];
                const PG8_LAS float* wp = wl + cl; asm volatile("" : "+v"(wp));
                const f32x4 w0a = *(const PG8_LAS f32x4*)(wp), w0b = *(const PG8_LAS f32x4*)(wp + 4), w1a = *(const PG8_LAS f32x4*)(wp + 128), w1b = *(const PG8_LAS f32x4*)(wp + 128 + 4);
                const f32x4 w2a = *(const PG8_LAS f32x4*)(wp + 256), w2b = *(const PG8_LAS f32x4*)(wp + 256 + 4), ba = *(const PG8_LAS f32x4*)(wp + 384), bb = *(const PG8_LAS f32x4*)(wp + 384 + 4);
                const f32x4 xa = acc[ai][0][m][0] * rs, xb = acc[ai][0][m][1] * rs, va = acc[ai][1][m][0] * rs, vb = acc[ai][1][m][1] * rs;
                const f32x4 r1a = ror4<0x121>(xa), r1b = ror4<0x121>(xb), r2a = ror4<0x122>(xa), r2b = ror4<0x122>(xb);
                f32x4 p1a = r1a, p1b = r1b, p2a = r2a, p2b = r2b;
                if (m > 0) { if (fr < 1) { p1a = q1a; p1b = q1b; } if (fr < 2) { p2a = q2a; p2b = q2b; } }
                const f32x4 ga = gelu4(ba + w0a * p2a + w1a * p1a + w2a * xa), gb = gelu4(bb + w0b * p2b + w1b * p1b + w2b * xb);
                if (m > 0 || fr >= 2) ST16W(ACT + (size_t)row * FF + cgl, pack8(ga * va, gb * vb));
                if (m == 0) { if (fr < 2) { bf16_t* hp = RAWH + ((size_t)(row >> 6) * 6 + 2 + fr) * FF + cgl; *(u32x4*)hp = pack8(xa, xb); *(u32x4*)(hp + 2 * FF) = pack8(va, vb); } }
                if (m == 3) { if (fr >= 14) *(u32x4*)(RAWH + ((size_t)(row >> 6) * 6 + (fr - 14)) * FF + cgl) = pack8(xa, xb); }
                q1a = r1a; q1b = r1b; q2a = r2a; q2b = r2b;
            }
        }
    }
};
struct EpiUpG {
    static constexpr bool PERM = true, AFTER_DRAIN = false;
    bf16_t* UG; const float* ss; PG8_LAS float* rsl;
    __device__ __forceinline__ void operator()(const f32x4 (&acc)[2][2][4][2], const Unit& u, int wr, int wc, int fr, int fq) const {
        const int row0 = u.pm * BM + wr * 64 + fr;
        rs_to_lds<16>(rsl, ss, u.pm, 1.0f / 1024.0f, 1.0f, (wr * 4 + wc) * 64 + fq * 16 + fr);
#pragma unroll
        for (int ai = 0; ai < 2; ++ai)
#pragma unroll
            for (int m = 0; m < 4; ++m) {
                const int row = row0 + ai * HALF + m * 16;
                const float rs = rsl[wr * 64 + ai * HALF + m * 16 + fr];
#pragma unroll
                for (int bj = 0; bj < 2; ++bj) ST16(UG + (size_t)row * FF + u.pn * BM + bj * HALF + wc * 32 + 8 * fq, pack8(acc[ai][bj][m][0] * rs, acc[ai][bj][m][1] * rs));
            }
    }
};
struct EpiUpV {
    static constexpr bool PERM = true, AFTER_DRAIN = false;
    bf16_t* ACT; const float* ss; PG8_LAS float* rsl;
    __device__ __forceinline__ void operator()(const f32x4 (&acc)[2][2][4][2], const Unit& u, int wr, int wc, int fr, int fq) const {
        const int row0 = u.pm * BM + wr * 64 + fr, c0 = u.pn * BM + wc * 32 + 8 * fq;
        u32x4 gc[2][4][2];
#pragma unroll
        for (int ai = 0; ai < 2; ++ai)
#pragma unroll
            for (int m = 0; m < 4; ++m)
#pragma unroll
                for (int bj = 0; bj < 2; ++bj) gc[ai][m][bj] = *(const u32x4*)(ACT + (size_t)(row0 + ai * HALF + m * 16) * FF + c0 + bj * HALF);
        rs_to_lds<16>(rsl, ss, u.pm, 1.0f / 1024.0f, 1.0f, (wr * 4 + wc) * 64 + fq * 16 + fr);
#pragma unroll
        for (int ai = 0; ai < 2; ++ai)
#pragma unroll
            for (int m = 0; m < 4; ++m) {
                const int row = row0 + ai * HALF + m * 16;
                const float rs = rsl[wr * 64 + ai * HALF + m * 16 + fr];
#pragma unroll
                for (int bj = 0; bj < 2; ++bj) { const u32x4 g = gc[ai][m][bj];
                    *(u32x4*)(ACT + (size_t)row * FF + c0 + bj * HALF) = pack8(up4((u32x2){g.x, g.y}) * (acc[ai][bj][m][0] * rs), up4((u32x2){g.z, g.w}) * (acc[ai][bj][m][1] * rs)); }
            }
    }
};
}


#ifndef NAIVE_GEMM
#define NAIVE_GEMM 0
#endif
#ifndef NAIVE_ATTN
#define NAIVE_ATTN 0
#endif
#ifndef SHFL_SCAN
#define SHFL_SCAN 0
#endif
namespace pg8 {
template <class Epi, class Sched>
__device__ __forceinline__ void gemm_phase_naive(const Gemm g, const Sched& S, const Epi& E) {
    const int tid = vtid(), wid = tid >> 6, lane = tid & 63, wr = wid >> 2, wc = wid & 3, fr = lane & 15, fq = lane >> 4;
    Unit u;
    for (int i = 0; S.next(i, u); ++i) {
        f32x4 acc[2][2][4][2];
        _Pragma("unroll") for (int a = 0; a < 2; ++a) _Pragma("unroll") for (int b = 0; b < 2; ++b) _Pragma("unroll") for (int m = 0; m < 4; ++m) _Pragma("unroll") for (int n = 0; n < 2; ++n) {
            const int row = u.pm * BM + a * HALF + wr * 64 + m * 16 + fr;
            _Pragma("unroll") for (int j = 0; j < 4; ++j) {
                const int col = u.pn * BM + b * HALF + wc * 32 + (Epi::PERM ? 8 * fq + 4 * n + j : 16 * n + 4 * fq + j);
                const bf16_t* ap = g.A + (size_t)row * g.lda; const bf16_t* bp = g.Bt + (size_t)col * g.K;
                float s = 0.f;
                _Pragma("unroll 1") for (int k = 0; k < g.K; k += 8) {
                    const u32x4 av = *(const u32x4*)(ap + k), bv = *(const u32x4*)(bp + k);
                    for (int e = 0; e < 4; ++e) { s += __uint_as_float(av[e] << 16) * __uint_as_float(bv[e] << 16); s += __uint_as_float(av[e] & 0xffff0000u) * __uint_as_float(bv[e] & 0xffff0000u); }
                }
                acc[a][b][m][n][j] = s;
            }
        }
        E(acc, u, wr, wc, fr, fq);
    }
}
}
#if NAIVE_GEMM
#define GEMM_PHASE(EPI, lds, g, S, E) pg8::gemm_phase_naive<EPI, pg8::StaticOrder>(g, S, E)
#else
#define GEMM_PHASE(EPI, lds, g, S, E) pg8::gemm_phase<EPI, pg8::StaticOrder, true, true>(lds, g, S, E)
#endif
struct Args {
    const float* in[28]; float* out; unsigned char* ws; int ph_lo, ph_hi;
};
enum { I_X = 0, I_POS, I_ATTN_NORM, I_W_IN, I_MU, I_DBASE, I_W_DEC, I_IBASE, I_W_ICLR, I_W_GATE, I_KK, I_KA, I_RK, I_LNXW, I_LNXB, I_W_ORWKV, I_QNORM, I_W_QUP,
       I_KVNORM, I_W_KVUP, I_W_OMLA, I_W_OUT, I_FFN_NORM, I_W_UP, I_CONVW, I_CONVB, I_W_DOWN, I_FINAL };

typedef const __attribute__((address_space(4))) Args* ArgsP;
__device__ __forceinline__ ArgsP args_ptr() { ArgsP p = (ArgsP)__builtin_amdgcn_kernarg_segment_ptr(); asm volatile("" : "+s"(p)); return p; }
__device__ __forceinline__ int ltid() { int t = vtid(); asm volatile("" : "+v"(t)); return t; }
constexpr int NWAVES = 8, NTHREADS = 512;
constexpr int RING_BYTES = 131072, MISC_OFF = RING_BYTES + 320, LDS_BYTES = 147456;

__device__ __forceinline__ void tr_item(const float* W, int N, int k0, int n0, bf16_t* dst, int mode, int roff, int ldk, int koff, const float* scale, LAS float* scr, int lane) {
    const int kq = lane >> 4, n4 = (lane & 15) * 4;
    f32x4 v[8];
#pragma unroll
    for (int i = 0; i < 8; ++i) v[i] = (n0 + n4 < N) ? *(const f32x4*)(W + (size_t)(k0 + kq + 4 * i) * N + n0 + n4) : (f32x4){0.f, 0.f, 0.f, 0.f};
#pragma unroll
    for (int i = 0; i < 8; ++i) { const int kk = kq + 4 * i; f32x4 x = v[i]; if (scale) x = x * scale[k0 + kk];
        LAS float* p = scr + kk * 65 + n4; p[0] = x.x; p[1] = x.y; p[2] = x.z; p[3] = x.w; }
    asm volatile("s_waitcnt lgkmcnt(0)" ::: "memory");
    const LAS float* s = scr + lane;
    const int n = n0 + lane;
    int drow = n;
    if (mode == 1) drow = n < 2208 ? n : n + 96;
    else if (mode == 2) { const int h = n / 96, j = n % 96; drow = j < 64 ? h * 64 + j : 512 + h * 32 + (j - 64); }
    else if (mode == 3) { const int h = n >> 7, j = n & 127; drow = j < 64 ? h * 64 + j : 512 + h * 64 + (j - 64); }
    else if (mode == 4) { const int v = n < FF ? n : n - FF; drow = (v >> 7) * 256 + (n < FF ? 0 : 128) + (v & 127); }
    bf16_t* d = dst + (size_t)(drow + roff) * ldk + koff + k0;
    if (n < N)
#pragma unroll
    for (int c = 0; c < 4; ++c) { u32x4 o; o.x = pk2(s[(8 * c + 0) * 65], s[(8 * c + 1) * 65]); o.y = pk2(s[(8 * c + 2) * 65], s[(8 * c + 3) * 65]); o.z = pk2(s[(8 * c + 4) * 65], s[(8 * c + 5) * 65]); o.w = pk2(s[(8 * c + 6) * 65], s[(8 * c + 7) * 65]);
        *(u32x4*)(d + 8 * c) = o; }
    asm volatile("s_waitcnt lgkmcnt(0)" ::: "memory");
}
__device__ __forceinline__ void phase_weights(ArgsP a, int l, LAS unsigned char* lds) {
    a = args_ptr();
    const int tid = ltid(), lane = tid & 63, wave = tid >> 6;
    const int gw = blockIdx.x * NWAVES + wave, NGW = gridDim.x * NWAVES;
    LAS float* scr = (LAS float*)(lds + wave * 16384);
    unsigned char* wb = a->ws + WS_W;
    bf16_t* Wt_in = (bf16_t*)(wb + W_IN); bf16_t* Wt_lora = (bf16_t*)(wb + W_LORA); bf16_t* Wt_q = (bf16_t*)(wb + W_Q); bf16_t* Wt_kv = (bf16_t*)(wb + W_KV);
    bf16_t* Wt_oa = (bf16_t*)(wb + W_OA); bf16_t* Wt_ob = (bf16_t*)(wb + W_OB); bf16_t* Wt_out = (bf16_t*)(wb + W_OUT); bf16_t* Wt_up = (bf16_t*)(wb + W_UP); bf16_t* Wt_down = (bf16_t*)(wb + W_DOWN);
    constexpr int I_IN = 32 * 67, I_DEC = 2 * 8, I_ICL = 2 * 8, I_GAT = 4 * 8, I_Q = 8 * 12, I_KV = 4 * 16, I_OA = 16 * 16, I_OB = 16 * 16, I_OUT = 32 * 16, I_UP = 32 * 88, I_DN = 88 * 16;
    constexpr int NITEMS = I_IN + I_DEC + I_ICL + I_GAT + I_Q + I_KV + I_OA + I_OB + I_OUT + I_UP + I_DN;
    for (int it = gw; it < NITEMS; it += NGW) {
        int r = it;
        const float* W; const float* scale = nullptr; bf16_t* dst; int N, kb, nb, mode = 0, roff = 0, ldk, koff = 0;
        if (r < I_IN) { kb = r / 67; nb = r % 67; W = a->in[I_W_IN] + (size_t)l * 1024 * IN_COLS; N = IN_COLS; dst = Wt_in; mode = 1; ldk = 1024; scale = a->in[I_ATTN_NORM] + l * 1024; }
        else if ((r -= I_IN) < I_DEC) { kb = r / 8; nb = r % 8; W = a->in[I_W_DEC] + (size_t)l * 64 * 512; N = 512; dst = Wt_lora; ldk = 256; }
        else if ((r -= I_DEC) < I_ICL) { kb = r / 8; nb = r % 8; W = a->in[I_W_ICLR] + (size_t)l * 64 * 512; N = 512; dst = Wt_lora; roff = 512; ldk = 256; koff = 64; }
        else if ((r -= I_ICL) < I_GAT) { kb = r / 8; nb = r % 8; W = a->in[I_W_GATE] + (size_t)l * 128 * 512; N = 512; dst = Wt_lora; roff = 1024; ldk = 256; koff = 128; }
        else if ((r -= I_GAT) < I_Q) { kb = r / 12; nb = r % 12; W = a->in[I_W_QUP] + (size_t)l * 256 * 768; N = 768; dst = Wt_q; mode = 2; ldk = 256; scale = a->in[I_QNORM] + l * 256; }
        else if ((r -= I_Q) < I_KV) { kb = r / 16; nb = r % 16; W = a->in[I_W_KVUP] + (size_t)l * 128 * 1024; N = 1024; dst = Wt_kv; mode = 3; ldk = 256; scale = a->in[I_KVNORM] + l * 128; }
        else if ((r -= I_KV) < I_OA) { kb = r / 16; nb = r % 16; W = a->in[I_W_ORWKV] + (size_t)l * 512 * 1024; N = 1024; dst = Wt_oa; ldk = 512; }
        else if ((r -= I_OA) < I_OB) { kb = r / 16; nb = r % 16; W = a->in[I_W_OMLA] + (size_t)l * 512 * 1024; N = 1024; dst = Wt_ob; ldk = 512; }
        else if ((r -= I_OB) < I_OUT) { kb = r / 16; nb = r % 16; W = a->in[I_W_OUT] + (size_t)l * 1024 * 1024; N = 1024; dst = Wt_out; ldk = 1024; }
        else if ((r -= I_OUT) < I_UP) { kb = r / 88; nb = r % 88; W = a->in[I_W_UP] + (size_t)l * 1024 * 2 * FF; N = 2 * FF; dst = Wt_up; mode = 4; ldk = 1024; scale = a->in[I_FFN_NORM] + l * 1024; }
        else { r -= I_UP; kb = r / 16; nb = r % 16; W = a->in[I_W_DOWN] + (size_t)l * FF * 1024; N = 1024; dst = Wt_down; ldk = FF; }
        tr_item(W, N, kb * 32, nb * 64, dst, mode, roff, ldk, koff, scale, scr, lane);
    }
    const int gt = blockIdx.x * NTHREADS + tid, NGT = gridDim.x * NTHREADS;
    unsigned z0_ = 0u; asm volatile("" : "+v"(z0_));
    const u32x4 z = (u32x4){z0_, z0_, z0_, z0_};
    for (int i = gt; i < 96 * 128; i += NGT) *(u32x4*)(Wt_in + (size_t)(2208 + i / 128) * 1024 + (i % 128) * 8) = z;
    for (int i = gt; i < 1536 * 32; i += NGT) { const int row = i / 32, k8 = (i % 32) * 8, kind = row >> 9; const bool live = kind == 0 ? (k8 < 64) : (kind == 1 ? (k8 >= 64 && k8 < 128) : (k8 >= 128)); if (!live) *(u32x4*)(Wt_lora + (size_t)row * 256 + k8) = z; }
    for (int i = gt; i < 1024 * 16; i += NGT) *(u32x4*)(Wt_kv + (size_t)(i / 16) * 256 + 128 + (i % 16) * 8) = z;
#ifdef SCRIBBLE
    if (l == 0) { u32x4* p = (u32x4*)(a->ws + WS_ACT); const u32x4 pz = (u32x4){0xAAAAAAAAu, 0xAAAAAAAAu, 0xAAAAAAAAu, 0xAAAAAAAAu};
        for (unsigned i = gt; i < 178u * 65536u; i += NGT) p[i] = pz; }
#endif
    if (l == 0) {
        float* SS0 = (float*)(a->ws + WS_SSP); bf16_t* HB = (bf16_t*)(a->ws + A_HB);
        for (int m = gw; m < M; m += NGW) {
            const f32x4* xr = (const f32x4*)(a->in[I_X] + (size_t)m * DM) + lane; float s = 0.f;
            u32x2* o = (u32x2*)(HB + (size_t)m * DM) + lane;
#pragma unroll
            for (int j = 0; j < 4; ++j) { const f32x4 v = xr[64 * j]; s += dot4(v, v); o[64 * j] = dn4(v); }
#pragma unroll
            for (int o2 = 1; o2 < 64; o2 <<= 1) s += shx(s, o2);
            if (lane < 16) SS0[(size_t)m * 16 + lane] = lane == 0 ? s : 0.f;
        }
        float* CS = (float*)(a->ws + WS_CS); const int* pos = (const int*)a->in[I_POS];
        for (int i = gt; i < M * 16; i += NGT) { const int row = i >> 4, f = i & 15;
            const float invf = exp2f(-0.830482023721841f * (float)f);
            const float ang = (float)pos[row] * invf;
            const float k = rintf(ang * 0.15915494309189535f);
            float rr = fmaf(-k, 6.2831854820251465f, ang); rr = fmaf(-k, -1.7484555314695172e-07f, rr);
            CS[(size_t)row * 32 + f] = cosf(rr); CS[(size_t)row * 32 + 16 + f] = sinf(rr); }
    }
}

__device__ __forceinline__ void phase_prep(ArgsP a, int l) {
    a = args_ptr();
    const unsigned gt = blockIdx.x * NTHREADS + ltid(), NGT = gridDim.x * NTHREADS;
    const bf16_t* LORAC = (const bf16_t*)(a->ws + A_LORAC); bf16_t* LIN = (bf16_t*)(a->ws + A_LIN);
    {
        const int j = (gt & 31) * 8; const float* mu = a->in[I_MU] + (size_t)l * 1792 + 1536 + j;
        const f32x4 m0 = *(const f32x4*)mu, m1 = *(const f32x4*)(mu + 4);
        for (unsigned i = gt; i < (unsigned)M * 32; i += NGT) { const unsigned row = i >> 5; const int t = row & 4095;
            const u32x4 cu = *(const u32x4*)(LORAC + (size_t)row * 256 + j); const u32x4 pv = t ? *(const u32x4*)(LORAC + (size_t)(row - 1) * 256 + j) : (u32x4){0u, 0u, 0u, 0u};
            const f32x4 c0 = up4((u32x2){cu.x, cu.y}), c1 = up4((u32x2){cu.z, cu.w}), q0 = up4((u32x2){pv.x, pv.y}), q1 = up4((u32x2){pv.z, pv.w});
            f32x4 s0 = c0 + (q0 - c0) * m0, s1 = c1 + (q1 - c1) * m1;
            if (j < 64) { for (int e = 0; e < 4; ++e) { s0[e] = tanhf(s0[e]); s1[e] = tanhf(s1[e]); } } else if (j >= 128) { for (int e = 0; e < 4; ++e) { s0[e] = sigm(s0[e]); s1[e] = sigm(s1[e]); } }
            const u32x2 o0 = dn4(s0), o1 = dn4(s1); *(u32x4*)(LIN + (size_t)row * 256 + j) = (u32x4){o0.x, o0.y, o1.x, o1.y}; }
    }
    const bf16_t* PMb = (const bf16_t*)(a->ws + A_PM); bf16_t* KPE = (bf16_t*)(a->ws + A_KPE); const float* CS = (const float*)(a->ws + WS_CS);
    for (unsigned i = gt; i < (unsigned)M * 4; i += NGT) { const unsigned row = i >> 2; const int f = (i & 3) * 4;
        const f32x4 x1 = up4(*(const u32x2*)(PMb + (size_t)row * 512 + 384 + f)), x2 = up4(*(const u32x2*)(PMb + (size_t)row * 512 + 400 + f));
        const f32x4 cs = *(const f32x4*)(CS + (size_t)row * 32 + f), sn = *(const f32x4*)(CS + (size_t)row * 32 + 16 + f);
        *(u32x2*)(KPE + (size_t)row * 32 + f) = dn4(x1 * cs - x2 * sn); *(u32x2*)(KPE + (size_t)row * 32 + 16 + f) = dn4(x1 * sn + x2 * cs); }
}

template <int CTRL> __device__ __forceinline__ float dppf(float x) { return __builtin_bit_cast(float, __builtin_amdgcn_update_dpp(0, __builtin_bit_cast(int, x), CTRL, 0xf, 0xf, false)); }
#if SHFL_SCAN
__device__ __forceinline__ float rr16(float x) { x += shx(x, 8); x += shx(x, 4); x += shx(x, 2); x += shx(x, 1); return x; }
#else
__device__ __forceinline__ float rr16(float x) { x += dppf<0x128>(x); x += dppf<0x124>(x); x += dppf<0x122>(x); x += dppf<0x121>(x); return x; }
#endif

typedef float f32x2 __attribute__((ext_vector_type(2)));
constexpr int SC_BUF = 43008, SC_R = 0, SC_W = 8192, SC_K = 16384, SC_A = 24576, SC_B = 32768, SC_V = 40960, SC_YP = 2 * SC_BUF, SC_YPB = 8192;
struct ScOps { f32x4 a, w, b, k, r; float v; };
__device__ __forceinline__ void sc_ld(ScOps& o, const LAS unsigned char* bp, const LAS unsigned char* vp, int t) {
    o.a = *(const LAS f32x4*)(bp + SC_A + t * 256); o.w = *(const LAS f32x4*)(bp + SC_W + t * 256); o.b = *(const LAS f32x4*)(bp + SC_B + t * 256);
    o.k = *(const LAS f32x4*)(bp + SC_K + t * 256); o.r = *(const LAS f32x4*)(bp + SC_R + t * 256); o.v = *(const LAS float*)(vp + t * 64);
}
__device__ __forceinline__ void scan_unit(ArgsP a, int l, int bh, int q4, LAS unsigned char* lds, size_t y_off = A_Y) {
    a = args_ptr();
    const int tid = ltid(), lane = tid & 63, wid = __builtin_amdgcn_readfirstlane(tid >> 6);
    const int b = bh >> 3, h = bh & 7, i0 = q4 * 16;
    const bf16_t* RKV = (const bf16_t*)(a->ws + A_RKV); const bf16_t* LW = (const bf16_t*)(a->ws + A_LW); const bf16_t* ICLR = (const bf16_t*)(a->ws + A_ICLR);
    bf16_t* Y = (bf16_t*)(a->ws + y_off); float* SCAL = (float*)(a->ws + WS_SCAL);
    constexpr int NCH = SEQ / 32;
    if (wid >= 4) {
        const int ht = tid - 256, pcg = ht & 15, tau0 = ht >> 4, ch = h * 64 + 4 * pcg;
        const float* mu = a->in[I_MU] + (size_t)l * 1792;
        const f32x4 mu_r = *(const f32x4*)(mu + ch), mu_k = *(const f32x4*)(mu + 512 + ch), mu_v = *(const f32x4*)(mu + 1024 + ch);
        const f32x4 kk_c = *(const f32x4*)(a->in[I_KK] + l * 512 + ch), ka_c = *(const f32x4*)(a->in[I_KA] + l * 512 + ch), rk_c = *(const f32x4*)(a->in[I_RK] + l * 512 + ch);
        u32x2 g[2][8];
        const u32x2 z2 = (u32x2){0u, 0u};
#define SC_LOAD(c) do { _Pragma("unroll") for (int k_ = 0; k_ < 2; ++k_) { const int t_ = (c) * 32 + tau0 + 16 * k_; const size_t row_ = (size_t)b * SEQ + t_; \
            g[k_][0] = *(const u32x2*)(RKV + row_ * 1536 + ch); g[k_][1] = *(const u32x2*)(RKV + row_ * 1536 + 512 + ch); g[k_][2] = *(const u32x2*)(RKV + row_ * 1536 + 1024 + ch); \
            if (t_) { g[k_][3] = *(const u32x2*)(RKV + (row_ - 1) * 1536 + ch); g[k_][4] = *(const u32x2*)(RKV + (row_ - 1) * 1536 + 512 + ch); g[k_][5] = *(const u32x2*)(RKV + (row_ - 1) * 1536 + 1024 + ch); } \
            else { g[k_][3] = z2; g[k_][4] = z2; g[k_][5] = z2; } \
            g[k_][6] = *(const u32x2*)(LW + row_ * 512 + ch); g[k_][7] = *(const u32x2*)(ICLR + row_ * 512 + ch); } } while (0)
#define SC_STORE(c, p) do { _Pragma("unroll") for (int k_ = 0; k_ < 2; ++k_) { const int tau_ = tau0 + 16 * k_; LAS unsigned char* base_ = lds + (p) * SC_BUF + tau_ * 256 + pcg * 16; \
            const f32x4 r2 = up4(g[k_][0]), k2 = up4(g[k_][1]), v2 = up4(g[k_][2]); \
            const f32x4 r = r2 + (up4(g[k_][3]) - r2) * mu_r, k = k2 + (up4(g[k_][4]) - k2) * mu_k, v = v2 + (up4(g[k_][5]) - v2) * mu_v; \
            const f32x4 lw = up4(g[k_][6]), ic = up4(g[k_][7]); \
            f32x4 kk = k * kk_c; float ssum = dot4(kk, kk); ssum += shx(ssum, 1); ssum += shx(ssum, 2); ssum += shx(ssum, 4); ssum += shx(ssum, 8); \
            kk = kk * rsqrtf(ssum + 1e-12f); \
            const f32x4 kp = k * (1.0f + (ic - 1.0f) * ka_c); \
            float sc = dot4(r * kp, rk_c); sc += shx(sc, 1); sc += shx(sc, 2); sc += shx(sc, 4); sc += shx(sc, 8); \
            if (q4 == 0 && pcg == 0) SCAL[((size_t)b * SEQ + (c) * 32 + tau_) * 8 + h] = sc; \
            f32x4 w; w.x = __expf(lw.x * CK_LWZ); w.y = __expf(lw.y * CK_LWZ); w.z = __expf(lw.z * CK_LWZ); w.w = __expf(lw.w * CK_LWZ); \
            *(LAS f32x4*)(base_ + SC_R) = r; *(LAS f32x4*)(base_ + SC_W) = w; *(LAS f32x4*)(base_ + SC_K) = kp; *(LAS f32x4*)(base_ + SC_A) = -kk * CK_AB; *(LAS f32x4*)(base_ + SC_B) = kk * ic * CK_AB; \
            if ((pcg >> 2) == q4) *(LAS f32x4*)(lds + (p) * SC_BUF + SC_V + tau_ * 64 + (pcg & 3) * 16) = v; } } while (0)
        SC_LOAD(0); SC_STORE(0, 0); SC_LOAD(1);
        __syncthreads();
        for (int c = 0; c < NCH; ++c) {
            if (c + 1 < NCH) { SC_STORE(c + 1, (c + 1) & 1); if (c + 2 < NCH) SC_LOAD(c + 2); }
            if (c > 0) {
                const LAS f32x4* yp = (const LAS f32x4*)(lds + SC_YP + ((c - 1) & 1) * SC_YPB + (ht >> 3) * 256 + (ht & 7) * 32);
                const f32x4 y0 = yp[0], y1 = yp[1];
                *(unsigned*)(Y + ((size_t)b * SEQ + (c - 1) * 32 + (ht >> 3)) * 512 + h * 64 + i0 + 2 * (ht & 7)) = pk2((y0.x + y0.y) + (y0.z + y0.w), (y1.x + y1.y) + (y1.z + y1.w));
            }
            __syncthreads();
        }
        { const int c = NCH;
          const LAS f32x4* yp = (const LAS f32x4*)(lds + SC_YP + ((c - 1) & 1) * SC_YPB + (ht >> 3) * 256 + (ht & 7) * 32);
          const f32x4 y0 = yp[0], y1 = yp[1];
          *(unsigned*)(Y + ((size_t)b * SEQ + (c - 1) * 32 + (ht >> 3)) * 512 + h * 64 + i0 + 2 * (ht & 7)) = pk2((y0.x + y0.y) + (y0.z + y0.w), (y1.x + y1.y) + (y1.z + y1.w)); }
#undef SC_LOAD
#undef SC_STORE
    } else {
        const int rloc = wid * 4 + (lane >> 4), cgp = lane & 15;
        __syncthreads();
        f32x2 s01 = (f32x2){0.f, 0.f}, s23 = s01;
        for (int c = 0; c < NCH; ++c) {
            const int p = c & 1;
            const LAS unsigned char* bp = lds + p * SC_BUF + cgp * 16;
            const LAS unsigned char* vp = lds + p * SC_BUF + SC_V + rloc * 4;
            LAS float* ypw = (LAS float*)(lds + SC_YP + p * SC_YPB) + rloc * 4 + cgp;
            ScOps oa, ob;
            sc_ld(oa, bp, vp, 0);
#define SC_STEP(cur, nxt, t) do { if ((t) + 1 < 32) sc_ld(nxt, bp, vp, (t) + 1); if (CK_NOSTATE && ((t) & 15) == 0) { s01 = (f32x2){0.f, 0.f}; s23 = s01; } \
                const f32x2 vk0 = (f32x2){cur.k.x, cur.k.y} * cur.v, vk1 = (f32x2){cur.k.z, cur.k.w} * cur.v; \
                const f32x2 t0 = s01 * (f32x2){cur.w.x, cur.w.y} + vk0, t1 = s23 * (f32x2){cur.w.z, cur.w.w} + vk1; \
                f32x2 pd = s01 * (f32x2){cur.a.x, cur.a.y}; pd = s23 * (f32x2){cur.a.z, cur.a.w} + pd; \
                const float d = rr16(pd.x + pd.y); \
                s01 = (f32x2){cur.b.x, cur.b.y} * d + t0; s23 = (f32x2){cur.b.z, cur.b.w} * d + t1; \
                f32x2 qd = s01 * (f32x2){cur.r.x, cur.r.y}; qd = s23 * (f32x2){cur.r.z, cur.r.w} + qd; \
                float y = qd.x + qd.y; y += dppf<0x128>(y); y += dppf<0x124>(y); \
                if (cgp < 4) ypw[(t) * 64] = y; } while (0)
#pragma unroll 1
            for (int t = 0; t < 32; t += 2) { SC_STEP(oa, ob, t); SC_STEP(ob, oa, t + 1); }
#undef SC_STEP
            __syncthreads();
        }
    }
    __syncthreads();
}

typedef short s16x4v __attribute__((ext_vector_type(4)));
constexpr int CK_ROW = 144;
constexpr int CK_AT = 0, CK_RT = 2304, CK_BT = 4608, CK_KT = 6912, CK_VT = 9216, CK_GL = 11520, CK_OPB = 11776, CK_NOP = 5;
constexpr int CK_MT0 = CK_NOP * CK_OPB, CK_MAK = 0, CK_MRB = 512, CK_MRK = 1024, CK_TT = 1536, CK_MAB = 2048, CK_MTB = 2048 + 16 * 80, CK_NMT = 4;
constexpr int CK_YT0 = CK_MT0 + CK_NMT * CK_MTB, CK_YTB = 1024;
typedef short v4i16_t __attribute__((ext_vector_type(4)));
__device__ __forceinline__ s16x4v ldtr(const LAS unsigned char* p) { return __builtin_bit_cast(s16x4v, __builtin_amdgcn_ds_read_tr16_b64_v4i16((LAS v4i16_t*)p)); }
__device__ __forceinline__ s16x4v pk4(f32x4 v) { const u32x2 p = dn4(v); return __builtin_bit_cast(s16x4v, p); }
__device__ __forceinline__ void scan_unit_chunked(ArgsP a, int l, int bh, int q4, LAS unsigned char* lds, size_t y_off = A_Y) {
    a = args_ptr();
    const int tid = ltid(), lane = tid & 63, wid = __builtin_amdgcn_readfirstlane(tid >> 6);
    const int b = bh >> 3, h = bh & 7, i0 = q4 * 16, q = lane >> 4, l15 = lane & 15;
    const bf16_t* RKV = (const bf16_t*)(a->ws + A_RKV); const bf16_t* EG = (const bf16_t*)(a->ws + A_LW); const bf16_t* ICLR = (const bf16_t*)(a->ws + A_ICLR);
    bf16_t* Y = (bf16_t*)(a->ws + y_off); float* SCAL = (float*)(a->ws + WS_SCAL);
    constexpr int NCH = SEQ / 16;
    const int ht = tid - 256, t_h = (ht >> 4) & 15, jg = ht & 15, ch = h * 64 + 4 * jg;
    f32x4 mu_r, mu_k, mu_v, kk_c, ka_c, rk_c;
    u32x2 g[10], g1[10], g2[10];
    if (wid >= 4) {
        const float* mu = a->in[I_MU] + (size_t)l * 1792;
        mu_r = *(const f32x4*)(mu + ch); mu_k = *(const f32x4*)(mu + 512 + ch); mu_v = *(const f32x4*)(mu + 1024 + ch);
        kk_c = *(const f32x4*)(a->in[I_KK] + l * 512 + ch); ka_c = *(const f32x4*)(a->in[I_KA] + l * 512 + ch); rk_c = *(const f32x4*)(a->in[I_RK] + l * 512 + ch);
    }
#define CK_LOAD(G_, c) do { const int t_ = (c) * 16 + t_h; const size_t row_ = (size_t)b * SEQ + t_; const size_t rp_ = t_ ? row_ - 1 : row_; \
        G_[0] = *(const u32x2*)(RKV + row_ * 1536 + ch); G_[1] = *(const u32x2*)(RKV + row_ * 1536 + 512 + ch); G_[2] = *(const u32x2*)(RKV + row_ * 1536 + 1024 + ch); \
        G_[3] = *(const u32x2*)(RKV + rp_ * 1536 + ch); G_[4] = *(const u32x2*)(RKV + rp_ * 1536 + 512 + ch); G_[5] = *(const u32x2*)(RKV + rp_ * 1536 + 1024 + ch); \
        G_[6] = *(const u32x2*)(ICLR + row_ * 512 + ch); G_[7] = *(const u32x2*)(EG + row_ * 512 + ch); \
        G_[8] = *(const u32x2*)(EG + (row_ - (t_h ? 1 : 0)) * 512 + ch); G_[9] = *(const u32x2*)(EG + ((size_t)b * SEQ + (c) * 16 + 15) * 512 + ch); } while (0)
    f32x4 accS[4];
#pragma unroll
    for (int jt = 0; jt < 4; ++jt) accS[jt] = (f32x4){0.f, 0.f, 0.f, 0.f};
    float x[16];
#pragma unroll
    for (int t_ = 0; t_ < 16; ++t_) x[t_] = 0.f;
#define CK_OPSTAGE(G_, it) do { \
            if (it < NCH) { \
                LAS unsigned char* op = lds + (it % CK_NOP) * CK_OPB; \
                const f32x4 r2 = up4(G_[0]), k2 = up4(G_[1]), v2 = up4(G_[2]); \
                const float pz_ = (it * 16 + t_h) ? 1.0f : 0.0f; \
                const f32x4 r = r2 + (up4(G_[3]) * pz_ - r2) * mu_r, k = k2 + (up4(G_[4]) * pz_ - k2) * mu_k, v = v2 + (up4(G_[5]) * pz_ - v2) * mu_v, ic = up4(G_[6]); \
                const f32x4 eG = up4(G_[7]), eGL = up4(G_[9]); \
                f32x4 eGx = up4(G_[8]); if (t_h == 0) eGx = (f32x4){1.f, 1.f, 1.f, 1.f}; \
                f32x4 enG; \
_Pragma("unroll") \
                for (int e = 0; e < 4; ++e) enG[e] = __builtin_amdgcn_rcpf(eG[e]); \
                f32x4 kk = k * kk_c; const float ssum = rr16(dot4(kk, kk)); \
                kk = kk * rsqrtf(ssum + 1e-12f); \
                const f32x4 kp = k * (1.0f + (ic - 1.0f) * ka_c), bb = kk * ic; \
                const float sc = rr16(dot4(r * kp, rk_c)); \
                if (q4 == 0 && jg == 0) SCAL[((size_t)b * SEQ + it * 16 + t_h) * 8 + h] = sc; \
                *(LAS u32x2*)(op + CK_AT + t_h * CK_ROW + jg * 8) = dn4(-(kk * eGx)); \
                *(LAS u32x2*)(op + CK_RT + t_h * CK_ROW + jg * 8) = dn4(r * eG); \
                *(LAS u32x2*)(op + CK_BT + t_h * CK_ROW + jg * 8) = dn4(bb * enG); \
                *(LAS u32x2*)(op + CK_KT + t_h * CK_ROW + jg * 8) = dn4(kp * enG); \
                *(LAS u32x2*)(op + CK_VT + t_h * CK_ROW + jg * 8) = dn4(v); \
                if (t_h == 0) *(LAS f32x4*)(op + CK_GL + jg * 16) = eGL; \
            } \
            if (it + 3 < NCH) CK_LOAD(G_, it + 3); \
        } while (0)
    if (wid >= 4) { CK_LOAD(g, 0); CK_LOAD(g1, 1); CK_LOAD(g2, 2); }
#ifdef CK_TIME
    unsigned long long tb_ = 0, t0_ = 0; const unsigned long long tstart_ = __builtin_readcyclecounter();
#define CK_T0() (t0_ = __builtin_readcyclecounter())
#define CK_T1() (tb_ += __builtin_readcyclecounter() - t0_)
#else
#define CK_T0() do {} while (0)
#define CK_T1() do {} while (0)
#endif
    constexpr int NIT = ((NCH + 6 + 2) / 3) * 3;
    if (wid >= 4) {
#define CK_YSTORE(it) do { if (wid == 4 && (it) >= 5 && (it) - 5 < NCH) { \
            const LAS float* yt = (const LAS float*)(lds + CK_YT0 + (((it) - 5) & 1) * CK_YTB); const int t_ = lane >> 2, ip = (lane & 3) * 4; \
            const f32x4 yv = *(const LAS f32x4*)(yt + t_ * 16 + ip); \
            *(u32x2*)(Y + ((size_t)b * SEQ + ((it) - 5) * 16 + t_) * 512 + h * 64 + i0 + ip) = dn4(yv); } } while (0)
        for (int it3 = 0; it3 < NIT; it3 += 3) {
            CK_T0(); CK_OPSTAGE(g, it3); CK_YSTORE(it3); CK_T1(); __syncthreads();
            CK_T0(); CK_OPSTAGE(g1, (it3 + 1)); CK_YSTORE((it3 + 1)); CK_T1(); __syncthreads();
            CK_T0(); CK_OPSTAGE(g2, (it3 + 2)); CK_YSTORE((it3 + 2)); CK_T1(); __syncthreads();
        }
#undef CK_YSTORE
    } else
    for (int it = 0; it < NIT; ++it) {
        CK_T0();
        if (wid >= 1) {
            const int ph3 = (it + 3 - wid) % 3;
            const int c = it - 1 - ph3;
            if (c >= 0 && c < NCH) {
                const LAS unsigned char* op = lds + (c % CK_NOP) * CK_OPB; LAS unsigned char* mt = lds + CK_MT0 + (c % CK_NMT) * CK_MTB;
                if (ph3 == 0) {
                    const int ro = l15 * CK_ROW + q * 16;
                    const bf16x8 at0 = *(const LAS bf16x8*)(op + CK_AT + ro), at1 = *(const LAS bf16x8*)(op + CK_AT + ro + 64), rt0 = *(const LAS bf16x8*)(op + CK_RT + ro), rt1 = *(const LAS bf16x8*)(op + CK_RT + ro + 64);
                    const bf16x8 bt0 = *(const LAS bf16x8*)(op + CK_BT + ro), bt1 = *(const LAS bf16x8*)(op + CK_BT + ro + 64), kt0 = *(const LAS bf16x8*)(op + CK_KT + ro), kt1 = *(const LAS bf16x8*)(op + CK_KT + ro + 64);
                    const f32x4 z = (f32x4){0.f, 0.f, 0.f, 0.f};
                    f32x4 mab = __builtin_amdgcn_mfma_f32_16x16x32_bf16(at0, bt0, z, 0, 0, 0); mab = __builtin_amdgcn_mfma_f32_16x16x32_bf16(at1, bt1, mab, 0, 0, 0);
                    f32x4 mak = __builtin_amdgcn_mfma_f32_16x16x32_bf16(at0, kt0, z, 0, 0, 0); mak = __builtin_amdgcn_mfma_f32_16x16x32_bf16(at1, kt1, mak, 0, 0, 0);
                    f32x4 mrb = __builtin_amdgcn_mfma_f32_16x16x32_bf16(rt0, bt0, z, 0, 0, 0); mrb = __builtin_amdgcn_mfma_f32_16x16x32_bf16(rt1, bt1, mrb, 0, 0, 0);
                    f32x4 mrk = __builtin_amdgcn_mfma_f32_16x16x32_bf16(rt0, kt0, z, 0, 0, 0); mrk = __builtin_amdgcn_mfma_f32_16x16x32_bf16(rt1, kt1, mrk, 0, 0, 0);
#pragma unroll
                    for (int r = 0; r < 4; ++r) { const int t_ = 4 * q + r; const bool lo_ = l15 < t_, le_ = l15 <= t_;
                        *(LAS float*)(mt + CK_MAB + t_ * 80 + l15 * 4) = lo_ ? mab[r] : 0.f;
                        *(LAS bf16_t*)(mt + CK_MAK + t_ * 32 + l15 * 2) = (bf16_t)f2bf(lo_ ? mak[r] : 0.f);
                        *(LAS bf16_t*)(mt + CK_MRB + t_ * 32 + l15 * 2) = (bf16_t)f2bf(le_ ? mrb[r] : 0.f);
                        *(LAS bf16_t*)(mt + CK_MRK + t_ * 32 + l15 * 2) = (bf16_t)f2bf(le_ ? mrk[r] : 0.f); }
                } else {
#define CK_MLD(t_) f32x4 m_##t_[4]; _Pragma("unroll") for (int s4 = 0; s4 < (t_); s4 += 4) m_##t_[s4 >> 2] = *(const LAS f32x4*)(mt + CK_MAB + (t_) * 80 + s4 * 4)
#define CK_TROW(t_) do { float acc_ = (l15 == (t_)) ? 1.f : 0.f; \
                        _Pragma("unroll") for (int s4 = 0; s4 < (t_); s4 += 4) { \
                            _Pragma("unroll") for (int e = 0; e < 4; ++e) if (s4 + e < (t_)) acc_ += m_##t_[s4 >> 2][e] * x[s4 + e]; } \
                        x[t_] = acc_; } while (0)
                    if (ph3 == 1) { CK_MLD(1); CK_MLD(2); CK_MLD(3); CK_MLD(4); CK_MLD(5); CK_MLD(6); CK_MLD(7); CK_MLD(8); CK_MLD(9); CK_MLD(10);
                        x[0] = (l15 == 0) ? 1.f : 0.f; CK_TROW(1); CK_TROW(2); CK_TROW(3); CK_TROW(4); CK_TROW(5); CK_TROW(6); CK_TROW(7); CK_TROW(8); CK_TROW(9); CK_TROW(10); }
                    else { CK_MLD(11); CK_MLD(12); CK_MLD(13); CK_MLD(14); CK_MLD(15); CK_TROW(11); CK_TROW(12); CK_TROW(13); CK_TROW(14); CK_TROW(15);
                        if (q == 0) {
#pragma unroll
                            for (int t_ = 0; t_ < 16; ++t_) *(LAS bf16_t*)(mt + CK_TT + t_ * 32 + l15 * 2) = (bf16_t)f2bf(x[t_]); } }
#undef CK_TROW
#undef CK_MLD
                }
            }
        } else {
            const int c = it - 4;
            if (c >= 0 && c < NCH) {
                const LAS unsigned char* op = lds + (c % CK_NOP) * CK_OPB; const LAS unsigned char* mt = lds + CK_MT0 + (c % CK_NMT) * CK_MTB;
                s16x4v sb[4];
#pragma unroll
                for (int jt = 0; jt < 4; ++jt) { if (CK_NOSTATE) accS[jt] = (f32x4){0.f, 0.f, 0.f, 0.f}; sb[jt] = pk4(accS[jt]); }
                const int ao = l15 * CK_ROW + q * 8;
                const int tro = (4 * q + (l15 >> 2)) * CK_ROW + (l15 & 3) * 8;
                const s16x4v vb = ldtr(op + CK_VT + tro + i0 * 2);
                f32x4 x1 = (f32x4){0.f, 0.f, 0.f, 0.f}, x2 = x1;
#pragma unroll
                for (int jt = 0; jt < 4; ++jt) {
                    const s16x4v a0 = *(const LAS s16x4v*)(op + CK_AT + ao + jt * 32), r0 = *(const LAS s16x4v*)(op + CK_RT + ao + jt * 32);
                    x1 = __builtin_amdgcn_mfma_f32_16x16x16bf16_1k(a0, sb[jt], x1, 0, 0, 0);
                    x2 = __builtin_amdgcn_mfma_f32_16x16x16bf16_1k(r0, sb[jt], x2, 0, 0, 0);
                }
                const s16x4v mak = *(const LAS s16x4v*)(mt + CK_MAK + l15 * 32 + q * 8), mrb = *(const LAS s16x4v*)(mt + CK_MRB + l15 * 32 + q * 8);
                const s16x4v mrk = *(const LAS s16x4v*)(mt + CK_MRK + l15 * 32 + q * 8), tt = *(const LAS s16x4v*)(mt + CK_TT + l15 * 32 + q * 8);
                x1 = __builtin_amdgcn_mfma_f32_16x16x16bf16_1k(mak, vb, x1, 0, 0, 0);
                x2 = __builtin_amdgcn_mfma_f32_16x16x16bf16_1k(mrk, vb, x2, 0, 0, 0);
                const f32x4 u = __builtin_amdgcn_mfma_f32_16x16x16bf16_1k(tt, pk4(x1), (f32x4){0.f, 0.f, 0.f, 0.f}, 0, 0, 0);
                const s16x4v ub = pk4(u);
                const f32x4 yv = __builtin_amdgcn_mfma_f32_16x16x16bf16_1k(mrb, ub, x2, 0, 0, 0);
                const bf16x8 uv = (bf16x8){ub[0], ub[1], ub[2], ub[3], vb[0], vb[1], vb[2], vb[3]};
#pragma unroll
                for (int jt = 0; jt < 4; ++jt) {
                    const f32x4 gl = *(const LAS f32x4*)(op + CK_GL + (16 * jt + 4 * q) * 4);
                    const s16x4v b0 = ldtr(op + CK_BT + tro + jt * 32), k0 = ldtr(op + CK_KT + tro + jt * 32);
                    accS[jt] = __builtin_amdgcn_mfma_f32_16x16x32_bf16((bf16x8){b0[0], b0[1], b0[2], b0[3], k0[0], k0[1], k0[2], k0[3]}, uv, accS[jt], 0, 0, 0) * gl;
                }
                LAS float* yt = (LAS float*)(lds + CK_YT0 + (c & 1) * CK_YTB);
#pragma unroll
                for (int r = 0; r < 4; ++r) yt[(4 * q + r) * 16 + l15] = yv[r];
            }
        }
        CK_T1();
        __syncthreads();
    }
#ifdef CK_TIME
    if (blockIdx.x == 0 && l == 0 && lane == 0) { unsigned long long* tw = (unsigned long long*)(a->ws + WS_CTL) + 24000; tw[wid] = tb_; if (wid == 0) tw[8] = __builtin_readcyclecounter() - tstart_; }
#endif
#undef CK_LOAD
#undef CK_OPSTAGE
}

constexpr int WP_SUB = 4 * 2304 + 1280;
constexpr int CW_WPFLAG = 65536;
constexpr int CW_YFLAG = 72000;
__device__ __forceinline__ void ST2W(bf16_t* p, unsigned v) { asm volatile("global_store_short %0, %1, off sc1\n\ts_nop 1" :: "v"(p), "v"(v) : "memory"); }
__device__ __forceinline__ void phase_wkvprep(ArgsP a, int l, LAS unsigned char* lds, int first, int stride) {
    a = args_ptr(); first = __builtin_amdgcn_readfirstlane(first); stride = __builtin_amdgcn_readfirstlane(stride); asm volatile("" : "+s"(first), "+s"(stride));
    const int tid = ltid(), lane = tid & 63, wid = __builtin_amdgcn_readfirstlane(tid >> 6), sub = tid >> 8, ht = tid & 255, t_h = ht >> 4, jg = ht & 15, q = lane >> 4, l15 = lane & 15;
    bf16_t* RKV = (bf16_t*)(a->ws + A_RKV); bf16_t* EG = (bf16_t*)(a->ws + A_LW); bf16_t* ICLR = (bf16_t*)(a->ws + A_ICLR); float* SCAL = (float*)(a->ws + WS_SCAL);
    const bf16_t* HALO = (const bf16_t*)((const unsigned char*)a->out + DO_HALO); unsigned char* MTR = (unsigned char*)a->out + DO_MTREC;
    const float* mu = a->in[I_MU] + (size_t)l * 1792;
    u32x2 grA, gkA, gvA, prA, pkA, pvA, gicA, geA, gexA, gelA, grB, gkB, gvB, prB, pkB, pvB, gicB, geB, gexB, gelB;
#define WP_LOAD(S, idxx) do { const int idx_ = (idxx), bh_ = idx_ >> 8, c_ = idx_ & 255, ch_ = (bh_ & 7) * 64 + 4 * jg, t_ = c_ * 16 + t_h; const size_t row_ = (size_t)(bh_ >> 3) * SEQ + t_; const u32x2 z2_ = (u32x2){0u, 0u}; \
        gr##S = *(const u32x2*)(RKV + row_ * 1536 + ch_); gk##S = *(const u32x2*)(RKV + row_ * 1536 + 512 + ch_); gv##S = *(const u32x2*)(RKV + row_ * 1536 + 1024 + ch_); \
        pr##S = z2_; pk##S = z2_; pv##S = z2_; \
        if (t_h) { pr##S = *(const u32x2*)(RKV + (row_ - 1) * 1536 + ch_); pk##S = *(const u32x2*)(RKV + (row_ - 1) * 1536 + 512 + ch_); pv##S = *(const u32x2*)(RKV + (row_ - 1) * 1536 + 1024 + ch_); } \
        else if (t_) { const bf16_t* hp_ = HALO + ((row_ >> 4) - 1) * 1536; pr##S = *(const u32x2*)(hp_ + ch_); pk##S = *(const u32x2*)(hp_ + 512 + ch_); pv##S = *(const u32x2*)(hp_ + 1024 + ch_); } \
        gic##S = *(const u32x2*)(ICLR + row_ * 512 + ch_); ge##S = *(const u32x2*)(EG + row_ * 512 + ch_); gex##S = *(const u32x2*)(EG + (row_ - (t_h ? 1 : 0)) * 512 + ch_); gel##S = *(const u32x2*)(EG + (row_ - t_h + 15) * 512 + ch_); } while (0)
#ifndef WP_SC1
#define WP_SC1 1
#endif
#if WP_SC1
#define WPST(p_, v_) pg8::ST8W((p_), (v_))
#else
#define WPST(p_, v_) (*(u32x2*)(p_) = (v_))
#endif
#define WP_PASS(S, SN, ps) do { \
            const int idx = 8 * tr + 2 * (ps) + sub, bh = idx >> 8, c = idx & 255, b = bh >> 3, h = bh & 7, ch = h * 64 + 4 * jg; \
            const int t = c * 16 + t_h; const size_t row = (size_t)b * SEQ + t; \
            { const int qn_ = qq + stride; const int nidx = ((ps) < 3) ? idx + 2 : (qn_ < 1024 ? 8 * ((qn_ & 31) * 32 + (qn_ >> 5)) + sub : 8192); if (nidx < 8192) WP_LOAD(SN, nidx); }         \
            LAS unsigned char* op = lds + (2 * (ps) + sub) * WP_SUB; \
            const f32x4 mu_r = *(const f32x4*)(mu + ch), mu_k = *(const f32x4*)(mu + 512 + ch), mu_v = *(const f32x4*)(mu + 1024 + ch); \
            const f32x4 kk_c = *(const f32x4*)(a->in[I_KK] + l * 512 + ch), ka_c = *(const f32x4*)(a->in[I_KA] + l * 512 + ch), rk_c = *(const f32x4*)(a->in[I_RK] + l * 512 + ch); \
            const f32x4 r2 = up4(gr##S), k2 = up4(gk##S), v2 = up4(gv##S); \
            const f32x4 r = r2 + (up4(pr##S) - r2) * mu_r, k = k2 + (up4(pk##S) - k2) * mu_k, v = v2 + (up4(pv##S) - v2) * mu_v, ic = up4(gic##S); \
            const f32x4 eG = up4(ge##S), eGL = up4(gel##S); \
            f32x4 eGx = up4(gex##S); if (t_h == 0) eGx = (f32x4){1.f, 1.f, 1.f, 1.f}; \
            f32x4 enG; \
            _Pragma("unroll") for (int e = 0; e < 4; ++e) enG[e] = __builtin_amdgcn_rcpf(eG[e]); \
            f32x4 kk = k * kk_c; const float ssum = rr16(dot4(kk, kk)); \
            kk = kk * rsqrtf(ssum + 1e-12f); \
            const f32x4 kp = k * (1.0f + (ic - 1.0f) * ka_c), bb = kk * ic; \
            const float sc = rr16(dot4(r * kp, rk_c)); \
            const u32x2 oa = dn4(-(kk * eGx)), orr = dn4(r * eG), ob = dn4(bb * enG), ok = dn4(kp * enG), ov = dn4(v); \
            __syncthreads();                                         \
            *(LAS u32x2*)(op + CK_AT + t_h * CK_ROW + jg * 8) = oa; *(LAS u32x2*)(op + CK_RT + t_h * CK_ROW + jg * 8) = orr; \
            *(LAS u32x2*)(op + CK_BT + t_h * CK_ROW + jg * 8) = ob; *(LAS u32x2*)(op + CK_KT + t_h * CK_ROW + jg * 8) = ok; \
            WPST(RKV + row * 1536 + ch, oa); WPST(RKV + row * 1536 + 512 + ch, orr); WPST(RKV + row * 1536 + 1024 + ch, ov); \
            WPST(EG + row * 512 + ch, ob); WPST(ICLR + row * 512 + ch, ok); \
            if (jg == 0) __hip_atomic_store(SCAL + row * 8 + h, sc, __ATOMIC_RELAXED, __HIP_MEMORY_SCOPE_AGENT); \
            if (t_h == 0) pg8::ST16W((bf16_t*)(MTR + (size_t)idx * MTREC_B + 2048 + jg * 16), __builtin_bit_cast(u32x4, eGL)); \
        } while (0)
    unsigned* wpflag = (unsigned*)(a->ws + WS_CTL) + CW_WPFLAG + l * 1024;
    if (first < 1024) WP_LOAD(A, 8 * ((first & 31) * 32 + (first >> 5)) + sub);
    for (int qq = first; qq < 1024; qq += stride) {
        const int tr = (qq & 31) * 32 + (qq >> 5);
#pragma unroll 1
        for (int ps = 0; ps < 4; ps += 2) { WP_PASS(A, B, ps); WP_PASS(B, A, ps + 1); }
        __syncthreads();
        {
            const int idx = 8 * tr + wid;
            const LAS unsigned char* op = lds + wid * WP_SUB; LAS unsigned char* mt = lds + wid * WP_SUB + 4 * 2304;
            const int ro = l15 * CK_ROW + q * 16;
            const bf16x8 at0 = *(const LAS bf16x8*)(op + CK_AT + ro), at1 = *(const LAS bf16x8*)(op + CK_AT + ro + 64), rt0 = *(const LAS bf16x8*)(op + CK_RT + ro), rt1 = *(const LAS bf16x8*)(op + CK_RT + ro + 64);
            const bf16x8 bt0 = *(const LAS bf16x8*)(op + CK_BT + ro), bt1 = *(const LAS bf16x8*)(op + CK_BT + ro + 64), kt0 = *(const LAS bf16x8*)(op + CK_KT + ro), kt1 = *(const LAS bf16x8*)(op + CK_KT + ro + 64);
            const f32x4 z = (f32x4){0.f, 0.f, 0.f, 0.f};
            f32x4 mab = __builtin_amdgcn_mfma_f32_16x16x32_bf16(at0, bt0, z, 0, 0, 0); mab = __builtin_amdgcn_mfma_f32_16x16x32_bf16(at1, bt1, mab, 0, 0, 0);
            f32x4 mak = __builtin_amdgcn_mfma_f32_16x16x32_bf16(at0, kt0, z, 0, 0, 0); mak = __builtin_amdgcn_mfma_f32_16x16x32_bf16(at1, kt1, mak, 0, 0, 0);
            f32x4 mrb = __builtin_amdgcn_mfma_f32_16x16x32_bf16(rt0, bt0, z, 0, 0, 0); mrb = __builtin_amdgcn_mfma_f32_16x16x32_bf16(rt1, bt1, mrb, 0, 0, 0);
            f32x4 mrk = __builtin_amdgcn_mfma_f32_16x16x32_bf16(rt0, kt0, z, 0, 0, 0); mrk = __builtin_amdgcn_mfma_f32_16x16x32_bf16(rt1, kt1, mrk, 0, 0, 0);
            bf16_t* rec = (bf16_t*)(MTR + (size_t)idx * MTREC_B);
            LAS bf16_t* stg = (LAS bf16_t*)(lds + wid * WP_SUB);
            asm volatile("s_waitcnt lgkmcnt(0)" ::: "memory");
#pragma unroll
            for (int rr = 0; rr < 4; ++rr) { const int t_ = 4 * q + rr; const bool lo_ = l15 < t_, le_ = l15 <= t_;
                *(LAS float*)(mt + t_ * 80 + l15 * 4) = lo_ ? mab[rr] : 0.f;
                stg[t_ * 16 + l15] = (bf16_t)f2bf(lo_ ? mak[rr] : 0.f);
                stg[256 + t_ * 16 + l15] = (bf16_t)f2bf(le_ ? mrb[rr] : 0.f);
                stg[512 + t_ * 16 + l15] = (bf16_t)f2bf(le_ ? mrk[rr] : 0.f); }
            asm volatile("s_waitcnt lgkmcnt(0)" ::: "memory");
            float x[16];
#define WP_MLD(t_) f32x4 m_##t_[4]; _Pragma("unroll") for (int s4 = 0; s4 < (t_); s4 += 4) m_##t_[s4 >> 2] = *(const LAS f32x4*)(mt + (t_) * 80 + s4 * 4)
#define WP_TROW(t_) do { float acc_ = (l15 == (t_)) ? 1.f : 0.f; \
                _Pragma("unroll") for (int s4 = 0; s4 < (t_); s4 += 4) { _Pragma("unroll") for (int e = 0; e < 4; ++e) if (s4 + e < (t_)) acc_ += m_##t_[s4 >> 2][e] * x[s4 + e]; } \
                x[t_] = acc_; } while (0)
            x[0] = (l15 == 0) ? 1.f : 0.f;
            { WP_MLD(1); WP_MLD(2); WP_MLD(3); WP_MLD(4); WP_MLD(5); WP_MLD(6); WP_MLD(7); WP_TROW(1); WP_TROW(2); WP_TROW(3); WP_TROW(4); WP_TROW(5); WP_TROW(6); WP_TROW(7); }
            { WP_MLD(8); WP_MLD(9); WP_MLD(10); WP_MLD(11); WP_TROW(8); WP_TROW(9); WP_TROW(10); WP_TROW(11); }
            { WP_MLD(12); WP_MLD(13); WP_MLD(14); WP_MLD(15); WP_TROW(12); WP_TROW(13); WP_TROW(14); WP_TROW(15); }
#undef WP_TROW
#undef WP_MLD
            if (q == 0) {
#pragma unroll
                for (int t_ = 0; t_ < 16; ++t_) stg[768 + t_ * 16 + l15] = (bf16_t)f2bf(x[t_]); }
            asm volatile("s_waitcnt lgkmcnt(0)" ::: "memory");
            pg8::ST16W(rec + lane * 8, *(const LAS u32x4*)((const LAS unsigned char*)stg + lane * 16));
            pg8::ST16W(rec + 512 + lane * 8, *(const LAS u32x4*)((const LAS unsigned char*)stg + 1024 + lane * 16));
        }
        asm volatile("s_waitcnt vmcnt(0)" ::: "memory");
        __syncthreads();
        if (tid == 0) __hip_atomic_store(wpflag + tr, 1u, __ATOMIC_RELAXED, __HIP_MEMORY_SCOPE_AGENT);
    }
#undef WP_LOAD
#undef WP_PASS
}

constexpr int WS_SLOT = 5 * 2048 + 3 * 1024, WS_NSLOT = 8, WS_DEPTH = 7, WS_YT = WS_NSLOT * WS_SLOT;
__device__ __forceinline__ void glds16(const void* gsrc, unsigned lds_dst) { unsigned keep;
    asm volatile("s_mov_b32 %0, m0\n\ts_mov_b32 m0, %2\n\ts_nop 0\n\tglobal_load_lds_dwordx4 %1, off\n\ts_mov_b32 m0, %0" : "=&s"(keep) : "v"(gsrc), "s"(lds_dst) : "memory"); }
__device__ __forceinline__ void scan_unit_stream(ArgsP a, int l, int bh, LAS unsigned char* lds) {
    a = args_ptr();
    const int tid = ltid(), lane = tid & 63, wid = __builtin_amdgcn_readfirstlane(tid >> 6), q = lane >> 4, l15 = lane & 15;
    const int b = bh >> 3, h = bh & 7;
    const unsigned char* RKVb = a->ws + A_RKV; const unsigned char* EGb = a->ws + A_LW; const unsigned char* ICb = a->ws + A_ICLR;
    const unsigned char* MTR = (const unsigned char*)a->out + DO_MTREC + (size_t)bh * 256 * MTREC_B;
    bf16_t* Y = (bf16_t*)(a->ws + A_Y);
    unsigned* yflag = (unsigned*)(a->ws + WS_CTL) + CW_YFLAG + l * 1024 + bh * 32;
    constexpr int NCH = SEQ / 16;
    const unsigned lds0 = (unsigned)(uintptr_t)lds;
    if (wid >= 4) {
        const int w = wid - 4, rw = lane >> 3, c16 = ((lane & 7) ^ rw) * 16;
        const int np = (w == 0) ? 4 : 3;
#define WS_ISSUE(cc) do { const size_t row0_ = (size_t)b * SEQ + (size_t)(cc) * 16; const unsigned slot_ = lds0 + (unsigned)(((cc) % WS_NSLOT) * WS_SLOT); \
            _Pragma("unroll") for (int k_ = 0; k_ < 4; ++k_) { const int p_ = w + 4 * k_; if (p_ < 13) { const void* src_; \
                if (p_ < 10) { const int tl_ = p_ >> 1; const size_t r_ = row0_ + 8 * (p_ & 1) + rw; \
                    src_ = tl_ < 3 ? (const void*)(RKVb + (r_ * 1536 + tl_ * 512 + h * 64) * 2 + c16) : (tl_ == 3 ? (const void*)(EGb + (r_ * 512 + h * 64) * 2 + c16) : (const void*)(ICb + (r_ * 512 + h * 64) * 2 + c16)); } \
                else src_ = (const void*)(MTR + (size_t)(cc) * MTREC_B + (p_ - 10) * 1024 + lane * 16); \
                glds16(src_, (unsigned)__builtin_amdgcn_readfirstlane(slot_ + (unsigned)(p_ < 10 ? (p_ >> 1) * 2048 + (p_ & 1) * 1024 : 10240 + (p_ - 10) * 1024))); } } } while (0)
        unsigned* wpflag = (unsigned*)(a->ws + WS_CTL) + CW_WPFLAG + l * 1024 + bh * 32;
        unsigned* tmo = (unsigned*)(a->ws + WS_CTL) + CW_BAR + XB_TMO;
#define WS_GATE(cc) do { if (((cc) & 7) == 0) { unsigned sp_ = 0; \
            while ((unsigned)__builtin_amdgcn_readfirstlane(__hip_atomic_load(wpflag + ((cc) >> 3), __ATOMIC_RELAXED, __HIP_MEMORY_SCOPE_AGENT)) == 0u) { __builtin_amdgcn_s_sleep(2); \
                if ((++sp_ & 255u) == 0u) { if (xb_ld(tmo)) break; if (sp_ > XB_SPIN_CAP) { atomicAdd(tmo, 1u); break; } } } \
            __builtin_amdgcn_fence(__ATOMIC_ACQUIRE, "agent"); } } while (0)
        WS_GATE(0);
#pragma unroll
        for (int cc = 0; cc < WS_DEPTH; ++cc) WS_ISSUE(cc);
        if (w == 0) asm volatile("s_waitcnt vmcnt(24)" ::: "memory"); else asm volatile("s_waitcnt vmcnt(18)" ::: "memory");
        __syncthreads();
        for (int it = 0; it < NCH; ++it) {
            if (it + WS_DEPTH < NCH) { WS_GATE(it + WS_DEPTH); WS_ISSUE(it + WS_DEPTH); if (w == 0) asm volatile("s_waitcnt vmcnt(24)" ::: "memory"); else asm volatile("s_waitcnt vmcnt(18)" ::: "memory"); }
            else asm volatile("s_waitcnt vmcnt(0)" ::: "memory");
            __syncthreads();
        }
#undef WS_ISSUE
#undef WS_GATE
        (void)np;
    } else {
        f32x4 accS[4];
#pragma unroll
        for (int jt = 0; jt < 4; ++jt) accS[jt] = (f32x4){0.f, 0.f, 0.f, 0.f};
        __syncthreads();
        for (int it = 0; it < NCH; ++it) {
            const LAS unsigned char* op = lds + (it % WS_NSLOT) * WS_SLOT; const LAS unsigned char* mt = op + 10240;
            s16x4v sb[4];
#pragma unroll
            for (int jt = 0; jt < 4; ++jt) sb[jt] = pk4(accS[jt]);
#define WS_SW(row, p8) ((row) * 128 + ((((p8) >> 1) ^ ((row) & 7)) << 4) + ((p8) & 1) * 8)
            const int trow = 4 * q + (l15 >> 2);
            const s16x4v vb = ldtr(op + 4096 + WS_SW(trow, (l15 & 3) + 4 * wid));
            f32x4 x1 = (f32x4){0.f, 0.f, 0.f, 0.f}, x2 = x1;
#pragma unroll
            for (int jt = 0; jt < 4; ++jt) {
                const s16x4v a0 = *(const LAS s16x4v*)(op + 0 + WS_SW(l15, q + 4 * jt)), r0 = *(const LAS s16x4v*)(op + 2048 + WS_SW(l15, q + 4 * jt));
                x1 = __builtin_amdgcn_mfma_f32_16x16x16bf16_1k(a0, sb[jt], x1, 0, 0, 0);
                x2 = __builtin_amdgcn_mfma_f32_16x16x16bf16_1k(r0, sb[jt], x2, 0, 0, 0);
            }
            const s16x4v mak = *(const LAS s16x4v*)(mt + 0 + l15 * 32 + q * 8), mrb = *(const LAS s16x4v*)(mt + 512 + l15 * 32 + q * 8);
            const s16x4v mrk = *(const LAS s16x4v*)(mt + 1024 + l15 * 32 + q * 8), tt = *(const LAS s16x4v*)(mt + 1536 + l15 * 32 + q * 8);
            x1 = __builtin_amdgcn_mfma_f32_16x16x16bf16_1k(mak, vb, x1, 0, 0, 0);
            x2 = __builtin_amdgcn_mfma_f32_16x16x16bf16_1k(mrk, vb, x2, 0, 0, 0);
            const f32x4 u = __builtin_amdgcn_mfma_f32_16x16x16bf16_1k(tt, pk4(x1), (f32x4){0.f, 0.f, 0.f, 0.f}, 0, 0, 0);
            const s16x4v ub = pk4(u);
            const f32x4 yv = __builtin_amdgcn_mfma_f32_16x16x16bf16_1k(mrb, ub, x2, 0, 0, 0);
            const bf16x8 uv = (bf16x8){ub[0], ub[1], ub[2], ub[3], vb[0], vb[1], vb[2], vb[3]};
#pragma unroll
            for (int jt = 0; jt < 4; ++jt) {
                const f32x4 gl = *(const LAS f32x4*)(mt + 2048 + (16 * jt + 4 * q) * 4);
                const s16x4v b0 = ldtr(op + 6144 + WS_SW(trow, (l15 & 3) + 4 * jt)), k0 = ldtr(op + 8192 + WS_SW(trow, (l15 & 3) + 4 * jt));
                accS[jt] = __builtin_amdgcn_mfma_f32_16x16x32_bf16((bf16x8){b0[0], b0[1], b0[2], b0[3], k0[0], k0[1], k0[2], k0[3]}, uv, accS[jt], 0, 0, 0) * gl;
            }
            LAS float* yt = (LAS float*)(lds + WS_YT + wid * 1024);
#pragma unroll
            for (int rr = 0; rr < 4; ++rr) yt[(4 * q + rr) * 16 + l15] = yv[rr];
            asm volatile("s_waitcnt lgkmcnt(0)" ::: "memory");
            { const int t_ = lane >> 2, ip = (lane & 3) * 4; const f32x4 yr = *(const LAS f32x4*)(yt + t_ * 16 + ip);
              pg8::ST8W(Y + ((size_t)b * SEQ + it * 16 + t_) * 512 + h * 64 + 16 * wid + ip, dn4(yr)); }
            const bool pub_ = ((it & 7) == 7) && it >= 15;
            if (pub_) asm volatile("s_waitcnt vmcnt(8)" ::: "memory");
            __syncthreads();
            if (pub_ && tid == 0) __hip_atomic_store(yflag + ((it - 15) >> 3), 1u, __ATOMIC_RELAXED, __HIP_MEMORY_SCOPE_AGENT);
        }
        asm volatile("s_waitcnt vmcnt(0)" ::: "memory");
#undef WS_SW
    }
    __syncthreads();
    if (tid == 0) __hip_atomic_store(yflag + 31, 1u, __ATOMIC_RELAXED, __HIP_MEMORY_SCOPE_AGENT);
}

__device__ __forceinline__ int crow(int r, int hi) { return (r & 3) + 8 * (r >> 2) + 4 * hi; }
constexpr int AT_KROW = 208, AT_VROW = 136, AT_KBUF = 64 * AT_KROW, AT_VBUF = 64 * AT_VROW, AT_V0 = 2 * AT_KBUF;
__device__ __forceinline__ void attn_unit(ArgsP a, int bh, int qb, LAS unsigned char* lds, size_t o_off = A_QN) {
    a = args_ptr();
    const int tid = ltid(), lane = tid & 63, wid = tid >> 6, r32 = lane & 31, hi = lane >> 5;
    const int b = bh >> 3, h = bh & 7, q0 = qb * 256, qw0 = q0 + wid * 32;
    const size_t rowb = (size_t)b * SEQ;
    const bf16_t* Qn = (const bf16_t*)(a->ws + A_QN); const bf16_t* Qp = (const bf16_t*)(a->ws + A_QP); const bf16_t* Kn = (const bf16_t*)(a->ws + A_KN);
    const bf16_t* KPE = (const bf16_t*)(a->ws + A_KPE); const bf16_t* Vt = (const bf16_t*)(a->ws + A_VT); bf16_t* O = (bf16_t*)(a->ws + o_off);
    bf16x8 qf[6];
    { const size_t qrow = rowb + qw0 + r32;
#pragma unroll
      for (int ds = 0; ds < 4; ++ds) qf[ds] = *(const bf16x8*)(Qn + qrow * 512 + h * 64 + ds * 16 + hi * 8);
#pragma unroll
      for (int ds = 0; ds < 2; ++ds) qf[4 + ds] = *(const bf16x8*)(Qp + qrow * 256 + h * 32 + ds * 16 + hi * 8); }
    const int NT = 4 * qb + 4;
    const bf16_t* ksrc = Kn + (rowb + (tid >> 3)) * 512 + h * 64 + (tid & 7) * 8;
    const bf16_t* psrc = KPE + (rowb + ((tid & 255) >> 2)) * 32 + (tid & 3) * 8;
    const bf16_t* vsrc = Vt + ((size_t)(bh * 64 + (tid >> 3)) << 12) + (tid & 7) * 8;
    const int kdst = (tid >> 3) * AT_KROW + (tid & 7) * 16, pdst = ((tid & 255) >> 2) * AT_KROW + 128 + (tid & 3) * 16, vdst = AT_V0 + (tid >> 3) * AT_VROW + (tid & 7) * 16;
    u32x4 rk0, rp0 = (u32x4){0u, 0u, 0u, 0u}, rv0, rk1, rp1 = rp0, rv1;
#define AT_LOAD(S, tt) do { rk##S = *(const u32x4*)(ksrc + (size_t)(tt) * 64 * 512); if (tid < 256) rp##S = *(const u32x4*)(psrc + (size_t)(tt) * 64 * 32); rv##S = *(const u32x4*)(vsrc + (tt) * 64); } while (0)
#define AT_WRITE(S, p) do { *(LAS u32x4*)(lds + (p) * AT_KBUF + kdst) = rk##S; if (tid < 256) *(LAS u32x4*)(lds + (p) * AT_KBUF + pdst) = rp##S; \
        *(LAS u32x2*)(lds + (p) * AT_VBUF + vdst) = (u32x2){rv##S.x, rv##S.y}; *(LAS u32x2*)(lds + (p) * AT_VBUF + vdst + 8) = (u32x2){rv##S.z, rv##S.w}; } while (0)
    AT_LOAD(0, 0); AT_WRITE(0, 0); AT_LOAD(0, 1);
    __syncthreads();
    float mrun = -INFINITY, lrun = 0.f;
    f32x16 o0, o1;
#pragma unroll
    for (int r = 0; r < 16; ++r) { o0[r] = 0.f; o1[r] = 0.f; }
    for (int t2 = 0; t2 < NT; t2 += 2)
#pragma unroll
    for (int tp = 0; tp < 2; ++tp) {
        const int t = t2 + tp, cur = tp;
        if (t + 2 < NT) { if (tp == 0) AT_LOAD(1, t + 2); else AT_LOAD(0, t + 2); }
        if (64 * t <= qw0 + 31) {
            const LAS unsigned char* Kb = lds + cur * AT_KBUF + r32 * AT_KROW + hi * 16;
            f32x16 p0, p1;
#pragma unroll
            for (int r = 0; r < 16; ++r) { p0[r] = 0.f; p1[r] = 0.f; }
#pragma unroll
            for (int ds = 0; ds < 6; ++ds) {
                const bf16x8 k0 = *(const LAS bf16x8*)(Kb + ds * 32), k1 = *(const LAS bf16x8*)(Kb + 32 * AT_KROW + ds * 32);
                p0 = __builtin_amdgcn_mfma_f32_32x32x16_bf16(k0, qf[ds], p0, 0, 0, 0);
                p1 = __builtin_amdgcn_mfma_f32_32x32x16_bf16(k1, qf[ds], p1, 0, 0, 0);
            }
            if (64 * t + 63 > qw0) {
                const int q = qw0 + r32;
#pragma unroll
                for (int r = 0; r < 16; ++r) { const int kv = 64 * t + crow(r, hi); if (kv > q) p0[r] = -INFINITY; if (kv + 32 > q) p1[r] = -INFINITY; }
            }
            float mx = fmaxf(p0[0], p1[0]);
#pragma unroll
            for (int r = 1; r < 16; ++r) mx = fmaxf(mx, fmaxf(p0[r], p1[r]));
            mx = fmaxf(mx, shx(mx, 32));
            const float mnew = fmaxf(mrun, mx), alpha = __builtin_amdgcn_exp2f(mrun - mnew);
            mrun = mnew;
            float ps = 0.f;
#pragma unroll
            for (int r = 0; r < 16; ++r) { p0[r] = __builtin_amdgcn_exp2f(p0[r] - mnew); p1[r] = __builtin_amdgcn_exp2f(p1[r] - mnew); ps += p0[r] + p1[r]; }
            lrun = lrun * alpha + ps;
#pragma unroll
            for (int r = 0; r < 16; ++r) { o0[r] *= alpha; o1[r] *= alpha; }
            bf16x8 pf[4];
#pragma unroll
            for (int ks = 0; ks < 4; ++ks) {
                u32x4 w;
                if (ks < 2) { w.x = pk2(p0[8 * ks + 0], p0[8 * ks + 1]); w.y = pk2(p0[8 * ks + 2], p0[8 * ks + 3]); w.z = pk2(p0[8 * ks + 4], p0[8 * ks + 5]); w.w = pk2(p0[8 * ks + 6], p0[8 * ks + 7]); }
                else { const int k2 = ks - 2; w.x = pk2(p1[8 * k2 + 0], p1[8 * k2 + 1]); w.y = pk2(p1[8 * k2 + 2], p1[8 * k2 + 3]); w.z = pk2(p1[8 * k2 + 4], p1[8 * k2 + 5]); w.w = pk2(p1[8 * k2 + 6], p1[8 * k2 + 7]); }
                pf[ks] = __builtin_bit_cast(bf16x8, w);
            }
            const LAS unsigned char* Vb = lds + AT_V0 + cur * AT_VBUF + r32 * AT_VROW + hi * 8;
#pragma unroll
            for (int ks = 0; ks < 4; ++ks) {
                const s16x4 a0 = *(const LAS s16x4*)(Vb + ks * 32), a1 = *(const LAS s16x4*)(Vb + ks * 32 + 16);
                const s16x4 c0 = *(const LAS s16x4*)(Vb + 32 * AT_VROW + ks * 32), c1 = *(const LAS s16x4*)(Vb + 32 * AT_VROW + ks * 32 + 16);
                const bf16x8 vf0 = (bf16x8){a0[0], a0[1], a0[2], a0[3], a1[0], a1[1], a1[2], a1[3]}, vf1 = (bf16x8){c0[0], c0[1], c0[2], c0[3], c1[0], c1[1], c1[2], c1[3]};
                o0 = __builtin_amdgcn_mfma_f32_32x32x16_bf16(vf0, pf[ks], o0, 0, 0, 0);
                o1 = __builtin_amdgcn_mfma_f32_32x32x16_bf16(vf1, pf[ks], o1, 0, 0, 0);
            }
        }
        if (t + 1 < NT) { if (tp == 0) AT_WRITE(0, 1); else AT_WRITE(1, 0); }
        __syncthreads();
    }
#undef AT_WRITE
#undef AT_LOAD
    const float ltot = lrun + shx(lrun, 32), inv = 1.0f / ltot;
    bf16_t* orow = O + (rowb + qw0 + r32) * 512 + h * 64 + 4 * hi;
#pragma unroll
    for (int g = 0; g < 4; ++g) {
        *(u32x2*)(orow + 8 * g) = (u32x2){pk2(o0[4 * g] * inv, o0[4 * g + 1] * inv), pk2(o0[4 * g + 2] * inv, o0[4 * g + 3] * inv)};
        *(u32x2*)(orow + 32 + 8 * g) = (u32x2){pk2(o1[4 * g] * inv, o1[4 * g + 1] * inv), pk2(o1[4 * g + 2] * inv, o1[4 * g + 3] * inv)};
    }
}


__device__ __forceinline__ void attn_unit_naive(ArgsP a, int bh, int qb, LAS unsigned char* lds) {
    a = args_ptr();
    const int tid = vtid(), lane = tid & 63, wid = tid >> 6;
    const int b = bh >> 3, h = bh & 7; const size_t rowb = (size_t)b * SEQ;
    const bf16_t* Qn = (const bf16_t*)(a->ws + A_QN); const bf16_t* Qp = (const bf16_t*)(a->ws + A_QP); const bf16_t* Kn = (const bf16_t*)(a->ws + A_KN);
    const bf16_t* KPE = (const bf16_t*)(a->ws + A_KPE); const bf16_t* Vt = (const bf16_t*)(a->ws + A_VT); bf16_t* O = (bf16_t*)(a->ws + A_QN);
    LAS float* sc = (LAS float*)(lds + wid * 16384);
    for (int i = 0; i < 32; ++i) {
        const int q = qb * 256 + wid * 32 + i; const size_t qrow = rowb + q;
        float mx = -INFINITY;
        for (int k0 = 0; k0 <= q; k0 += 64) {
            const int key = k0 + lane; float sv = -INFINITY;
            if (key <= q) { sv = 0.f;
                for (int d = 0; d < 64; ++d) sv += bf2f(Qn[qrow * 512 + h * 64 + d]) * bf2f(Kn[(rowb + key) * 512 + h * 64 + d]);
                for (int d = 0; d < 32; ++d) sv += bf2f(Qp[qrow * 256 + h * 32 + d]) * bf2f(KPE[(rowb + key) * 32 + d]); }
            sc[key] = sv; mx = fmaxf(mx, sv);
        }
        for (int o = 1; o < 64; o <<= 1) mx = fmaxf(mx, shx(mx, o));
        float sum = 0.f;
        for (int k0 = 0; k0 <= q; k0 += 64) { const int key = k0 + lane; const float p = key <= q ? exp2f(sc[key] - mx) : 0.f; sc[key] = p; sum += p; }
        for (int o = 1; o < 64; o <<= 1) sum += shx(sum, o);
        asm volatile("s_waitcnt lgkmcnt(0)" ::: "memory");
        float acc = 0.f;
        const bf16_t* vp = Vt + ((size_t)(bh * 64 + lane) << 12);
        for (int key = 0; key <= q; ++key) acc += sc[key] * bf2f(vp[key]);
        asm volatile("s_waitcnt lgkmcnt(0)" ::: "memory");
        O[qrow * 512 + h * 64 + lane] = (bf16_t)f2bf(acc / sum);
    }
}
__device__ __forceinline__ void ya_item(ArgsP a, int l, int bh, int gq) {
    a = args_ptr();
    const int tid = ltid();
    if (tid < 64) {
        unsigned* fl = (unsigned*)(a->ws + WS_CTL) + CW_YFLAG + l * 1024 + bh * 32 + gq * 4; unsigned* tmo = (unsigned*)(a->ws + WS_CTL) + CW_BAR + XB_TMO; unsigned sp_ = 0;
        for (;;) { const unsigned f_ = __hip_atomic_load(fl, __ATOMIC_RELAXED, __HIP_MEMORY_SCOPE_AGENT) & __hip_atomic_load(fl + 1, __ATOMIC_RELAXED, __HIP_MEMORY_SCOPE_AGENT)
                                      & __hip_atomic_load(fl + 2, __ATOMIC_RELAXED, __HIP_MEMORY_SCOPE_AGENT) & __hip_atomic_load(fl + 3, __ATOMIC_RELAXED, __HIP_MEMORY_SCOPE_AGENT);
            if ((unsigned)__builtin_amdgcn_readfirstlane(f_) != 0u) break;
            __builtin_amdgcn_s_sleep(2);
            if ((++sp_ & 255u) == 0u) { if (xb_ld(tmo)) break; if (sp_ > XB_SPIN_CAP) { atomicAdd(tmo, 1u); break; } } }
        __builtin_amdgcn_fence(__ATOMIC_ACQUIRE, "agent");
    }
    __syncthreads();
    const int h = bh & 7, c = h * 64 + (tid & 7) * 8; const size_t r0 = (size_t)(bh >> 3) * SEQ + (size_t)gq * 512 + (tid >> 3);
    const bf16_t* Y = (const bf16_t*)(a->ws + A_Y); const bf16_t* RKV = (const bf16_t*)(a->ws + A_RKV); const bf16_t* GATE = (const bf16_t*)(a->ws + A_GATE);
    const float* SCAL = (const float*)(a->ws + WS_SCAL); bf16_t* YA = (bf16_t*)(a->ws + A_YA);
    const float* lw = a->in[I_LNXW] + l * 512 + c; const float* lb = a->in[I_LNXB] + l * 512 + c;
    const f32x4 w0 = *(const f32x4*)lw, w1 = *(const f32x4*)(lw + 4), b0 = *(const f32x4*)lb, b1 = *(const f32x4*)(lb + 4);
    u32x4 yu[8], vu[8], gu[8]; float sc[8];
#pragma unroll
    for (int k = 0; k < 8; ++k) { const size_t row = r0 + 64 * k;
        yu[k] = *(const u32x4*)(Y + row * 512 + c); vu[k] = *(const u32x4*)(RKV + row * 1536 + 1024 + c);
        gu[k] = *(const u32x4*)(GATE + row * 512 + c); sc[k] = SCAL[row * 8 + h]; }
#pragma unroll
    for (int k = 0; k < 8; ++k) {
        const f32x4 ya0 = up4((u32x2){yu[k].x, yu[k].y}), ya1 = up4((u32x2){yu[k].z, yu[k].w});
        float sm = ((ya0.x + ya0.y) + (ya0.z + ya0.w)) + ((ya1.x + ya1.y) + (ya1.z + ya1.w));
        sm += shx(sm, 1); sm += shx(sm, 2); sm += shx(sm, 4);
        const float mean = sm * (1.0f / 64.0f);
        const f32x4 d0 = ya0 - mean, d1 = ya1 - mean;
        float qv = dot4(d0, d0) + dot4(d1, d1);
        qv += shx(qv, 1); qv += shx(qv, 2); qv += shx(qv, 4);
        const float rstd = rsqrtf(qv * (1.0f / 64.0f) + LNX_EPS);
        const f32x4 vv0 = up4((u32x2){vu[k].x, vu[k].y}), vv1 = up4((u32x2){vu[k].z, vu[k].w});
        const f32x4 g0 = up4((u32x2){gu[k].x, gu[k].y}), g1 = up4((u32x2){gu[k].z, gu[k].w});
        const f32x4 o0 = (d0 * rstd * w0 + b0 + vv0 * sc[k]) * g0, o1 = (d1 * rstd * w1 + b1 + vv1 * sc[k]) * g1;
        const u32x2 p0 = dn4(o0), p1 = dn4(o1);
        *(u32x4*)(YA + (r0 + 64 * k) * 512 + c) = (u32x4){p0.x, p0.y, p1.x, p1.y};
    }
}
#if NAIVE_ATTN
#define ATTN_UNIT attn_unit_naive
#else
#define ATTN_UNIT attn_unit
#endif
__device__ __forceinline__ void phase_ya(ArgsP a, int l) {
    a = args_ptr();
    const unsigned gt = blockIdx.x * NTHREADS + ltid(), NGT = gridDim.x * NTHREADS;
    const bf16_t* Y = (const bf16_t*)(a->ws + A_Y); const bf16_t* RKV = (const bf16_t*)(a->ws + A_RKV); const bf16_t* GATE = (const bf16_t*)(a->ws + A_GATE);
    const float* SCAL = (const float*)(a->ws + WS_SCAL); bf16_t* YA = (bf16_t*)(a->ws + A_YA);
    const int c = (gt & 63) * 8, h = c >> 6;
    const float* muv = a->in[I_MU] + (size_t)l * 1792 + 1024 + c; const float* lw = a->in[I_LNXW] + l * 512 + c; const float* lb = a->in[I_LNXB] + l * 512 + c;
    const f32x4 m0 = *(const f32x4*)muv, m1 = *(const f32x4*)(muv + 4), w0 = *(const f32x4*)lw, w1 = *(const f32x4*)(lw + 4), b0 = *(const f32x4*)lb, b1 = *(const f32x4*)(lb + 4);
    for (unsigned i = gt; i < (unsigned)M * 64; i += 2 * NGT) {
        u32x4 yu[2], v2u[2], v1u[2], gu[2]; float sc[2]; unsigned rowv[2];
#pragma unroll
        for (int k = 0; k < 2; ++k) { const unsigned row = (i + k * NGT) >> 6; const int t = row & 4095; rowv[k] = row;
            yu[k] = *(const u32x4*)(Y + (size_t)row * 512 + c); v2u[k] = *(const u32x4*)(RKV + (size_t)row * 1536 + 1024 + c);
            v1u[k] = WKV_STREAM ? v2u[k] : (t ? *(const u32x4*)(RKV + (size_t)(row - 1) * 1536 + 1024 + c) : (u32x4){0u, 0u, 0u, 0u});
            gu[k] = *(const u32x4*)(GATE + (size_t)row * 512 + c); sc[k] = SCAL[(size_t)row * 8 + h]; }
#pragma unroll
        for (int k = 0; k < 2; ++k) {
            const f32x4 ya0 = up4((u32x2){yu[k].x, yu[k].y}), ya1 = up4((u32x2){yu[k].z, yu[k].w});
            float sm = ((ya0.x + ya0.y) + (ya0.z + ya0.w)) + ((ya1.x + ya1.y) + (ya1.z + ya1.w));
            sm += shx(sm, 1); sm += shx(sm, 2); sm += shx(sm, 4);
            const float mean = sm * (1.0f / 64.0f);
            const f32x4 d0 = ya0 - mean, d1 = ya1 - mean;
            float qv = dot4(d0, d0) + dot4(d1, d1);
            qv += shx(qv, 1); qv += shx(qv, 2); qv += shx(qv, 4);
            const float rstd = rsqrtf(qv * (1.0f / 64.0f) + LNX_EPS);
            const f32x4 v20 = up4((u32x2){v2u[k].x, v2u[k].y}), v21 = up4((u32x2){v2u[k].z, v2u[k].w}), v10 = up4((u32x2){v1u[k].x, v1u[k].y}), v11 = up4((u32x2){v1u[k].z, v1u[k].w});
            const f32x4 vv0 = v20 + (v10 - v20) * m0, vv1 = v21 + (v11 - v21) * m1;
            const f32x4 g0 = up4((u32x2){gu[k].x, gu[k].y}), g1 = up4((u32x2){gu[k].z, gu[k].w});
            const f32x4 o0 = (d0 * rstd * w0 + b0 + vv0 * sc[k]) * g0, o1 = (d1 * rstd * w1 + b1 + vv1 * sc[k]) * g1;
            const u32x2 p0 = dn4(o0), p1 = dn4(o1);
            *(u32x4*)(YA + (size_t)rowv[k] * 512 + c) = (u32x4){p0.x, p0.y, p1.x, p1.y};
        }
    }
}


__device__ __forceinline__ void phase_gconv(ArgsP a, int l) {
    a = args_ptr();
    const unsigned gt = blockIdx.x * NTHREADS + ltid();
    constexpr unsigned NCHK = FF / 8, NSEG = 372, SEGR = (M + NSEG - 1) / NSEG;
    if (gt >= NCHK * NSEG) return;
    const unsigned chk = gt % NCHK, seg = gt / NCHK; const int c = chk * 8;
    const bf16_t* UG = (const bf16_t*)(a->ws + A_UG); bf16_t* GC = (bf16_t*)(a->ws + A_ACT);
    const float* cw = a->in[I_CONVW] + (size_t)l * 3 * FF + c; const float* cb = a->in[I_CONVB] + (size_t)l * FF + c;
    const f32x4 w0a = *(const f32x4*)cw, w0b = *(const f32x4*)(cw + 4), w1a = *(const f32x4*)(cw + FF), w1b = *(const f32x4*)(cw + FF + 4), w2a = *(const f32x4*)(cw + 2 * FF), w2b = *(const f32x4*)(cw + 2 * FF + 4);
    const f32x4 ba = *(const f32x4*)cb, bb = *(const f32x4*)(cb + 4);
    const unsigned r0 = seg * SEGR, r1 = (r0 + SEGR < (unsigned)M) ? r0 + SEGR : (unsigned)M;
    const u32x4 z = (u32x4){0u, 0u, 0u, 0u};
    u32x4 p1 = ((r0 & 4095u) >= 1u) ? *(const u32x4*)(UG + (size_t)(r0 - 1) * FF + c) : z, p2 = ((r0 & 4095u) >= 2u) ? *(const u32x4*)(UG + (size_t)(r0 - 2) * FF + c) : z;
    u32x4 nx = *(const u32x4*)(UG + (size_t)r0 * FF + c);
    for (unsigned r = r0; r < r1; ++r) {
        const u32x4 cur = nx;
        if (r + 1 < r1) nx = *(const u32x4*)(UG + (size_t)(r + 1) * FF + c);
        if ((r & 4095u) == 0u) { p1 = z; p2 = z; }
        const f32x4 x2a = up4((u32x2){cur.x, cur.y}), x2b = up4((u32x2){cur.z, cur.w}), x1a = up4((u32x2){p1.x, p1.y}), x1b = up4((u32x2){p1.z, p1.w}), x0a = up4((u32x2){p2.x, p2.y}), x0b = up4((u32x2){p2.z, p2.w});
        const f32x4 ca = ba + w0a * x0a + w1a * x1a + w2a * x2a, cc = bb + w0b * x0b + w1b * x1b + w2b * x2b;
        const pg8::f32x2 g0 = pg8::gelu_pk2((pg8::f32x2){ca.x, ca.y}), g1 = pg8::gelu_pk2((pg8::f32x2){ca.z, ca.w}), g2 = pg8::gelu_pk2((pg8::f32x2){cc.x, cc.y}), g3 = pg8::gelu_pk2((pg8::f32x2){cc.z, cc.w});
        *(u32x4*)(GC + (size_t)r * FF + c) = (u32x4){pk2(g0.x, g0.y), pk2(g1.x, g1.y), pk2(g2.x, g2.y), pk2(g3.x, g3.y)};
        p2 = p1; p1 = cur;
    }
}
__device__ __forceinline__ void ffn_halo_fix(ArgsP a, int l, int pm) {
    a = args_ptr();
    const int tid = ltid();
    const bf16_t* RAWH = (const bf16_t*)(a->ws + A_UG); bf16_t* ACT = (bf16_t*)(a->ws + A_ACT);
    const float* cw = a->in[I_CONVW] + (size_t)l * 3 * FF; const float* cb = a->in[I_CONVB] + (size_t)l * FF;
    for (int i = tid; i < 8 * (FF / 8); i += NTHREADS) {
        const int hr = i / (FF / 8), c = (i % (FF / 8)) * 8, blk = pm * 4 + (hr >> 1), fr = hr & 1, row = blk * 64 + fr;
        const bool first = (row & 4095) < 2; const bf16_t* hb = RAWH + (size_t)blk * 6 * FF + c; const u32x4 z = (u32x4){0u, 0u, 0u, 0u};
        const u32x4 cur = *(const u32x4*)(hb + (2 + fr) * FF), val = *(const u32x4*)(hb + (4 + fr) * FF);
        const u32x4 p1 = (fr == 0) ? (first ? z : *(const u32x4*)(hb - 5 * FF)) : *(const u32x4*)(hb + 2 * FF);
        const u32x4 p2 = first ? z : *(const u32x4*)(hb - (fr == 0 ? 6 : 5) * FF);
        const f32x4 w0a = *(const f32x4*)(cw + c), w0b = *(const f32x4*)(cw + c + 4), w1a = *(const f32x4*)(cw + FF + c), w1b = *(const f32x4*)(cw + FF + c + 4);
        const f32x4 w2a = *(const f32x4*)(cw + 2 * FF + c), w2b = *(const f32x4*)(cw + 2 * FF + c + 4), ba = *(const f32x4*)(cb + c), bb = *(const f32x4*)(cb + c + 4);
        const f32x4 ga = pg8::gelu4(ba + w0a * up4((u32x2){p2.x, p2.y}) + w1a * up4((u32x2){p1.x, p1.y}) + w2a * up4((u32x2){cur.x, cur.y}));
        const f32x4 gb = pg8::gelu4(bb + w0b * up4((u32x2){p2.z, p2.w}) + w1b * up4((u32x2){p1.z, p1.w}) + w2b * up4((u32x2){cur.z, cur.w}));
        *(u32x4*)(ACT + (size_t)row * FF + c) = pg8::pack8(ga * up4((u32x2){val.x, val.y}), gb * up4((u32x2){val.z, val.w}));
    }
    asm volatile("s_waitcnt vmcnt(0)" ::: "memory");
    __syncthreads();
}
__device__ __forceinline__ void phase_final(ArgsP a) {
    a = args_ptr();
    const int tid = ltid(), lane = tid & 63, gw = blockIdx.x * NWAVES + (tid >> 6), NGW = gridDim.x * NWAVES;
    const float* SS4 = (const float*)(a->ws + WS_SSP) + (size_t)4 * M * 16; const f32x4* g = (const f32x4*)a->in[I_FINAL] + lane; const bf16_t* HB = (const bf16_t*)(a->ws + A_HB);
    for (int m = gw; m < M; m += NGW) {
        const float rs = rsqrtf(pg8::sum16(SS4 + (size_t)m * 16) * (1.0f / 1024.0f) + NORM_EPS);
        f32x4* o = (f32x4*)(a->out + (size_t)m * DM) + lane; const u32x2* hb = (const u32x2*)(HB + (size_t)m * DM) + lane;
#pragma unroll
        for (int j = 0; j < 4; ++j) o[64 * j] = up4(hb[64 * j]) * rs * g[64 * j];
    }
}


#ifndef DUMP_MIB
#define DUMP_MIB 0
#endif
#ifndef DUMP_OFF_MIB
#define DUMP_OFF_MIB 0
#endif
__device__ __forceinline__ void phase_dump(ArgsP a) {
    a = args_ptr();
    const size_t n16 = (size_t)DUMP_MIB * 1024 * 512, nout = (size_t)M * DM;
    const unsigned short* src = (const unsigned short*)(a->ws + (size_t)DUMP_OFF_MIB * 1024 * 1024);
    for (size_t i = (size_t)blockIdx.x * NTHREADS + vtid(); i < nout; i += (size_t)gridDim.x * NTHREADS) {
        float sacc = 0.f; for (size_t j = i; j < n16; j += nout) sacc += (float)src[j] * (1.0f / 65536.0f);
        a->out[i] = sacc; }
}

#ifndef CHK_ONLY
#define CHK_ONLY 0
#endif
#ifdef CHKSUM_PROBE
__device__ __forceinline__ void phase_chk_sum(ArgsP a) {
    a = args_ptr(); unsigned* ctl = (unsigned*)(a->ws + WS_CTL) + 32768;
    const size_t offs[4] = {A_Y, A_QN, WS_SCAL, A_YA}; const unsigned n16[4] = {(unsigned)M * 512u, (unsigned)M * 512u, (unsigned)M * 16u, 0u};
    for (int k = 0; k < 3; ++k) { const unsigned short* p = (const unsigned short*)(a->ws + offs[k]); unsigned acc = 0;
        for (unsigned i = blockIdx.x * NTHREADS + vtid(); i < n16[k]; i += gridDim.x * NTHREADS) acc += p[i];
        for (int o = 1; o < 64; o <<= 1) acc += shx(acc, o);
        if ((vtid() & 63) == 0) atomicAdd(ctl + 64 * k, acc); }
}
__device__ __forceinline__ void phase_chk_out(ArgsP a) {
    a = args_ptr(); const unsigned* ctl = (const unsigned*)(a->ws + WS_CTL) + 32768;
    for (unsigned i = blockIdx.x * NTHREADS + vtid(); i < (unsigned)(M * DM); i += gridDim.x * NTHREADS) {
        float v = 0.f; if (i == CHK_ONLY) v = (float)(__hip_atomic_load(ctl + 64 * i, __ATOMIC_RELAXED, __HIP_MEMORY_SCOPE_AGENT) % CHKSUM_PROBE) * 100.0f; a->out[i] = v; }
}
#endif

#ifdef CMPY_PROBE
__device__ __forceinline__ void phase_cmp_y(ArgsP a) {
    a = args_ptr(); unsigned long long* ctl = (unsigned long long*)(a->ws + WS_CTL) + 20000;
    const unsigned short* y1 = (const unsigned short*)(a->ws + A_Y); const unsigned short* y2 = (const unsigned short*)(a->ws + A_GATE);
    float sd = 0.f, sy = 0.f;
    for (unsigned i = blockIdx.x * NTHREADS + vtid(); i < (unsigned)M * 512u; i += gridDim.x * NTHREADS) { const float p = bf2f(y1[i]), r = bf2f(y2[i]); sd += (p - r) * (p - r); sy += r * r; }
    atomicAdd(ctl, (unsigned long long)(sd * 1024.0f)); atomicAdd(ctl + 8, (unsigned long long)(sy * 1024.0f));
}
__device__ __forceinline__ void phase_cmp_out(ArgsP a) {
    a = args_ptr(); const unsigned long long* ctl = (const unsigned long long*)(a->ws + WS_CTL) + 20000;
    const float rel = sqrtf((float)__hip_atomic_load(ctl, __ATOMIC_RELAXED, __HIP_MEMORY_SCOPE_AGENT) / (float)__hip_atomic_load(ctl + 8, __ATOMIC_RELAXED, __HIP_MEMORY_SCOPE_AGENT));
    for (unsigned i = blockIdx.x * NTHREADS + vtid(); i < (unsigned)(M * DM); i += gridDim.x * NTHREADS) a->out[i] = (i == 0) ? floorf(rel * 10000.0f) : 0.f;
}
#endif

#ifdef CK_TIME
__device__ __forceinline__ void phase_time_out(ArgsP a) {
    a = args_ptr(); const unsigned long long* tw = (const unsigned long long*)(a->ws + WS_CTL) + 24000;
#ifdef CK_TIME_TOTAL
    const float frac = (float)__hip_atomic_load(tw + 8, __ATOMIC_RELAXED, __HIP_MEMORY_SCOPE_AGENT) * (1.0f / 100000.0f);
    for (unsigned i = blockIdx.x * NTHREADS + vtid(); i < (unsigned)(M * DM); i += gridDim.x * NTHREADS) a->out[i] = (i == 0) ? floorf(frac) * 100.0f : 0.f;
#else
    const float frac = (float)__hip_atomic_load(tw + CK_TIME, __ATOMIC_RELAXED, __HIP_MEMORY_SCOPE_AGENT) / (float)__hip_atomic_load(tw + 8, __ATOMIC_RELAXED, __HIP_MEMORY_SCOPE_AGENT);
    for (unsigned i = blockIdx.x * NTHREADS + vtid(); i < (unsigned)(M * DM); i += gridDim.x * NTHREADS) a->out[i] = (i == 0) ? floorf(frac * 8.0f + 0.5f) * 1000.0f : 0.f;
#endif
}
#endif

#ifdef PH_TIME
__device__ __forceinline__ void phase_phtime_out(ArgsP a) {
    a = args_ptr(); const unsigned long long* tw = (const unsigned long long*)(a->ws + WS_CTL) + 26000;
    const float us = (float)(__hip_atomic_load(tw + PH_TIME + 1, __ATOMIC_RELAXED, __HIP_MEMORY_SCOPE_AGENT) - __hip_atomic_load(tw + PH_TIME, __ATOMIC_RELAXED, __HIP_MEMORY_SCOPE_AGENT)) * 0.01f;
    for (unsigned i = blockIdx.x * NTHREADS + vtid(); i < (unsigned)(M * DM); i += gridDim.x * NTHREADS) a->out[i] = (i == 0) ? floorf(us / (float)PH_Q + 0.5f) * 100.0f : 0.f;
}
#endif
#ifdef SPLIT_SCAN_ATTN
constexpr int PH_EXTRA = 1;
#else
constexpr int PH_EXTRA = 0;
#endif
constexpr int PH_PER_LAYER = 9 + PH_EXTRA, N_PHASES = 2 * PH_PER_LAYER + 1;
__global__ void __launch_bounds__(NTHREADS, 2) mk_fwd(Args a_unused) {
    LAS unsigned char* lds = (LAS unsigned char*)lds_raw;
    { const unsigned t0_ = threadIdx.x; if ((t0_ & 63u) == 0u) *(volatile LAS unsigned*)(lds + WTAB_OFF + hw_wave_key() * 4u) = t0_ >> 6; }
    __syncthreads();
#if !MK_MULTI
    if (args_ptr()->ph_lo > 1000000) cg::this_grid().sync();
    volatile LAS unsigned* MISC = (volatile LAS unsigned*)(lds + MISC_OFF);
    if (vtid() < 32) MISC[vtid()] = 0u;
    __syncthreads();
    (void)xcd_barrier_post((unsigned*)(args_ptr()->ws + WS_CTL) + CW_BAR, MISC + 8);
#endif
    int ph = 0;
#ifdef PH_TIME
    if (blockIdx.x == 0 && vtid() == 0) ((unsigned long long*)(args_ptr()->ws + WS_CTL) + 26000)[0] = __builtin_amdgcn_s_memrealtime();
#endif
#define lo (args_ptr()->ph_lo)
#define hi (args_ptr()->ph_hi)
#if MK_MULTI
#define SEAM() do {} while (0)
#define SEAM1() do {} while (0)
#else
#define SEAM1() do { XcdBarrier b_; b_.bar = (unsigned*)(args_ptr()->ws + WS_CTL) + CW_BAR; b_.x = xb_xcc_id(); b_.st = (volatile LAS unsigned*)(lds + MISC_OFF) + 8; xcd_barrier(b_); } while (0)
#define SEAM() do { if (ph + 1 < hi) { XcdBarrier b_; b_.bar = (unsigned*)(args_ptr()->ws + WS_CTL) + CW_BAR; b_.x = xb_xcc_id(); b_.st = (volatile LAS unsigned*)(lds + MISC_OFF) + 8; xcd_barrier(b_); } } while (0)
#endif
#ifndef PH3SUB
#define PH3SUB 7
#endif
#ifndef PHMASK
#define PHMASK 0xFFFF
#endif
#ifndef SCAN_CHUNKED
#define SCAN_CHUNKED 1
#endif
#ifndef SCAN_REPS
#define SCAN_REPS 1
#endif
#ifndef REPEAT_PHASE
#define REPEAT_PHASE (-1)
#endif
#ifndef REPEAT_LAYER
#define REPEAT_LAYER (-1)
#endif
#ifdef PH_TIME
#define PH_STAMP() do { if (blockIdx.x == 0 && vtid() == 0) ((unsigned long long*)(args_ptr()->ws + WS_CTL) + 26000)[ph + 1] = __builtin_amdgcn_s_memrealtime(); } while (0)
#elif defined(PH_SPIN)
#ifdef PH_SUB
#define PH_SUBSEL() do { const unsigned long long* ts_ = st_ + 100; d_ = PH_SUB == 1 ? ts_[1] - ts_[0] : (PH_SUB == 2 ? ts_[2] - ts_[1] : (PH_SUB == 3 ? t1_ - ts_[2] : (PH_SUB == 4 ? __hip_atomic_load((unsigned long long*)ts_ + 4, __ATOMIC_RELAXED, __HIP_MEMORY_SCOPE_AGENT) - ts_[0] : ts_[0] - st_[ph]))); } while (0)
#else
#define PH_SUBSEL() do {} while (0)
#endif
#define PH_STAMP() do { if (ph + 1 == PH_SPIN || ph == PH_SPIN) { if (blockIdx.x == 0 && vtid() == 0) { unsigned long long* st_ = (unsigned long long*)(args_ptr()->ws + WS_CTL) + 26000; \
        const unsigned long long t1_ = __builtin_amdgcn_s_memrealtime(); st_[ph + 1] = t1_; st_[103] = t1_; \
        if (ph == PH_SPIN) { unsigned long long d_ = t1_ - st_[ph]; PH_SUBSEL(); if (d_ > 100000ull) d_ = 100000ull; while (__builtin_amdgcn_s_memrealtime() - t1_ < d_) __builtin_amdgcn_s_sleep(8); } } \
        if (ph == PH_SPIN) { SEAM1(); } } } while (0)
#else
#define PH_STAMP() do {} while (0)
#endif
#define RUN(K, ...) do { if (((PHMASK >> (K)) & 1) && lo <= ph && ph < hi) { const int nrep_ = ((K) == REPEAT_PHASE && (REPEAT_LAYER < 0 || REPEAT_LAYER == l_)) ? 2 : 1; \
    for (int rep_ = 0; rep_ < nrep_; ++rep_) { __VA_ARGS__; if (rep_ + 1 < nrep_) { SEAM1(); } } SEAM(); PH_STAMP(); } ++ph; } while (0)
#define LOCALS() ArgsP a = args_ptr(); unsigned char* ws = a->ws; unsigned char* wb = ws + WS_W; float* SSP = (float*)(ws + WS_SSP); float* SSQP = (float*)(ws + WS_SSQP); bf16_t* HB = (bf16_t*)(ws + A_HB); \
    const int G = gridDim.x, bid = blockIdx.x; (void)wb; (void)SSP; (void)SSQP; (void)HB; (void)G; (void)bid
#define WT(off) ((const pg8::bf16_t*)(wb + (off)))
    int l_ = 0;
    for (int l = 0; l < DEPTH; ++l) {
        l_ = l;
        RUN(0, phase_weights(nullptr, l, lds));
        RUN(1, { LOCALS(); pg8::Gemm g{HB, WT(W_IN), M, PC - 256, 1024, 1024}; pg8::StaticOrder S; S.init(M, PC - 256, G, bid);
              pg8::EpiP E{(bf16_t*)(ws + A_RKV), (bf16_t*)(ws + A_LORAC), (bf16_t*)(ws + A_PM), (unsigned char*)a->out, SSP + (size_t)(2 * l) * M * 16, SSQP + (size_t)l * M * 4, SSQP + (size_t)(2 + l) * M * 4, (bf16_t*)((unsigned char*)a->out + DO_HALO), (LAS float*)(lds + pg8::RS_OFF), 0};
              GEMM_PHASE(pg8::EpiP, lds, g, S, E); });
        RUN(2, phase_prep(nullptr, l));
        RUN(3, { if (PH3SUB & 1) { LOCALS(); pg8::Gemm g{(const bf16_t*)(ws + A_LIN), WT(W_LORA), M, 1536, 256, 256}; pg8::StaticOrder S; S.init(M, 1536, G, bid);
                pg8::EpiLora E{(bf16_t*)(ws + A_LW), (bf16_t*)(ws + A_ICLR), (bf16_t*)(ws + A_GATE), a->in[I_DBASE] + l * 512, a->in[I_IBASE] + l * 512};
                GEMM_PHASE(pg8::EpiLora, lds, g, S, E); }
              if (gridDim.x == 256 && blockIdx.x >= 192) {
                LOCALS(); pg8::Gemm g{HB, WT(W_IN) + (size_t)(PC - 256) * 1024, M, 256, 1024, 1024}; pg8::StaticOrder S; S.init(M, 256, 64, bid - 192);
                pg8::EpiP E{(bf16_t*)(ws + A_RKV), (bf16_t*)(ws + A_LORAC), (bf16_t*)(ws + A_PM), (unsigned char*)a->out, SSP + (size_t)(2 * l) * M * 16, SSQP + (size_t)l * M * 4, SSQP + (size_t)(2 + l) * M * 4, (bf16_t*)((unsigned char*)a->out + DO_HALO), (LAS float*)(lds + pg8::RS_OFF), 16};
                GEMM_PHASE(pg8::EpiP, lds, g, S, E); }
              else if (gridDim.x != 256) {
                LOCALS(); pg8::Gemm g{HB, WT(W_IN) + (size_t)(PC - 256) * 1024, M, 256, 1024, 1024}; pg8::StaticOrder S; S.init(M, 256, G, bid);
                pg8::EpiP E{(bf16_t*)(ws + A_RKV), (bf16_t*)(ws + A_LORAC), (bf16_t*)(ws + A_PM), (unsigned char*)a->out, SSP + (size_t)(2 * l) * M * 16, SSQP + (size_t)l * M * 4, SSQP + (size_t)(2 + l) * M * 4, (bf16_t*)((unsigned char*)a->out + DO_HALO), (LAS float*)(lds + pg8::RS_OFF), 16};
                GEMM_PHASE(pg8::EpiP, lds, g, S, E); }
              if (PH3SUB & 2) { LOCALS(); pg8::Gemm g{(const bf16_t*)(ws + A_PM), WT(W_Q), M, 768, 256, 512}; pg8::StaticOrder S; S.init(M, 768, G, bid);
                pg8::EpiQ E{(bf16_t*)(ws + A_QN), (bf16_t*)(ws + A_QP), SSQP + (size_t)l * M * 4, (const float*)(ws + WS_CS), (LAS float*)(lds + pg8::RS_OFF)};
                GEMM_PHASE(pg8::EpiQ, lds, g, S, E); }
              if (PH3SUB & 4) { LOCALS(); pg8::Gemm g{(const bf16_t*)(ws + A_PM) + 256, WT(W_KV), M, 1024, 256, 512}; pg8::StaticOrder S; S.init(M, 1024, G, bid);
                pg8::EpiKV E{(bf16_t*)(ws + A_KN), (bf16_t*)(ws + A_VT), SSQP + (size_t)(2 + l) * M * 4, (LAS float*)(lds + pg8::RS_OFF)};
                GEMM_PHASE(pg8::EpiKV, lds, g, S, E); } });
#if WKV_STREAM
        RUN(4, { if (gridDim.x >= 64) { if (blockIdx.x >= 32) phase_wkvprep(nullptr, l, lds, (int)blockIdx.x - 32, (int)gridDim.x - 32); }
                 else { phase_wkvprep(nullptr, l, lds, (int)blockIdx.x, (int)gridDim.x); SEAM1(); }
                 if (blockIdx.x < 32) { for (int sr_ = 0; sr_ < SCAN_REPS; ++sr_) scan_unit_stream(nullptr, l, blockIdx.x, lds); }
#ifdef PH_SUB
                 if (blockIdx.x == 0 && vtid() == 0) { unsigned long long* ts_ = (unsigned long long*)(args_ptr()->ws + WS_CTL) + 26100; ts_[0] = ts_[3]; ts_[1] = __builtin_amdgcn_s_memrealtime(); }
#endif
                 unsigned* qctr = (unsigned*)(args_ptr()->ws + WS_CTL) + CW_QUEUE + 64 * (2 * l);
                 volatile LAS unsigned* qslot = (volatile LAS unsigned*)(lds + MISC_OFF) + 16;
                 for (;;) { if (vtid() == 0) qslot[0] = __hip_atomic_fetch_add(qctr, 1u, __ATOMIC_RELAXED, __HIP_MEMORY_SCOPE_AGENT);
                            __syncthreads(); const unsigned u = qslot[0]; __syncthreads();
                            if (u >= 512u) break;
                            attn_unit(nullptr, (int)(u & 31u), 15 - (int)(u >> 5), lds, A_QN); }
                 { unsigned* yctr = (unsigned*)(args_ptr()->ws + WS_CTL) + CW_QUEUE + 64 * (2 * l + 1);
                   for (;;) { if (vtid() == 0) qslot[0] = __hip_atomic_fetch_add(yctr, 1u, __ATOMIC_RELAXED, __HIP_MEMORY_SCOPE_AGENT);
                              __syncthreads(); const unsigned u = qslot[0]; __syncthreads();
                              if (u >= 256u) break;
                              ya_item(nullptr, l, (int)(u & 31u), (int)(u >> 5)); } }
#ifdef PH_SUB
                 if (blockIdx.x == 0 && vtid() == 0) { unsigned long long* ts_ = (unsigned long long*)(args_ptr()->ws + WS_CTL) + 26100; ts_[2] = __builtin_amdgcn_s_memrealtime(); }
                 if (blockIdx.x == 255 && vtid() == 0) { unsigned long long* ts_ = (unsigned long long*)(args_ptr()->ws + WS_CTL) + 26100; __hip_atomic_store(ts_ + 4, (unsigned long long)__builtin_amdgcn_s_memrealtime(), __ATOMIC_RELAXED, __HIP_MEMORY_SCOPE_AGENT); }
#endif
                 });
#else
#ifdef SPLIT_SCAN_ATTN
        RUN(4, { if (blockIdx.x < 128) scan_unit_chunked(nullptr, l, blockIdx.x >> 2, blockIdx.x & 3, lds); });
        RUN(5, { for (int c = blockIdx.x; c < 256; c += gridDim.x) { attn_unit(nullptr, c >> 3, 15 - (c & 7), lds); attn_unit(nullptr, c >> 3, c & 7, lds); } });
#else
        RUN(4, { if (blockIdx.x < 128) { for (int sr_ = 0; sr_ < SCAN_REPS; ++sr_) { if (SCAN_CHUNKED) scan_unit_chunked(nullptr, l, blockIdx.x >> 2, blockIdx.x & 3, lds); else scan_unit(nullptr, l, blockIdx.x >> 2, blockIdx.x & 3, lds); } }
                 const size_t oo_ = (rep_ + 1 < nrep_) ? A_LW : A_QN;
                 unsigned* qctr = (unsigned*)(args_ptr()->ws + WS_CTL) + CW_QUEUE + 64 * (2 * l + rep_);
                 volatile LAS unsigned* qslot = (volatile LAS unsigned*)(lds + MISC_OFF) + 16;
                 for (;;) { if (vtid() == 0) qslot[0] = __hip_atomic_fetch_add(qctr, 1u, __ATOMIC_RELAXED, __HIP_MEMORY_SCOPE_AGENT);
                            __syncthreads(); const unsigned u = qslot[0]; __syncthreads();
                            if (u >= 512u) break;
                            attn_unit(nullptr, (int)(u & 31u), 15 - (int)(u >> 5), lds, oo_); } });
#endif
#endif
#ifdef CK_TIME
        if (l == 0) { phase_time_out(nullptr); return; }
#endif
#ifdef CMPY_PROBE
        if (l == 0) { if (blockIdx.x < 128) scan_unit(nullptr, l, blockIdx.x >> 2, blockIdx.x & 3, lds, A_GATE); SEAM1(); phase_cmp_y(nullptr); SEAM1(); phase_cmp_out(nullptr); return; }
#endif
#ifdef CHKSUM_PROBE
        if (l == 0) { phase_chk_sum(nullptr); SEAM1(); phase_chk_out(nullptr); return; }
#endif
        RUN(7, { { LOCALS(); pg8::Gemm g{(const bf16_t*)(ws + A_YA), WT(W_OA), M, 1024, 512, 512}; pg8::StaticOrder S; S.init(M, 1024, G, bid);
                pg8::EpiMix<1> E{(float*)(ws + A_TMP), (bf16_t*)(ws + A_MERGED), (const unsigned char*)a->out};
                GEMM_PHASE(pg8::EpiMix<1>, lds, g, S, E); }
              asm volatile("s_waitcnt vmcnt(0)" ::: "memory"); __syncthreads();
              { LOCALS(); pg8::Gemm g{(const bf16_t*)(ws + A_QN), WT(W_OB), M, 1024, 512, 512}; pg8::StaticOrder S; S.init(M, 1024, G, bid);
                pg8::EpiMix<2> E{(float*)(ws + A_TMP), (bf16_t*)(ws + A_MERGED), (const unsigned char*)a->out};
                GEMM_PHASE(pg8::EpiMix<2>, lds, g, S, E); } });
        RUN(8, { LOCALS(); pg8::Gemm g{(const bf16_t*)(ws + A_MERGED), WT(W_OUT), M, 1024, 1024, 1024}; pg8::StaticOrder S; S.init(M, 1024, G, bid);
#ifdef PH_SUB
              g.ts = (unsigned long long*)(ws + WS_CTL) + 26100;
#endif
              pg8::EpiRes E{HB, SSP + (size_t)(2 * l + 1) * M * 16};
              GEMM_PHASE(pg8::EpiRes, lds, g, S, E); });
        RUN(9, { LOCALS(); pg8::Gemm g{HB, WT(W_UP), M, 2 * FF, 1024, 1024}; pg8::StaticOrder S; S.init(M, 2 * FF, G, bid);
              pg8::EpiUp E{(bf16_t*)(ws + A_ACT), (bf16_t*)(ws + A_UG), SSP + (size_t)(2 * l + 1) * M * 16, a->in[I_CONVW] + (size_t)l * 3 * FF, a->in[I_CONVB] + (size_t)l * FF, (LAS float*)(lds + pg8::RS_OFF)};
              GEMM_PHASE(pg8::EpiUp, lds, g, S, E); });
        RUN(11, { LOCALS(); pg8::Gemm g{(const bf16_t*)(ws + A_ACT), WT(W_DOWN), M, 1024, FF, FF}; pg8::StaticOrder S; S.init(M, 1024, G, bid);
              { pg8::Unit hu_; for (int hi_ = 0; S.next(hi_, hu_); ++hi_) ffn_halo_fix(nullptr, l, hu_.pm); }
              pg8::EpiRes E{HB, SSP + (size_t)(2 * l + 2) * M * 16};
              GEMM_PHASE(pg8::EpiRes, lds, g, S, E); });
    }
    RUN(12, phase_final(nullptr));
#ifdef PH_TIME
    SEAM1(); phase_phtime_out(nullptr);
#endif
#if DUMP_MIB
    if (lo == 100) phase_dump(nullptr);
#endif
#ifdef CLOCKJUNK
    if (lo == 103 && blockIdx.x == 0) { args_ptr()->out[vtid()] += (float)(__builtin_amdgcn_s_memrealtime() & 1023); }
#endif
}

#undef lo
#undef hi
extern "C" void kernel_launch(void* const* d_in, const int* in_sizes, int n_in, void* d_out, int out_size, void* d_ws, size_t ws_size, hipStream_t stream) {
    static int grid = 0;
    if (grid == 0) {
        if (n_in != 28 || out_size != M * DM || ws_size < WS_END) { fprintf(stderr, "kernel_launch: unexpected shapes: n_in %d out %d ws %zu (need %zu)\n", n_in, out_size, ws_size, (size_t)WS_END); grid = -1; return; }
        int dev = 0, cus = 0, per_cu = 0;
        if (hipGetDevice(&dev) != hipSuccess || hipDeviceGetAttribute(&cus, hipDeviceAttributeMultiprocessorCount, dev) != hipSuccess) { grid = -1; return; }
        if (hipFuncSetAttribute((const void*)mk_fwd, hipFuncAttributeMaxDynamicSharedMemorySize, LDS_BYTES) != hipSuccess) { fprintf(stderr, "kernel_launch: hipFuncSetAttribute failed\n"); grid = -1; return; }
        if (hipOccupancyMaxActiveBlocksPerMultiprocessor(&per_cu, (const void*)mk_fwd, NTHREADS, LDS_BYTES) != hipSuccess || per_cu < 1) { fprintf(stderr, "kernel_launch: occupancy query says %d\n", per_cu); per_cu = 1; }
        (void)hipGetLastError();
        grid = cus * 1;
        if (grid > cus * per_cu) grid = cus * per_cu;
    }
    if (grid < 0) return;
    if (hipMemsetAsync((char*)d_ws + WS_CTL, 0, CTL_ZERO_BYTES, stream) != hipSuccess) { fprintf(stderr, "kernel_launch: memset failed\n"); return; }
    Args a{};
    for (int i = 0; i < 28; ++i) a.in[i] = (const float*)d_in[i];
    a.out = (float*)d_out; a.ws = (unsigned char*)d_ws;
#if MK_MULTI
#ifndef STOP_AFTER
#define STOP_AFTER (N_PHASES - 1)
#endif
    for (int p = 0; p <= STOP_AFTER; ++p) {
        a.ph_lo = p; a.ph_hi = p + 1;
        hipLaunchKernelGGL(mk_fwd, dim3(grid), dim3(NTHREADS), LDS_BYTES, stream, a);
    }
#ifdef CLOCKJUNK
    a.ph_lo = 103; a.ph_hi = 104;
    hipLaunchKernelGGL(mk_fwd, dim3(grid), dim3(NTHREADS), LDS_BYTES, stream, a);
#endif
#if DUMP_MIB
    a.ph_lo = 100; a.ph_hi = 101;
    hipLaunchKernelGGL(mk_fwd, dim3(grid), dim3(NTHREADS), LDS_BYTES, stream, a);
#endif
#else
    a.ph_lo = 0; a.ph_hi = N_PHASES;
    void* kargs[] = {&a};
    hipError_t e = hipLaunchCooperativeKernel((const void*)mk_fwd, dim3(grid), dim3(NTHREADS), kargs, LDS_BYTES, stream);
    if (e != hipSuccess) fprintf(stderr, "kernel_launch: cooperative launch failed: %s (grid %d)\n", hipGetErrorString(e), grid);
#endif
}
```

```cpp
#include <hip/hip_runtime.h>
#include <hip/hip_cooperative_groups.h>
#include <cstdio>
#include <cstdint>
#include <cmath>
namespace cg = cooperative_groups;

#ifndef MK_MULTI
#define MK_MULTI 0
#endif

#ifndef SCAN_CHUNKED
#define SCAN_CHUNKED 1
#endif
#define LW_CUM SCAN_CHUNKED
#ifndef WKV_STREAM
#define WKV_STREAM 1
#endif
#ifndef CK_LWZ
#define CK_LWZ 1.0f
#endif
#ifndef CK_NOSTATE
#define CK_NOSTATE 0
#endif
#ifndef CK_AB
#define CK_AB 1.0f
#endif
constexpr int BATCH = 4, SEQ = 4096, DM = 1024, M = BATCH * SEQ, DEPTH = 2;
constexpr int NH = 8, RD = 512;
constexpr int IN_COLS = 4256, PC = 4352;
constexpr int FF = 2816;
constexpr float NORM_EPS = 1e-6f, LNX_EPS = 64e-5f;
constexpr float C2 = 0.10206207261596577f * 1.4426950408889634f;

namespace pg8 {
#define PG8_LAS __attribute__((address_space(3)))
}
extern __shared__ __attribute__((aligned(16))) unsigned char lds_raw[];
constexpr int WTAB_OFF = 131072 + 448;
__device__ __forceinline__ unsigned hw_wave_key() { return (unsigned)__builtin_amdgcn_s_getreg((5 << 11) | 4) & 63u; }
__device__ __forceinline__ int vtid() {
    const int wv = __builtin_amdgcn_readfirstlane((int)*(volatile PG8_LAS unsigned*)((PG8_LAS unsigned char*)lds_raw + WTAB_OFF + hw_wave_key() * 4u));
    int t_ = (wv << 6) | (int)__builtin_amdgcn_mbcnt_hi(~0u, __builtin_amdgcn_mbcnt_lo(~0u, 0u));
    asm volatile("" : "+v"(t_));
    return t_;
}
__device__ __forceinline__ float shx(float v, int m) {
    int l_ = (int)__builtin_amdgcn_mbcnt_hi(~0u, __builtin_amdgcn_mbcnt_lo(~0u, 0u)); asm volatile("" : "+v"(l_));
    return __builtin_bit_cast(float, __builtin_amdgcn_ds_bpermute((l_ ^ m) << 2, __builtin_bit_cast(int, v)));
}
namespace pg8 {
typedef unsigned short bf16_t;
typedef short bf16x8 __attribute__((ext_vector_type(8)));
typedef float f32x4 __attribute__((ext_vector_type(4)));
typedef unsigned u32x4 __attribute__((ext_vector_type(4)));
constexpr int BM = 256, BK = 64, HALF = 128, HTB = HALF * BK * 2  , STAGE_BYTES = 8 * HTB, NXCD = 8, WGM = 8;

__host__ __device__ __forceinline__ int lds_byte(int r, int c) { const int st = (r >> 4) * 2 + (c >> 5), rr = r & 15, cc = c & 31, ob = rr * 64 + cc * 2; return st * 1024 + (ob ^ (((ob >> 9) & 1) << 5)); }
__host__ __device__ __forceinline__ void stage_rc(int b, int& R, int& C) { const int st = b / 1024, sb = b % 1024, swz = sb ^ (((sb >> 9) & 1) << 5); R = (st >> 1) * 16 + swz / 64; C = (st & 1) * 32 + (swz % 64) / 2; }
__host__ __device__ __forceinline__ int perm32(int rho) { const int n = rho >> 4, i = rho & 15; return 8 * (i >> 2) + 4 * n + (i & 3); }

struct Unit { int pm, pn; };
struct Gemm { const bf16_t* A; const bf16_t* Bt; int M, N, K, lda; unsigned long long* ts = nullptr; };

struct StaticOrder {
    int nM, nN, nwg, G, c;
    __host__ __device__ void init(int M, int N, int G_, int c_) { nM = M / BM; nN = N / BM; nwg = nM * nN; G = G_; c = c_; }
    __host__ __device__ __forceinline__ bool next(int i, Unit& u) const {
        const long L = (long)i * G + c; if (L >= nwg) return false;
        int wgid = (int)L; { const int q = nwg / NXCD, r = nwg % NXCD, xcd = wgid % NXCD, off = wgid / NXCD; wgid = (xcd < r ? xcd * (q + 1) : r * (q + 1) + (xcd - r) * q) + off; }
        const int nig = WGM * nN, gid = wgid / nig, fm = gid * WGM, gsz = (nM - fm) < WGM ? (nM - fm) : WGM;
        u.pm = fm + ((wgid % nig) % gsz); u.pn = (wgid % nig) / gsz; return true;
    }
    __device__ __forceinline__ void a_ready(const Unit&) const {}
    __device__ __forceinline__ void done(const Unit&) const {}
};

__device__ __forceinline__ unsigned cvt_pk_bf16(float lo, float hi) { unsigned r; asm volatile("v_cvt_pk_bf16_f32 %0, %1, %2" : "=v"(r) : "v"(lo), "v"(hi)); return r; }
template <class Epi, class Sched, bool ALIGN_EPI = false, bool SP2 = false>
__device__ __forceinline__ void gemm_phase(PG8_LAS unsigned char* lds, const Gemm g, const Sched& S, const Epi& E) {
    int tid_ = vtid(); asm volatile("" : "+v"(tid_)); const int tid = tid_, wid = __builtin_amdgcn_readfirstlane(tid >> 6), lane = tid & 63, wr = wid >> 2, wc = wid & 3, fr = lane & 15, fq = lane >> 4;
    int Kx_ = g.K; asm volatile("" : "+s"(Kx_)); const int K = Kx_, nt = K / BK;
    unsigned voffA[2], voffB[2];
#pragma unroll
    for (int i = 0; i < 2; ++i) { int R, C; stage_rc(tid * 16 + i * 8192, R, C); const int Rb = Epi::PERM ? ((R & ~31) + perm32(R & 31)) : R;
        voffA[i] = (unsigned)(R * g.lda + C) * 2u; voffB[i] = (unsigned)(Rb * K + C) * 2u; }
    const size_t kstep = (size_t)(BK * 2);
    const size_t hstep = (size_t)HALF * K * 2, hstepA = (size_t)HALF * g.lda * 2;
    const size_t tstep = 2 * hstep, tstepA = 2 * hstepA;
    const unsigned ldsw = (unsigned)wid * 1024u;
    const int aoff = lds_byte(wr * 64 + fr, fq * 8), boff = lds_byte(wc * 32 + fr, fq * 8);
#define PG8_SA(b, h) (((b) * 2 + (h)) * HTB)
#define PG8_SB(b, h) ((4 + (b) * 2 + (h)) * HTB)
#define PG8_STAGE(bufoff, gbase, voff) do { _Pragma("unroll") for (int _i = 0; _i < 2; ++_i) \
        __builtin_amdgcn_global_load_lds((const unsigned*)((const char*)(gbase) + (voff)[_i]), (PG8_LAS unsigned*)(lds + (bufoff) + ldsw + _i * 8192), 16, 0, 0); } while (0)
#define PG8_LDA(dst, b, h) do { _Pragma("unroll") for (int m = 0; m < 4; ++m) _Pragma("unroll") for (int k = 0; k < 2; ++k) dst[m][k] = *(const PG8_LAS bf16x8*)(lds + PG8_SA(b, h) + aoff + m * 2048 + k * 1024); } while (0)
#define PG8_LDB(dst, b, h) do { _Pragma("unroll") for (int n = 0; n < 2; ++n) _Pragma("unroll") for (int k = 0; k < 2; ++k) dst[n][k] = *(const PG8_LAS bf16x8*)(lds + PG8_SB(b, h) + boff + n * 2048 + k * 1024); } while (0)
#define PG8_MMA(ai, bj, At, Bt) do { __builtin_amdgcn_s_setprio(1); _Pragma("unroll") for (int m = 0; m < 4; ++m) _Pragma("unroll") for (int n = 0; n < 2; ++n) _Pragma("unroll") for (int k = 0; k < 2; ++k) \
        acc[ai][bj][m][n] = __builtin_amdgcn_mfma_f32_16x16x32_bf16(Bt[n][k], At[m][k], acc[ai][bj][m][n], 0, 0, 0); __builtin_amdgcn_s_setprio(0); } while (0)
#define PG8_WAIT_V(n) asm volatile("s_waitcnt vmcnt(" #n ")" ::: "memory")
#define PG8_WAIT_L(n) asm volatile("s_waitcnt lgkmcnt(" #n ")" ::: "memory")
#define PG8_BAR __builtin_amdgcn_s_barrier()
#define PG8_SCHED __builtin_amdgcn_sched_barrier(0)
    Unit cur, nxt; int ui = 0;
    if (!S.next(0, cur)) return;
#ifdef PH_SUB
#define PG8_TS(i) do { if (blockIdx.x == 0 && tid == 0) g.ts[i] = __builtin_amdgcn_s_memrealtime(); } while (0)
#else
#define PG8_TS(i) do {} while (0)
#endif
    PG8_TS(0);
    f32x4 acc[2][2][4][2];
#pragma unroll
    for (int a = 0; a < 2; ++a)
#pragma unroll
        for (int b = 0; b < 2; ++b)
#pragma unroll
            for (int m = 0; m < 4; ++m)
#pragma unroll
                for (int n = 0; n < 2; ++n) acc[a][b][m][n] = (f32x4){0.f, 0.f, 0.f, 0.f};
    bf16x8 At[4][2], B0[2][2], B1[2][2];
    const char* cA = (const char*)g.A + (size_t)cur.pm * tstepA; const char* cB = (const char*)g.Bt + (size_t)cur.pn * tstep;
    S.a_ready(cur);
    if constexpr (SP2) {
        PG8_STAGE(PG8_SB(0, 0), cB, voffB); PG8_STAGE(PG8_SB(0, 1), cB + hstep, voffB); PG8_STAGE(PG8_SA(0, 0), cA, voffA); PG8_STAGE(PG8_SA(0, 1), cA + hstepA, voffA);
        if (wr == 1) PG8_BAR;
        PG8_WAIT_V(2); PG8_BAR;
        PG8_STAGE(PG8_SB(1, 0), cB + kstep, voffB); PG8_STAGE(PG8_SA(1, 0), cA + kstep, voffA); PG8_STAGE(PG8_SB(1, 1), cB + hstep + kstep, voffB);
        PG8_WAIT_V(6); PG8_BAR;
    } else {
        PG8_STAGE(PG8_SB(0, 0), cB, voffB); PG8_STAGE(PG8_SA(0, 0), cA, voffA); PG8_STAGE(PG8_SB(0, 1), cB + hstep, voffB); PG8_STAGE(PG8_SA(0, 1), cA + hstepA, voffA);
        if (wr == 1) PG8_BAR;
        PG8_WAIT_V(4); PG8_BAR;
        PG8_STAGE(PG8_SB(1, 0), cB + kstep, voffB); PG8_STAGE(PG8_SA(1, 0), cA + kstep, voffA); PG8_STAGE(PG8_SB(1, 1), cB + hstep + kstep, voffB);
        PG8_WAIT_V(6); PG8_BAR;
    }
    for (;;) {
        const bool has_next = S.next(ui + 1, nxt);
        const char* nA = has_next ? (const char*)g.A + (size_t)nxt.pm * tstepA : cA; const char* nB = has_next ? (const char*)g.Bt + (size_t)nxt.pn * tstep : cB;
#pragma unroll 1
        for (int t = 0; t < nt; t += 2) {
            const bool last = (t == nt - 2);
            const char* a1 = cA + (size_t)(t + 1) * kstep;
            const char* a2 = last ? nA : cA + (size_t)(t + 2) * kstep; const char* b2 = last ? nB : cB + (size_t)(t + 2) * kstep;
            const char* a3 = a2 + kstep; const char* b3 = b2 + kstep;
            if (last && has_next) S.a_ready(nxt);
            if constexpr (SP2) {
            PG8_LDB(B0, 0, 0); PG8_LDB(B1, 0, 1); PG8_SCHED; PG8_LDA(At, 0, 0); PG8_STAGE(PG8_SA(1, 1), a1 + hstepA, voffA);
            PG8_WAIT_V(8); PG8_WAIT_L(0); PG8_BAR; PG8_MMA(0, 0, At, B0); PG8_MMA(0, 1, At, B1); PG8_BAR; PG8_SCHED;
            PG8_LDA(At, 0, 1); PG8_STAGE(PG8_SB(0, 0), b2, voffB); PG8_STAGE(PG8_SB(0, 1), b2 + hstep, voffB); PG8_STAGE(PG8_SA(0, 0), a2, voffA);
            PG8_WAIT_V(8); PG8_WAIT_L(0); PG8_BAR; PG8_MMA(1, 0, At, B0); PG8_MMA(1, 1, At, B1); PG8_BAR; PG8_SCHED;
            PG8_LDB(B0, 1, 0); PG8_LDB(B1, 1, 1); PG8_SCHED; PG8_LDA(At, 1, 0); PG8_STAGE(PG8_SA(0, 1), a2 + hstepA, voffA);
            PG8_WAIT_V(8); PG8_WAIT_L(0); PG8_BAR; PG8_MMA(0, 0, At, B0); PG8_MMA(0, 1, At, B1); PG8_BAR; PG8_SCHED;
            PG8_LDA(At, 1, 1); PG8_STAGE(PG8_SB(1, 0), b3, voffB); PG8_STAGE(PG8_SB(1, 1), b3 + hstep, voffB); PG8_STAGE(PG8_SA(1, 0), a3, voffA);
            PG8_WAIT_V(8); PG8_WAIT_L(0); PG8_BAR; PG8_MMA(1, 0, At, B0); PG8_MMA(1, 1, At, B1); PG8_BAR; PG8_SCHED;
            } else {
            PG8_LDB(B0, 0, 0); PG8_SCHED; PG8_LDA(At, 0, 0); PG8_STAGE(PG8_SA(1, 1), a1 + hstepA, voffA);
            PG8_WAIT_L(8); PG8_BAR; PG8_WAIT_L(0); PG8_MMA(0, 0, At, B0); PG8_BAR; PG8_SCHED;
            PG8_LDB(B1, 0, 1); PG8_STAGE(PG8_SB(0, 0), b2, voffB);
            PG8_BAR; PG8_WAIT_L(0); PG8_MMA(0, 1, At, B1); PG8_BAR;
            PG8_LDA(At, 0, 1); PG8_STAGE(PG8_SA(0, 0), a2, voffA);
            PG8_BAR; PG8_WAIT_L(0); PG8_MMA(1, 0, At, B0); PG8_BAR; PG8_SCHED;
            PG8_STAGE(PG8_SB(0, 1), b2 + hstep, voffB);
            PG8_WAIT_V(6); PG8_BAR; PG8_MMA(1, 1, At, B1); PG8_BAR;
            PG8_LDB(B0, 1, 0); PG8_SCHED; PG8_LDA(At, 1, 0); PG8_STAGE(PG8_SA(0, 1), a2 + hstepA, voffA);
            PG8_WAIT_L(8); PG8_BAR; PG8_WAIT_L(0); PG8_MMA(0, 0, At, B0); PG8_BAR; PG8_SCHED;
            PG8_LDB(B1, 1, 1); PG8_STAGE(PG8_SB(1, 0), b3, voffB);
            PG8_BAR; PG8_WAIT_L(0); PG8_MMA(0, 1, At, B1); PG8_BAR;
            PG8_LDA(At, 1, 1); PG8_STAGE(PG8_SA(1, 0), a3, voffA);
            PG8_BAR; PG8_WAIT_L(0); PG8_MMA(1, 0, At, B0); PG8_BAR; PG8_SCHED;
            PG8_STAGE(PG8_SB(1, 1), b3 + hstep, voffB);
            PG8_WAIT_V(6); PG8_BAR; PG8_MMA(1, 1, At, B1); PG8_BAR;
            }
        }
        if constexpr (ALIGN_EPI) { if (wr == 0) PG8_BAR; }
        PG8_TS(1);
        if constexpr (!Epi::AFTER_DRAIN) { E(acc, cur, wr, wc, fr, fq); S.done(cur); }
        asm volatile("" ::: "memory"); PG8_TS(2);
        if (!has_next) break;
#pragma unroll
        for (int a = 0; a < 2; ++a)
#pragma unroll
            for (int b = 0; b < 2; ++b)
#pragma unroll
                for (int m = 0; m < 4; ++m)
#pragma unroll
                    for (int n = 0; n < 2; ++n) acc[a][b][m][n] = (f32x4){0.f, 0.f, 0.f, 0.f};
        cur = nxt; cA = nA; cB = nB; ++ui;
        if constexpr (ALIGN_EPI) { if (wr == 1) PG8_BAR; }
    }
    PG8_WAIT_V(0);
    if constexpr (!ALIGN_EPI) { if (wr == 0) PG8_BAR; }
    PG8_BAR;
    if constexpr (Epi::AFTER_DRAIN) { E.fused(acc, cur, wr, wc, fr, fq, lds, wid, lane); S.done(cur); }
#undef PG8_SA
#undef PG8_SB
#undef PG8_STAGE
#undef PG8_LDA
#undef PG8_LDB
#undef PG8_MMA
#undef PG8_WAIT_V
#undef PG8_WAIT_L
#undef PG8_BAR
#undef PG8_SCHED
}
}

#define LAS __attribute__((address_space(3)))
typedef unsigned short bf16_t;
typedef short bf16x8 __attribute__((ext_vector_type(8)));
typedef short s16x4 __attribute__((ext_vector_type(4)));
typedef float f32x4 __attribute__((ext_vector_type(4)));
typedef float f32x16 __attribute__((ext_vector_type(16)));
typedef unsigned u32x4 __attribute__((ext_vector_type(4)));
typedef unsigned u32x2 __attribute__((ext_vector_type(2)));

__device__ __forceinline__ float bf2f(unsigned b) { return __uint_as_float(b << 16); }
__device__ __forceinline__ unsigned f2bf(float f) { unsigned u = __float_as_uint(f); return (u + 0x7fffu + ((u >> 16) & 1u)) >> 16; }
typedef float f32x2_t __attribute__((ext_vector_type(2))); typedef __bf16 bf16x2_t __attribute__((ext_vector_type(2)));
__device__ __forceinline__ unsigned pk2(float lo, float hi) { const f32x2_t v = {lo, hi}; const bf16x2_t b = __builtin_convertvector(v, bf16x2_t); return __builtin_bit_cast(unsigned, b); }
__device__ __forceinline__ float sigm(float x) { return 1.0f / (1.0f + __expf(-x)); }
__device__ __forceinline__ f32x4 up4(u32x2 v) { return (f32x4){__uint_as_float(v.x << 16), __uint_as_float(v.x & 0xffff0000u), __uint_as_float(v.y << 16), __uint_as_float(v.y & 0xffff0000u)}; }
__device__ __forceinline__ u32x2 dn4(f32x4 v) { u32x2 r; r.x = pk2(v.x, v.y); r.y = pk2(v.z, v.w); return r; }
__device__ __forceinline__ float dot4(f32x4 a, f32x4 b) { return (a.x * b.x + a.y * b.y) + (a.z * b.z + a.w * b.w); }

constexpr size_t MiB = 1u << 20;
constexpr size_t WS_CTL = 0, CTL_ZERO_BYTES = 2 * MiB;
constexpr size_t WS_STAT = 1 * MiB;
constexpr size_t WS_CS = 2 * MiB;
constexpr size_t WS_W = 4 * MiB;
constexpr size_t W_IN = 0, W_LORA = W_IN + (size_t)PC * 1024 * 2, W_Q = W_LORA + 1536 * 256 * 2, W_KV = W_Q + 768 * 256 * 2,
                 W_OA = W_KV + 1024 * 256 * 2, W_OB = W_OA + 1024 * 512 * 2, W_OUT = W_OB + 1024 * 512 * 2,
                 W_UP = W_OUT + 1024 * 1024 * 2, W_DOWN = W_UP + (size_t)2 * FF * 1024 * 2, W_END = W_DOWN + (size_t)1024 * FF * 2;
static_assert(W_END <= 31 * MiB, "weights region");
constexpr size_t WS_ACT = 35 * MiB;
constexpr size_t A_HB = WS_ACT + 0 * MiB;
constexpr size_t A_RKV = WS_ACT + 32 * MiB;
constexpr size_t A_LORAC = WS_ACT + 80 * MiB;
constexpr size_t A_QP = A_LORAC;
constexpr size_t A_PM = WS_ACT + 88 * MiB;
constexpr size_t A_Y = A_PM;
constexpr size_t A_LIN = WS_ACT + 104 * MiB;
constexpr size_t A_KPE = WS_ACT + 112 * MiB;
constexpr size_t WS_SCAL = WS_ACT + 113 * MiB;
constexpr size_t A_LW = WS_ACT + 114 * MiB;
constexpr size_t A_YA = A_LW;
constexpr size_t A_ICLR = WS_ACT + 130 * MiB;
constexpr size_t A_GATE = WS_ACT + 146 * MiB;
constexpr size_t A_MERGED = A_ICLR;
constexpr size_t A_QN = WS_ACT + 162 * MiB;
constexpr size_t A_KN = WS_ACT + 178 * MiB;
constexpr size_t A_VT = WS_ACT + 194 * MiB;
constexpr size_t A_TMP = WS_ACT + 32 * MiB;
constexpr size_t A_UG = WS_ACT + 32 * MiB;
constexpr size_t A_ACT = WS_ACT + 120 * MiB;
constexpr size_t DO_MTREC = 32 * MiB, MTREC_B = 2304, DO_HALO = DO_MTREC + (size_t)8192 * MTREC_B;
static_assert(DO_HALO + (size_t)(M / 16) * 1536 * 2 <= 64 * MiB, "d_out scratch map");
constexpr size_t WS_SSP = WS_ACT + 210 * MiB;
constexpr size_t WS_SSQP = WS_SSP + 5 * MiB;
constexpr size_t WS_END = WS_SSQP + 1 * MiB;
static_assert(A_UG + (size_t)M * FF * 2 <= A_ACT && A_ACT + (size_t)M * FF * 2 <= WS_SSP && WS_END <= 256 * MiB, "workspace map");
static_assert(A_ICLR == A_LW + (size_t)M * 512 * 2 && A_GATE == A_ICLR + (size_t)M * 512 * 2, "LW | ICLR | GATE consecutive");
constexpr int CW_BAR = 4096, CW_QUEUE = 16384;

#define XB_TMO      128
#define XB_XCNT(j)  (256  + 64 * (j))
#define XB_XSUB(j)  (1280 + 64 * (j))
#define XB_XGEN(j)  (2304 + 64 * (j))
#define XB_TOP      3328
#define XB_TOPGEN   3392
#define XCD_BAR_WORDS 3456
#define XB_SPIN_CAP (1u << 18)
__device__ __forceinline__ unsigned xb_ld(unsigned* p)              { return __hip_atomic_load(p, __ATOMIC_RELAXED, __HIP_MEMORY_SCOPE_AGENT); }
__device__ __forceinline__ unsigned xb_add(unsigned* p, unsigned v) { return __hip_atomic_fetch_add(p, v, __ATOMIC_RELAXED, __HIP_MEMORY_SCOPE_AGENT); }
__device__ __forceinline__ unsigned xb_xcc_id() { return (unsigned)__builtin_amdgcn_s_getreg((3 << 11) | 20) & 0xFu; }
#define XB_SPIN(cond, bar) do { unsigned _sp = 0; while (cond) { __builtin_amdgcn_s_sleep(1); \
    if ((++_sp & 255u) == 0u) { if (xb_ld(&(bar)[XB_TMO])) break; if (_sp > XB_SPIN_CAP) { atomicAdd(&(bar)[XB_TMO], 1u); break; } } } } while (0)
struct XcdBarrier { unsigned* bar; unsigned x; volatile LAS unsigned* st; };
__device__ __forceinline__ XcdBarrier xcd_barrier_post(unsigned* bar, volatile LAS unsigned* st) {
    XcdBarrier b; b.bar = bar; b.x = xb_xcc_id(); b.st = st;
    if (vtid() == 0) (void)xb_add(&bar[XB_XCNT(b.x)], 1u);
    return b;
}
__device__ __forceinline__ void xcd_barrier_complete(unsigned* bar, unsigned x, unsigned& nloc, unsigned& nx) {
    const unsigned G = gridDim.x * gridDim.y * gridDim.z;
    unsigned sum, cnt, mine, sp = 0u;
    for (;;) {
        sum = 0u; cnt = 0u; mine = 0u;
#pragma unroll
        for (unsigned j = 0; j < 16; ++j) { const unsigned c = xb_ld(&bar[XB_XCNT(j)]); sum += c; cnt += (c > 0u) ? 1u : 0u; mine = (j == x) ? c : mine; }
        if (sum == G) break;
        __builtin_amdgcn_s_sleep(1);
        if ((++sp & 255u) == 0u) { if (xb_ld(&bar[XB_TMO])) break; if (sp > XB_SPIN_CAP) { atomicAdd(&bar[XB_TMO], 1u); break; } }
    }
    nloc = mine > 0u ? mine : 1u; nx = cnt > 0u ? cnt : 1u;
}
__device__ __forceinline__ void xcd_barrier(const XcdBarrier& b) {
    asm volatile("s_waitcnt vmcnt(0)" ::: "memory");
    __syncthreads();
    if (vtid() == 0) {
        unsigned* bar = b.bar;
        __builtin_amdgcn_s_waitcnt(0);
        unsigned nloc = b.st[0], nx = b.st[1];
        if (nloc == 0u) { xcd_barrier_complete(bar, b.x, nloc, nx); b.st[0] = nloc; b.st[1] = nx; }
        const unsigned old = xb_add(&bar[XB_XSUB(b.x)], 1u);
        const unsigned gen = old / nloc;
        if (old + 1u == (gen + 1u) * nloc) {
            __builtin_amdgcn_fence(__ATOMIC_RELEASE, "agent");
            asm volatile("s_waitcnt vmcnt(0)" ::: "memory");
            const unsigned og = xb_add(&bar[XB_TOP], 1u);
            const unsigned tg = og / nx;
            if (og + 1u == (tg + 1u) * nx) xb_add(&bar[XB_TOPGEN], 1u);
            else XB_SPIN(xb_ld(&bar[XB_TOPGEN]) == tg, bar);
            __builtin_amdgcn_fence(__ATOMIC_ACQUIRE, "agent");
            xb_add(&bar[XB_XGEN(b.x)], 1u);
            asm volatile("s_waitcnt vmcnt(0)" ::: "memory");
        } else {
            XB_SPIN(xb_ld(&bar[XB_XGEN(b.x)]) == gen, bar);
            __builtin_amdgcn_fence(__ATOMIC_ACQUIRE, "agent");
            asm volatile("s_waitcnt vmcnt(0)" ::: "memory");
        }
    }
    __syncthreads();
}

namespace pg8 {
__device__ __forceinline__ float sum16(const float* p) { const f32x4 a = *(const f32x4*)p, b = *(const f32x4*)(p + 4), c = *(const f32x4*)(p + 8), d = *(const f32x4*)(p + 12);
    return (((a.x + a.y) + (a.z + a.w)) + ((b.x + b.y) + (b.z + b.w))) + (((c.x + c.y) + (c.z + c.w)) + ((d.x + d.y) + (d.z + d.w))); }
__device__ __forceinline__ float sum4(const float* p) { const f32x4 a = *(const f32x4*)p; return (a.x + a.y) + (a.z + a.w); }
__device__ __forceinline__ u32x4 pack8(f32x4 a, f32x4 b) { u32x4 w; w.x = cvt_pk_bf16(a[0], a[1]); w.y = cvt_pk_bf16(a[2], a[3]); w.z = cvt_pk_bf16(b[0], b[1]); w.w = cvt_pk_bf16(b[2], b[3]); return w; }
__device__ __forceinline__ unsigned q8(float s) { return (unsigned)(s * 255.0f + 0.5f); }
__device__ __forceinline__ unsigned sig8x4(f32x4 v) { return q8(sigm(v[0])) | (q8(sigm(v[1])) << 8) | (q8(sigm(v[2])) << 16) | (q8(sigm(v[3])) << 24); }

constexpr int RS_OFF = 131072 + 1024;
#ifndef NT_STORES
#define NT_STORES 0
#endif
#ifndef NT_STORES8
#define NT_STORES8 0
#endif
__device__ __forceinline__ void ST16(bf16_t* p, u32x4 v) {
    if (NT_STORES == 1) __builtin_nontemporal_store(v, (u32x4*)p);
    else if (NT_STORES == 2) asm volatile("global_store_dwordx4 %0, %1, off sc1\n\ts_nop 1" :: "v"(p), "v"(v) : "memory");
    else if (NT_STORES == 3) asm volatile("global_store_dwordx4 %0, %1, off sc0 sc1\n\ts_nop 1" :: "v"(p), "v"(v) : "memory");
    else *(u32x4*)p = v; }
#ifndef NT_UP
#define NT_UP 1
#endif
__device__ __forceinline__ void ST16W(bf16_t* p, u32x4 v) { if (NT_UP) asm volatile("global_store_dwordx4 %0, %1, off sc1\n\ts_nop 1" :: "v"(p), "v"(v) : "memory"); else *(u32x4*)p = v; }
__device__ __forceinline__ void ST8W(void* p, u32x2 v) { asm volatile("global_store_dwordx2 %0, %1, off sc1\n\ts_nop 1" :: "v"(p), "v"(v) : "memory"); }
#ifndef SC1_MIX
#define SC1_MIX 0
#endif
#ifndef SC1_RES
#define SC1_RES 0
#endif
#ifndef SC1_QKV
#define SC1_QKV 0
#endif
template <int W> __device__ __forceinline__ void ST16S(bf16_t* p, u32x4 v) { if (W) asm volatile("global_store_dwordx4 %0, %1, off sc1\n\ts_nop 1" :: "v"(p), "v"(v) : "memory"); else *(u32x4*)p = v; }
template <int W> __device__ __forceinline__ void ST8S(bf16_t* p, u32x2 v) { if (W) asm volatile("global_store_dwordx2 %0, %1, off sc1\n\ts_nop 1" :: "v"(p), "v"(v) : "memory"); else *(u32x2*)p = v; }
__device__ __forceinline__ void ST8(bf16_t* p, u32x2 v) {
    if (NT_STORES8 == 2) asm volatile("global_store_dwordx2 %0, %1, off sc1\n\ts_nop 1" :: "v"(p), "v"(v) : "memory");
    else *(u32x2*)p = v; }
template <int NS> __device__ __forceinline__ void rs_to_lds(PG8_LAS float* rsl, const float* ss, int pm, float inv_n, float mul, int tid) {
    if (tid < 256) { const float* p = ss + (size_t)(pm * BM + tid) * NS; const float s_ = NS == 16 ? sum16(p) : sum4(p); rsl[tid] = rsqrtf(s_ * inv_n + NORM_EPS) * mul; }
    asm volatile("s_waitcnt lgkmcnt(0)" ::: "memory"); __builtin_amdgcn_s_barrier();
}
struct EpiP {
    static constexpr bool PERM = true, AFTER_DRAIN = false;
    bf16_t* RKV; bf16_t* LORAC; bf16_t* PMb; unsigned char* G8; const float* ss; float* ssq; float* sskv; bf16_t* HALO; PG8_LAS float* rsl; int pn0;
    __device__ __forceinline__ void operator()(const f32x4 (&acc)[2][2][4][2], const Unit& u, int wr, int wc, int fr, int fq) const {
        const int row0 = u.pm * BM + wr * 64 + fr, pn = u.pn + pn0;
        rs_to_lds<16>(rsl, ss, u.pm, 1.0f / 1024.0f, 1.0f, (wr * 4 + wc) * 64 + fq * 16 + fr);
#pragma unroll
        for (int ai = 0; ai < 2; ++ai)
#pragma unroll
            for (int m = 0; m < 4; ++m) {
                const int row = row0 + ai * HALF + m * 16;
                const float rs = rsl[wr * 64 + ai * HALF + m * 16 + fr];
                float sq = 0.f;
#pragma unroll
                for (int bj = 0; bj < 2; ++bj) {
                    const f32x4 v0 = acc[ai][bj][m][0] * rs, v1 = acc[ai][bj][m][1] * rs;
                    const int ct = bj * HALF + wc * 32 + 8 * fq;
                    if (pn < 6) { const u32x4 pk_ = pack8(v0, v1); ST16(RKV + (size_t)row * 1536 + pn * 256 + ct, pk_); if (fr == 15) *(u32x4*)(HALO + (size_t)(row >> 4) * 1536 + pn * 256 + ct) = pk_; }
                    else if (pn == 6) ST16(LORAC + (size_t)row * 256 + ct, pack8(v0, v1));
                    else if (pn < 9) { ST16(PMb + (size_t)row * 512 + (pn - 7) * 256 + ct, pack8(v0, v1));
                        if (pn == 7 || bj == 0) sq += dot4(v0, v0) + dot4(v1, v1); }
                    else { u32x2 w; w.x = sig8x4(v0); w.y = sig8x4(v1); ST8((bf16_t*)(G8 + (size_t)row * 2048 + (pn - 9) * 256 + ct), w); }
                }
                if (pn == 7 || pn == 8) { sq += shx(sq, 16); sq += shx(sq, 32); if (fq == 0) (pn == 7 ? ssq : sskv)[(size_t)row * 4 + wc] = sq; }
            }
    }
};
#ifndef LW_CUM
#define LW_CUM 1
#endif
template <int CTRL> __device__ __forceinline__ float dppz(float x) { return __builtin_bit_cast(float, __builtin_amdgcn_update_dpp(0, __builtin_bit_cast(int, x), CTRL, 0xf, 0xf, true)); }
__device__ __forceinline__ float pfx16(float x) { x += dppz<0x111>(x); x += dppz<0x112>(x); x += dppz<0x114>(x); x += dppz<0x118>(x); return x; }
struct EpiLora {
    static constexpr bool PERM = true, AFTER_DRAIN = false;
    bf16_t* LW; bf16_t* ICLR; bf16_t* GATE; const float* dbase; const float* ibase;
    __device__ __forceinline__ void operator()(const f32x4 (&acc)[2][2][4][2], const Unit& u, int wr, int wc, int fr, int fq) const {
        const int pn = u.pn, kind = pn >> 1;
        bf16_t* dst = LW + (size_t)kind * ((size_t)M * 512);
        const float* bias = kind == 0 ? dbase : ibase;
        const unsigned c0 = (pn & 1) * 256 + wc * 32 + 8 * fq;
        const unsigned off0 = (unsigned)(u.pm * BM + wr * 64 + fr) * 512u + c0;
#pragma unroll
        for (int bj = 0; bj < 2; ++bj) {
            f32x4 b0 = (f32x4){0.f, 0.f, 0.f, 0.f}, b1 = b0;
            if (kind < 2) { b0 = *(const f32x4*)(bias + c0 + bj * HALF); b1 = *(const f32x4*)(bias + c0 + bj * HALF + 4); }
#pragma unroll
            for (int ai = 0; ai < 2; ++ai)
#pragma unroll
                for (int m = 0; m < 4; ++m) {
                    f32x4 v0 = acc[ai][bj][m][0] + b0, v1 = acc[ai][bj][m][1] + b1;
                    if (kind == 0) { for (int e = 0; e < 4; ++e) { v0[e] = -0.6065306597126334f * sigm(v0[e]); v1[e] = -0.6065306597126334f * sigm(v1[e]); }
                        if (LW_CUM) { for (int e = 0; e < 4; ++e) { v0[e] = __expf(pfx16(v0[e])); v1[e] = __expf(pfx16(v1[e])); } } }
                    else if (kind == 1) { for (int e = 0; e < 4; ++e) { v0[e] = sigm(v0[e]); v1[e] = sigm(v1[e]); } }
                    ST16(dst + off0 + (unsigned)((ai * HALF + m * 16) * 512 + bj * HALF), pack8(v0, v1));
                    asm volatile("" ::: "memory");
                }
        }
    }
};
struct EpiQ {
    static constexpr bool PERM = false, AFTER_DRAIN = false;
    bf16_t* Qn; bf16_t* Qp; const float* ssq; const float* CS; PG8_LAS float* rsl;
    __device__ __forceinline__ void operator()(const f32x4 (&acc)[2][2][4][2], const Unit& u, int wr, int wc, int fr, int fq) const {
        const int row0 = u.pm * BM + wr * 64 + fr, pn = u.pn;
        if (pn < 2) {
            rs_to_lds<4>(rsl, ssq, u.pm, 1.0f / 256.0f, C2, (wr * 4 + wc) * 64 + fq * 16 + fr);
#pragma unroll
            for (int ai = 0; ai < 2; ++ai)
#pragma unroll
                for (int m = 0; m < 4; ++m) {
                    const int row = row0 + ai * HALF + m * 16;
                    const float rs = rsl[wr * 64 + ai * HALF + m * 16 + fr];
#pragma unroll
                    for (int bj = 0; bj < 2; ++bj)
#pragma unroll
                        for (int n = 0; n < 2; ++n) ST8S<SC1_QKV>(Qn + (size_t)row * 512 + pn * 256 + bj * HALF + wc * 32 + n * 16 + 4 * fq, dn4(acc[ai][bj][m][n] * rs));
                }
        } else {
            f32x4 cs[2][4], sn[2][4];
#pragma unroll
            for (int ai = 0; ai < 2; ++ai)
#pragma unroll
                for (int m = 0; m < 4; ++m) { const int row = row0 + ai * HALF + m * 16; cs[ai][m] = *(const f32x4*)(CS + (size_t)row * 32 + 4 * fq); sn[ai][m] = *(const f32x4*)(CS + (size_t)row * 32 + 16 + 4 * fq); }
            rs_to_lds<4>(rsl, ssq, u.pm, 1.0f / 256.0f, C2, (wr * 4 + wc) * 64 + fq * 16 + fr);
#pragma unroll
            for (int ai = 0; ai < 2; ++ai)
#pragma unroll
                for (int m = 0; m < 4; ++m) {
                    const int row = row0 + ai * HALF + m * 16;
                    const float rs = rsl[wr * 64 + ai * HALF + m * 16 + fr];
#pragma unroll
                    for (int bj = 0; bj < 2; ++bj) {
                        const f32x4 x1 = acc[ai][bj][m][0] * rs, x2 = acc[ai][bj][m][1] * rs;
                        bf16_t* d = Qp + (size_t)row * 256 + (4 * bj + wc) * 32 + 4 * fq;
                        ST8S<SC1_QKV>(d, dn4(x1 * cs[ai][m] - x2 * sn[ai][m])); ST8S<SC1_QKV>(d + 16, dn4(x1 * sn[ai][m] + x2 * cs[ai][m]));
                    }
                }
        }
    }
};
struct EpiKV {
    static constexpr bool PERM = false, AFTER_DRAIN = false;
    bf16_t* Kn; bf16_t* Vt; const float* sskv; PG8_LAS float* rsl;
    __device__ __forceinline__ void operator()(const f32x4 (&acc)[2][2][4][2], const Unit& u, int wr, int wc, int fr, int fq) const {
        const int row0 = u.pm * BM + wr * 64 + fr, pn = u.pn;
        rs_to_lds<4>(rsl, sskv, u.pm, 1.0f / 128.0f, 1.0f, (wr * 4 + wc) * 64 + fq * 16 + fr);
#pragma unroll
        for (int ai = 0; ai < 2; ++ai)
#pragma unroll
            for (int m = 0; m < 4; ++m) {
                const int row = row0 + ai * HALF + m * 16;
                const float rs = rsl[wr * 64 + ai * HALF + m * 16 + fr];
                if (pn < 2) {
#pragma unroll
                    for (int bj = 0; bj < 2; ++bj)
#pragma unroll
                        for (int n = 0; n < 2; ++n) ST8S<SC1_QKV>(Kn + (size_t)row * 512 + pn * 256 + bj * HALF + wc * 32 + n * 16 + 4 * fq, dn4(acc[ai][bj][m][n] * rs));
                } else {
                    const int b = row >> 12, s = row & 4095;
#pragma unroll
                    for (int bj = 0; bj < 2; ++bj)
#pragma unroll
                        for (int n = 0; n < 2; ++n) {
                            const int hd = (pn - 2) * 4 + 2 * bj + (wc >> 1), d = 32 * (wc & 1) + 16 * n + 4 * fq;
                            const f32x4 v = acc[ai][bj][m][n] * rs;
                            bf16_t* dst = Vt + ((size_t)((b * 8 + hd) * 64 + d) << 12) + s;
#pragma unroll
                            for (int j = 0; j < 4; ++j) dst[(size_t)j << 12] = (bf16_t)f2bf(v[j]);
                        }
                }
            }
    }
};
template <int PASS> struct EpiMix {
    static constexpr bool PERM = true, AFTER_DRAIN = false;
    float* TMP; bf16_t* MERGED; const unsigned char* G8;
    template <int AI> __device__ __forceinline__ void load(u32x2 (&g)[4][2], u32x4 (&t)[4][2], int row0, int c0) const {
#pragma unroll
        for (int m = 0; m < 4; ++m)
#pragma unroll
            for (int bj = 0; bj < 2; ++bj) { const size_t row = (size_t)(row0 + AI * HALF + m * 16); const int c = c0 + bj * HALF;
                g[m][bj] = *(const u32x2*)(G8 + row * 2048 + (PASS - 1) * 1024 + c);
                if (PASS == 2) t[m][bj] = *(const u32x4*)(MERGED + row * 1024 + c); }
    }
    template <int AI> __device__ __forceinline__ void calc(const f32x4 (&acc)[2][2][4][2], const u32x2 (&g)[4][2], u32x4 (&t)[4][2]) const {
#pragma unroll
        for (int m = 0; m < 4; ++m)
#pragma unroll
            for (int bj = 0; bj < 2; ++bj) { const unsigned ga = g[m][bj].x, gb = g[m][bj].y;
                const f32x4 sa = (f32x4){(float)(ga & 255u), (float)((ga >> 8) & 255u), (float)((ga >> 16) & 255u), (float)(ga >> 24)} * (1.0f / 255.0f);
                const f32x4 sb = (f32x4){(float)(gb & 255u), (float)((gb >> 8) & 255u), (float)((gb >> 16) & 255u), (float)(gb >> 24)} * (1.0f / 255.0f);
                f32x4 oa = acc[AI][bj][m][0] * sa, ob = acc[AI][bj][m][1] * sb;
                if (PASS == 2) { oa = oa + up4((u32x2){t[m][bj].x, t[m][bj].y}); ob = ob + up4((u32x2){t[m][bj].z, t[m][bj].w}); }
                const u32x2 pa = dn4(oa), pb = dn4(ob); t[m][bj] = (u32x4){pa.x, pa.y, pb.x, pb.y}; }
    }
    template <int AI> __device__ __forceinline__ void store(const u32x4 (&o)[4][2], int row0, int c0) const {
#pragma unroll
        for (int m = 0; m < 4; ++m)
#pragma unroll
            for (int bj = 0; bj < 2; ++bj) ST16S<SC1_MIX>(MERGED + (size_t)(row0 + AI * HALF + m * 16) * 1024 + c0 + bj * HALF, o[m][bj]);
    }
    __device__ __forceinline__ void operator()(const f32x4 (&acc)[2][2][4][2], const Unit& u, int wr, int wc, int fr, int fq) const {
        const int row0 = u.pm * BM + wr * 64 + fr, c0 = u.pn * BM + wc * 32 + 8 * fq;
        u32x2 g0[4][2], g1[4][2]; u32x4 t0[4][2], t1[4][2];
        load<0>(g0, t0, row0, c0); calc<0>(acc, g0, t0);
        load<1>(g1, t1, row0, c0);
        store<0>(t0, row0, c0);
        calc<1>(acc, g1, t1); store<1>(t1, row0, c0);
    }
};
struct EpiRes {
    static constexpr bool PERM = false, AFTER_DRAIN = false;
    bf16_t* HB; float* ssacc;
    __device__ __forceinline__ void operator()(const f32x4 (&acc)[2][2][4][2], const Unit& u, int wr, int wc, int fr, int fq) const {
        const int row0 = u.pm * BM + wr * 64 + fr, c0 = u.pn * BM + wc * 32 + 4 * fq;
        u32x2 b[2][4][2][2];
#pragma unroll
        for (int ai = 0; ai < 2; ++ai)
#pragma unroll
            for (int m = 0; m < 4; ++m)
#pragma unroll
                for (int bj = 0; bj < 2; ++bj)
#pragma unroll
                    for (int n = 0; n < 2; ++n) b[ai][m][bj][n] = *(const u32x2*)(HB + (size_t)(row0 + ai * HALF + m * 16) * 1024 + c0 + bj * HALF + n * 16);
#pragma unroll
        for (int ai = 0; ai < 2; ++ai)
#pragma unroll
            for (int m = 0; m < 4; ++m) {
                const int row = row0 + ai * HALF + m * 16; float sq = 0.f;
#pragma unroll
                for (int bj = 0; bj < 2; ++bj)
#pragma unroll
                    for (int n = 0; n < 2; ++n) {
                        const u32x2 p = dn4(up4(b[ai][m][bj][n]) + acc[ai][bj][m][n]); const f32x4 v = up4(p);
                        ST8S<SC1_RES>(HB + (size_t)row * 1024 + c0 + bj * HALF + n * 16, p); sq += dot4(v, v);
                    }
                sq += shx(sq, 16); sq += shx(sq, 32);
                if (fq == 0) ssacc[(size_t)row * 16 + u.pn * 4 + wc] = sq;
            }
    }
};
typedef float f32x2 __attribute__((ext_vector_type(2)));
__device__ __forceinline__ f32x2 gelu_pk2(f32x2 v) {
    const f32x2 av = __builtin_elementwise_abs(v), d = av * 0.2316418882f + 1.0f;
    f32x2 t; t.x = __builtin_amdgcn_rcpf(d.x); t.y = __builtin_amdgcn_rcpf(d.y);
    f32x2 q = t * 0.5307027145f + (-0.7265760135f); q = q * t + 0.7107068705f; q = q * t + (-0.142248368f); q = q * t + 0.127414796f; q = q * t;
    const f32x2 s2 = (v * v) * (-0.72134752044f);
    f32x2 e; e.x = __builtin_amdgcn_exp2f(s2.x); e.y = __builtin_amdgcn_exp2f(s2.y);
    const f32x2 m = v * (q * e), r = v - m;
    f32x2 o; o.x = v.x < 0.f ? m.x : r.x; o.y = v.y < 0.f ? m.y : r.y; return o;
}
__device__ __forceinline__ f32x4 gelu4(f32x4 c) { const f32x2 g0 = gelu_pk2((f32x2){c.x, c.y}), g1 = gelu_pk2((f32x2){c.z, c.w}); return (f32x4){g0.x, g0.y, g1.x, g1.y}; }
template <int CTRL> __device__ __forceinline__ f32x4 ror4(f32x4 x) { f32x4 r;
#pragma unroll
    for (int e = 0; e < 4; ++e) { const float xe = x[e]; const int xi = __builtin_bit_cast(int, xe); r[e] = __builtin_bit_cast(float, __builtin_amdgcn_update_dpp(xi, xi, CTRL, 0xf, 0xf, false)); }
    return r; }
struct EpiUp {
    static constexpr bool PERM = true, AFTER_DRAIN = false;
    bf16_t* ACT; bf16_t* RAWH; const float* ss; const float* cw; const float* cb; PG8_LAS float* rsl;
    __device__ __forceinline__ void operator()(const f32x4 (&acc)[2][2][4][2], const Unit& u, int wr, int wc, int fr, int fq) const {
        const int tid = (wr * 4 + wc) * 64 + fq * 16 + fr, row0 = u.pm * BM + wr * 64 + fr;
        PG8_LAS float* wl = rsl + 256;
        if (tid >= 256 && tid < 384) { const int j = tid - 256, cg = u.pn * HALF + j; wl[j] = cw[cg]; wl[128 + j] = cw[FF + cg]; wl[256 + j] = cw[2 * FF + cg]; wl[384 + j] = cb[cg]; }
        rs_to_lds<16>(rsl, ss, u.pm, 1.0f / 1024.0f, 1.0f, tid);
        const int cl = wc * 32 + 8 * fq, cgl = u.pn * HALF + cl;
#pragma unroll
        for (int ai = 0; ai < 2; ++ai) {
            f32x4 q1a, q1b, q2a, q2b;
#pragma unroll
            for (int m = 0; m < 4; ++m) {
                const int row = row0 + ai * HALF + m * 16;
                const float rs = rsl[wr * 64 + ai * HALF + m * 16 + fr];
                const PG8_LAS float* wp = wl + cl; asm volatile("" : "+v"(wp));
                const f32x4 w0a = *(const PG8_LAS f32x4*)(wp), w0b = *(const PG8_LAS f32x4*)(wp + 4), w1a = *(const PG8_LAS f32x4*)(wp + 128), w1b = *(const PG8_LAS f32x4*)(wp + 128 + 4);
                const f32x4 w2a = *(const PG8_LAS f32x4*)(wp + 256), w2b = *(const PG8_LAS f32x4*)(wp + 256 + 4), ba = *(const PG8_LAS f32x4*)(wp + 384), bb = *(const PG8_LAS f32x4*)(wp + 384 + 4);
                const f32x4 xa = acc[ai][0][m][0] * rs, xb = acc[ai][0][m][1] * rs, va = acc[ai][1][m][0] * rs, vb = acc[ai][1][m][1] * rs;
                const f32x4 r1a = ror4<0x121>(xa), r1b = ror4<0x121>(xb), r2a = ror4<0x122>(xa), r2b = ror4<0x122>(xb);
                f32x4 p1a = r1a, p1b = r1b, p2a = r2a, p2b = r2b;
                if (m > 0) { if (fr < 1) { p1a = q1a; p1b = q1b; } if (fr < 2) { p2a = q2a; p2b = q2b; } }
                const f32x4 ga = gelu4(ba + w0a * p2a + w1a * p1a + w2a * xa), gb = gelu4(bb + w0b * p2b + w1b * p1b + w2b * xb);
                if (m > 0 || fr >= 2) ST16W(ACT + (size_t)row * FF + cgl, pack8(ga * va, gb * vb));
                if (m == 0) { if (fr < 2) { bf16_t* hp = RAWH + ((size_t)(row >> 6) * 6 + 2 + fr) * FF + cgl; *(u32x4*)hp = pack8(xa, xb); *(u32x4*)(hp + 2 * FF) = pack8(va, vb); } }
                if (m == 3) { if (fr >= 14) *(u32x4*)(RAWH + ((size_t)(row >> 6) * 6 + (fr - 14)) * FF + cgl) = pack8(xa, xb); }
                q1a = r1a; q1b = r1b; q2a = r2a; q2b = r2b;
            }
        }
    }
};
struct EpiUpG {
    static constexpr bool PERM = true, AFTER_DRAIN = false;
    bf16_t* UG; const float* ss; PG8_LAS float* rsl;
    __device__ __forceinline__ void operator()(const f32x4 (&acc)[2][2][4][2], const Unit& u, int wr, int wc, int fr, int fq) const {
        const int row0 = u.pm * BM + wr * 64 + fr;
        rs_to_lds<16>(rsl, ss, u.pm, 1.0f / 1024.0f, 1.0f, (wr * 4 + wc) * 64 + fq * 16 + fr);
#pragma unroll
        for (int ai = 0; ai < 2; ++ai)
#pragma unroll
            for (int m = 0; m < 4; ++m) {
                const int row = row0 + ai * HALF + m * 16;
                const float rs = rsl[wr * 64 + ai * HALF + m * 16 + fr];
#pragma unroll
                for (int bj = 0; bj < 2; ++bj) ST16(UG + (size_t)row * FF + u.pn * BM + bj * HALF + wc * 32 + 8 * fq, pack8(acc[ai][bj][m][0] * rs, acc[ai][bj][m][1] * rs));
            }
    }
};
struct EpiUpV {
    static constexpr bool PERM = true, AFTER_DRAIN = false;
    bf16_t* ACT; const float* ss; PG8_LAS float* rsl;
    __device__ __forceinline__ void operator()(const f32x4 (&acc)[2][2][4][2], const Unit& u, int wr, int wc, int fr, int fq) const {
        const int row0 = u.pm * BM + wr * 64 + fr, c0 = u.pn * BM + wc * 32 + 8 * fq;
        u32x4 gc[2][4][2];
#pragma unroll
        for (int ai = 0; ai < 2; ++ai)
#pragma unroll
            for (int m = 0; m < 4; ++m)
#pragma unroll
                for (int bj = 0; bj < 2; ++bj) gc[ai][m][bj] = *(const u32x4*)(ACT + (size_t)(row0 + ai * HALF + m * 16) * FF + c0 + bj * HALF);
        rs_to_lds<16>(rsl, ss, u.pm, 1.0f / 1024.0f, 1.0f, (wr * 4 + wc) * 64 + fq * 16 + fr);
#pragma unroll
        for (int ai = 0; ai < 2; ++ai)
#pragma unroll
            for (int m = 0; m < 4; ++m) {
                const int row = row0 + ai * HALF + m * 16;
                const float rs = rsl[wr * 64 + ai * HALF + m * 16 + fr];
#pragma unroll
                for (int bj = 0; bj < 2; ++bj) { const u32x4 g = gc[ai][m][bj];
                    *(u32x4*)(ACT + (size_t)row * FF + c0 + bj * HALF) = pack8(up4((u32x2){g.x, g.y}) * (acc[ai][bj][m][0] * rs), up4((u32x2){g.z, g.w}) * (acc[ai][bj][m][1] * rs)); }
            }
    }
};
}


#ifndef NAIVE_GEMM
#define NAIVE_GEMM 0
#endif
#ifndef NAIVE_ATTN
#define NAIVE_ATTN 0
#endif
#ifndef SHFL_SCAN
#define SHFL_SCAN 0
#endif
namespace pg8 {
template <class Epi, class Sched>
__device__ __forceinline__ void gemm_phase_naive(const Gemm g, const Sched& S, const Epi& E) {
    const int tid = vtid(), wid = tid >> 6, lane = tid & 63, wr = wid >> 2, wc = wid & 3, fr = lane & 15, fq = lane >> 4;
    Unit u;
    for (int i = 0; S.next(i, u); ++i) {
        f32x4 acc[2][2][4][2];
        _Pragma("unroll") for (int a = 0; a < 2; ++a) _Pragma("unroll") for (int b = 0; b < 2; ++b) _Pragma("unroll") for (int m = 0; m < 4; ++m) _Pragma("unroll") for (int n = 0; n < 2; ++n) {
            const int row = u.pm * BM + a * HALF + wr * 64 + m * 16 + fr;
            _Pragma("unroll") for (int j = 0; j < 4; ++j) {
                const int col = u.pn * BM + b * HALF + wc * 32 + (Epi::PERM ? 8 * fq + 4 * n + j : 16 * n + 4 * fq + j);
                const bf16_t* ap = g.A + (size_t)row * g.lda; const bf16_t* bp = g.Bt + (size_t)col * g.K;
                float s = 0.f;
                _Pragma("unroll 1") for (int k = 0; k < g.K; k += 8) {
                    const u32x4 av = *(const u32x4*)(ap + k), bv = *(const u32x4*)(bp + k);
                    for (int e = 0; e < 4; ++e) { s += __uint_as_float(av[e] << 16) * __uint_as_float(bv[e] << 16); s += __uint_as_float(av[e] & 0xffff0000u) * __uint_as_float(bv[e] & 0xffff0000u); }
                }
                acc[a][b][m][n][j] = s;
            }
        }
        E(acc, u, wr, wc, fr, fq);
    }
}
}
#if NAIVE_GEMM
#define GEMM_PHASE(EPI, lds, g, S, E) pg8::gemm_phase_naive<EPI, pg8::StaticOrder>(g, S, E)
#else
#define GEMM_PHASE(EPI, lds, g, S, E) pg8::gemm_phase<EPI, pg8::StaticOrder, true, true>(lds, g, S, E)
#endif
struct Args {
    const float* in[28]; float* out; unsigned char* ws; int ph_lo, ph_hi;
};
enum { I_X = 0, I_POS, I_ATTN_NORM, I_W_IN, I_MU, I_DBASE, I_W_DEC, I_IBASE, I_W_ICLR, I_W_GATE, I_KK, I_KA, I_RK, I_LNXW, I_LNXB, I_W_ORWKV, I_QNORM, I_W_QUP,
       I_KVNORM, I_W_KVUP, I_W_OMLA, I_W_OUT, I_FFN_NORM, I_W_UP, I_CONVW, I_CONVB, I_W_DOWN, I_FINAL };

typedef const __attribute__((address_space(4))) Args* ArgsP;
__device__ __forceinline__ ArgsP args_ptr() { ArgsP p = (ArgsP)__builtin_amdgcn_kernarg_segment_ptr(); asm volatile("" : "+s"(p)); return p; }
__device__ __forceinline__ int ltid() { int t = vtid(); asm volatile("" : "+v"(t)); return t; }
constexpr int NWAVES = 8, NTHREADS = 512;
constexpr int RING_BYTES = 131072, MISC_OFF = RING_BYTES + 320, LDS_BYTES = 147456;

__device__ __forceinline__ void tr_item(const float* W, int N, int k0, int n0, bf16_t* dst, int mode, int roff, int ldk, int koff, const float* scale, LAS float* scr, int lane) {
    const int kq = lane >> 4, n4 = (lane & 15) * 4;
    f32x4 v[8];
#pragma unroll
    for (int i = 0; i < 8; ++i) v[i] = (n0 + n4 < N) ? *(const f32x4*)(W + (size_t)(k0 + kq + 4 * i) * N + n0 + n4) : (f32x4){0.f, 0.f, 0.f, 0.f};
#pragma unroll
    for (int i = 0; i < 8; ++i) { const int kk = kq + 4 * i; f32x4 x = v[i]; if (scale) x = x * scale[k0 + kk];
        LAS float* p = scr + kk * 65 + n4; p[0] = x.x; p[1] = x.y; p[2] = x.z; p[3] = x.w; }
    asm volatile("s_waitcnt lgkmcnt(0)" ::: "memory");
    const LAS float* s = scr + lane;
    const int n = n0 + lane;
    int drow = n;
    if (mode == 1) drow = n < 2208 ? n : n + 96;
    else if (mode == 2) { const int h = n / 96, j = n % 96; drow = j < 64 ? h * 64 + j : 512 + h * 32 + (j - 64); }
    else if (mode == 3) { const int h = n >> 7, j = n & 127; drow = j < 64 ? h * 64 + j : 512 + h * 64 + (j - 64); }
    else if (mode == 4) { const int v = n < FF ? n : n - FF; drow = (v >> 7) * 256 + (n < FF ? 0 : 128) + (v & 127); }
    bf16_t* d = dst + (size_t)(drow + roff) * ldk + koff + k0;
    if (n < N)
#pragma unroll
    for (int c = 0; c < 4; ++c) { u32x4 o; o.x = pk2(s[(8 * c + 0) * 65], s[(8 * c + 1) * 65]); o.y = pk2(s[(8 * c + 2) * 65], s[(8 * c + 3) * 65]); o.z = pk2(s[(8 * c + 4) * 65], s[(8 * c + 5) * 65]); o.w = pk2(s[(8 * c + 6) * 65], s[(8 * c + 7) * 65]);
        *(u32x4*)(d + 8 * c) = o; }
    asm volatile("s_waitcnt lgkmcnt(0)" ::: "memory");
}
__device__ __forceinline__ void phase_weights(ArgsP a, int l, LAS unsigned char* lds) {
    a = args_ptr();
    const int tid = ltid(), lane = tid & 63, wave = tid >> 6;
    const int gw = blockIdx.x * NWAVES + wave, NGW = gridDim.x * NWAVES;
    LAS float* scr = (LAS float*)(lds + wave * 16384);
    unsigned char* wb = a->ws + WS_W;
    bf16_t* Wt_in = (bf16_t*)(wb + W_IN); bf16_t* Wt_lora = (bf16_t*)(wb + W_LORA); bf16_t* Wt_q = (bf16_t*)(wb + W_Q); bf16_t* Wt_kv = (bf16_t*)(wb + W_KV);
    bf16_t* Wt_oa = (bf16_t*)(wb + W_OA); bf16_t* Wt_ob = (bf16_t*)(wb + W_OB); bf16_t* Wt_out = (bf16_t*)(wb + W_OUT); bf16_t* Wt_up = (bf16_t*)(wb + W_UP); bf16_t* Wt_down = (bf16_t*)(wb + W_DOWN);
    constexpr int I_IN = 32 * 67, I_DEC = 2 * 8, I_ICL = 2 * 8, I_GAT = 4 * 8, I_Q = 8 * 12, I_KV = 4 * 16, I_OA = 16 * 16, I_OB = 16 * 16, I_OUT = 32 * 16, I_UP = 32 * 88, I_DN = 88 * 16;
    constexpr int NITEMS = I_IN + I_DEC + I_ICL + I_GAT + I_Q + I_KV + I_OA + I_OB + I_OUT + I_UP + I_DN;
    for (int it = gw; it < NITEMS; it += NGW) {
        int r = it;
        const float* W; const float* scale = nullptr; bf16_t* dst; int N, kb, nb, mode = 0, roff = 0, ldk, koff = 0;
        if (r < I_IN) { kb = r / 67; nb = r % 67; W = a->in[I_W_IN] + (size_t)l * 1024 * IN_COLS; N = IN_COLS; dst = Wt_in; mode = 1; ldk = 1024; scale = a->in[I_ATTN_NORM] + l * 1024; }
        else if ((r -= I_IN) < I_DEC) { kb = r / 8; nb = r % 8; W = a->in[I_W_DEC] + (size_t)l * 64 * 512; N = 512; dst = Wt_lora; ldk = 256; }
        else if ((r -= I_DEC) < I_ICL) { kb = r / 8; nb = r % 8; W = a->in[I_W_ICLR] + (size_t)l * 64 * 512; N = 512; dst = Wt_lora; roff = 512; ldk = 256; koff = 64; }
        else if ((r -= I_ICL) < I_GAT) { kb = r / 8; nb = r % 8; W = a->in[I_W_GATE] + (size_t)l * 128 * 512; N = 512; dst = Wt_lora; roff = 1024; ldk = 256; koff = 128; }
        else if ((r -= I_GAT) < I_Q) { kb = r / 12; nb = r % 12; W = a->in[I_W_QUP] + (size_t)l * 256 * 768; N = 768; dst = Wt_q; mode = 2; ldk = 256; scale = a->in[I_QNORM] + l * 256; }
        else if ((r -= I_Q) < I_KV) { kb = r / 16; nb = r % 16; W = a->in[I_W_KVUP] + (size_t)l * 128 * 1024; N = 1024; dst = Wt_kv; mode = 3; ldk = 256; scale = a->in[I_KVNORM] + l * 128; }
        else if ((r -= I_KV) < I_OA) { kb = r / 16; nb = r % 16; W = a->in[I_W_ORWKV] + (size_t)l * 512 * 1024; N = 1024; dst = Wt_oa; ldk = 512; }
        else if ((r -= I_OA) < I_OB) { kb = r / 16; nb = r % 16; W = a->in[I_W_OMLA] + (size_t)l * 512 * 1024; N = 1024; dst = Wt_ob; ldk = 512; }
        else if ((r -= I_OB) < I_OUT) { kb = r / 16; nb = r % 16; W = a->in[I_W_OUT] + (size_t)l * 1024 * 1024; N = 1024; dst = Wt_out; ldk = 1024; }
        else if ((r -= I_OUT) < I_UP) { kb = r / 88; nb = r % 88; W = a->in[I_W_UP] + (size_t)l * 1024 * 2 * FF; N = 2 * FF; dst = Wt_up; mode = 4; ldk = 1024; scale = a->in[I_FFN_NORM] + l * 1024; }
        else { r -= I_UP; kb = r / 16; nb = r % 16; W = a->in[I_W_DOWN] + (size_t)l * FF * 1024; N = 1024; dst = Wt_down; ldk = FF; }
        tr_item(W, N, kb * 32, nb * 64, dst, mode, roff, ldk, koff, scale, scr, lane);
    }
    const int gt = blockIdx.x * NTHREADS + tid, NGT = gridDim.x * NTHREADS;
    unsigned z0_ = 0u; asm volatile("" : "+v"(z0_));
    const u32x4 z = (u32x4){z0_, z0_, z0_, z0_};
    for (int i = gt; i < 96 * 128; i += NGT) *(u32x4*)(Wt_in + (size_t)(2208 + i / 128) * 1024 + (i % 128) * 8) = z;
    for (int i = gt; i < 1536 * 32; i += NGT) { const int row = i / 32, k8 = (i % 32) * 8, kind = row >> 9; const bool live = kind == 0 ? (k8 < 64) : (kind == 1 ? (k8 >= 64 && k8 < 128) : (k8 >= 128)); if (!live) *(u32x4*)(Wt_lora + (size_t)row * 256 + k8) = z; }
    for (int i = gt; i < 1024 * 16; i += NGT) *(u32x4*)(Wt_kv + (size_t)(i / 16) * 256 + 128 + (i % 16) * 8) = z;
#ifdef SCRIBBLE
    if (l == 0) { u32x4* p = (u32x4*)(a->ws + WS_ACT); const u32x4 pz = (u32x4){0xAAAAAAAAu, 0xAAAAAAAAu, 0xAAAAAAAAu, 0xAAAAAAAAu};
        for (unsigned i = gt; i < 178u * 65536u; i += NGT) p[i] = pz; }
#endif
    if (l == 0) {
        float* SS0 = (float*)(a->ws + WS_SSP); bf16_t* HB = (bf16_t*)(a->ws + A_HB);
        for (int m = gw; m < M; m += NGW) {
            const f32x4* xr = (const f32x4*)(a->in[I_X] + (size_t)m * DM) + lane; float s = 0.f;
            u32x2* o = (u32x2*)(HB + (size_t)m * DM) + lane;
#pragma unroll
            for (int j = 0; j < 4; ++j) { const f32x4 v = xr[64 * j]; s += dot4(v, v); o[64 * j] = dn4(v); }
#pragma unroll
            for (int o2 = 1; o2 < 64; o2 <<= 1) s += shx(s, o2);
            if (lane < 16) SS0[(size_t)m * 16 + lane] = lane == 0 ? s : 0.f;
        }
        float* CS = (float*)(a->ws + WS_CS); const int* pos = (const int*)a->in[I_POS];
        for (int i = gt; i < M * 16; i += NGT) { const int row = i >> 4, f = i & 15;
            const float invf = exp2f(-0.830482023721841f * (float)f);
            const float ang = (float)pos[row] * invf;
            const float k = rintf(ang * 0.15915494309189535f);
            float rr = fmaf(-k, 6.2831854820251465f, ang); rr = fmaf(-k, -1.7484555314695172e-07f, rr);
            CS[(size_t)row * 32 + f] = cosf(rr); CS[(size_t)row * 32 + 16 + f] = sinf(rr); }
    }
}

__device__ __forceinline__ void phase_prep(ArgsP a, int l) {
    a = args_ptr();
    const unsigned gt = blockIdx.x * NTHREADS + ltid(), NGT = gridDim.x * NTHREADS;
    const bf16_t* LORAC = (const bf16_t*)(a->ws + A_LORAC); bf16_t* LIN = (bf16_t*)(a->ws + A_LIN);
    {
        const int j = (gt & 31) * 8; const float* mu = a->in[I_MU] + (size_t)l * 1792 + 1536 + j;
        const f32x4 m0 = *(const f32x4*)mu, m1 = *(const f32x4*)(mu + 4);
        for (unsigned i = gt; i < (unsigned)M * 32; i += NGT) { const unsigned row = i >> 5; const int t = row & 4095;
            const u32x4 cu = *(const u32x4*)(LORAC + (size_t)row * 256 + j); const u32x4 pv = t ? *(const u32x4*)(LORAC + (size_t)(row - 1) * 256 + j) : (u32x4){0u, 0u, 0u, 0u};
            const f32x4 c0 = up4((u32x2){cu.x, cu.y}), c1 = up4((u32x2){cu.z, cu.w}), q0 = up4((u32x2){pv.x, pv.y}), q1 = up4((u32x2){pv.z, pv.w});
            f32x4 s0 = c0 + (q0 - c0) * m0, s1 = c1 + (q1 - c1) * m1;
            if (j < 64) { for (int e = 0; e < 4; ++e) { s0[e] = tanhf(s0[e]); s1[e] = tanhf(s1[e]); } } else if (j >= 128) { for (int e = 0; e < 4; ++e) { s0[e] = sigm(s0[e]); s1[e] = sigm(s1[e]); } }
            const u32x2 o0 = dn4(s0), o1 = dn4(s1); *(u32x4*)(LIN + (size_t)row * 256 + j) = (u32x4){o0.x, o0.y, o1.x, o1.y}; }
    }
    const bf16_t* PMb = (const bf16_t*)(a->ws + A_PM); bf16_t* KPE = (bf16_t*)(a->ws + A_KPE); const float* CS = (const float*)(a->ws + WS_CS);
    for (unsigned i = gt; i < (unsigned)M * 4; i += NGT) { const unsigned row = i >> 2; const int f = (i & 3) * 4;
        const f32x4 x1 = up4(*(const u32x2*)(PMb + (size_t)row * 512 + 384 + f)), x2 = up4(*(const u32x2*)(PMb + (size_t)row * 512 + 400 + f));
        const f32x4 cs = *(const f32x4*)(CS + (size_t)row * 32 + f), sn = *(const f32x4*)(CS + (size_t)row * 32 + 16 + f);
        *(u32x2*)(KPE + (size_t)row * 32 + f) = dn4(x1 * cs - x2 * sn); *(u32x2*)(KPE + (size_t)row * 32 + 16 + f) = dn4(x1 * sn + x2 * cs); }
}

template <int CTRL> __device__ __forceinline__ float dppf(float x) { return __builtin_bit_cast(float, __builtin_amdgcn_update_dpp(0, __builtin_bit_cast(int, x), CTRL, 0xf, 0xf, false)); }
#if SHFL_SCAN
__device__ __forceinline__ float rr16(float x) { x += shx(x, 8); x += shx(x, 4); x += shx(x, 2); x += shx(x, 1); return x; }
#else
__device__ __forceinline__ float rr16(float x) { x += dppf<0x128>(x); x += dppf<0x124>(x); x += dppf<0x122>(x); x += dppf<0x121>(x); return x; }
#endif

typedef float f32x2 __attribute__((ext_vector_type(2)));
constexpr int SC_BUF = 43008, SC_R = 0, SC_W = 8192, SC_K = 16384, SC_A = 24576, SC_B = 32768, SC_V = 40960, SC_YP = 2 * SC_BUF, SC_YPB = 8192;
struct ScOps { f32x4 a, w, b, k, r; float v; };
__device__ __forceinline__ void sc_ld(ScOps& o, const LAS unsigned char* bp, const LAS unsigned char* vp, int t) {
    o.a = *(const LAS f32x4*)(bp + SC_A + t * 256); o.w = *(const LAS f32x4*)(bp + SC_W + t * 256); o.b = *(const LAS f32x4*)(bp + SC_B + t * 256);
    o.k = *(const LAS f32x4*)(bp + SC_K + t * 256); o.r = *(const LAS f32x4*)(bp + SC_R + t * 256); o.v = *(const LAS float*)(vp + t * 64);
}
__device__ __forceinline__ void scan_unit(ArgsP a, int l, int bh, int q4, LAS unsigned char* lds, size_t y_off = A_Y) {
    a = args_ptr();
    const int tid = ltid(), lane = tid & 63, wid = __builtin_amdgcn_readfirstlane(tid >> 6);
    const int b = bh >> 3, h = bh & 7, i0 = q4 * 16;
    const bf16_t* RKV = (const bf16_t*)(a->ws + A_RKV); const bf16_t* LW = (const bf16_t*)(a->ws + A_LW); const bf16_t* ICLR = (const bf16_t*)(a->ws + A_ICLR);
    bf16_t* Y = (bf16_t*)(a->ws + y_off); float* SCAL = (float*)(a->ws + WS_SCAL);
    constexpr int NCH = SEQ / 32;
    if (wid >= 4) {
        const int ht = tid - 256, pcg = ht & 15, tau0 = ht >> 4, ch = h * 64 + 4 * pcg;
        const float* mu = a->in[I_MU] + (size_t)l * 1792;
        const f32x4 mu_r = *(const f32x4*)(mu + ch), mu_k = *(const f32x4*)(mu + 512 + ch), mu_v = *(const f32x4*)(mu + 1024 + ch);
        const f32x4 kk_c = *(const f32x4*)(a->in[I_KK] + l * 512 + ch), ka_c = *(const f32x4*)(a->in[I_KA] + l * 512 + ch), rk_c = *(const f32x4*)(a->in[I_RK] + l * 512 + ch);
        u32x2 g[2][8];
        const u32x2 z2 = (u32x2){0u, 0u};
#define SC_LOAD(c) do { _Pragma("unroll") for (int k_ = 0; k_ < 2; ++k_) { const int t_ = (c) * 32 + tau0 + 16 * k_; const size_t row_ = (size_t)b * SEQ + t_; \
            g[k_][0] = *(const u32x2*)(RKV + row_ * 1536 + ch); g[k_][1] = *(const u32x2*)(RKV + row_ * 1536 + 512 + ch); g[k_][2] = *(const u32x2*)(RKV + row_ * 1536 + 1024 + ch); \
            if (t_) { g[k_][3] = *(const u32x2*)(RKV + (row_ - 1) * 1536 + ch); g[k_][4] = *(const u32x2*)(RKV + (row_ - 1) * 1536 + 512 + ch); g[k_][5] = *(const u32x2*)(RKV + (row_ - 1) * 1536 + 1024 + ch); } \
            else { g[k_][3] = z2; g[k_][4] = z2; g[k_][5] = z2; } \
            g[k_][6] = *(const u32x2*)(LW + row_ * 512 + ch); g[k_][7] = *(const u32x2*)(ICLR + row_ * 512 + ch); } } while (0)
#define SC_STORE(c, p) do { _Pragma("unroll") for (int k_ = 0; k_ < 2; ++k_) { const int tau_ = tau0 + 16 * k_; LAS unsigned char* base_ = lds + (p) * SC_BUF + tau_ * 256 + pcg * 16; \
            const f32x4 r2 = up4(g[k_][0]), k2 = up4(g[k_][1]), v2 = up4(g[k_][2]); \
            const f32x4 r = r2 + (up4(g[k_][3]) - r2) * mu_r, k = k2 + (up4(g[k_][4]) - k2) * mu_k, v = v2 + (up4(g[k_][5]) - v2) * mu_v; \
            const f32x4 lw = up4(g[k_][6]), ic = up4(g[k_][7]); \
            f32x4 kk = k * kk_c; float ssum = dot4(kk, kk); ssum += shx(ssum, 1); ssum += shx(ssum, 2); ssum += shx(ssum, 4); ssum += shx(ssum, 8); \
            kk = kk * rsqrtf(ssum + 1e-12f); \
            const f32x4 kp = k * (1.0f + (ic - 1.0f) * ka_c); \
            float sc = dot4(r * kp, rk_c); sc += shx(sc, 1); sc += shx(sc, 2); sc += shx(sc, 4); sc += shx(sc, 8); \
            if (q4 == 0 && pcg == 0) SCAL[((size_t)b * SEQ + (c) * 32 + tau_) * 8 + h] = sc; \
            f32x4 w; w.x = __expf(lw.x * CK_LWZ); w.y = __expf(lw.y * CK_LWZ); w.z = __expf(lw.z * CK_LWZ); w.w = __expf(lw.w * CK_LWZ); \
            *(LAS f32x4*)(base_ + SC_R) = r; *(LAS f32x4*)(base_ + SC_W) = w; *(LAS f32x4*)(base_ + SC_K) = kp; *(LAS f32x4*)(base_ + SC_A) = -kk * CK_AB; *(LAS f32x4*)(base_ + SC_B) = kk * ic * CK_AB; \
            if ((pcg >> 2) == q4) *(LAS f32x4*)(lds + (p) * SC_BUF + SC_V + tau_ * 64 + (pcg & 3) * 16) = v; } } while (0)
        SC_LOAD(0); SC_STORE(0, 0); SC_LOAD(1);
        __syncthreads();
        for (int c = 0; c < NCH; ++c) {
            if (c + 1 < NCH) { SC_STORE(c + 1, (c + 1) & 1); if (c + 2 < NCH) SC_LOAD(c + 2); }
            if (c > 0) {
                const LAS f32x4* yp = (const LAS f32x4*)(lds + SC_YP + ((c - 1) & 1) * SC_YPB + (ht >> 3) * 256 + (ht & 7) * 32);
                const f32x4 y0 = yp[0], y1 = yp[1];
                *(unsigned*)(Y + ((size_t)b * SEQ + (c - 1) * 32 + (ht >> 3)) * 512 + h * 64 + i0 + 2 * (ht & 7)) = pk2((y0.x + y0.y) + (y0.z + y0.w), (y1.x + y1.y) + (y1.z + y1.w));
            }
            __syncthreads();
        }
        { const int c = NCH;
          const LAS f32x4* yp = (const LAS f32x4*)(lds + SC_YP + ((c - 1) & 1) * SC_YPB + (ht >> 3) * 256 + (ht & 7) * 32);
          const f32x4 y0 = yp[0], y1 = yp[1];
          *(unsigned*)(Y + ((size_t)b * SEQ + (c - 1) * 32 + (ht >> 3)) * 512 + h * 64 + i0 + 2 * (ht & 7)) = pk2((y0.x + y0.y) + (y0.z + y0.w), (y1.x + y1.y) + (y1.z + y1.w)); }
#undef SC_LOAD
#undef SC_STORE
    } else {
        const int rloc = wid * 4 + (lane >> 4), cgp = lane & 15;
        __syncthreads();
        f32x2 s01 = (f32x2){0.f, 0.f}, s23 = s01;
        for (int c = 0; c < NCH; ++c) {
            const int p = c & 1;
            const LAS unsigned char* bp = lds + p * SC_BUF + cgp * 16;
            const LAS unsigned char* vp = lds + p * SC_BUF + SC_V + rloc * 4;
            LAS float* ypw = (LAS float*)(lds + SC_YP + p * SC_YPB) + rloc * 4 + cgp;
            ScOps oa, ob;
            sc_ld(oa, bp, vp, 0);
#define SC_STEP(cur, nxt, t) do { if ((t) + 1 < 32) sc_ld(nxt, bp, vp, (t) + 1); if (CK_NOSTATE && ((t) & 15) == 0) { s01 = (f32x2){0.f, 0.f}; s23 = s01; } \
                const f32x2 vk0 = (f32x2){cur.k.x, cur.k.y} * cur.v, vk1 = (f32x2){cur.k.z, cur.k.w} * cur.v; \
                const f32x2 t0 = s01 * (f32x2){cur.w.x, cur.w.y} + vk0, t1 = s23 * (f32x2){cur.w.z, cur.w.w} + vk1; \
                f32x2 pd = s01 * (f32x2){cur.a.x, cur.a.y}; pd = s23 * (f32x2){cur.a.z, cur.a.w} + pd; \
                const float d = rr16(pd.x + pd.y); \
                s01 = (f32x2){cur.b.x, cur.b.y} * d + t0; s23 = (f32x2){cur.b.z, cur.b.w} * d + t1; \
                f32x2 qd = s01 * (f32x2){cur.r.x, cur.r.y}; qd = s23 * (f32x2){cur.r.z, cur.r.w} + qd; \
                float y = qd.x + qd.y; y += dppf<0x128>(y); y += dppf<0x124>(y); \
                if (cgp < 4) ypw[(t) * 64] = y; } while (0)
#pragma unroll 1
            for (int t = 0; t < 32; t += 2) { SC_STEP(oa, ob, t); SC_STEP(ob, oa, t + 1); }
#undef SC_STEP
            __syncthreads();
        }
    }
    __syncthreads();
}

typedef short s16x4v __attribute__((ext_vector_type(4)));
constexpr int CK_ROW = 144;
constexpr int CK_AT = 0, CK_RT = 2304, CK_BT = 4608, CK_KT = 6912, CK_VT = 9216, CK_GL = 11520, CK_OPB = 11776, CK_NOP = 5;
constexpr int CK_MT0 = CK_NOP * CK_OPB, CK_MAK = 0, CK_MRB = 512, CK_MRK = 1024, CK_TT = 1536, CK_MAB = 2048, CK_MTB = 2048 + 16 * 80, CK_NMT = 4;
constexpr int CK_YT0 = CK_MT0 + CK_NMT * CK_MTB, CK_YTB = 1024;
typedef short v4i16_t __attribute__((ext_vector_type(4)));
__device__ __forceinline__ s16x4v ldtr(const LAS unsigned char* p) { return __builtin_bit_cast(s16x4v, __builtin_amdgcn_ds_read_tr16_b64_v4i16((LAS v4i16_t*)p)); }
__device__ __forceinline__ s16x4v pk4(f32x4 v) { const u32x2 p = dn4(v); return __builtin_bit_cast(s16x4v, p); }
__device__ __forceinline__ void scan_unit_chunked(ArgsP a, int l, int bh, int q4, LAS unsigned char* lds, size_t y_off = A_Y) {
    a = args_ptr();
    const int tid = ltid(), lane = tid & 63, wid = __builtin_amdgcn_readfirstlane(tid >> 6);
    const int b = bh >> 3, h = bh & 7, i0 = q4 * 16, q = lane >> 4, l15 = lane & 15;
    const bf16_t* RKV = (const bf16_t*)(a->ws + A_RKV); const bf16_t* EG = (const bf16_t*)(a->ws + A_LW); const bf16_t* ICLR = (const bf16_t*)(a->ws + A_ICLR);
    bf16_t* Y = (bf16_t*)(a->ws + y_off); float* SCAL = (float*)(a->ws + WS_SCAL);
    constexpr int NCH = SEQ / 16;
    const int ht = tid - 256, t_h = (ht >> 4) & 15, jg = ht & 15, ch = h * 64 + 4 * jg;
    f32x4 mu_r, mu_k, mu_v, kk_c, ka_c, rk_c;
    u32x2 g[10], g1[10], g2[10];
    if (wid >= 4) {
        const float* mu = a->in[I_MU] + (size_t)l * 1792;
        mu_r = *(const f32x4*)(mu + ch); mu_k = *(const f32x4*)(mu + 512 + ch); mu_v = *(const f32x4*)(mu + 1024 + ch);
        kk_c = *(const f32x4*)(a->in[I_KK] + l * 512 + ch); ka_c = *(const f32x4*)(a->in[I_KA] + l * 512 + ch); rk_c = *(const f32x4*)(a->in[I_RK] + l * 512 + ch);
    }
#define CK_LOAD(G_, c) do { const int t_ = (c) * 16 + t_h; const size_t row_ = (size_t)b * SEQ + t_; const size_t rp_ = t_ ? row_ - 1 : row_; \
        G_[0] = *(const u32x2*)(RKV + row_ * 1536 + ch); G_[1] = *(const u32x2*)(RKV + row_ * 1536 + 512 + ch); G_[2] = *(const u32x2*)(RKV + row_ * 1536 + 1024 + ch); \
        G_[3] = *(const u32x2*)(RKV + rp_ * 1536 + ch); G_[4] = *(const u32x2*)(RKV + rp_ * 1536 + 512 + ch); G_[5] = *(const u32x2*)(RKV + rp_ * 1536 + 1024 + ch); \
        G_[6] = *(const u32x2*)(ICLR + row_ * 512 + ch); G_[7] = *(const u32x2*)(EG + row_ * 512 + ch); \
        G_[8] = *(const u32x2*)(EG + (row_ - (t_h ? 1 : 0)) * 512 + ch); G_[9] = *(const u32x2*)(EG + ((size_t)b * SEQ + (c) * 16 + 15) * 512 + ch); } while (0)
    f32x4 accS[4];
#pragma unroll
    for (int jt = 0; jt < 4; ++jt) accS[jt] = (f32x4){0.f, 0.f, 0.f, 0.f};
    float x[16];
#pragma unroll
    for (int t_ = 0; t_ < 16; ++t_) x[t_] = 0.f;
#define CK_OPSTAGE(G_, it) do { \
            if (it < NCH) { \
                LAS unsigned char* op = lds + (it % CK_NOP) * CK_OPB; \
                const f32x4 r2 = up4(G_[0]), k2 = up4(G_[1]), v2 = up4(G_[2]); \
                const float pz_ = (it * 16 + t_h) ? 1.0f : 0.0f; \
                const f32x4 r = r2 + (up4(G_[3]) * pz_ - r2) * mu_r, k = k2 + (up4(G_[4]) * pz_ - k2) * mu_k, v = v2 + (up4(G_[5]) * pz_ - v2) * mu_v, ic = up4(G_[6]); \
                const f32x4 eG = up4(G_[7]), eGL = up4(G_[9]); \
                f32x4 eGx = up4(G_[8]); if (t_h == 0) eGx = (f32x4){1.f, 1.f, 1.f, 1.f}; \
                f32x4 enG; \
_Pragma("unroll") \
                for (int e = 0; e < 4; ++e) enG[e] = __builtin_amdgcn_rcpf(eG[e]); \
                f32x4 kk = k * kk_c; const float ssum = rr16(dot4(kk, kk)); \
                kk = kk * rsqrtf(ssum + 1e-12f); \
                const f32x4 kp = k * (1.0f + (ic - 1.0f) * ka_c), bb = kk * ic; \
                const float sc = rr16(dot4(r * kp, rk_c)); \
                if (q4 == 0 && jg == 0) SCAL[((size_t)b * SEQ + it * 16 + t_h) * 8 + h] = sc; \
                *(LAS u32x2*)(op + CK_AT + t_h * CK_ROW + jg * 8) = dn4(-(kk * eGx)); \
                *(LAS u32x2*)(op + CK_RT + t_h * CK_ROW + jg * 8) = dn4(r * eG); \
                *(LAS u32x2*)(op + CK_BT + t_h * CK_ROW + jg * 8) = dn4(bb * enG); \
                *(LAS u32x2*)(op + CK_KT + t_h * CK_ROW + jg * 8) = dn4(kp * enG); \
                *(LAS u32x2*)(op + CK_VT + t_h * CK_ROW + jg * 8) = dn4(v); \
                if (t_h == 0) *(LAS f32x4*)(op + CK_GL + jg * 16) = eGL; \
            } \
            if (it + 3 < NCH) CK_LOAD(G_, it + 3); \
        } while (0)
    if (wid >= 4) { CK_LOAD(g, 0); CK_LOAD(g1, 1); CK_LOAD(g2, 2); }
#ifdef CK_TIME
    unsigned long long tb_ = 0, t0_ = 0; const unsigned long long tstart_ = __builtin_readcyclecounter();
#define CK_T0() (t0_ = __builtin_readcyclecounter())
#define CK_T1() (tb_ += __builtin_readcyclecounter() - t0_)
#else
#define CK_T0() do {} while (0)
#define CK_T1() do {} while (0)
#endif
    constexpr int NIT = ((NCH + 6 + 2) / 3) * 3;
    if (wid >= 4) {
#define CK_YSTORE(it) do { if (wid == 4 && (it) >= 5 && (it) - 5 < NCH) { \
            const LAS float* yt = (const LAS float*)(lds + CK_YT0 + (((it) - 5) & 1) * CK_YTB); const int t_ = lane >> 2, ip = (lane & 3) * 4; \
            const f32x4 yv = *(const LAS f32x4*)(yt + t_ * 16 + ip); \
            *(u32x2*)(Y + ((size_t)b * SEQ + ((it) - 5) * 16 + t_) * 512 + h * 64 + i0 + ip) = dn4(yv); } } while (0)
        for (int it3 = 0; it3 < NIT; it3 += 3) {
            CK_T0(); CK_OPSTAGE(g, it3); CK_YSTORE(it3); CK_T1(); __syncthreads();
            CK_T0(); CK_OPSTAGE(g1, (it3 + 1)); CK_YSTORE((it3 + 1)); CK_T1(); __syncthreads();
            CK_T0(); CK_OPSTAGE(g2, (it3 + 2)); CK_YSTORE((it3 + 2)); CK_T1(); __syncthreads();
        }
#undef CK_YSTORE
    } else
    for (int it = 0; it < NIT; ++it) {
        CK_T0();
        if (wid >= 1) {
            const int ph3 = (it + 3 - wid) % 3;
            const int c = it - 1 - ph3;
            if (c >= 0 && c < NCH) {
                const LAS unsigned char* op = lds + (c % CK_NOP) * CK_OPB; LAS unsigned char* mt = lds + CK_MT0 + (c % CK_NMT) * CK_MTB;
                if (ph3 == 0) {
                    const int ro = l15 * CK_ROW + q * 16;
                    const bf16x8 at0 = *(const LAS bf16x8*)(op + CK_AT + ro), at1 = *(const LAS bf16x8*)(op + CK_AT + ro + 64), rt0 = *(const LAS bf16x8*)(op + CK_RT + ro), rt1 = *(const LAS bf16x8*)(op + CK_RT + ro + 64);
                    const bf16x8 bt0 = *(const LAS bf16x8*)(op + CK_BT + ro), bt1 = *(const LAS bf16x8*)(op + CK_BT + ro + 64), kt0 = *(const LAS bf16x8*)(op + CK_KT + ro), kt1 = *(const LAS bf16x8*)(op + CK_KT + ro + 64);
                    const f32x4 z = (f32x4){0.f, 0.f, 0.f, 0.f};
                    f32x4 mab = __builtin_amdgcn_mfma_f32_16x16x32_bf16(at0, bt0, z, 0, 0, 0); mab = __builtin_amdgcn_mfma_f32_16x16x32_bf16(at1, bt1, mab, 0, 0, 0);
                    f32x4 mak = __builtin_amdgcn_mfma_f32_16x16x32_bf16(at0, kt0, z, 0, 0, 0); mak = __builtin_amdgcn_mfma_f32_16x16x32_bf16(at1, kt1, mak, 0, 0, 0);
                    f32x4 mrb = __builtin_amdgcn_mfma_f32_16x16x32_bf16(rt0, bt0, z, 0, 0, 0); mrb = __builtin_amdgcn_mfma_f32_16x16x32_bf16(rt1, bt1, mrb, 0, 0, 0);
                    f32x4 mrk = __builtin_amdgcn_mfma_f32_16x16x32_bf16(rt0, kt0, z, 0, 0, 0); mrk = __builtin_amdgcn_mfma_f32_16x16x32_bf16(rt1, kt1, mrk, 0, 0, 0);
#pragma unroll
                    for (int r = 0; r < 4; ++r) { const int t_ = 4 * q + r; const bool lo_ = l15 < t_, le_ = l15 <= t_;
                        *(LAS float*)(mt + CK_MAB + t_ * 80 + l15 * 4) = lo_ ? mab[r] : 0.f;
                        *(LAS bf16_t*)(mt + CK_MAK + t_ * 32 + l15 * 2) = (bf16_t)f2bf(lo_ ? mak[r] : 0.f);
                        *(LAS bf16_t*)(mt + CK_MRB + t_ * 32 + l15 * 2) = (bf16_t)f2bf(le_ ? mrb[r] : 0.f);
                        *(LAS bf16_t*)(mt + CK_MRK + t_ * 32 + l15 * 2) = (bf16_t)f2bf(le_ ? mrk[r] : 0.f); }
                } else {
#define CK_MLD(t_) f32x4 m_##t_[4]; _Pragma("unroll") for (int s4 = 0; s4 < (t_); s4 += 4) m_##t_[s4 >> 2] = *(const LAS f32x4*)(mt + CK_MAB + (t_) * 80 + s4 * 4)
#define CK_TROW(t_) do { float acc_ = (l15 == (t_)) ? 1.f : 0.f; \
                        _Pragma("unroll") for (int s4 = 0; s4 < (t_); s4 += 4) { \
                            _Pragma("unroll") for (int e = 0; e < 4; ++e) if (s4 + e < (t_)) acc_ += m_##t_[s4 >> 2][e] * x[s4 + e]; } \
                        x[t_] = acc_; } while (0)
                    if (ph3 == 1) { CK_MLD(1); CK_MLD(2); CK_MLD(3); CK_MLD(4); CK_MLD(5); CK_MLD(6); CK_MLD(7); CK_MLD(8); CK_MLD(9); CK_MLD(10);
                        x[0] = (l15 == 0) ? 1.f : 0.f; CK_TROW(1); CK_TROW(2); CK_TROW(3); CK_TROW(4); CK_TROW(5); CK_TROW(6); CK_TROW(7); CK_TROW(8); CK_TROW(9); CK_TROW(10); }
                    else { CK_MLD(11); CK_MLD(12); CK_MLD(13); CK_MLD(14); CK_MLD(15); CK_TROW(11); CK_TROW(12); CK_TROW(13); CK_TROW(14); CK_TROW(15);
                        if (q == 0) {
#pragma unroll
                            for (int t_ = 0; t_ < 16; ++t_) *(LAS bf16_t*)(mt + CK_TT + t_ * 32 + l15 * 2) = (bf16_t)f2bf(x[t_]); } }
#undef CK_TROW
#undef CK_MLD
                }
            }
        } else {
            const int c = it - 4;
            if (c >= 0 && c < NCH) {
                const LAS unsigned char* op = lds + (c % CK_NOP) * CK_OPB; const LAS unsigned char* mt = lds + CK_MT0 + (c % CK_NMT) * CK_MTB;
                s16x4v sb[4];
#pragma unroll
                for (int jt = 0; jt < 4; ++jt) { if (CK_NOSTATE) accS[jt] = (f32x4){0.f, 0.f, 0.f, 0.f}; sb[jt] = pk4(accS[jt]); }
                const int ao = l15 * CK_ROW + q * 8;
                const int tro = (4 * q + (l15 >> 2)) * CK_ROW + (l15 & 3) * 8;
                const s16x4v vb = ldtr(op + CK_VT + tro + i0 * 2);
                f32x4 x1 = (f32x4){0.f, 0.f, 0.f, 0.f}, x2 = x1;
#pragma unroll
                for (int jt = 0; jt < 4; ++jt) {
                    const s16x4v a0 = *(const LAS s16x4v*)(op + CK_AT + ao + jt * 32), r0 = *(const LAS s16x4v*)(op + CK_RT + ao + jt * 32);
                    x1 = __builtin_amdgcn_mfma_f32_16x16x16bf16_1k(a0, sb[jt], x1, 0, 0, 0);
                    x2 = __builtin_amdgcn_mfma_f32_16x16x16bf16_1k(r0, sb[jt], x2, 0, 0, 0);
                }
                const s16x4v mak = *(const LAS s16x4v*)(mt + CK_MAK + l15 * 32 + q * 8), mrb = *(const LAS s16x4v*)(mt + CK_MRB + l15 * 32 + q * 8);
                const s16x4v mrk = *(const LAS s16x4v*)(mt + CK_MRK + l15 * 32 + q * 8), tt = *(const LAS s16x4v*)(mt + CK_TT + l15 * 32 + q * 8);
                x1 = __builtin_amdgcn_mfma_f32_16x16x16bf16_1k(mak, vb, x1, 0, 0, 0);
                x2 = __builtin_amdgcn_mfma_f32_16x16x16bf16_1k(mrk, vb, x2, 0, 0, 0);
                const f32x4 u = __builtin_amdgcn_mfma_f32_16x16x16bf16_1k(tt, pk4(x1), (f32x4){0.f, 0.f, 0.f, 0.f}, 0, 0, 0);
                const s16x4v ub = pk4(u);
                const f32x4 yv = __builtin_amdgcn_mfma_f32_16x16x16bf16_1k(mrb, ub, x2, 0, 0, 0);
                const bf16x8 uv = (bf16x8){ub[0], ub[1], ub[2], ub[3], vb[0], vb[1], vb[2], vb[3]};
#pragma unroll
                for (int jt = 0; jt < 4; ++jt) {
                    const f32x4 gl = *(const LAS f32x4*)(op + CK_GL + (16 * jt + 4 * q) * 4);
                    const s16x4v b0 = ldtr(op + CK_BT + tro + jt * 32), k0 = ldtr(op + CK_KT + tro + jt * 32);
                    accS[jt] = __builtin_amdgcn_mfma_f32_16x16x32_bf16((bf16x8){b0[0], b0[1], b0[2], b0[3], k0[0], k0[1], k0[2], k0[3]}, uv, accS[jt], 0, 0, 0) * gl;
                }
                LAS float* yt = (LAS float*)(lds + CK_YT0 + (c & 1) * CK_YTB);
#pragma unroll
                for (int r = 0; r < 4; ++r) yt[(4 * q + r) * 16 + l15] = yv[r];
            }
        }
        CK_T1();
        __syncthreads();
    }
#ifdef CK_TIME
    if (blockIdx.x == 0 && l == 0 && lane == 0) { unsigned long long* tw = (unsigned long long*)(a->ws + WS_CTL) + 24000; tw[wid] = tb_; if (wid == 0) tw[8] = __builtin_readcyclecounter() - tstart_; }
#endif
#undef CK_LOAD
#undef CK_OPSTAGE
}

constexpr int WP_SUB = 4 * 2304 + 1280;
constexpr int CW_WPFLAG = 65536;
constexpr int CW_YFLAG = 72000;
__device__ __forceinline__ void ST2W(bf16_t* p, unsigned v) { asm volatile("global_store_short %0, %1, off sc1\n\ts_nop 1" :: "v"(p), "v"(v) : "memory"); }
__device__ __forceinline__ void phase_wkvprep(ArgsP a, int l, LAS unsigned char* lds, int first, int stride) {
    a = args_ptr(); first = __builtin_amdgcn_readfirstlane(first); stride = __builtin_amdgcn_readfirstlane(stride); asm volatile("" : "+s"(first), "+s"(stride));
    const int tid = ltid(), lane = tid & 63, wid = __builtin_amdgcn_readfirstlane(tid >> 6), sub = tid >> 8, ht = tid & 255, t_h = ht >> 4, jg = ht & 15, q = lane >> 4, l15 = lane & 15;
    bf16_t* RKV = (bf16_t*)(a->ws + A_RKV); bf16_t* EG = (bf16_t*)(a->ws + A_LW); bf16_t* ICLR = (bf16_t*)(a->ws + A_ICLR); float* SCAL = (float*)(a->ws + WS_SCAL);
    const bf16_t* HALO = (const bf16_t*)((const unsigned char*)a->out + DO_HALO); unsigned char* MTR = (unsigned char*)a->out + DO_MTREC;
    const float* mu = a->in[I_MU] + (size_t)l * 1792;
    struct WpIn { u32x2 gr, gk, gv, pr, pk, pv, gic, ge, gex, gel; };
    WpIn SA[4], SB[4];
    auto trip_of = [](int q_) { return (q_ & 31) * 32 + (q_ >> 5); };
    auto load1 = [&](WpIn& R1, int tr, int ps) { { const int idx_ = 8 * tr + 2 * ps + sub, bh_ = idx_ >> 8, c_ = idx_ & 255, ch_ = (bh_ & 7) * 64 + 4 * jg, t_ = c_ * 16 + t_h; const size_t row_ = (size_t)(bh_ >> 3) * SEQ + t_; const u32x2 z2_ = (u32x2){0u, 0u};
            R1.gr = *(const u32x2*)(RKV + row_ * 1536 + ch_); R1.gk = *(const u32x2*)(RKV + row_ * 1536 + 512 + ch_); R1.gv = *(const u32x2*)(RKV + row_ * 1536 + 1024 + ch_);
            R1.pr = z2_; R1.pk = z2_; R1.pv = z2_;
            if (t_h) { R1.pr = *(const u32x2*)(RKV + (row_ - 1) * 1536 + ch_); R1.pk = *(const u32x2*)(RKV + (row_ - 1) * 1536 + 512 + ch_); R1.pv = *(const u32x2*)(RKV + (row_ - 1) * 1536 + 1024 + ch_); }
            else if (t_) { const bf16_t* hp_ = HALO + ((row_ >> 4) - 1) * 1536; R1.pr = *(const u32x2*)(hp_ + ch_); R1.pk = *(const u32x2*)(hp_ + 512 + ch_); R1.pv = *(const u32x2*)(hp_ + 1024 + ch_); }
            R1.gic = *(const u32x2*)(ICLR + row_ * 512 + ch_); R1.ge = *(const u32x2*)(EG + row_ * 512 + ch_); R1.gex = *(const u32x2*)(EG + (row_ - (t_h ? 1 : 0)) * 512 + ch_); R1.gel = *(const u32x2*)(EG + (row_ - t_h + 15) * 512 + ch_); }
    };
    auto loadt = [&](WpIn (&R)[4], int tr, int half_) {
        if (half_ != 1) { load1(R[0], tr, 0); load1(R[1], tr, 1); }
        if (half_ != 0) { load1(R[2], tr, 2); load1(R[3], tr, 3); }
    };
    auto body = [&](WpIn (&R)[4], WpIn (&N)[4], int tr, int trn) {
        u32x2 oa[4], orr[4], ob[4], ok[4], ov[4], ogl[4]; float scv[4];
#pragma unroll
        for (int ps = 0; ps < 4; ++ps) {
            const int idx = 8 * tr + 2 * ps + sub, ch = ((idx >> 8) & 7) * 64 + 4 * jg;
            const f32x4 mu_r = *(const f32x4*)(mu + ch), mu_k = *(const f32x4*)(mu + 512 + ch), mu_v = *(const f32x4*)(mu + 1024 + ch);
            const f32x4 kk_c = *(const f32x4*)(a->in[I_KK] + l * 512 + ch), ka_c = *(const f32x4*)(a->in[I_KA] + l * 512 + ch), rk_c = *(const f32x4*)(a->in[I_RK] + l * 512 + ch);
            const f32x4 r2 = up4(R[ps].gr), k2 = up4(R[ps].gk), v2 = up4(R[ps].gv);
            const f32x4 r = r2 + (up4(R[ps].pr) - r2) * mu_r, k = k2 + (up4(R[ps].pk) - k2) * mu_k, v = v2 + (up4(R[ps].pv) - v2) * mu_v, ic = up4(R[ps].gic);
            const f32x4 eG = up4(R[ps].ge);
            f32x4 eGx = up4(R[ps].gex); if (t_h == 0) eGx = (f32x4){1.f, 1.f, 1.f, 1.f};
            f32x4 enG;
#pragma unroll
            for (int e = 0; e < 4; ++e) enG[e] = __builtin_amdgcn_rcpf(eG[e]);
            f32x4 kk = k * kk_c; const float ssum = rr16(dot4(kk, kk));
            kk = kk * rsqrtf(ssum + 1e-12f);
            const f32x4 kp = k * (1.0f + (ic - 1.0f) * ka_c), bb = kk * ic;
            scv[ps] = rr16(dot4(r * kp, rk_c));
            oa[ps] = dn4(-(kk * eGx)); orr[ps] = dn4(r * eG); ob[ps] = dn4(bb * enG); ok[ps] = dn4(kp * enG); ov[ps] = dn4(v); ogl[ps] = R[ps].gel;
            asm volatile("" ::: "memory");
        }
        __syncthreads();
        loadt(N, trn >= 0 ? trn : tr, 0);
#pragma unroll
        for (int ps = 0; ps < 4; ++ps) {
            const int idx = 8 * tr + 2 * ps + sub, bh = idx >> 8, c = idx & 255, b = bh >> 3, h = bh & 7, ch = h * 64 + 4 * jg;
            const size_t row = (size_t)b * SEQ + c * 16 + t_h;
            LAS unsigned char* op = lds + (2 * ps + sub) * WP_SUB;
            *(LAS u32x2*)(op + CK_AT + t_h * CK_ROW + jg * 8) = oa[ps]; *(LAS u32x2*)(op + CK_RT + t_h * CK_ROW + jg * 8) = orr[ps];
            *(LAS u32x2*)(op + CK_BT + t_h * CK_ROW + jg * 8) = ob[ps]; *(LAS u32x2*)(op + CK_KT + t_h * CK_ROW + jg * 8) = ok[ps];
            pg8::ST8W(RKV + row * 1536 + ch, oa[ps]); pg8::ST8W(RKV + row * 1536 + 512 + ch, orr[ps]); pg8::ST8W(RKV + row * 1536 + 1024 + ch, ov[ps]);
            pg8::ST8W(EG + row * 512 + ch, ob[ps]); pg8::ST8W(ICLR + row * 512 + ch, ok[ps]);
            if (jg == 0) __hip_atomic_store(SCAL + row * 8 + h, scv[ps], __ATOMIC_RELAXED, __HIP_MEMORY_SCOPE_AGENT);
            if (t_h == 0) { const f32x4 eGL = up4(ogl[ps]); pg8::ST16W((bf16_t*)(MTR + (size_t)idx * MTREC_B + 2048 + jg * 16), __builtin_bit_cast(u32x4, eGL)); }
        }
        __syncthreads();
    };
    unsigned* wpflag = (unsigned*)(a->ws + WS_CTL) + CW_WPFLAG + l * 1024;
    auto stepB = [&](int tr) {
        {
            const int idx = 8 * tr + wid;
            const LAS unsigned char* op = lds + wid * WP_SUB; LAS unsigned char* mt = lds + wid * WP_SUB + 4 * 2304;
            const int ro = l15 * CK_ROW + q * 16;
            const bf16x8 at0 = *(const LAS bf16x8*)(op + CK_AT + ro), at1 = *(const LAS bf16x8*)(op + CK_AT + ro + 64), rt0 = *(const LAS bf16x8*)(op + CK_RT + ro), rt1 = *(const LAS bf16x8*)(op + CK_RT + ro + 64);
            const bf16x8 bt0 = *(const LAS bf16x8*)(op + CK_BT + ro), bt1 = *(const LAS bf16x8*)(op + CK_BT + ro + 64), kt0 = *(const LAS bf16x8*)(op + CK_KT + ro), kt1 = *(const LAS bf16x8*)(op + CK_KT + ro + 64);
            const f32x4 z = (f32x4){0.f, 0.f, 0.f, 0.f};
            f32x4 mab = __builtin_amdgcn_mfma_f32_16x16x32_bf16(at0, bt0, z, 0, 0, 0); mab = __builtin_amdgcn_mfma_f32_16x16x32_bf16(at1, bt1, mab, 0, 0, 0);
            f32x4 mak = __builtin_amdgcn_mfma_f32_16x16x32_bf16(at0, kt0, z, 0, 0, 0); mak = __builtin_amdgcn_mfma_f32_16x16x32_bf16(at1, kt1, mak, 0, 0, 0);
            f32x4 mrb = __builtin_amdgcn_mfma_f32_16x16x32_bf16(rt0, bt0, z, 0, 0, 0); mrb = __builtin_amdgcn_mfma_f32_16x16x32_bf16(rt1, bt1, mrb, 0, 0, 0);
            f32x4 mrk = __builtin_amdgcn_mfma_f32_16x16x32_bf16(rt0, kt0, z, 0, 0, 0); mrk = __builtin_amdgcn_mfma_f32_16x16x32_bf16(rt1, kt1, mrk, 0, 0, 0);
            bf16_t* rec = (bf16_t*)(MTR + (size_t)idx * MTREC_B);
            LAS bf16_t* stg = (LAS bf16_t*)(lds + wid * WP_SUB);
            asm volatile("s_waitcnt lgkmcnt(0)" ::: "memory");
#pragma unroll
            for (int rr = 0; rr < 4; ++rr) { const int t_ = 4 * q + rr; const bool lo_ = l15 < t_, le_ = l15 <= t_;
                *(LAS float*)(mt + t_ * 80 + l15 * 4) = lo_ ? mab[rr] : 0.f;
                stg[t_ * 16 + l15] = (bf16_t)f2bf(lo_ ? mak[rr] : 0.f);
                stg[256 + t_ * 16 + l15] = (bf16_t)f2bf(le_ ? mrb[rr] : 0.f);
                stg[512 + t_ * 16 + l15] = (bf16_t)f2bf(le_ ? mrk[rr] : 0.f); }
            asm volatile("s_waitcnt lgkmcnt(0)" ::: "memory");
            float x[16];
#define WP_MLD(t_) f32x4 m_##t_[4]; _Pragma("unroll") for (int s4 = 0; s4 < (t_); s4 += 4) m_##t_[s4 >> 2] = *(const LAS f32x4*)(mt + (t_) * 80 + s4 * 4)
#define WP_TROW(t_) do { float acc_ = (l15 == (t_)) ? 1.f : 0.f; \
                _Pragma("unroll") for (int s4 = 0; s4 < (t_); s4 += 4) { _Pragma("unroll") for (int e = 0; e < 4; ++e) if (s4 + e < (t_)) acc_ += m_##t_[s4 >> 2][e] * x[s4 + e]; } \
                x[t_] = acc_; } while (0)
            x[0] = (l15 == 0) ? 1.f : 0.f;
            { WP_MLD(1); WP_MLD(2); WP_MLD(3); WP_MLD(4); WP_MLD(5); WP_MLD(6); WP_MLD(7); WP_TROW(1); WP_TROW(2); WP_TROW(3); WP_TROW(4); WP_TROW(5); WP_TROW(6); WP_TROW(7); }
            { WP_MLD(8); WP_MLD(9); WP_MLD(10); WP_MLD(11); WP_TROW(8); WP_TROW(9); WP_TROW(10); WP_TROW(11); }
            { WP_MLD(12); WP_MLD(13); WP_MLD(14); WP_MLD(15); WP_TROW(12); WP_TROW(13); WP_TROW(14); WP_TROW(15); }
#undef WP_TROW
#undef WP_MLD
            if (q == 0) {
#pragma unroll
                for (int t_ = 0; t_ < 16; ++t_) stg[768 + t_ * 16 + l15] = (bf16_t)f2bf(x[t_]); }
            asm volatile("s_waitcnt lgkmcnt(0)" ::: "memory");
            pg8::ST16W(rec + lane * 8, *(const LAS u32x4*)((const LAS unsigned char*)stg + lane * 16));
            pg8::ST16W(rec + 512 + lane * 8, *(const LAS u32x4*)((const LAS unsigned char*)stg + 1024 + lane * 16));
        }
        asm volatile("s_waitcnt vmcnt(0)" ::: "memory");
        __syncthreads();
        if (tid == 0) __hip_atomic_store(wpflag + tr, 1u, __ATOMIC_RELAXED, __HIP_MEMORY_SCOPE_AGENT);
    };
    if (first < 1024) loadt(SA, trip_of(first), 2);
#pragma unroll 1
    for (int qq = first; qq < 1024; qq += 2 * stride) {
        const int q1 = qq + stride, q2 = q1 + stride;
        const int tr0 = trip_of(qq), tr1 = q1 < 1024 ? trip_of(q1) : -1, tr2 = q2 < 1024 ? trip_of(q2) : -1;
        body(SA, SB, tr0, tr1); stepB(tr0);
        if (tr1 < 0) break;
        loadt(SB, tr1, 1);
        body(SB, SA, tr1, tr2); stepB(tr1);
        loadt(SA, tr2 >= 0 ? tr2 : tr1, 1);
    }
}

constexpr int WS_SLOT = 5 * 2048 + 3 * 1024, WS_NSLOT = 8, WS_DEPTH = 7, WS_YT = WS_NSLOT * WS_SLOT;
__device__ __forceinline__ void glds16(const void* gsrc, unsigned lds_dst) { unsigned keep;
    asm volatile("s_mov_b32 %0, m0\n\ts_mov_b32 m0, %2\n\ts_nop 0\n\tglobal_load_lds_dwordx4 %1, off\n\ts_mov_b32 m0, %0" : "=&s"(keep) : "v"(gsrc), "s"(lds_dst) : "memory"); }
__device__ __forceinline__ void scan_unit_stream(ArgsP a, int l, int bh, LAS unsigned char* lds) {
    a = args_ptr();
    const int tid = ltid(), lane = tid & 63, wid = __builtin_amdgcn_readfirstlane(tid >> 6), q = lane >> 4, l15 = lane & 15;
    const int b = bh >> 3, h = bh & 7;
    const unsigned char* RKVb = a->ws + A_RKV; const unsigned char* EGb = a->ws + A_LW; const unsigned char* ICb = a->ws + A_ICLR;
    const unsigned char* MTR = (const unsigned char*)a->out + DO_MTREC + (size_t)bh * 256 * MTREC_B;
    bf16_t* Y = (bf16_t*)(a->ws + A_Y);
    unsigned* yflag = (unsigned*)(a->ws + WS_CTL) + CW_YFLAG + l * 1024 + bh * 32;
    constexpr int NCH = SEQ / 16;
    const unsigned lds0 = (unsigned)(uintptr_t)lds;
    if (wid >= 4) {
        const int w = wid - 4, rw = lane >> 3, c16 = ((lane & 7) ^ rw) * 16;
        const int np = (w == 0) ? 4 : 3;
#define WS_ISSUE(cc) do { const size_t row0_ = (size_t)b * SEQ + (size_t)(cc) * 16; const unsigned slot_ = lds0 + (unsigned)(((cc) % WS_NSLOT) * WS_SLOT); \
            _Pragma("unroll") for (int k_ = 0; k_ < 4; ++k_) { const int p_ = w + 4 * k_; if (p_ < 13) { const void* src_; \
                if (p_ < 10) { const int tl_ = p_ >> 1; const size_t r_ = row0_ + 8 * (p_ & 1) + rw; \
                    src_ = tl_ < 3 ? (const void*)(RKVb + (r_ * 1536 + tl_ * 512 + h * 64) * 2 + c16) : (tl_ == 3 ? (const void*)(EGb + (r_ * 512 + h * 64) * 2 + c16) : (const void*)(ICb + (r_ * 512 + h * 64) * 2 + c16)); } \
                else src_ = (const void*)(MTR + (size_t)(cc) * MTREC_B + (p_ - 10) * 1024 + lane * 16); \
                glds16(src_, (unsigned)__builtin_amdgcn_readfirstlane(slot_ + (unsigned)(p_ < 10 ? (p_ >> 1) * 2048 + (p_ & 1) * 1024 : 10240 + (p_ - 10) * 1024))); } } } while (0)
        unsigned* wpflag = (unsigned*)(a->ws + WS_CTL) + CW_WPFLAG + l * 1024 + bh * 32;
        unsigned* tmo = (unsigned*)(a->ws + WS_CTL) + CW_BAR + XB_TMO;
#define WS_GATE(cc) do { if (((cc) & 7) == 0) { unsigned sp_ = 0; \
            while ((unsigned)__builtin_amdgcn_readfirstlane(__hip_atomic_load(wpflag + ((cc) >> 3), __ATOMIC_RELAXED, __HIP_MEMORY_SCOPE_AGENT)) == 0u) { __builtin_amdgcn_s_sleep(2); \
                if ((++sp_ & 255u) == 0u) { if (xb_ld(tmo)) break; if (sp_ > XB_SPIN_CAP) { atomicAdd(tmo, 1u); break; } } } \
            __builtin_amdgcn_fence(__ATOMIC_ACQUIRE, "agent"); } } while (0)
        WS_GATE(0);
#pragma unroll
        for (int cc = 0; cc < WS_DEPTH; ++cc) WS_ISSUE(cc);
        if (w == 0) asm volatile("s_waitcnt vmcnt(24)" ::: "memory"); else asm volatile("s_waitcnt vmcnt(18)" ::: "memory");
        __syncthreads();
        for (int it = 0; it < NCH; ++it) {
            if (it + WS_DEPTH < NCH) { WS_GATE(it + WS_DEPTH); WS_ISSUE(it + WS_DEPTH); if (w == 0) asm volatile("s_waitcnt vmcnt(24)" ::: "memory"); else asm volatile("s_waitcnt vmcnt(18)" ::: "memory"); }
            else asm volatile("s_waitcnt vmcnt(0)" ::: "memory");
            __syncthreads();
        }
#undef WS_ISSUE
#undef WS_GATE
        (void)np;
    } else {
        f32x4 accS[4];
#pragma unroll
        for (int jt = 0; jt < 4; ++jt) accS[jt] = (f32x4){0.f, 0.f, 0.f, 0.f};
        __syncthreads();
        for (int it = 0; it < NCH; ++it) {
            const LAS unsigned char* op = lds + (it % WS_NSLOT) * WS_SLOT; const LAS unsigned char* mt = op + 10240;
            s16x4v sb[4];
#pragma unroll
            for (int jt = 0; jt < 4; ++jt) sb[jt] = pk4(accS[jt]);
#define WS_SW(row, p8) ((row) * 128 + ((((p8) >> 1) ^ ((row) & 7)) << 4) + ((p8) & 1) * 8)
            const int trow = 4 * q + (l15 >> 2);
            const s16x4v vb = ldtr(op + 4096 + WS_SW(trow, (l15 & 3) + 4 * wid));
            f32x4 x1 = (f32x4){0.f, 0.f, 0.f, 0.f}, x2 = x1;
#pragma unroll
            for (int jt = 0; jt < 4; ++jt) {
                const s16x4v a0 = *(const LAS s16x4v*)(op + 0 + WS_SW(l15, q + 4 * jt)), r0 = *(const LAS s16x4v*)(op + 2048 + WS_SW(l15, q + 4 * jt));
                x1 = __builtin_amdgcn_mfma_f32_16x16x16bf16_1k(a0, sb[jt], x1, 0, 0, 0);
                x2 = __builtin_amdgcn_mfma_f32_16x16x16bf16_1k(r0, sb[jt], x2, 0, 0, 0);
            }
            const s16x4v mak = *(const LAS s16x4v*)(mt + 0 + l15 * 32 + q * 8), mrb = *(const LAS s16x4v*)(mt + 512 + l15 * 32 + q * 8);
            const s16x4v mrk = *(const LAS s16x4v*)(mt + 1024 + l15 * 32 + q * 8), tt = *(const LAS s16x4v*)(mt + 1536 + l15 * 32 + q * 8);
            x1 = __builtin_amdgcn_mfma_f32_16x16x16bf16_1k(mak, vb, x1, 0, 0, 0);
            x2 = __builtin_amdgcn_mfma_f32_16x16x16bf16_1k(mrk, vb, x2, 0, 0, 0);
            const f32x4 u = __builtin_amdgcn_mfma_f32_16x16x16bf16_1k(tt, pk4(x1), (f32x4){0.f, 0.f, 0.f, 0.f}, 0, 0, 0);
            const s16x4v ub = pk4(u);
            const f32x4 yv = __builtin_amdgcn_mfma_f32_16x16x16bf16_1k(mrb, ub, x2, 0, 0, 0);
            const bf16x8 uv = (bf16x8){ub[0], ub[1], ub[2], ub[3], vb[0], vb[1], vb[2], vb[3]};
#pragma unroll
            for (int jt = 0; jt < 4; ++jt) {
                const f32x4 gl = *(const LAS f32x4*)(mt + 2048 + (16 * jt + 4 * q) * 4);
                const s16x4v b0 = ldtr(op + 6144 + WS_SW(trow, (l15 & 3) + 4 * jt)), k0 = ldtr(op + 8192 + WS_SW(trow, (l15 & 3) + 4 * jt));
                accS[jt] = __builtin_amdgcn_mfma_f32_16x16x32_bf16((bf16x8){b0[0], b0[1], b0[2], b0[3], k0[0], k0[1], k0[2], k0[3]}, uv, accS[jt], 0, 0, 0) * gl;
            }
            LAS float* yt = (LAS float*)(lds + WS_YT + wid * 1024);
#pragma unroll
            for (int rr = 0; rr < 4; ++rr) yt[(4 * q + rr) * 16 + l15] = yv[rr];
            asm volatile("s_waitcnt lgkmcnt(0)" ::: "memory");
            { const int t_ = lane >> 2, ip = (lane & 3) * 4; const f32x4 yr = *(const LAS f32x4*)(yt + t_ * 16 + ip);
              pg8::ST8W(Y + ((size_t)b * SEQ + it * 16 + t_) * 512 + h * 64 + 16 * wid + ip, dn4(yr)); }
            const bool pub_ = ((it & 7) == 7) && it >= 15;
            if (pub_) asm volatile("s_waitcnt vmcnt(8)" ::: "memory");
            __syncthreads();
            if (pub_ && tid == 0) __hip_atomic_store(yflag + ((it - 15) >> 3), 1u, __ATOMIC_RELAXED, __HIP_MEMORY_SCOPE_AGENT);
        }
        asm volatile("s_waitcnt vmcnt(0)" ::: "memory");
#undef WS_SW
    }
    __syncthreads();
    if (tid == 0) __hip_atomic_store(yflag + 31, 1u, __ATOMIC_RELAXED, __HIP_MEMORY_SCOPE_AGENT);
}

__device__ __forceinline__ int crow(int r, int hi) { return (r & 3) + 8 * (r >> 2) + 4 * hi; }
constexpr int AT_KROW = 208, AT_VROW = 136, AT_KBUF = 64 * AT_KROW, AT_VBUF = 64 * AT_VROW, AT_V0 = 2 * AT_KBUF;
__device__ __forceinline__ void attn_unit(ArgsP a, int bh, int qb, LAS unsigned char* lds, size_t o_off = A_QN) {
    a = args_ptr();
    const int tid = ltid(), lane = tid & 63, wid = tid >> 6, r32 = lane & 31, hi = lane >> 5;
    const int b = bh >> 3, h = bh & 7, q0 = qb * 256, qw0 = q0 + wid * 32;
    const size_t rowb = (size_t)b * SEQ;
    const bf16_t* Qn = (const bf16_t*)(a->ws + A_QN); const bf16_t* Qp = (const bf16_t*)(a->ws + A_QP); const bf16_t* Kn = (const bf16_t*)(a->ws + A_KN);
    const bf16_t* KPE = (const bf16_t*)(a->ws + A_KPE); const bf16_t* Vt = (const bf16_t*)(a->ws + A_VT); bf16_t* O = (bf16_t*)(a->ws + o_off);
    bf16x8 qf[6];
    { const size_t qrow = rowb + qw0 + r32;
#pragma unroll
      for (int ds = 0; ds < 4; ++ds) qf[ds] = *(const bf16x8*)(Qn + qrow * 512 + h * 64 + ds * 16 + hi * 8);
#pragma unroll
      for (int ds = 0; ds < 2; ++ds) qf[4 + ds] = *(const bf16x8*)(Qp + qrow * 256 + h * 32 + ds * 16 + hi * 8); }
    const int NT = 4 * qb + 4;
    const bf16_t* ksrc = Kn + (rowb + (tid >> 3)) * 512 + h * 64 + (tid & 7) * 8;
    const bf16_t* psrc = KPE + (rowb + ((tid & 255) >> 2)) * 32 + (tid & 3) * 8;
    const bf16_t* vsrc = Vt + ((size_t)(bh * 64 + (tid >> 3)) << 12) + (tid & 7) * 8;
    const int kdst = (tid >> 3) * AT_KROW + (tid & 7) * 16, pdst = ((tid & 255) >> 2) * AT_KROW + 128 + (tid & 3) * 16, vdst = AT_V0 + (tid >> 3) * AT_VROW + (tid & 7) * 16;
    u32x4 rk0, rp0 = (u32x4){0u, 0u, 0u, 0u}, rv0, rk1, rp1 = rp0, rv1;
#define AT_LOAD(S, tt) do { rk##S = *(const u32x4*)(ksrc + (size_t)(tt) * 64 * 512); if (tid < 256) rp##S = *(const u32x4*)(psrc + (size_t)(tt) * 64 * 32); rv##S = *(const u32x4*)(vsrc + (tt) * 64); } while (0)
#define AT_WRITE(S, p) do { *(LAS u32x4*)(lds + (p) * AT_KBUF + kdst) = rk##S; if (tid < 256) *(LAS u32x4*)(lds + (p) * AT_KBUF + pdst) = rp##S; \
        *(LAS u32x2*)(lds + (p) * AT_VBUF + vdst) = (u32x2){rv##S.x, rv##S.y}; *(LAS u32x2*)(lds + (p) * AT_VBUF + vdst + 8) = (u32x2){rv##S.z, rv##S.w}; } while (0)
    AT_LOAD(0, 0); AT_WRITE(0, 0); AT_LOAD(0, 1);
    __syncthreads();
    float mrun = -INFINITY, lrun = 0.f;
    f32x16 o0, o1;
#pragma unroll
    for (int r = 0; r < 16; ++r) { o0[r] = 0.f; o1[r] = 0.f; }
    for (int t2 = 0; t2 < NT; t2 += 2)
#pragma unroll
    for (int tp = 0; tp < 2; ++tp) {
        const int t = t2 + tp, cur = tp;
        if (t + 2 < NT) { if (tp == 0) AT_LOAD(1, t + 2); else AT_LOAD(0, t + 2); }
        if (64 * t <= qw0 + 31) {
            const LAS unsigned char* Kb = lds + cur * AT_KBUF + r32 * AT_KROW + hi * 16;
            f32x16 p0, p1;
#pragma unroll
            for (int r = 0; r < 16; ++r) { p0[r] = 0.f; p1[r] = 0.f; }
#pragma unroll
            for (int ds = 0; ds < 6; ++ds) {
                const bf16x8 k0 = *(const LAS bf16x8*)(Kb + ds * 32), k1 = *(const LAS bf16x8*)(Kb + 32 * AT_KROW + ds * 32);
                p0 = __builtin_amdgcn_mfma_f32_32x32x16_bf16(k0, qf[ds], p0, 0, 0, 0);
                p1 = __builtin_amdgcn_mfma_f32_32x32x16_bf16(k1, qf[ds], p1, 0, 0, 0);
            }
            if (64 * t + 63 > qw0) {
                const int q = qw0 + r32;
#pragma unroll
                for (int r = 0; r < 16; ++r) { const int kv = 64 * t + crow(r, hi); if (kv > q) p0[r] = -INFINITY; if (kv + 32 > q) p1[r] = -INFINITY; }
            }
            float mx = fmaxf(p0[0], p1[0]);
#pragma unroll
            for (int r = 1; r < 16; ++r) mx = fmaxf(mx, fmaxf(p0[r], p1[r]));
            mx = fmaxf(mx, shx(mx, 32));
            const float mnew = fmaxf(mrun, mx), alpha = __builtin_amdgcn_exp2f(mrun - mnew);
            mrun = mnew;
            float ps = 0.f;
#pragma unroll
            for (int r = 0; r < 16; ++r) { p0[r] = __builtin_amdgcn_exp2f(p0[r] - mnew); p1[r] = __builtin_amdgcn_exp2f(p1[r] - mnew); ps += p0[r] + p1[r]; }
            lrun = lrun * alpha + ps;
#pragma unroll
            for (int r = 0; r < 16; ++r) { o0[r] *= alpha; o1[r] *= alpha; }
            bf16x8 pf[4];
#pragma unroll
            for (int ks = 0; ks < 4; ++ks) {
                u32x4 w;
                if (ks < 2) { w.x = pk2(p0[8 * ks + 0], p0[8 * ks + 1]); w.y = pk2(p0[8 * ks + 2], p0[8 * ks + 3]); w.z = pk2(p0[8 * ks + 4], p0[8 * ks + 5]); w.w = pk2(p0[8 * ks + 6], p0[8 * ks + 7]); }
                else { const int k2 = ks - 2; w.x = pk2(p1[8 * k2 + 0], p1[8 * k2 + 1]); w.y = pk2(p1[8 * k2 + 2], p1[8 * k2 + 3]); w.z = pk2(p1[8 * k2 + 4], p1[8 * k2 + 5]); w.w = pk2(p1[8 * k2 + 6], p1[8 * k2 + 7]); }
                pf[ks] = __builtin_bit_cast(bf16x8, w);
            }
            const LAS unsigned char* Vb = lds + AT_V0 + cur * AT_VBUF + r32 * AT_VROW + hi * 8;
#pragma unroll
            for (int ks = 0; ks < 4; ++ks) {
                const s16x4 a0 = *(const LAS s16x4*)(Vb + ks * 32), a1 = *(const LAS s16x4*)(Vb + ks * 32 + 16);
                const s16x4 c0 = *(const LAS s16x4*)(Vb + 32 * AT_VROW + ks * 32), c1 = *(const LAS s16x4*)(Vb + 32 * AT_VROW + ks * 32 + 16);
                const bf16x8 vf0 = (bf16x8){a0[0], a0[1], a0[2], a0[3], a1[0], a1[1], a1[2], a1[3]}, vf1 = (bf16x8){c0[0], c0[1], c0[2], c0[3], c1[0], c1[1], c1[2], c1[3]};
                o0 = __builtin_amdgcn_mfma_f32_32x32x16_bf16(vf0, pf[ks], o0, 0, 0, 0);
                o1 = __builtin_amdgcn_mfma_f32_32x32x16_bf16(vf1, pf[ks], o1, 0, 0, 0);
            }
        }
        if (t + 1 < NT) { if (tp == 0) AT_WRITE(0, 1); else AT_WRITE(1, 0); }
        __syncthreads();
    }
#undef AT_WRITE
#undef AT_LOAD
    const float ltot = lrun + shx(lrun, 32), inv = 1.0f / ltot;
    bf16_t* orow = O + (rowb + qw0 + r32) * 512 + h * 64 + 4 * hi;
#pragma unroll
    for (int g = 0; g < 4; ++g) {
        *(u32x2*)(orow + 8 * g) = (u32x2){pk2(o0[4 * g] * inv, o0[4 * g + 1] * inv), pk2(o0[4 * g + 2] * inv, o0[4 * g + 3] * inv)};
        *(u32x2*)(orow + 32 + 8 * g) = (u32x2){pk2(o1[4 * g] * inv, o1[4 * g + 1] * inv), pk2(o1[4 * g + 2] * inv, o1[4 * g + 3] * inv)};
    }
}


__device__ __forceinline__ void attn_unit_naive(ArgsP a, int bh, int qb, LAS unsigned char* lds) {
    a = args_ptr();
    const int tid = vtid(), lane = tid & 63, wid = tid >> 6;
    const int b = bh >> 3, h = bh & 7; const size_t rowb = (size_t)b * SEQ;
    const bf16_t* Qn = (const bf16_t*)(a->ws + A_QN); const bf16_t* Qp = (const bf16_t*)(a->ws + A_QP); const bf16_t* Kn = (const bf16_t*)(a->ws + A_KN);
    const bf16_t* KPE = (const bf16_t*)(a->ws + A_KPE); const bf16_t* Vt = (const bf16_t*)(a->ws + A_VT); bf16_t* O = (bf16_t*)(a->ws + A_QN);
    LAS float* sc = (LAS float*)(lds + wid * 16384);
    for (int i = 0; i < 32; ++i) {
        const int q = qb * 256 + wid * 32 + i; const size_t qrow = rowb + q;
        float mx = -INFINITY;
        for (int k0 = 0; k0 <= q; k0 += 64) {
            const int key = k0 + lane; float sv = -INFINITY;
            if (key <= q) { sv = 0.f;
                for (int d = 0; d < 64; ++d) sv += bf2f(Qn[qrow * 512 + h * 64 + d]) * bf2f(Kn[(rowb + key) * 512 + h * 64 + d]);
                for (int d = 0; d < 32; ++d) sv += bf2f(Qp[qrow * 256 + h * 32 + d]) * bf2f(KPE[(rowb + key) * 32 + d]); }
            sc[key] = sv; mx = fmaxf(mx, sv);
        }
        for (int o = 1; o < 64; o <<= 1) mx = fmaxf(mx, shx(mx, o));
        float sum = 0.f;
        for (int k0 = 0; k0 <= q; k0 += 64) { const int key = k0 + lane; const float p = key <= q ? exp2f(sc[key] - mx) : 0.f; sc[key] = p; sum += p; }
        for (int o = 1; o < 64; o <<= 1) sum += shx(sum, o);
        asm volatile("s_waitcnt lgkmcnt(0)" ::: "memory");
        float acc = 0.f;
        const bf16_t* vp = Vt + ((size_t)(bh * 64 + lane) << 12);
        for (int key = 0; key <= q; ++key) acc += sc[key] * bf2f(vp[key]);
        asm volatile("s_waitcnt lgkmcnt(0)" ::: "memory");
        O[qrow * 512 + h * 64 + lane] = (bf16_t)f2bf(acc / sum);
    }
}
__device__ __forceinline__ void ya_item(ArgsP a, int l, int bh, int gq) {
    a = args_ptr();
    const int tid = ltid();
    if (tid < 64) {
        unsigned* fl = (unsigned*)(a->ws + WS_CTL) + CW_YFLAG + l * 1024 + bh * 32 + gq * 4; unsigned* tmo = (unsigned*)(a->ws + WS_CTL) + CW_BAR + XB_TMO; unsigned sp_ = 0;
        for (;;) { const unsigned f_ = __hip_atomic_load(fl, __ATOMIC_RELAXED, __HIP_MEMORY_SCOPE_AGENT) & __hip_atomic_load(fl + 1, __ATOMIC_RELAXED, __HIP_MEMORY_SCOPE_AGENT)
                                      & __hip_atomic_load(fl + 2, __ATOMIC_RELAXED, __HIP_MEMORY_SCOPE_AGENT) & __hip_atomic_load(fl + 3, __ATOMIC_RELAXED, __HIP_MEMORY_SCOPE_AGENT);
            if ((unsigned)__builtin_amdgcn_readfirstlane(f_) != 0u) break;
            __builtin_amdgcn_s_sleep(2);
            if ((++sp_ & 255u) == 0u) { if (xb_ld(tmo)) break; if (sp_ > XB_SPIN_CAP) { atomicAdd(tmo, 1u); break; } } }
        __builtin_amdgcn_fence(__ATOMIC_ACQUIRE, "agent");
    }
    __syncthreads();
    const int h = bh & 7, c = h * 64 + (tid & 7) * 8; const size_t r0 = (size_t)(bh >> 3) * SEQ + (size_t)gq * 512 + (tid >> 3);
    const bf16_t* Y = (const bf16_t*)(a->ws + A_Y); const bf16_t* RKV = (const bf16_t*)(a->ws + A_RKV); const bf16_t* GATE = (const bf16_t*)(a->ws + A_GATE);
    const float* SCAL = (const float*)(a->ws + WS_SCAL); bf16_t* YA = (bf16_t*)(a->ws + A_YA);
    const float* lw = a->in[I_LNXW] + l * 512 + c; const float* lb = a->in[I_LNXB] + l * 512 + c;
    const f32x4 w0 = *(const f32x4*)lw, w1 = *(const f32x4*)(lw + 4), b0 = *(const f32x4*)lb, b1 = *(const f32x4*)(lb + 4);
    u32x4 yu[8], vu[8], gu[8]; float sc[8];
#pragma unroll
    for (int k = 0; k < 8; ++k) { const size_t row = r0 + 64 * k;
        yu[k] = *(const u32x4*)(Y + row * 512 + c); vu[k] = *(const u32x4*)(RKV + row * 1536 + 1024 + c);
        gu[k] = *(const u32x4*)(GATE + row * 512 + c); sc[k] = SCAL[row * 8 + h]; }
#pragma unroll
    for (int k = 0; k < 8; ++k) {
        const f32x4 ya0 = up4((u32x2){yu[k].x, yu[k].y}), ya1 = up4((u32x2){yu[k].z, yu[k].w});
        float sm = ((ya0.x + ya0.y) + (ya0.z + ya0.w)) + ((ya1.x + ya1.y) + (ya1.z + ya1.w));
        sm += shx(sm, 1); sm += shx(sm, 2); sm += shx(sm, 4);
        const float mean = sm * (1.0f / 64.0f);
        const f32x4 d0 = ya0 - mean, d1 = ya1 - mean;
        float qv = dot4(d0, d0) + dot4(d1, d1);
        qv += shx(qv, 1); qv += shx(qv, 2); qv += shx(qv, 4);
        const float rstd = rsqrtf(qv * (1.0f / 64.0f) + LNX_EPS);
        const f32x4 vv0 = up4((u32x2){vu[k].x, vu[k].y}), vv1 = up4((u32x2){vu[k].z, vu[k].w});
        const f32x4 g0 = up4((u32x2){gu[k].x, gu[k].y}), g1 = up4((u32x2){gu[k].z, gu[k].w});
        const f32x4 o0 = (d0 * rstd * w0 + b0 + vv0 * sc[k]) * g0, o1 = (d1 * rstd * w1 + b1 + vv1 * sc[k]) * g1;
        const u32x2 p0 = dn4(o0), p1 = dn4(o1);
        *(u32x4*)(YA + (r0 + 64 * k) * 512 + c) = (u32x4){p0.x, p0.y, p1.x, p1.y};
    }
}
#if NAIVE_ATTN
#define ATTN_UNIT attn_unit_naive
#else
#define ATTN_UNIT attn_unit
#endif
__device__ __forceinline__ void phase_ya(ArgsP a, int l) {
    a = args_ptr();
    const unsigned gt = blockIdx.x * NTHREADS + ltid(), NGT = gridDim.x * NTHREADS;
    const bf16_t* Y = (const bf16_t*)(a->ws + A_Y); const bf16_t* RKV = (const bf16_t*)(a->ws + A_RKV); const bf16_t* GATE = (const bf16_t*)(a->ws + A_GATE);
    const float* SCAL = (const float*)(a->ws + WS_SCAL); bf16_t* YA = (bf16_t*)(a->ws + A_YA);
    const int c = (gt & 63) * 8, h = c >> 6;
    const float* muv = a->in[I_MU] + (size_t)l * 1792 + 1024 + c; const float* lw = a->in[I_LNXW] + l * 512 + c; const float* lb = a->in[I_LNXB] + l * 512 + c;
    const f32x4 m0 = *(const f32x4*)muv, m1 = *(const f32x4*)(muv + 4), w0 = *(const f32x4*)lw, w1 = *(const f32x4*)(lw + 4), b0 = *(const f32x4*)lb, b1 = *(const f32x4*)(lb + 4);
    for (unsigned i = gt; i < (unsigned)M * 64; i += 2 * NGT) {
        u32x4 yu[2], v2u[2], v1u[2], gu[2]; float sc[2]; unsigned rowv[2];
#pragma unroll
        for (int k = 0; k < 2; ++k) { const unsigned row = (i + k * NGT) >> 6; const int t = row & 4095; rowv[k] = row;
            yu[k] = *(const u32x4*)(Y + (size_t)row * 512 + c); v2u[k] = *(const u32x4*)(RKV + (size_t)row * 1536 + 1024 + c);
            v1u[k] = WKV_STREAM ? v2u[k] : (t ? *(const u32x4*)(RKV + (size_t)(row - 1) * 1536 + 1024 + c) : (u32x4){0u, 0u, 0u, 0u});
            gu[k] = *(const u32x4*)(GATE + (size_t)row * 512 + c); sc[k] = SCAL[(size_t)row * 8 + h]; }
#pragma unroll
        for (int k = 0; k < 2; ++k) {
            const f32x4 ya0 = up4((u32x2){yu[k].x, yu[k].y}), ya1 = up4((u32x2){yu[k].z, yu[k].w});
            float sm = ((ya0.x + ya0.y) + (ya0.z + ya0.w)) + ((ya1.x + ya1.y) + (ya1.z + ya1.w));
            sm += shx(sm, 1); sm += shx(sm, 2); sm += shx(sm, 4);
            const float mean = sm * (1.0f / 64.0f);
            const f32x4 d0 = ya0 - mean, d1 = ya1 - mean;
            float qv = dot4(d0, d0) + dot4(d1, d1);
            qv += shx(qv, 1); qv += shx(qv, 2); qv += shx(qv, 4);
            const float rstd = rsqrtf(qv * (1.0f / 64.0f) + LNX_EPS);
            const f32x4 v20 = up4((u32x2){v2u[k].x, v2u[k].y}), v21 = up4((u32x2){v2u[k].z, v2u[k].w}), v10 = up4((u32x2){v1u[k].x, v1u[k].y}), v11 = up4((u32x2){v1u[k].z, v1u[k].w});
            const f32x4 vv0 = v20 + (v10 - v20) * m0, vv1 = v21 + (v11 - v21) * m1;
            const f32x4 g0 = up4((u32x2){gu[k].x, gu[k].y}), g1 = up4((u32x2){gu[k].z, gu[k].w});
            const f32x4 o0 = (d0 * rstd * w0 + b0 + vv0 * sc[k]) * g0, o1 = (d1 * rstd * w1 + b1 + vv1 * sc[k]) * g1;
            const u32x2 p0 = dn4(o0), p1 = dn4(o1);
            *(u32x4*)(YA + (size_t)rowv[k] * 512 + c) = (u32x4){p0.x, p0.y, p1.x, p1.y};
        }
    }
}


__device__ __forceinline__ void phase_gconv(ArgsP a, int l) {
    a = args_ptr();
    const unsigned gt = blockIdx.x * NTHREADS + ltid();
    constexpr unsigned NCHK = FF / 8, NSEG = 372, SEGR = (M + NSEG - 1) / NSEG;
    if (gt >= NCHK * NSEG) return;
    const unsigned chk = gt % NCHK, seg = gt / NCHK; const int c = chk * 8;
    const bf16_t* UG = (const bf16_t*)(a->ws + A_UG); bf16_t* GC = (bf16_t*)(a->ws + A_ACT);
    const float* cw = a->in[I_CONVW] + (size_t)l * 3 * FF + c; const float* cb = a->in[I_CONVB] + (size_t)l * FF + c;
    const f32x4 w0a = *(const f32x4*)cw, w0b = *(const f32x4*)(cw + 4), w1a = *(const f32x4*)(cw + FF), w1b = *(const f32x4*)(cw + FF + 4), w2a = *(const f32x4*)(cw + 2 * FF), w2b = *(const f32x4*)(cw + 2 * FF + 4);
    const f32x4 ba = *(const f32x4*)cb, bb = *(const f32x4*)(cb + 4);
    const unsigned r0 = seg * SEGR, r1 = (r0 + SEGR < (unsigned)M) ? r0 + SEGR : (unsigned)M;
    const u32x4 z = (u32x4){0u, 0u, 0u, 0u};
    u32x4 p1 = ((r0 & 4095u) >= 1u) ? *(const u32x4*)(UG + (size_t)(r0 - 1) * FF + c) : z, p2 = ((r0 & 4095u) >= 2u) ? *(const u32x4*)(UG + (size_t)(r0 - 2) * FF + c) : z;
    u32x4 nx = *(const u32x4*)(UG + (size_t)r0 * FF + c);
    for (unsigned r = r0; r < r1; ++r) {
        const u32x4 cur = nx;
        if (r + 1 < r1) nx = *(const u32x4*)(UG + (size_t)(r + 1) * FF + c);
        if ((r & 4095u) == 0u) { p1 = z; p2 = z; }
        const f32x4 x2a = up4((u32x2){cur.x, cur.y}), x2b = up4((u32x2){cur.z, cur.w}), x1a = up4((u32x2){p1.x, p1.y}), x1b = up4((u32x2){p1.z, p1.w}), x0a = up4((u32x2){p2.x, p2.y}), x0b = up4((u32x2){p2.z, p2.w});
        const f32x4 ca = ba + w0a * x0a + w1a * x1a + w2a * x2a, cc = bb + w0b * x0b + w1b * x1b + w2b * x2b;
        const pg8::f32x2 g0 = pg8::gelu_pk2((pg8::f32x2){ca.x, ca.y}), g1 = pg8::gelu_pk2((pg8::f32x2){ca.z, ca.w}), g2 = pg8::gelu_pk2((pg8::f32x2){cc.x, cc.y}), g3 = pg8::gelu_pk2((pg8::f32x2){cc.z, cc.w});
        *(u32x4*)(GC + (size_t)r * FF + c) = (u32x4){pk2(g0.x, g0.y), pk2(g1.x, g1.y), pk2(g2.x, g2.y), pk2(g3.x, g3.y)};
        p2 = p1; p1 = cur;
    }
}
__device__ __forceinline__ void ffn_halo_fix(ArgsP a, int l, int pm) {
    a = args_ptr();
    const int tid = ltid();
    const bf16_t* RAWH = (const bf16_t*)(a->ws + A_UG); bf16_t* ACT = (bf16_t*)(a->ws + A_ACT);
    const float* cw = a->in[I_CONVW] + (size_t)l * 3 * FF; const float* cb = a->in[I_CONVB] + (size_t)l * FF;
    for (int i = tid; i < 8 * (FF / 8); i += NTHREADS) {
        const int hr = i / (FF / 8), c = (i % (FF / 8)) * 8, blk = pm * 4 + (hr >> 1), fr = hr & 1, row = blk * 64 + fr;
        const bool first = (row & 4095) < 2; const bf16_t* hb = RAWH + (size_t)blk * 6 * FF + c; const u32x4 z = (u32x4){0u, 0u, 0u, 0u};
        const u32x4 cur = *(const u32x4*)(hb + (2 + fr) * FF), val = *(const u32x4*)(hb + (4 + fr) * FF);
        const u32x4 p1 = (fr == 0) ? (first ? z : *(const u32x4*)(hb - 5 * FF)) : *(const u32x4*)(hb + 2 * FF);
        const u32x4 p2 = first ? z : *(const u32x4*)(hb - (fr == 0 ? 6 : 5) * FF);
        const f32x4 w0a = *(const f32x4*)(cw + c), w0b = *(const f32x4*)(cw + c + 4), w1a = *(const f32x4*)(cw + FF + c), w1b = *(const f32x4*)(cw + FF + c + 4);
        const f32x4 w2a = *(const f32x4*)(cw + 2 * FF + c), w2b = *(const f32x4*)(cw + 2 * FF + c + 4), ba = *(const f32x4*)(cb + c), bb = *(const f32x4*)(cb + c + 4);
        const f32x4 ga = pg8::gelu4(ba + w0a * up4((u32x2){p2.x, p2.y}) + w1a * up4((u32x2){p1.x, p1.y}) + w2a * up4((u32x2){cur.x, cur.y}));
        const f32x4 gb = pg8::gelu4(bb + w0b * up4((u32x2){p2.z, p2.w}) + w1b * up4((u32x2){p1.z, p1.w}) + w2b * up4((u32x2){cur.z, cur.w}));
        *(u32x4*)(ACT + (size_t)row * FF + c) = pg8::pack8(ga * up4((u32x2){val.x, val.y}), gb * up4((u32x2){val.z, val.w}));
    }
    asm volatile("s_waitcnt vmcnt(0)" ::: "memory");
    __syncthreads();
}
__device__ __forceinline__ void phase_final(ArgsP a) {
    a = args_ptr();
    const int tid = ltid(), lane = tid & 63, gw = blockIdx.x * NWAVES + (tid >> 6), NGW = gridDim.x * NWAVES;
    const float* SS4 = (const float*)(a->ws + WS_SSP) + (size_t)4 * M * 16; const f32x4* g = (const f32x4*)a->in[I_FINAL] + lane; const bf16_t* HB = (const bf16_t*)(a->ws + A_HB);
    for (int m = gw; m < M; m += NGW) {
        const float rs = rsqrtf(pg8::sum16(SS4 + (size_t)m * 16) * (1.0f / 1024.0f) + NORM_EPS);
        f32x4* o = (f32x4*)(a->out + (size_t)m * DM) + lane; const u32x2* hb = (const u32x2*)(HB + (size_t)m * DM) + lane;
#pragma unroll
        for (int j = 0; j < 4; ++j) o[64 * j] = up4(hb[64 * j]) * rs * g[64 * j];
    }
}


#ifndef DUMP_MIB
#define DUMP_MIB 0
#endif
#ifndef DUMP_OFF_MIB
#define DUMP_OFF_MIB 0
#endif
__device__ __forceinline__ void phase_dump(ArgsP a) {
    a = args_ptr();
    const size_t n16 = (size_t)DUMP_MIB * 1024 * 512, nout = (size_t)M * DM;
    const unsigned short* src = (const unsigned short*)(a->ws + (size_t)DUMP_OFF_MIB * 1024 * 1024);
    for (size_t i = (size_t)blockIdx.x * NTHREADS + vtid(); i < nout; i += (size_t)gridDim.x * NTHREADS) {
        float sacc = 0.f; for (size_t j = i; j < n16; j += nout) sacc += (float)src[j] * (1.0f / 65536.0f);
        a->out[i] = sacc; }
}

#ifndef CHK_ONLY
#define CHK_ONLY 0
#endif
#ifdef CHKSUM_PROBE
__device__ __forceinline__ void phase_chk_sum(ArgsP a) {
    a = args_ptr(); unsigned* ctl = (unsigned*)(a->ws + WS_CTL) + 32768;
    const size_t offs[4] = {A_Y, A_QN, WS_SCAL, A_YA}; const unsigned n16[4] = {(unsigned)M * 512u, (unsigned)M * 512u, (unsigned)M * 16u, 0u};
    for (int k = 0; k < 3; ++k) { const unsigned short* p = (const unsigned short*)(a->ws + offs[k]); unsigned acc = 0;
        for (unsigned i = blockIdx.x * NTHREADS + vtid(); i < n16[k]; i += gridDim.x * NTHREADS) acc += p[i];
        for (int o = 1; o < 64; o <<= 1) acc += shx(acc, o);
        if ((vtid() & 63) == 0) atomicAdd(ctl + 64 * k, acc); }
}
__device__ __forceinline__ void phase_chk_out(ArgsP a) {
    a = args_ptr(); const unsigned* ctl = (const unsigned*)(a->ws + WS_CTL) + 32768;
    for (unsigned i = blockIdx.x * NTHREADS + vtid(); i < (unsigned)(M * DM); i += gridDim.x * NTHREADS) {
        float v = 0.f; if (i == CHK_ONLY) v = (float)(__hip_atomic_load(ctl + 64 * i, __ATOMIC_RELAXED, __HIP_MEMORY_SCOPE_AGENT) % CHKSUM_PROBE) * 100.0f; a->out[i] = v; }
}
#endif

#ifdef CMPY_PROBE
__device__ __forceinline__ void phase_cmp_y(ArgsP a) {
    a = args_ptr(); unsigned long long* ctl = (unsigned long long*)(a->ws + WS_CTL) + 20000;
    const unsigned short* y1 = (const unsigned short*)(a->ws + A_Y); const unsigned short* y2 = (const unsigned short*)(a->ws + A_GATE);
    float sd = 0.f, sy = 0.f;
    for (unsigned i = blockIdx.x * NTHREADS + vtid(); i < (unsigned)M * 512u; i += gridDim.x * NTHREADS) { const float p = bf2f(y1[i]), r = bf2f(y2[i]); sd += (p - r) * (p - r); sy += r * r; }
    atomicAdd(ctl, (unsigned long long)(sd * 1024.0f)); atomicAdd(ctl + 8, (unsigned long long)(sy * 1024.0f));
}
__device__ __forceinline__ void phase_cmp_out(ArgsP a) {
    a = args_ptr(); const unsigned long long* ctl = (const unsigned long long*)(a->ws + WS_CTL) + 20000;
    const float rel = sqrtf((float)__hip_atomic_load(ctl, __ATOMIC_RELAXED, __HIP_MEMORY_SCOPE_AGENT) / (float)__hip_atomic_load(ctl + 8, __ATOMIC_RELAXED, __HIP_MEMORY_SCOPE_AGENT));
    for (unsigned i = blockIdx.x * NTHREADS + vtid(); i < (unsigned)(M * DM); i += gridDim.x * NTHREADS) a->out[i] = (i == 0) ? floorf(rel * 10000.0f) : 0.f;
}
#endif

#ifdef CK_TIME
__device__ __forceinline__ void phase_time_out(ArgsP a) {
    a = args_ptr(); const unsigned long long* tw = (const unsigned long long*)(a->ws + WS_CTL) + 24000;
#ifdef CK_TIME_TOTAL
    const float frac = (float)__hip_atomic_load(tw + 8, __ATOMIC_RELAXED, __HIP_MEMORY_SCOPE_AGENT) * (1.0f / 100000.0f);
    for (unsigned i = blockIdx.x * NTHREADS + vtid(); i < (unsigned)(M * DM); i += gridDim.x * NTHREADS) a->out[i] = (i == 0) ? floorf(frac) * 100.0f : 0.f;
#else
    const float frac = (float)__hip_atomic_load(tw + CK_TIME, __ATOMIC_RELAXED, __HIP_MEMORY_SCOPE_AGENT) / (float)__hip_atomic_load(tw + 8, __ATOMIC_RELAXED, __HIP_MEMORY_SCOPE_AGENT);
    for (unsigned i = blockIdx.x * NTHREADS + vtid(); i < (unsigned)(M * DM); i += gridDim.x * NTHREADS) a->out[i] = (i == 0) ? floorf(frac * 8.0f + 0.5f) * 1000.0f : 0.f;
#endif
}
#endif

#ifdef PH_TIME
__device__ __forceinline__ void phase_phtime_out(ArgsP a) {
    a = args_ptr(); const unsigned long long* tw = (const unsigned long long*)(a->ws + WS_CTL) + 26000;
    const float us = (float)(__hip_atomic_load(tw + PH_TIME + 1, __ATOMIC_RELAXED, __HIP_MEMORY_SCOPE_AGENT) - __hip_atomic_load(tw + PH_TIME, __ATOMIC_RELAXED, __HIP_MEMORY_SCOPE_AGENT)) * 0.01f;
    for (unsigned i = blockIdx.x * NTHREADS + vtid(); i < (unsigned)(M * DM); i += gridDim.x * NTHREADS) a->out[i] = (i == 0) ? floorf(us / (float)PH_Q + 0.5f) * 100.0f : 0.f;
}
#endif
#ifdef SPLIT_SCAN_ATTN
constexpr int PH_EXTRA = 1;
#else
constexpr int PH_EXTRA = 0;
#endif
constexpr int PH_PER_LAYER = 9 + PH_EXTRA, N_PHASES = 2 * PH_PER_LAYER + 1;
__global__ void __launch_bounds__(NTHREADS, 2) mk_fwd(Args a_unused) {
    LAS unsigned char* lds = (LAS unsigned char*)lds_raw;
    { const unsigned t0_ = threadIdx.x; if ((t0_ & 63u) == 0u) *(volatile LAS unsigned*)(lds + WTAB_OFF + hw_wave_key() * 4u) = t0_ >> 6; }
    __syncthreads();
#if !MK_MULTI
    if (args_ptr()->ph_lo > 1000000) cg::this_grid().sync();
    volatile LAS unsigned* MISC = (volatile LAS unsigned*)(lds + MISC_OFF);
    if (vtid() < 32) MISC[vtid()] = 0u;
    __syncthreads();
    (void)xcd_barrier_post((unsigned*)(args_ptr()->ws + WS_CTL) + CW_BAR, MISC + 8);
#endif
    int ph = 0;
#ifdef PH_TIME
    if (blockIdx.x == 0 && vtid() == 0) ((unsigned long long*)(args_ptr()->ws + WS_CTL) + 26000)[0] = __builtin_amdgcn_s_memrealtime();
#endif
#define lo (args_ptr()->ph_lo)
#define hi (args_ptr()->ph_hi)
#if MK_MULTI
#define SEAM() do {} while (0)
#define SEAM1() do {} while (0)
#else
#define SEAM1() do { XcdBarrier b_; b_.bar = (unsigned*)(args_ptr()->ws + WS_CTL) + CW_BAR; b_.x = xb_xcc_id(); b_.st = (volatile LAS unsigned*)(lds + MISC_OFF) + 8; xcd_barrier(b_); } while (0)
#define SEAM() do { if (ph + 1 < hi) { XcdBarrier b_; b_.bar = (unsigned*)(args_ptr()->ws + WS_CTL) + CW_BAR; b_.x = xb_xcc_id(); b_.st = (volatile LAS unsigned*)(lds + MISC_OFF) + 8; xcd_barrier(b_); } } while (0)
#endif
#ifndef PH3SUB
#define PH3SUB 7
#endif
#ifndef PHMASK
#define PHMASK 0xFFFF
#endif
#ifndef SCAN_CHUNKED
#define SCAN_CHUNKED 1
#endif
#ifndef SCAN_REPS
#define SCAN_REPS 1
#endif
#ifndef REPEAT_PHASE
#define REPEAT_PHASE (-1)
#endif
#ifndef REPEAT_LAYER
#define REPEAT_LAYER (-1)
#endif
#ifdef PH_TIME
#define PH_STAMP() do { if (blockIdx.x == 0 && vtid() == 0) ((unsigned long long*)(args_ptr()->ws + WS_CTL) + 26000)[ph + 1] = __builtin_amdgcn_s_memrealtime(); } while (0)
#elif defined(PH_SPIN)
#ifdef PH_SUB
#define PH_SUBSEL() do { const unsigned long long* ts_ = st_ + 100; d_ = PH_SUB == 1 ? ts_[1] - ts_[0] : (PH_SUB == 2 ? ts_[2] - ts_[1] : (PH_SUB == 3 ? t1_ - ts_[2] : (PH_SUB == 4 ? __hip_atomic_load((unsigned long long*)ts_ + 4, __ATOMIC_RELAXED, __HIP_MEMORY_SCOPE_AGENT) - ts_[0] : ts_[0] - st_[ph]))); } while (0)
#else
#define PH_SUBSEL() do {} while (0)
#endif
#define PH_STAMP() do { if (ph + 1 == PH_SPIN || ph == PH_SPIN) { if (blockIdx.x == 0 && vtid() == 0) { unsigned long long* st_ = (unsigned long long*)(args_ptr()->ws + WS_CTL) + 26000; \
        const unsigned long long t1_ = __builtin_amdgcn_s_memrealtime(); st_[ph + 1] = t1_; st_[103] = t1_; \
        if (ph == PH_SPIN) { unsigned long long d_ = t1_ - st_[ph]; PH_SUBSEL(); if (d_ > 100000ull) d_ = 100000ull; while (__builtin_amdgcn_s_memrealtime() - t1_ < d_) __builtin_amdgcn_s_sleep(8); } } \
        if (ph == PH_SPIN) { SEAM1(); } } } while (0)
#else
#define PH_STAMP() do {} while (0)
#endif
#define RUN(K, ...) do { if (((PHMASK >> (K)) & 1) && lo <= ph && ph < hi) { const int nrep_ = ((K) == REPEAT_PHASE && (REPEAT_LAYER < 0 || REPEAT_LAYER == l_)) ? 2 : 1; \
    for (int rep_ = 0; rep_ < nrep_; ++rep_) { __VA_ARGS__; if (rep_ + 1 < nrep_) { SEAM1(); } } SEAM(); PH_STAMP(); } ++ph; } while (0)
#define LOCALS() ArgsP a = args_ptr(); unsigned char* ws = a->ws; unsigned char* wb = ws + WS_W; float* SSP = (float*)(ws + WS_SSP); float* SSQP = (float*)(ws + WS_SSQP); bf16_t* HB = (bf16_t*)(ws + A_HB); \
    const int G = gridDim.x, bid = blockIdx.x; (void)wb; (void)SSP; (void)SSQP; (void)HB; (void)G; (void)bid
#define WT(off) ((const pg8::bf16_t*)(wb + (off)))
    int l_ = 0;
    for (int l = 0; l < DEPTH; ++l) {
        l_ = l;
        RUN(0, phase_weights(nullptr, l, lds));
        RUN(1, { LOCALS(); pg8::Gemm g{HB, WT(W_IN), M, PC - 256, 1024, 1024}; pg8::StaticOrder S; S.init(M, PC - 256, G, bid);
              pg8::EpiP E{(bf16_t*)(ws + A_RKV), (bf16_t*)(ws + A_LORAC), (bf16_t*)(ws + A_PM), (unsigned char*)a->out, SSP + (size_t)(2 * l) * M * 16, SSQP + (size_t)l * M * 4, SSQP + (size_t)(2 + l) * M * 4, (bf16_t*)((unsigned char*)a->out + DO_HALO), (LAS float*)(lds + pg8::RS_OFF), 0};
              GEMM_PHASE(pg8::EpiP, lds, g, S, E); });
        RUN(2, phase_prep(nullptr, l));
        RUN(3, { if (PH3SUB & 1) { LOCALS(); pg8::Gemm g{(const bf16_t*)(ws + A_LIN), WT(W_LORA), M, 1536, 256, 256}; pg8::StaticOrder S; S.init(M, 1536, G, bid);
                pg8::EpiLora E{(bf16_t*)(ws + A_LW), (bf16_t*)(ws + A_ICLR), (bf16_t*)(ws + A_GATE), a->in[I_DBASE] + l * 512, a->in[I_IBASE] + l * 512};
                GEMM_PHASE(pg8::EpiLora, lds, g, S, E); }
              if (gridDim.x == 256 && blockIdx.x >= 192) {
                LOCALS(); pg8::Gemm g{HB, WT(W_IN) + (size_t)(PC - 256) * 1024, M, 256, 1024, 1024}; pg8::StaticOrder S; S.init(M, 256, 64, bid - 192);
                pg8::EpiP E{(bf16_t*)(ws + A_RKV), (bf16_t*)(ws + A_LORAC), (bf16_t*)(ws + A_PM), (unsigned char*)a->out, SSP + (size_t)(2 * l) * M * 16, SSQP + (size_t)l * M * 4, SSQP + (size_t)(2 + l) * M * 4, (bf16_t*)((unsigned char*)a->out + DO_HALO), (LAS float*)(lds + pg8::RS_OFF), 16};
                GEMM_PHASE(pg8::EpiP, lds, g, S, E); }
              else if (gridDim.x != 256) {
                LOCALS(); pg8::Gemm g{HB, WT(W_IN) + (size_t)(PC - 256) * 1024, M, 256, 1024, 1024}; pg8::StaticOrder S; S.init(M, 256, G, bid);
                pg8::EpiP E{(bf16_t*)(ws + A_RKV), (bf16_t*)(ws + A_LORAC), (bf16_t*)(ws + A_PM), (unsigned char*)a->out, SSP + (size_t)(2 * l) * M * 16, SSQP + (size_t)l * M * 4, SSQP + (size_t)(2 + l) * M * 4, (bf16_t*)((unsigned char*)a->out + DO_HALO), (LAS float*)(lds + pg8::RS_OFF), 16};
                GEMM_PHASE(pg8::EpiP, lds, g, S, E); }
              if (PH3SUB & 2) { LOCALS(); pg8::Gemm g{(const bf16_t*)(ws + A_PM), WT(W_Q), M, 768, 256, 512}; pg8::StaticOrder S; S.init(M, 768, G, bid);
                pg8::EpiQ E{(bf16_t*)(ws + A_QN), (bf16_t*)(ws + A_QP), SSQP + (size_t)l * M * 4, (const float*)(ws + WS_CS), (LAS float*)(lds + pg8::RS_OFF)};
                GEMM_PHASE(pg8::EpiQ, lds, g, S, E); }
              if (PH3SUB & 4) { LOCALS(); pg8::Gemm g{(const bf16_t*)(ws + A_PM) + 256, WT(W_KV), M, 1024, 256, 512}; pg8::StaticOrder S; S.init(M, 1024, G, bid);
                pg8::EpiKV E{(bf16_t*)(ws + A_KN), (bf16_t*)(ws + A_VT), SSQP + (size_t)(2 + l) * M * 4, (LAS float*)(lds + pg8::RS_OFF)};
                GEMM_PHASE(pg8::EpiKV, lds, g, S, E); } });
#if WKV_STREAM
        RUN(4, { if (gridDim.x >= 64) { if (blockIdx.x >= 32) phase_wkvprep(nullptr, l, lds, (int)blockIdx.x - 32, (int)gridDim.x - 32); }
                 else { phase_wkvprep(nullptr, l, lds, (int)blockIdx.x, (int)gridDim.x); SEAM1(); }
                 if (blockIdx.x < 32) { for (int sr_ = 0; sr_ < SCAN_REPS; ++sr_) scan_unit_stream(nullptr, l, blockIdx.x, lds); }
#ifdef PH_SUB
                 if (blockIdx.x == 0 && vtid() == 0) { unsigned long long* ts_ = (unsigned long long*)(args_ptr()->ws + WS_CTL) + 26100; ts_[0] = ts_[3]; ts_[1] = __builtin_amdgcn_s_memrealtime(); }
#endif
                 unsigned* qctr = (unsigned*)(args_ptr()->ws + WS_CTL) + CW_QUEUE + 64 * (2 * l);
                 volatile LAS unsigned* qslot = (volatile LAS unsigned*)(lds + MISC_OFF) + 16;
                 for (;;) { if (vtid() == 0) qslot[0] = __hip_atomic_fetch_add(qctr, 1u, __ATOMIC_RELAXED, __HIP_MEMORY_SCOPE_AGENT);
                            __syncthreads(); const unsigned u = qslot[0]; __syncthreads();
                            if (u >= 512u) break;
                            attn_unit(nullptr, (int)(u & 31u), 15 - (int)(u >> 5), lds, A_QN); }
                 { unsigned* yctr = (unsigned*)(args_ptr()->ws + WS_CTL) + CW_QUEUE + 64 * (2 * l + 1);
                   for (;;) { if (vtid() == 0) qslot[0] = __hip_atomic_fetch_add(yctr, 1u, __ATOMIC_RELAXED, __HIP_MEMORY_SCOPE_AGENT);
                              __syncthreads(); const unsigned u = qslot[0]; __syncthreads();
                              if (u >= 256u) break;
                              ya_item(nullptr, l, (int)(u & 31u), (int)(u >> 5)); } }
#ifdef PH_SUB
                 if (blockIdx.x == 0 && vtid() == 0) { unsigned long long* ts_ = (unsigned long long*)(args_ptr()->ws + WS_CTL) + 26100; ts_[2] = __builtin_amdgcn_s_memrealtime(); }
                 if (blockIdx.x == 255 && vtid() == 0) { unsigned long long* ts_ = (unsigned long long*)(args_ptr()->ws + WS_CTL) + 26100; __hip_atomic_store(ts_ + 4, (unsigned long long)__builtin_amdgcn_s_memrealtime(), __ATOMIC_RELAXED, __HIP_MEMORY_SCOPE_AGENT); }
#endif
                 });
#else
#ifdef SPLIT_SCAN_ATTN
        RUN(4, { if (blockIdx.x < 128) scan_unit_chunked(nullptr, l, blockIdx.x >> 2, blockIdx.x & 3, lds); });
        RUN(5, { for (int c = blockIdx.x; c < 256; c += gridDim.x) { attn_unit(nullptr, c >> 3, 15 - (c & 7), lds); attn_unit(nullptr, c >> 3, c & 7, lds); } });
#else
        RUN(4, { if (blockIdx.x < 128) { for (int sr_ = 0; sr_ < SCAN_REPS; ++sr_) { if (SCAN_CHUNKED) scan_unit_chunked(nullptr, l, blockIdx.x >> 2, blockIdx.x & 3, lds); else scan_unit(nullptr, l, blockIdx.x >> 2, blockIdx.x & 3, lds); } }
                 const size_t oo_ = (rep_ + 1 < nrep_) ? A_LW : A_QN;
                 unsigned* qctr = (unsigned*)(args_ptr()->ws + WS_CTL) + CW_QUEUE + 64 * (2 * l + rep_);
                 volatile LAS unsigned* qslot = (volatile LAS unsigned*)(lds + MISC_OFF) + 16;
                 for (;;) { if (vtid() == 0) qslot[0] = __hip_atomic_fetch_add(qctr, 1u, __ATOMIC_RELAXED, __HIP_MEMORY_SCOPE_AGENT);
                            __syncthreads(); const unsigned u = qslot[0]; __syncthreads();
                            if (u >= 512u) break;
                            attn_unit(nullptr, (int)(u & 31u), 15 - (int)(u >> 5), lds, oo_); } });
#endif
#endif
#ifdef CK_TIME
        if (l == 0) { phase_time_out(nullptr); return; }
#endif
#ifdef CMPY_PROBE
        if (l == 0) { if (blockIdx.x < 128) scan_unit(nullptr, l, blockIdx.x >> 2, blockIdx.x & 3, lds, A_GATE); SEAM1(); phase_cmp_y(nullptr); SEAM1(); phase_cmp_out(nullptr); return; }
#endif
#ifdef CHKSUM_PROBE
        if (l == 0) { phase_chk_sum(nullptr); SEAM1(); phase_chk_out(nullptr); return; }
#endif
        RUN(7, { { LOCALS(); pg8::Gemm g{(const bf16_t*)(ws + A_YA), WT(W_OA), M, 1024, 512, 512}; pg8::StaticOrder S; S.init(M, 1024, G, bid);
                pg8::EpiMix<1> E{(float*)(ws + A_TMP), (bf16_t*)(ws + A_MERGED), (const unsigned char*)a->out};
                GEMM_PHASE(pg8::EpiMix<1>, lds, g, S, E); }
              asm volatile("s_waitcnt vmcnt(0)" ::: "memory"); __syncthreads();
              { LOCALS(); pg8::Gemm g{(const bf16_t*)(ws + A_QN), WT(W_OB), M, 1024, 512, 512}; pg8::StaticOrder S; S.init(M, 1024, G, bid);
                pg8::EpiMix<2> E{(float*)(ws + A_TMP), (bf16_t*)(ws + A_MERGED), (const unsigned char*)a->out};
                GEMM_PHASE(pg8::EpiMix<2>, lds, g, S, E); } });
        RUN(8, { LOCALS(); pg8::Gemm g{(const bf16_t*)(ws + A_MERGED), WT(W_OUT), M, 1024, 1024, 1024}; pg8::StaticOrder S; S.init(M, 1024, G, bid);
#ifdef PH_SUB
              g.ts = (unsigned long long*)(ws + WS_CTL) + 26100;
#endif
              pg8::EpiRes E{HB, SSP + (size_t)(2 * l + 1) * M * 16};
              GEMM_PHASE(pg8::EpiRes, lds, g, S, E); });
        RUN(9, { LOCALS(); pg8::Gemm g{HB, WT(W_UP), M, 2 * FF, 1024, 1024}; pg8::StaticOrder S; S.init(M, 2 * FF, G, bid);
              pg8::EpiUp E{(bf16_t*)(ws + A_ACT), (bf16_t*)(ws + A_UG), SSP + (size_t)(2 * l + 1) * M * 16, a->in[I_CONVW] + (size_t)l * 3 * FF, a->in[I_CONVB] + (size_t)l * FF, (LAS float*)(lds + pg8::RS_OFF)};
              GEMM_PHASE(pg8::EpiUp, lds, g, S, E); });
        RUN(11, { LOCALS(); pg8::Gemm g{(const bf16_t*)(ws + A_ACT), WT(W_DOWN), M, 1024, FF, FF}; pg8::StaticOrder S; S.init(M, 1024, G, bid);
              { pg8::Unit hu_; for (int hi_ = 0; S.next(hi_, hu_); ++hi_) ffn_halo_fix(nullptr, l, hu_.pm); }
              pg8::EpiRes E{HB, SSP + (size_t)(2 * l + 2) * M * 16};
              GEMM_PHASE(pg8::EpiRes, lds, g, S, E); });
    }
    RUN(12, phase_final(nullptr));
#ifdef PH_TIME
    SEAM1(); phase_phtime_out(nullptr);
#endif
#if DUMP_MIB
    if (lo == 100) phase_dump(nullptr);
#endif
#ifdef CLOCKJUNK
    if (lo == 103 && blockIdx.x == 0) { args_ptr()->out[vtid()] += (float)(__builtin_amdgcn_s_memrealtime() & 1023); }
#endif
}

#undef lo
#undef hi
extern "C" void kernel_launch(void* const* d_in, const int* in_sizes, int n_in, void* d_out, int out_size, void* d_ws, size_t ws_size, hipStream_t stream) {
    static int grid = 0;
    if (grid == 0) {
        if (n_in != 28 || out_size != M * DM || ws_size < WS_END) { fprintf(stderr, "kernel_launch: unexpected shapes: n_in %d out %d ws %zu (need %zu)\n", n_in, out_size, ws_size, (size_t)WS_END); grid = -1; return; }
        int dev = 0, cus = 0, per_cu = 0;
        if (hipGetDevice(&dev) != hipSuccess || hipDeviceGetAttribute(&cus, hipDeviceAttributeMultiprocessorCount, dev) != hipSuccess) { grid = -1; return; }
        if (hipFuncSetAttribute((const void*)mk_fwd, hipFuncAttributeMaxDynamicSharedMemorySize, LDS_BYTES) != hipSuccess) { fprintf(stderr, "kernel_launch: hipFuncSetAttribute failed\n"); grid = -1; return; }
        if (hipOccupancyMaxActiveBlocksPerMultiprocessor(&per_cu, (const void*)mk_fwd, NTHREADS, LDS_BYTES) != hipSuccess || per_cu < 1) { fprintf(stderr, "kernel_launch: occupancy query says %d\n", per_cu); per_cu = 1; }
        (void)hipGetLastError();
        grid = cus * 1;
        if (grid > cus * per_cu) grid = cus * per_cu;
    }
    if (grid < 0) return;
    if (hipMemsetAsync((char*)d_ws + WS_CTL, 0, CTL_ZERO_BYTES, stream) != hipSuccess) { fprintf(stderr, "kernel_launch: memset failed\n"); return; }
    Args a{};
    for (int i = 0; i < 28; ++i) a.in[i] = (const float*)d_in[i];
    a.out = (float*)d_out; a.ws = (unsigned char*)d_ws;
#if MK_MULTI
#ifndef STOP_AFTER
#define STOP_AFTER (N_PHASES - 1)
#endif
    for (int p = 0; p <= STOP_AFTER; ++p) {
        a.ph_lo = p; a.ph_hi = p + 1;
        hipLaunchKernelGGL(mk_fwd, dim3(grid), dim3(NTHREADS), LDS_BYTES, stream, a);
    }
#ifdef CLOCKJUNK
    a.ph_lo = 103; a.ph_hi = 104;
    hipLaunchKernelGGL(mk_fwd, dim3(grid), dim3(NTHREADS), LDS_BYTES, stream, a);
#endif
#if DUMP_MIB
    a.ph_lo = 100; a.ph_hi = 101;
    hipLaunchKernelGGL(mk_fwd, dim3(grid), dim3(NTHREADS), LDS_BYTES, stream, a);
#endif
#else
    a.ph_lo = 0; a.ph_hi = N_PHASES;
    void* kargs[] = {&a};
    hipError_t e = hipLaunchCooperativeKernel((const void*)mk_fwd, dim3(grid), dim3(NTHREADS), kargs, LDS_BYTES, stream);
    if (e != hipSuccess) fprintf(stderr, "kernel_launch: cooperative launch failed: %s (grid %d)\n", hipGetErrorString(e), grid);
#endif
}
```

```cpp
#include <hip/hip_runtime.h>
#include <hip/hip_cooperative_groups.h>
#include <cstdio>
#include <cstdint>
#include <cmath>
namespace cg = cooperative_groups;

#ifndef MK_MULTI
#define MK_MULTI 0
#endif

#ifndef SCAN_CHUNKED
#define SCAN_CHUNKED 1
#endif
#define LW_CUM SCAN_CHUNKED
#ifndef WKV_STREAM
#define WKV_STREAM 1
#endif
#ifndef CK_LWZ
#define CK_LWZ 1.0f
#endif
#ifndef CK_NOSTATE
#define CK_NOSTATE 0
#endif
#ifndef CK_AB
#define CK_AB 1.0f
#endif
constexpr int BATCH = 4, SEQ = 4096, DM = 1024, M = BATCH * SEQ, DEPTH = 2;
constexpr int NH = 8, RD = 512;
constexpr int IN_COLS = 4256, PC = 4352;
constexpr int FF = 2816;
constexpr float NORM_EPS = 1e-6f, LNX_EPS = 64e-5f;
constexpr float C2 = 0.10206207261596577f * 1.4426950408889634f;

namespace pg8 {
#define PG8_LAS __attribute__((address_space(3)))
}
extern __shared__ __attribute__((aligned(16))) unsigned char lds_raw[];
constexpr int WTAB_OFF = 131072 + 448;
__device__ __forceinline__ unsigned hw_wave_key() { return (unsigned)__builtin_amdgcn_s_getreg((5 << 11) | 4) & 63u; }
__device__ __forceinline__ int vtid() {
    const int wv = __builtin_amdgcn_readfirstlane((int)*(volatile PG8_LAS unsigned*)((PG8_LAS unsigned char*)lds_raw + WTAB_OFF + hw_wave_key() * 4u));
    int t_ = (wv << 6) | (int)__builtin_amdgcn_mbcnt_hi(~0u, __builtin_amdgcn_mbcnt_lo(~0u, 0u));
    asm volatile("" : "+v"(t_));
    return t_;
}
__device__ __forceinline__ float shx(float v, int m) {
    int l_ = (int)__builtin_amdgcn_mbcnt_hi(~0u, __builtin_amdgcn_mbcnt_lo(~0u, 0u)); asm volatile("" : "+v"(l_));
    return __builtin_bit_cast(float, __builtin_amdgcn_ds_bpermute((l_ ^ m) << 2, __builtin_bit_cast(int, v)));
}
namespace pg8 {
typedef unsigned short bf16_t;
typedef short bf16x8 __attribute__((ext_vector_type(8)));
typedef float f32x4 __attribute__((ext_vector_type(4)));
typedef unsigned u32x4 __attribute__((ext_vector_type(4)));
constexpr int BM = 256, BK = 64, HALF = 128, HTB = HALF * BK * 2  , STAGE_BYTES = 8 * HTB, NXCD = 8, WGM = 8;

__host__ __device__ __forceinline__ int lds_byte(int r, int c) { const int st = (r >> 4) * 2 + (c >> 5), rr = r & 15, cc = c & 31, ob = rr * 64 + cc * 2; return st * 1024 + (ob ^ (((ob >> 9) & 1) << 5)); }
__host__ __device__ __forceinline__ void stage_rc(int b, int& R, int& C) { const int st = b / 1024, sb = b % 1024, swz = sb ^ (((sb >> 9) & 1) << 5); R = (st >> 1) * 16 + swz / 64; C = (st & 1) * 32 + (swz % 64) / 2; }
__host__ __device__ __forceinline__ int perm32(int rho) { const int n = rho >> 4, i = rho & 15; return 8 * (i >> 2) + 4 * n + (i & 3); }

struct Unit { int pm, pn; };
struct Gemm { const bf16_t* A; const bf16_t* Bt; int M, N, K, lda; unsigned long long* ts = nullptr; };

struct StaticOrder {
    int nM, nN, nwg, G, c;
    __host__ __device__ void init(int M, int N, int G_, int c_) { nM = M / BM; nN = N / BM; nwg = nM * nN; G = G_; c = c_; }
    __host__ __device__ __forceinline__ bool next(int i, Unit& u) const {
        const long L = (long)i * G + c; if (L >= nwg) return false;
        int wgid = (int)L; { const int q = nwg / NXCD, r = nwg % NXCD, xcd = wgid % NXCD, off = wgid / NXCD; wgid = (xcd < r ? xcd * (q + 1) : r * (q + 1) + (xcd - r) * q) + off; }
        const int nig = WGM * nN, gid = wgid / nig, fm = gid * WGM, gsz = (nM - fm) < WGM ? (nM - fm) : WGM;
        u.pm = fm + ((wgid % nig) % gsz); u.pn = (wgid % nig) / gsz; return true;
    }
    __device__ __forceinline__ void a_ready(const Unit&) const {}
    __device__ __forceinline__ void done(const Unit&) const {}
};

__device__ __forceinline__ unsigned cvt_pk_bf16(float lo, float hi) { unsigned r; asm volatile("v_cvt_pk_bf16_f32 %0, %1, %2" : "=v"(r) : "v"(lo), "v"(hi)); return r; }
template <class Epi, class Sched, bool ALIGN_EPI = false, bool SP2 = false>
__device__ __forceinline__ void gemm_phase(PG8_LAS unsigned char* lds, const Gemm g, const Sched& S, const Epi& E) {
    int tid_ = vtid(); asm volatile("" : "+v"(tid_)); const int tid = tid_, wid = __builtin_amdgcn_readfirstlane(tid >> 6), lane = tid & 63, wr = wid >> 2, wc = wid & 3, fr = lane & 15, fq = lane >> 4;
    int Kx_ = g.K; asm volatile("" : "+s"(Kx_)); const int K = Kx_, nt = K / BK;
    unsigned voffA[2], voffB[2];
#pragma unroll
    for (int i = 0; i < 2; ++i) { int R, C; stage_rc(tid * 16 + i * 8192, R, C); const int Rb = Epi::PERM ? ((R & ~31) + perm32(R & 31)) : R;
        voffA[i] = (unsigned)(R * g.lda + C) * 2u; voffB[i] = (unsigned)(Rb * K + C) * 2u; }
    const size_t kstep = (size_t)(BK * 2);
    const size_t hstep = (size_t)HALF * K * 2, hstepA = (size_t)HALF * g.lda * 2;
    const size_t tstep = 2 * hstep, tstepA = 2 * hstepA;
    const unsigned ldsw = (unsigned)wid * 1024u;
    const int aoff = lds_byte(wr * 64 + fr, fq * 8), boff = lds_byte(wc * 32 + fr, fq * 8);
#define PG8_SA(b, h) (((b) * 2 + (h)) * HTB)
#define PG8_SB(b, h) ((4 + (b) * 2 + (h)) * HTB)
#define PG8_STAGE(bufoff, gbase, voff) do { _Pragma("unroll") for (int _i = 0; _i < 2; ++_i) \
        __builtin_amdgcn_global_load_lds((const unsigned*)((const char*)(gbase) + (voff)[_i]), (PG8_LAS unsigned*)(lds + (bufoff) + ldsw + _i * 8192), 16, 0, 0); } while (0)
#define PG8_LDA(dst, b, h) do { _Pragma("unroll") for (int m = 0; m < 4; ++m) _Pragma("unroll") for (int k = 0; k < 2; ++k) dst[m][k] = *(const PG8_LAS bf16x8*)(lds + PG8_SA(b, h) + aoff + m * 2048 + k * 1024); } while (0)
#define PG8_LDB(dst, b, h) do { _Pragma("unroll") for (int n = 0; n < 2; ++n) _Pragma("unroll") for (int k = 0; k < 2; ++k) dst[n][k] = *(const PG8_LAS bf16x8*)(lds + PG8_SB(b, h) + boff + n * 2048 + k * 1024); } while (0)
#define PG8_MMA(ai, bj, At, Bt) do { __builtin_amdgcn_s_setprio(1); _Pragma("unroll") for (int m = 0; m < 4; ++m) _Pragma("unroll") for (int n = 0; n < 2; ++n) _Pragma("unroll") for (int k = 0; k < 2; ++k) \
        acc[ai][bj][m][n] = __builtin_amdgcn_mfma_f32_16x16x32_bf16(Bt[n][k], At[m][k], acc[ai][bj][m][n], 0, 0, 0); __builtin_amdgcn_s_setprio(0); } while (0)
#define PG8_WAIT_V(n) asm volatile("s_waitcnt vmcnt(" #n ")" ::: "memory")
#define PG8_WAIT_L(n) asm volatile("s_waitcnt lgkmcnt(" #n ")" ::: "memory")
#define PG8_BAR __builtin_amdgcn_s_barrier()
#define PG8_SCHED __builtin_amdgcn_sched_barrier(0)
    Unit cur, nxt; int ui = 0;
    if (!S.next(0, cur)) return;
#ifdef PH_SUB
#define PG8_TS(i) do { if (blockIdx.x == 0 && tid == 0) g.ts[i] = __builtin_amdgcn_s_memrealtime(); } while (0)
#else
#define PG8_TS(i) do {} while (0)
#endif
    PG8_TS(0);
    f32x4 acc[2][2][4][2];
#pragma unroll
    for (int a = 0; a < 2; ++a)
#pragma unroll
        for (int b = 0; b < 2; ++b)
#pragma unroll
            for (int m = 0; m < 4; ++m)
#pragma unroll
                for (int n = 0; n < 2; ++n) acc[a][b][m][n] = (f32x4){0.f, 0.f, 0.f, 0.f};
    bf16x8 At[4][2], B0[2][2], B1[2][2];
    const char* cA = (const char*)g.A + (size_t)cur.pm * tstepA; const char* cB = (const char*)g.Bt + (size_t)cur.pn * tstep;
    S.a_ready(cur);
    if constexpr (SP2) {
        PG8_STAGE(PG8_SB(0, 0), cB, voffB); PG8_STAGE(PG8_SB(0, 1), cB + hstep, voffB); PG8_STAGE(PG8_SA(0, 0), cA, voffA); PG8_STAGE(PG8_SA(0, 1), cA + hstepA, voffA);
        if (wr == 1) PG8_BAR;
        PG8_WAIT_V(2); PG8_BAR;
        PG8_STAGE(PG8_SB(1, 0), cB + kstep, voffB); PG8_STAGE(PG8_SA(1, 0), cA + kstep, voffA); PG8_STAGE(PG8_SB(1, 1), cB + hstep + kstep, voffB);
        PG8_WAIT_V(6); PG8_BAR;
    } else {
        PG8_STAGE(PG8_SB(0, 0), cB, voffB); PG8_STAGE(PG8_SA(0, 0), cA, voffA); PG8_STAGE(PG8_SB(0, 1), cB + hstep, voffB); PG8_STAGE(PG8_SA(0, 1), cA + hstepA, voffA);
        if (wr == 1) PG8_BAR;
        PG8_WAIT_V(4); PG8_BAR;
        PG8_STAGE(PG8_SB(1, 0), cB + kstep, voffB); PG8_STAGE(PG8_SA(1, 0), cA + kstep, voffA); PG8_STAGE(PG8_SB(1, 1), cB + hstep + kstep, voffB);
        PG8_WAIT_V(6); PG8_BAR;
    }
    for (;;) {
        const bool has_next = S.next(ui + 1, nxt);
        const char* nA = has_next ? (const char*)g.A + (size_t)nxt.pm * tstepA : cA; const char* nB = has_next ? (const char*)g.Bt + (size_t)nxt.pn * tstep : cB;
#pragma unroll 1
        for (int t = 0; t < nt; t += 2) {
            const bool last = (t == nt - 2);
            const char* a1 = cA + (size_t)(t + 1) * kstep;
            const char* a2 = last ? nA : cA + (size_t)(t + 2) * kstep; const char* b2 = last ? nB : cB + (size_t)(t + 2) * kstep;
            const char* a3 = a2 + kstep; const char* b3 = b2 + kstep;
            if (last && has_next) S.a_ready(nxt);
            if constexpr (SP2) {
            PG8_LDB(B0, 0, 0); PG8_LDB(B1, 0, 1); PG8_SCHED; PG8_LDA(At, 0, 0); PG8_STAGE(PG8_SA(1, 1), a1 + hstepA, voffA);
            PG8_WAIT_V(8); PG8_WAIT_L(0); PG8_BAR; PG8_MMA(0, 0, At, B0); PG8_MMA(0, 1, At, B1); PG8_BAR; PG8_SCHED;
            PG8_LDA(At, 0, 1); PG8_STAGE(PG8_SB(0, 0), b2, voffB); PG8_STAGE(PG8_SB(0, 1), b2 + hstep, voffB); PG8_STAGE(PG8_SA(0, 0), a2, voffA);
            PG8_WAIT_V(8); PG8_WAIT_L(0); PG8_BAR; PG8_MMA(1, 0, At, B0); PG8_MMA(1, 1, At, B1); PG8_BAR; PG8_SCHED;
            PG8_LDB(B0, 1, 0); PG8_LDB(B1, 1, 1); PG8_SCHED; PG8_LDA(At, 1, 0); PG8_STAGE(PG8_SA(0, 1), a2 + hstepA, voffA);
            PG8_WAIT_V(8); PG8_WAIT_L(0); PG8_BAR; PG8_MMA(0, 0, At, B0); PG8_MMA(0, 1, At, B1); PG8_BAR; PG8_SCHED;
            PG8_LDA(At, 1, 1); PG8_STAGE(PG8_SB(1, 0), b3, voffB); PG8_STAGE(PG8_SB(1, 1), b3 + hstep, voffB); PG8_STAGE(PG8_SA(1, 0), a3, voffA);
            PG8_WAIT_V(8); PG8_WAIT_L(0); PG8_BAR; PG8_MMA(1, 0, At, B0); PG8_MMA(1, 1, At, B1); PG8_BAR; PG8_SCHED;
            } else {
            PG8_LDB(B0, 0, 0); PG8_SCHED; PG8_LDA(At, 0, 0); PG8_STAGE(PG8_SA(1, 1), a1 + hstepA, voffA);
            PG8_WAIT_L(8); PG8_BAR; PG8_WAIT_L(0); PG8_MMA(0, 0, At, B0); PG8_BAR; PG8_SCHED;
            PG8_LDB(B1, 0, 1); PG8_STAGE(PG8_SB(0, 0), b2, voffB);
            PG8_BAR; PG8_WAIT_L(0); PG8_MMA(0, 1, At, B1); PG8_BAR;
            PG8_LDA(At, 0, 1); PG8_STAGE(PG8_SA(0, 0), a2, voffA);
            PG8_BAR; PG8_WAIT_L(0); PG8_MMA(1, 0, At, B0); PG8_BAR; PG8_SCHED;
            PG8_STAGE(PG8_SB(0, 1), b2 + hstep, voffB);
            PG8_WAIT_V(6); PG8_BAR; PG8_MMA(1, 1, At, B1); PG8_BAR;
            PG8_LDB(B0, 1, 0); PG8_SCHED; PG8_LDA(At, 1, 0); PG8_STAGE(PG8_SA(0, 1), a2 + hstepA, voffA);
            PG8_WAIT_L(8); PG8_BAR; PG8_WAIT_L(0); PG8_MMA(0, 0, At, B0); PG8_BAR; PG8_SCHED;
            PG8_LDB(B1, 1, 1); PG8_STAGE(PG8_SB(1, 0), b3, voffB);
            PG8_BAR; PG8_WAIT_L(0); PG8_MMA(0, 1, At, B1); PG8_BAR;
            PG8_LDA(At, 1, 1); PG8_STAGE(PG8_SA(1, 0), a3, voffA);
            PG8_BAR; PG8_WAIT_L(0); PG8_MMA(1, 0, At, B0); PG8_BAR; PG8_SCHED;
            PG8_STAGE(PG8_SB(1, 1), b3 + hstep, voffB);
            PG8_WAIT_V(6); PG8_BAR; PG8_MMA(1, 1, At, B1); PG8_BAR;
            }
        }
        if constexpr (ALIGN_EPI) { if (wr == 0) PG8_BAR; }
        PG8_TS(1);
        if constexpr (!Epi::AFTER_DRAIN) { E(acc, cur, wr, wc, fr, fq); S.done(cur); }
        asm volatile("" ::: "memory"); PG8_TS(2);
        if (!has_next) break;
#pragma unroll
        for (int a = 0; a < 2; ++a)
#pragma unroll
            for (int b = 0; b < 2; ++b)
#pragma unroll
                for (int m = 0; m < 4; ++m)
#pragma unroll
                    for (int n = 0; n < 2; ++n) acc[a][b][m][n] = (f32x4){0.f, 0.f, 0.f, 0.f};
        cur = nxt; cA = nA; cB = nB; ++ui;
        if constexpr (ALIGN_EPI) { if (wr == 1) PG8_BAR; }
    }
    PG8_WAIT_V(0);
    if constexpr (!ALIGN_EPI) { if (wr == 0) PG8_BAR; }
    PG8_BAR;
    if constexpr (Epi::AFTER_DRAIN) { E.fused(acc, cur, wr, wc, fr, fq, lds, wid, lane); S.done(cur); }
#undef PG8_SA
#undef PG8_SB
#undef PG8_STAGE
#undef PG8_LDA
#undef PG8_LDB
#undef PG8_MMA
#undef PG8_WAIT_V
#undef PG8_WAIT_L
#undef PG8_BAR
#undef PG8_SCHED
}
}

#define LAS __attribute__((address_space(3)))
typedef unsigned short bf16_t;
typedef short bf16x8 __attribute__((ext_vector_type(8)));
typedef short s16x4 __attribute__((ext_vector_type(4)));
typedef float f32x4 __attribute__((ext_vector_type(4)));
typedef float f32x16 __attribute__((ext_vector_type(16)));
typedef unsigned u32x4 __attribute__((ext_vector_type(4)));
typedef unsigned u32x2 __attribute__((ext_vector_type(2)));

__device__ __forceinline__ float bf2f(unsigned b) { return __uint_as_float(b << 16); }
__device__ __forceinline__ unsigned f2bf(float f) { unsigned u = __float_as_uint(f); return (u + 0x7fffu + ((u >> 16) & 1u)) >> 16; }
typedef float f32x2_t __attribute__((ext_vector_type(2))); typedef __bf16 bf16x2_t __attribute__((ext_vector_type(2)));
__device__ __forceinline__ unsigned pk2(float lo, float hi) { const f32x2_t v = {lo, hi}; const bf16x2_t b = __builtin_convertvector(v, bf16x2_t); return __builtin_bit_cast(unsigned, b); }
__device__ __forceinline__ float sigm(float x) { return 1.0f / (1.0f + __expf(-x)); }
__device__ __forceinline__ f32x4 up4(u32x2 v) { return (f32x4){__uint_as_float(v.x << 16), __uint_as_float(v.x & 0xffff0000u), __uint_as_float(v.y << 16), __uint_as_float(v.y & 0xffff0000u)}; }
__device__ __forceinline__ u32x2 dn4(f32x4 v) { u32x2 r; r.x = pk2(v.x, v.y); r.y = pk2(v.z, v.w); return r; }
__device__ __forceinline__ float dot4(f32x4 a, f32x4 b) { return (a.x * b.x + a.y * b.y) + (a.z * b.z + a.w * b.w); }

constexpr size_t MiB = 1u << 20;
constexpr size_t WS_CTL = 0, CTL_ZERO_BYTES = 2 * MiB;
constexpr size_t WS_STAT = 1 * MiB;
constexpr size_t WS_CS = 2 * MiB;
constexpr size_t WS_W = 4 * MiB;
constexpr size_t W_IN = 0, W_LORA = W_IN + (size_t)PC * 1024 * 2, W_Q = W_LORA + 1536 * 256 * 2, W_KV = W_Q + 768 * 256 * 2,
                 W_OA = W_KV + 1024 * 256 * 2, W_OB = W_OA + 1024 * 512 * 2, W_OUT = W_OB + 1024 * 512 * 2,
                 W_UP = W_OUT + 1024 * 1024 * 2, W_DOWN = W_UP + (size_t)2 * FF * 1024 * 2, W_END = W_DOWN + (size_t)1024 * FF * 2;
static_assert(W_END <= 31 * MiB, "weights region");
constexpr size_t WS_ACT = 35 * MiB;
constexpr size_t A_HB = WS_ACT + 0 * MiB;
constexpr size_t A_RKV = WS_ACT + 32 * MiB;
constexpr size_t A_LORAC = WS_ACT + 80 * MiB;
constexpr size_t A_QP = A_LORAC;
constexpr size_t A_PM = WS_ACT + 88 * MiB;
constexpr size_t A_Y = A_PM;
constexpr size_t A_LIN = WS_ACT + 104 * MiB;
constexpr size_t A_KPE = WS_ACT + 112 * MiB;
constexpr size_t WS_SCAL = WS_ACT + 113 * MiB;
constexpr size_t A_LW = WS_ACT + 114 * MiB;
constexpr size_t A_YA = A_LW;
constexpr size_t A_ICLR = WS_ACT + 130 * MiB;
constexpr size_t A_GATE = WS_ACT + 146 * MiB;
constexpr size_t A_MERGED = A_ICLR;
constexpr size_t A_QN = WS_ACT + 162 * MiB;
constexpr size_t A_KN = WS_ACT + 178 * MiB;
constexpr size_t A_VT = WS_ACT + 194 * MiB;
constexpr size_t A_TMP = WS_ACT + 32 * MiB;
constexpr size_t A_UG = WS_ACT + 32 * MiB;
constexpr size_t A_ACT = WS_ACT + 120 * MiB;
constexpr size_t DO_MTREC = 32 * MiB, MTREC_B = 2304, DO_HALO = DO_MTREC + (size_t)8192 * MTREC_B;
static_assert(DO_HALO + (size_t)(M / 16) * 1536 * 2 <= 64 * MiB, "d_out scratch map");
constexpr size_t WS_SSP = WS_ACT + 210 * MiB;
constexpr size_t WS_SSQP = WS_SSP + 5 * MiB;
constexpr size_t WS_END = WS_SSQP + 1 * MiB;
static_assert(A_UG + (size_t)M * FF * 2 <= A_ACT && A_ACT + (size_t)M * FF * 2 <= WS_SSP && WS_END <= 256 * MiB, "workspace map");
static_assert(A_ICLR == A_LW + (size_t)M * 512 * 2 && A_GATE == A_ICLR + (size_t)M * 512 * 2, "LW | ICLR | GATE consecutive");
constexpr int CW_BAR = 4096, CW_QUEUE = 16384;

#define XB_TMO      128
#define XB_XCNT(j)  (256  + 64 * (j))
#define XB_XSUB(j)  (1280 + 64 * (j))
#define XB_XGEN(j)  (2304 + 64 * (j))
#define XB_TOP      3328
#define XB_TOPGEN   3392
#define XCD_BAR_WORDS 3456
#define XB_SPIN_CAP (1u << 18)
__device__ __forceinline__ unsigned xb_ld(unsigned* p)              { return __hip_atomic_load(p, __ATOMIC_RELAXED, __HIP_MEMORY_SCOPE_AGENT); }
__device__ __forceinline__ unsigned xb_add(unsigned* p, unsigned v) { return __hip_atomic_fetch_add(p, v, __ATOMIC_RELAXED, __HIP_MEMORY_SCOPE_AGENT); }
__device__ __forceinline__ unsigned xb_xcc_id() { return (unsigned)__builtin_amdgcn_s_getreg((3 << 11) | 20) & 0xFu; }
#define XB_SPIN(cond, bar) do { unsigned _sp = 0; while (cond) { __builtin_amdgcn_s_sleep(1); \
    if ((++_sp & 255u) == 0u) { if (xb_ld(&(bar)[XB_TMO])) break; if (_sp > XB_SPIN_CAP) { atomicAdd(&(bar)[XB_TMO], 1u); break; } } } } while (0)
struct XcdBarrier { unsigned* bar; unsigned x; volatile LAS unsigned* st; };
__device__ __forceinline__ XcdBarrier xcd_barrier_post(unsigned* bar, volatile LAS unsigned* st) {
    XcdBarrier b; b.bar = bar; b.x = xb_xcc_id(); b.st = st;
    if (vtid() == 0) (void)xb_add(&bar[XB_XCNT(b.x)], 1u);
    return b;
}
__device__ __forceinline__ void xcd_barrier_complete(unsigned* bar, unsigned x, unsigned& nloc, unsigned& nx) {
    const unsigned G = gridDim.x * gridDim.y * gridDim.z;
    unsigned sum, cnt, mine, sp = 0u;
    for (;;) {
        sum = 0u; cnt = 0u; mine = 0u;
#pragma unroll
        for (unsigned j = 0; j < 16; ++j) { const unsigned c = xb_ld(&bar[XB_XCNT(j)]); sum += c; cnt += (c > 0u) ? 1u : 0u; mine = (j == x) ? c : mine; }
        if (sum == G) break;
        __builtin_amdgcn_s_sleep(1);
        if ((++sp & 255u) == 0u) { if (xb_ld(&bar[XB_TMO])) break; if (sp > XB_SPIN_CAP) { atomicAdd(&bar[XB_TMO], 1u); break; } }
    }
    nloc = mine > 0u ? mine : 1u; nx = cnt > 0u ? cnt : 1u;
}
__device__ __forceinline__ void xcd_barrier(const XcdBarrier& b) {
    asm volatile("s_waitcnt vmcnt(0)" ::: "memory");
    __syncthreads();
    if (vtid() == 0) {
        unsigned* bar = b.bar;
        __builtin_amdgcn_s_waitcnt(0);
        unsigned nloc = b.st[0], nx = b.st[1];
        if (nloc == 0u) { xcd_barrier_complete(bar, b.x, nloc, nx); b.st[0] = nloc; b.st[1] = nx; }
        const unsigned old = xb_add(&bar[XB_XSUB(b.x)], 1u);
        const unsigned gen = old / nloc;
        if (old + 1u == (gen + 1u) * nloc) {
            __builtin_amdgcn_fence(__ATOMIC_RELEASE, "agent");
            asm volatile("s_waitcnt vmcnt(0)" ::: "memory");
            const unsigned og = xb_add(&bar[XB_TOP], 1u);
            const unsigned tg = og / nx;
            if (og + 1u == (tg + 1u) * nx) xb_add(&bar[XB_TOPGEN], 1u);
            else XB_SPIN(xb_ld(&bar[XB_TOPGEN]) == tg, bar);
            __builtin_amdgcn_fence(__ATOMIC_ACQUIRE, "agent");
            xb_add(&bar[XB_XGEN(b.x)], 1u);
            asm volatile("s_waitcnt vmcnt(0)" ::: "memory");
        } else {
            XB_SPIN(xb_ld(&bar[XB_XGEN(b.x)]) == gen, bar);
            __builtin_amdgcn_fence(__ATOMIC_ACQUIRE, "agent");
            asm volatile("s_waitcnt vmcnt(0)" ::: "memory");
        }
    }
    __syncthreads();
}

namespace pg8 {
__device__ __forceinline__ float sum16(const float* p) { const f32x4 a = *(const f32x4*)p, b = *(const f32x4*)(p + 4), c = *(const f32x4*)(p + 8), d = *(const f32x4*)(p + 12);
    return (((a.x + a.y) + (a.z + a.w)) + ((b.x + b.y) + (b.z + b.w))) + (((c.x + c.y) + (c.z + c.w)) + ((d.x + d.y) + (d.z + d.w))); }
__device__ __forceinline__ float sum4(const float* p) { const f32x4 a = *(const f32x4*)p; return (a.x + a.y) + (a.z + a.w); }
__device__ __forceinline__ u32x4 pack8(f32x4 a, f32x4 b) { u32x4 w; w.x = cvt_pk_bf16(a[0], a[1]); w.y = cvt_pk_bf16(a[2], a[3]); w.z = cvt_pk_bf16(b[0], b[1]); w.w = cvt_pk_bf16(b[2], b[3]); return w; }
__device__ __forceinline__ unsigned q8(float s) { return (unsigned)(s * 255.0f + 0.5f); }
__device__ __forceinline__ unsigned sig8x4(f32x4 v) { return q8(sigm(v[0])) | (q8(sigm(v[1])) << 8) | (q8(sigm(v[2])) << 16) | (q8(sigm(v[3])) << 24); }

constexpr int RS_OFF = 131072 + 1024;
#ifndef NT_STORES
#define NT_STORES 0
#endif
#ifndef NT_STORES8
#define NT_STORES8 0
#endif
__device__ __forceinline__ void ST16(bf16_t* p, u32x4 v) {
    if (NT_STORES == 1) __builtin_nontemporal_store(v, (u32x4*)p);
    else if (NT_STORES == 2) asm volatile("global_store_dwordx4 %0, %1, off sc1\n\ts_nop 1" :: "v"(p), "v"(v) : "memory");
    else if (NT_STORES == 3) asm volatile("global_store_dwordx4 %0, %1, off sc0 sc1\n\ts_nop 1" :: "v"(p), "v"(v) : "memory");
    else *(u32x4*)p = v; }
#ifndef NT_UP
#define NT_UP 1
#endif
__device__ __forceinline__ void ST16W(bf16_t* p, u32x4 v) { if (NT_UP) asm volatile("global_store_dwordx4 %0, %1, off sc1\n\ts_nop 1" :: "v"(p), "v"(v) : "memory"); else *(u32x4*)p = v; }
__device__ __forceinline__ void ST8W(void* p, u32x2 v) { asm volatile("global_store_dwordx2 %0, %1, off sc1\n\ts_nop 1" :: "v"(p), "v"(v) : "memory"); }
#ifndef SC1_MIX
#define SC1_MIX 0
#endif
#ifndef SC1_RES
#define SC1_RES 0
#endif
#ifndef SC1_QKV
#define SC1_QKV 0
#endif
template <int W> __device__ __forceinline__ void ST16S(bf16_t* p, u32x4 v) { if (W) asm volatile("global_store_dwordx4 %0, %1, off sc1\n\ts_nop 1" :: "v"(p), "v"(v) : "memory"); else *(u32x4*)p = v; }
template <int W> __device__ __forceinline__ void ST8S(bf16_t* p, u32x2 v) { if (W) asm volatile("global_store_dwordx2 %0, %1, off sc1\n\ts_nop 1" :: "v"(p), "v"(v) : "memory"); else *(u32x2*)p = v; }
__device__ __forceinline__ void ST8(bf16_t* p, u32x2 v) {
    if (NT_STORES8 == 2) asm volatile("global_store_dwordx2 %0, %1, off sc1\n\ts_nop 1" :: "v"(p), "v"(v) : "memory");
    else *(u32x2*)p = v; }
template <int NS> __device__ __forceinline__ void rs_to_lds(PG8_LAS float* rsl, const float* ss, int pm, float inv_n, float mul, int tid) {
    if (tid < 256) { const float* p = ss + (size_t)(pm * BM + tid) * NS; const float s_ = NS == 16 ? sum16(p) : sum4(p); rsl[tid] = rsqrtf(s_ * inv_n + NORM_EPS) * mul; }
    asm volatile("s_waitcnt lgkmcnt(0)" ::: "memory"); __builtin_amdgcn_s_barrier();
}
struct EpiP {
    static constexpr bool PERM = true, AFTER_DRAIN = false;
    bf16_t* RKV; bf16_t* LORAC; bf16_t* PMb; unsigned char* G8; const float* ss; float* ssq; float* sskv; bf16_t* HALO; PG8_LAS float* rsl; int pn0;
    __device__ __forceinline__ void operator()(const f32x4 (&acc)[2][2][4][2], const Unit& u, int wr, int wc, int fr, int fq) const {
        const int row0 = u.pm * BM + wr * 64 + fr, pn = u.pn + pn0;
        rs_to_lds<16>(rsl, ss, u.pm, 1.0f / 1024.0f, 1.0f, (wr * 4 + wc) * 64 + fq * 16 + fr);
#pragma unroll
        for (int ai = 0; ai < 2; ++ai)
#pragma unroll
            for (int m = 0; m < 4; ++m) {
                const int row = row0 + ai * HALF + m * 16;
                const float rs = rsl[wr * 64 + ai * HALF + m * 16 + fr];
                float sq = 0.f;
#pragma unroll
                for (int bj = 0; bj < 2; ++bj) {
                    const f32x4 v0 = acc[ai][bj][m][0] * rs, v1 = acc[ai][bj][m][1] * rs;
                    const int ct = bj * HALF + wc * 32 + 8 * fq;
                    if (pn < 6) { const u32x4 pk_ = pack8(v0, v1); ST16(RKV + (size_t)row * 1536 + pn * 256 + ct, pk_); if (fr == 15) *(u32x4*)(HALO + (size_t)(row >> 4) * 1536 + pn * 256 + ct) = pk_; }
                    else if (pn == 6) ST16(LORAC + (size_t)row * 256 + ct, pack8(v0, v1));
                    else if (pn < 9) { ST16(PMb + (size_t)row * 512 + (pn - 7) * 256 + ct, pack8(v0, v1));
                        if (pn == 7 || bj == 0) sq += dot4(v0, v0) + dot4(v1, v1); }
                    else { u32x2 w; w.x = sig8x4(v0); w.y = sig8x4(v1); ST8((bf16_t*)(G8 + (size_t)row * 2048 + (pn - 9) * 256 + ct), w); }
                }
                if (pn == 7 || pn == 8) { sq += shx(sq, 16); sq += shx(sq, 32); if (fq == 0) (pn == 7 ? ssq : sskv)[(size_t)row * 4 + wc] = sq; }
            }
    }
};
#ifndef LW_CUM
#define LW_CUM 1
#endif
template <int CTRL> __device__ __forceinline__ float dppz(float x) { return __builtin_bit_cast(float, __builtin_amdgcn_update_dpp(0, __builtin_bit_cast(int, x), CTRL, 0xf, 0xf, true)); }
__device__ __forceinline__ float pfx16(float x) { x += dppz<0x111>(x); x += dppz<0x112>(x); x += dppz<0x114>(x); x += dppz<0x118>(x); return x; }
struct EpiLora {
    static constexpr bool PERM = true, AFTER_DRAIN = false;
    bf16_t* LW; bf16_t* ICLR; bf16_t* GATE; const float* dbase; const float* ibase;
    __device__ __forceinline__ void operator()(const f32x4 (&acc)[2][2][4][2], const Unit& u, int wr, int wc, int fr, int fq) const {
        const int pn = u.pn, kind = pn >> 1;
        bf16_t* dst = LW + (size_t)kind * ((size_t)M * 512);
        const float* bias = kind == 0 ? dbase : ibase;
        const unsigned c0 = (pn & 1) * 256 + wc * 32 + 8 * fq;
        const unsigned off0 = (unsigned)(u.pm * BM + wr * 64 + fr) * 512u + c0;
#pragma unroll
        for (int bj = 0; bj < 2; ++bj) {
            f32x4 b0 = (f32x4){0.f, 0.f, 0.f, 0.f}, b1 = b0;
            if (kind < 2) { b0 = *(const f32x4*)(bias + c0 + bj * HALF); b1 = *(const f32x4*)(bias + c0 + bj * HALF + 4); }
#pragma unroll
            for (int ai = 0; ai < 2; ++ai)
#pragma unroll
                for (int m = 0; m < 4; ++m) {
                    f32x4 v0 = acc[ai][bj][m][0] + b0, v1 = acc[ai][bj][m][1] + b1;
                    if (kind == 0) { for (int e = 0; e < 4; ++e) { v0[e] = -0.6065306597126334f * sigm(v0[e]); v1[e] = -0.6065306597126334f * sigm(v1[e]); }
                        if (LW_CUM) { for (int e = 0; e < 4; ++e) { v0[e] = __expf(pfx16(v0[e])); v1[e] = __expf(pfx16(v1[e])); } } }
                    else if (kind == 1) { for (int e = 0; e < 4; ++e) { v0[e] = sigm(v0[e]); v1[e] = sigm(v1[e]); } }
                    ST16(dst + off0 + (unsigned)((ai * HALF + m * 16) * 512 + bj * HALF), pack8(v0, v1));
                    asm volatile("" ::: "memory");
                }
        }
    }
};
struct EpiQ {
    static constexpr bool PERM = false, AFTER_DRAIN = false;
    bf16_t* Qn; bf16_t* Qp; const float* ssq; const float* CS; PG8_LAS float* rsl;
    __device__ __forceinline__ void operator()(const f32x4 (&acc)[2][2][4][2], const Unit& u, int wr, int wc, int fr, int fq) const {
        const int row0 = u.pm * BM + wr * 64 + fr, pn = u.pn;
        if (pn < 2) {
            rs_to_lds<4>(rsl, ssq, u.pm, 1.0f / 256.0f, C2, (wr * 4 + wc) * 64 + fq * 16 + fr);
#pragma unroll
            for (int ai = 0; ai < 2; ++ai)
#pragma unroll
                for (int m = 0; m < 4; ++m) {
                    const int row = row0 + ai * HALF + m * 16;
                    const float rs = rsl[wr * 64 + ai * HALF + m * 16 + fr];
#pragma unroll
                    for (int bj = 0; bj < 2; ++bj)
#pragma unroll
                        for (int n = 0; n < 2; ++n) ST8S<SC1_QKV>(Qn + (size_t)row * 512 + pn * 256 + bj * HALF + wc * 32 + n * 16 + 4 * fq, dn4(acc[ai][bj][m][n] * rs));
                }
        } else {
            f32x4 cs[2][4], sn[2][4];
#pragma unroll
            for (int ai = 0; ai < 2; ++ai)
#pragma unroll
                for (int m = 0; m < 4; ++m) { const int row = row0 + ai * HALF + m * 16; cs[ai][m] = *(const f32x4*)(CS + (size_t)row * 32 + 4 * fq); sn[ai][m] = *(const f32x4*)(CS + (size_t)row * 32 + 16 + 4 * fq); }
            rs_to_lds<4>(rsl, ssq, u.pm, 1.0f / 256.0f, C2, (wr * 4 + wc) * 64 + fq * 16 + fr);
#pragma unroll
            for (int ai = 0; ai < 2; ++ai)
#pragma unroll
                for (int m = 0; m < 4; ++m) {
                    const int row = row0 + ai * HALF + m * 16;
                    const float rs = rsl[wr * 64 + ai * HALF + m * 16 + fr];
#pragma unroll
                    for (int bj = 0; bj < 2; ++bj) {
                        const f32x4 x1 = acc[ai][bj][m][0] * rs, x2 = acc[ai][bj][m][1] * rs;
                        bf16_t* d = Qp + (size_t)row * 256 + (4 * bj + wc) * 32 + 4 * fq;
                        ST8S<SC1_QKV>(d, dn4(x1 * cs[ai][m] - x2 * sn[ai][m])); ST8S<SC1_QKV>(d + 16, dn4(x1 * sn[ai][m] + x2 * cs[ai][m]));
                    }
                }
        }
    }
};
struct EpiKV {
    static constexpr bool PERM = false, AFTER_DRAIN = false;
    bf16_t* Kn; bf16_t* Vt; const float* sskv; PG8_LAS float* rsl;
    __device__ __forceinline__ void operator()(const f32x4 (&acc)[2][2][4][2], const Unit& u, int wr, int wc, int fr, int fq) const {
        const int row0 = u.pm * BM + wr * 64 + fr, pn = u.pn;
        rs_to_lds<4>(rsl, sskv, u.pm, 1.0f / 128.0f, 1.0f, (wr * 4 + wc) * 64 + fq * 16 + fr);
#pragma unroll
        for (int ai = 0; ai < 2; ++ai)
#pragma unroll
            for (int m = 0; m < 4; ++m) {
                const int row = row0 + ai * HALF + m * 16;
                const float rs = rsl[wr * 64 + ai * HALF + m * 16 + fr];
                if (pn < 2) {
#pragma unroll
                    for (int bj = 0; bj < 2; ++bj)
#pragma unroll
                        for (int n = 0; n < 2; ++n) ST8S<SC1_QKV>(Kn + (size_t)row * 512 + pn * 256 + bj * HALF + wc * 32 + n * 16 + 4 * fq, dn4(acc[ai][bj][m][n] * rs));
                } else {
                    const int b = row >> 12, s = row & 4095;
#pragma unroll
                    for (int bj = 0; bj < 2; ++bj)
#pragma unroll
                        for (int n = 0; n < 2; ++n) {
                            const int hd = (pn - 2) * 4 + 2 * bj + (wc >> 1), d = 32 * (wc & 1) + 16 * n + 4 * fq;
                            const f32x4 v = acc[ai][bj][m][n] * rs;
                            bf16_t* dst = Vt + ((size_t)((b * 8 + hd) * 64 + d) << 12) + s;
#pragma unroll
                            for (int j = 0; j < 4; ++j) dst[(size_t)j << 12] = (bf16_t)f2bf(v[j]);
                        }
                }
            }
    }
};
template <int PASS> struct EpiMix {
    static constexpr bool PERM = true, AFTER_DRAIN = false;
    float* TMP; bf16_t* MERGED; const unsigned char* G8;
    template <int AI> __device__ __forceinline__ void load(u32x2 (&g)[4][2], u32x4 (&t)[4][2], int row0, int c0) const {
#pragma unroll
        for (int m = 0; m < 4; ++m)
#pragma unroll
            for (int bj = 0; bj < 2; ++bj) { const size_t row = (size_t)(row0 + AI * HALF + m * 16); const int c = c0 + bj * HALF;
                g[m][bj] = *(const u32x2*)(G8 + row * 2048 + (PASS - 1) * 1024 + c);
                if (PASS == 2) t[m][bj] = *(const u32x4*)(MERGED + row * 1024 + c); }
    }
    template <int AI> __device__ __forceinline__ void calc(const f32x4 (&acc)[2][2][4][2], const u32x2 (&g)[4][2], u32x4 (&t)[4][2]) const {
#pragma unroll
        for (int m = 0; m < 4; ++m)
#pragma unroll
            for (int bj = 0; bj < 2; ++bj) { const unsigned ga = g[m][bj].x, gb = g[m][bj].y;
                const f32x4 sa = (f32x4){(float)(ga & 255u), (float)((ga >> 8) & 255u), (float)((ga >> 16) & 255u), (float)(ga >> 24)} * (1.0f / 255.0f);
                const f32x4 sb = (f32x4){(float)(gb & 255u), (float)((gb >> 8) & 255u), (float)((gb >> 16) & 255u), (float)(gb >> 24)} * (1.0f / 255.0f);
                f32x4 oa = acc[AI][bj][m][0] * sa, ob = acc[AI][bj][m][1] * sb;
                if (PASS == 2) { oa = oa + up4((u32x2){t[m][bj].x, t[m][bj].y}); ob = ob + up4((u32x2){t[m][bj].z, t[m][bj].w}); }
                const u32x2 pa = dn4(oa), pb = dn4(ob); t[m][bj] = (u32x4){pa.x, pa.y, pb.x, pb.y}; }
    }
    template <int AI> __device__ __forceinline__ void store(const u32x4 (&o)[4][2], int row0, int c0) const {
#pragma unroll
        for (int m = 0; m < 4; ++m)
#pragma unroll
            for (int bj = 0; bj < 2; ++bj) ST16S<SC1_MIX>(MERGED + (size_t)(row0 + AI * HALF + m * 16) * 1024 + c0 + bj * HALF, o[m][bj]);
    }
    __device__ __forceinline__ void operator()(const f32x4 (&acc)[2][2][4][2], const Unit& u, int wr, int wc, int fr, int fq) const {
        const int row0 = u.pm * BM + wr * 64 + fr, c0 = u.pn * BM + wc * 32 + 8 * fq;
        u32x2 g0[4][2], g1[4][2]; u32x4 t0[4][2], t1[4][2];
        load<0>(g0, t0, row0, c0); calc<0>(acc, g0, t0);
        load<1>(g1, t1, row0, c0);
        store<0>(t0, row0, c0);
        calc<1>(acc, g1, t1); store<1>(t1, row0, c0);
    }
};
struct EpiRes {
    static constexpr bool PERM = false, AFTER_DRAIN = false;
    bf16_t* HB; float* ssacc;
    __device__ __forceinline__ void operator()(const f32x4 (&acc)[2][2][4][2], const Unit& u, int wr, int wc, int fr, int fq) const {
        const int row0 = u.pm * BM + wr * 64 + fr, c0 = u.pn * BM + wc * 32 + 4 * fq;
        u32x2 b[2][4][2][2];
#pragma unroll
        for (int ai = 0; ai < 2; ++ai)
#pragma unroll
            for (int m = 0; m < 4; ++m)
#pragma unroll
                for (int bj = 0; bj < 2; ++bj)
#pragma unroll
                    for (int n = 0; n < 2; ++n) b[ai][m][bj][n] = *(const u32x2*)(HB + (size_t)(row0 + ai * HALF + m * 16) * 1024 + c0 + bj * HALF + n * 16);
#pragma unroll
        for (int ai = 0; ai < 2; ++ai)
#pragma unroll
            for (int m = 0; m < 4; ++m) {
                const int row = row0 + ai * HALF + m * 16; float sq = 0.f;
#pragma unroll
                for (int bj = 0; bj < 2; ++bj)
#pragma unroll
                    for (int n = 0; n < 2; ++n) {
                        const u32x2 p = dn4(up4(b[ai][m][bj][n]) + acc[ai][bj][m][n]); const f32x4 v = up4(p);
                        ST8S<SC1_RES>(HB + (size_t)row * 1024 + c0 + bj * HALF + n * 16, p); sq += dot4(v, v);
                    }
                sq += shx(sq, 16); sq += shx(sq, 32);
                if (fq == 0) ssacc[(size_t)row * 16 + u.pn * 4 + wc] = sq;
            }
    }
};
typedef float f32x2 __attribute__((ext_vector_type(2)));
__device__ __forceinline__ f32x2 gelu_pk2(f32x2 v) {
    const f32x2 av = __builtin_elementwise_abs(v), d = av * 0.2316418882f + 1.0f;
    f32x2 t; t.x = __builtin_amdgcn_rcpf(d.x); t.y = __builtin_amdgcn_rcpf(d.y);
    f32x2 q = t * 0.5307027145f + (-0.7265760135f); q = q * t + 0.7107068705f; q = q * t + (-0.142248368f); q = q * t + 0.127414796f; q = q * t;
    const f32x2 s2 = (v * v) * (-0.72134752044f);
    f32x2 e; e.x = __builtin_amdgcn_exp2f(s2.x); e.y = __builtin_amdgcn_exp2f(s2.y);
    const f32x2 m = v * (q * e), r = v - m;
    f32x2 o; o.x = v.x < 0.f ? m.x : r.x; o.y = v.y < 0.f ? m.y : r.y; return o;
}
__device__ __forceinline__ f32x4 gelu4(f32x4 c) { const f32x2 g0 = gelu_pk2((f32x2){c.x, c.y}), g1 = gelu_pk2((f32x2){c.z, c.w}); return (f32x4){g0.x, g0.y, g1.x, g1.y}; }
template <int CTRL> __device__ __forceinline__ f32x4 ror4(f32x4 x) { f32x4 r;
#pragma unroll
    for (int e = 0; e < 4; ++e) { const float xe = x[e]; const int xi = __builtin_bit_cast(int, xe); r[e] = __builtin_bit_cast(float, __builtin_amdgcn_update_dpp(xi, xi, CTRL, 0xf, 0xf, false)); }
    return r; }
struct EpiUp {
    static constexpr bool PERM = true, AFTER_DRAIN = false;
    bf16_t* ACT; bf16_t* RAWH; const float* ss; const float* cw; const float* cb; PG8_LAS float* rsl;
    __device__ __forceinline__ void operator()(const f32x4 (&acc)[2][2][4][2], const Unit& u, int wr, int wc, int fr, int fq) const {
        const int tid = (wr * 4 + wc) * 64 + fq * 16 + fr, row0 = u.pm * BM + wr * 64 + fr;
        PG8_LAS float* wl = rsl + 256;
        if (tid >= 256 && tid < 384) { const int j = tid - 256, cg = u.pn * HALF + j; wl[j] = cw[cg]; wl[128 + j] = cw[FF + cg]; wl[256 + j] = cw[2 * FF + cg]; wl[384 + j] = cb[cg]; }
        rs_to_lds<16>(rsl, ss, u.pm, 1.0f / 1024.0f, 1.0f, tid);
        const int cl = wc * 32 + 8 * fq, cgl = u.pn * HALF + cl;
#pragma unroll
        for (int ai = 0; ai < 2; ++ai) {
            f32x4 q1a, q1b, q2a, q2b;
#pragma unroll
            for (int m = 0; m < 4; ++m) {
                const int row = row0 + ai * HALF + m * 16;
                const float rs = rsl[wr * 64 + ai * HALF + m * 16 + fr];
                const PG8_LAS float* wp = wl + cl; asm volatile("" : "+v"(wp));
                const f32x4 w0a = *(const PG8_LAS f32x4*)(wp), w0b = *(const PG8_LAS f32x4*)(wp + 4), w1a = *(const PG8_LAS f32x4*)(wp + 128), w1b = *(const PG8_LAS f32x4*)(wp + 128 + 4);
                const f32x4 w2a = *(const PG8_LAS f32x4*)(wp + 256), w2b = *(const PG8_LAS f32x4*)(wp + 256 + 4), ba = *(const PG8_LAS f32x4*)(wp + 384), bb = *(const PG8_LAS f32x4*)(wp + 384 + 4);
                const f32x4 xa = acc[ai][0][m][0] * rs, xb = acc[ai][0][m][1] * rs, va = acc[ai][1][m][0] * rs, vb = acc[ai][1][m][1] * rs;
                const f32x4 r1a = ror4<0x121>(xa), r1b = ror4<0x121>(xb), r2a = ror4<0x122>(xa), r2b = ror4<0x122>(xb);
                f32x4 p1a = r1a, p1b = r1b, p2a = r2a, p2b = r2b;
                if (m > 0) { if (fr < 1) { p1a = q1a; p1b = q1b; } if (fr < 2) { p2a = q2a; p2b = q2b; } }
                const f32x4 ga = gelu4(ba + w0a * p2a + w1a * p1a + w2a * xa), gb = gelu4(bb + w0b * p2b + w1b * p1b + w2b * xb);
                if (m > 0 || fr >= 2) ST16W(ACT + (size_t)row * FF + cgl, pack8(ga * va, gb * vb));
                if (m == 0) { if (fr < 2) { bf16_t* hp = RAWH + ((size_t)(row >> 6) * 6 + 2 + fr) * FF + cgl; *(u32x4*)hp = pack8(xa, xb); *(u32x4*)(hp + 2 * FF) = pack8(va, vb); } }
                if (m == 3) { if (fr >= 14) *(u32x4*)(RAWH + ((size_t)(row >> 6) * 6 + (fr - 14)) * FF + cgl) = pack8(xa, xb); }
                q1a = r1a; q1b = r1b; q2a = r2a; q2b = r2b;
            }
        }
    }
};
struct EpiUpG {
    static constexpr bool PERM = true, AFTER_DRAIN = false;
    bf16_t* UG; const float* ss; PG8_LAS float* rsl;
    __device__ __forceinline__ void operator()(const f32x4 (&acc)[2][2][4][2], const Unit& u, int wr, int wc, int fr, int fq) const {
        const int row0 = u.pm * BM + wr * 64 + fr;
        rs_to_lds<16>(rsl, ss, u.pm, 1.0f / 1024.0f, 1.0f, (wr * 4 + wc) * 64 + fq * 16 + fr);
#pragma unroll
        for (int ai = 0; ai < 2; ++ai)
#pragma unroll
            for (int m = 0; m < 4; ++m) {
                const int row = row0 + ai * HALF + m * 16;
                const float rs = rsl[wr * 64 + ai * HALF + m * 16 + fr];
#pragma unroll
                for (int bj = 0; bj < 2; ++bj) ST16(UG + (size_t)row * FF + u.pn * BM + bj * HALF + wc * 32 + 8 * fq, pack8(acc[ai][bj][m][0] * rs, acc[ai][bj][m][1] * rs));
            }
    }
};
struct EpiUpV {
    static constexpr bool PERM = true, AFTER_DRAIN = false;
    bf16_t* ACT; const float* ss; PG8_LAS float* rsl;
    __device__ __forceinline__ void operator()(const f32x4 (&acc)[2][2][4][2], const Unit& u, int wr, int wc, int fr, int fq) const {
        const int row0 = u.pm * BM + wr * 64 + fr, c0 = u.pn * BM + wc * 32 + 8 * fq;
        u32x4 gc[2][4][2];
#pragma unroll
        for (int ai = 0; ai < 2; ++ai)
#pragma unroll
            for (int m = 0; m < 4; ++m)
#pragma unroll
                for (int bj = 0; bj < 2; ++bj) gc[ai][m][bj] = *(const u32x4*)(ACT + (size_t)(row0 + ai * HALF + m * 16) * FF + c0 + bj * HALF);
        rs_to_lds<16>(rsl, ss, u.pm, 1.0f / 1024.0f, 1.0f, (wr * 4 + wc) * 64 + fq * 16 + fr);
#pragma unroll
        for (int ai = 0; ai < 2; ++ai)
#pragma unroll
            for (int m = 0; m < 4; ++m) {
                const int row = row0 + ai * HALF + m * 16;
                const float rs = rsl[wr * 64 + ai * HALF + m * 16 + fr];
#pragma unroll
                for (int bj = 0; bj < 2; ++bj) { const u32x4 g = gc[ai][m][bj];
                    *(u32x4*)(ACT + (size_t)row * FF + c0 + bj * HALF) = pack8(up4((u32x2){g.x, g.y}) * (acc[ai][bj][m][0] * rs), up4((u32x2){g.z, g.w}) * (acc[ai][bj][m][1] * rs)); }
            }
    }
};
}


#ifndef NAIVE_GEMM
#define NAIVE_GEMM 0
#endif
#ifndef NAIVE_ATTN
#define NAIVE_ATTN 0
#endif
#ifndef SHFL_SCAN
#define SHFL_SCAN 0
#endif
namespace pg8 {
template <class Epi, class Sched>
__device__ __forceinline__ void gemm_phase_naive(const Gemm g, const Sched& S, const Epi& E) {
    const int tid = vtid(), wid = tid >> 6, lane = tid & 63, wr = wid >> 2, wc = wid & 3, fr = lane & 15, fq = lane >> 4;
    Unit u;
    for (int i = 0; S.next(i, u); ++i) {
        f32x4 acc[2][2][4][2];
        _Pragma("unroll") for (int a = 0; a < 2; ++a) _Pragma("unroll") for (int b = 0; b < 2; ++b) _Pragma("unroll") for (int m = 0; m < 4; ++m) _Pragma("unroll") for (int n = 0; n < 2; ++n) {
            const int row = u.pm * BM + a * HALF + wr * 64 + m * 16 + fr;
            _Pragma("unroll") for (int j = 0; j < 4; ++j) {
                const int col = u.pn * BM + b * HALF + wc * 32 + (Epi::PERM ? 8 * fq + 4 * n + j : 16 * n + 4 * fq + j);
                const bf16_t* ap = g.A + (size_t)row * g.lda; const bf16_t* bp = g.Bt + (size_t)col * g.K;
                float s = 0.f;
                _Pragma("unroll 1") for (int k = 0; k < g.K; k += 8) {
                    const u32x4 av = *(const u32x4*)(ap + k), bv = *(const u32x4*)(bp + k);
                    for (int e = 0; e < 4; ++e) { s += __uint_as_float(av[e] << 16) * __uint_as_float(bv[e] << 16); s += __uint_as_float(av[e] & 0xffff0000u) * __uint_as_float(bv[e] & 0xffff0000u); }
                }
                acc[a][b][m][n][j] = s;
            }
        }
        E(acc, u, wr, wc, fr, fq);
    }
}
}
#if NAIVE_GEMM
#define GEMM_PHASE(EPI, lds, g, S, E) pg8::gemm_phase_naive<EPI, pg8::StaticOrder>(g, S, E)
#else
#define GEMM_PHASE(EPI, lds, g, S, E) pg8::gemm_phase<EPI, pg8::StaticOrder, true, true>(lds, g, S, E)
#endif
struct Args {
    const float* in[28]; float* out; unsigned char* ws; int ph_lo, ph_hi;
};
enum { I_X = 0, I_POS, I_ATTN_NORM, I_W_IN, I_MU, I_DBASE, I_W_DEC, I_IBASE, I_W_ICLR, I_W_GATE, I_KK, I_KA, I_RK, I_LNXW, I_LNXB, I_W_ORWKV, I_QNORM, I_W_QUP,
       I_KVNORM, I_W_KVUP, I_W_OMLA, I_W_OUT, I_FFN_NORM, I_W_UP, I_CONVW, I_CONVB, I_W_DOWN, I_FINAL };

typedef const __attribute__((address_space(4))) Args* ArgsP;
__device__ __forceinline__ ArgsP args_ptr() { ArgsP p = (ArgsP)__builtin_amdgcn_kernarg_segment_ptr(); asm volatile("" : "+s"(p)); return p; }
__device__ __forceinline__ int ltid() { int t = vtid(); asm volatile("" : "+v"(t)); return t; }
constexpr int NWAVES = 8, NTHREADS = 512;
constexpr int RING_BYTES = 131072, MISC_OFF = RING_BYTES + 320, LDS_BYTES = 147456;

struct WDesc { const float* W; const float* scale; bf16_t* dst; int N, k0, n0, mode, roff, ldk, koff; };
__device__ __forceinline__ void tr_load(const WDesc& d, f32x4 (&v)[8], int lane) {
    const int kq = lane >> 4, n4 = (lane & 15) * 4;
#pragma unroll
    for (int i = 0; i < 8; ++i) v[i] = (d.n0 + n4 < d.N) ? *(const f32x4*)(d.W + (size_t)(d.k0 + kq + 4 * i) * d.N + d.n0 + n4) : (f32x4){0.f, 0.f, 0.f, 0.f};
}
__device__ __forceinline__ void tr_store(const WDesc& d, const f32x4 (&v)[8], LAS float* scr, int lane) {
    const int kq = lane >> 4, n4 = (lane & 15) * 4;
#pragma unroll
    for (int i = 0; i < 8; ++i) { const int kk = kq + 4 * i; f32x4 x = v[i]; if (d.scale) x = x * d.scale[d.k0 + kk];
        LAS float* p = scr + kk * 65 + n4; p[0] = x.x; p[1] = x.y; p[2] = x.z; p[3] = x.w; }
    asm volatile("s_waitcnt lgkmcnt(0)" ::: "memory");
    const LAS float* s = scr + lane;
    const int n = d.n0 + lane, mode = d.mode;
    int drow = n;
    if (mode == 1) drow = n < 2208 ? n : n + 96;
    else if (mode == 2) { const int h = n / 96, j = n % 96; drow = j < 64 ? h * 64 + j : 512 + h * 32 + (j - 64); }
    else if (mode == 3) { const int h = n >> 7, j = n & 127; drow = j < 64 ? h * 64 + j : 512 + h * 64 + (j - 64); }
    else if (mode == 4) { const int v_ = n < FF ? n : n - FF; drow = (v_ >> 7) * 256 + (n < FF ? 0 : 128) + (v_ & 127); }
    bf16_t* o_ = d.dst + (size_t)(drow + d.roff) * d.ldk + d.koff + d.k0;
    if (n < d.N)
#pragma unroll
    for (int c = 0; c < 4; ++c) { u32x4 o; o.x = pk2(s[(8 * c + 0) * 65], s[(8 * c + 1) * 65]); o.y = pk2(s[(8 * c + 2) * 65], s[(8 * c + 3) * 65]); o.z = pk2(s[(8 * c + 4) * 65], s[(8 * c + 5) * 65]); o.w = pk2(s[(8 * c + 6) * 65], s[(8 * c + 7) * 65]);
        *(u32x4*)(o_ + 8 * c) = o; }
    asm volatile("s_waitcnt lgkmcnt(0)" ::: "memory");
}
__device__ __forceinline__ void phase_weights(ArgsP a, int l, LAS unsigned char* lds) {
    a = args_ptr();
    const int tid = ltid(), lane = tid & 63, wave = tid >> 6;
    const int gw = blockIdx.x * NWAVES + wave, NGW = gridDim.x * NWAVES;
    LAS float* scr = (LAS float*)(lds + wave * 16384);
    unsigned char* wb = a->ws + WS_W;
    bf16_t* Wt_in = (bf16_t*)(wb + W_IN); bf16_t* Wt_lora = (bf16_t*)(wb + W_LORA); bf16_t* Wt_q = (bf16_t*)(wb + W_Q); bf16_t* Wt_kv = (bf16_t*)(wb + W_KV);
    bf16_t* Wt_oa = (bf16_t*)(wb + W_OA); bf16_t* Wt_ob = (bf16_t*)(wb + W_OB); bf16_t* Wt_out = (bf16_t*)(wb + W_OUT); bf16_t* Wt_up = (bf16_t*)(wb + W_UP); bf16_t* Wt_down = (bf16_t*)(wb + W_DOWN);
    constexpr int I_IN = 32 * 67, I_DEC = 2 * 8, I_ICL = 2 * 8, I_GAT = 4 * 8, I_Q = 8 * 12, I_KV = 4 * 16, I_OA = 16 * 16, I_OB = 16 * 16, I_OUT = 32 * 16, I_UP = 32 * 88, I_DN = 88 * 16;
    constexpr int NITEMS = I_IN + I_DEC + I_ICL + I_GAT + I_Q + I_KV + I_OA + I_OB + I_OUT + I_UP + I_DN;
    auto decode = [&](int it) { WDesc d; int r = it, kb, nb; d.scale = nullptr; d.mode = 0; d.roff = 0; d.koff = 0;
        if (r < I_IN) { kb = r / 67; nb = r % 67; d.W = a->in[I_W_IN] + (size_t)l * 1024 * IN_COLS; d.N = IN_COLS; d.dst = Wt_in; d.mode = 1; d.ldk = 1024; d.scale = a->in[I_ATTN_NORM] + l * 1024; }
        else if ((r -= I_IN) < I_DEC) { kb = r / 8; nb = r % 8; d.W = a->in[I_W_DEC] + (size_t)l * 64 * 512; d.N = 512; d.dst = Wt_lora; d.ldk = 256; }
        else if ((r -= I_DEC) < I_ICL) { kb = r / 8; nb = r % 8; d.W = a->in[I_W_ICLR] + (size_t)l * 64 * 512; d.N = 512; d.dst = Wt_lora; d.roff = 512; d.ldk = 256; d.koff = 64; }
        else if ((r -= I_ICL) < I_GAT) { kb = r / 8; nb = r % 8; d.W = a->in[I_W_GATE] + (size_t)l * 128 * 512; d.N = 512; d.dst = Wt_lora; d.roff = 1024; d.ldk = 256; d.koff = 128; }
        else if ((r -= I_GAT) < I_Q) { kb = r / 12; nb = r % 12; d.W = a->in[I_W_QUP] + (size_t)l * 256 * 768; d.N = 768; d.dst = Wt_q; d.mode = 2; d.ldk = 256; d.scale = a->in[I_QNORM] + l * 256; }
        else if ((r -= I_Q) < I_KV) { kb = r / 16; nb = r % 16; d.W = a->in[I_W_KVUP] + (size_t)l * 128 * 1024; d.N = 1024; d.dst = Wt_kv; d.mode = 3; d.ldk = 256; d.scale = a->in[I_KVNORM] + l * 128; }
        else if ((r -= I_KV) < I_OA) { kb = r / 16; nb = r % 16; d.W = a->in[I_W_ORWKV] + (size_t)l * 512 * 1024; d.N = 1024; d.dst = Wt_oa; d.ldk = 512; }
        else if ((r -= I_OA) < I_OB) { kb = r / 16; nb = r % 16; d.W = a->in[I_W_OMLA] + (size_t)l * 512 * 1024; d.N = 1024; d.dst = Wt_ob; d.ldk = 512; }
        else if ((r -= I_OB) < I_OUT) { kb = r / 16; nb = r % 16; d.W = a->in[I_W_OUT] + (size_t)l * 1024 * 1024; d.N = 1024; d.dst = Wt_out; d.ldk = 1024; }
        else if ((r -= I_OUT) < I_UP) { kb = r / 88; nb = r % 88; d.W = a->in[I_W_UP] + (size_t)l * 1024 * 2 * FF; d.N = 2 * FF; d.dst = Wt_up; d.mode = 4; d.ldk = 1024; d.scale = a->in[I_FFN_NORM] + l * 1024; }
        else { r -= I_UP; kb = r / 16; nb = r % 16; d.W = a->in[I_W_DOWN] + (size_t)l * FF * 1024; d.N = 1024; d.dst = Wt_down; d.ldk = FF; }
        d.k0 = kb * 32; d.n0 = nb * 64; return d; };
    if (gw < NITEMS) {
        WDesc d0 = decode(gw), d1; f32x4 va[8], vb[8];
        tr_load(d0, va, lane);
#pragma unroll 1
        for (int it = gw; it < NITEMS; it += 2 * NGW) {
            const int i1 = it + NGW, i2 = i1 + NGW;
            d1 = decode(i1 < NITEMS ? i1 : it); tr_load(d1, vb, lane);
            tr_store(d0, va, scr, lane);
            if (i1 >= NITEMS) break;
            d0 = decode(i2 < NITEMS ? i2 : i1); tr_load(d0, va, lane);
            tr_store(d1, vb, scr, lane);
        }
    }
    const int gt = blockIdx.x * NTHREADS + tid, NGT = gridDim.x * NTHREADS;
    unsigned z0_ = 0u; asm volatile("" : "+v"(z0_));
    const u32x4 z = (u32x4){z0_, z0_, z0_, z0_};
    for (int i = gt; i < 96 * 128; i += NGT) *(u32x4*)(Wt_in + (size_t)(2208 + i / 128) * 1024 + (i % 128) * 8) = z;
    for (int i = gt; i < 1536 * 32; i += NGT) { const int row = i / 32, k8 = (i % 32) * 8, kind = row >> 9; const bool live = kind == 0 ? (k8 < 64) : (kind == 1 ? (k8 >= 64 && k8 < 128) : (k8 >= 128)); if (!live) *(u32x4*)(Wt_lora + (size_t)row * 256 + k8) = z; }
    for (int i = gt; i < 1024 * 16; i += NGT) *(u32x4*)(Wt_kv + (size_t)(i / 16) * 256 + 128 + (i % 16) * 8) = z;
#ifdef SCRIBBLE
    if (l == 0) { u32x4* p = (u32x4*)(a->ws + WS_ACT); const u32x4 pz = (u32x4){0xAAAAAAAAu, 0xAAAAAAAAu, 0xAAAAAAAAu, 0xAAAAAAAAu};
        for (unsigned i = gt; i < 178u * 65536u; i += NGT) p[i] = pz; }
#endif
    if (l == 0) {
        float* SS0 = (float*)(a->ws + WS_SSP); bf16_t* HB = (bf16_t*)(a->ws + A_HB);
        for (int m = gw; m < M; m += 2 * NGW) {
            const int m2 = m + NGW;
            const f32x4* xr = (const f32x4*)(a->in[I_X] + (size_t)m * DM) + lane; const f32x4* xr2 = (const f32x4*)(a->in[I_X] + (size_t)(m2 < M ? m2 : m) * DM) + lane;
            f32x4 v1[4], v2[4];
#pragma unroll
            for (int j = 0; j < 4; ++j) { v1[j] = xr[64 * j]; v2[j] = xr2[64 * j]; }
            float s = 0.f, s2 = 0.f;
            u32x2* o = (u32x2*)(HB + (size_t)m * DM) + lane; u32x2* o2p = (u32x2*)(HB + (size_t)m2 * DM) + lane;
#pragma unroll
            for (int j = 0; j < 4; ++j) { s += dot4(v1[j], v1[j]); o[64 * j] = dn4(v1[j]); }
            if (m2 < M) {
#pragma unroll
                for (int j = 0; j < 4; ++j) { s2 += dot4(v2[j], v2[j]); o2p[64 * j] = dn4(v2[j]); } }
#pragma unroll
            for (int o2 = 1; o2 < 64; o2 <<= 1) { s += shx(s, o2); s2 += shx(s2, o2); }
            if (lane < 16) { SS0[(size_t)m * 16 + lane] = lane == 0 ? s : 0.f; if (m2 < M) SS0[(size_t)m2 * 16 + lane] = lane == 0 ? s2 : 0.f; }
        }
        float* CS = (float*)(a->ws + WS_CS); const int* pos = (const int*)a->in[I_POS];
        for (int i = gt; i < M * 16; i += NGT) { const int row = i >> 4, f = i & 15;
            const float invf = exp2f(-0.830482023721841f * (float)f);
            const float ang = (float)pos[row] * invf;
            const float k = rintf(ang * 0.15915494309189535f);
            float rr = fmaf(-k, 6.2831854820251465f, ang); rr = fmaf(-k, -1.7484555314695172e-07f, rr);
            CS[(size_t)row * 32 + f] = cosf(rr); CS[(size_t)row * 32 + 16 + f] = sinf(rr); }
    }
}

__device__ __forceinline__ void phase_prep(ArgsP a, int l) {
    a = args_ptr();
    const unsigned gt = blockIdx.x * NTHREADS + ltid(), NGT = gridDim.x * NTHREADS;
    const bf16_t* LORAC = (const bf16_t*)(a->ws + A_LORAC); bf16_t* LIN = (bf16_t*)(a->ws + A_LIN);
    {
        const int j = (gt & 31) * 8; const float* mu = a->in[I_MU] + (size_t)l * 1792 + 1536 + j;
        const f32x4 m0 = *(const f32x4*)mu, m1 = *(const f32x4*)(mu + 4);
        for (unsigned i = gt; i < (unsigned)M * 32; i += NGT) { const unsigned row = i >> 5; const int t = row & 4095;
            const u32x4 cu = *(const u32x4*)(LORAC + (size_t)row * 256 + j); const u32x4 pv = t ? *(const u32x4*)(LORAC + (size_t)(row - 1) * 256 + j) : (u32x4){0u, 0u, 0u, 0u};
            const f32x4 c0 = up4((u32x2){cu.x, cu.y}), c1 = up4((u32x2){cu.z, cu.w}), q0 = up4((u32x2){pv.x, pv.y}), q1 = up4((u32x2){pv.z, pv.w});
            f32x4 s0 = c0 + (q0 - c0) * m0, s1 = c1 + (q1 - c1) * m1;
            if (j < 64) { for (int e = 0; e < 4; ++e) { s0[e] = tanhf(s0[e]); s1[e] = tanhf(s1[e]); } } else if (j >= 128) { for (int e = 0; e < 4; ++e) { s0[e] = sigm(s0[e]); s1[e] = sigm(s1[e]); } }
            const u32x2 o0 = dn4(s0), o1 = dn4(s1); *(u32x4*)(LIN + (size_t)row * 256 + j) = (u32x4){o0.x, o0.y, o1.x, o1.y}; }
    }
    const bf16_t* PMb = (const bf16_t*)(a->ws + A_PM); bf16_t* KPE = (bf16_t*)(a->ws + A_KPE); const float* CS = (const float*)(a->ws + WS_CS);
    for (unsigned i = gt; i < (unsigned)M * 4; i += NGT) { const unsigned row = i >> 2; const int f = (i & 3) * 4;
        const f32x4 x1 = up4(*(const u32x2*)(PMb + (size_t)row * 512 + 384 + f)), x2 = up4(*(const u32x2*)(PMb + (size_t)row * 512 + 400 + f));
        const f32x4 cs = *(const f32x4*)(CS + (size_t)row * 32 + f), sn = *(const f32x4*)(CS + (size_t)row * 32 + 16 + f);
        *(u32x2*)(KPE + (size_t)row * 32 + f) = dn4(x1 * cs - x2 * sn); *(u32x2*)(KPE + (size_t)row * 32 + 16 + f) = dn4(x1 * sn + x2 * cs); }
}

template <int CTRL> __device__ __forceinline__ float dppf(float x) { return __builtin_bit_cast(float, __builtin_amdgcn_update_dpp(0, __builtin_bit_cast(int, x), CTRL, 0xf, 0xf, false)); }
#if SHFL_SCAN
__device__ __forceinline__ float rr16(float x) { x += shx(x, 8); x += shx(x, 4); x += shx(x, 2); x += shx(x, 1); return x; }
#else
__device__ __forceinline__ float rr16(float x) { x += dppf<0x128>(x); x += dppf<0x124>(x); x += dppf<0x122>(x); x += dppf<0x121>(x); return x; }
#endif

typedef float f32x2 __attribute__((ext_vector_type(2)));
constexpr int SC_BUF = 43008, SC_R = 0, SC_W = 8192, SC_K = 16384, SC_A = 24576, SC_B = 32768, SC_V = 40960, SC_YP = 2 * SC_BUF, SC_YPB = 8192;
struct ScOps { f32x4 a, w, b, k, r; float v; };
__device__ __forceinline__ void sc_ld(ScOps& o, const LAS unsigned char* bp, const LAS unsigned char* vp, int t) {
    o.a = *(const LAS f32x4*)(bp + SC_A + t * 256); o.w = *(const LAS f32x4*)(bp + SC_W + t * 256); o.b = *(const LAS f32x4*)(bp + SC_B + t * 256);
    o.k = *(const LAS f32x4*)(bp + SC_K + t * 256); o.r = *(const LAS f32x4*)(bp + SC_R + t * 256); o.v = *(const LAS float*)(vp + t * 64);
}
__device__ __forceinline__ void scan_unit(ArgsP a, int l, int bh, int q4, LAS unsigned char* lds, size_t y_off = A_Y) {
    a = args_ptr();
    const int tid = ltid(), lane = tid & 63, wid = __builtin_amdgcn_readfirstlane(tid >> 6);
    const int b = bh >> 3, h = bh & 7, i0 = q4 * 16;
    const bf16_t* RKV = (const bf16_t*)(a->ws + A_RKV); const bf16_t* LW = (const bf16_t*)(a->ws + A_LW); const bf16_t* ICLR = (const bf16_t*)(a->ws + A_ICLR);
    bf16_t* Y = (bf16_t*)(a->ws + y_off); float* SCAL = (float*)(a->ws + WS_SCAL);
    constexpr int NCH = SEQ / 32;
    if (wid >= 4) {
        const int ht = tid - 256, pcg = ht & 15, tau0 = ht >> 4, ch = h * 64 + 4 * pcg;
        const float* mu = a->in[I_MU] + (size_t)l * 1792;
        const f32x4 mu_r = *(const f32x4*)(mu + ch), mu_k = *(const f32x4*)(mu + 512 + ch), mu_v = *(const f32x4*)(mu + 1024 + ch);
        const f32x4 kk_c = *(const f32x4*)(a->in[I_KK] + l * 512 + ch), ka_c = *(const f32x4*)(a->in[I_KA] + l * 512 + ch), rk_c = *(const f32x4*)(a->in[I_RK] + l * 512 + ch);
        u32x2 g[2][8];
        const u32x2 z2 = (u32x2){0u, 0u};
#define SC_LOAD(c) do { _Pragma("unroll") for (int k_ = 0; k_ < 2; ++k_) { const int t_ = (c) * 32 + tau0 + 16 * k_; const size_t row_ = (size_t)b * SEQ + t_; \
            g[k_][0] = *(const u32x2*)(RKV + row_ * 1536 + ch); g[k_][1] = *(const u32x2*)(RKV + row_ * 1536 + 512 + ch); g[k_][2] = *(const u32x2*)(RKV + row_ * 1536 + 1024 + ch); \
            if (t_) { g[k_][3] = *(const u32x2*)(RKV + (row_ - 1) * 1536 + ch); g[k_][4] = *(const u32x2*)(RKV + (row_ - 1) * 1536 + 512 + ch); g[k_][5] = *(const u32x2*)(RKV + (row_ - 1) * 1536 + 1024 + ch); } \
            else { g[k_][3] = z2; g[k_][4] = z2; g[k_][5] = z2; } \
            g[k_][6] = *(const u32x2*)(LW + row_ * 512 + ch); g[k_][7] = *(const u32x2*)(ICLR + row_ * 512 + ch); } } while (0)
#define SC_STORE(c, p) do { _Pragma("unroll") for (int k_ = 0; k_ < 2; ++k_) { const int tau_ = tau0 + 16 * k_; LAS unsigned char* base_ = lds + (p) * SC_BUF + tau_ * 256 + pcg * 16; \
            const f32x4 r2 = up4(g[k_][0]), k2 = up4(g[k_][1]), v2 = up4(g[k_][2]); \
            const f32x4 r = r2 + (up4(g[k_][3]) - r2) * mu_r, k = k2 + (up4(g[k_][4]) - k2) * mu_k, v = v2 + (up4(g[k_][5]) - v2) * mu_v; \
            const f32x4 lw = up4(g[k_][6]), ic = up4(g[k_][7]); \
            f32x4 kk = k * kk_c; float ssum = dot4(kk, kk); ssum += shx(ssum, 1); ssum += shx(ssum, 2); ssum += shx(ssum, 4); ssum += shx(ssum, 8); \
            kk = kk * rsqrtf(ssum + 1e-12f); \
            const f32x4 kp = k * (1.0f + (ic - 1.0f) * ka_c); \
            float sc = dot4(r * kp, rk_c); sc += shx(sc, 1); sc += shx(sc, 2); sc += shx(sc, 4); sc += shx(sc, 8); \
            if (q4 == 0 && pcg == 0) SCAL[((size_t)b * SEQ + (c) * 32 + tau_) * 8 + h] = sc; \
            f32x4 w; w.x = __expf(lw.x * CK_LWZ); w.y = __expf(lw.y * CK_LWZ); w.z = __expf(lw.z * CK_LWZ); w.w = __expf(lw.w * CK_LWZ); \
            *(LAS f32x4*)(base_ + SC_R) = r; *(LAS f32x4*)(base_ + SC_W) = w; *(LAS f32x4*)(base_ + SC_K) = kp; *(LAS f32x4*)(base_ + SC_A) = -kk * CK_AB; *(LAS f32x4*)(base_ + SC_B) = kk * ic * CK_AB; \
            if ((pcg >> 2) == q4) *(LAS f32x4*)(lds + (p) * SC_BUF + SC_V + tau_ * 64 + (pcg & 3) * 16) = v; } } while (0)
        SC_LOAD(0); SC_STORE(0, 0); SC_LOAD(1);
        __syncthreads();
        for (int c = 0; c < NCH; ++c) {
            if (c + 1 < NCH) { SC_STORE(c + 1, (c + 1) & 1); if (c + 2 < NCH) SC_LOAD(c + 2); }
            if (c > 0) {
                const LAS f32x4* yp = (const LAS f32x4*)(lds + SC_YP + ((c - 1) & 1) * SC_YPB + (ht >> 3) * 256 + (ht & 7) * 32);
                const f32x4 y0 = yp[0], y1 = yp[1];
                *(unsigned*)(Y + ((size_t)b * SEQ + (c - 1) * 32 + (ht >> 3)) * 512 + h * 64 + i0 + 2 * (ht & 7)) = pk2((y0.x + y0.y) + (y0.z + y0.w), (y1.x + y1.y) + (y1.z + y1.w));
            }
            __syncthreads();
        }
        { const int c = NCH;
          const LAS f32x4* yp = (const LAS f32x4*)(lds + SC_YP + ((c - 1) & 1) * SC_YPB + (ht >> 3) * 256 + (ht & 7) * 32);
          const f32x4 y0 = yp[0], y1 = yp[1];
          *(unsigned*)(Y + ((size_t)b * SEQ + (c - 1) * 32 + (ht >> 3)) * 512 + h * 64 + i0 + 2 * (ht & 7)) = pk2((y0.x + y0.y) + (y0.z + y0.w), (y1.x + y1.y) + (y1.z + y1.w)); }
#undef SC_LOAD
#undef SC_STORE
    } else {
        const int rloc = wid * 4 + (lane >> 4), cgp = lane & 15;
        __syncthreads();
        f32x2 s01 = (f32x2){0.f, 0.f}, s23 = s01;
        for (int c = 0; c < NCH; ++c) {
            const int p = c & 1;
            const LAS unsigned char* bp = lds + p * SC_BUF + cgp * 16;
            const LAS unsigned char* vp = lds + p * SC_BUF + SC_V + rloc * 4;
            LAS float* ypw = (LAS float*)(lds + SC_YP + p * SC_YPB) + rloc * 4 + cgp;
            ScOps oa, ob;
            sc_ld(oa, bp, vp, 0);
#define SC_STEP(cur, nxt, t) do { if ((t) + 1 < 32) sc_ld(nxt, bp, vp, (t) + 1); if (CK_NOSTATE && ((t) & 15) == 0) { s01 = (f32x2){0.f, 0.f}; s23 = s01; } \
                const f32x2 vk0 = (f32x2){cur.k.x, cur.k.y} * cur.v, vk1 = (f32x2){cur.k.z, cur.k.w} * cur.v; \
                const f32x2 t0 = s01 * (f32x2){cur.w.x, cur.w.y} + vk0, t1 = s23 * (f32x2){cur.w.z, cur.w.w} + vk1; \
                f32x2 pd = s01 * (f32x2){cur.a.x, cur.a.y}; pd = s23 * (f32x2){cur.a.z, cur.a.w} + pd; \
                const float d = rr16(pd.x + pd.y); \
                s01 = (f32x2){cur.b.x, cur.b.y} * d + t0; s23 = (f32x2){cur.b.z, cur.b.w} * d + t1; \
                f32x2 qd = s01 * (f32x2){cur.r.x, cur.r.y}; qd = s23 * (f32x2){cur.r.z, cur.r.w} + qd; \
                float y = qd.x + qd.y; y += dppf<0x128>(y); y += dppf<0x124>(y); \
                if (cgp < 4) ypw[(t) * 64] = y; } while (0)
#pragma unroll 1
            for (int t = 0; t < 32; t += 2) { SC_STEP(oa, ob, t); SC_STEP(ob, oa, t + 1); }
#undef SC_STEP
            __syncthreads();
        }
    }
    __syncthreads();
}

typedef short s16x4v __attribute__((ext_vector_type(4)));
constexpr int CK_ROW = 144;
constexpr int CK_AT = 0, CK_RT = 2304, CK_BT = 4608, CK_KT = 6912, CK_VT = 9216, CK_GL = 11520, CK_OPB = 11776, CK_NOP = 5;
constexpr int CK_MT0 = CK_NOP * CK_OPB, CK_MAK = 0, CK_MRB = 512, CK_MRK = 1024, CK_TT = 1536, CK_MAB = 2048, CK_MTB = 2048 + 16 * 80, CK_NMT = 4;
constexpr int CK_YT0 = CK_MT0 + CK_NMT * CK_MTB, CK_YTB = 1024;
typedef short v4i16_t __attribute__((ext_vector_type(4)));
__device__ __forceinline__ s16x4v ldtr(const LAS unsigned char* p) { return __builtin_bit_cast(s16x4v, __builtin_amdgcn_ds_read_tr16_b64_v4i16((LAS v4i16_t*)p)); }
__device__ __forceinline__ s16x4v pk4(f32x4 v) { const u32x2 p = dn4(v); return __builtin_bit_cast(s16x4v, p); }
__device__ __forceinline__ void scan_unit_chunked(ArgsP a, int l, int bh, int q4, LAS unsigned char* lds, size_t y_off = A_Y) {
    a = args_ptr();
    const int tid = ltid(), lane = tid & 63, wid = __builtin_amdgcn_readfirstlane(tid >> 6);
    const int b = bh >> 3, h = bh & 7, i0 = q4 * 16, q = lane >> 4, l15 = lane & 15;
    const bf16_t* RKV = (const bf16_t*)(a->ws + A_RKV); const bf16_t* EG = (const bf16_t*)(a->ws + A_LW); const bf16_t* ICLR = (const bf16_t*)(a->ws + A_ICLR);
    bf16_t* Y = (bf16_t*)(a->ws + y_off); float* SCAL = (float*)(a->ws + WS_SCAL);
    constexpr int NCH = SEQ / 16;
    const int ht = tid - 256, t_h = (ht >> 4) & 15, jg = ht & 15, ch = h * 64 + 4 * jg;
    f32x4 mu_r, mu_k, mu_v, kk_c, ka_c, rk_c;
    u32x2 g[10], g1[10], g2[10];
    if (wid >= 4) {
        const float* mu = a->in[I_MU] + (size_t)l * 1792;
        mu_r = *(const f32x4*)(mu + ch); mu_k = *(const f32x4*)(mu + 512 + ch); mu_v = *(const f32x4*)(mu + 1024 + ch);
        kk_c = *(const f32x4*)(a->in[I_KK] + l * 512 + ch); ka_c = *(const f32x4*)(a->in[I_KA] + l * 512 + ch); rk_c = *(const f32x4*)(a->in[I_RK] + l * 512 + ch);
    }
#define CK_LOAD(G_, c) do { const int t_ = (c) * 16 + t_h; const size_t row_ = (size_t)b * SEQ + t_; const size_t rp_ = t_ ? row_ - 1 : row_; \
        G_[0] = *(const u32x2*)(RKV + row_ * 1536 + ch); G_[1] = *(const u32x2*)(RKV + row_ * 1536 + 512 + ch); G_[2] = *(const u32x2*)(RKV + row_ * 1536 + 1024 + ch); \
        G_[3] = *(const u32x2*)(RKV + rp_ * 1536 + ch); G_[4] = *(const u32x2*)(RKV + rp_ * 1536 + 512 + ch); G_[5] = *(const u32x2*)(RKV + rp_ * 1536 + 1024 + ch); \
        G_[6] = *(const u32x2*)(ICLR + row_ * 512 + ch); G_[7] = *(const u32x2*)(EG + row_ * 512 + ch); \
        G_[8] = *(const u32x2*)(EG + (row_ - (t_h ? 1 : 0)) * 512 + ch); G_[9] = *(const u32x2*)(EG + ((size_t)b * SEQ + (c) * 16 + 15) * 512 + ch); } while (0)
    f32x4 accS[4];
#pragma unroll
    for (int jt = 0; jt < 4; ++jt) accS[jt] = (f32x4){0.f, 0.f, 0.f, 0.f};
    float x[16];
#pragma unroll
    for (int t_ = 0; t_ < 16; ++t_) x[t_] = 0.f;
#define CK_OPSTAGE(G_, it) do { \
            if (it < NCH) { \
                LAS unsigned char* op = lds + (it % CK_NOP) * CK_OPB; \
                const f32x4 r2 = up4(G_[0]), k2 = up4(G_[1]), v2 = up4(G_[2]); \
                const float pz_ = (it * 16 + t_h) ? 1.0f : 0.0f; \
                const f32x4 r = r2 + (up4(G_[3]) * pz_ - r2) * mu_r, k = k2 + (up4(G_[4]) * pz_ - k2) * mu_k, v = v2 + (up4(G_[5]) * pz_ - v2) * mu_v, ic = up4(G_[6]); \
                const f32x4 eG = up4(G_[7]), eGL = up4(G_[9]); \
                f32x4 eGx = up4(G_[8]); if (t_h == 0) eGx = (f32x4){1.f, 1.f, 1.f, 1.f}; \
                f32x4 enG; \
_Pragma("unroll") \
                for (int e = 0; e < 4; ++e) enG[e] = __builtin_amdgcn_rcpf(eG[e]); \
                f32x4 kk = k * kk_c; const float ssum = rr16(dot4(kk, kk)); \
                kk = kk * rsqrtf(ssum + 1e-12f); \
                const f32x4 kp = k * (1.0f + (ic - 1.0f) * ka_c), bb = kk * ic; \
                const float sc = rr16(dot4(r * kp, rk_c)); \
                if (q4 == 0 && jg == 0) SCAL[((size_t)b * SEQ + it * 16 + t_h) * 8 + h] = sc; \
                *(LAS u32x2*)(op + CK_AT + t_h * CK_ROW + jg * 8) = dn4(-(kk * eGx)); \
                *(LAS u32x2*)(op + CK_RT + t_h * CK_ROW + jg * 8) = dn4(r * eG); \
                *(LAS u32x2*)(op + CK_BT + t_h * CK_ROW + jg * 8) = dn4(bb * enG); \
                *(LAS u32x2*)(op + CK_KT + t_h * CK_ROW + jg * 8) = dn4(kp * enG); \
                *(LAS u32x2*)(op + CK_VT + t_h * CK_ROW + jg * 8) = dn4(v); \
                if (t_h == 0) *(LAS f32x4*)(op + CK_GL + jg * 16) = eGL; \
            } \
            if (it + 3 < NCH) CK_LOAD(G_, it + 3); \
        } while (0)
    if (wid >= 4) { CK_LOAD(g, 0); CK_LOAD(g1, 1); CK_LOAD(g2, 2); }
#ifdef CK_TIME
    unsigned long long tb_ = 0, t0_ = 0; const unsigned long long tstart_ = __builtin_readcyclecounter();
#define CK_T0() (t0_ = __builtin_readcyclecounter())
#define CK_T1() (tb_ += __builtin_readcyclecounter() - t0_)
#else
#define CK_T0() do {} while (0)
#define CK_T1() do {} while (0)
#endif
    constexpr int NIT = ((NCH + 6 + 2) / 3) * 3;
    if (wid >= 4) {
#define CK_YSTORE(it) do { if (wid == 4 && (it) >= 5 && (it) - 5 < NCH) { \
            const LAS float* yt = (const LAS float*)(lds + CK_YT0 + (((it) - 5) & 1) * CK_YTB); const int t_ = lane >> 2, ip = (lane & 3) * 4; \
            const f32x4 yv = *(const LAS f32x4*)(yt + t_ * 16 + ip); \
            *(u32x2*)(Y + ((size_t)b * SEQ + ((it) - 5) * 16 + t_) * 512 + h * 64 + i0 + ip) = dn4(yv); } } while (0)
        for (int it3 = 0; it3 < NIT; it3 += 3) {
            CK_T0(); CK_OPSTAGE(g, it3); CK_YSTORE(it3); CK_T1(); __syncthreads();
            CK_T0(); CK_OPSTAGE(g1, (it3 + 1)); CK_YSTORE((it3 + 1)); CK_T1(); __syncthreads();
            CK_T0(); CK_OPSTAGE(g2, (it3 + 2)); CK_YSTORE((it3 + 2)); CK_T1(); __syncthreads();
        }
#undef CK_YSTORE
    } else
    for (int it = 0; it < NIT; ++it) {
        CK_T0();
        if (wid >= 1) {
            const int ph3 = (it + 3 - wid) % 3;
            const int c = it - 1 - ph3;
            if (c >= 0 && c < NCH) {
                const LAS unsigned char* op = lds + (c % CK_NOP) * CK_OPB; LAS unsigned char* mt = lds + CK_MT0 + (c % CK_NMT) * CK_MTB;
                if (ph3 == 0) {
                    const int ro = l15 * CK_ROW + q * 16;
                    const bf16x8 at0 = *(const LAS bf16x8*)(op + CK_AT + ro), at1 = *(const LAS bf16x8*)(op + CK_AT + ro + 64), rt0 = *(const LAS bf16x8*)(op + CK_RT + ro), rt1 = *(const LAS bf16x8*)(op + CK_RT + ro + 64);
                    const bf16x8 bt0 = *(const LAS bf16x8*)(op + CK_BT + ro), bt1 = *(const LAS bf16x8*)(op + CK_BT + ro + 64), kt0 = *(const LAS bf16x8*)(op + CK_KT + ro), kt1 = *(const LAS bf16x8*)(op + CK_KT + ro + 64);
                    const f32x4 z = (f32x4){0.f, 0.f, 0.f, 0.f};
                    f32x4 mab = __builtin_amdgcn_mfma_f32_16x16x32_bf16(at0, bt0, z, 0, 0, 0); mab = __builtin_amdgcn_mfma_f32_16x16x32_bf16(at1, bt1, mab, 0, 0, 0);
                    f32x4 mak = __builtin_amdgcn_mfma_f32_16x16x32_bf16(at0, kt0, z, 0, 0, 0); mak = __builtin_amdgcn_mfma_f32_16x16x32_bf16(at1, kt1, mak, 0, 0, 0);
                    f32x4 mrb = __builtin_amdgcn_mfma_f32_16x16x32_bf16(rt0, bt0, z, 0, 0, 0); mrb = __builtin_amdgcn_mfma_f32_16x16x32_bf16(rt1, bt1, mrb, 0, 0, 0);
                    f32x4 mrk = __builtin_amdgcn_mfma_f32_16x16x32_bf16(rt0, kt0, z, 0, 0, 0); mrk = __builtin_amdgcn_mfma_f32_16x16x32_bf16(rt1, kt1, mrk, 0, 0, 0);
#pragma unroll
                    for (int r = 0; r < 4; ++r) { const int t_ = 4 * q + r; const bool lo_ = l15 < t_, le_ = l15 <= t_;
                        *(LAS float*)(mt + CK_MAB + t_ * 80 + l15 * 4) = lo_ ? mab[r] : 0.f;
                        *(LAS bf16_t*)(mt + CK_MAK + t_ * 32 + l15 * 2) = (bf16_t)f2bf(lo_ ? mak[r] : 0.f);
                        *(LAS bf16_t*)(mt + CK_MRB + t_ * 32 + l15 * 2) = (bf16_t)f2bf(le_ ? mrb[r] : 0.f);
                        *(LAS bf16_t*)(mt + CK_MRK + t_ * 32 + l15 * 2) = (bf16_t)f2bf(le_ ? mrk[r] : 0.f); }
                } else {
#define CK_MLD(t_) f32x4 m_##t_[4]; _Pragma("unroll") for (int s4 = 0; s4 < (t_); s4 += 4) m_##t_[s4 >> 2] = *(const LAS f32x4*)(mt + CK_MAB + (t_) * 80 + s4 * 4)
#define CK_TROW(t_) do { float acc_ = (l15 == (t_)) ? 1.f : 0.f; \
                        _Pragma("unroll") for (int s4 = 0; s4 < (t_); s4 += 4) { \
                            _Pragma("unroll") for (int e = 0; e < 4; ++e) if (s4 + e < (t_)) acc_ += m_##t_[s4 >> 2][e] * x[s4 + e]; } \
                        x[t_] = acc_; } while (0)
                    if (ph3 == 1) { CK_MLD(1); CK_MLD(2); CK_MLD(3); CK_MLD(4); CK_MLD(5); CK_MLD(6); CK_MLD(7); CK_MLD(8); CK_MLD(9); CK_MLD(10);
                        x[0] = (l15 == 0) ? 1.f : 0.f; CK_TROW(1); CK_TROW(2); CK_TROW(3); CK_TROW(4); CK_TROW(5); CK_TROW(6); CK_TROW(7); CK_TROW(8); CK_TROW(9); CK_TROW(10); }
                    else { CK_MLD(11); CK_MLD(12); CK_MLD(13); CK_MLD(14); CK_MLD(15); CK_TROW(11); CK_TROW(12); CK_TROW(13); CK_TROW(14); CK_TROW(15);
                        if (q == 0) {
#pragma unroll
                            for (int t_ = 0; t_ < 16; ++t_) *(LAS bf16_t*)(mt + CK_TT + t_ * 32 + l15 * 2) = (bf16_t)f2bf(x[t_]); } }
#undef CK_TROW
#undef CK_MLD
                }
            }
        } else {
            const int c = it - 4;
            if (c >= 0 && c < NCH) {
                const LAS unsigned char* op = lds + (c % CK_NOP) * CK_OPB; const LAS unsigned char* mt = lds + CK_MT0 + (c % CK_NMT) * CK_MTB;
                s16x4v sb[4];
#pragma unroll
                for (int jt = 0; jt < 4; ++jt) { if (CK_NOSTATE) accS[jt] = (f32x4){0.f, 0.f, 0.f, 0.f}; sb[jt] = pk4(accS[jt]); }
                const int ao = l15 * CK_ROW + q * 8;
                const int tro = (4 * q + (l15 >> 2)) * CK_ROW + (l15 & 3) * 8;
                const s16x4v vb = ldtr(op + CK_VT + tro + i0 * 2);
                f32x4 x1 = (f32x4){0.f, 0.f, 0.f, 0.f}, x2 = x1;
#pragma unroll
                for (int jt = 0; jt < 4; ++jt) {
                    const s16x4v a0 = *(const LAS s16x4v*)(op + CK_AT + ao + jt * 32), r0 = *(const LAS s16x4v*)(op + CK_RT + ao + jt * 32);
                    x1 = __builtin_amdgcn_mfma_f32_16x16x16bf16_1k(a0, sb[jt], x1, 0, 0, 0);
                    x2 = __builtin_amdgcn_mfma_f32_16x16x16bf16_1k(r0, sb[jt], x2, 0, 0, 0);
                }
                const s16x4v mak = *(const LAS s16x4v*)(mt + CK_MAK + l15 * 32 + q * 8), mrb = *(const LAS s16x4v*)(mt + CK_MRB + l15 * 32 + q * 8);
                const s16x4v mrk = *(const LAS s16x4v*)(mt + CK_MRK + l15 * 32 + q * 8), tt = *(const LAS s16x4v*)(mt + CK_TT + l15 * 32 + q * 8);
                x1 = __builtin_amdgcn_mfma_f32_16x16x16bf16_1k(mak, vb, x1, 0, 0, 0);
                x2 = __builtin_amdgcn_mfma_f32_16x16x16bf16_1k(mrk, vb, x2, 0, 0, 0);
                const f32x4 u = __builtin_amdgcn_mfma_f32_16x16x16bf16_1k(tt, pk4(x1), (f32x4){0.f, 0.f, 0.f, 0.f}, 0, 0, 0);
                const s16x4v ub = pk4(u);
                const f32x4 yv = __builtin_amdgcn_mfma_f32_16x16x16bf16_1k(mrb, ub, x2, 0, 0, 0);
                const bf16x8 uv = (bf16x8){ub[0], ub[1], ub[2], ub[3], vb[0], vb[1], vb[2], vb[3]};
#pragma unroll
                for (int jt = 0; jt < 4; ++jt) {
                    const f32x4 gl = *(const LAS f32x4*)(op + CK_GL + (16 * jt + 4 * q) * 4);
                    const s16x4v b0 = ldtr(op + CK_BT + tro + jt * 32), k0 = ldtr(op + CK_KT + tro + jt * 32);
                    accS[jt] = __builtin_amdgcn_mfma_f32_16x16x32_bf16((bf16x8){b0[0], b0[1], b0[2], b0[3], k0[0], k0[1], k0[2], k0[3]}, uv, accS[jt], 0, 0, 0) * gl;
                }
                LAS float* yt = (LAS float*)(lds + CK_YT0 + (c & 1) * CK_YTB);
#pragma unroll
                for (int r = 0; r < 4; ++r) yt[(4 * q + r) * 16 + l15] = yv[r];
            }
        }
        CK_T1();
        __syncthreads();
    }
#ifdef CK_TIME
    if (blockIdx.x == 0 && l == 0 && lane == 0) { unsigned long long* tw = (unsigned long long*)(a->ws + WS_CTL) + 24000; tw[wid] = tb_; if (wid == 0) tw[8] = __builtin_readcyclecounter() - tstart_; }
#endif
#undef CK_LOAD
#undef CK_OPSTAGE
}

constexpr int WP_SUB = 4 * 2304 + 1280;
constexpr int CW_WPFLAG = 65536;
constexpr int CW_YFLAG = 72000;
__device__ __forceinline__ void ST2W(bf16_t* p, unsigned v) { asm volatile("global_store_short %0, %1, off sc1\n\ts_nop 1" :: "v"(p), "v"(v) : "memory"); }
__device__ __forceinline__ void phase_wkvprep(ArgsP a, int l, LAS unsigned char* lds, int first, int stride) {
    a = args_ptr(); first = __builtin_amdgcn_readfirstlane(first); stride = __builtin_amdgcn_readfirstlane(stride); asm volatile("" : "+s"(first), "+s"(stride));
    const int tid = ltid(), lane = tid & 63, wid = __builtin_amdgcn_readfirstlane(tid >> 6), sub = tid >> 8, ht = tid & 255, t_h = ht >> 4, jg = ht & 15, q = lane >> 4, l15 = lane & 15;
    bf16_t* RKV = (bf16_t*)(a->ws + A_RKV); bf16_t* EG = (bf16_t*)(a->ws + A_LW); bf16_t* ICLR = (bf16_t*)(a->ws + A_ICLR); float* SCAL = (float*)(a->ws + WS_SCAL);
    const bf16_t* HALO = (const bf16_t*)((const unsigned char*)a->out + DO_HALO); unsigned char* MTR = (unsigned char*)a->out + DO_MTREC;
    const float* mu = a->in[I_MU] + (size_t)l * 1792;
    struct WpIn { u32x2 gr, gk, gv, pr, pk, pv, gic, ge, gex, gel; };
    WpIn SA[4], SB[4];
    auto trip_of = [](int q_) { return (q_ & 31) * 32 + (q_ >> 5); };
    auto load1 = [&](WpIn& R1, int tr, int ps) { { const int idx_ = 8 * tr + 2 * ps + sub, bh_ = idx_ >> 8, c_ = idx_ & 255, ch_ = (bh_ & 7) * 64 + 4 * jg, t_ = c_ * 16 + t_h; const size_t row_ = (size_t)(bh_ >> 3) * SEQ + t_; const u32x2 z2_ = (u32x2){0u, 0u};
            R1.gr = *(const u32x2*)(RKV + row_ * 1536 + ch_); R1.gk = *(const u32x2*)(RKV + row_ * 1536 + 512 + ch_); R1.gv = *(const u32x2*)(RKV + row_ * 1536 + 1024 + ch_);
            R1.pr = z2_; R1.pk = z2_; R1.pv = z2_;
            if (t_h) { R1.pr = *(const u32x2*)(RKV + (row_ - 1) * 1536 + ch_); R1.pk = *(const u32x2*)(RKV + (row_ - 1) * 1536 + 512 + ch_); R1.pv = *(const u32x2*)(RKV + (row_ - 1) * 1536 + 1024 + ch_); }
            else if (t_) { const bf16_t* hp_ = HALO + ((row_ >> 4) - 1) * 1536; R1.pr = *(const u32x2*)(hp_ + ch_); R1.pk = *(const u32x2*)(hp_ + 512 + ch_); R1.pv = *(const u32x2*)(hp_ + 1024 + ch_); }
            R1.gic = *(const u32x2*)(ICLR + row_ * 512 + ch_); R1.ge = *(const u32x2*)(EG + row_ * 512 + ch_); R1.gex = *(const u32x2*)(EG + (row_ - (t_h ? 1 : 0)) * 512 + ch_); R1.gel = *(const u32x2*)(EG + (row_ - t_h + 15) * 512 + ch_); }
    };
    auto loadt = [&](WpIn (&R)[4], int tr, int half_) {
        if (half_ != 1) { load1(R[0], tr, 0); load1(R[1], tr, 1); }
        if (half_ != 0) { load1(R[2], tr, 2); load1(R[3], tr, 3); }
    };
    auto body = [&](WpIn (&R)[4], WpIn (&N)[4], int tr, int trn) {
        u32x2 oa[4], orr[4], ob[4], ok[4], ov[4], ogl[4]; float scv[4];
#pragma unroll
        for (int ps = 0; ps < 4; ++ps) {
            const int idx = 8 * tr + 2 * ps + sub, ch = ((idx >> 8) & 7) * 64 + 4 * jg;
            const f32x4 mu_r = *(const f32x4*)(mu + ch), mu_k = *(const f32x4*)(mu + 512 + ch), mu_v = *(const f32x4*)(mu + 1024 + ch);
            const f32x4 kk_c = *(const f32x4*)(a->in[I_KK] + l * 512 + ch), ka_c = *(const f32x4*)(a->in[I_KA] + l * 512 + ch), rk_c = *(const f32x4*)(a->in[I_RK] + l * 512 + ch);
            const f32x4 r2 = up4(R[ps].gr), k2 = up4(R[ps].gk), v2 = up4(R[ps].gv);
            const f32x4 r = r2 + (up4(R[ps].pr) - r2) * mu_r, k = k2 + (up4(R[ps].pk) - k2) * mu_k, v = v2 + (up4(R[ps].pv) - v2) * mu_v, ic = up4(R[ps].gic);
            const f32x4 eG = up4(R[ps].ge);
            f32x4 eGx = up4(R[ps].gex); if (t_h == 0) eGx = (f32x4){1.f, 1.f, 1.f, 1.f};
            f32x4 enG;
#pragma unroll
            for (int e = 0; e < 4; ++e) enG[e] = __builtin_amdgcn_rcpf(eG[e]);
            f32x4 kk = k * kk_c; const float ssum = rr16(dot4(kk, kk));
            kk = kk * rsqrtf(ssum + 1e-12f);
            const f32x4 kp = k * (1.0f + (ic - 1.0f) * ka_c), bb = kk * ic;
            scv[ps] = rr16(dot4(r * kp, rk_c));
            oa[ps] = dn4(-(kk * eGx)); orr[ps] = dn4(r * eG); ob[ps] = dn4(bb * enG); ok[ps] = dn4(kp * enG); ov[ps] = dn4(v); ogl[ps] = R[ps].gel;
            asm volatile("" ::: "memory");
        }
        __syncthreads();
        loadt(N, trn >= 0 ? trn : tr, 0);
#pragma unroll
        for (int ps = 0; ps < 4; ++ps) {
            const int idx = 8 * tr + 2 * ps + sub, bh = idx >> 8, c = idx & 255, b = bh >> 3, h = bh & 7, ch = h * 64 + 4 * jg;
            const size_t row = (size_t)b * SEQ + c * 16 + t_h;
            LAS unsigned char* op = lds + (2 * ps + sub) * WP_SUB;
            *(LAS u32x2*)(op + CK_AT + t_h * CK_ROW + jg * 8) = oa[ps]; *(LAS u32x2*)(op + CK_RT + t_h * CK_ROW + jg * 8) = orr[ps];
            *(LAS u32x2*)(op + CK_BT + t_h * CK_ROW + jg * 8) = ob[ps]; *(LAS u32x2*)(op + CK_KT + t_h * CK_ROW + jg * 8) = ok[ps];
            pg8::ST8W(RKV + row * 1536 + ch, oa[ps]); pg8::ST8W(RKV + row * 1536 + 512 + ch, orr[ps]); pg8::ST8W(RKV + row * 1536 + 1024 + ch, ov[ps]);
            pg8::ST8W(EG + row * 512 + ch, ob[ps]); pg8::ST8W(ICLR + row * 512 + ch, ok[ps]);
            if (jg == 0) __hip_atomic_store(SCAL + row * 8 + h, scv[ps], __ATOMIC_RELAXED, __HIP_MEMORY_SCOPE_AGENT);
            if (t_h == 0) { const f32x4 eGL = up4(ogl[ps]); pg8::ST16W((bf16_t*)(MTR + (size_t)idx * MTREC_B + 2048 + jg * 16), __builtin_bit_cast(u32x4, eGL)); }
        }
        __syncthreads();
    };
    unsigned* wpflag = (unsigned*)(a->ws + WS_CTL) + CW_WPFLAG + l * 1024;
    auto stepB = [&](int tr) {
        {
            const int idx = 8 * tr + wid;
            const LAS unsigned char* op = lds + wid * WP_SUB; LAS unsigned char* mt = lds + wid * WP_SUB + 4 * 2304;
            const int ro = l15 * CK_ROW + q * 16;
            const bf16x8 at0 = *(const LAS bf16x8*)(op + CK_AT + ro), at1 = *(const LAS bf16x8*)(op + CK_AT + ro + 64), rt0 = *(const LAS bf16x8*)(op + CK_RT + ro), rt1 = *(const LAS bf16x8*)(op + CK_RT + ro + 64);
            const bf16x8 bt0 = *(const LAS bf16x8*)(op + CK_BT + ro), bt1 = *(const LAS bf16x8*)(op + CK_BT + ro + 64), kt0 = *(const LAS bf16x8*)(op + CK_KT + ro), kt1 = *(const LAS bf16x8*)(op + CK_KT + ro + 64);
            const f32x4 z = (f32x4){0.f, 0.f, 0.f, 0.f};
            f32x4 mab = __builtin_amdgcn_mfma_f32_16x16x32_bf16(at0, bt0, z, 0, 0, 0); mab = __builtin_amdgcn_mfma_f32_16x16x32_bf16(at1, bt1, mab, 0, 0, 0);
            f32x4 mak = __builtin_amdgcn_mfma_f32_16x16x32_bf16(at0, kt0, z, 0, 0, 0); mak = __builtin_amdgcn_mfma_f32_16x16x32_bf16(at1, kt1, mak, 0, 0, 0);
            f32x4 mrb = __builtin_amdgcn_mfma_f32_16x16x32_bf16(rt0, bt0, z, 0, 0, 0); mrb = __builtin_amdgcn_mfma_f32_16x16x32_bf16(rt1, bt1, mrb, 0, 0, 0);
            f32x4 mrk = __builtin_amdgcn_mfma_f32_16x16x32_bf16(rt0, kt0, z, 0, 0, 0); mrk = __builtin_amdgcn_mfma_f32_16x16x32_bf16(rt1, kt1, mrk, 0, 0, 0);
            bf16_t* rec = (bf16_t*)(MTR + (size_t)idx * MTREC_B);
            LAS bf16_t* stg = (LAS bf16_t*)(lds + wid * WP_SUB);
            asm volatile("s_waitcnt lgkmcnt(0)" ::: "memory");
#pragma unroll
            for (int rr = 0; rr < 4; ++rr) { const int t_ = 4 * q + rr; const bool lo_ = l15 < t_, le_ = l15 <= t_;
                *(LAS float*)(mt + t_ * 80 + l15 * 4) = lo_ ? mab[rr] : 0.f;
                stg[t_ * 16 + l15] = (bf16_t)f2bf(lo_ ? mak[rr] : 0.f);
                stg[256 + t_ * 16 + l15] = (bf16_t)f2bf(le_ ? mrb[rr] : 0.f);
                stg[512 + t_ * 16 + l15] = (bf16_t)f2bf(le_ ? mrk[rr] : 0.f); }
            asm volatile("s_waitcnt lgkmcnt(0)" ::: "memory");
            float x[16];
#define WP_MLD(t_) f32x4 m_##t_[4]; _Pragma("unroll") for (int s4 = 0; s4 < (t_); s4 += 4) m_##t_[s4 >> 2] = *(const LAS f32x4*)(mt + (t_) * 80 + s4 * 4)
#define WP_TROW(t_) do { float acc_ = (l15 == (t_)) ? 1.f : 0.f; \
                _Pragma("unroll") for (int s4 = 0; s4 < (t_); s4 += 4) { _Pragma("unroll") for (int e = 0; e < 4; ++e) if (s4 + e < (t_)) acc_ += m_##t_[s4 >> 2][e] * x[s4 + e]; } \
                x[t_] = acc_; } while (0)
            x[0] = (l15 == 0) ? 1.f : 0.f;
            { WP_MLD(1); WP_MLD(2); WP_MLD(3); WP_MLD(4); WP_MLD(5); WP_MLD(6); WP_MLD(7); WP_TROW(1); WP_TROW(2); WP_TROW(3); WP_TROW(4); WP_TROW(5); WP_TROW(6); WP_TROW(7); }
            { WP_MLD(8); WP_MLD(9); WP_MLD(10); WP_MLD(11); WP_TROW(8); WP_TROW(9); WP_TROW(10); WP_TROW(11); }
            { WP_MLD(12); WP_MLD(13); WP_MLD(14); WP_MLD(15); WP_TROW(12); WP_TROW(13); WP_TROW(14); WP_TROW(15); }
#undef WP_TROW
#undef WP_MLD
            if (q == 0) {
#pragma unroll
                for (int t_ = 0; t_ < 16; ++t_) stg[768 + t_ * 16 + l15] = (bf16_t)f2bf(x[t_]); }
            asm volatile("s_waitcnt lgkmcnt(0)" ::: "memory");
            pg8::ST16W(rec + lane * 8, *(const LAS u32x4*)((const LAS unsigned char*)stg + lane * 16));
            pg8::ST16W(rec + 512 + lane * 8, *(const LAS u32x4*)((const LAS unsigned char*)stg + 1024 + lane * 16));
        }
        asm volatile("s_waitcnt vmcnt(0)" ::: "memory");
        __syncthreads();
        if (tid == 0) __hip_atomic_store(wpflag + tr, 1u, __ATOMIC_RELAXED, __HIP_MEMORY_SCOPE_AGENT);
    };
    if (first < 1024) loadt(SA, trip_of(first), 2);
#pragma unroll 1
    for (int qq = first; qq < 1024; qq += 2 * stride) {
        const int q1 = qq + stride, q2 = q1 + stride;
        const int tr0 = trip_of(qq), tr1 = q1 < 1024 ? trip_of(q1) : -1, tr2 = q2 < 1024 ? trip_of(q2) : -1;
        body(SA, SB, tr0, tr1); stepB(tr0);
        if (tr1 < 0) break;
        loadt(SB, tr1, 1);
        body(SB, SA, tr1, tr2); stepB(tr1);
        loadt(SA, tr2 >= 0 ? tr2 : tr1, 1);
    }
}

constexpr int WS_SLOT = 5 * 2048 + 3 * 1024, WS_NSLOT = 8, WS_DEPTH = 7, WS_YT = WS_NSLOT * WS_SLOT;
__device__ __forceinline__ void glds16(const void* gsrc, unsigned lds_dst) { unsigned keep;
    asm volatile("s_mov_b32 %0, m0\n\ts_mov_b32 m0, %2\n\ts_nop 0\n\tglobal_load_lds_dwordx4 %1, off\n\ts_mov_b32 m0, %0" : "=&s"(keep) : "v"(gsrc), "s"(lds_dst) : "memory"); }
__device__ __forceinline__ void scan_unit_stream(ArgsP a, int l, int bh, LAS unsigned char* lds) {
    a = args_ptr();
    const int tid = ltid(), lane = tid & 63, wid = __builtin_amdgcn_readfirstlane(tid >> 6), q = lane >> 4, l15 = lane & 15;
    const int b = bh >> 3, h = bh & 7;
    const unsigned char* RKVb = a->ws + A_RKV; const unsigned char* EGb = a->ws + A_LW; const unsigned char* ICb = a->ws + A_ICLR;
    const unsigned char* MTR = (const unsigned char*)a->out + DO_MTREC + (size_t)bh * 256 * MTREC_B;
    bf16_t* Y = (bf16_t*)(a->ws + A_Y);
    unsigned* yflag = (unsigned*)(a->ws + WS_CTL) + CW_YFLAG + l * 1024 + bh * 32;
    constexpr int NCH = SEQ / 16;
    const unsigned lds0 = (unsigned)(uintptr_t)lds;
    if (wid >= 4) {
        const int w = wid - 4, rw = lane >> 3, c16 = ((lane & 7) ^ rw) * 16;
        const int np = (w == 0) ? 4 : 3;
#define WS_ISSUE(cc) do { const size_t row0_ = (size_t)b * SEQ + (size_t)(cc) * 16; const unsigned slot_ = lds0 + (unsigned)(((cc) % WS_NSLOT) * WS_SLOT); \
            _Pragma("unroll") for (int k_ = 0; k_ < 4; ++k_) { const int p_ = w + 4 * k_; if (p_ < 13) { const void* src_; \
                if (p_ < 10) { const int tl_ = p_ >> 1; const size_t r_ = row0_ + 8 * (p_ & 1) + rw; \
                    src_ = tl_ < 3 ? (const void*)(RKVb + (r_ * 1536 + tl_ * 512 + h * 64) * 2 + c16) : (tl_ == 3 ? (const void*)(EGb + (r_ * 512 + h * 64) * 2 + c16) : (const void*)(ICb + (r_ * 512 + h * 64) * 2 + c16)); } \
                else src_ = (const void*)(MTR + (size_t)(cc) * MTREC_B + (p_ - 10) * 1024 + lane * 16); \
                glds16(src_, (unsigned)__builtin_amdgcn_readfirstlane(slot_ + (unsigned)(p_ < 10 ? (p_ >> 1) * 2048 + (p_ & 1) * 1024 : 10240 + (p_ - 10) * 1024))); } } } while (0)
        unsigned* wpflag = (unsigned*)(a->ws + WS_CTL) + CW_WPFLAG + l * 1024 + bh * 32;
        unsigned* tmo = (unsigned*)(a->ws + WS_CTL) + CW_BAR + XB_TMO;
#define WS_GATE(cc) do { if (((cc) & 7) == 0) { unsigned sp_ = 0; \
            while ((unsigned)__builtin_amdgcn_readfirstlane(__hip_atomic_load(wpflag + ((cc) >> 3), __ATOMIC_RELAXED, __HIP_MEMORY_SCOPE_AGENT)) == 0u) { __builtin_amdgcn_s_sleep(2); \
                if ((++sp_ & 255u) == 0u) { if (xb_ld(tmo)) break; if (sp_ > XB_SPIN_CAP) { atomicAdd(tmo, 1u); break; } } } \
            __builtin_amdgcn_fence(__ATOMIC_ACQUIRE, "agent"); } } while (0)
        WS_GATE(0);
#pragma unroll
        for (int cc = 0; cc < WS_DEPTH; ++cc) WS_ISSUE(cc);
        if (w == 0) asm volatile("s_waitcnt vmcnt(24)" ::: "memory"); else asm volatile("s_waitcnt vmcnt(18)" ::: "memory");
        __syncthreads();
        for (int it = 0; it < NCH; ++it) {
            if (it + WS_DEPTH < NCH) { WS_GATE(it + WS_DEPTH); WS_ISSUE(it + WS_DEPTH); if (w == 0) asm volatile("s_waitcnt vmcnt(24)" ::: "memory"); else asm volatile("s_waitcnt vmcnt(18)" ::: "memory"); }
            else asm volatile("s_waitcnt vmcnt(0)" ::: "memory");
            __syncthreads();
        }
#undef WS_ISSUE
#undef WS_GATE
        (void)np;
    } else {
        f32x4 accS[4];
#pragma unroll
        for (int jt = 0; jt < 4; ++jt) accS[jt] = (f32x4){0.f, 0.f, 0.f, 0.f};
        __syncthreads();
        for (int it = 0; it < NCH; ++it) {
            const LAS unsigned char* op = lds + (it % WS_NSLOT) * WS_SLOT; const LAS unsigned char* mt = op + 10240;
            s16x4v sb[4];
#pragma unroll
            for (int jt = 0; jt < 4; ++jt) sb[jt] = pk4(accS[jt]);
#define WS_SW(row, p8) ((row) * 128 + ((((p8) >> 1) ^ ((row) & 7)) << 4) + ((p8) & 1) * 8)
            const int trow = 4 * q + (l15 >> 2);
            const s16x4v vb = ldtr(op + 4096 + WS_SW(trow, (l15 & 3) + 4 * wid));
            f32x4 x1 = (f32x4){0.f, 0.f, 0.f, 0.f}, x2 = x1;
#pragma unroll
            for (int jt = 0; jt < 4; ++jt) {
                const s16x4v a0 = *(const LAS s16x4v*)(op + 0 + WS_SW(l15, q + 4 * jt)), r0 = *(const LAS s16x4v*)(op + 2048 + WS_SW(l15, q + 4 * jt));
                x1 = __builtin_amdgcn_mfma_f32_16x16x16bf16_1k(a0, sb[jt], x1, 0, 0, 0);
                x2 = __builtin_amdgcn_mfma_f32_16x16x16bf16_1k(r0, sb[jt], x2, 0, 0, 0);
            }
            const s16x4v mak = *(const LAS s16x4v*)(mt + 0 + l15 * 32 + q * 8), mrb = *(const LAS s16x4v*)(mt + 512 + l15 * 32 + q * 8);
            const s16x4v mrk = *(const LAS s16x4v*)(mt + 1024 + l15 * 32 + q * 8), tt = *(const LAS s16x4v*)(mt + 1536 + l15 * 32 + q * 8);
            x1 = __builtin_amdgcn_mfma_f32_16x16x16bf16_1k(mak, vb, x1, 0, 0, 0);
            x2 = __builtin_amdgcn_mfma_f32_16x16x16bf16_1k(mrk, vb, x2, 0, 0, 0);
            const f32x4 u = __builtin_amdgcn_mfma_f32_16x16x16bf16_1k(tt, pk4(x1), (f32x4){0.f, 0.f, 0.f, 0.f}, 0, 0, 0);
            const s16x4v ub = pk4(u);
            const f32x4 yv = __builtin_amdgcn_mfma_f32_16x16x16bf16_1k(mrb, ub, x2, 0, 0, 0);
            const bf16x8 uv = (bf16x8){ub[0], ub[1], ub[2], ub[3], vb[0], vb[1], vb[2], vb[3]};
#pragma unroll
            for (int jt = 0; jt < 4; ++jt) {
                const f32x4 gl = *(const LAS f32x4*)(mt + 2048 + (16 * jt + 4 * q) * 4);
                const s16x4v b0 = ldtr(op + 6144 + WS_SW(trow, (l15 & 3) + 4 * jt)), k0 = ldtr(op + 8192 + WS_SW(trow, (l15 & 3) + 4 * jt));
                accS[jt] = __builtin_amdgcn_mfma_f32_16x16x32_bf16((bf16x8){b0[0], b0[1], b0[2], b0[3], k0[0], k0[1], k0[2], k0[3]}, uv, accS[jt], 0, 0, 0) * gl;
            }
            LAS float* yt = (LAS float*)(lds + WS_YT + wid * 1024);
#pragma unroll
            for (int rr = 0; rr < 4; ++rr) yt[(4 * q + rr) * 16 + l15] = yv[rr];
            asm volatile("s_waitcnt lgkmcnt(0)" ::: "memory");
            { const int t_ = lane >> 2, ip = (lane & 3) * 4; const f32x4 yr = *(const LAS f32x4*)(yt + t_ * 16 + ip);
              pg8::ST8W(Y + ((size_t)b * SEQ + it * 16 + t_) * 512 + h * 64 + 16 * wid + ip, dn4(yr)); }
            const bool pub_ = ((it & 7) == 7) && it >= 15;
            if (pub_) asm volatile("s_waitcnt vmcnt(8)" ::: "memory");
            __syncthreads();
            if (pub_ && tid == 0) __hip_atomic_store(yflag + ((it - 15) >> 3), 1u, __ATOMIC_RELAXED, __HIP_MEMORY_SCOPE_AGENT);
        }
        asm volatile("s_waitcnt vmcnt(0)" ::: "memory");
#undef WS_SW
    }
    __syncthreads();
    if (tid == 0) __hip_atomic_store(yflag + 31, 1u, __ATOMIC_RELAXED, __HIP_MEMORY_SCOPE_AGENT);
}

__device__ __forceinline__ int crow(int r, int hi) { return (r & 3) + 8 * (r >> 2) + 4 * hi; }
constexpr int AT_KROW = 208, AT_VROW = 136, AT_KBUF = 64 * AT_KROW, AT_VBUF = 64 * AT_VROW, AT_V0 = 2 * AT_KBUF;
__device__ __forceinline__ void attn_unit(ArgsP a, int bh, int qb, LAS unsigned char* lds, size_t o_off = A_QN) {
    a = args_ptr();
    const int tid = ltid(), lane = tid & 63, wid = tid >> 6, r32 = lane & 31, hi = lane >> 5;
    const int b = bh >> 3, h = bh & 7, q0 = qb * 256, qw0 = q0 + wid * 32;
    const size_t rowb = (size_t)b * SEQ;
    const bf16_t* Qn = (const bf16_t*)(a->ws + A_QN); const bf16_t* Qp = (const bf16_t*)(a->ws + A_QP); const bf16_t* Kn = (const bf16_t*)(a->ws + A_KN);
    const bf16_t* KPE = (const bf16_t*)(a->ws + A_KPE); const bf16_t* Vt = (const bf16_t*)(a->ws + A_VT); bf16_t* O = (bf16_t*)(a->ws + o_off);
    bf16x8 qf[6];
    { const size_t qrow = rowb + qw0 + r32;
#pragma unroll
      for (int ds = 0; ds < 4; ++ds) qf[ds] = *(const bf16x8*)(Qn + qrow * 512 + h * 64 + ds * 16 + hi * 8);
#pragma unroll
      for (int ds = 0; ds < 2; ++ds) qf[4 + ds] = *(const bf16x8*)(Qp + qrow * 256 + h * 32 + ds * 16 + hi * 8); }
    const int NT = 4 * qb + 4;
    const bf16_t* ksrc = Kn + (rowb + (tid >> 3)) * 512 + h * 64 + (tid & 7) * 8;
    const bf16_t* psrc = KPE + (rowb + ((tid & 255) >> 2)) * 32 + (tid & 3) * 8;
    const bf16_t* vsrc = Vt + ((size_t)(bh * 64 + (tid >> 3)) << 12) + (tid & 7) * 8;
    const int kdst = (tid >> 3) * AT_KROW + (tid & 7) * 16, pdst = ((tid & 255) >> 2) * AT_KROW + 128 + (tid & 3) * 16, vdst = AT_V0 + (tid >> 3) * AT_VROW + (tid & 7) * 16;
    u32x4 rk0, rp0 = (u32x4){0u, 0u, 0u, 0u}, rv0, rk1, rp1 = rp0, rv1;
#define AT_LOAD(S, tt) do { rk##S = *(const u32x4*)(ksrc + (size_t)(tt) * 64 * 512); if (tid < 256) rp##S = *(const u32x4*)(psrc + (size_t)(tt) * 64 * 32); rv##S = *(const u32x4*)(vsrc + (tt) * 64); } while (0)
#define AT_WRITE(S, p) do { *(LAS u32x4*)(lds + (p) * AT_KBUF + kdst) = rk##S; if (tid < 256) *(LAS u32x4*)(lds + (p) * AT_KBUF + pdst) = rp##S; \
        *(LAS u32x2*)(lds + (p) * AT_VBUF + vdst) = (u32x2){rv##S.x, rv##S.y}; *(LAS u32x2*)(lds + (p) * AT_VBUF + vdst + 8) = (u32x2){rv##S.z, rv##S.w}; } while (0)
    AT_LOAD(0, 0); AT_WRITE(0, 0); AT_LOAD(0, 1);
    __syncthreads();
    float mrun = -INFINITY, lrun = 0.f;
    f32x16 o0, o1;
#pragma unroll
    for (int r = 0; r < 16; ++r) { o0[r] = 0.f; o1[r] = 0.f; }
    for (int t2 = 0; t2 < NT; t2 += 2)
#pragma unroll
    for (int tp = 0; tp < 2; ++tp) {
        const int t = t2 + tp, cur = tp;
        if (t + 2 < NT) { if (tp == 0) AT_LOAD(1, t + 2); else AT_LOAD(0, t + 2); }
        if (64 * t <= qw0 + 31) {
            const LAS unsigned char* Kb = lds + cur * AT_KBUF + r32 * AT_KROW + hi * 16;
            f32x16 p0, p1;
#pragma unroll
            for (int r = 0; r < 16; ++r) { p0[r] = 0.f; p1[r] = 0.f; }
#pragma unroll
            for (int ds = 0; ds < 6; ++ds) {
                const bf16x8 k0 = *(const LAS bf16x8*)(Kb + ds * 32), k1 = *(const LAS bf16x8*)(Kb + 32 * AT_KROW + ds * 32);
                p0 = __builtin_amdgcn_mfma_f32_32x32x16_bf16(k0, qf[ds], p0, 0, 0, 0);
                p1 = __builtin_amdgcn_mfma_f32_32x32x16_bf16(k1, qf[ds], p1, 0, 0, 0);
            }
            if (64 * t + 63 > qw0) {
                const int q = qw0 + r32;
#pragma unroll
                for (int r = 0; r < 16; ++r) { const int kv = 64 * t + crow(r, hi); if (kv > q) p0[r] = -INFINITY; if (kv + 32 > q) p1[r] = -INFINITY; }
            }
            float mx = fmaxf(p0[0], p1[0]);
#pragma unroll
            for (int r = 1; r < 16; ++r) mx = fmaxf(mx, fmaxf(p0[r], p1[r]));
            mx = fmaxf(mx, shx(mx, 32));
            const float mnew = fmaxf(mrun, mx), alpha = __builtin_amdgcn_exp2f(mrun - mnew);
            mrun = mnew;
            float ps = 0.f;
#pragma unroll
            for (int r = 0; r < 16; ++r) { p0[r] = __builtin_amdgcn_exp2f(p0[r] - mnew); p1[r] = __builtin_amdgcn_exp2f(p1[r] - mnew); ps += p0[r] + p1[r]; }
            lrun = lrun * alpha + ps;
#pragma unroll
            for (int r = 0; r < 16; ++r) { o0[r] *= alpha; o1[r] *= alpha; }
            bf16x8 pf[4];
#pragma unroll
            for (int ks = 0; ks < 4; ++ks) {
                u32x4 w;
                if (ks < 2) { w.x = pk2(p0[8 * ks + 0], p0[8 * ks + 1]); w.y = pk2(p0[8 * ks + 2], p0[8 * ks + 3]); w.z = pk2(p0[8 * ks + 4], p0[8 * ks + 5]); w.w = pk2(p0[8 * ks + 6], p0[8 * ks + 7]); }
                else { const int k2 = ks - 2; w.x = pk2(p1[8 * k2 + 0], p1[8 * k2 + 1]); w.y = pk2(p1[8 * k2 + 2], p1[8 * k2 + 3]); w.z = pk2(p1[8 * k2 + 4], p1[8 * k2 + 5]); w.w = pk2(p1[8 * k2 + 6], p1[8 * k2 + 7]); }
                pf[ks] = __builtin_bit_cast(bf16x8, w);
            }
            const LAS unsigned char* Vb = lds + AT_V0 + cur * AT_VBUF + r32 * AT_VROW + hi * 8;
#pragma unroll
            for (int ks = 0; ks < 4; ++ks) {
                const s16x4 a0 = *(const LAS s16x4*)(Vb + ks * 32), a1 = *(const LAS s16x4*)(Vb + ks * 32 + 16);
                const s16x4 c0 = *(const LAS s16x4*)(Vb + 32 * AT_VROW + ks * 32), c1 = *(const LAS s16x4*)(Vb + 32 * AT_VROW + ks * 32 + 16);
                const bf16x8 vf0 = (bf16x8){a0[0], a0[1], a0[2], a0[3], a1[0], a1[1], a1[2], a1[3]}, vf1 = (bf16x8){c0[0], c0[1], c0[2], c0[3], c1[0], c1[1], c1[2], c1[3]};
                o0 = __builtin_amdgcn_mfma_f32_32x32x16_bf16(vf0, pf[ks], o0, 0, 0, 0);
                o1 = __builtin_amdgcn_mfma_f32_32x32x16_bf16(vf1, pf[ks], o1, 0, 0, 0);
            }
        }
        if (t + 1 < NT) { if (tp == 0) AT_WRITE(0, 1); else AT_WRITE(1, 0); }
        __syncthreads();
    }
#undef AT_WRITE
#undef AT_LOAD
    const float ltot = lrun + shx(lrun, 32), inv = 1.0f / ltot;
    bf16_t* orow = O + (rowb + qw0 + r32) * 512 + h * 64 + 4 * hi;
#pragma unroll
    for (int g = 0; g < 4; ++g) {
        *(u32x2*)(orow + 8 * g) = (u32x2){pk2(o0[4 * g] * inv, o0[4 * g + 1] * inv), pk2(o0[4 * g + 2] * inv, o0[4 * g + 3] * inv)};
        *(u32x2*)(orow + 32 + 8 * g) = (u32x2){pk2(o1[4 * g] * inv, o1[4 * g + 1] * inv), pk2(o1[4 * g + 2] * inv, o1[4 * g + 3] * inv)};
    }
}


__device__ __forceinline__ void attn_unit_naive(ArgsP a, int bh, int qb, LAS unsigned char* lds) {
    a = args_ptr();
    const int tid = vtid(), lane = tid & 63, wid = tid >> 6;
    const int b = bh >> 3, h = bh & 7; const size_t rowb = (size_t)b * SEQ;
    const bf16_t* Qn = (const bf16_t*)(a->ws + A_QN); const bf16_t* Qp = (const bf16_t*)(a->ws + A_QP); const bf16_t* Kn = (const bf16_t*)(a->ws + A_KN);
    const bf16_t* KPE = (const bf16_t*)(a->ws + A_KPE); const bf16_t* Vt = (const bf16_t*)(a->ws + A_VT); bf16_t* O = (bf16_t*)(a->ws + A_QN);
    LAS float* sc = (LAS float*)(lds + wid * 16384);
    for (int i = 0; i < 32; ++i) {
        const int q = qb * 256 + wid * 32 + i; const size_t qrow = rowb + q;
        float mx = -INFINITY;
        for (int k0 = 0; k0 <= q; k0 += 64) {
            const int key = k0 + lane; float sv = -INFINITY;
            if (key <= q) { sv = 0.f;
                for (int d = 0; d < 64; ++d) sv += bf2f(Qn[qrow * 512 + h * 64 + d]) * bf2f(Kn[(rowb + key) * 512 + h * 64 + d]);
                for (int d = 0; d < 32; ++d) sv += bf2f(Qp[qrow * 256 + h * 32 + d]) * bf2f(KPE[(rowb + key) * 32 + d]); }
            sc[key] = sv; mx = fmaxf(mx, sv);
        }
        for (int o = 1; o < 64; o <<= 1) mx = fmaxf(mx, shx(mx, o));
        float sum = 0.f;
        for (int k0 = 0; k0 <= q; k0 += 64) { const int key = k0 + lane; const float p = key <= q ? exp2f(sc[key] - mx) : 0.f; sc[key] = p; sum += p; }
        for (int o = 1; o < 64; o <<= 1) sum += shx(sum, o);
        asm volatile("s_waitcnt lgkmcnt(0)" ::: "memory");
        float acc = 0.f;
        const bf16_t* vp = Vt + ((size_t)(bh * 64 + lane) << 12);
        for (int key = 0; key <= q; ++key) acc += sc[key] * bf2f(vp[key]);
        asm volatile("s_waitcnt lgkmcnt(0)" ::: "memory");
        O[qrow * 512 + h * 64 + lane] = (bf16_t)f2bf(acc / sum);
    }
}
__device__ __forceinline__ void ya_item(ArgsP a, int l, int bh, int gq) {
    a = args_ptr();
    const int tid = ltid();
    if (tid < 64) {
        unsigned* fl = (unsigned*)(a->ws + WS_CTL) + CW_YFLAG + l * 1024 + bh * 32 + gq * 4; unsigned* tmo = (unsigned*)(a->ws + WS_CTL) + CW_BAR + XB_TMO; unsigned sp_ = 0;
        for (;;) { const unsigned f_ = __hip_atomic_load(fl, __ATOMIC_RELAXED, __HIP_MEMORY_SCOPE_AGENT) & __hip_atomic_load(fl + 1, __ATOMIC_RELAXED, __HIP_MEMORY_SCOPE_AGENT)
                                      & __hip_atomic_load(fl + 2, __ATOMIC_RELAXED, __HIP_MEMORY_SCOPE_AGENT) & __hip_atomic_load(fl + 3, __ATOMIC_RELAXED, __HIP_MEMORY_SCOPE_AGENT);
            if ((unsigned)__builtin_amdgcn_readfirstlane(f_) != 0u) break;
            __builtin_amdgcn_s_sleep(2);
            if ((++sp_ & 255u) == 0u) { if (xb_ld(tmo)) break; if (sp_ > XB_SPIN_CAP) { atomicAdd(tmo, 1u); break; } } }
        __builtin_amdgcn_fence(__ATOMIC_ACQUIRE, "agent");
    }
    __syncthreads();
    const int h = bh & 7, c = h * 64 + (tid & 7) * 8; const size_t r0 = (size_t)(bh >> 3) * SEQ + (size_t)gq * 512 + (tid >> 3);
    const bf16_t* Y = (const bf16_t*)(a->ws + A_Y); const bf16_t* RKV = (const bf16_t*)(a->ws + A_RKV); const bf16_t* GATE = (const bf16_t*)(a->ws + A_GATE);
    const float* SCAL = (const float*)(a->ws + WS_SCAL); bf16_t* YA = (bf16_t*)(a->ws + A_YA);
    const float* lw = a->in[I_LNXW] + l * 512 + c; const float* lb = a->in[I_LNXB] + l * 512 + c;
    const f32x4 w0 = *(const f32x4*)lw, w1 = *(const f32x4*)(lw + 4), b0 = *(const f32x4*)lb, b1 = *(const f32x4*)(lb + 4);
    u32x4 yu[8], vu[8], gu[8]; float sc[8];
#pragma unroll
    for (int k = 0; k < 8; ++k) { const size_t row = r0 + 64 * k;
        yu[k] = *(const u32x4*)(Y + row * 512 + c); vu[k] = *(const u32x4*)(RKV + row * 1536 + 1024 + c);
        gu[k] = *(const u32x4*)(GATE + row * 512 + c); sc[k] = SCAL[row * 8 + h]; }
#pragma unroll
    for (int k = 0; k < 8; ++k) {
        const f32x4 ya0 = up4((u32x2){yu[k].x, yu[k].y}), ya1 = up4((u32x2){yu[k].z, yu[k].w});
        float sm = ((ya0.x + ya0.y) + (ya0.z + ya0.w)) + ((ya1.x + ya1.y) + (ya1.z + ya1.w));
        sm += shx(sm, 1); sm += shx(sm, 2); sm += shx(sm, 4);
        const float mean = sm * (1.0f / 64.0f);
        const f32x4 d0 = ya0 - mean, d1 = ya1 - mean;
        float qv = dot4(d0, d0) + dot4(d1, d1);
        qv += shx(qv, 1); qv += shx(qv, 2); qv += shx(qv, 4);
        const float rstd = rsqrtf(qv * (1.0f / 64.0f) + LNX_EPS);
        const f32x4 vv0 = up4((u32x2){vu[k].x, vu[k].y}), vv1 = up4((u32x2){vu[k].z, vu[k].w});
        const f32x4 g0 = up4((u32x2){gu[k].x, gu[k].y}), g1 = up4((u32x2){gu[k].z, gu[k].w});
        const f32x4 o0 = (d0 * rstd * w0 + b0 + vv0 * sc[k]) * g0, o1 = (d1 * rstd * w1 + b1 + vv1 * sc[k]) * g1;
        const u32x2 p0 = dn4(o0), p1 = dn4(o1);
        *(u32x4*)(YA + (r0 + 64 * k) * 512 + c) = (u32x4){p0.x, p0.y, p1.x, p1.y};
    }
}
#if NAIVE_ATTN
#define ATTN_UNIT attn_unit_naive
#else
#define ATTN_UNIT attn_unit
#endif
__device__ __forceinline__ void phase_ya(ArgsP a, int l) {
    a = args_ptr();
    const unsigned gt = blockIdx.x * NTHREADS + ltid(), NGT = gridDim.x * NTHREADS;
    const bf16_t* Y = (const bf16_t*)(a->ws + A_Y); const bf16_t* RKV = (const bf16_t*)(a->ws + A_RKV); const bf16_t* GATE = (const bf16_t*)(a->ws + A_GATE);
    const float* SCAL = (const float*)(a->ws + WS_SCAL); bf16_t* YA = (bf16_t*)(a->ws + A_YA);
    const int c = (gt & 63) * 8, h = c >> 6;
    const float* muv = a->in[I_MU] + (size_t)l * 1792 + 1024 + c; const float* lw = a->in[I_LNXW] + l * 512 + c; const float* lb = a->in[I_LNXB] + l * 512 + c;
    const f32x4 m0 = *(const f32x4*)muv, m1 = *(const f32x4*)(muv + 4), w0 = *(const f32x4*)lw, w1 = *(const f32x4*)(lw + 4), b0 = *(const f32x4*)lb, b1 = *(const f32x4*)(lb + 4);
    for (unsigned i = gt; i < (unsigned)M * 64; i += 2 * NGT) {
        u32x4 yu[2], v2u[2], v1u[2], gu[2]; float sc[2]; unsigned rowv[2];
#pragma unroll
        for (int k = 0; k < 2; ++k) { const unsigned row = (i + k * NGT) >> 6; const int t = row & 4095; rowv[k] = row;
            yu[k] = *(const u32x4*)(Y + (size_t)row * 512 + c); v2u[k] = *(const u32x4*)(RKV + (size_t)row * 1536 + 1024 + c);
            v1u[k] = WKV_STREAM ? v2u[k] : (t ? *(const u32x4*)(RKV + (size_t)(row - 1) * 1536 + 1024 + c) : (u32x4){0u, 0u, 0u, 0u});
            gu[k] = *(const u32x4*)(GATE + (size_t)row * 512 + c); sc[k] = SCAL[(size_t)row * 8 + h]; }
#pragma unroll
        for (int k = 0; k < 2; ++k) {
            const f32x4 ya0 = up4((u32x2){yu[k].x, yu[k].y}), ya1 = up4((u32x2){yu[k].z, yu[k].w});
            float sm = ((ya0.x + ya0.y) + (ya0.z + ya0.w)) + ((ya1.x + ya1.y) + (ya1.z + ya1.w));
            sm += shx(sm, 1); sm += shx(sm, 2); sm += shx(sm, 4);
            const float mean = sm * (1.0f / 64.0f);
            const f32x4 d0 = ya0 - mean, d1 = ya1 - mean;
            float qv = dot4(d0, d0) + dot4(d1, d1);
            qv += shx(qv, 1); qv += shx(qv, 2); qv += shx(qv, 4);
            const float rstd = rsqrtf(qv * (1.0f / 64.0f) + LNX_EPS);
            const f32x4 v20 = up4((u32x2){v2u[k].x, v2u[k].y}), v21 = up4((u32x2){v2u[k].z, v2u[k].w}), v10 = up4((u32x2){v1u[k].x, v1u[k].y}), v11 = up4((u32x2){v1u[k].z, v1u[k].w});
            const f32x4 vv0 = v20 + (v10 - v20) * m0, vv1 = v21 + (v11 - v21) * m1;
            const f32x4 g0 = up4((u32x2){gu[k].x, gu[k].y}), g1 = up4((u32x2){gu[k].z, gu[k].w});
            const f32x4 o0 = (d0 * rstd * w0 + b0 + vv0 * sc[k]) * g0, o1 = (d1 * rstd * w1 + b1 + vv1 * sc[k]) * g1;
            const u32x2 p0 = dn4(o0), p1 = dn4(o1);
            *(u32x4*)(YA + (size_t)rowv[k] * 512 + c) = (u32x4){p0.x, p0.y, p1.x, p1.y};
        }
    }
}


__device__ __forceinline__ void phase_gconv(ArgsP a, int l) {
    a = args_ptr();
    const unsigned gt = blockIdx.x * NTHREADS + ltid();
    constexpr unsigned NCHK = FF / 8, NSEG = 372, SEGR = (M + NSEG - 1) / NSEG;
    if (gt >= NCHK * NSEG) return;
    const unsigned chk = gt % NCHK, seg = gt / NCHK; const int c = chk * 8;
    const bf16_t* UG = (const bf16_t*)(a->ws + A_UG); bf16_t* GC = (bf16_t*)(a->ws + A_ACT);
    const float* cw = a->in[I_CONVW] + (size_t)l * 3 * FF + c; const float* cb = a->in[I_CONVB] + (size_t)l * FF + c;
    const f32x4 w0a = *(const f32x4*)cw, w0b = *(const f32x4*)(cw + 4), w1a = *(const f32x4*)(cw + FF), w1b = *(const f32x4*)(cw + FF + 4), w2a = *(const f32x4*)(cw + 2 * FF), w2b = *(const f32x4*)(cw + 2 * FF + 4);
    const f32x4 ba = *(const f32x4*)cb, bb = *(const f32x4*)(cb + 4);
    const unsigned r0 = seg * SEGR, r1 = (r0 + SEGR < (unsigned)M) ? r0 + SEGR : (unsigned)M;
    const u32x4 z = (u32x4){0u, 0u, 0u, 0u};
    u32x4 p1 = ((r0 & 4095u) >= 1u) ? *(const u32x4*)(UG + (size_t)(r0 - 1) * FF + c) : z, p2 = ((r0 & 4095u) >= 2u) ? *(const u32x4*)(UG + (size_t)(r0 - 2) * FF + c) : z;
    u32x4 nx = *(const u32x4*)(UG + (size_t)r0 * FF + c);
    for (unsigned r = r0; r < r1; ++r) {
        const u32x4 cur = nx;
        if (r + 1 < r1) nx = *(const u32x4*)(UG + (size_t)(r + 1) * FF + c);
        if ((r & 4095u) == 0u) { p1 = z; p2 = z; }
        const f32x4 x2a = up4((u32x2){cur.x, cur.y}), x2b = up4((u32x2){cur.z, cur.w}), x1a = up4((u32x2){p1.x, p1.y}), x1b = up4((u32x2){p1.z, p1.w}), x0a = up4((u32x2){p2.x, p2.y}), x0b = up4((u32x2){p2.z, p2.w});
        const f32x4 ca = ba + w0a * x0a + w1a * x1a + w2a * x2a, cc = bb + w0b * x0b + w1b * x1b + w2b * x2b;
        const pg8::f32x2 g0 = pg8::gelu_pk2((pg8::f32x2){ca.x, ca.y}), g1 = pg8::gelu_pk2((pg8::f32x2){ca.z, ca.w}), g2 = pg8::gelu_pk2((pg8::f32x2){cc.x, cc.y}), g3 = pg8::gelu_pk2((pg8::f32x2){cc.z, cc.w});
        *(u32x4*)(GC + (size_t)r * FF + c) = (u32x4){pk2(g0.x, g0.y), pk2(g1.x, g1.y), pk2(g2.x, g2.y), pk2(g3.x, g3.y)};
        p2 = p1; p1 = cur;
    }
}
__device__ __forceinline__ void ffn_halo_fix(ArgsP a, int l, int pm) {
    a = args_ptr();
    const int tid = ltid();
    const bf16_t* RAWH = (const bf16_t*)(a->ws + A_UG); bf16_t* ACT = (bf16_t*)(a->ws + A_ACT);
    const float* cw = a->in[I_CONVW] + (size_t)l * 3 * FF; const float* cb = a->in[I_CONVB] + (size_t)l * FF;
    for (int i = tid; i < 8 * (FF / 8); i += NTHREADS) {
        const int hr = i / (FF / 8), c = (i % (FF / 8)) * 8, blk = pm * 4 + (hr >> 1), fr = hr & 1, row = blk * 64 + fr;
        const bool first = (row & 4095) < 2; const bf16_t* hb = RAWH + (size_t)blk * 6 * FF + c; const u32x4 z = (u32x4){0u, 0u, 0u, 0u};
        const u32x4 cur = *(const u32x4*)(hb + (2 + fr) * FF), val = *(const u32x4*)(hb + (4 + fr) * FF);
        const u32x4 p1 = (fr == 0) ? (first ? z : *(const u32x4*)(hb - 5 * FF)) : *(const u32x4*)(hb + 2 * FF);
        const u32x4 p2 = first ? z : *(const u32x4*)(hb - (fr == 0 ? 6 : 5) * FF);
        const f32x4 w0a = *(const f32x4*)(cw + c), w0b = *(const f32x4*)(cw + c + 4), w1a = *(const f32x4*)(cw + FF + c), w1b = *(const f32x4*)(cw + FF + c + 4);
        const f32x4 w2a = *(const f32x4*)(cw + 2 * FF + c), w2b = *(const f32x4*)(cw + 2 * FF + c + 4), ba = *(const f32x4*)(cb + c), bb = *(const f32x4*)(cb + c + 4);
        const f32x4 ga = pg8::gelu4(ba + w0a * up4((u32x2){p2.x, p2.y}) + w1a * up4((u32x2){p1.x, p1.y}) + w2a * up4((u32x2){cur.x, cur.y}));
        const f32x4 gb = pg8::gelu4(bb + w0b * up4((u32x2){p2.z, p2.w}) + w1b * up4((u32x2){p1.z, p1.w}) + w2b * up4((u32x2){cur.z, cur.w}));
        *(u32x4*)(ACT + (size_t)row * FF + c) = pg8::pack8(ga * up4((u32x2){val.x, val.y}), gb * up4((u32x2){val.z, val.w}));
    }
    asm volatile("s_waitcnt vmcnt(0)" ::: "memory");
    __syncthreads();
}
__device__ __forceinline__ void phase_final(ArgsP a) {
    a = args_ptr();
    const int tid = ltid(), lane = tid & 63, gw = blockIdx.x * NWAVES + (tid >> 6), NGW = gridDim.x * NWAVES;
    const float* SS4 = (const float*)(a->ws + WS_SSP) + (size_t)4 * M * 16; const f32x4* g = (const f32x4*)a->in[I_FINAL] + lane; const bf16_t* HB = (const bf16_t*)(a->ws + A_HB);
    for (int m = gw; m < M; m += NGW) {
        const float rs = rsqrtf(pg8::sum16(SS4 + (size_t)m * 16) * (1.0f / 1024.0f) + NORM_EPS);
        f32x4* o = (f32x4*)(a->out + (size_t)m * DM) + lane; const u32x2* hb = (const u32x2*)(HB + (size_t)m * DM) + lane;
#pragma unroll
        for (int j = 0; j < 4; ++j) o[64 * j] = up4(hb[64 * j]) * rs * g[64 * j];
    }
}


#ifndef DUMP_MIB
#define DUMP_MIB 0
#endif
#ifndef DUMP_OFF_MIB
#define DUMP_OFF_MIB 0
#endif
__device__ __forceinline__ void phase_dump(ArgsP a) {
    a = args_ptr();
    const size_t n16 = (size_t)DUMP_MIB * 1024 * 512, nout = (size_t)M * DM;
    const unsigned short* src = (const unsigned short*)(a->ws + (size_t)DUMP_OFF_MIB * 1024 * 1024);
    for (size_t i = (size_t)blockIdx.x * NTHREADS + vtid(); i < nout; i += (size_t)gridDim.x * NTHREADS) {
        float sacc = 0.f; for (size_t j = i; j < n16; j += nout) sacc += (float)src[j] * (1.0f / 65536.0f);
        a->out[i] = sacc; }
}

#ifndef CHK_ONLY
#define CHK_ONLY 0
#endif
#ifdef CHKSUM_PROBE
__device__ __forceinline__ void phase_chk_sum(ArgsP a) {
    a = args_ptr(); unsigned* ctl = (unsigned*)(a->ws + WS_CTL) + 32768;
    const size_t offs[4] = {A_Y, A_QN, WS_SCAL, A_YA}; const unsigned n16[4] = {(unsigned)M * 512u, (unsigned)M * 512u, (unsigned)M * 16u, 0u};
    for (int k = 0; k < 3; ++k) { const unsigned short* p = (const unsigned short*)(a->ws + offs[k]); unsigned acc = 0;
        for (unsigned i = blockIdx.x * NTHREADS + vtid(); i < n16[k]; i += gridDim.x * NTHREADS) acc += p[i];
        for (int o = 1; o < 64; o <<= 1) acc += shx(acc, o);
        if ((vtid() & 63) == 0) atomicAdd(ctl + 64 * k, acc); }
}
__device__ __forceinline__ void phase_chk_out(ArgsP a) {
    a = args_ptr(); const unsigned* ctl = (const unsigned*)(a->ws + WS_CTL) + 32768;
    for (unsigned i = blockIdx.x * NTHREADS + vtid(); i < (unsigned)(M * DM); i += gridDim.x * NTHREADS) {
        float v = 0.f; if (i == CHK_ONLY) v = (float)(__hip_atomic_load(ctl + 64 * i, __ATOMIC_RELAXED, __HIP_MEMORY_SCOPE_AGENT) % CHKSUM_PROBE) * 100.0f; a->out[i] = v; }
}
#endif

#ifdef CMPY_PROBE
__device__ __forceinline__ void phase_cmp_y(ArgsP a) {
    a = args_ptr(); unsigned long long* ctl = (unsigned long long*)(a->ws + WS_CTL) + 20000;
    const unsigned short* y1 = (const unsigned short*)(a->ws + A_Y); const unsigned short* y2 = (const unsigned short*)(a->ws + A_GATE);
    float sd = 0.f, sy = 0.f;
    for (unsigned i = blockIdx.x * NTHREADS + vtid(); i < (unsigned)M * 512u; i += gridDim.x * NTHREADS) { const float p = bf2f(y1[i]), r = bf2f(y2[i]); sd += (p - r) * (p - r); sy += r * r; }
    atomicAdd(ctl, (unsigned long long)(sd * 1024.0f)); atomicAdd(ctl + 8, (unsigned long long)(sy * 1024.0f));
}
__device__ __forceinline__ void phase_cmp_out(ArgsP a) {
    a = args_ptr(); const unsigned long long* ctl = (const unsigned long long*)(a->ws + WS_CTL) + 20000;
    const float rel = sqrtf((float)__hip_atomic_load(ctl, __ATOMIC_RELAXED, __HIP_MEMORY_SCOPE_AGENT) / (float)__hip_atomic_load(ctl + 8, __ATOMIC_RELAXED, __HIP_MEMORY_SCOPE_AGENT));
    for (unsigned i = blockIdx.x * NTHREADS + vtid(); i < (unsigned)(M * DM); i += gridDim.x * NTHREADS) a->out[i] = (i == 0) ? floorf(rel * 10000.0f) : 0.f;
}
#endif

#ifdef CK_TIME
__device__ __forceinline__ void phase_time_out(ArgsP a) {
    a = args_ptr(); const unsigned long long* tw = (const unsigned long long*)(a->ws + WS_CTL) + 24000;
#ifdef CK_TIME_TOTAL
    const float frac = (float)__hip_atomic_load(tw + 8, __ATOMIC_RELAXED, __HIP_MEMORY_SCOPE_AGENT) * (1.0f / 100000.0f);
    for (unsigned i = blockIdx.x * NTHREADS + vtid(); i < (unsigned)(M * DM); i += gridDim.x * NTHREADS) a->out[i] = (i == 0) ? floorf(frac) * 100.0f : 0.f;
#else
    const float frac = (float)__hip_atomic_load(tw + CK_TIME, __ATOMIC_RELAXED, __HIP_MEMORY_SCOPE_AGENT) / (float)__hip_atomic_load(tw + 8, __ATOMIC_RELAXED, __HIP_MEMORY_SCOPE_AGENT);
    for (unsigned i = blockIdx.x * NTHREADS + vtid(); i < (unsigned)(M * DM); i += gridDim.x * NTHREADS) a->out[i] = (i == 0) ? floorf(frac * 8.0f + 0.5f) * 1000.0f : 0.f;
#endif
}
#endif

#ifdef PH_TIME
__device__ __forceinline__ void phase_phtime_out(ArgsP a) {
    a = args_ptr(); const unsigned long long* tw = (const unsigned long long*)(a->ws + WS_CTL) + 26000;
    const float us = (float)(__hip_atomic_load(tw + PH_TIME + 1, __ATOMIC_RELAXED, __HIP_MEMORY_SCOPE_AGENT) - __hip_atomic_load(tw + PH_TIME, __ATOMIC_RELAXED, __HIP_MEMORY_SCOPE_AGENT)) * 0.01f;
    for (unsigned i = blockIdx.x * NTHREADS + vtid(); i < (unsigned)(M * DM); i += gridDim.x * NTHREADS) a->out[i] = (i == 0) ? floorf(us / (float)PH_Q + 0.5f) * 100.0f : 0.f;
}
#endif
#ifdef SPLIT_SCAN_ATTN
constexpr int PH_EXTRA = 1;
#else
constexpr int PH_EXTRA = 0;
#endif
constexpr int PH_PER_LAYER = 9 + PH_EXTRA, N_PHASES = 2 * PH_PER_LAYER + 1;
__global__ void __launch_bounds__(NTHREADS, 2) mk_fwd(Args a_unused) {
    LAS unsigned char* lds = (LAS unsigned char*)lds_raw;
    { const unsigned t0_ = threadIdx.x; if ((t0_ & 63u) == 0u) *(volatile LAS unsigned*)(lds + WTAB_OFF + hw_wave_key() * 4u) = t0_ >> 6; }
    __syncthreads();
#if !MK_MULTI
    if (args_ptr()->ph_lo > 1000000) cg::this_grid().sync();
    volatile LAS unsigned* MISC = (volatile LAS unsigned*)(lds + MISC_OFF);
    if (vtid() < 32) MISC[vtid()] = 0u;
    __syncthreads();
    (void)xcd_barrier_post((unsigned*)(args_ptr()->ws + WS_CTL) + CW_BAR, MISC + 8);
#endif
    int ph = 0;
#ifdef PH_TIME
    if (blockIdx.x == 0 && vtid() == 0) ((unsigned long long*)(args_ptr()->ws + WS_CTL) + 26000)[0] = __builtin_amdgcn_s_memrealtime();
#endif
#define lo (args_ptr()->ph_lo)
#define hi (args_ptr()->ph_hi)
#if MK_MULTI
#define SEAM() do {} while (0)
#define SEAM1() do {} while (0)
#else
#define SEAM1() do { XcdBarrier b_; b_.bar = (unsigned*)(args_ptr()->ws + WS_CTL) + CW_BAR; b_.x = xb_xcc_id(); b_.st = (volatile LAS unsigned*)(lds + MISC_OFF) + 8; xcd_barrier(b_); } while (0)
#define SEAM() do { if (ph + 1 < hi) { XcdBarrier b_; b_.bar = (unsigned*)(args_ptr()->ws + WS_CTL) + CW_BAR; b_.x = xb_xcc_id(); b_.st = (volatile LAS unsigned*)(lds + MISC_OFF) + 8; xcd_barrier(b_); } } while (0)
#endif
#ifndef PH3SUB
#define PH3SUB 7
#endif
#ifndef PHMASK
#define PHMASK 0xFFFF
#endif
#ifndef SCAN_CHUNKED
#define SCAN_CHUNKED 1
#endif
#ifndef SCAN_REPS
#define SCAN_REPS 1
#endif
#ifndef REPEAT_PHASE
#define REPEAT_PHASE (-1)
#endif
#ifndef REPEAT_LAYER
#define REPEAT_LAYER (-1)
#endif
#ifdef PH_TIME
#define PH_STAMP() do { if (blockIdx.x == 0 && vtid() == 0) ((unsigned long long*)(args_ptr()->ws + WS_CTL) + 26000)[ph + 1] = __builtin_amdgcn_s_memrealtime(); } while (0)
#elif defined(PH_SPIN)
#ifdef PH_SUB
#define PH_SUBSEL() do { const unsigned long long* ts_ = st_ + 100; d_ = PH_SUB == 1 ? ts_[1] - ts_[0] : (PH_SUB == 2 ? ts_[2] - ts_[1] : (PH_SUB == 3 ? t1_ - ts_[2] : (PH_SUB == 4 ? __hip_atomic_load((unsigned long long*)ts_ + 4, __ATOMIC_RELAXED, __HIP_MEMORY_SCOPE_AGENT) - ts_[0] : ts_[0] - st_[ph]))); } while (0)
#else
#define PH_SUBSEL() do {} while (0)
#endif
#define PH_STAMP() do { if (ph + 1 == PH_SPIN || ph == PH_SPIN) { if (blockIdx.x == 0 && vtid() == 0) { unsigned long long* st_ = (unsigned long long*)(args_ptr()->ws + WS_CTL) + 26000; \
        const unsigned long long t1_ = __builtin_amdgcn_s_memrealtime(); st_[ph + 1] = t1_; st_[103] = t1_; \
        if (ph == PH_SPIN) { unsigned long long d_ = t1_ - st_[ph]; PH_SUBSEL(); if (d_ > 100000ull) d_ = 100000ull; while (__builtin_amdgcn_s_memrealtime() - t1_ < d_) __builtin_amdgcn_s_sleep(8); } } \
        if (ph == PH_SPIN) { SEAM1(); } } } while (0)
#else
#define PH_STAMP() do {} while (0)
#endif
#define RUN(K, ...) do { if (((PHMASK >> (K)) & 1) && lo <= ph && ph < hi) { const int nrep_ = ((K) == REPEAT_PHASE && (REPEAT_LAYER < 0 || REPEAT_LAYER == l_)) ? 2 : 1; \
    for (int rep_ = 0; rep_ < nrep_; ++rep_) { __VA_ARGS__; if (rep_ + 1 < nrep_) { SEAM1(); } } SEAM(); PH_STAMP(); } ++ph; } while (0)
#define LOCALS() ArgsP a = args_ptr(); unsigned char* ws = a->ws; unsigned char* wb = ws + WS_W; float* SSP = (float*)(ws + WS_SSP); float* SSQP = (float*)(ws + WS_SSQP); bf16_t* HB = (bf16_t*)(ws + A_HB); \
    const int G = gridDim.x, bid = blockIdx.x; (void)wb; (void)SSP; (void)SSQP; (void)HB; (void)G; (void)bid
#define WT(off) ((const pg8::bf16_t*)(wb + (off)))
    int l_ = 0;
    for (int l = 0; l < DEPTH; ++l) {
        l_ = l;
        RUN(0, phase_weights(nullptr, l, lds));
        RUN(1, { LOCALS(); pg8::Gemm g{HB, WT(W_IN), M, PC - 256, 1024, 1024}; pg8::StaticOrder S; S.init(M, PC - 256, G, bid);
              pg8::EpiP E{(bf16_t*)(ws + A_RKV), (bf16_t*)(ws + A_LORAC), (bf16_t*)(ws + A_PM), (unsigned char*)a->out, SSP + (size_t)(2 * l) * M * 16, SSQP + (size_t)l * M * 4, SSQP + (size_t)(2 + l) * M * 4, (bf16_t*)((unsigned char*)a->out + DO_HALO), (LAS float*)(lds + pg8::RS_OFF), 0};
              GEMM_PHASE(pg8::EpiP, lds, g, S, E); });
        RUN(2, phase_prep(nullptr, l));
        RUN(3, { if (PH3SUB & 1) { LOCALS(); pg8::Gemm g{(const bf16_t*)(ws + A_LIN), WT(W_LORA), M, 1536, 256, 256}; pg8::StaticOrder S; S.init(M, 1536, G, bid);
                pg8::EpiLora E{(bf16_t*)(ws + A_LW), (bf16_t*)(ws + A_ICLR), (bf16_t*)(ws + A_GATE), a->in[I_DBASE] + l * 512, a->in[I_IBASE] + l * 512};
                GEMM_PHASE(pg8::EpiLora, lds, g, S, E); }
              if (gridDim.x == 256 && blockIdx.x >= 192) {
                LOCALS(); pg8::Gemm g{HB, WT(W_IN) + (size_t)(PC - 256) * 1024, M, 256, 1024, 1024}; pg8::StaticOrder S; S.init(M, 256, 64, bid - 192);
                pg8::EpiP E{(bf16_t*)(ws + A_RKV), (bf16_t*)(ws + A_LORAC), (bf16_t*)(ws + A_PM), (unsigned char*)a->out, SSP + (size_t)(2 * l) * M * 16, SSQP + (size_t)l * M * 4, SSQP + (size_t)(2 + l) * M * 4, (bf16_t*)((unsigned char*)a->out + DO_HALO), (LAS float*)(lds + pg8::RS_OFF), 16};
                GEMM_PHASE(pg8::EpiP, lds, g, S, E); }
              else if (gridDim.x != 256) {
                LOCALS(); pg8::Gemm g{HB, WT(W_IN) + (size_t)(PC - 256) * 1024, M, 256, 1024, 1024}; pg8::StaticOrder S; S.init(M, 256, G, bid);
                pg8::EpiP E{(bf16_t*)(ws + A_RKV), (bf16_t*)(ws + A_LORAC), (bf16_t*)(ws + A_PM), (unsigned char*)a->out, SSP + (size_t)(2 * l) * M * 16, SSQP + (size_t)l * M * 4, SSQP + (size_t)(2 + l) * M * 4, (bf16_t*)((unsigned char*)a->out + DO_HALO), (LAS float*)(lds + pg8::RS_OFF), 16};
                GEMM_PHASE(pg8::EpiP, lds, g, S, E); }
              if (PH3SUB & 2) { LOCALS(); pg8::Gemm g{(const bf16_t*)(ws + A_PM), WT(W_Q), M, 768, 256, 512}; pg8::StaticOrder S; S.init(M, 768, G, bid);
                pg8::EpiQ E{(bf16_t*)(ws + A_QN), (bf16_t*)(ws + A_QP), SSQP + (size_t)l * M * 4, (const float*)(ws + WS_CS), (LAS float*)(lds + pg8::RS_OFF)};
                GEMM_PHASE(pg8::EpiQ, lds, g, S, E); }
              if (PH3SUB & 4) { LOCALS(); pg8::Gemm g{(const bf16_t*)(ws + A_PM) + 256, WT(W_KV), M, 1024, 256, 512}; pg8::StaticOrder S; S.init(M, 1024, G, bid);
                pg8::EpiKV E{(bf16_t*)(ws + A_KN), (bf16_t*)(ws + A_VT), SSQP + (size_t)(2 + l) * M * 4, (LAS float*)(lds + pg8::RS_OFF)};
                GEMM_PHASE(pg8::EpiKV, lds, g, S, E); } });
#if WKV_STREAM
        RUN(4, { if (gridDim.x >= 64) { if (blockIdx.x >= 32) phase_wkvprep(nullptr, l, lds, (int)blockIdx.x - 32, (int)gridDim.x - 32); }
                 else { phase_wkvprep(nullptr, l, lds, (int)blockIdx.x, (int)gridDim.x); SEAM1(); }
                 if (blockIdx.x < 32) { for (int sr_ = 0; sr_ < SCAN_REPS; ++sr_) scan_unit_stream(nullptr, l, blockIdx.x, lds); }
#ifdef PH_SUB
                 if (blockIdx.x == 0 && vtid() == 0) { unsigned long long* ts_ = (unsigned long long*)(args_ptr()->ws + WS_CTL) + 26100; ts_[0] = ts_[3]; ts_[1] = __builtin_amdgcn_s_memrealtime(); }
#endif
                 unsigned* qctr = (unsigned*)(args_ptr()->ws + WS_CTL) + CW_QUEUE + 64 * (2 * l);
                 volatile LAS unsigned* qslot = (volatile LAS unsigned*)(lds + MISC_OFF) + 16;
                 for (;;) { if (vtid() == 0) qslot[0] = __hip_atomic_fetch_add(qctr, 1u, __ATOMIC_RELAXED, __HIP_MEMORY_SCOPE_AGENT);
                            __syncthreads(); const unsigned u = qslot[0]; __syncthreads();
                            if (u >= 512u) break;
                            attn_unit(nullptr, (int)(u & 31u), 15 - (int)(u >> 5), lds, A_QN); }
                 { unsigned* yctr = (unsigned*)(args_ptr()->ws + WS_CTL) + CW_QUEUE + 64 * (2 * l + 1);
                   for (;;) { if (vtid() == 0) qslot[0] = __hip_atomic_fetch_add(yctr, 1u, __ATOMIC_RELAXED, __HIP_MEMORY_SCOPE_AGENT);
                              __syncthreads(); const unsigned u = qslot[0]; __syncthreads();
                              if (u >= 256u) break;
                              ya_item(nullptr, l, (int)(u & 31u), (int)(u >> 5)); } }
#ifdef PH_SUB
                 if (blockIdx.x == 0 && vtid() == 0) { unsigned long long* ts_ = (unsigned long long*)(args_ptr()->ws + WS_CTL) + 26100; ts_[2] = __builtin_amdgcn_s_memrealtime(); }
                 if (blockIdx.x == 255 && vtid() == 0) { unsigned long long* ts_ = (unsigned long long*)(args_ptr()->ws + WS_CTL) + 26100; __hip_atomic_store(ts_ + 4, (unsigned long long)__builtin_amdgcn_s_memrealtime(), __ATOMIC_RELAXED, __HIP_MEMORY_SCOPE_AGENT); }
#endif
                 });
#else
#ifdef SPLIT_SCAN_ATTN
        RUN(4, { if (blockIdx.x < 128) scan_unit_chunked(nullptr, l, blockIdx.x >> 2, blockIdx.x & 3, lds); });
        RUN(5, { for (int c = blockIdx.x; c < 256; c += gridDim.x) { attn_unit(nullptr, c >> 3, 15 - (c & 7), lds); attn_unit(nullptr, c >> 3, c & 7, lds); } });
#else
        RUN(4, { if (blockIdx.x < 128) { for (int sr_ = 0; sr_ < SCAN_REPS; ++sr_) { if (SCAN_CHUNKED) scan_unit_chunked(nullptr, l, blockIdx.x >> 2, blockIdx.x & 3, lds); else scan_unit(nullptr, l, blockIdx.x >> 2, blockIdx.x & 3, lds); } }
                 const size_t oo_ = (rep_ + 1 < nrep_) ? A_LW : A_QN;
                 unsigned* qctr = (unsigned*)(args_ptr()->ws + WS_CTL) + CW_QUEUE + 64 * (2 * l + rep_);
                 volatile LAS unsigned* qslot = (volatile LAS unsigned*)(lds + MISC_OFF) + 16;
                 for (;;) { if (vtid() == 0) qslot[0] = __hip_atomic_fetch_add(qctr, 1u, __ATOMIC_RELAXED, __HIP_MEMORY_SCOPE_AGENT);
                            __syncthreads(); const unsigned u = qslot[0]; __syncthreads();
                            if (u >= 512u) break;
                            attn_unit(nullptr, (int)(u & 31u), 15 - (int)(u >> 5), lds, oo_); } });
#endif
#endif
#ifdef CK_TIME
        if (l == 0) { phase_time_out(nullptr); return; }
#endif
#ifdef CMPY_PROBE
        if (l == 0) { if (blockIdx.x < 128) scan_unit(nullptr, l, blockIdx.x >> 2, blockIdx.x & 3, lds, A_GATE); SEAM1(); phase_cmp_y(nullptr); SEAM1(); phase_cmp_out(nullptr); return; }
#endif
#ifdef CHKSUM_PROBE
        if (l == 0) { phase_chk_sum(nullptr); SEAM1(); phase_chk_out(nullptr); return; }
#endif
        RUN(7, { { LOCALS(); pg8::Gemm g{(const bf16_t*)(ws + A_YA), WT(W_OA), M, 1024, 512, 512}; pg8::StaticOrder S; S.init(M, 1024, G, bid);
                pg8::EpiMix<1> E{(float*)(ws + A_TMP), (bf16_t*)(ws + A_MERGED), (const unsigned char*)a->out};
                GEMM_PHASE(pg8::EpiMix<1>, lds, g, S, E); }
              asm volatile("s_waitcnt vmcnt(0)" ::: "memory"); __syncthreads();
              { LOCALS(); pg8::Gemm g{(const bf16_t*)(ws + A_QN), WT(W_OB), M, 1024, 512, 512}; pg8::StaticOrder S; S.init(M, 1024, G, bid);
                pg8::EpiMix<2> E{(float*)(ws + A_TMP), (bf16_t*)(ws + A_MERGED), (const unsigned char*)a->out};
                GEMM_PHASE(pg8::EpiMix<2>, lds, g, S, E); } });
        RUN(8, { LOCALS(); pg8::Gemm g{(const bf16_t*)(ws + A_MERGED), WT(W_OUT), M, 1024, 1024, 1024}; pg8::StaticOrder S; S.init(M, 1024, G, bid);
#ifdef PH_SUB
              g.ts = (unsigned long long*)(ws + WS_CTL) + 26100;
#endif
              pg8::EpiRes E{HB, SSP + (size_t)(2 * l + 1) * M * 16};
              GEMM_PHASE(pg8::EpiRes, lds, g, S, E); });
        RUN(9, { LOCALS(); pg8::Gemm g{HB, WT(W_UP), M, 2 * FF, 1024, 1024}; pg8::StaticOrder S; S.init(M, 2 * FF, G, bid);
              pg8::EpiUp E{(bf16_t*)(ws + A_ACT), (bf16_t*)(ws + A_UG), SSP + (size_t)(2 * l + 1) * M * 16, a->in[I_CONVW] + (size_t)l * 3 * FF, a->in[I_CONVB] + (size_t)l * FF, (LAS float*)(lds + pg8::RS_OFF)};
              GEMM_PHASE(pg8::EpiUp, lds, g, S, E); });
        RUN(11, { LOCALS(); pg8::Gemm g{(const bf16_t*)(ws + A_ACT), WT(W_DOWN), M, 1024, FF, FF}; pg8::StaticOrder S; S.init(M, 1024, G, bid);
              { pg8::Unit hu_; for (int hi_ = 0; S.next(hi_, hu_); ++hi_) ffn_halo_fix(nullptr, l, hu_.pm); }
              pg8::EpiRes E{HB, SSP + (size_t)(2 * l + 2) * M * 16};
              GEMM_PHASE(pg8::EpiRes, lds, g, S, E); });
    }
    RUN(12, phase_final(nullptr));
#ifdef PH_TIME
    SEAM1(); phase_phtime_out(nullptr);
#endif
#if DUMP_MIB
    if (lo == 100) phase_dump(nullptr);
#endif
#ifdef CLOCKJUNK
    if (lo == 103 && blockIdx.x == 0) { args_ptr()->out[vtid()] += (float)(__builtin_amdgcn_s_memrealtime() & 1023); }
#endif
}

#undef lo
#undef hi
extern "C" void kernel_launch(void* const* d_in, const int* in_sizes, int n_in, void* d_out, int out_size, void* d_ws, size_t ws_size, hipStream_t stream) {
    static int grid = 0;
    if (grid == 0) {
        if (n_in != 28 || out_size != M * DM || ws_size < WS_END) { fprintf(stderr, "kernel_launch: unexpected shapes: n_in %d out %d ws %zu (need %zu)\n", n_in, out_size, ws_size, (size_t)WS_END); grid = -1; return; }
        int dev = 0, cus = 0, per_cu = 0;
        if (hipGetDevice(&dev) != hipSuccess || hipDeviceGetAttribute(&cus, hipDeviceAttributeMultiprocessorCount, dev) != hipSuccess) { grid = -1; return; }
        if (hipFuncSetAttribute((const void*)mk_fwd, hipFuncAttributeMaxDynamicSharedMemorySize, LDS_BYTES) != hipSuccess) { fprintf(stderr, "kernel_launch: hipFuncSetAttribute failed\n"); grid = -1; return; }
        if (hipOccupancyMaxActiveBlocksPerMultiprocessor(&per_cu, (const void*)mk_fwd, NTHREADS, LDS_BYTES) != hipSuccess || per_cu < 1) { fprintf(stderr, "kernel_launch: occupancy query says %d\n", per_cu); per_cu = 1; }
        (void)hipGetLastError();
        grid = cus * 1;
        if (grid > cus * per_cu) grid = cus * per_cu;
    }
    if (grid < 0) return;
    if (hipMemsetAsync((char*)d_ws + WS_CTL, 0, CTL_ZERO_BYTES, stream) != hipSuccess) { fprintf(stderr, "kernel_launch: memset failed\n"); return; }
    Args a{};
    for (int i = 0; i < 28; ++i) a.in[i] = (const float*)d_in[i];
    a.out = (float*)d_out; a.ws = (unsigned char*)d_ws;
#if MK_MULTI
#ifndef STOP_AFTER
#define STOP_AFTER (N_PHASES - 1)
#endif
    for (int p = 0; p <= STOP_AFTER; ++p) {
        a.ph_lo = p; a.ph_hi = p + 1;
        hipLaunchKernelGGL(mk_fwd, dim3(grid), dim3(NTHREADS), LDS_BYTES, stream, a);
    }
#ifdef CLOCKJUNK
    a.ph_lo = 103; a.ph_hi = 104;
    hipLaunchKernelGGL(mk_fwd, dim3(grid), dim3(NTHREADS), LDS_BYTES, stream, a);
#endif
#if DUMP_MIB
    a.ph_lo = 100; a.ph_hi = 101;
    hipLaunchKernelGGL(mk_fwd, dim3(grid), dim3(NTHREADS), LDS_BYTES, stream, a);
#endif
#else
    a.ph_lo = 0; a.ph_hi = N_PHASES;
    void* kargs[] = {&a};
    hipError_t e = hipLaunchCooperativeKernel((const void*)mk_fwd, dim3(grid), dim3(NTHREADS), kargs, LDS_BYTES, stream);
    if (e != hipSuccess) fprintf(stderr, "kernel_launch: cooperative launch failed: %s (grid %d)\n", hipGetErrorString(e), grid);
#endif
}
```

```cpp
#include <hip/hip_runtime.h>
#include <hip/hip_cooperative_groups.h>
#include <cstdio>
#include <cstdint>
#include <cmath>
namespace cg = cooperative_groups;

#ifndef MK_MULTI
#define MK_MULTI 0
#endif

#ifndef SCAN_CHUNKED
#define SCAN_CHUNKED 1
#endif
#define LW_CUM SCAN_CHUNKED
#ifndef WKV_STREAM
#define WKV_STREAM 1
#endif
#ifndef CK_LWZ
#define CK_LWZ 1.0f
#endif
#ifndef CK_NOSTATE
#define CK_NOSTATE 0
#endif
#ifndef CK_AB
#define CK_AB 1.0f
#endif
constexpr int BATCH = 4, SEQ = 4096, DM = 1024, M = BATCH * SEQ, DEPTH = 2;
constexpr int NH = 8, RD = 512;
constexpr int IN_COLS = 4256, PC = 4352;
constexpr int FF = 2816;
constexpr float NORM_EPS = 1e-6f, LNX_EPS = 64e-5f;
constexpr float C2 = 0.10206207261596577f * 1.4426950408889634f;

namespace pg8 {
#define PG8_LAS __attribute__((address_space(3)))
}
extern __shared__ __attribute__((aligned(16))) unsigned char lds_raw[];
constexpr int WTAB_OFF = 131072 + 448;
__device__ __forceinline__ unsigned hw_wave_key() { return (unsigned)__builtin_amdgcn_s_getreg((5 << 11) | 4) & 63u; }
__device__ __forceinline__ int vtid() {
    const int wv = __builtin_amdgcn_readfirstlane((int)*(volatile PG8_LAS unsigned*)((PG8_LAS unsigned char*)lds_raw + WTAB_OFF + hw_wave_key() * 4u));
    int t_ = (wv << 6) | (int)__builtin_amdgcn_mbcnt_hi(~0u, __builtin_amdgcn_mbcnt_lo(~0u, 0u));
    asm volatile("" : "+v"(t_));
    return t_;
}
__device__ __forceinline__ float shx(float v, int m) {
    int l_ = (int)__builtin_amdgcn_mbcnt_hi(~0u, __builtin_amdgcn_mbcnt_lo(~0u, 0u)); asm volatile("" : "+v"(l_));
    return __builtin_bit_cast(float, __builtin_amdgcn_ds_bpermute((l_ ^ m) << 2, __builtin_bit_cast(int, v)));
}
namespace pg8 {
typedef unsigned short bf16_t;
typedef short bf16x8 __attribute__((ext_vector_type(8)));
typedef float f32x4 __attribute__((ext_vector_type(4)));
typedef unsigned u32x4 __attribute__((ext_vector_type(4)));
constexpr int BM = 256, BK = 64, HALF = 128, HTB = HALF * BK * 2  , STAGE_BYTES = 8 * HTB, NXCD = 8, WGM = 8;

__host__ __device__ __forceinline__ int lds_byte(int r, int c) { const int st = (r >> 4) * 2 + (c >> 5), rr = r & 15, cc = c & 31, ob = rr * 64 + cc * 2; return st * 1024 + (ob ^ (((ob >> 9) & 1) << 5)); }
__host__ __device__ __forceinline__ void stage_rc(int b, int& R, int& C) { const int st = b / 1024, sb = b % 1024, swz = sb ^ (((sb >> 9) & 1) << 5); R = (st >> 1) * 16 + swz / 64; C = (st & 1) * 32 + (swz % 64) / 2; }
__host__ __device__ __forceinline__ int perm32(int rho) { const int n = rho >> 4, i = rho & 15; return 8 * (i >> 2) + 4 * n + (i & 3); }

struct Unit { int pm, pn; };
struct Gemm { const bf16_t* A; const bf16_t* Bt; int M, N, K, lda; unsigned long long* ts = nullptr; };

struct StaticOrder {
    int nM, nN, nwg, G, c;
    __host__ __device__ void init(int M, int N, int G_, int c_) { nM = M / BM; nN = N / BM; nwg = nM * nN; G = G_; c = c_; }
    __host__ __device__ __forceinline__ bool next(int i, Unit& u) const {
        const long L = (long)i * G + c; if (L >= nwg) return false;
        int wgid = (int)L; { const int q = nwg / NXCD, r = nwg % NXCD, xcd = wgid % NXCD, off = wgid / NXCD; wgid = (xcd < r ? xcd * (q + 1) : r * (q + 1) + (xcd - r) * q) + off; }
        const int nig = WGM * nN, gid = wgid / nig, fm = gid * WGM, gsz = (nM - fm) < WGM ? (nM - fm) : WGM;
        u.pm = fm + ((wgid % nig) % gsz); u.pn = (wgid % nig) / gsz; return true;
    }
    __device__ __forceinline__ void a_ready(const Unit&) const {}
    __device__ __forceinline__ void done(const Unit&) const {}
};

__device__ __forceinline__ unsigned cvt_pk_bf16(float lo, float hi) { unsigned r; asm volatile("v_cvt_pk_bf16_f32 %0, %1, %2" : "=v"(r) : "v"(lo), "v"(hi)); return r; }
template <class Epi, class Sched, bool ALIGN_EPI = false, bool SP2 = false>
__device__ __forceinline__ void gemm_phase(PG8_LAS unsigned char* lds, const Gemm g, const Sched& S, const Epi& E) {
    int tid_ = vtid(); asm volatile("" : "+v"(tid_)); const int tid = tid_, wid = __builtin_amdgcn_readfirstlane(tid >> 6), lane = tid & 63, wr = wid >> 2, wc = wid & 3, fr = lane & 15, fq = lane >> 4;
    int Kx_ = g.K; asm volatile("" : "+s"(Kx_)); const int K = Kx_, nt = K / BK;
    unsigned voffA[2], voffB[2];
#pragma unroll
    for (int i = 0; i < 2; ++i) { int R, C; stage_rc(tid * 16 + i * 8192, R, C); const int Rb = Epi::PERM ? ((R & ~31) + perm32(R & 31)) : R;
        voffA[i] = (unsigned)(R * g.lda + C) * 2u; voffB[i] = (unsigned)(Rb * K + C) * 2u; }
    const size_t kstep = (size_t)(BK * 2);
    const size_t hstep = (size_t)HALF * K * 2, hstepA = (size_t)HALF * g.lda * 2;
    const size_t tstep = 2 * hstep, tstepA = 2 * hstepA;
    const unsigned ldsw = (unsigned)wid * 1024u;
    const int aoff = lds_byte(wr * 64 + fr, fq * 8), boff = lds_byte(wc * 32 + fr, fq * 8);
#define PG8_SA(b, h) (((b) * 2 + (h)) * HTB)
#define PG8_SB(b, h) ((4 + (b) * 2 + (h)) * HTB)
#define PG8_STAGE(bufoff, gbase, voff) do { _Pragma("unroll") for (int _i = 0; _i < 2; ++_i) \
        __builtin_amdgcn_global_load_lds((const unsigned*)((const char*)(gbase) + (voff)[_i]), (PG8_LAS unsigned*)(lds + (bufoff) + ldsw + _i * 8192), 16, 0, 0); } while (0)
#define PG8_LDA(dst, b, h) do { _Pragma("unroll") for (int m = 0; m < 4; ++m) _Pragma("unroll") for (int k = 0; k < 2; ++k) dst[m][k] = *(const PG8_LAS bf16x8*)(lds + PG8_SA(b, h) + aoff + m * 2048 + k * 1024); } while (0)
#define PG8_LDB(dst, b, h) do { _Pragma("unroll") for (int n = 0; n < 2; ++n) _Pragma("unroll") for (int k = 0; k < 2; ++k) dst[n][k] = *(const PG8_LAS bf16x8*)(lds + PG8_SB(b, h) + boff + n * 2048 + k * 1024); } while (0)
#define PG8_MMA(ai, bj, At, Bt) do { __builtin_amdgcn_s_setprio(1); _Pragma("unroll") for (int m = 0; m < 4; ++m) _Pragma("unroll") for (int n = 0; n < 2; ++n) _Pragma("unroll") for (int k = 0; k < 2; ++k) \
        acc[ai][bj][m][n] = __builtin_amdgcn_mfma_f32_16x16x32_bf16(Bt[n][k], At[m][k], acc[ai][bj][m][n], 0, 0, 0); __builtin_amdgcn_s_setprio(0); } while (0)
#define PG8_WAIT_V(n) asm volatile("s_waitcnt vmcnt(" #n ")" ::: "memory")
#define PG8_WAIT_L(n) asm volatile("s_waitcnt lgkmcnt(" #n ")" ::: "memory")
#define PG8_BAR __builtin_amdgcn_s_barrier()
#define PG8_SCHED __builtin_amdgcn_sched_barrier(0)
    Unit cur, nxt; int ui = 0;
    if (!S.next(0, cur)) return;
#ifdef PH_SUB
#define PG8_TS(i) do { if (blockIdx.x == 0 && tid == 0) g.ts[i] = __builtin_amdgcn_s_memrealtime(); } while (0)
#else
#define PG8_TS(i) do {} while (0)
#endif
    PG8_TS(0);
    f32x4 acc[2][2][4][2];
#pragma unroll
    for (int a = 0; a < 2; ++a)
#pragma unroll
        for (int b = 0; b < 2; ++b)
#pragma unroll
            for (int m = 0; m < 4; ++m)
#pragma unroll
                for (int n = 0; n < 2; ++n) acc[a][b][m][n] = (f32x4){0.f, 0.f, 0.f, 0.f};
    bf16x8 At[4][2], B0[2][2], B1[2][2];
    const char* cA = (const char*)g.A + (size_t)cur.pm * tstepA; const char* cB = (const char*)g.Bt + (size_t)cur.pn * tstep;
    S.a_ready(cur);
    if constexpr (SP2) {
        PG8_STAGE(PG8_SB(0, 0), cB, voffB); PG8_STAGE(PG8_SB(0, 1), cB + hstep, voffB); PG8_STAGE(PG8_SA(0, 0), cA, voffA); PG8_STAGE(PG8_SA(0, 1), cA + hstepA, voffA);
        if (wr == 1) PG8_BAR;
        PG8_WAIT_V(2); PG8_BAR;
        PG8_STAGE(PG8_SB(1, 0), cB + kstep, voffB); PG8_STAGE(PG8_SA(1, 0), cA + kstep, voffA); PG8_STAGE(PG8_SB(1, 1), cB + hstep + kstep, voffB);
        PG8_WAIT_V(6); PG8_BAR;
    } else {
        PG8_STAGE(PG8_SB(0, 0), cB, voffB); PG8_STAGE(PG8_SA(0, 0), cA, voffA); PG8_STAGE(PG8_SB(0, 1), cB + hstep, voffB); PG8_STAGE(PG8_SA(0, 1), cA + hstepA, voffA);
        if (wr == 1) PG8_BAR;
        PG8_WAIT_V(4); PG8_BAR;
        PG8_STAGE(PG8_SB(1, 0), cB + kstep, voffB); PG8_STAGE(PG8_SA(1, 0), cA + kstep, voffA); PG8_STAGE(PG8_SB(1, 1), cB + hstep + kstep, voffB);
        PG8_WAIT_V(6); PG8_BAR;
    }
    for (;;) {
        const bool has_next = S.next(ui + 1, nxt);
        const char* nA = has_next ? (const char*)g.A + (size_t)nxt.pm * tstepA : cA; const char* nB = has_next ? (const char*)g.Bt + (size_t)nxt.pn * tstep : cB;
#pragma unroll 1
        for (int t = 0; t < nt; t += 2) {
            const bool last = (t == nt - 2);
            const char* a1 = cA + (size_t)(t + 1) * kstep;
            const char* a2 = last ? nA : cA + (size_t)(t + 2) * kstep; const char* b2 = last ? nB : cB + (size_t)(t + 2) * kstep;
            const char* a3 = a2 + kstep; const char* b3 = b2 + kstep;
            if (last && has_next) S.a_ready(nxt);
            if constexpr (SP2) {
            PG8_LDB(B0, 0, 0); PG8_LDB(B1, 0, 1); PG8_SCHED; PG8_LDA(At, 0, 0); PG8_STAGE(PG8_SA(1, 1), a1 + hstepA, voffA);
            PG8_WAIT_V(8); PG8_WAIT_L(0); PG8_BAR; PG8_MMA(0, 0, At, B0); PG8_MMA(0, 1, At, B1); PG8_BAR; PG8_SCHED;
            PG8_LDA(At, 0, 1); PG8_STAGE(PG8_SB(0, 0), b2, voffB); PG8_STAGE(PG8_SB(0, 1), b2 + hstep, voffB); PG8_STAGE(PG8_SA(0, 0), a2, voffA);
            PG8_WAIT_V(8); PG8_WAIT_L(0); PG8_BAR; PG8_MMA(1, 0, At, B0); PG8_MMA(1, 1, At, B1); PG8_BAR; PG8_SCHED;
            PG8_LDB(B0, 1, 0); PG8_LDB(B1, 1, 1); PG8_SCHED; PG8_LDA(At, 1, 0); PG8_STAGE(PG8_SA(0, 1), a2 + hstepA, voffA);
            PG8_WAIT_V(8); PG8_WAIT_L(0); PG8_BAR; PG8_MMA(0, 0, At, B0); PG8_MMA(0, 1, At, B1); PG8_BAR; PG8_SCHED;
            PG8_LDA(At, 1, 1); PG8_STAGE(PG8_SB(1, 0), b3, voffB); PG8_STAGE(PG8_SB(1, 1), b3 + hstep, voffB); PG8_STAGE(PG8_SA(1, 0), a3, voffA);
            PG8_WAIT_V(8); PG8_WAIT_L(0); PG8_BAR; PG8_MMA(1, 0, At, B0); PG8_MMA(1, 1, At, B1); PG8_BAR; PG8_SCHED;
            } else {
            PG8_LDB(B0, 0, 0); PG8_SCHED; PG8_LDA(At, 0, 0); PG8_STAGE(PG8_SA(1, 1), a1 + hstepA, voffA);
            PG8_WAIT_L(8); PG8_BAR; PG8_WAIT_L(0); PG8_MMA(0, 0, At, B0); PG8_BAR; PG8_SCHED;
            PG8_LDB(B1, 0, 1); PG8_STAGE(PG8_SB(0, 0), b2, voffB);
            PG8_BAR; PG8_WAIT_L(0); PG8_MMA(0, 1, At, B1); PG8_BAR;
            PG8_LDA(At, 0, 1); PG8_STAGE(PG8_SA(0, 0), a2, voffA);
            PG8_BAR; PG8_WAIT_L(0); PG8_MMA(1, 0, At, B0); PG8_BAR; PG8_SCHED;
            PG8_STAGE(PG8_SB(0, 1), b2 + hstep, voffB);
            PG8_WAIT_V(6); PG8_BAR; PG8_MMA(1, 1, At, B1); PG8_BAR;
            PG8_LDB(B0, 1, 0); PG8_SCHED; PG8_LDA(At, 1, 0); PG8_STAGE(PG8_SA(0, 1), a2 + hstepA, voffA);
            PG8_WAIT_L(8); PG8_BAR; PG8_WAIT_L(0); PG8_MMA(0, 0, At, B0); PG8_BAR; PG8_SCHED;
            PG8_LDB(B1, 1, 1); PG8_STAGE(PG8_SB(1, 0), b3, voffB);
            PG8_BAR; PG8_WAIT_L(0); PG8_MMA(0, 1, At, B1); PG8_BAR;
            PG8_LDA(At, 1, 1); PG8_STAGE(PG8_SA(1, 0), a3, voffA);
            PG8_BAR; PG8_WAIT_L(0); PG8_MMA(1, 0, At, B0); PG8_BAR; PG8_SCHED;
            PG8_STAGE(PG8_SB(1, 1), b3 + hstep, voffB);
            PG8_WAIT_V(6); PG8_BAR; PG8_MMA(1, 1, At, B1); PG8_BAR;
            }
        }
        if constexpr (ALIGN_EPI) { if (wr == 0) PG8_BAR; }
        PG8_TS(1);
        if constexpr (!Epi::AFTER_DRAIN) { E(acc, cur, wr, wc, fr, fq); S.done(cur); }
        asm volatile("" ::: "memory"); PG8_TS(2);
        if (!has_next) break;
#pragma unroll
        for (int a = 0; a < 2; ++a)
#pragma unroll
            for (int b = 0; b < 2; ++b)
#pragma unroll
                for (int m = 0; m < 4; ++m)
#pragma unroll
                    for (int n = 0; n < 2; ++n) acc[a][b][m][n] = (f32x4){0.f, 0.f, 0.f, 0.f};
        cur = nxt; cA = nA; cB = nB; ++ui;
        if constexpr (ALIGN_EPI) { if (wr == 1) PG8_BAR; }
    }
    PG8_WAIT_V(0);
    if constexpr (!ALIGN_EPI) { if (wr == 0) PG8_BAR; }
    PG8_BAR;
    if constexpr (Epi::AFTER_DRAIN) { E.fused(acc, cur, wr, wc, fr, fq, lds, wid, lane); S.done(cur); }
#undef PG8_SA
#undef PG8_SB
#undef PG8_STAGE
#undef PG8_LDA
#undef PG8_LDB
#undef PG8_MMA
#undef PG8_WAIT_V
#undef PG8_WAIT_L
#undef PG8_BAR
#undef PG8_SCHED
}
}

#define LAS __attribute__((address_space(3)))
typedef unsigned short bf16_t;
typedef short bf16x8 __attribute__((ext_vector_type(8)));
typedef short s16x4 __attribute__((ext_vector_type(4)));
typedef float f32x4 __attribute__((ext_vector_type(4)));
typedef float f32x16 __attribute__((ext_vector_type(16)));
typedef unsigned u32x4 __attribute__((ext_vector_type(4)));
typedef unsigned u32x2 __attribute__((ext_vector_type(2)));

__device__ __forceinline__ float bf2f(unsigned b) { return __uint_as_float(b << 16); }
__device__ __forceinline__ unsigned f2bf(float f) { unsigned u = __float_as_uint(f); return (u + 0x7fffu + ((u >> 16) & 1u)) >> 16; }
typedef float f32x2_t __attribute__((ext_vector_type(2))); typedef __bf16 bf16x2_t __attribute__((ext_vector_type(2)));
__device__ __forceinline__ unsigned pk2(float lo, float hi) { const f32x2_t v = {lo, hi}; const bf16x2_t b = __builtin_convertvector(v, bf16x2_t); return __builtin_bit_cast(unsigned, b); }
__device__ __forceinline__ float sigm(float x) { return 1.0f / (1.0f + __expf(-x)); }
__device__ __forceinline__ f32x4 up4(u32x2 v) { return (f32x4){__uint_as_float(v.x << 16), __uint_as_float(v.x & 0xffff0000u), __uint_as_float(v.y << 16), __uint_as_float(v.y & 0xffff0000u)}; }
__device__ __forceinline__ u32x2 dn4(f32x4 v) { u32x2 r; r.x = pk2(v.x, v.y); r.y = pk2(v.z, v.w); return r; }
__device__ __forceinline__ float dot4(f32x4 a, f32x4 b) { return (a.x * b.x + a.y * b.y) + (a.z * b.z + a.w * b.w); }

constexpr size_t MiB = 1u << 20;
constexpr size_t WS_CTL = 0, CTL_ZERO_BYTES = 2 * MiB;
constexpr size_t WS_STAT = 1 * MiB;
constexpr size_t WS_CS = 2 * MiB;
constexpr size_t WS_W = 4 * MiB;
constexpr size_t W_IN = 0, W_LORA = W_IN + (size_t)PC * 1024 * 2, W_Q = W_LORA + 1536 * 256 * 2, W_KV = W_Q + 768 * 256 * 2,
                 W_OA = W_KV + 1024 * 256 * 2, W_OB = W_OA + 1024 * 512 * 2, W_OUT = W_OB + 1024 * 512 * 2,
                 W_UP = W_OUT + 1024 * 1024 * 2, W_DOWN = W_UP + (size_t)2 * FF * 1024 * 2, W_END = W_DOWN + (size_t)1024 * FF * 2;
static_assert(W_END <= 31 * MiB, "weights region");
constexpr size_t WS_ACT = 35 * MiB;
constexpr size_t A_HB = WS_ACT + 0 * MiB;
constexpr size_t A_RKV = WS_ACT + 32 * MiB;
constexpr size_t A_LORAC = WS_ACT + 80 * MiB;
constexpr size_t A_QP = A_LORAC;
constexpr size_t A_PM = WS_ACT + 88 * MiB;
constexpr size_t A_Y = A_PM;
constexpr size_t A_LIN = WS_ACT + 104 * MiB;
constexpr size_t A_KPE = WS_ACT + 112 * MiB;
constexpr size_t WS_SCAL = WS_ACT + 113 * MiB;
constexpr size_t A_LW = WS_ACT + 114 * MiB;
constexpr size_t A_YA = A_LW;
constexpr size_t A_ICLR = WS_ACT + 130 * MiB;
constexpr size_t A_GATE = WS_ACT + 146 * MiB;
constexpr size_t A_MERGED = A_ICLR;
constexpr size_t A_QN = WS_ACT + 162 * MiB;
constexpr size_t A_KN = WS_ACT + 178 * MiB;
constexpr size_t A_VT = WS_ACT + 194 * MiB;
constexpr size_t A_TMP = WS_ACT + 32 * MiB;
constexpr size_t A_UG = WS_ACT + 32 * MiB;
constexpr size_t A_ACT = WS_ACT + 120 * MiB;
constexpr size_t DO_MTREC = 32 * MiB, MTREC_B = 2304, DO_HALO = DO_MTREC + (size_t)8192 * MTREC_B;
static_assert(DO_HALO + (size_t)(M / 16) * 1536 * 2 <= 64 * MiB, "d_out scratch map");
constexpr size_t WS_SSP = WS_ACT + 210 * MiB;
constexpr size_t WS_SSQP = WS_SSP + 5 * MiB;
constexpr size_t WS_END = WS_SSQP + 1 * MiB;
static_assert(A_UG + (size_t)M * FF * 2 <= A_ACT && A_ACT + (size_t)M * FF * 2 <= WS_SSP && WS_END <= 256 * MiB, "workspace map");
static_assert(A_ICLR == A_LW + (size_t)M * 512 * 2 && A_GATE == A_ICLR + (size_t)M * 512 * 2, "LW | ICLR | GATE consecutive");
constexpr int CW_BAR = 4096, CW_QUEUE = 16384;

#define XB_TMO      128
#define XB_XCNT(j)  (256  + 64 * (j))
#define XB_XSUB(j)  (1280 + 64 * (j))
#define XB_XGEN(j)  (2304 + 64 * (j))
#define XB_TOP      3328
#define XB_TOPGEN   3392
#define XCD_BAR_WORDS 3456
#define XB_SPIN_CAP (1u << 18)
__device__ __forceinline__ unsigned xb_ld(unsigned* p)              { return __hip_atomic_load(p, __ATOMIC_RELAXED, __HIP_MEMORY_SCOPE_AGENT); }
__device__ __forceinline__ unsigned xb_add(unsigned* p, unsigned v) { return __hip_atomic_fetch_add(p, v, __ATOMIC_RELAXED, __HIP_MEMORY_SCOPE_AGENT); }
__device__ __forceinline__ unsigned xb_xcc_id() { return (unsigned)__builtin_amdgcn_s_getreg((3 << 11) | 20) & 0xFu; }
#define XB_SPIN(cond, bar) do { unsigned _sp = 0; while (cond) { __builtin_amdgcn_s_sleep(1); \
    if ((++_sp & 255u) == 0u) { if (xb_ld(&(bar)[XB_TMO])) break; if (_sp > XB_SPIN_CAP) { atomicAdd(&(bar)[XB_TMO], 1u); break; } } } } while (0)
struct XcdBarrier { unsigned* bar; unsigned x; volatile LAS unsigned* st; };
__device__ __forceinline__ XcdBarrier xcd_barrier_post(unsigned* bar, volatile LAS unsigned* st) {
    XcdBarrier b; b.bar = bar; b.x = xb_xcc_id(); b.st = st;
    if (vtid() == 0) (void)xb_add(&bar[XB_XCNT(b.x)], 1u);
    return b;
}
__device__ __forceinline__ void xcd_barrier_complete(unsigned* bar, unsigned x, unsigned& nloc, unsigned& nx) {
    const unsigned G = gridDim.x * gridDim.y * gridDim.z;
    unsigned sum, cnt, mine, sp = 0u;
    for (;;) {
        sum = 0u; cnt = 0u; mine = 0u;
#pragma unroll
        for (unsigned j = 0; j < 16; ++j) { const unsigned c = xb_ld(&bar[XB_XCNT(j)]); sum += c; cnt += (c > 0u) ? 1u : 0u; mine = (j == x) ? c : mine; }
        if (sum == G) break;
        __builtin_amdgcn_s_sleep(1);
        if ((++sp & 255u) == 0u) { if (xb_ld(&bar[XB_TMO])) break; if (sp > XB_SPIN_CAP) { atomicAdd(&bar[XB_TMO], 1u); break; } }
    }
    nloc = mine > 0u ? mine : 1u; nx = cnt > 0u ? cnt : 1u;
}
__device__ __forceinline__ void xcd_barrier(const XcdBarrier& b) {
    asm volatile("s_waitcnt vmcnt(0)" ::: "memory");
    __syncthreads();
    if (vtid() == 0) {
        unsigned* bar = b.bar;
        __builtin_amdgcn_s_waitcnt(0);
        unsigned nloc = b.st[0], nx = b.st[1];
        if (nloc == 0u) { xcd_barrier_complete(bar, b.x, nloc, nx); b.st[0] = nloc; b.st[1] = nx; }
        const unsigned old = xb_add(&bar[XB_XSUB(b.x)], 1u);
        const unsigned gen = old / nloc;
        if (old + 1u == (gen + 1u) * nloc) {
            __builtin_amdgcn_fence(__ATOMIC_RELEASE, "agent");
            asm volatile("s_waitcnt vmcnt(0)" ::: "memory");
            const unsigned og = xb_add(&bar[XB_TOP], 1u);
            const unsigned tg = og / nx;
            if (og + 1u == (tg + 1u) * nx) xb_add(&bar[XB_TOPGEN], 1u);
            else XB_SPIN(xb_ld(&bar[XB_TOPGEN]) == tg, bar);
            __builtin_amdgcn_fence(__ATOMIC_ACQUIRE, "agent");
            xb_add(&bar[XB_XGEN(b.x)], 1u);
            asm volatile("s_waitcnt vmcnt(0)" ::: "memory");
        } else {
            XB_SPIN(xb_ld(&bar[XB_XGEN(b.x)]) == gen, bar);
            __builtin_amdgcn_fence(__ATOMIC_ACQUIRE, "agent");
            asm volatile("s_waitcnt vmcnt(0)" ::: "memory");
        }
    }
    __syncthreads();
}

namespace pg8 {
__device__ __forceinline__ float sum16(const float* p) { const f32x4 a = *(const f32x4*)p, b = *(const f32x4*)(p + 4), c = *(const f32x4*)(p + 8), d = *(const f32x4*)(p + 12);
    return (((a.x + a.y) + (a.z + a.w)) + ((b.x + b.y) + (b.z + b.w))) + (((c.x + c.y) + (c.z + c.w)) + ((d.x + d.y) + (d.z + d.w))); }
__device__ __forceinline__ float sum4(const float* p) { const f32x4 a = *(const f32x4*)p; return (a.x + a.y) + (a.z + a.w); }
__device__ __forceinline__ u32x4 pack8(f32x4 a, f32x4 b) { u32x4 w; w.x = cvt_pk_bf16(a[0], a[1]); w.y = cvt_pk_bf16(a[2], a[3]); w.z = cvt_pk_bf16(b[0], b[1]); w.w = cvt_pk_bf16(b[2], b[3]); return w; }
__device__ __forceinline__ unsigned q8(float s) { return (unsigned)(s * 255.0f + 0.5f); }
__device__ __forceinline__ unsigned sig8x4(f32x4 v) { return q8(sigm(v[0])) | (q8(sigm(v[1])) << 8) | (q8(sigm(v[2])) << 16) | (q8(sigm(v[3])) << 24); }

constexpr int RS_OFF = 131072 + 1024;
#ifndef NT_STORES
#define NT_STORES 0
#endif
#ifndef NT_STORES8
#define NT_STORES8 0
#endif
__device__ __forceinline__ void ST16(bf16_t* p, u32x4 v) {
    if (NT_STORES == 1) __builtin_nontemporal_store(v, (u32x4*)p);
    else if (NT_STORES == 2) asm volatile("global_store_dwordx4 %0, %1, off sc1\n\ts_nop 1" :: "v"(p), "v"(v) : "memory");
    else if (NT_STORES == 3) asm volatile("global_store_dwordx4 %0, %1, off sc0 sc1\n\ts_nop 1" :: "v"(p), "v"(v) : "memory");
    else *(u32x4*)p = v; }
#ifndef NT_UP
#define NT_UP 1
#endif
__device__ __forceinline__ void ST16W(bf16_t* p, u32x4 v) { if (NT_UP) asm volatile("global_store_dwordx4 %0, %1, off sc1\n\ts_nop 1" :: "v"(p), "v"(v) : "memory"); else *(u32x4*)p = v; }
__device__ __forceinline__ void ST8W(void* p, u32x2 v) { asm volatile("global_store_dwordx2 %0, %1, off sc1\n\ts_nop 1" :: "v"(p), "v"(v) : "memory"); }
#ifndef SC1_MIX
#define SC1_MIX 0
#endif
#ifndef SC1_RES
#define SC1_RES 0
#endif
#ifndef SC1_QKV
#define SC1_QKV 0
#endif
template <int W> __device__ __forceinline__ void ST16S(bf16_t* p, u32x4 v) { if (W) asm volatile("global_store_dwordx4 %0, %1, off sc1\n\ts_nop 1" :: "v"(p), "v"(v) : "memory"); else *(u32x4*)p = v; }
template <int W> __device__ __forceinline__ void ST8S(bf16_t* p, u32x2 v) { if (W) asm volatile("global_store_dwordx2 %0, %1, off sc1\n\ts_nop 1" :: "v"(p), "v"(v) : "memory"); else *(u32x2*)p = v; }
__device__ __forceinline__ void ST8(bf16_t* p, u32x2 v) {
    if (NT_STORES8 == 2) asm volatile("global_store_dwordx2 %0, %1, off sc1\n\ts_nop 1" :: "v"(p), "v"(v) : "memory");
    else *(u32x2*)p = v; }
template <int NS> __device__ __forceinline__ void rs_to_lds(PG8_LAS float* rsl, const float* ss, int pm, float inv_n, float mul, int tid) {
    if (tid < 256) { const float* p = ss + (size_t)(pm * BM + tid) * NS; const float s_ = NS == 16 ? sum16(p) : sum4(p); rsl[tid] = rsqrtf(s_ * inv_n + NORM_EPS) * mul; }
    asm volatile("s_waitcnt lgkmcnt(0)" ::: "memory"); __builtin_amdgcn_s_barrier();
}
struct EpiP {
    static constexpr bool PERM = true, AFTER_DRAIN = false;
    bf16_t* RKV; bf16_t* LORAC; bf16_t* PMb; unsigned char* G8; const float* ss; float* ssq; float* sskv; bf16_t* HALO; PG8_LAS float* rsl; int pn0;
    __device__ __forceinline__ void operator()(const f32x4 (&acc)[2][2][4][2], const Unit& u, int wr, int wc, int fr, int fq) const {
        const int row0 = u.pm * BM + wr * 64 + fr, pn = u.pn + pn0;
        rs_to_lds<16>(rsl, ss, u.pm, 1.0f / 1024.0f, 1.0f, (wr * 4 + wc) * 64 + fq * 16 + fr);
#pragma unroll
        for (int ai = 0; ai < 2; ++ai)
#pragma unroll
            for (int m = 0; m < 4; ++m) {
                const int row = row0 + ai * HALF + m * 16;
                const float rs = rsl[wr * 64 + ai * HALF + m * 16 + fr];
                float sq = 0.f;
#pragma unroll
                for (int bj = 0; bj < 2; ++bj) {
                    const f32x4 v0 = acc[ai][bj][m][0] * rs, v1 = acc[ai][bj][m][1] * rs;
                    const int ct = bj * HALF + wc * 32 + 8 * fq;
                    if (pn < 6) { const u32x4 pk_ = pack8(v0, v1); ST16(RKV + (size_t)row * 1536 + pn * 256 + ct, pk_); if (fr == 15) *(u32x4*)(HALO + (size_t)(row >> 4) * 1536 + pn * 256 + ct) = pk_; }
                    else if (pn == 6) ST16(LORAC + (size_t)row * 256 + ct, pack8(v0, v1));
                    else if (pn < 9) { ST16(PMb + (size_t)row * 512 + (pn - 7) * 256 + ct, pack8(v0, v1));
                        if (pn == 7 || bj == 0) sq += dot4(v0, v0) + dot4(v1, v1); }
                    else { u32x2 w; w.x = sig8x4(v0); w.y = sig8x4(v1); ST8((bf16_t*)(G8 + (size_t)row * 2048 + (pn - 9) * 256 + ct), w); }
                }
                if (pn == 7 || pn == 8) { sq += shx(sq, 16); sq += shx(sq, 32); if (fq == 0) (pn == 7 ? ssq : sskv)[(size_t)row * 4 + wc] = sq; }
            }
    }
};
#ifndef LW_CUM
#define LW_CUM 1
#endif
template <int CTRL> __device__ __forceinline__ float dppz(float x) { return __builtin_bit_cast(float, __builtin_amdgcn_update_dpp(0, __builtin_bit_cast(int, x), CTRL, 0xf, 0xf, true)); }
__device__ __forceinline__ float pfx16(float x) { x += dppz<0x111>(x); x += dppz<0x112>(x); x += dppz<0x114>(x); x += dppz<0x118>(x); return x; }
struct EpiLora {
    static constexpr bool PERM = true, AFTER_DRAIN = false;
    bf16_t* LW; bf16_t* ICLR; bf16_t* GATE; const float* dbase; const float* ibase;
    __device__ __forceinline__ void operator()(const f32x4 (&acc)[2][2][4][2], const Unit& u, int wr, int wc, int fr, int fq) const {
        const int pn = u.pn, kind = pn >> 1;
        bf16_t* dst = LW + (size_t)kind * ((size_t)M * 512);
        const float* bias = kind == 0 ? dbase : ibase;
        const unsigned c0 = (pn & 1) * 256 + wc * 32 + 8 * fq;
        const unsigned off0 = (unsigned)(u.pm * BM + wr * 64 + fr) * 512u + c0;
#pragma unroll
        for (int bj = 0; bj < 2; ++bj) {
            f32x4 b0 = (f32x4){0.f, 0.f, 0.f, 0.f}, b1 = b0;
            if (kind < 2) { b0 = *(const f32x4*)(bias + c0 + bj * HALF); b1 = *(const f32x4*)(bias + c0 + bj * HALF + 4); }
#pragma unroll
            for (int ai = 0; ai < 2; ++ai)
#pragma unroll
                for (int m = 0; m < 4; ++m) {
                    f32x4 v0 = acc[ai][bj][m][0] + b0, v1 = acc[ai][bj][m][1] + b1;
                    if (kind == 0) { for (int e = 0; e < 4; ++e) { v0[e] = -0.6065306597126334f * sigm(v0[e]); v1[e] = -0.6065306597126334f * sigm(v1[e]); }
                        if (LW_CUM) { for (int e = 0; e < 4; ++e) { v0[e] = __expf(pfx16(v0[e])); v1[e] = __expf(pfx16(v1[e])); } } }
                    else if (kind == 1) { for (int e = 0; e < 4; ++e) { v0[e] = sigm(v0[e]); v1[e] = sigm(v1[e]); } }
                    ST16(dst + off0 + (unsigned)((ai * HALF + m * 16) * 512 + bj * HALF), pack8(v0, v1));
                    asm volatile("" ::: "memory");
                }
        }
    }
};
struct EpiQ {
    static constexpr bool PERM = false, AFTER_DRAIN = false;
    bf16_t* Qn; bf16_t* Qp; const float* ssq; const float* CS; PG8_LAS float* rsl;
    __device__ __forceinline__ void operator()(const f32x4 (&acc)[2][2][4][2], const Unit& u, int wr, int wc, int fr, int fq) const {
        const int row0 = u.pm * BM + wr * 64 + fr, pn = u.pn;
        if (pn < 2) {
            rs_to_lds<4>(rsl, ssq, u.pm, 1.0f / 256.0f, C2, (wr * 4 + wc) * 64 + fq * 16 + fr);
#pragma unroll
            for (int ai = 0; ai < 2; ++ai)
#pragma unroll
                for (int m = 0; m < 4; ++m) {
                    const int row = row0 + ai * HALF + m * 16;
                    const float rs = rsl[wr * 64 + ai * HALF + m * 16 + fr];
#pragma unroll
                    for (int bj = 0; bj < 2; ++bj)
#pragma unroll
                        for (int n = 0; n < 2; ++n) ST8S<SC1_QKV>(Qn + (size_t)row * 512 + pn * 256 + bj * HALF + wc * 32 + n * 16 + 4 * fq, dn4(acc[ai][bj][m][n] * rs));
                }
        } else {
            f32x4 cs[2][4], sn[2][4];
#pragma unroll
            for (int ai = 0; ai < 2; ++ai)
#pragma unroll
                for (int m = 0; m < 4; ++m) { const int row = row0 + ai * HALF + m * 16; cs[ai][m] = *(const f32x4*)(CS + (size_t)row * 32 + 4 * fq); sn[ai][m] = *(const f32x4*)(CS + (size_t)row * 32 + 16 + 4 * fq); }
            rs_to_lds<4>(rsl, ssq, u.pm, 1.0f / 256.0f, C2, (wr * 4 + wc) * 64 + fq * 16 + fr);
#pragma unroll
            for (int ai = 0; ai < 2; ++ai)
#pragma unroll
                for (int m = 0; m < 4; ++m) {
                    const int row = row0 + ai * HALF + m * 16;
                    const float rs = rsl[wr * 64 + ai * HALF + m * 16 + fr];
#pragma unroll
                    for (int bj = 0; bj < 2; ++bj) {
                        const f32x4 x1 = acc[ai][bj][m][0] * rs, x2 = acc[ai][bj][m][1] * rs;
                        bf16_t* d = Qp + (size_t)row * 256 + (4 * bj + wc) * 32 + 4 * fq;
                        ST8S<SC1_QKV>(d, dn4(x1 * cs[ai][m] - x2 * sn[ai][m])); ST8S<SC1_QKV>(d + 16, dn4(x1 * sn[ai][m] + x2 * cs[ai][m]));
                    }
                }
        }
    }
};
struct EpiKV {
    static constexpr bool PERM = false, AFTER_DRAIN = false;
    bf16_t* Kn; bf16_t* Vt; const float* sskv; PG8_LAS float* rsl;
    __device__ __forceinline__ void operator()(const f32x4 (&acc)[2][2][4][2], const Unit& u, int wr, int wc, int fr, int fq) const {
        const int row0 = u.pm * BM + wr * 64 + fr, pn = u.pn;
        rs_to_lds<4>(rsl, sskv, u.pm, 1.0f / 128.0f, 1.0f, (wr * 4 + wc) * 64 + fq * 16 + fr);
#pragma unroll
        for (int ai = 0; ai < 2; ++ai)
#pragma unroll
            for (int m = 0; m < 4; ++m) {
                const int row = row0 + ai * HALF + m * 16;
                const float rs = rsl[wr * 64 + ai * HALF + m * 16 + fr];
                if (pn < 2) {
#pragma unroll
                    for (int bj = 0; bj < 2; ++bj)
#pragma unroll
                        for (int n = 0; n < 2; ++n) ST8S<SC1_QKV>(Kn + (size_t)row * 512 + pn * 256 + bj * HALF + wc * 32 + n * 16 + 4 * fq, dn4(acc[ai][bj][m][n] * rs));
                } else {
                    const int b = row >> 12, s = row & 4095;
#pragma unroll
                    for (int bj = 0; bj < 2; ++bj)
#pragma unroll
                        for (int n = 0; n < 2; ++n) {
                            const int hd = (pn - 2) * 4 + 2 * bj + (wc >> 1), d = 32 * (wc & 1) + 16 * n + 4 * fq;
                            const f32x4 v = acc[ai][bj][m][n] * rs;
                            bf16_t* dst = Vt + ((size_t)((b * 8 + hd) * 64 + d) << 12) + s;
#pragma unroll
                            for (int j = 0; j < 4; ++j) dst[(size_t)j << 12] = (bf16_t)f2bf(v[j]);
                        }
                }
            }
    }
};
template <int PASS> struct EpiMix {
    static constexpr bool PERM = true, AFTER_DRAIN = false;
    float* TMP; bf16_t* MERGED; const unsigned char* G8;
    template <int AI> __device__ __forceinline__ void load(u32x2 (&g)[4][2], u32x4 (&t)[4][2], int row0, int c0) const {
#pragma unroll
        for (int m = 0; m < 4; ++m)
#pragma unroll
            for (int bj = 0; bj < 2; ++bj) { const size_t row = (size_t)(row0 + AI * HALF + m * 16); const int c = c0 + bj * HALF;
                g[m][bj] = *(const u32x2*)(G8 + row * 2048 + (PASS - 1) * 1024 + c);
                if (PASS == 2) t[m][bj] = *(const u32x4*)(MERGED + row * 1024 + c); }
    }
    template <int AI> __device__ __forceinline__ void calc(const f32x4 (&acc)[2][2][4][2], const u32x2 (&g)[4][2], u32x4 (&t)[4][2]) const {
#pragma unroll
        for (int m = 0; m < 4; ++m)
#pragma unroll
            for (int bj = 0; bj < 2; ++bj) { const unsigned ga = g[m][bj].x, gb = g[m][bj].y;
                const f32x4 sa = (f32x4){(float)(ga & 255u), (float)((ga >> 8) & 255u), (float)((ga >> 16) & 255u), (float)(ga >> 24)} * (1.0f / 255.0f);
                const f32x4 sb = (f32x4){(float)(gb & 255u), (float)((gb >> 8) & 255u), (float)((gb >> 16) & 255u), (float)(gb >> 24)} * (1.0f / 255.0f);
                f32x4 oa = acc[AI][bj][m][0] * sa, ob = acc[AI][bj][m][1] * sb;
                if (PASS == 2) { oa = oa + up4((u32x2){t[m][bj].x, t[m][bj].y}); ob = ob + up4((u32x2){t[m][bj].z, t[m][bj].w}); }
                const u32x2 pa = dn4(oa), pb = dn4(ob); t[m][bj] = (u32x4){pa.x, pa.y, pb.x, pb.y}; }
    }
    template <int AI> __device__ __forceinline__ void store(const u32x4 (&o)[4][2], int row0, int c0) const {
#pragma unroll
        for (int m = 0; m < 4; ++m)
#pragma unroll
            for (int bj = 0; bj < 2; ++bj) ST16S<SC1_MIX>(MERGED + (size_t)(row0 + AI * HALF + m * 16) * 1024 + c0 + bj * HALF, o[m][bj]);
    }
    __device__ __forceinline__ void operator()(const f32x4 (&acc)[2][2][4][2], const Unit& u, int wr, int wc, int fr, int fq) const {
        const int row0 = u.pm * BM + wr * 64 + fr, c0 = u.pn * BM + wc * 32 + 8 * fq;
        u32x2 g0[4][2], g1[4][2]; u32x4 t0[4][2], t1[4][2];
        load<0>(g0, t0, row0, c0); calc<0>(acc, g0, t0);
        load<1>(g1, t1, row0, c0);
        store<0>(t0, row0, c0);
        calc<1>(acc, g1, t1); store<1>(t1, row0, c0);
    }
};
struct EpiRes {
    static constexpr bool PERM = false, AFTER_DRAIN = false;
    bf16_t* HB; float* ssacc;
    __device__ __forceinline__ void operator()(const f32x4 (&acc)[2][2][4][2], const Unit& u, int wr, int wc, int fr, int fq) const {
        const int row0 = u.pm * BM + wr * 64 + fr, c0 = u.pn * BM + wc * 32 + 4 * fq;
        u32x2 b[2][4][2][2];
#pragma unroll
        for (int ai = 0; ai < 2; ++ai)
#pragma unroll
            for (int m = 0; m < 4; ++m)
#pragma unroll
                for (int bj = 0; bj < 2; ++bj)
#pragma unroll
                    for (int n = 0; n < 2; ++n) b[ai][m][bj][n] = *(const u32x2*)(HB + (size_t)(row0 + ai * HALF + m * 16) * 1024 + c0 + bj * HALF + n * 16);
#pragma unroll
        for (int ai = 0; ai < 2; ++ai)
#pragma unroll
            for (int m = 0; m < 4; ++m) {
                const int row = row0 + ai * HALF + m * 16; float sq = 0.f;
#pragma unroll
                for (int bj = 0; bj < 2; ++bj)
#pragma unroll
                    for (int n = 0; n < 2; ++n) {
                        const u32x2 p = dn4(up4(b[ai][m][bj][n]) + acc[ai][bj][m][n]); const f32x4 v = up4(p);
                        ST8S<SC1_RES>(HB + (size_t)row * 1024 + c0 + bj * HALF + n * 16, p); sq += dot4(v, v);
                    }
                sq += shx(sq, 16); sq += shx(sq, 32);
                if (fq == 0) ssacc[(size_t)row * 16 + u.pn * 4 + wc] = sq;
            }
    }
};
typedef float f32x2 __attribute__((ext_vector_type(2)));
__device__ __forceinline__ f32x2 gelu_pk2(f32x2 v) {
    const f32x2 av = __builtin_elementwise_abs(v), d = av * 0.2316418882f + 1.0f;
    f32x2 t; t.x = __builtin_amdgcn_rcpf(d.x); t.y = __builtin_amdgcn_rcpf(d.y);
    f32x2 q = t * 0.5307027145f + (-0.7265760135f); q = q * t + 0.7107068705f; q = q * t + (-0.142248368f); q = q * t + 0.127414796f; q = q * t;
    const f32x2 s2 = (v * v) * (-0.72134752044f);
    f32x2 e; e.x = __builtin_amdgcn_exp2f(s2.x); e.y = __builtin_amdgcn_exp2f(s2.y);
    const f32x2 m = v * (q * e), r = v - m;
    f32x2 o; o.x = v.x < 0.f ? m.x : r.x; o.y = v.y < 0.f ? m.y : r.y; return o;
}
__device__ __forceinline__ f32x4 gelu4(f32x4 c) { const f32x2 g0 = gelu_pk2((f32x2){c.x, c.y}), g1 = gelu_pk2((f32x2){c.z, c.w}); return (f32x4){g0.x, g0.y, g1.x, g1.y}; }
template <int CTRL> __device__ __forceinline__ f32x4 ror4(f32x4 x) { f32x4 r;
#pragma unroll
    for (int e = 0; e < 4; ++e) { const float xe = x[e]; const int xi = __builtin_bit_cast(int, xe); r[e] = __builtin_bit_cast(float, __builtin_amdgcn_update_dpp(xi, xi, CTRL, 0xf, 0xf, false)); }
    return r; }
struct EpiUp {
    static constexpr bool PERM = true, AFTER_DRAIN = false;
    bf16_t* ACT; bf16_t* RAWH; const float* ss; const float* cw; const float* cb; PG8_LAS float* rsl;
    __device__ __forceinline__ void operator()(const f32x4 (&acc)[2][2][4][2], const Unit& u, int wr, int wc, int fr, int fq) const {
        const int tid = (wr * 4 + wc) * 64 + fq * 16 + fr, row0 = u.pm * BM + wr * 64 + fr;
        PG8_LAS float* wl = rsl + 256;
        if (tid >= 256 && tid < 384) { const int j = tid - 256, cg = u.pn * HALF + j; wl[j] = cw[cg]; wl[128 + j] = cw[FF + cg]; wl[256 + j] = cw[2 * FF + cg]; wl[384 + j] = cb[cg]; }
        rs_to_lds<16>(rsl, ss, u.pm, 1.0f / 1024.0f, 1.0f, tid);
        const int cl = wc * 32 + 8 * fq, cgl = u.pn * HALF + cl;
#pragma unroll
        for (int ai = 0; ai < 2; ++ai) {
            f32x4 q1a, q1b, q2a, q2b;
#pragma unroll
            for (int m = 0; m < 4; ++m) {
                const int row = row0 + ai * HALF + m * 16;
                const float rs = rsl[wr * 64 + ai * HALF + m * 16 + fr];
                const PG8_LAS float* wp = wl + cl; asm volatile("" : "+v"(wp));
                const f32x4 w0a = *(const PG8_LAS f32x4*)(wp), w0b = *(const PG8_LAS f32x4*)(wp + 4), w1a = *(const PG8_LAS f32x4*)(wp + 128), w1b = *(const PG8_LAS f32x4*)(wp + 128 + 4);
                const f32x4 w2a = *(const PG8_LAS f32x4*)(wp + 256), w2b = *(const PG8_LAS f32x4*)(wp + 256 + 4), ba = *(const PG8_LAS f32x4*)(wp + 384), bb = *(const PG8_LAS f32x4*)(wp + 384 + 4);
                const f32x4 xa = acc[ai][0][m][0] * rs, xb = acc[ai][0][m][1] * rs, va = acc[ai][1][m][0] * rs, vb = acc[ai][1][m][1] * rs;
                const f32x4 r1a = ror4<0x121>(xa), r1b = ror4<0x121>(xb), r2a = ror4<0x122>(xa), r2b = ror4<0x122>(xb);
                f32x4 p1a = r1a, p1b = r1b, p2a = r2a, p2b = r2b;
                if (m > 0) { if (fr < 1) { p1a = q1a; p1b = q1b; } if (fr < 2) { p2a = q2a; p2b = q2b; } }
                const f32x4 ga = gelu4(ba + w0a * p2a + w1a * p1a + w2a * xa), gb = gelu4(bb + w0b * p2b + w1b * p1b + w2b * xb);
                if (m > 0 || fr >= 2) ST16W(ACT + (size_t)row * FF + cgl, pack8(ga * va, gb * vb));
                if (m == 0) { if (fr < 2) { bf16_t* hp = RAWH + ((size_t)(row >> 6) * 6 + 2 + fr) * FF + cgl; *(u32x4*)hp = pack8(xa, xb); *(u32x4*)(hp + 2 * FF) = pack8(va, vb); } }
                if (m == 3) { if (fr >= 14) *(u32x4*)(RAWH + ((size_t)(row >> 6) * 6 + (fr - 14)) * FF + cgl) = pack8(xa, xb); }
                q1a = r1a; q1b = r1b; q2a = r2a; q2b = r2b;
            }
        }
    }
};
struct EpiUpG {
    static constexpr bool PERM = true, AFTER_DRAIN = false;
    bf16_t* UG; const float* ss; PG8_LAS float* rsl;
    __device__ __forceinline__ void operator()(const f32x4 (&acc)[2][2][4][2], const Unit& u, int wr, int wc, int fr, int fq) const {
        const int row0 = u.pm * BM + wr * 64 + fr;
        rs_to_lds<16>(rsl, ss, u.pm, 1.0f / 1024.0f, 1.0f, (wr * 4 + wc) * 64 + fq * 16 + fr);
#pragma unroll
        for (int ai = 0; ai < 2; ++ai)
#pragma unroll
            for (int m = 0; m < 4; ++m) {
                const int row = row0 + ai * HALF + m * 16;
                const float rs = rsl[wr * 64 + ai * HALF + m * 16 + fr];
#pragma unroll
                for (int bj = 0; bj < 2; ++bj) ST16(UG + (size_t)row * FF + u.pn * BM + bj * HALF + wc * 32 + 8 * fq, pack8(acc[ai][bj][m][0] * rs, acc[ai][bj][m][1] * rs));
            }
    }
};
struct EpiUpV {
    static constexpr bool PERM = true, AFTER_DRAIN = false;
    bf16_t* ACT; const float* ss; PG8_LAS float* rsl;
    __device__ __forceinline__ void operator()(const f32x4 (&acc)[2][2][4][2], const Unit& u, int wr, int wc, int fr, int fq) const {
        const int row0 = u.pm * BM + wr * 64 + fr, c0 = u.pn * BM + wc * 32 + 8 * fq;
        u32x4 gc[2][4][2];
#pragma unroll
        for (int ai = 0; ai < 2; ++ai)
#pragma unroll
            for (int m = 0; m < 4; ++m)
#pragma unroll
                for (int bj = 0; bj < 2; ++bj) gc[ai][m][bj] = *(const u32x4*)(ACT + (size_t)(row0 + ai * HALF + m * 16) * FF + c0 + bj * HALF);
        rs_to_lds<16>(rsl, ss, u.pm, 1.0f / 1024.0f, 1.0f, (wr * 4 + wc) * 64 + fq * 16 + fr);
#pragma unroll
        for (int ai = 0; ai < 2; ++ai)
#pragma unroll
            for (int m = 0; m < 4; ++m) {
                const int row = row0 + ai * HALF + m * 16;
                const float rs = rsl[wr * 64 + ai * HALF + m * 16 + fr];
#pragma unroll
                for (int bj = 0; bj < 2; ++bj) { const u32x4 g = gc[ai][m][bj];
                    *(u32x4*)(ACT + (size_t)row * FF + c0 + bj * HALF) = pack8(up4((u32x2){g.x, g.y}) * (acc[ai][bj][m][0] * rs), up4((u32x2){g.z, g.w}) * (acc[ai][bj][m][1] * rs)); }
            }
    }
};
}


#ifndef NAIVE_GEMM
#define NAIVE_GEMM 0
#endif
#ifndef NAIVE_ATTN
#define NAIVE_ATTN 0
#endif
#ifndef SHFL_SCAN
#define SHFL_SCAN 0
#endif
namespace pg8 {
template <class Epi, class Sched>
__device__ __forceinline__ void gemm_phase_naive(const Gemm g, const Sched& S, const Epi& E) {
    const int tid = vtid(), wid = tid >> 6, lane = tid & 63, wr = wid >> 2, wc = wid & 3, fr = lane & 15, fq = lane >> 4;
    Unit u;
    for (int i = 0; S.next(i, u); ++i) {
        f32x4 acc[2][2][4][2];
        _Pragma("unroll") for (int a = 0; a < 2; ++a) _Pragma("unroll") for (int b = 0; b < 2; ++b) _Pragma("unroll") for (int m = 0; m < 4; ++m) _Pragma("unroll") for (int n = 0; n < 2; ++n) {
            const int row = u.pm * BM + a * HALF + wr * 64 + m * 16 + fr;
            _Pragma("unroll") for (int j = 0; j < 4; ++j) {
                const int col = u.pn * BM + b * HALF + wc * 32 + (Epi::PERM ? 8 * fq + 4 * n + j : 16 * n + 4 * fq + j);
                const bf16_t* ap = g.A + (size_t)row * g.lda; const bf16_t* bp = g.Bt + (size_t)col * g.K;
                float s = 0.f;
                _Pragma("unroll 1") for (int k = 0; k < g.K; k += 8) {
                    const u32x4 av = *(const u32x4*)(ap + k), bv = *(const u32x4*)(bp + k);
                    for (int e = 0; e < 4; ++e) { s += __uint_as_float(av[e] << 16) * __uint_as_float(bv[e] << 16); s += __uint_as_float(av[e] & 0xffff0000u) * __uint_as_float(bv[e] & 0xffff0000u); }
                }
                acc[a][b][m][n][j] = s;
            }
        }
        E(acc, u, wr, wc, fr, fq);
    }
}
}
#if NAIVE_GEMM
#define GEMM_PHASE(EPI, lds, g, S, E) pg8::gemm_phase_naive<EPI, pg8::StaticOrder>(g, S, E)
#else
#define GEMM_PHASE(EPI, lds, g, S, E) pg8::gemm_phase<EPI, pg8::StaticOrder, true, true>(lds, g, S, E)
#endif
struct Args {
    const float* in[28]; float* out; unsigned char* ws; int ph_lo, ph_hi;
};
enum { I_X = 0, I_POS, I_ATTN_NORM, I_W_IN, I_MU, I_DBASE, I_W_DEC, I_IBASE, I_W_ICLR, I_W_GATE, I_KK, I_KA, I_RK, I_LNXW, I_LNXB, I_W_ORWKV, I_QNORM, I_W_QUP,
       I_KVNORM, I_W_KVUP, I_W_OMLA, I_W_OUT, I_FFN_NORM, I_W_UP, I_CONVW, I_CONVB, I_W_DOWN, I_FINAL };

typedef const __attribute__((address_space(4))) Args* ArgsP;
__device__ __forceinline__ ArgsP args_ptr() { ArgsP p = (ArgsP)__builtin_amdgcn_kernarg_segment_ptr(); asm volatile("" : "+s"(p)); return p; }
__device__ __forceinline__ int ltid() { int t = vtid(); asm volatile("" : "+v"(t)); return t; }
constexpr int NWAVES = 8, NTHREADS = 512;
constexpr int RING_BYTES = 131072, MISC_OFF = RING_BYTES + 320, LDS_BYTES = 147456;

struct WDesc { const float* W; const float* scale; bf16_t* dst; int N, k0, n0, mode, roff, ldk, koff; };
__device__ __forceinline__ void tr_load(const WDesc& d, f32x4 (&v)[8], int lane) {
    const int kq = lane >> 4, n4 = (lane & 15) * 4;
#pragma unroll
    for (int i = 0; i < 8; ++i) v[i] = (d.n0 + n4 < d.N) ? *(const f32x4*)(d.W + (size_t)(d.k0 + kq + 4 * i) * d.N + d.n0 + n4) : (f32x4){0.f, 0.f, 0.f, 0.f};
}
__device__ __forceinline__ void tr_store(const WDesc& d, const f32x4 (&v)[8], LAS float* scr, int lane) {
    const int kq = lane >> 4, n4 = (lane & 15) * 4;
#pragma unroll
    for (int i = 0; i < 8; ++i) { const int kk = kq + 4 * i; f32x4 x = v[i]; if (d.scale) x = x * d.scale[d.k0 + kk];
        LAS float* p = scr + kk * 65 + n4; p[0] = x.x; p[1] = x.y; p[2] = x.z; p[3] = x.w; }
    asm volatile("s_waitcnt lgkmcnt(0)" ::: "memory");
    const LAS float* s = scr + lane;
    const int n = d.n0 + lane, mode = d.mode;
    int drow = n;
    if (mode == 1) drow = n < 2208 ? n : n + 96;
    else if (mode == 2) { const int h = n / 96, j = n % 96; drow = j < 64 ? h * 64 + j : 512 + h * 32 + (j - 64); }
    else if (mode == 3) { const int h = n >> 7, j = n & 127; drow = j < 64 ? h * 64 + j : 512 + h * 64 + (j - 64); }
    else if (mode == 4) { const int v_ = n < FF ? n : n - FF; drow = (v_ >> 7) * 256 + (n < FF ? 0 : 128) + (v_ & 127); }
    bf16_t* o_ = d.dst + (size_t)(drow + d.roff) * d.ldk + d.koff + d.k0;
    if (n < d.N)
#pragma unroll
    for (int c = 0; c < 4; ++c) { u32x4 o; o.x = pk2(s[(8 * c + 0) * 65], s[(8 * c + 1) * 65]); o.y = pk2(s[(8 * c + 2) * 65], s[(8 * c + 3) * 65]); o.z = pk2(s[(8 * c + 4) * 65], s[(8 * c + 5) * 65]); o.w = pk2(s[(8 * c + 6) * 65], s[(8 * c + 7) * 65]);
        *(u32x4*)(o_ + 8 * c) = o; }
    asm volatile("s_waitcnt lgkmcnt(0)" ::: "memory");
}
__device__ __forceinline__ void phase_weights(ArgsP a, int l, LAS unsigned char* lds) {
    a = args_ptr();
    const int tid = ltid(), lane = tid & 63, wave = tid >> 6;
    const int gw = blockIdx.x * NWAVES + wave, NGW = gridDim.x * NWAVES;
    LAS float* scr = (LAS float*)(lds + wave * 16384);
    unsigned char* wb = a->ws + WS_W;
    bf16_t* Wt_in = (bf16_t*)(wb + W_IN); bf16_t* Wt_lora = (bf16_t*)(wb + W_LORA); bf16_t* Wt_q = (bf16_t*)(wb + W_Q); bf16_t* Wt_kv = (bf16_t*)(wb + W_KV);
    bf16_t* Wt_oa = (bf16_t*)(wb + W_OA); bf16_t* Wt_ob = (bf16_t*)(wb + W_OB); bf16_t* Wt_out = (bf16_t*)(wb + W_OUT); bf16_t* Wt_up = (bf16_t*)(wb + W_UP); bf16_t* Wt_down = (bf16_t*)(wb + W_DOWN);
    constexpr int I_IN = 32 * 67, I_DEC = 2 * 8, I_ICL = 2 * 8, I_GAT = 4 * 8, I_Q = 8 * 12, I_KV = 4 * 16, I_OA = 16 * 16, I_OB = 16 * 16, I_OUT = 32 * 16, I_UP = 32 * 88, I_DN = 88 * 16;
    constexpr int NITEMS = I_IN + I_DEC + I_ICL + I_GAT + I_Q + I_KV + I_OA + I_OB + I_OUT + I_UP + I_DN;
    auto decode = [&](int it) { WDesc d; int r = it, kb, nb; d.scale = nullptr; d.mode = 0; d.roff = 0; d.koff = 0;
        if (r < I_IN) { kb = r / 67; nb = r % 67; d.W = a->in[I_W_IN] + (size_t)l * 1024 * IN_COLS; d.N = IN_COLS; d.dst = Wt_in; d.mode = 1; d.ldk = 1024; d.scale = a->in[I_ATTN_NORM] + l * 1024; }
        else if ((r -= I_IN) < I_DEC) { kb = r / 8; nb = r % 8; d.W = a->in[I_W_DEC] + (size_t)l * 64 * 512; d.N = 512; d.dst = Wt_lora; d.ldk = 256; }
        else if ((r -= I_DEC) < I_ICL) { kb = r / 8; nb = r % 8; d.W = a->in[I_W_ICLR] + (size_t)l * 64 * 512; d.N = 512; d.dst = Wt_lora; d.roff = 512; d.ldk = 256; d.koff = 64; }
        else if ((r -= I_ICL) < I_GAT) { kb = r / 8; nb = r % 8; d.W = a->in[I_W_GATE] + (size_t)l * 128 * 512; d.N = 512; d.dst = Wt_lora; d.roff = 1024; d.ldk = 256; d.koff = 128; }
        else if ((r -= I_GAT) < I_Q) { kb = r / 12; nb = r % 12; d.W = a->in[I_W_QUP] + (size_t)l * 256 * 768; d.N = 768; d.dst = Wt_q; d.mode = 2; d.ldk = 256; d.scale = a->in[I_QNORM] + l * 256; }
        else if ((r -= I_Q) < I_KV) { kb = r / 16; nb = r % 16; d.W = a->in[I_W_KVUP] + (size_t)l * 128 * 1024; d.N = 1024; d.dst = Wt_kv; d.mode = 3; d.ldk = 256; d.scale = a->in[I_KVNORM] + l * 128; }
        else if ((r -= I_KV) < I_OA) { kb = r / 16; nb = r % 16; d.W = a->in[I_W_ORWKV] + (size_t)l * 512 * 1024; d.N = 1024; d.dst = Wt_oa; d.ldk = 512; }
        else if ((r -= I_OA) < I_OB) { kb = r / 16; nb = r % 16; d.W = a->in[I_W_OMLA] + (size_t)l * 512 * 1024; d.N = 1024; d.dst = Wt_ob; d.ldk = 512; }
        else if ((r -= I_OB) < I_OUT) { kb = r / 16; nb = r % 16; d.W = a->in[I_W_OUT] + (size_t)l * 1024 * 1024; d.N = 1024; d.dst = Wt_out; d.ldk = 1024; }
        else if ((r -= I_OUT) < I_UP) { kb = r / 88; nb = r % 88; d.W = a->in[I_W_UP] + (size_t)l * 1024 * 2 * FF; d.N = 2 * FF; d.dst = Wt_up; d.mode = 4; d.ldk = 1024; d.scale = a->in[I_FFN_NORM] + l * 1024; }
        else { r -= I_UP; kb = r / 16; nb = r % 16; d.W = a->in[I_W_DOWN] + (size_t)l * FF * 1024; d.N = 1024; d.dst = Wt_down; d.ldk = FF; }
        d.k0 = kb * 32; d.n0 = nb * 64; return d; };
    if (gw < NITEMS) {
        WDesc d0 = decode(gw), d1; f32x4 va[8], vb[8];
        tr_load(d0, va, lane);
#pragma unroll 1
        for (int it = gw; it < NITEMS; it += 2 * NGW) {
            const int i1 = it + NGW, i2 = i1 + NGW;
            d1 = decode(i1 < NITEMS ? i1 : it); tr_load(d1, vb, lane);
            tr_store(d0, va, scr, lane);
            if (i1 >= NITEMS) break;
            d0 = decode(i2 < NITEMS ? i2 : i1); tr_load(d0, va, lane);
            tr_store(d1, vb, scr, lane);
        }
    }
    const int gt = blockIdx.x * NTHREADS + tid, NGT = gridDim.x * NTHREADS;
    unsigned z0_ = 0u; asm volatile("" : "+v"(z0_));
    const u32x4 z = (u32x4){z0_, z0_, z0_, z0_};
    for (int i = gt; i < 96 * 128; i += NGT) *(u32x4*)(Wt_in + (size_t)(2208 + i / 128) * 1024 + (i % 128) * 8) = z;
    for (int i = gt; i < 1536 * 32; i += NGT) { const int row = i / 32, k8 = (i % 32) * 8, kind = row >> 9; const bool live = kind == 0 ? (k8 < 64) : (kind == 1 ? (k8 >= 64 && k8 < 128) : (k8 >= 128)); if (!live) *(u32x4*)(Wt_lora + (size_t)row * 256 + k8) = z; }
    for (int i = gt; i < 1024 * 16; i += NGT) *(u32x4*)(Wt_kv + (size_t)(i / 16) * 256 + 128 + (i % 16) * 8) = z;
#ifdef SCRIBBLE
    if (l == 0) { u32x4* p = (u32x4*)(a->ws + WS_ACT); const u32x4 pz = (u32x4){0xAAAAAAAAu, 0xAAAAAAAAu, 0xAAAAAAAAu, 0xAAAAAAAAu};
        for (unsigned i = gt; i < 178u * 65536u; i += NGT) p[i] = pz; }
#endif
    if (l == 0) {
        float* SS0 = (float*)(a->ws + WS_SSP); bf16_t* HB = (bf16_t*)(a->ws + A_HB);
        for (int m = gw; m < M; m += 2 * NGW) {
            const int m2 = m + NGW;
            const f32x4* xr = (const f32x4*)(a->in[I_X] + (size_t)m * DM) + lane; const f32x4* xr2 = (const f32x4*)(a->in[I_X] + (size_t)(m2 < M ? m2 : m) * DM) + lane;
            f32x4 v1[4], v2[4];
#pragma unroll
            for (int j = 0; j < 4; ++j) { v1[j] = xr[64 * j]; v2[j] = xr2[64 * j]; }
            float s = 0.f, s2 = 0.f;
            u32x2* o = (u32x2*)(HB + (size_t)m * DM) + lane; u32x2* o2p = (u32x2*)(HB + (size_t)m2 * DM) + lane;
#pragma unroll
            for (int j = 0; j < 4; ++j) { s += dot4(v1[j], v1[j]); o[64 * j] = dn4(v1[j]); }
            if (m2 < M) {
#pragma unroll
                for (int j = 0; j < 4; ++j) { s2 += dot4(v2[j], v2[j]); o2p[64 * j] = dn4(v2[j]); } }
#pragma unroll
            for (int o2 = 1; o2 < 64; o2 <<= 1) { s += shx(s, o2); s2 += shx(s2, o2); }
            if (lane < 16) { SS0[(size_t)m * 16 + lane] = lane == 0 ? s : 0.f; if (m2 < M) SS0[(size_t)m2 * 16 + lane] = lane == 0 ? s2 : 0.f; }
        }
        float* CS = (float*)(a->ws + WS_CS); const int* pos = (const int*)a->in[I_POS];
        for (int i = gt; i < M * 16; i += NGT) { const int row = i >> 4, f = i & 15;
            const float invf = exp2f(-0.830482023721841f * (float)f);
            const float ang = (float)pos[row] * invf;
            const float k = rintf(ang * 0.15915494309189535f);
            float rr = fmaf(-k, 6.2831854820251465f, ang); rr = fmaf(-k, -1.7484555314695172e-07f, rr);
            CS[(size_t)row * 32 + f] = cosf(rr); CS[(size_t)row * 32 + 16 + f] = sinf(rr); }
    }
}

__device__ __forceinline__ void phase_prep(ArgsP a, int l) {
    a = args_ptr();
    const unsigned gt = blockIdx.x * NTHREADS + ltid(), NGT = gridDim.x * NTHREADS;
    const bf16_t* LORAC = (const bf16_t*)(a->ws + A_LORAC); bf16_t* LIN = (bf16_t*)(a->ws + A_LIN);
    {
        const int j = (gt & 31) * 8; const float* mu = a->in[I_MU] + (size_t)l * 1792 + 1536 + j;
        const f32x4 m0 = *(const f32x4*)mu, m1 = *(const f32x4*)(mu + 4);
        for (unsigned i = gt; i < (unsigned)M * 32; i += NGT) { const unsigned row = i >> 5; const int t = row & 4095;
            const u32x4 cu = *(const u32x4*)(LORAC + (size_t)row * 256 + j); const u32x4 pv = t ? *(const u32x4*)(LORAC + (size_t)(row - 1) * 256 + j) : (u32x4){0u, 0u, 0u, 0u};
            const f32x4 c0 = up4((u32x2){cu.x, cu.y}), c1 = up4((u32x2){cu.z, cu.w}), q0 = up4((u32x2){pv.x, pv.y}), q1 = up4((u32x2){pv.z, pv.w});
            f32x4 s0 = c0 + (q0 - c0) * m0, s1 = c1 + (q1 - c1) * m1;
            if (j < 64) { for (int e = 0; e < 4; ++e) { s0[e] = tanhf(s0[e]); s1[e] = tanhf(s1[e]); } } else if (j >= 128) { for (int e = 0; e < 4; ++e) { s0[e] = sigm(s0[e]); s1[e] = sigm(s1[e]); } }
            const u32x2 o0 = dn4(s0), o1 = dn4(s1); *(u32x4*)(LIN + (size_t)row * 256 + j) = (u32x4){o0.x, o0.y, o1.x, o1.y}; }
    }
    const bf16_t* PMb = (const bf16_t*)(a->ws + A_PM); bf16_t* KPE = (bf16_t*)(a->ws + A_KPE); const float* CS = (const float*)(a->ws + WS_CS);
    for (unsigned i = gt; i < (unsigned)M * 4; i += NGT) { const unsigned row = i >> 2; const int f = (i & 3) * 4;
        const f32x4 x1 = up4(*(const u32x2*)(PMb + (size_t)row * 512 + 384 + f)), x2 = up4(*(const u32x2*)(PMb + (size_t)row * 512 + 400 + f));
        const f32x4 cs = *(const f32x4*)(CS + (size_t)row * 32 + f), sn = *(const f32x4*)(CS + (size_t)row * 32 + 16 + f);
        *(u32x2*)(KPE + (size_t)row * 32 + f) = dn4(x1 * cs - x2 * sn); *(u32x2*)(KPE + (size_t)row * 32 + 16 + f) = dn4(x1 * sn + x2 * cs); }
}
constexpr int CW_LINCNT = 70000;
__device__ __forceinline__ void prep_rows(ArgsP a, int l, int r0) {
    a = args_ptr();
    const int tid = ltid();
    const bf16_t* LORAC = (const bf16_t*)(a->ws + A_LORAC); bf16_t* LIN = (bf16_t*)(a->ws + A_LIN);
    {   const int j = (tid & 31) * 8; const float* mu = a->in[I_MU] + (size_t)l * 1792 + 1536 + j;
        const f32x4 m0 = *(const f32x4*)mu, m1 = *(const f32x4*)(mu + 4);
        u32x4 cu[4], pv[4];
#pragma unroll
        for (int k = 0; k < 4; ++k) { const int row = r0 + (tid >> 5) + 16 * k;
            cu[k] = *(const u32x4*)(LORAC + (size_t)row * 256 + j); pv[k] = (row & 4095) ? *(const u32x4*)(LORAC + (size_t)(row - 1) * 256 + j) : (u32x4){0u, 0u, 0u, 0u}; }
#pragma unroll
        for (int k = 0; k < 4; ++k) { const int row = r0 + (tid >> 5) + 16 * k;
            const f32x4 c0 = up4((u32x2){cu[k].x, cu[k].y}), c1 = up4((u32x2){cu[k].z, cu[k].w}), q0 = up4((u32x2){pv[k].x, pv[k].y}), q1 = up4((u32x2){pv[k].z, pv[k].w});
            f32x4 s0 = c0 + (q0 - c0) * m0, s1 = c1 + (q1 - c1) * m1;
            if (j < 64) { for (int e = 0; e < 4; ++e) { s0[e] = tanhf(s0[e]); s1[e] = tanhf(s1[e]); } } else if (j >= 128) { for (int e = 0; e < 4; ++e) { s0[e] = sigm(s0[e]); s1[e] = sigm(s1[e]); } }
            const u32x2 o0 = dn4(s0), o1 = dn4(s1); pg8::ST16W(LIN + (size_t)row * 256 + j, (u32x4){o0.x, o0.y, o1.x, o1.y}); }
    }
    if (tid < 256) { const bf16_t* PMb = (const bf16_t*)(a->ws + A_PM); bf16_t* KPE = (bf16_t*)(a->ws + A_KPE); const float* CS = (const float*)(a->ws + WS_CS);
        const int row = r0 + (tid >> 2), f = (tid & 3) * 4;
        const f32x4 x1 = up4(*(const u32x2*)(PMb + (size_t)row * 512 + 384 + f)), x2 = up4(*(const u32x2*)(PMb + (size_t)row * 512 + 400 + f));
        const f32x4 cs = *(const f32x4*)(CS + (size_t)row * 32 + f), sn = *(const f32x4*)(CS + (size_t)row * 32 + 16 + f);
        *(u32x2*)(KPE + (size_t)row * 32 + f) = dn4(x1 * cs - x2 * sn); *(u32x2*)(KPE + (size_t)row * 32 + 16 + f) = dn4(x1 * sn + x2 * cs); }
    asm volatile("s_waitcnt vmcnt(0)" ::: "memory");
    __syncthreads();
    if (tid == 0) (void)__hip_atomic_fetch_add((unsigned*)(a->ws + WS_CTL) + CW_LINCNT + (l * 64 + (r0 >> 8)) * 16, 1u, __ATOMIC_RELAXED, __HIP_MEMORY_SCOPE_AGENT);
}
__device__ __forceinline__ void lin_wait(ArgsP a, int l, int pm) {
    a = args_ptr();
    if (ltid() < 64) {
        unsigned* cnt = (unsigned*)(a->ws + WS_CTL) + CW_LINCNT + (l * 64 + pm) * 16; unsigned* tmo = (unsigned*)(a->ws + WS_CTL) + CW_BAR + XB_TMO; unsigned sp_ = 0;
        while ((unsigned)__builtin_amdgcn_readfirstlane(__hip_atomic_load(cnt, __ATOMIC_RELAXED, __HIP_MEMORY_SCOPE_AGENT)) < 4u) { __builtin_amdgcn_s_sleep(1);
            if ((++sp_ & 255u) == 0u) { if (xb_ld(tmo)) break; if (sp_ > XB_SPIN_CAP) { atomicAdd(tmo, 1u); break; } } }
        __builtin_amdgcn_fence(__ATOMIC_ACQUIRE, "agent");
    }
    __syncthreads();
}

template <int CTRL> __device__ __forceinline__ float dppf(float x) { return __builtin_bit_cast(float, __builtin_amdgcn_update_dpp(0, __builtin_bit_cast(int, x), CTRL, 0xf, 0xf, false)); }
#if SHFL_SCAN
__device__ __forceinline__ float rr16(float x) { x += shx(x, 8); x += shx(x, 4); x += shx(x, 2); x += shx(x, 1); return x; }
#else
__device__ __forceinline__ float rr16(float x) { x += dppf<0x128>(x); x += dppf<0x124>(x); x += dppf<0x122>(x); x += dppf<0x121>(x); return x; }
#endif

typedef float f32x2 __attribute__((ext_vector_type(2)));
constexpr int SC_BUF = 43008, SC_R = 0, SC_W = 8192, SC_K = 16384, SC_A = 24576, SC_B = 32768, SC_V = 40960, SC_YP = 2 * SC_BUF, SC_YPB = 8192;
struct ScOps { f32x4 a, w, b, k, r; float v; };
__device__ __forceinline__ void sc_ld(ScOps& o, const LAS unsigned char* bp, const LAS unsigned char* vp, int t) {
    o.a = *(const LAS f32x4*)(bp + SC_A + t * 256); o.w = *(const LAS f32x4*)(bp + SC_W + t * 256); o.b = *(const LAS f32x4*)(bp + SC_B + t * 256);
    o.k = *(const LAS f32x4*)(bp + SC_K + t * 256); o.r = *(const LAS f32x4*)(bp + SC_R + t * 256); o.v = *(const LAS float*)(vp + t * 64);
}
__device__ __forceinline__ void scan_unit(ArgsP a, int l, int bh, int q4, LAS unsigned char* lds, size_t y_off = A_Y) {
    a = args_ptr();
    const int tid = ltid(), lane = tid & 63, wid = __builtin_amdgcn_readfirstlane(tid >> 6);
    const int b = bh >> 3, h = bh & 7, i0 = q4 * 16;
    const bf16_t* RKV = (const bf16_t*)(a->ws + A_RKV); const bf16_t* LW = (const bf16_t*)(a->ws + A_LW); const bf16_t* ICLR = (const bf16_t*)(a->ws + A_ICLR);
    bf16_t* Y = (bf16_t*)(a->ws + y_off); float* SCAL = (float*)(a->ws + WS_SCAL);
    constexpr int NCH = SEQ / 32;
    if (wid >= 4) {
        const int ht = tid - 256, pcg = ht & 15, tau0 = ht >> 4, ch = h * 64 + 4 * pcg;
        const float* mu = a->in[I_MU] + (size_t)l * 1792;
        const f32x4 mu_r = *(const f32x4*)(mu + ch), mu_k = *(const f32x4*)(mu + 512 + ch), mu_v = *(const f32x4*)(mu + 1024 + ch);
        const f32x4 kk_c = *(const f32x4*)(a->in[I_KK] + l * 512 + ch), ka_c = *(const f32x4*)(a->in[I_KA] + l * 512 + ch), rk_c = *(const f32x4*)(a->in[I_RK] + l * 512 + ch);
        u32x2 g[2][8];
        const u32x2 z2 = (u32x2){0u, 0u};
#define SC_LOAD(c) do { _Pragma("unroll") for (int k_ = 0; k_ < 2; ++k_) { const int t_ = (c) * 32 + tau0 + 16 * k_; const size_t row_ = (size_t)b * SEQ + t_; \
            g[k_][0] = *(const u32x2*)(RKV + row_ * 1536 + ch); g[k_][1] = *(const u32x2*)(RKV + row_ * 1536 + 512 + ch); g[k_][2] = *(const u32x2*)(RKV + row_ * 1536 + 1024 + ch); \
            if (t_) { g[k_][3] = *(const u32x2*)(RKV + (row_ - 1) * 1536 + ch); g[k_][4] = *(const u32x2*)(RKV + (row_ - 1) * 1536 + 512 + ch); g[k_][5] = *(const u32x2*)(RKV + (row_ - 1) * 1536 + 1024 + ch); } \
            else { g[k_][3] = z2; g[k_][4] = z2; g[k_][5] = z2; } \
            g[k_][6] = *(const u32x2*)(LW + row_ * 512 + ch); g[k_][7] = *(const u32x2*)(ICLR + row_ * 512 + ch); } } while (0)
#define SC_STORE(c, p) do { _Pragma("unroll") for (int k_ = 0; k_ < 2; ++k_) { const int tau_ = tau0 + 16 * k_; LAS unsigned char* base_ = lds + (p) * SC_BUF + tau_ * 256 + pcg * 16; \
            const f32x4 r2 = up4(g[k_][0]), k2 = up4(g[k_][1]), v2 = up4(g[k_][2]); \
            const f32x4 r = r2 + (up4(g[k_][3]) - r2) * mu_r, k = k2 + (up4(g[k_][4]) - k2) * mu_k, v = v2 + (up4(g[k_][5]) - v2) * mu_v; \
            const f32x4 lw = up4(g[k_][6]), ic = up4(g[k_][7]); \
            f32x4 kk = k * kk_c; float ssum = dot4(kk, kk); ssum += shx(ssum, 1); ssum += shx(ssum, 2); ssum += shx(ssum, 4); ssum += shx(ssum, 8); \
            kk = kk * rsqrtf(ssum + 1e-12f); \
            const f32x4 kp = k * (1.0f + (ic - 1.0f) * ka_c); \
            float sc = dot4(r * kp, rk_c); sc += shx(sc, 1); sc += shx(sc, 2); sc += shx(sc, 4); sc += shx(sc, 8); \
            if (q4 == 0 && pcg == 0) SCAL[((size_t)b * SEQ + (c) * 32 + tau_) * 8 + h] = sc; \
            f32x4 w; w.x = __expf(lw.x * CK_LWZ); w.y = __expf(lw.y * CK_LWZ); w.z = __expf(lw.z * CK_LWZ); w.w = __expf(lw.w * CK_LWZ); \
            *(LAS f32x4*)(base_ + SC_R) = r; *(LAS f32x4*)(base_ + SC_W) = w; *(LAS f32x4*)(base_ + SC_K) = kp; *(LAS f32x4*)(base_ + SC_A) = -kk * CK_AB; *(LAS f32x4*)(base_ + SC_B) = kk * ic * CK_AB; \
            if ((pcg >> 2) == q4) *(LAS f32x4*)(lds + (p) * SC_BUF + SC_V + tau_ * 64 + (pcg & 3) * 16) = v; } } while (0)
        SC_LOAD(0); SC_STORE(0, 0); SC_LOAD(1);
        __syncthreads();
        for (int c = 0; c < NCH; ++c) {
            if (c + 1 < NCH) { SC_STORE(c + 1, (c + 1) & 1); if (c + 2 < NCH) SC_LOAD(c + 2); }
            if (c > 0) {
                const LAS f32x4* yp = (const LAS f32x4*)(lds + SC_YP + ((c - 1) & 1) * SC_YPB + (ht >> 3) * 256 + (ht & 7) * 32);
                const f32x4 y0 = yp[0], y1 = yp[1];
                *(unsigned*)(Y + ((size_t)b * SEQ + (c - 1) * 32 + (ht >> 3)) * 512 + h * 64 + i0 + 2 * (ht & 7)) = pk2((y0.x + y0.y) + (y0.z + y0.w), (y1.x + y1.y) + (y1.z + y1.w));
            }
            __syncthreads();
        }
        { const int c = NCH;
          const LAS f32x4* yp = (const LAS f32x4*)(lds + SC_YP + ((c - 1) & 1) * SC_YPB + (ht >> 3) * 256 + (ht & 7) * 32);
          const f32x4 y0 = yp[0], y1 = yp[1];
          *(unsigned*)(Y + ((size_t)b * SEQ + (c - 1) * 32 + (ht >> 3)) * 512 + h * 64 + i0 + 2 * (ht & 7)) = pk2((y0.x + y0.y) + (y0.z + y0.w), (y1.x + y1.y) + (y1.z + y1.w)); }
#undef SC_LOAD
#undef SC_STORE
    } else {
        const int rloc = wid * 4 + (lane >> 4), cgp = lane & 15;
        __syncthreads();
        f32x2 s01 = (f32x2){0.f, 0.f}, s23 = s01;
        for (int c = 0; c < NCH; ++c) {
            const int p = c & 1;
            const LAS unsigned char* bp = lds + p * SC_BUF + cgp * 16;
            const LAS unsigned char* vp = lds + p * SC_BUF + SC_V + rloc * 4;
            LAS float* ypw = (LAS float*)(lds + SC_YP + p * SC_YPB) + rloc * 4 + cgp;
            ScOps oa, ob;
            sc_ld(oa, bp, vp, 0);
#define SC_STEP(cur, nxt, t) do { if ((t) + 1 < 32) sc_ld(nxt, bp, vp, (t) + 1); if (CK_NOSTATE && ((t) & 15) == 0) { s01 = (f32x2){0.f, 0.f}; s23 = s01; } \
                const f32x2 vk0 = (f32x2){cur.k.x, cur.k.y} * cur.v, vk1 = (f32x2){cur.k.z, cur.k.w} * cur.v; \
                const f32x2 t0 = s01 * (f32x2){cur.w.x, cur.w.y} + vk0, t1 = s23 * (f32x2){cur.w.z, cur.w.w} + vk1; \
                f32x2 pd = s01 * (f32x2){cur.a.x, cur.a.y}; pd = s23 * (f32x2){cur.a.z, cur.a.w} + pd; \
                const float d = rr16(pd.x + pd.y); \
                s01 = (f32x2){cur.b.x, cur.b.y} * d + t0; s23 = (f32x2){cur.b.z, cur.b.w} * d + t1; \
                f32x2 qd = s01 * (f32x2){cur.r.x, cur.r.y}; qd = s23 * (f32x2){cur.r.z, cur.r.w} + qd; \
                float y = qd.x + qd.y; y += dppf<0x128>(y); y += dppf<0x124>(y); \
                if (cgp < 4) ypw[(t) * 64] = y; } while (0)
#pragma unroll 1
            for (int t = 0; t < 32; t += 2) { SC_STEP(oa, ob, t); SC_STEP(ob, oa, t + 1); }
#undef SC_STEP
            __syncthreads();
        }
    }
    __syncthreads();
}

typedef short s16x4v __attribute__((ext_vector_type(4)));
constexpr int CK_ROW = 144;
constexpr int CK_AT = 0, CK_RT = 2304, CK_BT = 4608, CK_KT = 6912, CK_VT = 9216, CK_GL = 11520, CK_OPB = 11776, CK_NOP = 5;
constexpr int CK_MT0 = CK_NOP * CK_OPB, CK_MAK = 0, CK_MRB = 512, CK_MRK = 1024, CK_TT = 1536, CK_MAB = 2048, CK_MTB = 2048 + 16 * 80, CK_NMT = 4;
constexpr int CK_YT0 = CK_MT0 + CK_NMT * CK_MTB, CK_YTB = 1024;
typedef short v4i16_t __attribute__((ext_vector_type(4)));
__device__ __forceinline__ s16x4v ldtr(const LAS unsigned char* p) { return __builtin_bit_cast(s16x4v, __builtin_amdgcn_ds_read_tr16_b64_v4i16((LAS v4i16_t*)p)); }
__device__ __forceinline__ s16x4v pk4(f32x4 v) { const u32x2 p = dn4(v); return __builtin_bit_cast(s16x4v, p); }
__device__ __forceinline__ void scan_unit_chunked(ArgsP a, int l, int bh, int q4, LAS unsigned char* lds, size_t y_off = A_Y) {
    a = args_ptr();
    const int tid = ltid(), lane = tid & 63, wid = __builtin_amdgcn_readfirstlane(tid >> 6);
    const int b = bh >> 3, h = bh & 7, i0 = q4 * 16, q = lane >> 4, l15 = lane & 15;
    const bf16_t* RKV = (const bf16_t*)(a->ws + A_RKV); const bf16_t* EG = (const bf16_t*)(a->ws + A_LW); const bf16_t* ICLR = (const bf16_t*)(a->ws + A_ICLR);
    bf16_t* Y = (bf16_t*)(a->ws + y_off); float* SCAL = (float*)(a->ws + WS_SCAL);
    constexpr int NCH = SEQ / 16;
    const int ht = tid - 256, t_h = (ht >> 4) & 15, jg = ht & 15, ch = h * 64 + 4 * jg;
    f32x4 mu_r, mu_k, mu_v, kk_c, ka_c, rk_c;
    u32x2 g[10], g1[10], g2[10];
    if (wid >= 4) {
        const float* mu = a->in[I_MU] + (size_t)l * 1792;
        mu_r = *(const f32x4*)(mu + ch); mu_k = *(const f32x4*)(mu + 512 + ch); mu_v = *(const f32x4*)(mu + 1024 + ch);
        kk_c = *(const f32x4*)(a->in[I_KK] + l * 512 + ch); ka_c = *(const f32x4*)(a->in[I_KA] + l * 512 + ch); rk_c = *(const f32x4*)(a->in[I_RK] + l * 512 + ch);
    }
#define CK_LOAD(G_, c) do { const int t_ = (c) * 16 + t_h; const size_t row_ = (size_t)b * SEQ + t_; const size_t rp_ = t_ ? row_ - 1 : row_; \
        G_[0] = *(const u32x2*)(RKV + row_ * 1536 + ch); G_[1] = *(const u32x2*)(RKV + row_ * 1536 + 512 + ch); G_[2] = *(const u32x2*)(RKV + row_ * 1536 + 1024 + ch); \
        G_[3] = *(const u32x2*)(RKV + rp_ * 1536 + ch); G_[4] = *(const u32x2*)(RKV + rp_ * 1536 + 512 + ch); G_[5] = *(const u32x2*)(RKV + rp_ * 1536 + 1024 + ch); \
        G_[6] = *(const u32x2*)(ICLR + row_ * 512 + ch); G_[7] = *(const u32x2*)(EG + row_ * 512 + ch); \
        G_[8] = *(const u32x2*)(EG + (row_ - (t_h ? 1 : 0)) * 512 + ch); G_[9] = *(const u32x2*)(EG + ((size_t)b * SEQ + (c) * 16 + 15) * 512 + ch); } while (0)
    f32x4 accS[4];
#pragma unroll
    for (int jt = 0; jt < 4; ++jt) accS[jt] = (f32x4){0.f, 0.f, 0.f, 0.f};
    float x[16];
#pragma unroll
    for (int t_ = 0; t_ < 16; ++t_) x[t_] = 0.f;
#define CK_OPSTAGE(G_, it) do { \
            if (it < NCH) { \
                LAS unsigned char* op = lds + (it % CK_NOP) * CK_OPB; \
                const f32x4 r2 = up4(G_[0]), k2 = up4(G_[1]), v2 = up4(G_[2]); \
                const float pz_ = (it * 16 + t_h) ? 1.0f : 0.0f; \
                const f32x4 r = r2 + (up4(G_[3]) * pz_ - r2) * mu_r, k = k2 + (up4(G_[4]) * pz_ - k2) * mu_k, v = v2 + (up4(G_[5]) * pz_ - v2) * mu_v, ic = up4(G_[6]); \
                const f32x4 eG = up4(G_[7]), eGL = up4(G_[9]); \
                f32x4 eGx = up4(G_[8]); if (t_h == 0) eGx = (f32x4){1.f, 1.f, 1.f, 1.f}; \
                f32x4 enG; \
_Pragma("unroll") \
                for (int e = 0; e < 4; ++e) enG[e] = __builtin_amdgcn_rcpf(eG[e]); \
                f32x4 kk = k * kk_c; const float ssum = rr16(dot4(kk, kk)); \
                kk = kk * rsqrtf(ssum + 1e-12f); \
                const f32x4 kp = k * (1.0f + (ic - 1.0f) * ka_c), bb = kk * ic; \
                const float sc = rr16(dot4(r * kp, rk_c)); \
                if (q4 == 0 && jg == 0) SCAL[((size_t)b * SEQ + it * 16 + t_h) * 8 + h] = sc; \
                *(LAS u32x2*)(op + CK_AT + t_h * CK_ROW + jg * 8) = dn4(-(kk * eGx)); \
                *(LAS u32x2*)(op + CK_RT + t_h * CK_ROW + jg * 8) = dn4(r * eG); \
                *(LAS u32x2*)(op + CK_BT + t_h * CK_ROW + jg * 8) = dn4(bb * enG); \
                *(LAS u32x2*)(op + CK_KT + t_h * CK_ROW + jg * 8) = dn4(kp * enG); \
                *(LAS u32x2*)(op + CK_VT + t_h * CK_ROW + jg * 8) = dn4(v); \
                if (t_h == 0) *(LAS f32x4*)(op + CK_GL + jg * 16) = eGL; \
            } \
            if (it + 3 < NCH) CK_LOAD(G_, it + 3); \
        } while (0)
    if (wid >= 4) { CK_LOAD(g, 0); CK_LOAD(g1, 1); CK_LOAD(g2, 2); }
#ifdef CK_TIME
    unsigned long long tb_ = 0, t0_ = 0; const unsigned long long tstart_ = __builtin_readcyclecounter();
#define CK_T0() (t0_ = __builtin_readcyclecounter())
#define CK_T1() (tb_ += __builtin_readcyclecounter() - t0_)
#else
#define CK_T0() do {} while (0)
#define CK_T1() do {} while (0)
#endif
    constexpr int NIT = ((NCH + 6 + 2) / 3) * 3;
    if (wid >= 4) {
#define CK_YSTORE(it) do { if (wid == 4 && (it) >= 5 && (it) - 5 < NCH) { \
            const LAS float* yt = (const LAS float*)(lds + CK_YT0 + (((it) - 5) & 1) * CK_YTB); const int t_ = lane >> 2, ip = (lane & 3) * 4; \
            const f32x4 yv = *(const LAS f32x4*)(yt + t_ * 16 + ip); \
            *(u32x2*)(Y + ((size_t)b * SEQ + ((it) - 5) * 16 + t_) * 512 + h * 64 + i0 + ip) = dn4(yv); } } while (0)
        for (int it3 = 0; it3 < NIT; it3 += 3) {
            CK_T0(); CK_OPSTAGE(g, it3); CK_YSTORE(it3); CK_T1(); __syncthreads();
            CK_T0(); CK_OPSTAGE(g1, (it3 + 1)); CK_YSTORE((it3 + 1)); CK_T1(); __syncthreads();
            CK_T0(); CK_OPSTAGE(g2, (it3 + 2)); CK_YSTORE((it3 + 2)); CK_T1(); __syncthreads();
        }
#undef CK_YSTORE
    } else
    for (int it = 0; it < NIT; ++it) {
        CK_T0();
        if (wid >= 1) {
            const int ph3 = (it + 3 - wid) % 3;
            const int c = it - 1 - ph3;
            if (c >= 0 && c < NCH) {
                const LAS unsigned char* op = lds + (c % CK_NOP) * CK_OPB; LAS unsigned char* mt = lds + CK_MT0 + (c % CK_NMT) * CK_MTB;
                if (ph3 == 0) {
                    const int ro = l15 * CK_ROW + q * 16;
                    const bf16x8 at0 = *(const LAS bf16x8*)(op + CK_AT + ro), at1 = *(const LAS bf16x8*)(op + CK_AT + ro + 64), rt0 = *(const LAS bf16x8*)(op + CK_RT + ro), rt1 = *(const LAS bf16x8*)(op + CK_RT + ro + 64);
                    const bf16x8 bt0 = *(const LAS bf16x8*)(op + CK_BT + ro), bt1 = *(const LAS bf16x8*)(op + CK_BT + ro + 64), kt0 = *(const LAS bf16x8*)(op + CK_KT + ro), kt1 = *(const LAS bf16x8*)(op + CK_KT + ro + 64);
                    const f32x4 z = (f32x4){0.f, 0.f, 0.f, 0.f};
                    f32x4 mab = __builtin_amdgcn_mfma_f32_16x16x32_bf16(at0, bt0, z, 0, 0, 0); mab = __builtin_amdgcn_mfma_f32_16x16x32_bf16(at1, bt1, mab, 0, 0, 0);
                    f32x4 mak = __builtin_amdgcn_mfma_f32_16x16x32_bf16(at0, kt0, z, 0, 0, 0); mak = __builtin_amdgcn_mfma_f32_16x16x32_bf16(at1, kt1, mak, 0, 0, 0);
                    f32x4 mrb = __builtin_amdgcn_mfma_f32_16x16x32_bf16(rt0, bt0, z, 0, 0, 0); mrb = __builtin_amdgcn_mfma_f32_16x16x32_bf16(rt1, bt1, mrb, 0, 0, 0);
                    f32x4 mrk = __builtin_amdgcn_mfma_f32_16x16x32_bf16(rt0, kt0, z, 0, 0, 0); mrk = __builtin_amdgcn_mfma_f32_16x16x32_bf16(rt1, kt1, mrk, 0, 0, 0);
#pragma unroll
                    for (int r = 0; r < 4; ++r) { const int t_ = 4 * q + r; const bool lo_ = l15 < t_, le_ = l15 <= t_;
                        *(LAS float*)(mt + CK_MAB + t_ * 80 + l15 * 4) = lo_ ? mab[r] : 0.f;
                        *(LAS bf16_t*)(mt + CK_MAK + t_ * 32 + l15 * 2) = (bf16_t)f2bf(lo_ ? mak[r] : 0.f);
                        *(LAS bf16_t*)(mt + CK_MRB + t_ * 32 + l15 * 2) = (bf16_t)f2bf(le_ ? mrb[r] : 0.f);
                        *(LAS bf16_t*)(mt + CK_MRK + t_ * 32 + l15 * 2) = (bf16_t)f2bf(le_ ? mrk[r] : 0.f); }
                } else {
#define CK_MLD(t_) f32x4 m_##t_[4]; _Pragma("unroll") for (int s4 = 0; s4 < (t_); s4 += 4) m_##t_[s4 >> 2] = *(const LAS f32x4*)(mt + CK_MAB + (t_) * 80 + s4 * 4)
#define CK_TROW(t_) do { float acc_ = (l15 == (t_)) ? 1.f : 0.f; \
                        _Pragma("unroll") for (int s4 = 0; s4 < (t_); s4 += 4) { \
                            _Pragma("unroll") for (int e = 0; e < 4; ++e) if (s4 + e < (t_)) acc_ += m_##t_[s4 >> 2][e] * x[s4 + e]; } \
                        x[t_] = acc_; } while (0)
                    if (ph3 == 1) { CK_MLD(1); CK_MLD(2); CK_MLD(3); CK_MLD(4); CK_MLD(5); CK_MLD(6); CK_MLD(7); CK_MLD(8); CK_MLD(9); CK_MLD(10);
                        x[0] = (l15 == 0) ? 1.f : 0.f; CK_TROW(1); CK_TROW(2); CK_TROW(3); CK_TROW(4); CK_TROW(5); CK_TROW(6); CK_TROW(7); CK_TROW(8); CK_TROW(9); CK_TROW(10); }
                    else { CK_MLD(11); CK_MLD(12); CK_MLD(13); CK_MLD(14); CK_MLD(15); CK_TROW(11); CK_TROW(12); CK_TROW(13); CK_TROW(14); CK_TROW(15);
                        if (q == 0) {
#pragma unroll
                            for (int t_ = 0; t_ < 16; ++t_) *(LAS bf16_t*)(mt + CK_TT + t_ * 32 + l15 * 2) = (bf16_t)f2bf(x[t_]); } }
#undef CK_TROW
#undef CK_MLD
                }
            }
        } else {
            const int c = it - 4;
            if (c >= 0 && c < NCH) {
                const LAS unsigned char* op = lds + (c % CK_NOP) * CK_OPB; const LAS unsigned char* mt = lds + CK_MT0 + (c % CK_NMT) * CK_MTB;
                s16x4v sb[4];
#pragma unroll
                for (int jt = 0; jt < 4; ++jt) { if (CK_NOSTATE) accS[jt] = (f32x4){0.f, 0.f, 0.f, 0.f}; sb[jt] = pk4(accS[jt]); }
                const int ao = l15 * CK_ROW + q * 8;
                const int tro = (4 * q + (l15 >> 2)) * CK_ROW + (l15 & 3) * 8;
                const s16x4v vb = ldtr(op + CK_VT + tro + i0 * 2);
                f32x4 x1 = (f32x4){0.f, 0.f, 0.f, 0.f}, x2 = x1;
#pragma unroll
                for (int jt = 0; jt < 4; ++jt) {
                    const s16x4v a0 = *(const LAS s16x4v*)(op + CK_AT + ao + jt * 32), r0 = *(const LAS s16x4v*)(op + CK_RT + ao + jt * 32);
                    x1 = __builtin_amdgcn_mfma_f32_16x16x16bf16_1k(a0, sb[jt], x1, 0, 0, 0);
                    x2 = __builtin_amdgcn_mfma_f32_16x16x16bf16_1k(r0, sb[jt], x2, 0, 0, 0);
                }
                const s16x4v mak = *(const LAS s16x4v*)(mt + CK_MAK + l15 * 32 + q * 8), mrb = *(const LAS s16x4v*)(mt + CK_MRB + l15 * 32 + q * 8);
                const s16x4v mrk = *(const LAS s16x4v*)(mt + CK_MRK + l15 * 32 + q * 8), tt = *(const LAS s16x4v*)(mt + CK_TT + l15 * 32 + q * 8);
                x1 = __builtin_amdgcn_mfma_f32_16x16x16bf16_1k(mak, vb, x1, 0, 0, 0);
                x2 = __builtin_amdgcn_mfma_f32_16x16x16bf16_1k(mrk, vb, x2, 0, 0, 0);
                const f32x4 u = __builtin_amdgcn_mfma_f32_16x16x16bf16_1k(tt, pk4(x1), (f32x4){0.f, 0.f, 0.f, 0.f}, 0, 0, 0);
                const s16x4v ub = pk4(u);
                const f32x4 yv = __builtin_amdgcn_mfma_f32_16x16x16bf16_1k(mrb, ub, x2, 0, 0, 0);
                const bf16x8 uv = (bf16x8){ub[0], ub[1], ub[2], ub[3], vb[0], vb[1], vb[2], vb[3]};
#pragma unroll
                for (int jt = 0; jt < 4; ++jt) {
                    const f32x4 gl = *(const LAS f32x4*)(op + CK_GL + (16 * jt + 4 * q) * 4);
                    const s16x4v b0 = ldtr(op + CK_BT + tro + jt * 32), k0 = ldtr(op + CK_KT + tro + jt * 32);
                    accS[jt] = __builtin_amdgcn_mfma_f32_16x16x32_bf16((bf16x8){b0[0], b0[1], b0[2], b0[3], k0[0], k0[1], k0[2], k0[3]}, uv, accS[jt], 0, 0, 0) * gl;
                }
                LAS float* yt = (LAS float*)(lds + CK_YT0 + (c & 1) * CK_YTB);
#pragma unroll
                for (int r = 0; r < 4; ++r) yt[(4 * q + r) * 16 + l15] = yv[r];
            }
        }
        CK_T1();
        __syncthreads();
    }
#ifdef CK_TIME
    if (blockIdx.x == 0 && l == 0 && lane == 0) { unsigned long long* tw = (unsigned long long*)(a->ws + WS_CTL) + 24000; tw[wid] = tb_; if (wid == 0) tw[8] = __builtin_readcyclecounter() - tstart_; }
#endif
#undef CK_LOAD
#undef CK_OPSTAGE
}

constexpr int WP_SUB = 4 * 2304 + 1280;
constexpr int CW_WPFLAG = 65536;
constexpr int CW_YFLAG = 72000;
__device__ __forceinline__ void ST2W(bf16_t* p, unsigned v) { asm volatile("global_store_short %0, %1, off sc1\n\ts_nop 1" :: "v"(p), "v"(v) : "memory"); }
__device__ __forceinline__ void phase_wkvprep(ArgsP a, int l, LAS unsigned char* lds, int first, int stride) {
    a = args_ptr(); first = __builtin_amdgcn_readfirstlane(first); stride = __builtin_amdgcn_readfirstlane(stride); asm volatile("" : "+s"(first), "+s"(stride));
    const int tid = ltid(), lane = tid & 63, wid = __builtin_amdgcn_readfirstlane(tid >> 6), sub = tid >> 8, ht = tid & 255, t_h = ht >> 4, jg = ht & 15, q = lane >> 4, l15 = lane & 15;
    bf16_t* RKV = (bf16_t*)(a->ws + A_RKV); bf16_t* EG = (bf16_t*)(a->ws + A_LW); bf16_t* ICLR = (bf16_t*)(a->ws + A_ICLR); float* SCAL = (float*)(a->ws + WS_SCAL);
    const bf16_t* HALO = (const bf16_t*)((const unsigned char*)a->out + DO_HALO); unsigned char* MTR = (unsigned char*)a->out + DO_MTREC;
    const float* mu = a->in[I_MU] + (size_t)l * 1792;
    struct WpIn { u32x2 gr, gk, gv, pr, pk, pv, gic, ge, gex, gel; };
    WpIn SA[4], SB[4];
    auto trip_of = [](int q_) { return (q_ & 31) * 32 + (q_ >> 5); };
    auto load1 = [&](WpIn& R1, int tr, int ps) { { const int idx_ = 8 * tr + 2 * ps + sub, bh_ = idx_ >> 8, c_ = idx_ & 255, ch_ = (bh_ & 7) * 64 + 4 * jg, t_ = c_ * 16 + t_h; const size_t row_ = (size_t)(bh_ >> 3) * SEQ + t_; const u32x2 z2_ = (u32x2){0u, 0u};
            R1.gr = *(const u32x2*)(RKV + row_ * 1536 + ch_); R1.gk = *(const u32x2*)(RKV + row_ * 1536 + 512 + ch_); R1.gv = *(const u32x2*)(RKV + row_ * 1536 + 1024 + ch_);
            R1.pr = z2_; R1.pk = z2_; R1.pv = z2_;
            if (t_h) { R1.pr = *(const u32x2*)(RKV + (row_ - 1) * 1536 + ch_); R1.pk = *(const u32x2*)(RKV + (row_ - 1) * 1536 + 512 + ch_); R1.pv = *(const u32x2*)(RKV + (row_ - 1) * 1536 + 1024 + ch_); }
            else if (t_) { const bf16_t* hp_ = HALO + ((row_ >> 4) - 1) * 1536; R1.pr = *(const u32x2*)(hp_ + ch_); R1.pk = *(const u32x2*)(hp_ + 512 + ch_); R1.pv = *(const u32x2*)(hp_ + 1024 + ch_); }
            R1.gic = *(const u32x2*)(ICLR + row_ * 512 + ch_); R1.ge = *(const u32x2*)(EG + row_ * 512 + ch_); R1.gex = *(const u32x2*)(EG + (row_ - (t_h ? 1 : 0)) * 512 + ch_); R1.gel = *(const u32x2*)(EG + (row_ - t_h + 15) * 512 + ch_); }
    };
    auto loadt = [&](WpIn (&R)[4], int tr, int half_) {
        if (half_ != 1) { load1(R[0], tr, 0); load1(R[1], tr, 1); }
        if (half_ != 0) { load1(R[2], tr, 2); load1(R[3], tr, 3); }
    };
    auto body = [&](WpIn (&R)[4], WpIn (&N)[4], int tr, int trn) {
        u32x2 oa[4], orr[4], ob[4], ok[4], ov[4], ogl[4]; float scv[4];
#pragma unroll
        for (int ps = 0; ps < 4; ++ps) {
            const int idx = 8 * tr + 2 * ps + sub, ch = ((idx >> 8) & 7) * 64 + 4 * jg;
            const f32x4 mu_r = *(const f32x4*)(mu + ch), mu_k = *(const f32x4*)(mu + 512 + ch), mu_v = *(const f32x4*)(mu + 1024 + ch);
            const f32x4 kk_c = *(const f32x4*)(a->in[I_KK] + l * 512 + ch), ka_c = *(const f32x4*)(a->in[I_KA] + l * 512 + ch), rk_c = *(const f32x4*)(a->in[I_RK] + l * 512 + ch);
            const f32x4 r2 = up4(R[ps].gr), k2 = up4(R[ps].gk), v2 = up4(R[ps].gv);
            const f32x4 r = r2 + (up4(R[ps].pr) - r2) * mu_r, k = k2 + (up4(R[ps].pk) - k2) * mu_k, v = v2 + (up4(R[ps].pv) - v2) * mu_v, ic = up4(R[ps].gic);
            const f32x4 eG = up4(R[ps].ge);
            f32x4 eGx = up4(R[ps].gex); if (t_h == 0) eGx = (f32x4){1.f, 1.f, 1.f, 1.f};
            f32x4 enG;
#pragma unroll
            for (int e = 0; e < 4; ++e) enG[e] = __builtin_amdgcn_rcpf(eG[e]);
            f32x4 kk = k * kk_c; const float ssum = rr16(dot4(kk, kk));
            kk = kk * rsqrtf(ssum + 1e-12f);
            const f32x4 kp = k * (1.0f + (ic - 1.0f) * ka_c), bb = kk * ic;
            scv[ps] = rr16(dot4(r * kp, rk_c));
            oa[ps] = dn4(-(kk * eGx)); orr[ps] = dn4(r * eG); ob[ps] = dn4(bb * enG); ok[ps] = dn4(kp * enG); ov[ps] = dn4(v); ogl[ps] = R[ps].gel;
            asm volatile("" ::: "memory");
        }
        __syncthreads();
        loadt(N, trn >= 0 ? trn : tr, 0);
#pragma unroll
        for (int ps = 0; ps < 4; ++ps) {
            const int idx = 8 * tr + 2 * ps + sub, bh = idx >> 8, c = idx & 255, b = bh >> 3, h = bh & 7, ch = h * 64 + 4 * jg;
            const size_t row = (size_t)b * SEQ + c * 16 + t_h;
            LAS unsigned char* op = lds + (2 * ps + sub) * WP_SUB;
            *(LAS u32x2*)(op + CK_AT + t_h * CK_ROW + jg * 8) = oa[ps]; *(LAS u32x2*)(op + CK_RT + t_h * CK_ROW + jg * 8) = orr[ps];
            *(LAS u32x2*)(op + CK_BT + t_h * CK_ROW + jg * 8) = ob[ps]; *(LAS u32x2*)(op + CK_KT + t_h * CK_ROW + jg * 8) = ok[ps];
            pg8::ST8W(RKV + row * 1536 + ch, oa[ps]); pg8::ST8W(RKV + row * 1536 + 512 + ch, orr[ps]); pg8::ST8W(RKV + row * 1536 + 1024 + ch, ov[ps]);
            pg8::ST8W(EG + row * 512 + ch, ob[ps]); pg8::ST8W(ICLR + row * 512 + ch, ok[ps]);
            if (jg == 0) __hip_atomic_store(SCAL + row * 8 + h, scv[ps], __ATOMIC_RELAXED, __HIP_MEMORY_SCOPE_AGENT);
            if (t_h == 0) { const f32x4 eGL = up4(ogl[ps]); pg8::ST16W((bf16_t*)(MTR + (size_t)idx * MTREC_B + 2048 + jg * 16), __builtin_bit_cast(u32x4, eGL)); }
        }
        __syncthreads();
    };
    unsigned* wpflag = (unsigned*)(a->ws + WS_CTL) + CW_WPFLAG + l * 1024;
    auto stepB = [&](int tr) {
        {
            const int idx = 8 * tr + wid;
            const LAS unsigned char* op = lds + wid * WP_SUB; LAS unsigned char* mt = lds + wid * WP_SUB + 4 * 2304;
            const int ro = l15 * CK_ROW + q * 16;
            const bf16x8 at0 = *(const LAS bf16x8*)(op + CK_AT + ro), at1 = *(const LAS bf16x8*)(op + CK_AT + ro + 64), rt0 = *(const LAS bf16x8*)(op + CK_RT + ro), rt1 = *(const LAS bf16x8*)(op + CK_RT + ro + 64);
            const bf16x8 bt0 = *(const LAS bf16x8*)(op + CK_BT + ro), bt1 = *(const LAS bf16x8*)(op + CK_BT + ro + 64), kt0 = *(const LAS bf16x8*)(op + CK_KT + ro), kt1 = *(const LAS bf16x8*)(op + CK_KT + ro + 64);
            const f32x4 z = (f32x4){0.f, 0.f, 0.f, 0.f};
            f32x4 mab = __builtin_amdgcn_mfma_f32_16x16x32_bf16(at0, bt0, z, 0, 0, 0); mab = __builtin_amdgcn_mfma_f32_16x16x32_bf16(at1, bt1, mab, 0, 0, 0);
            f32x4 mak = __builtin_amdgcn_mfma_f32_16x16x32_bf16(at0, kt0, z, 0, 0, 0); mak = __builtin_amdgcn_mfma_f32_16x16x32_bf16(at1, kt1, mak, 0, 0, 0);
            f32x4 mrb = __builtin_amdgcn_mfma_f32_16x16x32_bf16(rt0, bt0, z, 0, 0, 0); mrb = __builtin_amdgcn_mfma_f32_16x16x32_bf16(rt1, bt1, mrb, 0, 0, 0);
            f32x4 mrk = __builtin_amdgcn_mfma_f32_16x16x32_bf16(rt0, kt0, z, 0, 0, 0); mrk = __builtin_amdgcn_mfma_f32_16x16x32_bf16(rt1, kt1, mrk, 0, 0, 0);
            bf16_t* rec = (bf16_t*)(MTR + (size_t)idx * MTREC_B);
            LAS bf16_t* stg = (LAS bf16_t*)(lds + wid * WP_SUB);
            asm volatile("s_waitcnt lgkmcnt(0)" ::: "memory");
#pragma unroll
            for (int rr = 0; rr < 4; ++rr) { const int t_ = 4 * q + rr; const bool lo_ = l15 < t_, le_ = l15 <= t_;
                *(LAS float*)(mt + t_ * 80 + l15 * 4) = lo_ ? mab[rr] : 0.f;
                stg[t_ * 16 + l15] = (bf16_t)f2bf(lo_ ? mak[rr] : 0.f);
                stg[256 + t_ * 16 + l15] = (bf16_t)f2bf(le_ ? mrb[rr] : 0.f);
                stg[512 + t_ * 16 + l15] = (bf16_t)f2bf(le_ ? mrk[rr] : 0.f); }
            asm volatile("s_waitcnt lgkmcnt(0)" ::: "memory");
            float x[16];
#define WP_MLD(t_) f32x4 m_##t_[4]; _Pragma("unroll") for (int s4 = 0; s4 < (t_); s4 += 4) m_##t_[s4 >> 2] = *(const LAS f32x4*)(mt + (t_) * 80 + s4 * 4)
#define WP_TROW(t_) do { float acc_ = (l15 == (t_)) ? 1.f : 0.f; \
                _Pragma("unroll") for (int s4 = 0; s4 < (t_); s4 += 4) { _Pragma("unroll") for (int e = 0; e < 4; ++e) if (s4 + e < (t_)) acc_ += m_##t_[s4 >> 2][e] * x[s4 + e]; } \
                x[t_] = acc_; } while (0)
            x[0] = (l15 == 0) ? 1.f : 0.f;
            { WP_MLD(1); WP_MLD(2); WP_MLD(3); WP_MLD(4); WP_MLD(5); WP_MLD(6); WP_MLD(7); WP_TROW(1); WP_TROW(2); WP_TROW(3); WP_TROW(4); WP_TROW(5); WP_TROW(6); WP_TROW(7); }
            { WP_MLD(8); WP_MLD(9); WP_MLD(10); WP_MLD(11); WP_TROW(8); WP_TROW(9); WP_TROW(10); WP_TROW(11); }
            { WP_MLD(12); WP_MLD(13); WP_MLD(14); WP_MLD(15); WP_TROW(12); WP_TROW(13); WP_TROW(14); WP_TROW(15); }
#undef WP_TROW
#undef WP_MLD
            if (q == 0) {
#pragma unroll
                for (int t_ = 0; t_ < 16; ++t_) stg[768 + t_ * 16 + l15] = (bf16_t)f2bf(x[t_]); }
            asm volatile("s_waitcnt lgkmcnt(0)" ::: "memory");
            pg8::ST16W(rec + lane * 8, *(const LAS u32x4*)((const LAS unsigned char*)stg + lane * 16));
            pg8::ST16W(rec + 512 + lane * 8, *(const LAS u32x4*)((const LAS unsigned char*)stg + 1024 + lane * 16));
        }
        asm volatile("s_waitcnt vmcnt(0)" ::: "memory");
        __syncthreads();
        if (tid == 0) __hip_atomic_store(wpflag + tr, 1u, __ATOMIC_RELAXED, __HIP_MEMORY_SCOPE_AGENT);
    };
    if (first < 1024) loadt(SA, trip_of(first), 2);
#pragma unroll 1
    for (int qq = first; qq < 1024; qq += 2 * stride) {
        const int q1 = qq + stride, q2 = q1 + stride;
        const int tr0 = trip_of(qq), tr1 = q1 < 1024 ? trip_of(q1) : -1, tr2 = q2 < 1024 ? trip_of(q2) : -1;
        body(SA, SB, tr0, tr1); stepB(tr0);
        if (tr1 < 0) break;
        loadt(SB, tr1, 1);
        body(SB, SA, tr1, tr2); stepB(tr1);
        loadt(SA, tr2 >= 0 ? tr2 : tr1, 1);
    }
}

constexpr int WS_SLOT = 5 * 2048 + 3 * 1024, WS_NSLOT = 8, WS_DEPTH = 7, WS_YT = WS_NSLOT * WS_SLOT;
__device__ __forceinline__ void glds16(const void* gsrc, unsigned lds_dst) { unsigned keep;
    asm volatile("s_mov_b32 %0, m0\n\ts_mov_b32 m0, %2\n\ts_nop 0\n\tglobal_load_lds_dwordx4 %1, off\n\ts_mov_b32 m0, %0" : "=&s"(keep) : "v"(gsrc), "s"(lds_dst) : "memory"); }
__device__ __forceinline__ void scan_unit_stream(ArgsP a, int l, int bh, LAS unsigned char* lds) {
    a = args_ptr();
    const int tid = ltid(), lane = tid & 63, wid = __builtin_amdgcn_readfirstlane(tid >> 6), q = lane >> 4, l15 = lane & 15;
    const int b = bh >> 3, h = bh & 7;
    const unsigned char* RKVb = a->ws + A_RKV; const unsigned char* EGb = a->ws + A_LW; const unsigned char* ICb = a->ws + A_ICLR;
    const unsigned char* MTR = (const unsigned char*)a->out + DO_MTREC + (size_t)bh * 256 * MTREC_B;
    bf16_t* Y = (bf16_t*)(a->ws + A_Y);
    unsigned* yflag = (unsigned*)(a->ws + WS_CTL) + CW_YFLAG + l * 1024 + bh * 32;
    constexpr int NCH = SEQ / 16;
    const unsigned lds0 = (unsigned)(uintptr_t)lds;
    if (wid >= 4) {
        const int w = wid - 4, rw = lane >> 3, c16 = ((lane & 7) ^ rw) * 16;
        const int np = (w == 0) ? 4 : 3;
#define WS_ISSUE(cc) do { const size_t row0_ = (size_t)b * SEQ + (size_t)(cc) * 16; const unsigned slot_ = lds0 + (unsigned)(((cc) % WS_NSLOT) * WS_SLOT); \
            _Pragma("unroll") for (int k_ = 0; k_ < 4; ++k_) { const int p_ = w + 4 * k_; if (p_ < 13) { const void* src_; \
                if (p_ < 10) { const int tl_ = p_ >> 1; const size_t r_ = row0_ + 8 * (p_ & 1) + rw; \
                    src_ = tl_ < 3 ? (const void*)(RKVb + (r_ * 1536 + tl_ * 512 + h * 64) * 2 + c16) : (tl_ == 3 ? (const void*)(EGb + (r_ * 512 + h * 64) * 2 + c16) : (const void*)(ICb + (r_ * 512 + h * 64) * 2 + c16)); } \
                else src_ = (const void*)(MTR + (size_t)(cc) * MTREC_B + (p_ - 10) * 1024 + lane * 16); \
                glds16(src_, (unsigned)__builtin_amdgcn_readfirstlane(slot_ + (unsigned)(p_ < 10 ? (p_ >> 1) * 2048 + (p_ & 1) * 1024 : 10240 + (p_ - 10) * 1024))); } } } while (0)
        unsigned* wpflag = (unsigned*)(a->ws + WS_CTL) + CW_WPFLAG + l * 1024 + bh * 32;
        unsigned* tmo = (unsigned*)(a->ws + WS_CTL) + CW_BAR + XB_TMO;
#define WS_GATE(cc) do { if (((cc) & 7) == 0) { unsigned sp_ = 0; \
            while ((unsigned)__builtin_amdgcn_readfirstlane(__hip_atomic_load(wpflag + ((cc) >> 3), __ATOMIC_RELAXED, __HIP_MEMORY_SCOPE_AGENT)) == 0u) { __builtin_amdgcn_s_sleep(2); \
                if ((++sp_ & 255u) == 0u) { if (xb_ld(tmo)) break; if (sp_ > XB_SPIN_CAP) { atomicAdd(tmo, 1u); break; } } } \
            __builtin_amdgcn_fence(__ATOMIC_ACQUIRE, "agent"); } } while (0)
        WS_GATE(0);
#pragma unroll
        for (int cc = 0; cc < WS_DEPTH; ++cc) WS_ISSUE(cc);
        if (w == 0) asm volatile("s_waitcnt vmcnt(24)" ::: "memory"); else asm volatile("s_waitcnt vmcnt(18)" ::: "memory");
        __syncthreads();
        for (int it = 0; it < NCH; ++it) {
            if (it + WS_DEPTH < NCH) { WS_GATE(it + WS_DEPTH); WS_ISSUE(it + WS_DEPTH); if (w == 0) asm volatile("s_waitcnt vmcnt(24)" ::: "memory"); else asm volatile("s_waitcnt vmcnt(18)" ::: "memory"); }
            else asm volatile("s_waitcnt vmcnt(0)" ::: "memory");
            __syncthreads();
        }
#undef WS_ISSUE
#undef WS_GATE
        (void)np;
    } else {
        f32x4 accS[4];
#pragma unroll
        for (int jt = 0; jt < 4; ++jt) accS[jt] = (f32x4){0.f, 0.f, 0.f, 0.f};
        __syncthreads();
        for (int it = 0; it < NCH; ++it) {
            const LAS unsigned char* op = lds + (it % WS_NSLOT) * WS_SLOT; const LAS unsigned char* mt = op + 10240;
            s16x4v sb[4];
#pragma unroll
            for (int jt = 0; jt < 4; ++jt) sb[jt] = pk4(accS[jt]);
#define WS_SW(row, p8) ((row) * 128 + ((((p8) >> 1) ^ ((row) & 7)) << 4) + ((p8) & 1) * 8)
            const int trow = 4 * q + (l15 >> 2);
            const s16x4v vb = ldtr(op + 4096 + WS_SW(trow, (l15 & 3) + 4 * wid));
            f32x4 x1 = (f32x4){0.f, 0.f, 0.f, 0.f}, x2 = x1;
#pragma unroll
            for (int jt = 0; jt < 4; ++jt) {
                const s16x4v a0 = *(const LAS s16x4v*)(op + 0 + WS_SW(l15, q + 4 * jt)), r0 = *(const LAS s16x4v*)(op + 2048 + WS_SW(l15, q + 4 * jt));
                x1 = __builtin_amdgcn_mfma_f32_16x16x16bf16_1k(a0, sb[jt], x1, 0, 0, 0);
                x2 = __builtin_amdgcn_mfma_f32_16x16x16bf16_1k(r0, sb[jt], x2, 0, 0, 0);
            }
            const s16x4v mak = *(const LAS s16x4v*)(mt + 0 + l15 * 32 + q * 8), mrb = *(const LAS s16x4v*)(mt + 512 + l15 * 32 + q * 8);
            const s16x4v mrk = *(const LAS s16x4v*)(mt + 1024 + l15 * 32 + q * 8), tt = *(const LAS s16x4v*)(mt + 1536 + l15 * 32 + q * 8);
            x1 = __builtin_amdgcn_mfma_f32_16x16x16bf16_1k(mak, vb, x1, 0, 0, 0);
            x2 = __builtin_amdgcn_mfma_f32_16x16x16bf16_1k(mrk, vb, x2, 0, 0, 0);
            const f32x4 u = __builtin_amdgcn_mfma_f32_16x16x16bf16_1k(tt, pk4(x1), (f32x4){0.f, 0.f, 0.f, 0.f}, 0, 0, 0);
            const s16x4v ub = pk4(u);
            const f32x4 yv = __builtin_amdgcn_mfma_f32_16x16x16bf16_1k(mrb, ub, x2, 0, 0, 0);
            const bf16x8 uv = (bf16x8){ub[0], ub[1], ub[2], ub[3], vb[0], vb[1], vb[2], vb[3]};
#pragma unroll
            for (int jt = 0; jt < 4; ++jt) {
                const f32x4 gl = *(const LAS f32x4*)(mt + 2048 + (16 * jt + 4 * q) * 4);
                const s16x4v b0 = ldtr(op + 6144 + WS_SW(trow, (l15 & 3) + 4 * jt)), k0 = ldtr(op + 8192 + WS_SW(trow, (l15 & 3) + 4 * jt));
                accS[jt] = __builtin_amdgcn_mfma_f32_16x16x32_bf16((bf16x8){b0[0], b0[1], b0[2], b0[3], k0[0], k0[1], k0[2], k0[3]}, uv, accS[jt], 0, 0, 0) * gl;
            }
            LAS float* yt = (LAS float*)(lds + WS_YT + wid * 1024);
#pragma unroll
            for (int rr = 0; rr < 4; ++rr) yt[(4 * q + rr) * 16 + l15] = yv[rr];
            asm volatile("s_waitcnt lgkmcnt(0)" ::: "memory");
            { const int t_ = lane >> 2, ip = (lane & 3) * 4; const f32x4 yr = *(const LAS f32x4*)(yt + t_ * 16 + ip);
              pg8::ST8W(Y + ((size_t)b * SEQ + it * 16 + t_) * 512 + h * 64 + 16 * wid + ip, dn4(yr)); }
            const bool pub_ = ((it & 7) == 7) && it >= 15;
            if (pub_) asm volatile("s_waitcnt vmcnt(8)" ::: "memory");
            __syncthreads();
            if (pub_ && tid == 0) __hip_atomic_store(yflag + ((it - 15) >> 3), 1u, __ATOMIC_RELAXED, __HIP_MEMORY_SCOPE_AGENT);
        }
        asm volatile("s_waitcnt vmcnt(0)" ::: "memory");
#undef WS_SW
    }
    __syncthreads();
    if (tid == 0) __hip_atomic_store(yflag + 31, 1u, __ATOMIC_RELAXED, __HIP_MEMORY_SCOPE_AGENT);
}

__device__ __forceinline__ int crow(int r, int hi) { return (r & 3) + 8 * (r >> 2) + 4 * hi; }
constexpr int AT_KROW = 208, AT_VROW = 136, AT_KBUF = 64 * AT_KROW, AT_VBUF = 64 * AT_VROW, AT_V0 = 2 * AT_KBUF;
__device__ __forceinline__ void attn_unit(ArgsP a, int bh, int qb, LAS unsigned char* lds, size_t o_off = A_QN) {
    a = args_ptr();
    const int tid = ltid(), lane = tid & 63, wid = tid >> 6, r32 = lane & 31, hi = lane >> 5;
    const int b = bh >> 3, h = bh & 7, q0 = qb * 256, qw0 = q0 + wid * 32;
    const size_t rowb = (size_t)b * SEQ;
    const bf16_t* Qn = (const bf16_t*)(a->ws + A_QN); const bf16_t* Qp = (const bf16_t*)(a->ws + A_QP); const bf16_t* Kn = (const bf16_t*)(a->ws + A_KN);
    const bf16_t* KPE = (const bf16_t*)(a->ws + A_KPE); const bf16_t* Vt = (const bf16_t*)(a->ws + A_VT); bf16_t* O = (bf16_t*)(a->ws + o_off);
    bf16x8 qf[6];
    { const size_t qrow = rowb + qw0 + r32;
#pragma unroll
      for (int ds = 0; ds < 4; ++ds) qf[ds] = *(const bf16x8*)(Qn + qrow * 512 + h * 64 + ds * 16 + hi * 8);
#pragma unroll
      for (int ds = 0; ds < 2; ++ds) qf[4 + ds] = *(const bf16x8*)(Qp + qrow * 256 + h * 32 + ds * 16 + hi * 8); }
    const int NT = 4 * qb + 4;
    const bf16_t* ksrc = Kn + (rowb + (tid >> 3)) * 512 + h * 64 + (tid & 7) * 8;
    const bf16_t* psrc = KPE + (rowb + ((tid & 255) >> 2)) * 32 + (tid & 3) * 8;
    const bf16_t* vsrc = Vt + ((size_t)(bh * 64 + (tid >> 3)) << 12) + (tid & 7) * 8;
    const int kdst = (tid >> 3) * AT_KROW + (tid & 7) * 16, pdst = ((tid & 255) >> 2) * AT_KROW + 128 + (tid & 3) * 16, vdst = AT_V0 + (tid >> 3) * AT_VROW + (tid & 7) * 16;
    u32x4 rk0, rp0 = (u32x4){0u, 0u, 0u, 0u}, rv0, rk1, rp1 = rp0, rv1;
#define AT_LOAD(S, tt) do { rk##S = *(const u32x4*)(ksrc + (size_t)(tt) * 64 * 512); if (tid < 256) rp##S = *(const u32x4*)(psrc + (size_t)(tt) * 64 * 32); rv##S = *(const u32x4*)(vsrc + (tt) * 64); } while (0)
#define AT_WRITE(S, p) do { *(LAS u32x4*)(lds + (p) * AT_KBUF + kdst) = rk##S; if (tid < 256) *(LAS u32x4*)(lds + (p) * AT_KBUF + pdst) = rp##S; \
        *(LAS u32x2*)(lds + (p) * AT_VBUF + vdst) = (u32x2){rv##S.x, rv##S.y}; *(LAS u32x2*)(lds + (p) * AT_VBUF + vdst + 8) = (u32x2){rv##S.z, rv##S.w}; } while (0)
    AT_LOAD(0, 0); AT_WRITE(0, 0); AT_LOAD(0, 1);
    __syncthreads();
    float mrun = -INFINITY, lrun = 0.f;
    f32x16 o0, o1;
#pragma unroll
    for (int r = 0; r < 16; ++r) { o0[r] = 0.f; o1[r] = 0.f; }
    for (int t2 = 0; t2 < NT; t2 += 2)
#pragma unroll
    for (int tp = 0; tp < 2; ++tp) {
        const int t = t2 + tp, cur = tp;
        if (t + 2 < NT) { if (tp == 0) AT_LOAD(1, t + 2); else AT_LOAD(0, t + 2); }
        if (64 * t <= qw0 + 31) {
            const LAS unsigned char* Kb = lds + cur * AT_KBUF + r32 * AT_KROW + hi * 16;
            f32x16 p0, p1;
#pragma unroll
            for (int r = 0; r < 16; ++r) { p0[r] = 0.f; p1[r] = 0.f; }
#pragma unroll
            for (int ds = 0; ds < 6; ++ds) {
                const bf16x8 k0 = *(const LAS bf16x8*)(Kb + ds * 32), k1 = *(const LAS bf16x8*)(Kb + 32 * AT_KROW + ds * 32);
                p0 = __builtin_amdgcn_mfma_f32_32x32x16_bf16(k0, qf[ds], p0, 0, 0, 0);
                p1 = __builtin_amdgcn_mfma_f32_32x32x16_bf16(k1, qf[ds], p1, 0, 0, 0);
            }
            if (64 * t + 63 > qw0) {
                const int q = qw0 + r32;
#pragma unroll
                for (int r = 0; r < 16; ++r) { const int kv = 64 * t + crow(r, hi); if (kv > q) p0[r] = -INFINITY; if (kv + 32 > q) p1[r] = -INFINITY; }
            }
            float mx = fmaxf(p0[0], p1[0]);
#pragma unroll
            for (int r = 1; r < 16; ++r) mx = fmaxf(mx, fmaxf(p0[r], p1[r]));
            mx = fmaxf(mx, shx(mx, 32));
            const float mnew = fmaxf(mrun, mx), alpha = __builtin_amdgcn_exp2f(mrun - mnew);
            mrun = mnew;
            float ps = 0.f;
#pragma unroll
            for (int r = 0; r < 16; ++r) { p0[r] = __builtin_amdgcn_exp2f(p0[r] - mnew); p1[r] = __builtin_amdgcn_exp2f(p1[r] - mnew); ps += p0[r] + p1[r]; }
            lrun = lrun * alpha + ps;
#pragma unroll
            for (int r = 0; r < 16; ++r) { o0[r] *= alpha; o1[r] *= alpha; }
            bf16x8 pf[4];
#pragma unroll
            for (int ks = 0; ks < 4; ++ks) {
                u32x4 w;
                if (ks < 2) { w.x = pk2(p0[8 * ks + 0], p0[8 * ks + 1]); w.y = pk2(p0[8 * ks + 2], p0[8 * ks + 3]); w.z = pk2(p0[8 * ks + 4], p0[8 * ks + 5]); w.w = pk2(p0[8 * ks + 6], p0[8 * ks + 7]); }
                else { const int k2 = ks - 2; w.x = pk2(p1[8 * k2 + 0], p1[8 * k2 + 1]); w.y = pk2(p1[8 * k2 + 2], p1[8 * k2 + 3]); w.z = pk2(p1[8 * k2 + 4], p1[8 * k2 + 5]); w.w = pk2(p1[8 * k2 + 6], p1[8 * k2 + 7]); }
                pf[ks] = __builtin_bit_cast(bf16x8, w);
            }
            const LAS unsigned char* Vb = lds + AT_V0 + cur * AT_VBUF + r32 * AT_VROW + hi * 8;
#pragma unroll
            for (int ks = 0; ks < 4; ++ks) {
                const s16x4 a0 = *(const LAS s16x4*)(Vb + ks * 32), a1 = *(const LAS s16x4*)(Vb + ks * 32 + 16);
                const s16x4 c0 = *(const LAS s16x4*)(Vb + 32 * AT_VROW + ks * 32), c1 = *(const LAS s16x4*)(Vb + 32 * AT_VROW + ks * 32 + 16);
                const bf16x8 vf0 = (bf16x8){a0[0], a0[1], a0[2], a0[3], a1[0], a1[1], a1[2], a1[3]}, vf1 = (bf16x8){c0[0], c0[1], c0[2], c0[3], c1[0], c1[1], c1[2], c1[3]};
                o0 = __builtin_amdgcn_mfma_f32_32x32x16_bf16(vf0, pf[ks], o0, 0, 0, 0);
                o1 = __builtin_amdgcn_mfma_f32_32x32x16_bf16(vf1, pf[ks], o1, 0, 0, 0);
            }
        }
        if (t + 1 < NT) { if (tp == 0) AT_WRITE(0, 1); else AT_WRITE(1, 0); }
        __syncthreads();
    }
#undef AT_WRITE
#undef AT_LOAD
    const float ltot = lrun + shx(lrun, 32), inv = 1.0f / ltot;
    bf16_t* orow = O + (rowb + qw0 + r32) * 512 + h * 64 + 4 * hi;
#pragma unroll
    for (int g = 0; g < 4; ++g) {
        *(u32x2*)(orow + 8 * g) = (u32x2){pk2(o0[4 * g] * inv, o0[4 * g + 1] * inv), pk2(o0[4 * g + 2] * inv, o0[4 * g + 3] * inv)};
        *(u32x2*)(orow + 32 + 8 * g) = (u32x2){pk2(o1[4 * g] * inv, o1[4 * g + 1] * inv), pk2(o1[4 * g + 2] * inv, o1[4 * g + 3] * inv)};
    }
}


__device__ __forceinline__ void attn_unit_naive(ArgsP a, int bh, int qb, LAS unsigned char* lds) {
    a = args_ptr();
    const int tid = vtid(), lane = tid & 63, wid = tid >> 6;
    const int b = bh >> 3, h = bh & 7; const size_t rowb = (size_t)b * SEQ;
    const bf16_t* Qn = (const bf16_t*)(a->ws + A_QN); const bf16_t* Qp = (const bf16_t*)(a->ws + A_QP); const bf16_t* Kn = (const bf16_t*)(a->ws + A_KN);
    const bf16_t* KPE = (const bf16_t*)(a->ws + A_KPE); const bf16_t* Vt = (const bf16_t*)(a->ws + A_VT); bf16_t* O = (bf16_t*)(a->ws + A_QN);
    LAS float* sc = (LAS float*)(lds + wid * 16384);
    for (int i = 0; i < 32; ++i) {
        const int q = qb * 256 + wid * 32 + i; const size_t qrow = rowb + q;
        float mx = -INFINITY;
        for (int k0 = 0; k0 <= q; k0 += 64) {
            const int key = k0 + lane; float sv = -INFINITY;
            if (key <= q) { sv = 0.f;
                for (int d = 0; d < 64; ++d) sv += bf2f(Qn[qrow * 512 + h * 64 + d]) * bf2f(Kn[(rowb + key) * 512 + h * 64 + d]);
                for (int d = 0; d < 32; ++d) sv += bf2f(Qp[qrow * 256 + h * 32 + d]) * bf2f(KPE[(rowb + key) * 32 + d]); }
            sc[key] = sv; mx = fmaxf(mx, sv);
        }
        for (int o = 1; o < 64; o <<= 1) mx = fmaxf(mx, shx(mx, o));
        float sum = 0.f;
        for (int k0 = 0; k0 <= q; k0 += 64) { const int key = k0 + lane; const float p = key <= q ? exp2f(sc[key] - mx) : 0.f; sc[key] = p; sum += p; }
        for (int o = 1; o < 64; o <<= 1) sum += shx(sum, o);
        asm volatile("s_waitcnt lgkmcnt(0)" ::: "memory");
        float acc = 0.f;
        const bf16_t* vp = Vt + ((size_t)(bh * 64 + lane) << 12);
        for (int key = 0; key <= q; ++key) acc += sc[key] * bf2f(vp[key]);
        asm volatile("s_waitcnt lgkmcnt(0)" ::: "memory");
        O[qrow * 512 + h * 64 + lane] = (bf16_t)f2bf(acc / sum);
    }
}
__device__ __forceinline__ void ya_item(ArgsP a, int l, int bh, int gq) {
    a = args_ptr();
    const int tid = ltid();
    if (tid < 64) {
        unsigned* fl = (unsigned*)(a->ws + WS_CTL) + CW_YFLAG + l * 1024 + bh * 32 + gq * 4; unsigned* tmo = (unsigned*)(a->ws + WS_CTL) + CW_BAR + XB_TMO; unsigned sp_ = 0;
        for (;;) { const unsigned f_ = __hip_atomic_load(fl, __ATOMIC_RELAXED, __HIP_MEMORY_SCOPE_AGENT) & __hip_atomic_load(fl + 1, __ATOMIC_RELAXED, __HIP_MEMORY_SCOPE_AGENT)
                                      & __hip_atomic_load(fl + 2, __ATOMIC_RELAXED, __HIP_MEMORY_SCOPE_AGENT) & __hip_atomic_load(fl + 3, __ATOMIC_RELAXED, __HIP_MEMORY_SCOPE_AGENT);
            if ((unsigned)__builtin_amdgcn_readfirstlane(f_) != 0u) break;
            __builtin_amdgcn_s_sleep(2);
            if ((++sp_ & 255u) == 0u) { if (xb_ld(tmo)) break; if (sp_ > XB_SPIN_CAP) { atomicAdd(tmo, 1u); break; } } }
        __builtin_amdgcn_fence(__ATOMIC_ACQUIRE, "agent");
    }
    __syncthreads();
    const int h = bh & 7, c = h * 64 + (tid & 7) * 8; const size_t r0 = (size_t)(bh >> 3) * SEQ + (size_t)gq * 512 + (tid >> 3);
    const bf16_t* Y = (const bf16_t*)(a->ws + A_Y); const bf16_t* RKV = (const bf16_t*)(a->ws + A_RKV); const bf16_t* GATE = (const bf16_t*)(a->ws + A_GATE);
    const float* SCAL = (const float*)(a->ws + WS_SCAL); bf16_t* YA = (bf16_t*)(a->ws + A_YA);
    const float* lw = a->in[I_LNXW] + l * 512 + c; const float* lb = a->in[I_LNXB] + l * 512 + c;
    const f32x4 w0 = *(const f32x4*)lw, w1 = *(const f32x4*)(lw + 4), b0 = *(const f32x4*)lb, b1 = *(const f32x4*)(lb + 4);
    u32x4 yu[8], vu[8], gu[8]; float sc[8];
#pragma unroll
    for (int k = 0; k < 8; ++k) { const size_t row = r0 + 64 * k;
        yu[k] = *(const u32x4*)(Y + row * 512 + c); vu[k] = *(const u32x4*)(RKV + row * 1536 + 1024 + c);
        gu[k] = *(const u32x4*)(GATE + row * 512 + c); sc[k] = SCAL[row * 8 + h]; }
#pragma unroll
    for (int k = 0; k < 8; ++k) {
        const f32x4 ya0 = up4((u32x2){yu[k].x, yu[k].y}), ya1 = up4((u32x2){yu[k].z, yu[k].w});
        float sm = ((ya0.x + ya0.y) + (ya0.z + ya0.w)) + ((ya1.x + ya1.y) + (ya1.z + ya1.w));
        sm += shx(sm, 1); sm += shx(sm, 2); sm += shx(sm, 4);
        const float mean = sm * (1.0f / 64.0f);
        const f32x4 d0 = ya0 - mean, d1 = ya1 - mean;
        float qv = dot4(d0, d0) + dot4(d1, d1);
        qv += shx(qv, 1); qv += shx(qv, 2); qv += shx(qv, 4);
        const float rstd = rsqrtf(qv * (1.0f / 64.0f) + LNX_EPS);
        const f32x4 vv0 = up4((u32x2){vu[k].x, vu[k].y}), vv1 = up4((u32x2){vu[k].z, vu[k].w});
        const f32x4 g0 = up4((u32x2){gu[k].x, gu[k].y}), g1 = up4((u32x2){gu[k].z, gu[k].w});
        const f32x4 o0 = (d0 * rstd * w0 + b0 + vv0 * sc[k]) * g0, o1 = (d1 * rstd * w1 + b1 + vv1 * sc[k]) * g1;
        const u32x2 p0 = dn4(o0), p1 = dn4(o1);
        *(u32x4*)(YA + (r0 + 64 * k) * 512 + c) = (u32x4){p0.x, p0.y, p1.x, p1.y};
    }
}
#if NAIVE_ATTN
#define ATTN_UNIT attn_unit_naive
#else
#define ATTN_UNIT attn_unit
#endif
__device__ __forceinline__ void phase_ya(ArgsP a, int l) {
    a = args_ptr();
    const unsigned gt = blockIdx.x * NTHREADS + ltid(), NGT = gridDim.x * NTHREADS;
    const bf16_t* Y = (const bf16_t*)(a->ws + A_Y); const bf16_t* RKV = (const bf16_t*)(a->ws + A_RKV); const bf16_t* GATE = (const bf16_t*)(a->ws + A_GATE);
    const float* SCAL = (const float*)(a->ws + WS_SCAL); bf16_t* YA = (bf16_t*)(a->ws + A_YA);
    const int c = (gt & 63) * 8, h = c >> 6;
    const float* muv = a->in[I_MU] + (size_t)l * 1792 + 1024 + c; const float* lw = a->in[I_LNXW] + l * 512 + c; const float* lb = a->in[I_LNXB] + l * 512 + c;
    const f32x4 m0 = *(const f32x4*)muv, m1 = *(const f32x4*)(muv + 4), w0 = *(const f32x4*)lw, w1 = *(const f32x4*)(lw + 4), b0 = *(const f32x4*)lb, b1 = *(const f32x4*)(lb + 4);
    for (unsigned i = gt; i < (unsigned)M * 64; i += 2 * NGT) {
        u32x4 yu[2], v2u[2], v1u[2], gu[2]; float sc[2]; unsigned rowv[2];
#pragma unroll
        for (int k = 0; k < 2; ++k) { const unsigned row = (i + k * NGT) >> 6; const int t = row & 4095; rowv[k] = row;
            yu[k] = *(const u32x4*)(Y + (size_t)row * 512 + c); v2u[k] = *(const u32x4*)(RKV + (size_t)row * 1536 + 1024 + c);
            v1u[k] = WKV_STREAM ? v2u[k] : (t ? *(const u32x4*)(RKV + (size_t)(row - 1) * 1536 + 1024 + c) : (u32x4){0u, 0u, 0u, 0u});
            gu[k] = *(const u32x4*)(GATE + (size_t)row * 512 + c); sc[k] = SCAL[(size_t)row * 8 + h]; }
#pragma unroll
        for (int k = 0; k < 2; ++k) {
            const f32x4 ya0 = up4((u32x2){yu[k].x, yu[k].y}), ya1 = up4((u32x2){yu[k].z, yu[k].w});
            float sm = ((ya0.x + ya0.y) + (ya0.z + ya0.w)) + ((ya1.x + ya1.y) + (ya1.z + ya1.w));
            sm += shx(sm, 1); sm += shx(sm, 2); sm += shx(sm, 4);
            const float mean = sm * (1.0f / 64.0f);
            const f32x4 d0 = ya0 - mean, d1 = ya1 - mean;
            float qv = dot4(d0, d0) + dot4(d1, d1);
            qv += shx(qv, 1); qv += shx(qv, 2); qv += shx(qv, 4);
            const float rstd = rsqrtf(qv * (1.0f / 64.0f) + LNX_EPS);
            const f32x4 v20 = up4((u32x2){v2u[k].x, v2u[k].y}), v21 = up4((u32x2){v2u[k].z, v2u[k].w}), v10 = up4((u32x2){v1u[k].x, v1u[k].y}), v11 = up4((u32x2){v1u[k].z, v1u[k].w});
            const f32x4 vv0 = v20 + (v10 - v20) * m0, vv1 = v21 + (v11 - v21) * m1;
            const f32x4 g0 = up4((u32x2){gu[k].x, gu[k].y}), g1 = up4((u32x2){gu[k].z, gu[k].w});
            const f32x4 o0 = (d0 * rstd * w0 + b0 + vv0 * sc[k]) * g0, o1 = (d1 * rstd * w1 + b1 + vv1 * sc[k]) * g1;
            const u32x2 p0 = dn4(o0), p1 = dn4(o1);
            *(u32x4*)(YA + (size_t)rowv[k] * 512 + c) = (u32x4){p0.x, p0.y, p1.x, p1.y};
        }
    }
}


__device__ __forceinline__ void phase_gconv(ArgsP a, int l) {
    a = args_ptr();
    const unsigned gt = blockIdx.x * NTHREADS + ltid();
    constexpr unsigned NCHK = FF / 8, NSEG = 372, SEGR = (M + NSEG - 1) / NSEG;
    if (gt >= NCHK * NSEG) return;
    const unsigned chk = gt % NCHK, seg = gt / NCHK; const int c = chk * 8;
    const bf16_t* UG = (const bf16_t*)(a->ws + A_UG); bf16_t* GC = (bf16_t*)(a->ws + A_ACT);
    const float* cw = a->in[I_CONVW] + (size_t)l * 3 * FF + c; const float* cb = a->in[I_CONVB] + (size_t)l * FF + c;
    const f32x4 w0a = *(const f32x4*)cw, w0b = *(const f32x4*)(cw + 4), w1a = *(const f32x4*)(cw + FF), w1b = *(const f32x4*)(cw + FF + 4), w2a = *(const f32x4*)(cw + 2 * FF), w2b = *(const f32x4*)(cw + 2 * FF + 4);
    const f32x4 ba = *(const f32x4*)cb, bb = *(const f32x4*)(cb + 4);
    const unsigned r0 = seg * SEGR, r1 = (r0 + SEGR < (unsigned)M) ? r0 + SEGR : (unsigned)M;
    const u32x4 z = (u32x4){0u, 0u, 0u, 0u};
    u32x4 p1 = ((r0 & 4095u) >= 1u) ? *(const u32x4*)(UG + (size_t)(r0 - 1) * FF + c) : z, p2 = ((r0 & 4095u) >= 2u) ? *(const u32x4*)(UG + (size_t)(r0 - 2) * FF + c) : z;
    u32x4 nx = *(const u32x4*)(UG + (size_t)r0 * FF + c);
    for (unsigned r = r0; r < r1; ++r) {
        const u32x4 cur = nx;
        if (r + 1 < r1) nx = *(const u32x4*)(UG + (size_t)(r + 1) * FF + c);
        if ((r & 4095u) == 0u) { p1 = z; p2 = z; }
        const f32x4 x2a = up4((u32x2){cur.x, cur.y}), x2b = up4((u32x2){cur.z, cur.w}), x1a = up4((u32x2){p1.x, p1.y}), x1b = up4((u32x2){p1.z, p1.w}), x0a = up4((u32x2){p2.x, p2.y}), x0b = up4((u32x2){p2.z, p2.w});
        const f32x4 ca = ba + w0a * x0a + w1a * x1a + w2a * x2a, cc = bb + w0b * x0b + w1b * x1b + w2b * x2b;
        const pg8::f32x2 g0 = pg8::gelu_pk2((pg8::f32x2){ca.x, ca.y}), g1 = pg8::gelu_pk2((pg8::f32x2){ca.z, ca.w}), g2 = pg8::gelu_pk2((pg8::f32x2){cc.x, cc.y}), g3 = pg8::gelu_pk2((pg8::f32x2){cc.z, cc.w});
        *(u32x4*)(GC + (size_t)r * FF + c) = (u32x4){pk2(g0.x, g0.y), pk2(g1.x, g1.y), pk2(g2.x, g2.y), pk2(g3.x, g3.y)};
        p2 = p1; p1 = cur;
    }
}
__device__ __forceinline__ void ffn_halo_fix(ArgsP a, int l, int pm) {
    a = args_ptr();
    const int tid = ltid();
    const bf16_t* RAWH = (const bf16_t*)(a->ws + A_UG); bf16_t* ACT = (bf16_t*)(a->ws + A_ACT);
    const float* cw = a->in[I_CONVW] + (size_t)l * 3 * FF; const float* cb = a->in[I_CONVB] + (size_t)l * FF;
    for (int i = tid; i < 8 * (FF / 8); i += NTHREADS) {
        const int hr = i / (FF / 8), c = (i % (FF / 8)) * 8, blk = pm * 4 + (hr >> 1), fr = hr & 1, row = blk * 64 + fr;
        const bool first = (row & 4095) < 2; const bf16_t* hb = RAWH + (size_t)blk * 6 * FF + c; const u32x4 z = (u32x4){0u, 0u, 0u, 0u};
        const u32x4 cur = *(const u32x4*)(hb + (2 + fr) * FF), val = *(const u32x4*)(hb + (4 + fr) * FF);
        const u32x4 p1 = (fr == 0) ? (first ? z : *(const u32x4*)(hb - 5 * FF)) : *(const u32x4*)(hb + 2 * FF);
        const u32x4 p2 = first ? z : *(const u32x4*)(hb - (fr == 0 ? 6 : 5) * FF);
        const f32x4 w0a = *(const f32x4*)(cw + c), w0b = *(const f32x4*)(cw + c + 4), w1a = *(const f32x4*)(cw + FF + c), w1b = *(const f32x4*)(cw + FF + c + 4);
        const f32x4 w2a = *(const f32x4*)(cw + 2 * FF + c), w2b = *(const f32x4*)(cw + 2 * FF + c + 4), ba = *(const f32x4*)(cb + c), bb = *(const f32x4*)(cb + c + 4);
        const f32x4 ga = pg8::gelu4(ba + w0a * up4((u32x2){p2.x, p2.y}) + w1a * up4((u32x2){p1.x, p1.y}) + w2a * up4((u32x2){cur.x, cur.y}));
        const f32x4 gb = pg8::gelu4(bb + w0b * up4((u32x2){p2.z, p2.w}) + w1b * up4((u32x2){p1.z, p1.w}) + w2b * up4((u32x2){cur.z, cur.w}));
        *(u32x4*)(ACT + (size_t)row * FF + c) = pg8::pack8(ga * up4((u32x2){val.x, val.y}), gb * up4((u32x2){val.z, val.w}));
    }
    asm volatile("s_waitcnt vmcnt(0)" ::: "memory");
    __syncthreads();
}
__device__ __forceinline__ void phase_final(ArgsP a) {
    a = args_ptr();
    const int tid = ltid(), lane = tid & 63, gw = blockIdx.x * NWAVES + (tid >> 6), NGW = gridDim.x * NWAVES;
    const float* SS4 = (const float*)(a->ws + WS_SSP) + (size_t)4 * M * 16; const f32x4* g = (const f32x4*)a->in[I_FINAL] + lane; const bf16_t* HB = (const bf16_t*)(a->ws + A_HB);
    for (int m = gw; m < M; m += NGW) {
        const float rs = rsqrtf(pg8::sum16(SS4 + (size_t)m * 16) * (1.0f / 1024.0f) + NORM_EPS);
        f32x4* o = (f32x4*)(a->out + (size_t)m * DM) + lane; const u32x2* hb = (const u32x2*)(HB + (size_t)m * DM) + lane;
#pragma unroll
        for (int j = 0; j < 4; ++j) o[64 * j] = up4(hb[64 * j]) * rs * g[64 * j];
    }
}


#ifndef DUMP_MIB
#define DUMP_MIB 0
#endif
#ifndef DUMP_OFF_MIB
#define DUMP_OFF_MIB 0
#endif
__device__ __forceinline__ void phase_dump(ArgsP a) {
    a = args_ptr();
    const size_t n16 = (size_t)DUMP_MIB * 1024 * 512, nout = (size_t)M * DM;
    const unsigned short* src = (const unsigned short*)(a->ws + (size_t)DUMP_OFF_MIB * 1024 * 1024);
    for (size_t i = (size_t)blockIdx.x * NTHREADS + vtid(); i < nout; i += (size_t)gridDim.x * NTHREADS) {
        float sacc = 0.f; for (size_t j = i; j < n16; j += nout) sacc += (float)src[j] * (1.0f / 65536.0f);
        a->out[i] = sacc; }
}

#ifndef CHK_ONLY
#define CHK_ONLY 0
#endif
#ifdef CHKSUM_PROBE
__device__ __forceinline__ void phase_chk_sum(ArgsP a) {
    a = args_ptr(); unsigned* ctl = (unsigned*)(a->ws + WS_CTL) + 32768;
    const size_t offs[4] = {A_Y, A_QN, WS_SCAL, A_YA}; const unsigned n16[4] = {(unsigned)M * 512u, (unsigned)M * 512u, (unsigned)M * 16u, 0u};
    for (int k = 0; k < 3; ++k) { const unsigned short* p = (const unsigned short*)(a->ws + offs[k]); unsigned acc = 0;
        for (unsigned i = blockIdx.x * NTHREADS + vtid(); i < n16[k]; i += gridDim.x * NTHREADS) acc += p[i];
        for (int o = 1; o < 64; o <<= 1) acc += shx(acc, o);
        if ((vtid() & 63) == 0) atomicAdd(ctl + 64 * k, acc); }
}
__device__ __forceinline__ void phase_chk_out(ArgsP a) {
    a = args_ptr(); const unsigned* ctl = (const unsigned*)(a->ws + WS_CTL) + 32768;
    for (unsigned i = blockIdx.x * NTHREADS + vtid(); i < (unsigned)(M * DM); i += gridDim.x * NTHREADS) {
        float v = 0.f; if (i == CHK_ONLY) v = (float)(__hip_atomic_load(ctl + 64 * i, __ATOMIC_RELAXED, __HIP_MEMORY_SCOPE_AGENT) % CHKSUM_PROBE) * 100.0f; a->out[i] = v; }
}
#endif

#ifdef CMPY_PROBE
__device__ __forceinline__ void phase_cmp_y(ArgsP a) {
    a = args_ptr(); unsigned long long* ctl = (unsigned long long*)(a->ws + WS_CTL) + 20000;
    const unsigned short* y1 = (const unsigned short*)(a->ws + A_Y); const unsigned short* y2 = (const unsigned short*)(a->ws + A_GATE);
    float sd = 0.f, sy = 0.f;
    for (unsigned i = blockIdx.x * NTHREADS + vtid(); i < (unsigned)M * 512u; i += gridDim.x * NTHREADS) { const float p = bf2f(y1[i]), r = bf2f(y2[i]); sd += (p - r) * (p - r); sy += r * r; }
    atomicAdd(ctl, (unsigned long long)(sd * 1024.0f)); atomicAdd(ctl + 8, (unsigned long long)(sy * 1024.0f));
}
__device__ __forceinline__ void phase_cmp_out(ArgsP a) {
    a = args_ptr(); const unsigned long long* ctl = (const unsigned long long*)(a->ws + WS_CTL) + 20000;
    const float rel = sqrtf((float)__hip_atomic_load(ctl, __ATOMIC_RELAXED, __HIP_MEMORY_SCOPE_AGENT) / (float)__hip_atomic_load(ctl + 8, __ATOMIC_RELAXED, __HIP_MEMORY_SCOPE_AGENT));
    for (unsigned i = blockIdx.x * NTHREADS + vtid(); i < (unsigned)(M * DM); i += gridDim.x * NTHREADS) a->out[i] = (i == 0) ? floorf(rel * 10000.0f) : 0.f;
}
#endif

#ifdef CK_TIME
__device__ __forceinline__ void phase_time_out(ArgsP a) {
    a = args_ptr(); const unsigned long long* tw = (const unsigned long long*)(a->ws + WS_CTL) + 24000;
#ifdef CK_TIME_TOTAL
    const float frac = (float)__hip_atomic_load(tw + 8, __ATOMIC_RELAXED, __HIP_MEMORY_SCOPE_AGENT) * (1.0f / 100000.0f);
    for (unsigned i = blockIdx.x * NTHREADS + vtid(); i < (unsigned)(M * DM); i += gridDim.x * NTHREADS) a->out[i] = (i == 0) ? floorf(frac) * 100.0f : 0.f;
#else
    const float frac = (float)__hip_atomic_load(tw + CK_TIME, __ATOMIC_RELAXED, __HIP_MEMORY_SCOPE_AGENT) / (float)__hip_atomic_load(tw + 8, __ATOMIC_RELAXED, __HIP_MEMORY_SCOPE_AGENT);
    for (unsigned i = blockIdx.x * NTHREADS + vtid(); i < (unsigned)(M * DM); i += gridDim.x * NTHREADS) a->out[i] = (i == 0) ? floorf(frac * 8.0f + 0.5f) * 1000.0f : 0.f;
#endif
}
#endif

#ifdef PH_TIME
__device__ __forceinline__ void phase_phtime_out(ArgsP a) {
    a = args_ptr(); const unsigned long long* tw = (const unsigned long long*)(a->ws + WS_CTL) + 26000;
    const float us = (float)(__hip_atomic_load(tw + PH_TIME + 1, __ATOMIC_RELAXED, __HIP_MEMORY_SCOPE_AGENT) - __hip_atomic_load(tw + PH_TIME, __ATOMIC_RELAXED, __HIP_MEMORY_SCOPE_AGENT)) * 0.01f;
    for (unsigned i = blockIdx.x * NTHREADS + vtid(); i < (unsigned)(M * DM); i += gridDim.x * NTHREADS) a->out[i] = (i == 0) ? floorf(us / (float)PH_Q + 0.5f) * 100.0f : 0.f;
}
#endif
#ifdef SPLIT_SCAN_ATTN
constexpr int PH_EXTRA = 1;
#else
constexpr int PH_EXTRA = 0;
#endif
constexpr int PH_PER_LAYER = 8 + PH_EXTRA, N_PHASES = 2 * PH_PER_LAYER + 1;
__global__ void __launch_bounds__(NTHREADS, 2) mk_fwd(Args a_unused) {
    LAS unsigned char* lds = (LAS unsigned char*)lds_raw;
    { const unsigned t0_ = threadIdx.x; if ((t0_ & 63u) == 0u) *(volatile LAS unsigned*)(lds + WTAB_OFF + hw_wave_key() * 4u) = t0_ >> 6; }
    __syncthreads();
#if !MK_MULTI
    if (args_ptr()->ph_lo > 1000000) cg::this_grid().sync();
    volatile LAS unsigned* MISC = (volatile LAS unsigned*)(lds + MISC_OFF);
    if (vtid() < 32) MISC[vtid()] = 0u;
    __syncthreads();
    (void)xcd_barrier_post((unsigned*)(args_ptr()->ws + WS_CTL) + CW_BAR, MISC + 8);
#endif
    int ph = 0;
#ifdef PH_TIME
    if (blockIdx.x == 0 && vtid() == 0) ((unsigned long long*)(args_ptr()->ws + WS_CTL) + 26000)[0] = __builtin_amdgcn_s_memrealtime();
#endif
#define lo (args_ptr()->ph_lo)
#define hi (args_ptr()->ph_hi)
#if MK_MULTI
#define SEAM() do {} while (0)
#define SEAM1() do {} while (0)
#else
#define SEAM1() do { XcdBarrier b_; b_.bar = (unsigned*)(args_ptr()->ws + WS_CTL) + CW_BAR; b_.x = xb_xcc_id(); b_.st = (volatile LAS unsigned*)(lds + MISC_OFF) + 8; xcd_barrier(b_); } while (0)
#define SEAM() do { if (ph + 1 < hi) { XcdBarrier b_; b_.bar = (unsigned*)(args_ptr()->ws + WS_CTL) + CW_BAR; b_.x = xb_xcc_id(); b_.st = (volatile LAS unsigned*)(lds + MISC_OFF) + 8; xcd_barrier(b_); } } while (0)
#endif
#ifndef PH3SUB
#define PH3SUB 7
#endif
#ifndef PHMASK
#define PHMASK 0xFFFF
#endif
#ifndef SCAN_CHUNKED
#define SCAN_CHUNKED 1
#endif
#ifndef SCAN_REPS
#define SCAN_REPS 1
#endif
#ifndef REPEAT_PHASE
#define REPEAT_PHASE (-1)
#endif
#ifndef REPEAT_LAYER
#define REPEAT_LAYER (-1)
#endif
#ifdef PH_TIME
#define PH_STAMP() do { if (blockIdx.x == 0 && vtid() == 0) ((unsigned long long*)(args_ptr()->ws + WS_CTL) + 26000)[ph + 1] = __builtin_amdgcn_s_memrealtime(); } while (0)
#elif defined(PH_SPIN)
#ifdef PH_SUB
#define PH_SUBSEL() do { const unsigned long long* ts_ = st_ + 100; d_ = PH_SUB == 1 ? ts_[1] - ts_[0] : (PH_SUB == 2 ? ts_[2] - ts_[1] : (PH_SUB == 3 ? t1_ - ts_[2] : (PH_SUB == 4 ? __hip_atomic_load((unsigned long long*)ts_ + 4, __ATOMIC_RELAXED, __HIP_MEMORY_SCOPE_AGENT) - ts_[0] : ts_[0] - st_[ph]))); } while (0)
#else
#define PH_SUBSEL() do {} while (0)
#endif
#define PH_STAMP() do { if (ph + 1 == PH_SPIN || ph == PH_SPIN) { if (blockIdx.x == 0 && vtid() == 0) { unsigned long long* st_ = (unsigned long long*)(args_ptr()->ws + WS_CTL) + 26000; \
        const unsigned long long t1_ = __builtin_amdgcn_s_memrealtime(); st_[ph + 1] = t1_; st_[103] = t1_; \
        if (ph == PH_SPIN) { unsigned long long d_ = t1_ - st_[ph]; PH_SUBSEL(); if (d_ > 100000ull) d_ = 100000ull; while (__builtin_amdgcn_s_memrealtime() - t1_ < d_) __builtin_amdgcn_s_sleep(8); } } \
        if (ph == PH_SPIN) { SEAM1(); } } } while (0)
#else
#define PH_STAMP() do {} while (0)
#endif
#define RUN(K, ...) do { if (((PHMASK >> (K)) & 1) && lo <= ph && ph < hi) { const int nrep_ = ((K) == REPEAT_PHASE && (REPEAT_LAYER < 0 || REPEAT_LAYER == l_)) ? 2 : 1; \
    for (int rep_ = 0; rep_ < nrep_; ++rep_) { __VA_ARGS__; if (rep_ + 1 < nrep_) { SEAM1(); } } SEAM(); PH_STAMP(); } ++ph; } while (0)
#define LOCALS() ArgsP a = args_ptr(); unsigned char* ws = a->ws; unsigned char* wb = ws + WS_W; float* SSP = (float*)(ws + WS_SSP); float* SSQP = (float*)(ws + WS_SSQP); bf16_t* HB = (bf16_t*)(ws + A_HB); \
    const int G = gridDim.x, bid = blockIdx.x; (void)wb; (void)SSP; (void)SSQP; (void)HB; (void)G; (void)bid
#define WT(off) ((const pg8::bf16_t*)(wb + (off)))
    int l_ = 0;
    for (int l = 0; l < DEPTH; ++l) {
        l_ = l;
        RUN(0, phase_weights(nullptr, l, lds));
        RUN(1, { LOCALS(); pg8::Gemm g{HB, WT(W_IN), M, PC - 256, 1024, 1024}; pg8::StaticOrder S; S.init(M, PC - 256, G, bid);
              pg8::EpiP E{(bf16_t*)(ws + A_RKV), (bf16_t*)(ws + A_LORAC), (bf16_t*)(ws + A_PM), (unsigned char*)a->out, SSP + (size_t)(2 * l) * M * 16, SSQP + (size_t)l * M * 4, SSQP + (size_t)(2 + l) * M * 4, (bf16_t*)((unsigned char*)a->out + DO_HALO), (LAS float*)(lds + pg8::RS_OFF), 0};
              GEMM_PHASE(pg8::EpiP, lds, g, S, E); });
        RUN(3, { for (int r_ = (int)blockIdx.x * 64; r_ < M; r_ += (int)gridDim.x * 64) prep_rows(nullptr, l, r_);
              if (gridDim.x == 256 && blockIdx.x >= 192) {
                LOCALS(); pg8::Gemm g{HB, WT(W_IN) + (size_t)(PC - 256) * 1024, M, 256, 1024, 1024}; pg8::StaticOrder S; S.init(M, 256, 64, bid - 192);
                pg8::EpiP E{(bf16_t*)(ws + A_RKV), (bf16_t*)(ws + A_LORAC), (bf16_t*)(ws + A_PM), (unsigned char*)a->out, SSP + (size_t)(2 * l) * M * 16, SSQP + (size_t)l * M * 4, SSQP + (size_t)(2 + l) * M * 4, (bf16_t*)((unsigned char*)a->out + DO_HALO), (LAS float*)(lds + pg8::RS_OFF), 16};
                GEMM_PHASE(pg8::EpiP, lds, g, S, E); }
              else if (gridDim.x != 256) {
                LOCALS(); pg8::Gemm g{HB, WT(W_IN) + (size_t)(PC - 256) * 1024, M, 256, 1024, 1024}; pg8::StaticOrder S; S.init(M, 256, G, bid);
                pg8::EpiP E{(bf16_t*)(ws + A_RKV), (bf16_t*)(ws + A_LORAC), (bf16_t*)(ws + A_PM), (unsigned char*)a->out, SSP + (size_t)(2 * l) * M * 16, SSQP + (size_t)l * M * 4, SSQP + (size_t)(2 + l) * M * 4, (bf16_t*)((unsigned char*)a->out + DO_HALO), (LAS float*)(lds + pg8::RS_OFF), 16};
                GEMM_PHASE(pg8::EpiP, lds, g, S, E); }
              if (PH3SUB & 2) { LOCALS(); pg8::Gemm g{(const bf16_t*)(ws + A_PM), WT(W_Q), M, 768, 256, 512}; pg8::StaticOrder S; S.init(M, 768, G, bid);
                { pg8::Unit u_; for (int i_ = 0; S.next(i_, u_); ++i_) { lin_wait(nullptr, l, u_.pm); lin_wait(nullptr, l, u_.pm < 63 ? u_.pm + 1 : 63); } }
                pg8::EpiQ E{(bf16_t*)(ws + A_QN), (bf16_t*)(ws + A_QP), SSQP + (size_t)l * M * 4, (const float*)(ws + WS_CS), (LAS float*)(lds + pg8::RS_OFF)};
                GEMM_PHASE(pg8::EpiQ, lds, g, S, E); }
              if (PH3SUB & 4) { LOCALS(); pg8::Gemm g{(const bf16_t*)(ws + A_PM) + 256, WT(W_KV), M, 1024, 256, 512}; pg8::StaticOrder S; S.init(M, 1024, G, bid);
                pg8::EpiKV E{(bf16_t*)(ws + A_KN), (bf16_t*)(ws + A_VT), SSQP + (size_t)(2 + l) * M * 4, (LAS float*)(lds + pg8::RS_OFF)};
                GEMM_PHASE(pg8::EpiKV, lds, g, S, E); }
              { LOCALS(); pg8::StaticOrder S; S.init(M, 1536, G, bid); pg8::Unit u_; for (int i_ = 0; S.next(i_, u_); ++i_) lin_wait(nullptr, l, u_.pm); }
              if (PH3SUB & 1) { LOCALS(); pg8::Gemm g{(const bf16_t*)(ws + A_LIN), WT(W_LORA), M, 1536, 256, 256}; pg8::StaticOrder S; S.init(M, 1536, G, bid);
                pg8::EpiLora E{(bf16_t*)(ws + A_LW), (bf16_t*)(ws + A_ICLR), (bf16_t*)(ws + A_GATE), a->in[I_DBASE] + l * 512, a->in[I_IBASE] + l * 512};
                GEMM_PHASE(pg8::EpiLora, lds, g, S, E); } });
#if WKV_STREAM
        RUN(4, { if (gridDim.x >= 64) { if (blockIdx.x >= 32) phase_wkvprep(nullptr, l, lds, (int)blockIdx.x - 32, (int)gridDim.x - 32); }
                 else { phase_wkvprep(nullptr, l, lds, (int)blockIdx.x, (int)gridDim.x); SEAM1(); }
                 if (blockIdx.x < 32) { for (int sr_ = 0; sr_ < SCAN_REPS; ++sr_) scan_unit_stream(nullptr, l, blockIdx.x, lds); }
#ifdef PH_SUB
                 if (blockIdx.x == 0 && vtid() == 0) { unsigned long long* ts_ = (unsigned long long*)(args_ptr()->ws + WS_CTL) + 26100; ts_[0] = ts_[3]; ts_[1] = __builtin_amdgcn_s_memrealtime(); }
#endif
                 unsigned* qctr = (unsigned*)(args_ptr()->ws + WS_CTL) + CW_QUEUE + 64 * (2 * l);
                 volatile LAS unsigned* qslot = (volatile LAS unsigned*)(lds + MISC_OFF) + 16;
                 for (;;) { if (vtid() == 0) qslot[0] = __hip_atomic_fetch_add(qctr, 1u, __ATOMIC_RELAXED, __HIP_MEMORY_SCOPE_AGENT);
                            __syncthreads(); const unsigned u = qslot[0]; __syncthreads();
                            if (u >= 512u) break;
                            attn_unit(nullptr, (int)(u & 31u), 15 - (int)(u >> 5), lds, A_QN); }
                 { unsigned* yctr = (unsigned*)(args_ptr()->ws + WS_CTL) + CW_QUEUE + 64 * (2 * l + 1);
                   for (;;) { if (vtid() == 0) qslot[0] = __hip_atomic_fetch_add(yctr, 1u, __ATOMIC_RELAXED, __HIP_MEMORY_SCOPE_AGENT);
                              __syncthreads(); const unsigned u = qslot[0]; __syncthreads();
                              if (u >= 256u) break;
                              ya_item(nullptr, l, (int)(u & 31u), (int)(u >> 5)); } }
#ifdef PH_SUB
                 if (blockIdx.x == 0 && vtid() == 0) { unsigned long long* ts_ = (unsigned long long*)(args_ptr()->ws + WS_CTL) + 26100; ts_[2] = __builtin_amdgcn_s_memrealtime(); }
                 if (blockIdx.x == 255 && vtid() == 0) { unsigned long long* ts_ = (unsigned long long*)(args_ptr()->ws + WS_CTL) + 26100; __hip_atomic_store(ts_ + 4, (unsigned long long)__builtin_amdgcn_s_memrealtime(), __ATOMIC_RELAXED, __HIP_MEMORY_SCOPE_AGENT); }
#endif
                 });
#else
#ifdef SPLIT_SCAN_ATTN
        RUN(4, { if (blockIdx.x < 128) scan_unit_chunked(nullptr, l, blockIdx.x >> 2, blockIdx.x & 3, lds); });
        RUN(5, { for (int c = blockIdx.x; c < 256; c += gridDim.x) { attn_unit(nullptr, c >> 3, 15 - (c & 7), lds); attn_unit(nullptr, c >> 3, c & 7, lds); } });
#else
        RUN(4, { if (blockIdx.x < 128) { for (int sr_ = 0; sr_ < SCAN_REPS; ++sr_) { if (SCAN_CHUNKED) scan_unit_chunked(nullptr, l, blockIdx.x >> 2, blockIdx.x & 3, lds); else scan_unit(nullptr, l, blockIdx.x >> 2, blockIdx.x & 3, lds); } }
                 const size_t oo_ = (rep_ + 1 < nrep_) ? A_LW : A_QN;
                 unsigned* qctr = (unsigned*)(args_ptr()->ws + WS_CTL) + CW_QUEUE + 64 * (2 * l + rep_);
                 volatile LAS unsigned* qslot = (volatile LAS unsigned*)(lds + MISC_OFF) + 16;
                 for (;;) { if (vtid() == 0) qslot[0] = __hip_atomic_fetch_add(qctr, 1u, __ATOMIC_RELAXED, __HIP_MEMORY_SCOPE_AGENT);
                            __syncthreads(); const unsigned u = qslot[0]; __syncthreads();
                            if (u >= 512u) break;
                            attn_unit(nullptr, (int)(u & 31u), 15 - (int)(u >> 5), lds, oo_); } });
#endif
#endif
#ifdef CK_TIME
        if (l == 0) { phase_time_out(nullptr); return; }
#endif
#ifdef CMPY_PROBE
        if (l == 0) { if (blockIdx.x < 128) scan_unit(nullptr, l, blockIdx.x >> 2, blockIdx.x & 3, lds, A_GATE); SEAM1(); phase_cmp_y(nullptr); SEAM1(); phase_cmp_out(nullptr); return; }
#endif
#ifdef CHKSUM_PROBE
        if (l == 0) { phase_chk_sum(nullptr); SEAM1(); phase_chk_out(nullptr); return; }
#endif
        RUN(7, { { LOCALS(); pg8::Gemm g{(const bf16_t*)(ws + A_YA), WT(W_OA), M, 1024, 512, 512}; pg8::StaticOrder S; S.init(M, 1024, G, bid);
                pg8::EpiMix<1> E{(float*)(ws + A_TMP), (bf16_t*)(ws + A_MERGED), (const unsigned char*)a->out};
                GEMM_PHASE(pg8::EpiMix<1>, lds, g, S, E); }
              asm volatile("s_waitcnt vmcnt(0)" ::: "memory"); __syncthreads();
              { LOCALS(); pg8::Gemm g{(const bf16_t*)(ws + A_QN), WT(W_OB), M, 1024, 512, 512}; pg8::StaticOrder S; S.init(M, 1024, G, bid);
                pg8::EpiMix<2> E{(float*)(ws + A_TMP), (bf16_t*)(ws + A_MERGED), (const unsigned char*)a->out};
                GEMM_PHASE(pg8::EpiMix<2>, lds, g, S, E); } });
        RUN(8, { LOCALS(); pg8::Gemm g{(const bf16_t*)(ws + A_MERGED), WT(W_OUT), M, 1024, 1024, 1024}; pg8::StaticOrder S; S.init(M, 1024, G, bid);
#ifdef PH_SUB
              g.ts = (unsigned long long*)(ws + WS_CTL) + 26100;
#endif
              pg8::EpiRes E{HB, SSP + (size_t)(2 * l + 1) * M * 16};
              GEMM_PHASE(pg8::EpiRes, lds, g, S, E); });
        RUN(9, { LOCALS(); pg8::Gemm g{HB, WT(W_UP), M, 2 * FF, 1024, 1024}; pg8::StaticOrder S; S.init(M, 2 * FF, G, bid);
              pg8::EpiUp E{(bf16_t*)(ws + A_ACT), (bf16_t*)(ws + A_UG), SSP + (size_t)(2 * l + 1) * M * 16, a->in[I_CONVW] + (size_t)l * 3 * FF, a->in[I_CONVB] + (size_t)l * FF, (LAS float*)(lds + pg8::RS_OFF)};
              GEMM_PHASE(pg8::EpiUp, lds, g, S, E); });
        RUN(11, { LOCALS(); pg8::Gemm g{(const bf16_t*)(ws + A_ACT), WT(W_DOWN), M, 1024, FF, FF}; pg8::StaticOrder S; S.init(M, 1024, G, bid);
              { pg8::Unit hu_; for (int hi_ = 0; S.next(hi_, hu_); ++hi_) ffn_halo_fix(nullptr, l, hu_.pm); }
              pg8::EpiRes E{HB, SSP + (size_t)(2 * l + 2) * M * 16};
              GEMM_PHASE(pg8::EpiRes, lds, g, S, E); });
    }
    RUN(12, phase_final(nullptr));
#ifdef PH_TIME
    SEAM1(); phase_phtime_out(nullptr);
#endif
#if DUMP_MIB
    if (lo == 100) phase_dump(nullptr);
#endif
#ifdef CLOCKJUNK
    if (lo == 103 && blockIdx.x == 0) { args_ptr()->out[vtid()] += (float)(__builtin_amdgcn_s_memrealtime() & 1023); }
#endif
}

#undef lo
#undef hi
extern "C" void kernel_launch(void* const* d_in, const int* in_sizes, int n_in, void* d_out, int out_size, void* d_ws, size_t ws_size, hipStream_t stream) {
    static int grid = 0;
    if (grid == 0) {
        if (n_in != 28 || out_size != M * DM || ws_size < WS_END) { fprintf(stderr, "kernel_launch: unexpected shapes: n_in %d out %d ws %zu (need %zu)\n", n_in, out_size, ws_size, (size_t)WS_END); grid = -1; return; }
        int dev = 0, cus = 0, per_cu = 0;
        if (hipGetDevice(&dev) != hipSuccess || hipDeviceGetAttribute(&cus, hipDeviceAttributeMultiprocessorCount, dev) != hipSuccess) { grid = -1; return; }
        if (hipFuncSetAttribute((const void*)mk_fwd, hipFuncAttributeMaxDynamicSharedMemorySize, LDS_BYTES) != hipSuccess) { fprintf(stderr, "kernel_launch: hipFuncSetAttribute failed\n"); grid = -1; return; }
        if (hipOccupancyMaxActiveBlocksPerMultiprocessor(&per_cu, (const void*)mk_fwd, NTHREADS, LDS_BYTES) != hipSuccess || per_cu < 1) { fprintf(stderr, "kernel_launch: occupancy query says %d\n", per_cu); per_cu = 1; }
        (void)hipGetLastError();
        grid = cus * 1;
        if (grid > cus * per_cu) grid = cus * per_cu;
    }
    if (grid < 0) return;
    if (hipMemsetAsync((char*)d_ws + WS_CTL, 0, CTL_ZERO_BYTES, stream) != hipSuccess) { fprintf(stderr, "kernel_launch: memset failed\n"); return; }
    Args a{};
    for (int i = 0; i < 28; ++i) a.in[i] = (const float*)d_in[i];
    a.out = (float*)d_out; a.ws = (unsigned char*)d_ws;
#if MK_MULTI
#ifndef STOP_AFTER
#define STOP_AFTER (N_PHASES - 1)
#endif
    for (int p = 0; p <= STOP_AFTER; ++p) {
        a.ph_lo = p; a.ph_hi = p + 1;
        hipLaunchKernelGGL(mk_fwd, dim3(grid), dim3(NTHREADS), LDS_BYTES, stream, a);
    }
#ifdef CLOCKJUNK
    a.ph_lo = 103; a.ph_hi = 104;
    hipLaunchKernelGGL(mk_fwd, dim3(grid), dim3(NTHREADS), LDS_BYTES, stream, a);
#endif
#if DUMP_MIB
    a.ph_lo = 100; a.ph_hi = 101;
    hipLaunchKernelGGL(mk_fwd, dim3(grid), dim3(NTHREADS), LDS_BYTES, stream, a);
#endif
#else
    a.ph_lo = 0; a.ph_hi = N_PHASES;
    void* kargs[] = {&a};
    hipError_t e = hipLaunchCooperativeKernel((const void*)mk_fwd, dim3(grid), dim3(NTHREADS), kargs, LDS_BYTES, stream);
    if (e != hipSuccess) fprintf(stderr, "kernel_launch: cooperative launch failed: %s (grid %d)\n", hipGetErrorString(e), grid);
#endif
}
```

```cpp
#include <hip/hip_runtime.h>
#include <hip/hip_cooperative_groups.h>
#include <cstdio>
#include <cstdint>
#include <cmath>
namespace cg = cooperative_groups;

#ifndef MK_MULTI
#define MK_MULTI 0
#endif

#ifndef SCAN_CHUNKED
#define SCAN_CHUNKED 1
#endif
#define LW_CUM SCAN_CHUNKED
#ifndef WKV_STREAM
#define WKV_STREAM 1
#endif
#ifndef CK_LWZ
#define CK_LWZ 1.0f
#endif
#ifndef CK_NOSTATE
#define CK_NOSTATE 0
#endif
#ifndef CK_AB
#define CK_AB 1.0f
#endif
constexpr int BATCH = 4, SEQ = 4096, DM = 1024, M = BATCH * SEQ, DEPTH = 2;
constexpr int NH = 8, RD = 512;
constexpr int IN_COLS = 4256, PC = 4352;
constexpr int FF = 2816;
constexpr float NORM_EPS = 1e-6f, LNX_EPS = 64e-5f;
constexpr float C2 = 0.10206207261596577f * 1.4426950408889634f;

namespace pg8 {
#define PG8_LAS __attribute__((address_space(3)))
}
extern __shared__ __attribute__((aligned(16))) unsigned char lds_raw[];
constexpr int WTAB_OFF = 131072 + 448;
__device__ __forceinline__ unsigned hw_wave_key() { return (unsigned)__builtin_amdgcn_s_getreg((5 << 11) | 4) & 63u; }
__device__ __forceinline__ int vtid() {
    const int wv = __builtin_amdgcn_readfirstlane((int)*(volatile PG8_LAS unsigned*)((PG8_LAS unsigned char*)lds_raw + WTAB_OFF + hw_wave_key() * 4u));
    int t_ = (wv << 6) | (int)__builtin_amdgcn_mbcnt_hi(~0u, __builtin_amdgcn_mbcnt_lo(~0u, 0u));
    asm volatile("" : "+v"(t_));
    return t_;
}
__device__ __forceinline__ float shx(float v, int m) {
    int l_ = (int)__builtin_amdgcn_mbcnt_hi(~0u, __builtin_amdgcn_mbcnt_lo(~0u, 0u)); asm volatile("" : "+v"(l_));
    return __builtin_bit_cast(float, __builtin_amdgcn_ds_bpermute((l_ ^ m) << 2, __builtin_bit_cast(int, v)));
}
namespace pg8 {
typedef unsigned short bf16_t;
typedef short bf16x8 __attribute__((ext_vector_type(8)));
typedef float f32x4 __attribute__((ext_vector_type(4)));
typedef unsigned u32x4 __attribute__((ext_vector_type(4)));
constexpr int BM = 256, BK = 64, HALF = 128, HTB = HALF * BK * 2  , STAGE_BYTES = 8 * HTB, NXCD = 8, WGM = 8;

__host__ __device__ __forceinline__ int lds_byte(int r, int c) { const int st = (r >> 4) * 2 + (c >> 5), rr = r & 15, cc = c & 31, ob = rr * 64 + cc * 2; return st * 1024 + (ob ^ (((ob >> 9) & 1) << 5)); }
__host__ __device__ __forceinline__ void stage_rc(int b, int& R, int& C) { const int st = b / 1024, sb = b % 1024, swz = sb ^ (((sb >> 9) & 1) << 5); R = (st >> 1) * 16 + swz / 64; C = (st & 1) * 32 + (swz % 64) / 2; }
__host__ __device__ __forceinline__ int perm32(int rho) { const int n = rho >> 4, i = rho & 15; return 8 * (i >> 2) + 4 * n + (i & 3); }

struct Unit { int pm, pn; };
struct Gemm { const bf16_t* A; const bf16_t* Bt; int M, N, K, lda; unsigned long long* ts = nullptr; };

struct StaticOrder {
    int nM, nN, nwg, G, c;
    __host__ __device__ void init(int M, int N, int G_, int c_) { nM = M / BM; nN = N / BM; nwg = nM * nN; G = G_; c = c_; }
    __host__ __device__ __forceinline__ bool next(int i, Unit& u) const {
        const long L = (long)i * G + c; if (L >= nwg) return false;
        int wgid = (int)L; { const int q = nwg / NXCD, r = nwg % NXCD, xcd = wgid % NXCD, off = wgid / NXCD; wgid = (xcd < r ? xcd * (q + 1) : r * (q + 1) + (xcd - r) * q) + off; }
        const int nig = WGM * nN, gid = wgid / nig, fm = gid * WGM, gsz = (nM - fm) < WGM ? (nM - fm) : WGM;
        u.pm = fm + ((wgid % nig) % gsz); u.pn = (wgid % nig) / gsz; return true;
    }
    __device__ __forceinline__ void a_ready(const Unit&) const {}
    __device__ __forceinline__ void done(const Unit&) const {}
};

__device__ __forceinline__ unsigned cvt_pk_bf16(float lo, float hi) { unsigned r; asm volatile("v_cvt_pk_bf16_f32 %0, %1, %2" : "=v"(r) : "v"(lo), "v"(hi)); return r; }
template <class Epi, class Sched, bool ALIGN_EPI = false, bool SP2 = false>
__device__ __forceinline__ void gemm_phase(PG8_LAS unsigned char* lds, const Gemm g, const Sched& S, const Epi& E) {
    int tid_ = vtid(); asm volatile("" : "+v"(tid_)); const int tid = tid_, wid = __builtin_amdgcn_readfirstlane(tid >> 6), lane = tid & 63, wr = wid >> 2, wc = wid & 3, fr = lane & 15, fq = lane >> 4;
    int Kx_ = g.K; asm volatile("" : "+s"(Kx_)); const int K = Kx_, nt = K / BK;
    unsigned voffA[2], voffB[2];
#pragma unroll
    for (int i = 0; i < 2; ++i) { int R, C; stage_rc(tid * 16 + i * 8192, R, C); const int Rb = Epi::PERM ? ((R & ~31) + perm32(R & 31)) : R;
        voffA[i] = (unsigned)(R * g.lda + C) * 2u; voffB[i] = (unsigned)(Rb * K + C) * 2u; }
    const size_t kstep = (size_t)(BK * 2);
    const size_t hstep = (size_t)HALF * K * 2, hstepA = (size_t)HALF * g.lda * 2;
    const size_t tstep = 2 * hstep, tstepA = 2 * hstepA;
    const unsigned ldsw = (unsigned)wid * 1024u;
    const int aoff = lds_byte(wr * 64 + fr, fq * 8), boff = lds_byte(wc * 32 + fr, fq * 8);
#define PG8_SA(b, h) (((b) * 2 + (h)) * HTB)
#define PG8_SB(b, h) ((4 + (b) * 2 + (h)) * HTB)
#define PG8_STAGE(bufoff, gbase, voff) do { _Pragma("unroll") for (int _i = 0; _i < 2; ++_i) \
        __builtin_amdgcn_global_load_lds((const unsigned*)((const char*)(gbase) + (voff)[_i]), (PG8_LAS unsigned*)(lds + (bufoff) + ldsw + _i * 8192), 16, 0, 0); } while (0)
#define PG8_LDA(dst, b, h) do { _Pragma("unroll") for (int m = 0; m < 4; ++m) _Pragma("unroll") for (int k = 0; k < 2; ++k) dst[m][k] = *(const PG8_LAS bf16x8*)(lds + PG8_SA(b, h) + aoff + m * 2048 + k * 1024); } while (0)
#define PG8_LDB(dst, b, h) do { _Pragma("unroll") for (int n = 0; n < 2; ++n) _Pragma("unroll") for (int k = 0; k < 2; ++k) dst[n][k] = *(const PG8_LAS bf16x8*)(lds + PG8_SB(b, h) + boff + n * 2048 + k * 1024); } while (0)
#define PG8_MMA(ai, bj, At, Bt) do { __builtin_amdgcn_s_setprio(1); _Pragma("unroll") for (int m = 0; m < 4; ++m) _Pragma("unroll") for (int n = 0; n < 2; ++n) _Pragma("unroll") for (int k = 0; k < 2; ++k) \
        acc[ai][bj][m][n] = __builtin_amdgcn_mfma_f32_16x16x32_bf16(Bt[n][k], At[m][k], acc[ai][bj][m][n], 0, 0, 0); __builtin_amdgcn_s_setprio(0); } while (0)
#define PG8_WAIT_V(n) asm volatile("s_waitcnt vmcnt(" #n ")" ::: "memory")
#define PG8_WAIT_L(n) asm volatile("s_waitcnt lgkmcnt(" #n ")" ::: "memory")
#define PG8_BAR __builtin_amdgcn_s_barrier()
#define PG8_SCHED __builtin_amdgcn_sched_barrier(0)
    Unit cur, nxt; int ui = 0;
    if (!S.next(0, cur)) return;
#ifdef PH_SUB
#define PG8_TS(i) do { if (blockIdx.x == 0 && tid == 0) g.ts[i] = __builtin_amdgcn_s_memrealtime(); } while (0)
#else
#define PG8_TS(i) do {} while (0)
#endif
    PG8_TS(0);
    f32x4 acc[2][2][4][2];
#pragma unroll
    for (int a = 0; a < 2; ++a)
#pragma unroll
        for (int b = 0; b < 2; ++b)
#pragma unroll
            for (int m = 0; m < 4; ++m)
#pragma unroll
                for (int n = 0; n < 2; ++n) acc[a][b][m][n] = (f32x4){0.f, 0.f, 0.f, 0.f};
    bf16x8 At[4][2], B0[2][2], B1[2][2];
    const char* cA = (const char*)g.A + (size_t)cur.pm * tstepA; const char* cB = (const char*)g.Bt + (size_t)cur.pn * tstep;
    S.a_ready(cur);
    if constexpr (SP2) {
        PG8_STAGE(PG8_SB(0, 0), cB, voffB); PG8_STAGE(PG8_SB(0, 1), cB + hstep, voffB); PG8_STAGE(PG8_SA(0, 0), cA, voffA); PG8_STAGE(PG8_SA(0, 1), cA + hstepA, voffA);
        if (wr == 1) PG8_BAR;
        PG8_WAIT_V(2); PG8_BAR;
        PG8_STAGE(PG8_SB(1, 0), cB + kstep, voffB); PG8_STAGE(PG8_SA(1, 0), cA + kstep, voffA); PG8_STAGE(PG8_SB(1, 1), cB + hstep + kstep, voffB);
        PG8_WAIT_V(6); PG8_BAR;
    } else {
        PG8_STAGE(PG8_SB(0, 0), cB, voffB); PG8_STAGE(PG8_SA(0, 0), cA, voffA); PG8_STAGE(PG8_SB(0, 1), cB + hstep, voffB); PG8_STAGE(PG8_SA(0, 1), cA + hstepA, voffA);
        if (wr == 1) PG8_BAR;
        PG8_WAIT_V(4); PG8_BAR;
        PG8_STAGE(PG8_SB(1, 0), cB + kstep, voffB); PG8_STAGE(PG8_SA(1, 0), cA + kstep, voffA); PG8_STAGE(PG8_SB(1, 1), cB + hstep + kstep, voffB);
        PG8_WAIT_V(6); PG8_BAR;
    }
    for (;;) {
        const bool has_next = S.next(ui + 1, nxt);
        const char* nA = has_next ? (const char*)g.A + (size_t)nxt.pm * tstepA : cA; const char* nB = has_next ? (const char*)g.Bt + (size_t)nxt.pn * tstep : cB;
#pragma unroll 1
        for (int t = 0; t < nt; t += 2) {
            const bool last = (t == nt - 2);
            const char* a1 = cA + (size_t)(t + 1) * kstep;
            const char* a2 = last ? nA : cA + (size_t)(t + 2) * kstep; const char* b2 = last ? nB : cB + (size_t)(t + 2) * kstep;
            const char* a3 = a2 + kstep; const char* b3 = b2 + kstep;
            if (last && has_next) S.a_ready(nxt);
            if constexpr (SP2) {
            PG8_LDB(B0, 0, 0); PG8_LDB(B1, 0, 1); PG8_SCHED; PG8_LDA(At, 0, 0); PG8_STAGE(PG8_SA(1, 1), a1 + hstepA, voffA);
            PG8_WAIT_V(8); PG8_WAIT_L(0); PG8_BAR; PG8_MMA(0, 0, At, B0); PG8_MMA(0, 1, At, B1); PG8_BAR; PG8_SCHED;
            PG8_LDA(At, 0, 1); PG8_STAGE(PG8_SB(0, 0), b2, voffB); PG8_STAGE(PG8_SB(0, 1), b2 + hstep, voffB); PG8_STAGE(PG8_SA(0, 0), a2, voffA);
            PG8_WAIT_V(8); PG8_WAIT_L(0); PG8_BAR; PG8_MMA(1, 0, At, B0); PG8_MMA(1, 1, At, B1); PG8_BAR; PG8_SCHED;
            PG8_LDB(B0, 1, 0); PG8_LDB(B1, 1, 1); PG8_SCHED; PG8_LDA(At, 1, 0); PG8_STAGE(PG8_SA(0, 1), a2 + hstepA, voffA);
            PG8_WAIT_V(8); PG8_WAIT_L(0); PG8_BAR; PG8_MMA(0, 0, At, B0); PG8_MMA(0, 1, At, B1); PG8_BAR; PG8_SCHED;
            PG8_LDA(At, 1, 1); PG8_STAGE(PG8_SB(1, 0), b3, voffB); PG8_STAGE(PG8_SB(1, 1), b3 + hstep, voffB); PG8_STAGE(PG8_SA(1, 0), a3, voffA);
            PG8_WAIT_V(8); PG8_WAIT_L(0); PG8_BAR; PG8_MMA(1, 0, At, B0); PG8_MMA(1, 1, At, B1); PG8_BAR; PG8_SCHED;
            } else {
            PG8_LDB(B0, 0, 0); PG8_SCHED; PG8_LDA(At, 0, 0); PG8_STAGE(PG8_SA(1, 1), a1 + hstepA, voffA);
            PG8_WAIT_L(8); PG8_BAR; PG8_WAIT_L(0); PG8_MMA(0, 0, At, B0); PG8_BAR; PG8_SCHED;
            PG8_LDB(B1, 0, 1); PG8_STAGE(PG8_SB(0, 0), b2, voffB);
            PG8_BAR; PG8_WAIT_L(0); PG8_MMA(0, 1, At, B1); PG8_BAR;
            PG8_LDA(At, 0, 1); PG8_STAGE(PG8_SA(0, 0), a2, voffA);
            PG8_BAR; PG8_WAIT_L(0); PG8_MMA(1, 0, At, B0); PG8_BAR; PG8_SCHED;
            PG8_STAGE(PG8_SB(0, 1), b2 + hstep, voffB);
            PG8_WAIT_V(6); PG8_BAR; PG8_MMA(1, 1, At, B1); PG8_BAR;
            PG8_LDB(B0, 1, 0); PG8_SCHED; PG8_LDA(At, 1, 0); PG8_STAGE(PG8_SA(0, 1), a2 + hstepA, voffA);
            PG8_WAIT_L(8); PG8_BAR; PG8_WAIT_L(0); PG8_MMA(0, 0, At, B0); PG8_BAR; PG8_SCHED;
            PG8_LDB(B1, 1, 1); PG8_STAGE(PG8_SB(1, 0), b3, voffB);
            PG8_BAR; PG8_WAIT_L(0); PG8_MMA(0, 1, At, B1); PG8_BAR;
            PG8_LDA(At, 1, 1); PG8_STAGE(PG8_SA(1, 0), a3, voffA);
            PG8_BAR; PG8_WAIT_L(0); PG8_MMA(1, 0, At, B0); PG8_BAR; PG8_SCHED;
            PG8_STAGE(PG8_SB(1, 1), b3 + hstep, voffB);
            PG8_WAIT_V(6); PG8_BAR; PG8_MMA(1, 1, At, B1); PG8_BAR;
            }
        }
        if constexpr (ALIGN_EPI) { if (wr == 0) PG8_BAR; }
        PG8_TS(1);
        if constexpr (!Epi::AFTER_DRAIN) { E(acc, cur, wr, wc, fr, fq); S.done(cur); }
        asm volatile("" ::: "memory"); PG8_TS(2);
        if (!has_next) break;
#pragma unroll
        for (int a = 0; a < 2; ++a)
#pragma unroll
            for (int b = 0; b < 2; ++b)
#pragma unroll
                for (int m = 0; m < 4; ++m)
#pragma unroll
                    for (int n = 0; n < 2; ++n) acc[a][b][m][n] = (f32x4){0.f, 0.f, 0.f, 0.f};
        cur = nxt; cA = nA; cB = nB; ++ui;
        if constexpr (ALIGN_EPI) { if (wr == 1) PG8_BAR; }
    }
    PG8_WAIT_V(0);
    if constexpr (!ALIGN_EPI) { if (wr == 0) PG8_BAR; }
    PG8_BAR;
    if constexpr (Epi::AFTER_DRAIN) { E.fused(acc, cur, wr, wc, fr, fq, lds, wid, lane); S.done(cur); }
#undef PG8_SA
#undef PG8_SB
#undef PG8_STAGE
#undef PG8_LDA
#undef PG8_LDB
#undef PG8_MMA
#undef PG8_WAIT_V
#undef PG8_WAIT_L
#undef PG8_BAR
#undef PG8_SCHED
}
}

#define LAS __attribute__((address_space(3)))
typedef unsigned short bf16_t;
typedef short bf16x8 __attribute__((ext_vector_type(8)));
typedef short s16x4 __attribute__((ext_vector_type(4)));
typedef float f32x4 __attribute__((ext_vector_type(4)));
typedef float f32x16 __attribute__((ext_vector_type(16)));
typedef unsigned u32x4 __attribute__((ext_vector_type(4)));
typedef unsigned u32x2 __attribute__((ext_vector_type(2)));

__device__ __forceinline__ float bf2f(unsigned b) { return __uint_as_float(b << 16); }
__device__ __forceinline__ unsigned f2bf(float f) { unsigned u = __float_as_uint(f); return (u + 0x7fffu + ((u >> 16) & 1u)) >> 16; }
typedef float f32x2_t __attribute__((ext_vector_type(2))); typedef __bf16 bf16x2_t __attribute__((ext_vector_type(2)));
__device__ __forceinline__ unsigned pk2(float lo, float hi) { const f32x2_t v = {lo, hi}; const bf16x2_t b = __builtin_convertvector(v, bf16x2_t); return __builtin_bit_cast(unsigned, b); }
__device__ __forceinline__ float sigm(float x) { return 1.0f / (1.0f + __expf(-x)); }
__device__ __forceinline__ f32x4 up4(u32x2 v) { return (f32x4){__uint_as_float(v.x << 16), __uint_as_float(v.x & 0xffff0000u), __uint_as_float(v.y << 16), __uint_as_float(v.y & 0xffff0000u)}; }
__device__ __forceinline__ u32x2 dn4(f32x4 v) { u32x2 r; r.x = pk2(v.x, v.y); r.y = pk2(v.z, v.w); return r; }
__device__ __forceinline__ float dot4(f32x4 a, f32x4 b) { return (a.x * b.x + a.y * b.y) + (a.z * b.z + a.w * b.w); }

constexpr size_t MiB = 1u << 20;
constexpr size_t WS_CTL = 0, CTL_ZERO_BYTES = 2 * MiB;
constexpr size_t WS_STAT = 1 * MiB;
constexpr size_t WS_CS = 2 * MiB;
constexpr size_t WS_W = 4 * MiB;
constexpr size_t W_IN = 0, W_LORA = W_IN + (size_t)PC * 1024 * 2, W_Q = W_LORA + 1536 * 256 * 2, W_KV = W_Q + 768 * 256 * 2,
                 W_OA = W_KV + 1024 * 256 * 2, W_OB = W_OA + 1024 * 512 * 2, W_OUT = W_OB + 1024 * 512 * 2,
                 W_UP = W_OUT + 1024 * 1024 * 2, W_DOWN = W_UP + (size_t)2 * FF * 1024 * 2, W_END = W_DOWN + (size_t)1024 * FF * 2;
static_assert(W_END <= 31 * MiB, "weights region");
constexpr size_t WS_ACT = 35 * MiB;
constexpr size_t A_HB = WS_ACT + 0 * MiB;
constexpr size_t A_RKV = WS_ACT + 32 * MiB;
constexpr size_t A_LORAC = WS_ACT + 80 * MiB;
constexpr size_t A_QP = A_LORAC;
constexpr size_t A_PM = WS_ACT + 88 * MiB;
constexpr size_t A_Y = A_PM;
constexpr size_t A_LIN = WS_ACT + 104 * MiB;
constexpr size_t A_KPE = WS_ACT + 112 * MiB;
constexpr size_t WS_SCAL = WS_ACT + 113 * MiB;
constexpr size_t A_LW = WS_ACT + 114 * MiB;
constexpr size_t A_YA = A_LW;
constexpr size_t A_ICLR = WS_ACT + 130 * MiB;
constexpr size_t A_GATE = WS_ACT + 146 * MiB;
constexpr size_t A_MERGED = A_ICLR;
constexpr size_t A_QN = WS_ACT + 162 * MiB;
constexpr size_t A_KN = WS_ACT + 178 * MiB;
constexpr size_t A_VT = WS_ACT + 194 * MiB;
constexpr size_t A_TMP = WS_ACT + 32 * MiB;
constexpr size_t A_UG = WS_ACT + 32 * MiB;
constexpr size_t A_ACT = WS_ACT + 120 * MiB;
constexpr size_t DO_MTREC = 32 * MiB, MTREC_B = 2304, DO_HALO = DO_MTREC + (size_t)8192 * MTREC_B;
static_assert(DO_HALO + (size_t)(M / 16) * 1536 * 2 <= 64 * MiB, "d_out scratch map");
constexpr size_t WS_SSP = WS_ACT + 210 * MiB;
constexpr size_t WS_SSQP = WS_SSP + 5 * MiB;
constexpr size_t WS_END = WS_SSQP + 1 * MiB;
static_assert(A_UG + (size_t)M * FF * 2 <= A_ACT && A_ACT + (size_t)M * FF * 2 <= WS_SSP && WS_END <= 256 * MiB, "workspace map");
static_assert(A_ICLR == A_LW + (size_t)M * 512 * 2 && A_GATE == A_ICLR + (size_t)M * 512 * 2, "LW | ICLR | GATE consecutive");
constexpr int CW_BAR = 4096, CW_QUEUE = 16384;

#define XB_TMO      128
#define XB_XCNT(j)  (256  + 64 * (j))
#define XB_XSUB(j)  (1280 + 64 * (j))
#define XB_XGEN(j)  (2304 + 64 * (j))
#define XB_TOP      3328
#define XB_TOPGEN   3392
#define XCD_BAR_WORDS 3456
#define XB_SPIN_CAP (1u << 18)
__device__ __forceinline__ unsigned xb_ld(unsigned* p)              { return __hip_atomic_load(p, __ATOMIC_RELAXED, __HIP_MEMORY_SCOPE_AGENT); }
__device__ __forceinline__ unsigned xb_add(unsigned* p, unsigned v) { return __hip_atomic_fetch_add(p, v, __ATOMIC_RELAXED, __HIP_MEMORY_SCOPE_AGENT); }
__device__ __forceinline__ unsigned xb_xcc_id() { return (unsigned)__builtin_amdgcn_s_getreg((3 << 11) | 20) & 0xFu; }
#define XB_SPIN(cond, bar) do { unsigned _sp = 0; while (cond) { __builtin_amdgcn_s_sleep(1); \
    if ((++_sp & 255u) == 0u) { if (xb_ld(&(bar)[XB_TMO])) break; if (_sp > XB_SPIN_CAP) { atomicAdd(&(bar)[XB_TMO], 1u); break; } } } } while (0)
struct XcdBarrier { unsigned* bar; unsigned x; volatile LAS unsigned* st; };
__device__ __forceinline__ XcdBarrier xcd_barrier_post(unsigned* bar, volatile LAS unsigned* st) {
    XcdBarrier b; b.bar = bar; b.x = xb_xcc_id(); b.st = st;
    if (vtid() == 0) (void)xb_add(&bar[XB_XCNT(b.x)], 1u);
    return b;
}
__device__ __forceinline__ void xcd_barrier_complete(unsigned* bar, unsigned x, unsigned& nloc, unsigned& nx) {
    const unsigned G = gridDim.x * gridDim.y * gridDim.z;
    unsigned sum, cnt, mine, sp = 0u;
    for (;;) {
        sum = 0u; cnt = 0u; mine = 0u;
#pragma unroll
        for (unsigned j = 0; j < 16; ++j) { const unsigned c = xb_ld(&bar[XB_XCNT(j)]); sum += c; cnt += (c > 0u) ? 1u : 0u; mine = (j == x) ? c : mine; }
        if (sum == G) break;
        __builtin_amdgcn_s_sleep(1);
        if ((++sp & 255u) == 0u) { if (xb_ld(&bar[XB_TMO])) break; if (sp > XB_SPIN_CAP) { atomicAdd(&bar[XB_TMO], 1u); break; } }
    }
    nloc = mine > 0u ? mine : 1u; nx = cnt > 0u ? cnt : 1u;
}
__device__ __forceinline__ void xcd_barrier(const XcdBarrier& b) {
    asm volatile("s_waitcnt vmcnt(0)" ::: "memory");
    __syncthreads();
    if (vtid() == 0) {
        unsigned* bar = b.bar;
        __builtin_amdgcn_s_waitcnt(0);
        unsigned nloc = b.st[0], nx = b.st[1];
        if (nloc == 0u) { xcd_barrier_complete(bar, b.x, nloc, nx); b.st[0] = nloc; b.st[1] = nx; }
        const unsigned old = xb_add(&bar[XB_XSUB(b.x)], 1u);
        const unsigned gen = old / nloc;
        if (old + 1u == (gen + 1u) * nloc) {
            __builtin_amdgcn_fence(__ATOMIC_RELEASE, "agent");
            asm volatile("s_waitcnt vmcnt(0)" ::: "memory");
            const unsigned og = xb_add(&bar[XB_TOP], 1u);
            const unsigned tg = og / nx;
            if (og + 1u == (tg + 1u) * nx) xb_add(&bar[XB_TOPGEN], 1u);
            else XB_SPIN(xb_ld(&bar[XB_TOPGEN]) == tg, bar);
            __builtin_amdgcn_fence(__ATOMIC_ACQUIRE, "agent");
            xb_add(&bar[XB_XGEN(b.x)], 1u);
            asm volatile("s_waitcnt vmcnt(0)" ::: "memory");
        } else {
            XB_SPIN(xb_ld(&bar[XB_XGEN(b.x)]) == gen, bar);
            __builtin_amdgcn_fence(__ATOMIC_ACQUIRE, "agent");
            asm volatile("s_waitcnt vmcnt(0)" ::: "memory");
        }
    }
    __syncthreads();
}

namespace pg8 {
__device__ __forceinline__ float sum16(const float* p) { const f32x4 a = *(const f32x4*)p, b = *(const f32x4*)(p + 4), c = *(const f32x4*)(p + 8), d = *(const f32x4*)(p + 12);
    return (((a.x + a.y) + (a.z + a.w)) + ((b.x + b.y) + (b.z + b.w))) + (((c.x + c.y) + (c.z + c.w)) + ((d.x + d.y) + (d.z + d.w))); }
__device__ __forceinline__ float sum4(const float* p) { const f32x4 a = *(const f32x4*)p; return (a.x + a.y) + (a.z + a.w); }
__device__ __forceinline__ u32x4 pack8(f32x4 a, f32x4 b) { u32x4 w; w.x = cvt_pk_bf16(a[0], a[1]); w.y = cvt_pk_bf16(a[2], a[3]); w.z = cvt_pk_bf16(b[0], b[1]); w.w = cvt_pk_bf16(b[2], b[3]); return w; }
__device__ __forceinline__ unsigned q8(float s) { return (unsigned)(s * 255.0f + 0.5f); }
__device__ __forceinline__ unsigned sig8x4(f32x4 v) { return q8(sigm(v[0])) | (q8(sigm(v[1])) << 8) | (q8(sigm(v[2])) << 16) | (q8(sigm(v[3])) << 24); }

constexpr int RS_OFF = 131072 + 1024;
#ifndef NT_STORES
#define NT_STORES 0
#endif
#ifndef NT_STORES8
#define NT_STORES8 0
#endif
__device__ __forceinline__ void ST16(bf16_t* p, u32x4 v) {
    if (NT_STORES == 1) __builtin_nontemporal_store(v, (u32x4*)p);
    else if (NT_STORES == 2) asm volatile("global_store_dwordx4 %0, %1, off sc1\n\ts_nop 1" :: "v"(p), "v"(v) : "memory");
    else if (NT_STORES == 3) asm volatile("global_store_dwordx4 %0, %1, off sc0 sc1\n\ts_nop 1" :: "v"(p), "v"(v) : "memory");
    else *(u32x4*)p = v; }
#ifndef NT_UP
#define NT_UP 1
#endif
__device__ __forceinline__ void ST16W(bf16_t* p, u32x4 v) { if (NT_UP) asm volatile("global_store_dwordx4 %0, %1, off sc1\n\ts_nop 1" :: "v"(p), "v"(v) : "memory"); else *(u32x4*)p = v; }
__device__ __forceinline__ void ST8W(void* p, u32x2 v) { asm volatile("global_store_dwordx2 %0, %1, off sc1\n\ts_nop 1" :: "v"(p), "v"(v) : "memory"); }
#ifndef SC1_MIX
#define SC1_MIX 0
#endif
#ifndef SC1_RES
#define SC1_RES 0
#endif
#ifndef SC1_QKV
#define SC1_QKV 0
#endif
template <int W> __device__ __forceinline__ void ST16S(bf16_t* p, u32x4 v) { if (W) asm volatile("global_store_dwordx4 %0, %1, off sc1\n\ts_nop 1" :: "v"(p), "v"(v) : "memory"); else *(u32x4*)p = v; }
template <int W> __device__ __forceinline__ void ST8S(bf16_t* p, u32x2 v) { if (W) asm volatile("global_store_dwordx2 %0, %1, off sc1\n\ts_nop 1" :: "v"(p), "v"(v) : "memory"); else *(u32x2*)p = v; }
__device__ __forceinline__ void ST8(bf16_t* p, u32x2 v) {
    if (NT_STORES8 == 2) asm volatile("global_store_dwordx2 %0, %1, off sc1\n\ts_nop 1" :: "v"(p), "v"(v) : "memory");
    else *(u32x2*)p = v; }
template <int NS> __device__ __forceinline__ void rs_to_lds(PG8_LAS float* rsl, const float* ss, int pm, float inv_n, float mul, int tid) {
    if (tid < 256) { const float* p = ss + (size_t)(pm * BM + tid) * NS; const float s_ = NS == 16 ? sum16(p) : sum4(p); rsl[tid] = rsqrtf(s_ * inv_n + NORM_EPS) * mul; }
    asm volatile("s_waitcnt lgkmcnt(0)" ::: "memory"); __builtin_amdgcn_s_barrier();
}
struct EpiP {
    static constexpr bool PERM = true, AFTER_DRAIN = false;
    bf16_t* RKV; bf16_t* LORAC; bf16_t* PMb; unsigned char* G8; const float* ss; float* ssq; float* sskv; bf16_t* HALO; PG8_LAS float* rsl; int pn0;
    __device__ __forceinline__ void operator()(const f32x4 (&acc)[2][2][4][2], const Unit& u, int wr, int wc, int fr, int fq) const {
        const int row0 = u.pm * BM + wr * 64 + fr, pn = u.pn + pn0;
        rs_to_lds<16>(rsl, ss, u.pm, 1.0f / 1024.0f, 1.0f, (wr * 4 + wc) * 64 + fq * 16 + fr);
#pragma unroll
        for (int ai = 0; ai < 2; ++ai)
#pragma unroll
            for (int m = 0; m < 4; ++m) {
                const int row = row0 + ai * HALF + m * 16;
                const float rs = rsl[wr * 64 + ai * HALF + m * 16 + fr];
                float sq = 0.f;
#pragma unroll
                for (int bj = 0; bj < 2; ++bj) {
                    const f32x4 v0 = acc[ai][bj][m][0] * rs, v1 = acc[ai][bj][m][1] * rs;
                    const int ct = bj * HALF + wc * 32 + 8 * fq;
                    if (pn < 6) { const u32x4 pk_ = pack8(v0, v1); ST16(RKV + (size_t)row * 1536 + pn * 256 + ct, pk_); if (fr == 15) *(u32x4*)(HALO + (size_t)(row >> 4) * 1536 + pn * 256 + ct) = pk_; }
                    else if (pn == 6) ST16(LORAC + (size_t)row * 256 + ct, pack8(v0, v1));
                    else if (pn < 9) { ST16(PMb + (size_t)row * 512 + (pn - 7) * 256 + ct, pack8(v0, v1));
                        if (pn == 7 || bj == 0) sq += dot4(v0, v0) + dot4(v1, v1); }
                    else { u32x2 w; w.x = sig8x4(v0); w.y = sig8x4(v1); ST8((bf16_t*)(G8 + (size_t)row * 2048 + (pn - 9) * 256 + ct), w); }
                }
                if (pn == 7 || pn == 8) { sq += shx(sq, 16); sq += shx(sq, 32); if (fq == 0) (pn == 7 ? ssq : sskv)[(size_t)row * 4 + wc] = sq; }
            }
    }
};
#ifndef LW_CUM
#define LW_CUM 1
#endif
template <int CTRL> __device__ __forceinline__ float dppz(float x) { return __builtin_bit_cast(float, __builtin_amdgcn_update_dpp(0, __builtin_bit_cast(int, x), CTRL, 0xf, 0xf, true)); }
__device__ __forceinline__ float pfx16(float x) { x += dppz<0x111>(x); x += dppz<0x112>(x); x += dppz<0x114>(x); x += dppz<0x118>(x); return x; }
struct EpiLora {
    static constexpr bool PERM = true, AFTER_DRAIN = false;
    bf16_t* LW; bf16_t* ICLR; bf16_t* GATE; const float* dbase; const float* ibase;
    __device__ __forceinline__ void operator()(const f32x4 (&acc)[2][2][4][2], const Unit& u, int wr, int wc, int fr, int fq) const {
        const int pn = u.pn, kind = pn >> 1;
        bf16_t* dst = LW + (size_t)kind * ((size_t)M * 512);
        const float* bias = kind == 0 ? dbase : ibase;
        const unsigned c0 = (pn & 1) * 256 + wc * 32 + 8 * fq;
        const unsigned off0 = (unsigned)(u.pm * BM + wr * 64 + fr) * 512u + c0;
#pragma unroll
        for (int bj = 0; bj < 2; ++bj) {
            f32x4 b0 = (f32x4){0.f, 0.f, 0.f, 0.f}, b1 = b0;
            if (kind < 2) { b0 = *(const f32x4*)(bias + c0 + bj * HALF); b1 = *(const f32x4*)(bias + c0 + bj * HALF + 4); }
#pragma unroll
            for (int ai = 0; ai < 2; ++ai)
#pragma unroll
                for (int m = 0; m < 4; ++m) {
                    f32x4 v0 = acc[ai][bj][m][0] + b0, v1 = acc[ai][bj][m][1] + b1;
                    if (kind == 0) { for (int e = 0; e < 4; ++e) { v0[e] = -0.6065306597126334f * sigm(v0[e]); v1[e] = -0.6065306597126334f * sigm(v1[e]); }
                        if (LW_CUM) { for (int e = 0; e < 4; ++e) { v0[e] = __expf(pfx16(v0[e])); v1[e] = __expf(pfx16(v1[e])); } } }
                    else if (kind == 1) { for (int e = 0; e < 4; ++e) { v0[e] = sigm(v0[e]); v1[e] = sigm(v1[e]); } }
                    ST16(dst + off0 + (unsigned)((ai * HALF + m * 16) * 512 + bj * HALF), pack8(v0, v1));
                    asm volatile("" ::: "memory");
                }
        }
    }
};
struct EpiQ {
    static constexpr bool PERM = false, AFTER_DRAIN = false;
    bf16_t* Qn; bf16_t* Qp; const float* ssq; const float* CS; PG8_LAS float* rsl;
    __device__ __forceinline__ void operator()(const f32x4 (&acc)[2][2][4][2], const Unit& u, int wr, int wc, int fr, int fq) const {
        const int row0 = u.pm * BM + wr * 64 + fr, pn = u.pn;
        if (pn < 2) {
            rs_to_lds<4>(rsl, ssq, u.pm, 1.0f / 256.0f, C2, (wr * 4 + wc) * 64 + fq * 16 + fr);
#pragma unroll
            for (int ai = 0; ai < 2; ++ai)
#pragma unroll
                for (int m = 0; m < 4; ++m) {
                    const int row = row0 + ai * HALF + m * 16;
                    const float rs = rsl[wr * 64 + ai * HALF + m * 16 + fr];
#pragma unroll
                    for (int bj = 0; bj < 2; ++bj)
#pragma unroll
                        for (int n = 0; n < 2; ++n) ST8S<SC1_QKV>(Qn + (size_t)row * 512 + pn * 256 + bj * HALF + wc * 32 + n * 16 + 4 * fq, dn4(acc[ai][bj][m][n] * rs));
                }
        } else {
            f32x4 cs[2][4], sn[2][4];
#pragma unroll
            for (int ai = 0; ai < 2; ++ai)
#pragma unroll
                for (int m = 0; m < 4; ++m) { const int row = row0 + ai * HALF + m * 16; cs[ai][m] = *(const f32x4*)(CS + (size_t)row * 32 + 4 * fq); sn[ai][m] = *(const f32x4*)(CS + (size_t)row * 32 + 16 + 4 * fq); }
            rs_to_lds<4>(rsl, ssq, u.pm, 1.0f / 256.0f, C2, (wr * 4 + wc) * 64 + fq * 16 + fr);
#pragma unroll
            for (int ai = 0; ai < 2; ++ai)
#pragma unroll
                for (int m = 0; m < 4; ++m) {
                    const int row = row0 + ai * HALF + m * 16;
                    const float rs = rsl[wr * 64 + ai * HALF + m * 16 + fr];
#pragma unroll
                    for (int bj = 0; bj < 2; ++bj) {
                        const f32x4 x1 = acc[ai][bj][m][0] * rs, x2 = acc[ai][bj][m][1] * rs;
                        bf16_t* d = Qp + (size_t)row * 256 + (4 * bj + wc) * 32 + 4 * fq;
                        ST8S<SC1_QKV>(d, dn4(x1 * cs[ai][m] - x2 * sn[ai][m])); ST8S<SC1_QKV>(d + 16, dn4(x1 * sn[ai][m] + x2 * cs[ai][m]));
                    }
                }
        }
    }
};
struct EpiKV {
    static constexpr bool PERM = false, AFTER_DRAIN = false;
    bf16_t* Kn; bf16_t* Vt; const float* sskv; PG8_LAS float* rsl;
    __device__ __forceinline__ void operator()(const f32x4 (&acc)[2][2][4][2], const Unit& u, int wr, int wc, int fr, int fq) const {
        const int row0 = u.pm * BM + wr * 64 + fr, pn = u.pn;
        rs_to_lds<4>(rsl, sskv, u.pm, 1.0f / 128.0f, 1.0f, (wr * 4 + wc) * 64 + fq * 16 + fr);
#pragma unroll
        for (int ai = 0; ai < 2; ++ai)
#pragma unroll
            for (int m = 0; m < 4; ++m) {
                const int row = row0 + ai * HALF + m * 16;
                const float rs = rsl[wr * 64 + ai * HALF + m * 16 + fr];
                if (pn < 2) {
#pragma unroll
                    for (int bj = 0; bj < 2; ++bj)
#pragma unroll
                        for (int n = 0; n < 2; ++n) ST8S<SC1_QKV>(Kn + (size_t)row * 512 + pn * 256 + bj * HALF + wc * 32 + n * 16 + 4 * fq, dn4(acc[ai][bj][m][n] * rs));
                } else {
                    const int b = row >> 12, s = row & 4095;
#pragma unroll
                    for (int bj = 0; bj < 2; ++bj)
#pragma unroll
                        for (int n = 0; n < 2; ++n) {
                            const int hd = (pn - 2) * 4 + 2 * bj + (wc >> 1), d = 32 * (wc & 1) + 16 * n + 4 * fq;
                            const f32x4 v = acc[ai][bj][m][n] * rs;
                            bf16_t* dst = Vt + ((size_t)((b * 8 + hd) * 64 + d) << 12) + s;
#pragma unroll
                            for (int j = 0; j < 4; ++j) dst[(size_t)j << 12] = (bf16_t)f2bf(v[j]);
                        }
                }
            }
    }
};
template <int PASS> struct EpiMix {
    static constexpr bool PERM = true, AFTER_DRAIN = false;
    float* TMP; bf16_t* MERGED; const unsigned char* G8;
    template <int AI> __device__ __forceinline__ void load(u32x2 (&g)[4][2], u32x4 (&t)[4][2], int row0, int c0) const {
#pragma unroll
        for (int m = 0; m < 4; ++m)
#pragma unroll
            for (int bj = 0; bj < 2; ++bj) { const size_t row = (size_t)(row0 + AI * HALF + m * 16); const int c = c0 + bj * HALF;
                g[m][bj] = *(const u32x2*)(G8 + row * 2048 + (PASS - 1) * 1024 + c);
                if (PASS == 2) t[m][bj] = *(const u32x4*)(MERGED + row * 1024 + c); }
    }
    template <int AI> __device__ __forceinline__ void calc(const f32x4 (&acc)[2][2][4][2], const u32x2 (&g)[4][2], u32x4 (&t)[4][2]) const {
#pragma unroll
        for (int m = 0; m < 4; ++m)
#pragma unroll
            for (int bj = 0; bj < 2; ++bj) { const unsigned ga = g[m][bj].x, gb = g[m][bj].y;
                const f32x4 sa = (f32x4){(float)(ga & 255u), (float)((ga >> 8) & 255u), (float)((ga >> 16) & 255u), (float)(ga >> 24)} * (1.0f / 255.0f);
                const f32x4 sb = (f32x4){(float)(gb & 255u), (float)((gb >> 8) & 255u), (float)((gb >> 16) & 255u), (float)(gb >> 24)} * (1.0f / 255.0f);
                f32x4 oa = acc[AI][bj][m][0] * sa, ob = acc[AI][bj][m][1] * sb;
                if (PASS == 2) { oa = oa + up4((u32x2){t[m][bj].x, t[m][bj].y}); ob = ob + up4((u32x2){t[m][bj].z, t[m][bj].w}); }
                const u32x2 pa = dn4(oa), pb = dn4(ob); t[m][bj] = (u32x4){pa.x, pa.y, pb.x, pb.y}; }
    }
    template <int AI> __device__ __forceinline__ void store(const u32x4 (&o)[4][2], int row0, int c0) const {
#pragma unroll
        for (int m = 0; m < 4; ++m)
#pragma unroll
            for (int bj = 0; bj < 2; ++bj) ST16S<SC1_MIX>(MERGED + (size_t)(row0 + AI * HALF + m * 16) * 1024 + c0 + bj * HALF, o[m][bj]);
    }
    __device__ __forceinline__ void operator()(const f32x4 (&acc)[2][2][4][2], const Unit& u, int wr, int wc, int fr, int fq) const {
        const int row0 = u.pm * BM + wr * 64 + fr, c0 = u.pn * BM + wc * 32 + 8 * fq;
        u32x2 g0[4][2], g1[4][2]; u32x4 t0[4][2], t1[4][2];
        load<0>(g0, t0, row0, c0); calc<0>(acc, g0, t0);
        load<1>(g1, t1, row0, c0);
        store<0>(t0, row0, c0);
        calc<1>(acc, g1, t1); store<1>(t1, row0, c0);
    }
};
struct EpiRes {
    static constexpr bool PERM = false, AFTER_DRAIN = false;
    bf16_t* HB; float* ssacc;
    __device__ __forceinline__ void operator()(const f32x4 (&acc)[2][2][4][2], const Unit& u, int wr, int wc, int fr, int fq) const {
        const int row0 = u.pm * BM + wr * 64 + fr, c0 = u.pn * BM + wc * 32 + 4 * fq;
        u32x2 b[2][4][2][2];
#pragma unroll
        for (int ai = 0; ai < 2; ++ai)
#pragma unroll
            for (int m = 0; m < 4; ++m)
#pragma unroll
                for (int bj = 0; bj < 2; ++bj)
#pragma unroll
                    for (int n = 0; n < 2; ++n) b[ai][m][bj][n] = *(const u32x2*)(HB + (size_t)(row0 + ai * HALF + m * 16) * 1024 + c0 + bj * HALF + n * 16);
#pragma unroll
        for (int ai = 0; ai < 2; ++ai)
#pragma unroll
            for (int m = 0; m < 4; ++m) {
                const int row = row0 + ai * HALF + m * 16; float sq = 0.f;
#pragma unroll
                for (int bj = 0; bj < 2; ++bj)
#pragma unroll
                    for (int n = 0; n < 2; ++n) {
                        const u32x2 p = dn4(up4(b[ai][m][bj][n]) + acc[ai][bj][m][n]); const f32x4 v = up4(p);
                        ST8S<SC1_RES>(HB + (size_t)row * 1024 + c0 + bj * HALF + n * 16, p); sq += dot4(v, v);
                    }
                sq += shx(sq, 16); sq += shx(sq, 32);
                if (fq == 0) ssacc[(size_t)row * 16 + u.pn * 4 + wc] = sq;
            }
    }
};
typedef float f32x2 __attribute__((ext_vector_type(2)));
__device__ __forceinline__ f32x2 gelu_pk2(f32x2 v) {
    const f32x2 av = __builtin_elementwise_abs(v), d = av * 0.2316418882f + 1.0f;
    f32x2 t; t.x = __builtin_amdgcn_rcpf(d.x); t.y = __builtin_amdgcn_rcpf(d.y);
    f32x2 q = t * 0.5307027145f + (-0.7265760135f); q = q * t + 0.7107068705f; q = q * t + (-0.142248368f); q = q * t + 0.127414796f; q = q * t;
    const f32x2 s2 = (v * v) * (-0.72134752044f);
    f32x2 e; e.x = __builtin_amdgcn_exp2f(s2.x); e.y = __builtin_amdgcn_exp2f(s2.y);
    const f32x2 m = v * (q * e), r = v - m;
    f32x2 o; o.x = v.x < 0.f ? m.x : r.x; o.y = v.y < 0.f ? m.y : r.y; return o;
}
__device__ __forceinline__ f32x4 gelu4(f32x4 c) { const f32x2 g0 = gelu_pk2((f32x2){c.x, c.y}), g1 = gelu_pk2((f32x2){c.z, c.w}); return (f32x4){g0.x, g0.y, g1.x, g1.y}; }
template <int CTRL> __device__ __forceinline__ f32x4 ror4(f32x4 x) { f32x4 r;
#pragma unroll
    for (int e = 0; e < 4; ++e) { const float xe = x[e]; const int xi = __builtin_bit_cast(int, xe); r[e] = __builtin_bit_cast(float, __builtin_amdgcn_update_dpp(xi, xi, CTRL, 0xf, 0xf, false)); }
    return r; }
struct EpiUp {
    static constexpr bool PERM = true, AFTER_DRAIN = false;
    bf16_t* ACT; bf16_t* RAWH; const float* ss; const float* cw; const float* cb; PG8_LAS float* rsl;
    __device__ __forceinline__ void operator()(const f32x4 (&acc)[2][2][4][2], const Unit& u, int wr, int wc, int fr, int fq) const {
        const int tid = (wr * 4 + wc) * 64 + fq * 16 + fr, row0 = u.pm * BM + wr * 64 + fr;
        PG8_LAS float* wl = rsl + 256;
        if (tid >= 256 && tid < 384) { const int j = tid - 256, cg = u.pn * HALF + j; wl[j] = cw[cg]; wl[128 + j] = cw[FF + cg]; wl[256 + j] = cw[2 * FF + cg]; wl[384 + j] = cb[cg]; }
        rs_to_lds<16>(rsl, ss, u.pm, 1.0f / 1024.0f, 1.0f, tid);
        const int cl = wc * 32 + 8 * fq, cgl = u.pn * HALF + cl;
#pragma unroll
        for (int ai = 0; ai < 2; ++ai) {
            f32x4 q1a, q1b, q2a, q2b;
#pragma unroll
            for (int m = 0; m < 4; ++m) {
                const int row = row0 + ai * HALF + m * 16;
                const float rs = rsl[wr * 64 + ai * HALF + m * 16 + fr];
                const PG8_LAS float* wp = wl + cl; asm volatile("" : "+v"(wp));
                const f32x4 w0a = *(const PG8_LAS f32x4*)(wp), w0b = *(const PG8_LAS f32x4*)(wp + 4), w1a = *(const PG8_LAS f32x4*)(wp + 128), w1b = *(const PG8_LAS f32x4*)(wp + 128 + 4);
                const f32x4 w2a = *(const PG8_LAS f32x4*)(wp + 256), w2b = *(const PG8_LAS f32x4*)(wp + 256 + 4), ba = *(const PG8_LAS f32x4*)(wp + 384), bb = *(const PG8_LAS f32x4*)(wp + 384 + 4);
                const f32x4 xa = acc[ai][0][m][0] * rs, xb = acc[ai][0][m][1] * rs, va = acc[ai][1][m][0] * rs, vb = acc[ai][1][m][1] * rs;
                const f32x4 r1a = ror4<0x121>(xa), r1b = ror4<0x121>(xb), r2a = ror4<0x122>(xa), r2b = ror4<0x122>(xb);
                f32x4 p1a = r1a, p1b = r1b, p2a = r2a, p2b = r2b;
                if (m > 0) { if (fr < 1) { p1a = q1a; p1b = q1b; } if (fr < 2) { p2a = q2a; p2b = q2b; } }
                const f32x4 ga = gelu4(ba + w0a * p2a + w1a * p1a + w2a * xa), gb = gelu4(bb + w0b * p2b + w1b * p1b + w2b * xb);
                if (m > 0 || fr >= 2) ST16W(ACT + (size_t)row * FF + cgl, pack8(ga * va, gb * vb));
                if (m == 0) { if (fr < 2) { bf16_t* hp = RAWH + ((size_t)(row >> 6) * 6 + 2 + fr) * FF + cgl; *(u32x4*)hp = pack8(xa, xb); *(u32x4*)(hp + 2 * FF) = pack8(va, vb); } }
                if (m == 3) { if (fr >= 14) *(u32x4*)(RAWH + ((size_t)(row >> 6) * 6 + (fr - 14)) * FF + cgl) = pack8(xa, xb); }
                q1a = r1a; q1b = r1b; q2a = r2a; q2b = r2b;
            }
        }
    }
};
struct EpiUpG {
    static constexpr bool PERM = true, AFTER_DRAIN = false;
    bf16_t* UG; const float* ss; PG8_LAS float* rsl;
    __device__ __forceinline__ void operator()(const f32x4 (&acc)[2][2][4][2], const Unit& u, int wr, int wc, int fr, int fq) const {
        const int row0 = u.pm * BM + wr * 64 + fr;
        rs_to_lds<16>(rsl, ss, u.pm, 1.0f / 1024.0f, 1.0f, (wr * 4 + wc) * 64 + fq * 16 + fr);
#pragma unroll
        for (int ai = 0; ai < 2; ++ai)
#pragma unroll
            for (int m = 0; m < 4; ++m) {
                const int row = row0 + ai * HALF + m * 16;
                const float rs = rsl[wr * 64 + ai * HALF + m * 16 + fr];
#pragma unroll
                for (int bj = 0; bj < 2; ++bj) ST16(UG + (size_t)row * FF + u.pn * BM + bj * HALF + wc * 32 + 8 * fq, pack8(acc[ai][bj][m][0] * rs, acc[ai][bj][m][1] * rs));
            }
    }
};
struct EpiUpV {
    static constexpr bool PERM = true, AFTER_DRAIN = false;
    bf16_t* ACT; const float* ss; PG8_LAS float* rsl;
    __device__ __forceinline__ void operator()(const f32x4 (&acc)[2][2][4][2], const Unit& u, int wr, int wc, int fr, int fq) const {
        const int row0 = u.pm * BM + wr * 64 + fr, c0 = u.pn * BM + wc * 32 + 8 * fq;
        u32x4 gc[2][4][2];
#pragma unroll
        for (int ai = 0; ai < 2; ++ai)
#pragma unroll
            for (int m = 0; m < 4; ++m)
#pragma unroll
                for (int bj = 0; bj < 2; ++bj) gc[ai][m][bj] = *(const u32x4*)(ACT + (size_t)(row0 + ai * HALF + m * 16) * FF + c0 + bj * HALF);
        rs_to_lds<16>(rsl, ss, u.pm, 1.0f / 1024.0f, 1.0f, (wr * 4 + wc) * 64 + fq * 16 + fr);
#pragma unroll
        for (int ai = 0; ai < 2; ++ai)
#pragma unroll
            for (int m = 0; m < 4; ++m) {
                const int row = row0 + ai * HALF + m * 16;
                const float rs = rsl[wr * 64 + ai * HALF + m * 16 + fr];
#pragma unroll
                for (int bj = 0; bj < 2; ++bj) { const u32x4 g = gc[ai][m][bj];
                    *(u32x4*)(ACT + (size_t)row * FF + c0 + bj * HALF) = pack8(up4((u32x2){g.x, g.y}) * (acc[ai][bj][m][0] * rs), up4((u32x2){g.z, g.w}) * (acc[ai][bj][m][1] * rs)); }
            }
    }
};
}


#ifndef NAIVE_GEMM
#define NAIVE_GEMM 0
#endif
#ifndef NAIVE_ATTN
#define NAIVE_ATTN 0
#endif
#ifndef SHFL_SCAN
#define SHFL_SCAN 0
#endif
namespace pg8 {
template <class Epi, class Sched>
__device__ __forceinline__ void gemm_phase_naive(const Gemm g, const Sched& S, const Epi& E) {
    const int tid = vtid(), wid = tid >> 6, lane = tid & 63, wr = wid >> 2, wc = wid & 3, fr = lane & 15, fq = lane >> 4;
    Unit u;
    for (int i = 0; S.next(i, u); ++i) {
        f32x4 acc[2][2][4][2];
        _Pragma("unroll") for (int a = 0; a < 2; ++a) _Pragma("unroll") for (int b = 0; b < 2; ++b) _Pragma("unroll") for (int m = 0; m < 4; ++m) _Pragma("unroll") for (int n = 0; n < 2; ++n) {
            const int row = u.pm * BM + a * HALF + wr * 64 + m * 16 + fr;
            _Pragma("unroll") for (int j = 0; j < 4; ++j) {
                const int col = u.pn * BM + b * HALF + wc * 32 + (Epi::PERM ? 8 * fq + 4 * n + j : 16 * n + 4 * fq + j);
                const bf16_t* ap = g.A + (size_t)row * g.lda; const bf16_t* bp = g.Bt + (size_t)col * g.K;
                float s = 0.f;
                _Pragma("unroll 1") for (int k = 0; k < g.K; k += 8) {
                    const u32x4 av = *(const u32x4*)(ap + k), bv = *(const u32x4*)(bp + k);
                    for (int e = 0; e < 4; ++e) { s += __uint_as_float(av[e] << 16) * __uint_as_float(bv[e] << 16); s += __uint_as_float(av[e] & 0xffff0000u) * __uint_as_float(bv[e] & 0xffff0000u); }
                }
                acc[a][b][m][n][j] = s;
            }
        }
        E(acc, u, wr, wc, fr, fq);
    }
}
}
#if NAIVE_GEMM
#define GEMM_PHASE(EPI, lds, g, S, E) pg8::gemm_phase_naive<EPI, pg8::StaticOrder>(g, S, E)
#else
#define GEMM_PHASE(EPI, lds, g, S, E) pg8::gemm_phase<EPI, pg8::StaticOrder, true, true>(lds, g, S, E)
#endif
struct Args {
    const float* in[28]; float* out; unsigned char* ws; int ph_lo, ph_hi;
};
enum { I_X = 0, I_POS, I_ATTN_NORM, I_W_IN, I_MU, I_DBASE, I_W_DEC, I_IBASE, I_W_ICLR, I_W_GATE, I_KK, I_KA, I_RK, I_LNXW, I_LNXB, I_W_ORWKV, I_QNORM, I_W_QUP,
       I_KVNORM, I_W_KVUP, I_W_OMLA, I_W_OUT, I_FFN_NORM, I_W_UP, I_CONVW, I_CONVB, I_W_DOWN, I_FINAL };

typedef const __attribute__((address_space(4))) Args* ArgsP;
__device__ __forceinline__ ArgsP args_ptr() { ArgsP p = (ArgsP)__builtin_amdgcn_kernarg_segment_ptr(); asm volatile("" : "+s"(p)); return p; }
__device__ __forceinline__ int ltid() { int t = vtid(); asm volatile("" : "+v"(t)); return t; }
constexpr int NWAVES = 8, NTHREADS = 512;
constexpr int RING_BYTES = 131072, MISC_OFF = RING_BYTES + 320, LDS_BYTES = 147456;

struct WDesc { const float* W; const float* scale; bf16_t* dst; int N, k0, n0, mode, roff, ldk, koff; };
__device__ __forceinline__ void tr_load(const WDesc& d, f32x4 (&v)[8], int lane) {
    const int kq = lane >> 4, n4 = (lane & 15) * 4;
#pragma unroll
    for (int i = 0; i < 8; ++i) v[i] = (d.n0 + n4 < d.N) ? *(const f32x4*)(d.W + (size_t)(d.k0 + kq + 4 * i) * d.N + d.n0 + n4) : (f32x4){0.f, 0.f, 0.f, 0.f};
}
__device__ __forceinline__ void tr_store(const WDesc& d, const f32x4 (&v)[8], LAS float* scr, int lane) {
    const int kq = lane >> 4, n4 = (lane & 15) * 4;
#pragma unroll
    for (int i = 0; i < 8; ++i) { const int kk = kq + 4 * i; f32x4 x = v[i]; if (d.scale) x = x * d.scale[d.k0 + kk];
        LAS float* p = scr + kk * 65 + n4; p[0] = x.x; p[1] = x.y; p[2] = x.z; p[3] = x.w; }
    asm volatile("s_waitcnt lgkmcnt(0)" ::: "memory");
    const LAS float* s = scr + lane;
    const int n = d.n0 + lane, mode = d.mode;
    int drow = n;
    if (mode == 1) drow = n < 2208 ? n : n + 96;
    else if (mode == 2) { const int h = n / 96, j = n % 96; drow = j < 64 ? h * 64 + j : 512 + h * 32 + (j - 64); }
    else if (mode == 3) { const int h = n >> 7, j = n & 127; drow = j < 64 ? h * 64 + j : 512 + h * 64 + (j - 64); }
    else if (mode == 4) { const int v_ = n < FF ? n : n - FF; drow = (v_ >> 7) * 256 + (n < FF ? 0 : 128) + (v_ & 127); }
    bf16_t* o_ = d.dst + (size_t)(drow + d.roff) * d.ldk + d.koff + d.k0;
    if (n < d.N)
#pragma unroll
    for (int c = 0; c < 4; ++c) { u32x4 o; o.x = pk2(s[(8 * c + 0) * 65], s[(8 * c + 1) * 65]); o.y = pk2(s[(8 * c + 2) * 65], s[(8 * c + 3) * 65]); o.z = pk2(s[(8 * c + 4) * 65], s[(8 * c + 5) * 65]); o.w = pk2(s[(8 * c + 6) * 65], s[(8 * c + 7) * 65]);
        *(u32x4*)(o_ + 8 * c) = o; }
    asm volatile("s_waitcnt lgkmcnt(0)" ::: "memory");
}
__device__ __forceinline__ void phase_weights(ArgsP a, int l, LAS unsigned char* lds) {
    a = args_ptr();
    const int tid = ltid(), lane = tid & 63, wave = tid >> 6;
    const int gw = blockIdx.x * NWAVES + wave, NGW = gridDim.x * NWAVES;
    LAS float* scr = (LAS float*)(lds + wave * 16384);
    unsigned char* wb = a->ws + WS_W;
    bf16_t* Wt_in = (bf16_t*)(wb + W_IN); bf16_t* Wt_lora = (bf16_t*)(wb + W_LORA); bf16_t* Wt_q = (bf16_t*)(wb + W_Q); bf16_t* Wt_kv = (bf16_t*)(wb + W_KV);
    bf16_t* Wt_oa = (bf16_t*)(wb + W_OA); bf16_t* Wt_ob = (bf16_t*)(wb + W_OB); bf16_t* Wt_out = (bf16_t*)(wb + W_OUT); bf16_t* Wt_up = (bf16_t*)(wb + W_UP); bf16_t* Wt_down = (bf16_t*)(wb + W_DOWN);
    constexpr int I_IN = 32 * 67, I_DEC = 2 * 8, I_ICL = 2 * 8, I_GAT = 4 * 8, I_Q = 8 * 12, I_KV = 4 * 16, I_OA = 16 * 16, I_OB = 16 * 16, I_OUT = 32 * 16, I_UP = 32 * 88, I_DN = 88 * 16;
    constexpr int NITEMS = I_IN + I_DEC + I_ICL + I_GAT + I_Q + I_KV + I_OA + I_OB + I_OUT + I_UP + I_DN;
    auto decode = [&](int it) { WDesc d; int r = it, kb, nb; d.scale = nullptr; d.mode = 0; d.roff = 0; d.koff = 0;
        if (r < I_IN) { kb = r / 67; nb = r % 67; d.W = a->in[I_W_IN] + (size_t)l * 1024 * IN_COLS; d.N = IN_COLS; d.dst = Wt_in; d.mode = 1; d.ldk = 1024; d.scale = a->in[I_ATTN_NORM] + l * 1024; }
        else if ((r -= I_IN) < I_DEC) { kb = r / 8; nb = r % 8; d.W = a->in[I_W_DEC] + (size_t)l * 64 * 512; d.N = 512; d.dst = Wt_lora; d.ldk = 256; }
        else if ((r -= I_DEC) < I_ICL) { kb = r / 8; nb = r % 8; d.W = a->in[I_W_ICLR] + (size_t)l * 64 * 512; d.N = 512; d.dst = Wt_lora; d.roff = 512; d.ldk = 256; d.koff = 64; }
        else if ((r -= I_ICL) < I_GAT) { kb = r / 8; nb = r % 8; d.W = a->in[I_W_GATE] + (size_t)l * 128 * 512; d.N = 512; d.dst = Wt_lora; d.roff = 1024; d.ldk = 256; d.koff = 128; }
        else if ((r -= I_GAT) < I_Q) { kb = r / 12; nb = r % 12; d.W = a->in[I_W_QUP] + (size_t)l * 256 * 768; d.N = 768; d.dst = Wt_q; d.mode = 2; d.ldk = 256; d.scale = a->in[I_QNORM] + l * 256; }
        else if ((r -= I_Q) < I_KV) { kb = r / 16; nb = r % 16; d.W = a->in[I_W_KVUP] + (size_t)l * 128 * 1024; d.N = 1024; d.dst = Wt_kv; d.mode = 3; d.ldk = 256; d.scale = a->in[I_KVNORM] + l * 128; }
        else if ((r -= I_KV) < I_OA) { kb = r / 16; nb = r % 16; d.W = a->in[I_W_ORWKV] + (size_t)l * 512 * 1024; d.N = 1024; d.dst = Wt_oa; d.ldk = 512; }
        else if ((r -= I_OA) < I_OB) { kb = r / 16; nb = r % 16; d.W = a->in[I_W_OMLA] + (size_t)l * 512 * 1024; d.N = 1024; d.dst = Wt_ob; d.ldk = 512; }
        else if ((r -= I_OB) < I_OUT) { kb = r / 16; nb = r % 16; d.W = a->in[I_W_OUT] + (size_t)l * 1024 * 1024; d.N = 1024; d.dst = Wt_out; d.ldk = 1024; }
        else if ((r -= I_OUT) < I_UP) { kb = r / 88; nb = r % 88; d.W = a->in[I_W_UP] + (size_t)l * 1024 * 2 * FF; d.N = 2 * FF; d.dst = Wt_up; d.mode = 4; d.ldk = 1024; d.scale = a->in[I_FFN_NORM] + l * 1024; }
        else { r -= I_UP; kb = r / 16; nb = r % 16; d.W = a->in[I_W_DOWN] + (size_t)l * FF * 1024; d.N = 1024; d.dst = Wt_down; d.ldk = FF; }
        d.k0 = kb * 32; d.n0 = nb * 64; return d; };
    if (gw < NITEMS) {
        WDesc d0 = decode(gw), d1; f32x4 va[8], vb[8];
        tr_load(d0, va, lane);
#pragma unroll 1
        for (int it = gw; it < NITEMS; it += 2 * NGW) {
            const int i1 = it + NGW, i2 = i1 + NGW;
            d1 = decode(i1 < NITEMS ? i1 : it); tr_load(d1, vb, lane);
            tr_store(d0, va, scr, lane);
            if (i1 >= NITEMS) break;
            d0 = decode(i2 < NITEMS ? i2 : i1); tr_load(d0, va, lane);
            tr_store(d1, vb, scr, lane);
        }
    }
    const int gt = blockIdx.x * NTHREADS + tid, NGT = gridDim.x * NTHREADS;
    unsigned z0_ = 0u; asm volatile("" : "+v"(z0_));
    const u32x4 z = (u32x4){z0_, z0_, z0_, z0_};
    for (int i = gt; i < 96 * 128; i += NGT) *(u32x4*)(Wt_in + (size_t)(2208 + i / 128) * 1024 + (i % 128) * 8) = z;
    for (int i = gt; i < 1536 * 32; i += NGT) { const int row = i / 32, k8 = (i % 32) * 8, kind = row >> 9; const bool live = kind == 0 ? (k8 < 64) : (kind == 1 ? (k8 >= 64 && k8 < 128) : (k8 >= 128)); if (!live) *(u32x4*)(Wt_lora + (size_t)row * 256 + k8) = z; }
    for (int i = gt; i < 1024 * 16; i += NGT) *(u32x4*)(Wt_kv + (size_t)(i / 16) * 256 + 128 + (i % 16) * 8) = z;
#ifdef SCRIBBLE
    if (l == 0) { u32x4* p = (u32x4*)(a->ws + WS_ACT); const u32x4 pz = (u32x4){0xAAAAAAAAu, 0xAAAAAAAAu, 0xAAAAAAAAu, 0xAAAAAAAAu};
        for (unsigned i = gt; i < 178u * 65536u; i += NGT) p[i] = pz; }
#endif
    if (l == 0) {
        float* SS0 = (float*)(a->ws + WS_SSP); bf16_t* HB = (bf16_t*)(a->ws + A_HB);
        for (int m = gw; m < M; m += 2 * NGW) {
            const int m2 = m + NGW;
            const f32x4* xr = (const f32x4*)(a->in[I_X] + (size_t)m * DM) + lane; const f32x4* xr2 = (const f32x4*)(a->in[I_X] + (size_t)(m2 < M ? m2 : m) * DM) + lane;
            f32x4 v1[4], v2[4];
#pragma unroll
            for (int j = 0; j < 4; ++j) { v1[j] = xr[64 * j]; v2[j] = xr2[64 * j]; }
            float s = 0.f, s2 = 0.f;
            u32x2* o = (u32x2*)(HB + (size_t)m * DM) + lane; u32x2* o2p = (u32x2*)(HB + (size_t)m2 * DM) + lane;
#pragma unroll
            for (int j = 0; j < 4; ++j) { s += dot4(v1[j], v1[j]); o[64 * j] = dn4(v1[j]); }
            if (m2 < M) {
#pragma unroll
                for (int j = 0; j < 4; ++j) { s2 += dot4(v2[j], v2[j]); o2p[64 * j] = dn4(v2[j]); } }
#pragma unroll
            for (int o2 = 1; o2 < 64; o2 <<= 1) { s += shx(s, o2); s2 += shx(s2, o2); }
            if (lane < 16) { SS0[(size_t)m * 16 + lane] = lane == 0 ? s : 0.f; if (m2 < M) SS0[(size_t)m2 * 16 + lane] = lane == 0 ? s2 : 0.f; }
        }
        float* CS = (float*)(a->ws + WS_CS); const int* pos = (const int*)a->in[I_POS];
        for (int i = gt; i < M * 16; i += NGT) { const int row = i >> 4, f = i & 15;
            const float invf = exp2f(-0.830482023721841f * (float)f);
            const float ang = (float)pos[row] * invf;
            const float k = rintf(ang * 0.15915494309189535f);
            float rr = fmaf(-k, 6.2831854820251465f, ang); rr = fmaf(-k, -1.7484555314695172e-07f, rr);
            CS[(size_t)row * 32 + f] = cosf(rr); CS[(size_t)row * 32 + 16 + f] = sinf(rr); }
    }
}

__device__ __forceinline__ void phase_prep(ArgsP a, int l) {
    a = args_ptr();
    const unsigned gt = blockIdx.x * NTHREADS + ltid(), NGT = gridDim.x * NTHREADS;
    const bf16_t* LORAC = (const bf16_t*)(a->ws + A_LORAC); bf16_t* LIN = (bf16_t*)(a->ws + A_LIN);
    {
        const int j = (gt & 31) * 8; const float* mu = a->in[I_MU] + (size_t)l * 1792 + 1536 + j;
        const f32x4 m0 = *(const f32x4*)mu, m1 = *(const f32x4*)(mu + 4);
        for (unsigned i = gt; i < (unsigned)M * 32; i += NGT) { const unsigned row = i >> 5; const int t = row & 4095;
            const u32x4 cu = *(const u32x4*)(LORAC + (size_t)row * 256 + j); const u32x4 pv = t ? *(const u32x4*)(LORAC + (size_t)(row - 1) * 256 + j) : (u32x4){0u, 0u, 0u, 0u};
            const f32x4 c0 = up4((u32x2){cu.x, cu.y}), c1 = up4((u32x2){cu.z, cu.w}), q0 = up4((u32x2){pv.x, pv.y}), q1 = up4((u32x2){pv.z, pv.w});
            f32x4 s0 = c0 + (q0 - c0) * m0, s1 = c1 + (q1 - c1) * m1;
            if (j < 64) { for (int e = 0; e < 4; ++e) { s0[e] = tanhf(s0[e]); s1[e] = tanhf(s1[e]); } } else if (j >= 128) { for (int e = 0; e < 4; ++e) { s0[e] = sigm(s0[e]); s1[e] = sigm(s1[e]); } }
            const u32x2 o0 = dn4(s0), o1 = dn4(s1); *(u32x4*)(LIN + (size_t)row * 256 + j) = (u32x4){o0.x, o0.y, o1.x, o1.y}; }
    }
    const bf16_t* PMb = (const bf16_t*)(a->ws + A_PM); bf16_t* KPE = (bf16_t*)(a->ws + A_KPE); const float* CS = (const float*)(a->ws + WS_CS);
    for (unsigned i = gt; i < (unsigned)M * 4; i += NGT) { const unsigned row = i >> 2; const int f = (i & 3) * 4;
        const f32x4 x1 = up4(*(const u32x2*)(PMb + (size_t)row * 512 + 384 + f)), x2 = up4(*(const u32x2*)(PMb + (size_t)row * 512 + 400 + f));
        const f32x4 cs = *(const f32x4*)(CS + (size_t)row * 32 + f), sn = *(const f32x4*)(CS + (size_t)row * 32 + 16 + f);
        *(u32x2*)(KPE + (size_t)row * 32 + f) = dn4(x1 * cs - x2 * sn); *(u32x2*)(KPE + (size_t)row * 32 + 16 + f) = dn4(x1 * sn + x2 * cs); }
}

template <int CTRL> __device__ __forceinline__ float dppf(float x) { return __builtin_bit_cast(float, __builtin_amdgcn_update_dpp(0, __builtin_bit_cast(int, x), CTRL, 0xf, 0xf, false)); }
#if SHFL_SCAN
__device__ __forceinline__ float rr16(float x) { x += shx(x, 8); x += shx(x, 4); x += shx(x, 2); x += shx(x, 1); return x; }
#else
__device__ __forceinline__ float rr16(float x) { x += dppf<0x128>(x); x += dppf<0x124>(x); x += dppf<0x122>(x); x += dppf<0x121>(x); return x; }
#endif

typedef float f32x2 __attribute__((ext_vector_type(2)));
constexpr int SC_BUF = 43008, SC_R = 0, SC_W = 8192, SC_K = 16384, SC_A = 24576, SC_B = 32768, SC_V = 40960, SC_YP = 2 * SC_BUF, SC_YPB = 8192;
struct ScOps { f32x4 a, w, b, k, r; float v; };
__device__ __forceinline__ void sc_ld(ScOps& o, const LAS unsigned char* bp, const LAS unsigned char* vp, int t) {
    o.a = *(const LAS f32x4*)(bp + SC_A + t * 256); o.w = *(const LAS f32x4*)(bp + SC_W + t * 256); o.b = *(const LAS f32x4*)(bp + SC_B + t * 256);
    o.k = *(const LAS f32x4*)(bp + SC_K + t * 256); o.r = *(const LAS f32x4*)(bp + SC_R + t * 256); o.v = *(const LAS float*)(vp + t * 64);
}
__device__ __forceinline__ void scan_unit(ArgsP a, int l, int bh, int q4, LAS unsigned char* lds, size_t y_off = A_Y) {
    a = args_ptr();
    const int tid = ltid(), lane = tid & 63, wid = __builtin_amdgcn_readfirstlane(tid >> 6);
    const int b = bh >> 3, h = bh & 7, i0 = q4 * 16;
    const bf16_t* RKV = (const bf16_t*)(a->ws + A_RKV); const bf16_t* LW = (const bf16_t*)(a->ws + A_LW); const bf16_t* ICLR = (const bf16_t*)(a->ws + A_ICLR);
    bf16_t* Y = (bf16_t*)(a->ws + y_off); float* SCAL = (float*)(a->ws + WS_SCAL);
    constexpr int NCH = SEQ / 32;
    if (wid >= 4) {
        const int ht = tid - 256, pcg = ht & 15, tau0 = ht >> 4, ch = h * 64 + 4 * pcg;
        const float* mu = a->in[I_MU] + (size_t)l * 1792;
        const f32x4 mu_r = *(const f32x4*)(mu + ch), mu_k = *(const f32x4*)(mu + 512 + ch), mu_v = *(const f32x4*)(mu + 1024 + ch);
        const f32x4 kk_c = *(const f32x4*)(a->in[I_KK] + l * 512 + ch), ka_c = *(const f32x4*)(a->in[I_KA] + l * 512 + ch), rk_c = *(const f32x4*)(a->in[I_RK] + l * 512 + ch);
        u32x2 g[2][8];
        const u32x2 z2 = (u32x2){0u, 0u};
#define SC_LOAD(c) do { _Pragma("unroll") for (int k_ = 0; k_ < 2; ++k_) { const int t_ = (c) * 32 + tau0 + 16 * k_; const size_t row_ = (size_t)b * SEQ + t_; \
            g[k_][0] = *(const u32x2*)(RKV + row_ * 1536 + ch); g[k_][1] = *(const u32x2*)(RKV + row_ * 1536 + 512 + ch); g[k_][2] = *(const u32x2*)(RKV + row_ * 1536 + 1024 + ch); \
            if (t_) { g[k_][3] = *(const u32x2*)(RKV + (row_ - 1) * 1536 + ch); g[k_][4] = *(const u32x2*)(RKV + (row_ - 1) * 1536 + 512 + ch); g[k_][5] = *(const u32x2*)(RKV + (row_ - 1) * 1536 + 1024 + ch); } \
            else { g[k_][3] = z2; g[k_][4] = z2; g[k_][5] = z2; } \
            g[k_][6] = *(const u32x2*)(LW + row_ * 512 + ch); g[k_][7] = *(const u32x2*)(ICLR + row_ * 512 + ch); } } while (0)
#define SC_STORE(c, p) do { _Pragma("unroll") for (int k_ = 0; k_ < 2; ++k_) { const int tau_ = tau0 + 16 * k_; LAS unsigned char* base_ = lds + (p) * SC_BUF + tau_ * 256 + pcg * 16; \
            const f32x4 r2 = up4(g[k_][0]), k2 = up4(g[k_][1]), v2 = up4(g[k_][2]); \
            const f32x4 r = r2 + (up4(g[k_][3]) - r2) * mu_r, k = k2 + (up4(g[k_][4]) - k2) * mu_k, v = v2 + (up4(g[k_][5]) - v2) * mu_v; \
            const f32x4 lw = up4(g[k_][6]), ic = up4(g[k_][7]); \
            f32x4 kk = k * kk_c; float ssum = dot4(kk, kk); ssum += shx(ssum, 1); ssum += shx(ssum, 2); ssum += shx(ssum, 4); ssum += shx(ssum, 8); \
            kk = kk * rsqrtf(ssum + 1e-12f); \
            const f32x4 kp = k * (1.0f + (ic - 1.0f) * ka_c); \
            float sc = dot4(r * kp, rk_c); sc += shx(sc, 1); sc += shx(sc, 2); sc += shx(sc, 4); sc += shx(sc, 8); \
            if (q4 == 0 && pcg == 0) SCAL[((size_t)b * SEQ + (c) * 32 + tau_) * 8 + h] = sc; \
            f32x4 w; w.x = __expf(lw.x * CK_LWZ); w.y = __expf(lw.y * CK_LWZ); w.z = __expf(lw.z * CK_LWZ); w.w = __expf(lw.w * CK_LWZ); \
            *(LAS f32x4*)(base_ + SC_R) = r; *(LAS f32x4*)(base_ + SC_W) = w; *(LAS f32x4*)(base_ + SC_K) = kp; *(LAS f32x4*)(base_ + SC_A) = -kk * CK_AB; *(LAS f32x4*)(base_ + SC_B) = kk * ic * CK_AB; \
            if ((pcg >> 2) == q4) *(LAS f32x4*)(lds + (p) * SC_BUF + SC_V + tau_ * 64 + (pcg & 3) * 16) = v; } } while (0)
        SC_LOAD(0); SC_STORE(0, 0); SC_LOAD(1);
        __syncthreads();
        for (int c = 0; c < NCH; ++c) {
            if (c + 1 < NCH) { SC_STORE(c + 1, (c + 1) & 1); if (c + 2 < NCH) SC_LOAD(c + 2); }
            if (c > 0) {
                const LAS f32x4* yp = (const LAS f32x4*)(lds + SC_YP + ((c - 1) & 1) * SC_YPB + (ht >> 3) * 256 + (ht & 7) * 32);
                const f32x4 y0 = yp[0], y1 = yp[1];
                *(unsigned*)(Y + ((size_t)b * SEQ + (c - 1) * 32 + (ht >> 3)) * 512 + h * 64 + i0 + 2 * (ht & 7)) = pk2((y0.x + y0.y) + (y0.z + y0.w), (y1.x + y1.y) + (y1.z + y1.w));
            }
            __syncthreads();
        }
        { const int c = NCH;
          const LAS f32x4* yp = (const LAS f32x4*)(lds + SC_YP + ((c - 1) & 1) * SC_YPB + (ht >> 3) * 256 + (ht & 7) * 32);
          const f32x4 y0 = yp[0], y1 = yp[1];
          *(unsigned*)(Y + ((size_t)b * SEQ + (c - 1) * 32 + (ht >> 3)) * 512 + h * 64 + i0 + 2 * (ht & 7)) = pk2((y0.x + y0.y) + (y0.z + y0.w), (y1.x + y1.y) + (y1.z + y1.w)); }
#undef SC_LOAD
#undef SC_STORE
    } else {
        const int rloc = wid * 4 + (lane >> 4), cgp = lane & 15;
        __syncthreads();
        f32x2 s01 = (f32x2){0.f, 0.f}, s23 = s01;
        for (int c = 0; c < NCH; ++c) {
            const int p = c & 1;
            const LAS unsigned char* bp = lds + p * SC_BUF + cgp * 16;
            const LAS unsigned char* vp = lds + p * SC_BUF + SC_V + rloc * 4;
            LAS float* ypw = (LAS float*)(lds + SC_YP + p * SC_YPB) + rloc * 4 + cgp;
            ScOps oa, ob;
            sc_ld(oa, bp, vp, 0);
#define SC_STEP(cur, nxt, t) do { if ((t) + 1 < 32) sc_ld(nxt, bp, vp, (t) + 1); if (CK_NOSTATE && ((t) & 15) == 0) { s01 = (f32x2){0.f, 0.f}; s23 = s01; } \
                const f32x2 vk0 = (f32x2){cur.k.x, cur.k.y} * cur.v, vk1 = (f32x2){cur.k.z, cur.k.w} * cur.v; \
                const f32x2 t0 = s01 * (f32x2){cur.w.x, cur.w.y} + vk0, t1 = s23 * (f32x2){cur.w.z, cur.w.w} + vk1; \
                f32x2 pd = s01 * (f32x2){cur.a.x, cur.a.y}; pd = s23 * (f32x2){cur.a.z, cur.a.w} + pd; \
                const float d = rr16(pd.x + pd.y); \
                s01 = (f32x2){cur.b.x, cur.b.y} * d + t0; s23 = (f32x2){cur.b.z, cur.b.w} * d + t1; \
                f32x2 qd = s01 * (f32x2){cur.r.x, cur.r.y}; qd = s23 * (f32x2){cur.r.z, cur.r.w} + qd; \
                float y = qd.x + qd.y; y += dppf<0x128>(y); y += dppf<0x124>(y); \
                if (cgp < 4) ypw[(t) * 64] = y; } while (0)
#pragma unroll 1
            for (int t = 0; t < 32; t += 2) { SC_STEP(oa, ob, t); SC_STEP(ob, oa, t + 1); }
#undef SC_STEP
            __syncthreads();
        }
    }
    __syncthreads();
}

typedef short s16x4v __attribute__((ext_vector_type(4)));
constexpr int CK_ROW = 144;
constexpr int CK_AT = 0, CK_RT = 2304, CK_BT = 4608, CK_KT = 6912, CK_VT = 9216, CK_GL = 11520, CK_OPB = 11776, CK_NOP = 5;
constexpr int CK_MT0 = CK_NOP * CK_OPB, CK_MAK = 0, CK_MRB = 512, CK_MRK = 1024, CK_TT = 1536, CK_MAB = 2048, CK_MTB = 2048 + 16 * 80, CK_NMT = 4;
constexpr int CK_YT0 = CK_MT0 + CK_NMT * CK_MTB, CK_YTB = 1024;
typedef short v4i16_t __attribute__((ext_vector_type(4)));
__device__ __forceinline__ s16x4v ldtr(const LAS unsigned char* p) { return __builtin_bit_cast(s16x4v, __builtin_amdgcn_ds_read_tr16_b64_v4i16((LAS v4i16_t*)p)); }
__device__ __forceinline__ s16x4v pk4(f32x4 v) { const u32x2 p = dn4(v); return __builtin_bit_cast(s16x4v, p); }
__device__ __forceinline__ void scan_unit_chunked(ArgsP a, int l, int bh, int q4, LAS unsigned char* lds, size_t y_off = A_Y) {
    a = args_ptr();
    const int tid = ltid(), lane = tid & 63, wid = __builtin_amdgcn_readfirstlane(tid >> 6);
    const int b = bh >> 3, h = bh & 7, i0 = q4 * 16, q = lane >> 4, l15 = lane & 15;
    const bf16_t* RKV = (const bf16_t*)(a->ws + A_RKV); const bf16_t* EG = (const bf16_t*)(a->ws + A_LW); const bf16_t* ICLR = (const bf16_t*)(a->ws + A_ICLR);
    bf16_t* Y = (bf16_t*)(a->ws + y_off); float* SCAL = (float*)(a->ws + WS_SCAL);
    constexpr int NCH = SEQ / 16;
    const int ht = tid - 256, t_h = (ht >> 4) & 15, jg = ht & 15, ch = h * 64 + 4 * jg;
    f32x4 mu_r, mu_k, mu_v, kk_c, ka_c, rk_c;
    u32x2 g[10], g1[10], g2[10];
    if (wid >= 4) {
        const float* mu = a->in[I_MU] + (size_t)l * 1792;
        mu_r = *(const f32x4*)(mu + ch); mu_k = *(const f32x4*)(mu + 512 + ch); mu_v = *(const f32x4*)(mu + 1024 + ch);
        kk_c = *(const f32x4*)(a->in[I_KK] + l * 512 + ch); ka_c = *(const f32x4*)(a->in[I_KA] + l * 512 + ch); rk_c = *(const f32x4*)(a->in[I_RK] + l * 512 + ch);
    }
#define CK_LOAD(G_, c) do { const int t_ = (c) * 16 + t_h; const size_t row_ = (size_t)b * SEQ + t_; const size_t rp_ = t_ ? row_ - 1 : row_; \
        G_[0] = *(const u32x2*)(RKV + row_ * 1536 + ch); G_[1] = *(const u32x2*)(RKV + row_ * 1536 + 512 + ch); G_[2] = *(const u32x2*)(RKV + row_ * 1536 + 1024 + ch); \
        G_[3] = *(const u32x2*)(RKV + rp_ * 1536 + ch); G_[4] = *(const u32x2*)(RKV + rp_ * 1536 + 512 + ch); G_[5] = *(const u32x2*)(RKV + rp_ * 1536 + 1024 + ch); \
        G_[6] = *(const u32x2*)(ICLR + row_ * 512 + ch); G_[7] = *(const u32x2*)(EG + row_ * 512 + ch); \
        G_[8] = *(const u32x2*)(EG + (row_ - (t_h ? 1 : 0)) * 512 + ch); G_[9] = *(const u32x2*)(EG + ((size_t)b * SEQ + (c) * 16 + 15) * 512 + ch); } while (0)
    f32x4 accS[4];
#pragma unroll
    for (int jt = 0; jt < 4; ++jt) accS[jt] = (f32x4){0.f, 0.f, 0.f, 0.f};
    float x[16];
#pragma unroll
    for (int t_ = 0; t_ < 16; ++t_) x[t_] = 0.f;
#define CK_OPSTAGE(G_, it) do { \
            if (it < NCH) { \
                LAS unsigned char* op = lds + (it % CK_NOP) * CK_OPB; \
                const f32x4 r2 = up4(G_[0]), k2 = up4(G_[1]), v2 = up4(G_[2]); \
                const float pz_ = (it * 16 + t_h) ? 1.0f : 0.0f; \
                const f32x4 r = r2 + (up4(G_[3]) * pz_ - r2) * mu_r, k = k2 + (up4(G_[4]) * pz_ - k2) * mu_k, v = v2 + (up4(G_[5]) * pz_ - v2) * mu_v, ic = up4(G_[6]); \
                const f32x4 eG = up4(G_[7]), eGL = up4(G_[9]); \
                f32x4 eGx = up4(G_[8]); if (t_h == 0) eGx = (f32x4){1.f, 1.f, 1.f, 1.f}; \
                f32x4 enG; \
_Pragma("unroll") \
                for (int e = 0; e < 4; ++e) enG[e] = __builtin_amdgcn_rcpf(eG[e]); \
                f32x4 kk = k * kk_c; const float ssum = rr16(dot4(kk, kk)); \
                kk = kk * rsqrtf(ssum + 1e-12f); \
                const f32x4 kp = k * (1.0f + (ic - 1.0f) * ka_c), bb = kk * ic; \
                const float sc = rr16(dot4(r * kp, rk_c)); \
                if (q4 == 0 && jg == 0) SCAL[((size_t)b * SEQ + it * 16 + t_h) * 8 + h] = sc; \
                *(LAS u32x2*)(op + CK_AT + t_h * CK_ROW + jg * 8) = dn4(-(kk * eGx)); \
                *(LAS u32x2*)(op + CK_RT + t_h * CK_ROW + jg * 8) = dn4(r * eG); \
                *(LAS u32x2*)(op + CK_BT + t_h * CK_ROW + jg * 8) = dn4(bb * enG); \
                *(LAS u32x2*)(op + CK_KT + t_h * CK_ROW + jg * 8) = dn4(kp * enG); \
                *(LAS u32x2*)(op + CK_VT + t_h * CK_ROW + jg * 8) = dn4(v); \
                if (t_h == 0) *(LAS f32x4*)(op + CK_GL + jg * 16) = eGL; \
            } \
            if (it + 3 < NCH) CK_LOAD(G_, it + 3); \
        } while (0)
    if (wid >= 4) { CK_LOAD(g, 0); CK_LOAD(g1, 1); CK_LOAD(g2, 2); }
#ifdef CK_TIME
    unsigned long long tb_ = 0, t0_ = 0; const unsigned long long tstart_ = __builtin_readcyclecounter();
#define CK_T0() (t0_ = __builtin_readcyclecounter())
#define CK_T1() (tb_ += __builtin_readcyclecounter() - t0_)
#else
#define CK_T0() do {} while (0)
#define CK_T1() do {} while (0)
#endif
    constexpr int NIT = ((NCH + 6 + 2) / 3) * 3;
    if (wid >= 4) {
#define CK_YSTORE(it) do { if (wid == 4 && (it) >= 5 && (it) - 5 < NCH) { \
            const LAS float* yt = (const LAS float*)(lds + CK_YT0 + (((it) - 5) & 1) * CK_YTB); const int t_ = lane >> 2, ip = (lane & 3) * 4; \
            const f32x4 yv = *(const LAS f32x4*)(yt + t_ * 16 + ip); \
            *(u32x2*)(Y + ((size_t)b * SEQ + ((it) - 5) * 16 + t_) * 512 + h * 64 + i0 + ip) = dn4(yv); } } while (0)
        for (int it3 = 0; it3 < NIT; it3 += 3) {
            CK_T0(); CK_OPSTAGE(g, it3); CK_YSTORE(it3); CK_T1(); __syncthreads();
            CK_T0(); CK_OPSTAGE(g1, (it3 + 1)); CK_YSTORE((it3 + 1)); CK_T1(); __syncthreads();
            CK_T0(); CK_OPSTAGE(g2, (it3 + 2)); CK_YSTORE((it3 + 2)); CK_T1(); __syncthreads();
        }
#undef CK_YSTORE
    } else
    for (int it = 0; it < NIT; ++it) {
        CK_T0();
        if (wid >= 1) {
            const int ph3 = (it + 3 - wid) % 3;
            const int c = it - 1 - ph3;
            if (c >= 0 && c < NCH) {
                const LAS unsigned char* op = lds + (c % CK_NOP) * CK_OPB; LAS unsigned char* mt = lds + CK_MT0 + (c % CK_NMT) * CK_MTB;
                if (ph3 == 0) {
                    const int ro = l15 * CK_ROW + q * 16;
                    const bf16x8 at0 = *(const LAS bf16x8*)(op + CK_AT + ro), at1 = *(const LAS bf16x8*)(op + CK_AT + ro + 64), rt0 = *(const LAS bf16x8*)(op + CK_RT + ro), rt1 = *(const LAS bf16x8*)(op + CK_RT + ro + 64);
                    const bf16x8 bt0 = *(const LAS bf16x8*)(op + CK_BT + ro), bt1 = *(const LAS bf16x8*)(op + CK_BT + ro + 64), kt0 = *(const LAS bf16x8*)(op + CK_KT + ro), kt1 = *(const LAS bf16x8*)(op + CK_KT + ro + 64);
                    const f32x4 z = (f32x4){0.f, 0.f, 0.f, 0.f};
                    f32x4 mab = __builtin_amdgcn_mfma_f32_16x16x32_bf16(at0, bt0, z, 0, 0, 0); mab = __builtin_amdgcn_mfma_f32_16x16x32_bf16(at1, bt1, mab, 0, 0, 0);
                    f32x4 mak = __builtin_amdgcn_mfma_f32_16x16x32_bf16(at0, kt0, z, 0, 0, 0); mak = __builtin_amdgcn_mfma_f32_16x16x32_bf16(at1, kt1, mak, 0, 0, 0);
                    f32x4 mrb = __builtin_amdgcn_mfma_f32_16x16x32_bf16(rt0, bt0, z, 0, 0, 0); mrb = __builtin_amdgcn_mfma_f32_16x16x32_bf16(rt1, bt1, mrb, 0, 0, 0);
                    f32x4 mrk = __builtin_amdgcn_mfma_f32_16x16x32_bf16(rt0, kt0, z, 0, 0, 0); mrk = __builtin_amdgcn_mfma_f32_16x16x32_bf16(rt1, kt1, mrk, 0, 0, 0);
#pragma unroll
                    for (int r = 0; r < 4; ++r) { const int t_ = 4 * q + r; const bool lo_ = l15 < t_, le_ = l15 <= t_;
                        *(LAS float*)(mt + CK_MAB + t_ * 80 + l15 * 4) = lo_ ? mab[r] : 0.f;
                        *(LAS bf16_t*)(mt + CK_MAK + t_ * 32 + l15 * 2) = (bf16_t)f2bf(lo_ ? mak[r] : 0.f);
                        *(LAS bf16_t*)(mt + CK_MRB + t_ * 32 + l15 * 2) = (bf16_t)f2bf(le_ ? mrb[r] : 0.f);
                        *(LAS bf16_t*)(mt + CK_MRK + t_ * 32 + l15 * 2) = (bf16_t)f2bf(le_ ? mrk[r] : 0.f); }
                } else {
#define CK_MLD(t_) f32x4 m_##t_[4]; _Pragma("unroll") for (int s4 = 0; s4 < (t_); s4 += 4) m_##t_[s4 >> 2] = *(const LAS f32x4*)(mt + CK_MAB + (t_) * 80 + s4 * 4)
#define CK_TROW(t_) do { float acc_ = (l15 == (t_)) ? 1.f : 0.f; \
                        _Pragma("unroll") for (int s4 = 0; s4 < (t_); s4 += 4) { \
                            _Pragma("unroll") for (int e = 0; e < 4; ++e) if (s4 + e < (t_)) acc_ += m_##t_[s4 >> 2][e] * x[s4 + e]; } \
                        x[t_] = acc_; } while (0)
                    if (ph3 == 1) { CK_MLD(1); CK_MLD(2); CK_MLD(3); CK_MLD(4); CK_MLD(5); CK_MLD(6); CK_MLD(7); CK_MLD(8); CK_MLD(9); CK_MLD(10);
                        x[0] = (l15 == 0) ? 1.f : 0.f; CK_TROW(1); CK_TROW(2); CK_TROW(3); CK_TROW(4); CK_TROW(5); CK_TROW(6); CK_TROW(7); CK_TROW(8); CK_TROW(9); CK_TROW(10); }
                    else { CK_MLD(11); CK_MLD(12); CK_MLD(13); CK_MLD(14); CK_MLD(15); CK_TROW(11); CK_TROW(12); CK_TROW(13); CK_TROW(14); CK_TROW(15);
                        if (q == 0) {
#pragma unroll
                            for (int t_ = 0; t_ < 16; ++t_) *(LAS bf16_t*)(mt + CK_TT + t_ * 32 + l15 * 2) = (bf16_t)f2bf(x[t_]); } }
#undef CK_TROW
#undef CK_MLD
                }
            }
        } else {
            const int c = it - 4;
            if (c >= 0 && c < NCH) {
                const LAS unsigned char* op = lds + (c % CK_NOP) * CK_OPB; const LAS unsigned char* mt = lds + CK_MT0 + (c % CK_NMT) * CK_MTB;
                s16x4v sb[4];
#pragma unroll
                for (int jt = 0; jt < 4; ++jt) { if (CK_NOSTATE) accS[jt] = (f32x4){0.f, 0.f, 0.f, 0.f}; sb[jt] = pk4(accS[jt]); }
                const int ao = l15 * CK_ROW + q * 8;
                const int tro = (4 * q + (l15 >> 2)) * CK_ROW + (l15 & 3) * 8;
                const s16x4v vb = ldtr(op + CK_VT + tro + i0 * 2);
                f32x4 x1 = (f32x4){0.f, 0.f, 0.f, 0.f}, x2 = x1;
#pragma unroll
                for (int jt = 0; jt < 4; ++jt) {
                    const s16x4v a0 = *(const LAS s16x4v*)(op + CK_AT + ao + jt * 32), r0 = *(const LAS s16x4v*)(op + CK_RT + ao + jt * 32);
                    x1 = __builtin_amdgcn_mfma_f32_16x16x16bf16_1k(a0, sb[jt], x1, 0, 0, 0);
                    x2 = __builtin_amdgcn_mfma_f32_16x16x16bf16_1k(r0, sb[jt], x2, 0, 0, 0);
                }
                const s16x4v mak = *(const LAS s16x4v*)(mt + CK_MAK + l15 * 32 + q * 8), mrb = *(const LAS s16x4v*)(mt + CK_MRB + l15 * 32 + q * 8);
                const s16x4v mrk = *(const LAS s16x4v*)(mt + CK_MRK + l15 * 32 + q * 8), tt = *(const LAS s16x4v*)(mt + CK_TT + l15 * 32 + q * 8);
                x1 = __builtin_amdgcn_mfma_f32_16x16x16bf16_1k(mak, vb, x1, 0, 0, 0);
                x2 = __builtin_amdgcn_mfma_f32_16x16x16bf16_1k(mrk, vb, x2, 0, 0, 0);
                const f32x4 u = __builtin_amdgcn_mfma_f32_16x16x16bf16_1k(tt, pk4(x1), (f32x4){0.f, 0.f, 0.f, 0.f}, 0, 0, 0);
                const s16x4v ub = pk4(u);
                const f32x4 yv = __builtin_amdgcn_mfma_f32_16x16x16bf16_1k(mrb, ub, x2, 0, 0, 0);
                const bf16x8 uv = (bf16x8){ub[0], ub[1], ub[2], ub[3], vb[0], vb[1], vb[2], vb[3]};
#pragma unroll
                for (int jt = 0; jt < 4; ++jt) {
                    const f32x4 gl = *(const LAS f32x4*)(op + CK_GL + (16 * jt + 4 * q) * 4);
                    const s16x4v b0 = ldtr(op + CK_BT + tro + jt * 32), k0 = ldtr(op + CK_KT + tro + jt * 32);
                    accS[jt] = __builtin_amdgcn_mfma_f32_16x16x32_bf16((bf16x8){b0[0], b0[1], b0[2], b0[3], k0[0], k0[1], k0[2], k0[3]}, uv, accS[jt], 0, 0, 0) * gl;
                }
                LAS float* yt = (LAS float*)(lds + CK_YT0 + (c & 1) * CK_YTB);
#pragma unroll
                for (int r = 0; r < 4; ++r) yt[(4 * q + r) * 16 + l15] = yv[r];
            }
        }
        CK_T1();
        __syncthreads();
    }
#ifdef CK_TIME
    if (blockIdx.x == 0 && l == 0 && lane == 0) { unsigned long long* tw = (unsigned long long*)(a->ws + WS_CTL) + 24000; tw[wid] = tb_; if (wid == 0) tw[8] = __builtin_readcyclecounter() - tstart_; }
#endif
#undef CK_LOAD
#undef CK_OPSTAGE
}

constexpr int WP_SUB = 4 * 2304 + 1280;
constexpr int CW_WPFLAG = 65536;
constexpr int CW_YFLAG = 72000;
__device__ __forceinline__ void ST2W(bf16_t* p, unsigned v) { asm volatile("global_store_short %0, %1, off sc1\n\ts_nop 1" :: "v"(p), "v"(v) : "memory"); }
__device__ __forceinline__ void phase_wkvprep(ArgsP a, int l, LAS unsigned char* lds, int first, int stride) {
    a = args_ptr(); first = __builtin_amdgcn_readfirstlane(first); stride = __builtin_amdgcn_readfirstlane(stride); asm volatile("" : "+s"(first), "+s"(stride));
    const int tid = ltid(), lane = tid & 63, wid = __builtin_amdgcn_readfirstlane(tid >> 6), sub = tid >> 8, ht = tid & 255, t_h = ht >> 4, jg = ht & 15, q = lane >> 4, l15 = lane & 15;
    bf16_t* RKV = (bf16_t*)(a->ws + A_RKV); bf16_t* EG = (bf16_t*)(a->ws + A_LW); bf16_t* ICLR = (bf16_t*)(a->ws + A_ICLR); float* SCAL = (float*)(a->ws + WS_SCAL);
    const bf16_t* HALO = (const bf16_t*)((const unsigned char*)a->out + DO_HALO); unsigned char* MTR = (unsigned char*)a->out + DO_MTREC;
    const float* mu = a->in[I_MU] + (size_t)l * 1792;
    struct WpIn { u32x2 gr, gk, gv, pr, pk, pv, gic, ge, gex, gel; };
    WpIn SA[4], SB[4];
    auto trip_of = [](int q_) { return (q_ & 31) * 32 + (q_ >> 5); };
    auto load1 = [&](WpIn& R1, int tr, int ps) { { const int idx_ = 8 * tr + 2 * ps + sub, bh_ = idx_ >> 8, c_ = idx_ & 255, ch_ = (bh_ & 7) * 64 + 4 * jg, t_ = c_ * 16 + t_h; const size_t row_ = (size_t)(bh_ >> 3) * SEQ + t_; const u32x2 z2_ = (u32x2){0u, 0u};
            R1.gr = *(const u32x2*)(RKV + row_ * 1536 + ch_); R1.gk = *(const u32x2*)(RKV + row_ * 1536 + 512 + ch_); R1.gv = *(const u32x2*)(RKV + row_ * 1536 + 1024 + ch_);
            R1.pr = z2_; R1.pk = z2_; R1.pv = z2_;
            if (t_h) { R1.pr = *(const u32x2*)(RKV + (row_ - 1) * 1536 + ch_); R1.pk = *(const u32x2*)(RKV + (row_ - 1) * 1536 + 512 + ch_); R1.pv = *(const u32x2*)(RKV + (row_ - 1) * 1536 + 1024 + ch_); }
            else if (t_) { const bf16_t* hp_ = HALO + ((row_ >> 4) - 1) * 1536; R1.pr = *(const u32x2*)(hp_ + ch_); R1.pk = *(const u32x2*)(hp_ + 512 + ch_); R1.pv = *(const u32x2*)(hp_ + 1024 + ch_); }
            R1.gic = *(const u32x2*)(ICLR + row_ * 512 + ch_); R1.ge = *(const u32x2*)(EG + row_ * 512 + ch_); R1.gex = *(const u32x2*)(EG + (row_ - (t_h ? 1 : 0)) * 512 + ch_); R1.gel = *(const u32x2*)(EG + (row_ - t_h + 15) * 512 + ch_); }
    };
    auto loadt = [&](WpIn (&R)[4], int tr, int half_) {
        if (half_ != 1) { load1(R[0], tr, 0); load1(R[1], tr, 1); }
        if (half_ != 0) { load1(R[2], tr, 2); load1(R[3], tr, 3); }
    };
    auto body = [&](WpIn (&R)[4], WpIn (&N)[4], int tr, int trn) {
        u32x2 oa[4], orr[4], ob[4], ok[4], ov[4], ogl[4]; float scv[4];
#pragma unroll
        for (int ps = 0; ps < 4; ++ps) {
            const int idx = 8 * tr + 2 * ps + sub, ch = ((idx >> 8) & 7) * 64 + 4 * jg;
            const f32x4 mu_r = *(const f32x4*)(mu + ch), mu_k = *(const f32x4*)(mu + 512 + ch), mu_v = *(const f32x4*)(mu + 1024 + ch);
            const f32x4 kk_c = *(const f32x4*)(a->in[I_KK] + l * 512 + ch), ka_c = *(const f32x4*)(a->in[I_KA] + l * 512 + ch), rk_c = *(const f32x4*)(a->in[I_RK] + l * 512 + ch);
            const f32x4 r2 = up4(R[ps].gr), k2 = up4(R[ps].gk), v2 = up4(R[ps].gv);
            const f32x4 r = r2 + (up4(R[ps].pr) - r2) * mu_r, k = k2 + (up4(R[ps].pk) - k2) * mu_k, v = v2 + (up4(R[ps].pv) - v2) * mu_v, ic = up4(R[ps].gic);
            const f32x4 eG = up4(R[ps].ge);
            f32x4 eGx = up4(R[ps].gex); if (t_h == 0) eGx = (f32x4){1.f, 1.f, 1.f, 1.f};
            f32x4 enG;
#pragma unroll
            for (int e = 0; e < 4; ++e) enG[e] = __builtin_amdgcn_rcpf(eG[e]);
            f32x4 kk = k * kk_c; const float ssum = rr16(dot4(kk, kk));
            kk = kk * rsqrtf(ssum + 1e-12f);
            const f32x4 kp = k * (1.0f + (ic - 1.0f) * ka_c), bb = kk * ic;
            scv[ps] = rr16(dot4(r * kp, rk_c));
            oa[ps] = dn4(-(kk * eGx)); orr[ps] = dn4(r * eG); ob[ps] = dn4(bb * enG); ok[ps] = dn4(kp * enG); ov[ps] = dn4(v); ogl[ps] = R[ps].gel;
            asm volatile("" ::: "memory");
        }
        __syncthreads();
        loadt(N, trn >= 0 ? trn : tr, 0);
#pragma unroll
        for (int ps = 0; ps < 4; ++ps) {
            const int idx = 8 * tr + 2 * ps + sub, bh = idx >> 8, c = idx & 255, b = bh >> 3, h = bh & 7, ch = h * 64 + 4 * jg;
            const size_t row = (size_t)b * SEQ + c * 16 + t_h;
            LAS unsigned char* op = lds + (2 * ps + sub) * WP_SUB;
            *(LAS u32x2*)(op + CK_AT + t_h * CK_ROW + jg * 8) = oa[ps]; *(LAS u32x2*)(op + CK_RT + t_h * CK_ROW + jg * 8) = orr[ps];
            *(LAS u32x2*)(op + CK_BT + t_h * CK_ROW + jg * 8) = ob[ps]; *(LAS u32x2*)(op + CK_KT + t_h * CK_ROW + jg * 8) = ok[ps];
            pg8::ST8W(RKV + row * 1536 + ch, oa[ps]); pg8::ST8W(RKV + row * 1536 + 512 + ch, orr[ps]); pg8::ST8W(RKV + row * 1536 + 1024 + ch, ov[ps]);
            pg8::ST8W(EG + row * 512 + ch, ob[ps]); pg8::ST8W(ICLR + row * 512 + ch, ok[ps]);
            if (jg == 0) __hip_atomic_store(SCAL + row * 8 + h, scv[ps], __ATOMIC_RELAXED, __HIP_MEMORY_SCOPE_AGENT);
            if (t_h == 0) { const f32x4 eGL = up4(ogl[ps]); pg8::ST16W((bf16_t*)(MTR + (size_t)idx * MTREC_B + 2048 + jg * 16), __builtin_bit_cast(u32x4, eGL)); }
        }
        __syncthreads();
    };
    unsigned* wpflag = (unsigned*)(a->ws + WS_CTL) + CW_WPFLAG + l * 1024;
    auto stepB = [&](int tr) {
        {
            const int idx = 8 * tr + wid;
            const LAS unsigned char* op = lds + wid * WP_SUB; LAS unsigned char* mt = lds + wid * WP_SUB + 4 * 2304;
            const int ro = l15 * CK_ROW + q * 16;
            const bf16x8 at0 = *(const LAS bf16x8*)(op + CK_AT + ro), at1 = *(const LAS bf16x8*)(op + CK_AT + ro + 64), rt0 = *(const LAS bf16x8*)(op + CK_RT + ro), rt1 = *(const LAS bf16x8*)(op + CK_RT + ro + 64);
            const bf16x8 bt0 = *(const LAS bf16x8*)(op + CK_BT + ro), bt1 = *(const LAS bf16x8*)(op + CK_BT + ro + 64), kt0 = *(const LAS bf16x8*)(op + CK_KT + ro), kt1 = *(const LAS bf16x8*)(op + CK_KT + ro + 64);
            const f32x4 z = (f32x4){0.f, 0.f, 0.f, 0.f};
            f32x4 mab = __builtin_amdgcn_mfma_f32_16x16x32_bf16(at0, bt0, z, 0, 0, 0); mab = __builtin_amdgcn_mfma_f32_16x16x32_bf16(at1, bt1, mab, 0, 0, 0);
            f32x4 mak = __builtin_amdgcn_mfma_f32_16x16x32_bf16(at0, kt0, z, 0, 0, 0); mak = __builtin_amdgcn_mfma_f32_16x16x32_bf16(at1, kt1, mak, 0, 0, 0);
            f32x4 mrb = __builtin_amdgcn_mfma_f32_16x16x32_bf16(rt0, bt0, z, 0, 0, 0); mrb = __builtin_amdgcn_mfma_f32_16x16x32_bf16(rt1, bt1, mrb, 0, 0, 0);
            f32x4 mrk = __builtin_amdgcn_mfma_f32_16x16x32_bf16(rt0, kt0, z, 0, 0, 0); mrk = __builtin_amdgcn_mfma_f32_16x16x32_bf16(rt1, kt1, mrk, 0, 0, 0);
            bf16_t* rec = (bf16_t*)(MTR + (size_t)idx * MTREC_B);
            LAS bf16_t* stg = (LAS bf16_t*)(lds + wid * WP_SUB);
            asm volatile("s_waitcnt lgkmcnt(0)" ::: "memory");
#pragma unroll
            for (int rr = 0; rr < 4; ++rr) { const int t_ = 4 * q + rr; const bool lo_ = l15 < t_, le_ = l15 <= t_;
                *(LAS float*)(mt + t_ * 80 + l15 * 4) = lo_ ? mab[rr] : 0.f;
                stg[t_ * 16 + l15] = (bf16_t)f2bf(lo_ ? mak[rr] : 0.f);
                stg[256 + t_ * 16 + l15] = (bf16_t)f2bf(le_ ? mrb[rr] : 0.f);
                stg[512 + t_ * 16 + l15] = (bf16_t)f2bf(le_ ? mrk[rr] : 0.f); }
            asm volatile("s_waitcnt lgkmcnt(0)" ::: "memory");
            float x[16];
#define WP_MLD(t_) f32x4 m_##t_[4]; _Pragma("unroll") for (int s4 = 0; s4 < (t_); s4 += 4) m_##t_[s4 >> 2] = *(const LAS f32x4*)(mt + (t_) * 80 + s4 * 4)
#define WP_TROW(t_) do { float acc_ = (l15 == (t_)) ? 1.f : 0.f; \
                _Pragma("unroll") for (int s4 = 0; s4 < (t_); s4 += 4) { _Pragma("unroll") for (int e = 0; e < 4; ++e) if (s4 + e < (t_)) acc_ += m_##t_[s4 >> 2][e] * x[s4 + e]; } \
                x[t_] = acc_; } while (0)
            x[0] = (l15 == 0) ? 1.f : 0.f;
            { WP_MLD(1); WP_MLD(2); WP_MLD(3); WP_MLD(4); WP_MLD(5); WP_MLD(6); WP_MLD(7); WP_TROW(1); WP_TROW(2); WP_TROW(3); WP_TROW(4); WP_TROW(5); WP_TROW(6); WP_TROW(7); }
            { WP_MLD(8); WP_MLD(9); WP_MLD(10); WP_MLD(11); WP_TROW(8); WP_TROW(9); WP_TROW(10); WP_TROW(11); }
            { WP_MLD(12); WP_MLD(13); WP_MLD(14); WP_MLD(15); WP_TROW(12); WP_TROW(13); WP_TROW(14); WP_TROW(15); }
#undef WP_TROW
#undef WP_MLD
            if (q == 0) {
#pragma unroll
                for (int t_ = 0; t_ < 16; ++t_) stg[768 + t_ * 16 + l15] = (bf16_t)f2bf(x[t_]); }
            asm volatile("s_waitcnt lgkmcnt(0)" ::: "memory");
            pg8::ST16W(rec + lane * 8, *(const LAS u32x4*)((const LAS unsigned char*)stg + lane * 16));
            pg8::ST16W(rec + 512 + lane * 8, *(const LAS u32x4*)((const LAS unsigned char*)stg + 1024 + lane * 16));
        }
        asm volatile("s_waitcnt vmcnt(0)" ::: "memory");
        __syncthreads();
        if (tid == 0) __hip_atomic_store(wpflag + tr, 1u, __ATOMIC_RELAXED, __HIP_MEMORY_SCOPE_AGENT);
    };
    if (first < 1024) loadt(SA, trip_of(first), 2);
#pragma unroll 1
    for (int qq = first; qq < 1024; qq += 2 * stride) {
        const int q1 = qq + stride, q2 = q1 + stride;
        const int tr0 = trip_of(qq), tr1 = q1 < 1024 ? trip_of(q1) : -1, tr2 = q2 < 1024 ? trip_of(q2) : -1;
        body(SA, SB, tr0, tr1); stepB(tr0);
        if (tr1 < 0) break;
        loadt(SB, tr1, 1);
        body(SB, SA, tr1, tr2); stepB(tr1);
        loadt(SA, tr2 >= 0 ? tr2 : tr1, 1);
    }
}

constexpr int WS_SLOT = 5 * 2048 + 3 * 1024, WS_NSLOT = 8, WS_DEPTH = 7, WS_YT = WS_NSLOT * WS_SLOT;
__device__ __forceinline__ void glds16(const void* gsrc, unsigned lds_dst) { unsigned keep;
    asm volatile("s_mov_b32 %0, m0\n\ts_mov_b32 m0, %2\n\ts_nop 0\n\tglobal_load_lds_dwordx4 %1, off\n\ts_mov_b32 m0, %0" : "=&s"(keep) : "v"(gsrc), "s"(lds_dst) : "memory"); }
__device__ __forceinline__ void scan_unit_stream(ArgsP a, int l, int bh, LAS unsigned char* lds) {
    a = args_ptr();
    const int tid = ltid(), lane = tid & 63, wid = __builtin_amdgcn_readfirstlane(tid >> 6), q = lane >> 4, l15 = lane & 15;
    const int b = bh >> 3, h = bh & 7;
    const unsigned char* RKVb = a->ws + A_RKV; const unsigned char* EGb = a->ws + A_LW; const unsigned char* ICb = a->ws + A_ICLR;
    const unsigned char* MTR = (const unsigned char*)a->out + DO_MTREC + (size_t)bh * 256 * MTREC_B;
    bf16_t* Y = (bf16_t*)(a->ws + A_Y);
    unsigned* yflag = (unsigned*)(a->ws + WS_CTL) + CW_YFLAG + l * 1024 + bh * 32;
    constexpr int NCH = SEQ / 16;
    const unsigned lds0 = (unsigned)(uintptr_t)lds;
    if (wid >= 4) {
        const int w = wid - 4, rw = lane >> 3, c16 = ((lane & 7) ^ rw) * 16;
        const int np = (w == 0) ? 4 : 3;
#define WS_ISSUE(cc) do { const size_t row0_ = (size_t)b * SEQ + (size_t)(cc) * 16; const unsigned slot_ = lds0 + (unsigned)(((cc) % WS_NSLOT) * WS_SLOT); \
            _Pragma("unroll") for (int k_ = 0; k_ < 4; ++k_) { const int p_ = w + 4 * k_; if (p_ < 13) { const void* src_; \
                if (p_ < 10) { const int tl_ = p_ >> 1; const size_t r_ = row0_ + 8 * (p_ & 1) + rw; \
                    src_ = tl_ < 3 ? (const void*)(RKVb + (r_ * 1536 + tl_ * 512 + h * 64) * 2 + c16) : (tl_ == 3 ? (const void*)(EGb + (r_ * 512 + h * 64) * 2 + c16) : (const void*)(ICb + (r_ * 512 + h * 64) * 2 + c16)); } \
                else src_ = (const void*)(MTR + (size_t)(cc) * MTREC_B + (p_ - 10) * 1024 + lane * 16); \
                glds16(src_, (unsigned)__builtin_amdgcn_readfirstlane(slot_ + (unsigned)(p_ < 10 ? (p_ >> 1) * 2048 + (p_ & 1) * 1024 : 10240 + (p_ - 10) * 1024))); } } } while (0)
        unsigned* wpflag = (unsigned*)(a->ws + WS_CTL) + CW_WPFLAG + l * 1024 + bh * 32;
        unsigned* tmo = (unsigned*)(a->ws + WS_CTL) + CW_BAR + XB_TMO;
#define WS_GATE(cc) do { if (((cc) & 7) == 0) { unsigned sp_ = 0; \
            while ((unsigned)__builtin_amdgcn_readfirstlane(__hip_atomic_load(wpflag + ((cc) >> 3), __ATOMIC_RELAXED, __HIP_MEMORY_SCOPE_AGENT)) == 0u) { __builtin_amdgcn_s_sleep(2); \
                if ((++sp_ & 255u) == 0u) { if (xb_ld(tmo)) break; if (sp_ > XB_SPIN_CAP) { atomicAdd(tmo, 1u); break; } } } \
            __builtin_amdgcn_fence(__ATOMIC_ACQUIRE, "agent"); } } while (0)
        WS_GATE(0);
#pragma unroll
        for (int cc = 0; cc < WS_DEPTH; ++cc) WS_ISSUE(cc);
        if (w == 0) asm volatile("s_waitcnt vmcnt(24)" ::: "memory"); else asm volatile("s_waitcnt vmcnt(18)" ::: "memory");
        __syncthreads();
        for (int it = 0; it < NCH; ++it) {
            if (it + WS_DEPTH < NCH) { WS_GATE(it + WS_DEPTH); WS_ISSUE(it + WS_DEPTH); if (w == 0) asm volatile("s_waitcnt vmcnt(24)" ::: "memory"); else asm volatile("s_waitcnt vmcnt(18)" ::: "memory"); }
            else asm volatile("s_waitcnt vmcnt(0)" ::: "memory");
            __syncthreads();
        }
#undef WS_ISSUE
#undef WS_GATE
        (void)np;
    } else {
        f32x4 accS[4];
#pragma unroll
        for (int jt = 0; jt < 4; ++jt) accS[jt] = (f32x4){0.f, 0.f, 0.f, 0.f};
        __syncthreads();
        for (int it = 0; it < NCH; ++it) {
            const LAS unsigned char* op = lds + (it % WS_NSLOT) * WS_SLOT; const LAS unsigned char* mt = op + 10240;
            s16x4v sb[4];
#pragma unroll
            for (int jt = 0; jt < 4; ++jt) sb[jt] = pk4(accS[jt]);
#define WS_SW(row, p8) ((row) * 128 + ((((p8) >> 1) ^ ((row) & 7)) << 4) + ((p8) & 1) * 8)
            const int trow = 4 * q + (l15 >> 2);
            const s16x4v vb = ldtr(op + 4096 + WS_SW(trow, (l15 & 3) + 4 * wid));
            f32x4 x1 = (f32x4){0.f, 0.f, 0.f, 0.f}, x2 = x1;
#pragma unroll
            for (int jt = 0; jt < 4; ++jt) {
                const s16x4v a0 = *(const LAS s16x4v*)(op + 0 + WS_SW(l15, q + 4 * jt)), r0 = *(const LAS s16x4v*)(op + 2048 + WS_SW(l15, q + 4 * jt));
                x1 = __builtin_amdgcn_mfma_f32_16x16x16bf16_1k(a0, sb[jt], x1, 0, 0, 0);
                x2 = __builtin_amdgcn_mfma_f32_16x16x16bf16_1k(r0, sb[jt], x2, 0, 0, 0);
            }
            const s16x4v mak = *(const LAS s16x4v*)(mt + 0 + l15 * 32 + q * 8), mrb = *(const LAS s16x4v*)(mt + 512 + l15 * 32 + q * 8);
            const s16x4v mrk = *(const LAS s16x4v*)(mt + 1024 + l15 * 32 + q * 8), tt = *(const LAS s16x4v*)(mt + 1536 + l15 * 32 + q * 8);
            x1 = __builtin_amdgcn_mfma_f32_16x16x16bf16_1k(mak, vb, x1, 0, 0, 0);
            x2 = __builtin_amdgcn_mfma_f32_16x16x16bf16_1k(mrk, vb, x2, 0, 0, 0);
            const f32x4 u = __builtin_amdgcn_mfma_f32_16x16x16bf16_1k(tt, pk4(x1), (f32x4){0.f, 0.f, 0.f, 0.f}, 0, 0, 0);
            const s16x4v ub = pk4(u);
            const f32x4 yv = __builtin_amdgcn_mfma_f32_16x16x16bf16_1k(mrb, ub, x2, 0, 0, 0);
            const bf16x8 uv = (bf16x8){ub[0], ub[1], ub[2], ub[3], vb[0], vb[1], vb[2], vb[3]};
#pragma unroll
            for (int jt = 0; jt < 4; ++jt) {
                const f32x4 gl = *(const LAS f32x4*)(mt + 2048 + (16 * jt + 4 * q) * 4);
                const s16x4v b0 = ldtr(op + 6144 + WS_SW(trow, (l15 & 3) + 4 * jt)), k0 = ldtr(op + 8192 + WS_SW(trow, (l15 & 3) + 4 * jt));
                accS[jt] = __builtin_amdgcn_mfma_f32_16x16x32_bf16((bf16x8){b0[0], b0[1], b0[2], b0[3], k0[0], k0[1], k0[2], k0[3]}, uv, accS[jt], 0, 0, 0) * gl;
            }
            LAS float* yt = (LAS float*)(lds + WS_YT + wid * 1024);
#pragma unroll
            for (int rr = 0; rr < 4; ++rr) yt[(4 * q + rr) * 16 + l15] = yv[rr];
            asm volatile("s_waitcnt lgkmcnt(0)" ::: "memory");
            { const int t_ = lane >> 2, ip = (lane & 3) * 4; const f32x4 yr = *(const LAS f32x4*)(yt + t_ * 16 + ip);
              pg8::ST8W(Y + ((size_t)b * SEQ + it * 16 + t_) * 512 + h * 64 + 16 * wid + ip, dn4(yr)); }
            const bool pub_ = ((it & 7) == 7) && it >= 15;
            if (pub_) asm volatile("s_waitcnt vmcnt(8)" ::: "memory");
            __syncthreads();
            if (pub_ && tid == 0) __hip_atomic_store(yflag + ((it - 15) >> 3), 1u, __ATOMIC_RELAXED, __HIP_MEMORY_SCOPE_AGENT);
        }
        asm volatile("s_waitcnt vmcnt(0)" ::: "memory");
#undef WS_SW
    }
    __syncthreads();
    if (tid == 0) __hip_atomic_store(yflag + 31, 1u, __ATOMIC_RELAXED, __HIP_MEMORY_SCOPE_AGENT);
}

__device__ __forceinline__ int crow(int r, int hi) { return (r & 3) + 8 * (r >> 2) + 4 * hi; }
constexpr int AT_KROW = 208, AT_VROW = 136, AT_KBUF = 64 * AT_KROW, AT_VBUF = 64 * AT_VROW, AT_V0 = 2 * AT_KBUF;
__device__ __forceinline__ void attn_unit(ArgsP a, int bh, int qb, LAS unsigned char* lds, size_t o_off = A_QN) {
    a = args_ptr();
    const int tid = ltid(), lane = tid & 63, wid = tid >> 6, r32 = lane & 31, hi = lane >> 5;
    const int b = bh >> 3, h = bh & 7, q0 = qb * 256, qw0 = q0 + wid * 32;
    const size_t rowb = (size_t)b * SEQ;
    const bf16_t* Qn = (const bf16_t*)(a->ws + A_QN); const bf16_t* Qp = (const bf16_t*)(a->ws + A_QP); const bf16_t* Kn = (const bf16_t*)(a->ws + A_KN);
    const bf16_t* KPE = (const bf16_t*)(a->ws + A_KPE); const bf16_t* Vt = (const bf16_t*)(a->ws + A_VT); bf16_t* O = (bf16_t*)(a->ws + o_off);
    bf16x8 qf[6];
    { const size_t qrow = rowb + qw0 + r32;
#pragma unroll
      for (int ds = 0; ds < 4; ++ds) qf[ds] = *(const bf16x8*)(Qn + qrow * 512 + h * 64 + ds * 16 + hi * 8);
#pragma unroll
      for (int ds = 0; ds < 2; ++ds) qf[4 + ds] = *(const bf16x8*)(Qp + qrow * 256 + h * 32 + ds * 16 + hi * 8); }
    const int NT = 4 * qb + 4;
    const bf16_t* ksrc = Kn + (rowb + (tid >> 3)) * 512 + h * 64 + (tid & 7) * 8;
    const bf16_t* psrc = KPE + (rowb + ((tid & 255) >> 2)) * 32 + (tid & 3) * 8;
    const bf16_t* vsrc = Vt + ((size_t)(bh * 64 + (tid >> 3)) << 12) + (tid & 7) * 8;
    const int kdst = (tid >> 3) * AT_KROW + (tid & 7) * 16, pdst = ((tid & 255) >> 2) * AT_KROW + 128 + (tid & 3) * 16, vdst = AT_V0 + (tid >> 3) * AT_VROW + (tid & 7) * 16;
    u32x4 rk0, rp0 = (u32x4){0u, 0u, 0u, 0u}, rv0, rk1, rp1 = rp0, rv1;
#define AT_LOAD(S, tt) do { rk##S = *(const u32x4*)(ksrc + (size_t)(tt) * 64 * 512); if (tid < 256) rp##S = *(const u32x4*)(psrc + (size_t)(tt) * 64 * 32); rv##S = *(const u32x4*)(vsrc + (tt) * 64); } while (0)
#define AT_WRITE(S, p) do { *(LAS u32x4*)(lds + (p) * AT_KBUF + kdst) = rk##S; if (tid < 256) *(LAS u32x4*)(lds + (p) * AT_KBUF + pdst) = rp##S; \
        *(LAS u32x2*)(lds + (p) * AT_VBUF + vdst) = (u32x2){rv##S.x, rv##S.y}; *(LAS u32x2*)(lds + (p) * AT_VBUF + vdst + 8) = (u32x2){rv##S.z, rv##S.w}; } while (0)
    AT_LOAD(0, 0); AT_WRITE(0, 0); AT_LOAD(0, 1);
    __syncthreads();
    float mrun = -INFINITY, lrun = 0.f;
    f32x16 o0, o1;
#pragma unroll
    for (int r = 0; r < 16; ++r) { o0[r] = 0.f; o1[r] = 0.f; }
    for (int t2 = 0; t2 < NT; t2 += 2)
#pragma unroll
    for (int tp = 0; tp < 2; ++tp) {
        const int t = t2 + tp, cur = tp;
        if (t + 2 < NT) { if (tp == 0) AT_LOAD(1, t + 2); else AT_LOAD(0, t + 2); }
        if (64 * t <= qw0 + 31) {
            const LAS unsigned char* Kb = lds + cur * AT_KBUF + r32 * AT_KROW + hi * 16;
            f32x16 p0, p1;
#pragma unroll
            for (int r = 0; r < 16; ++r) { p0[r] = 0.f; p1[r] = 0.f; }
#pragma unroll
            for (int ds = 0; ds < 6; ++ds) {
                const bf16x8 k0 = *(const LAS bf16x8*)(Kb + ds * 32), k1 = *(const LAS bf16x8*)(Kb + 32 * AT_KROW + ds * 32);
                p0 = __builtin_amdgcn_mfma_f32_32x32x16_bf16(k0, qf[ds], p0, 0, 0, 0);
                p1 = __builtin_amdgcn_mfma_f32_32x32x16_bf16(k1, qf[ds], p1, 0, 0, 0);
            }
            if (64 * t + 63 > qw0) {
                const int q = qw0 + r32;
#pragma unroll
                for (int r = 0; r < 16; ++r) { const int kv = 64 * t + crow(r, hi); if (kv > q) p0[r] = -INFINITY; if (kv + 32 > q) p1[r] = -INFINITY; }
            }
            float mx = fmaxf(p0[0], p1[0]);
#pragma unroll
            for (int r = 1; r < 16; ++r) mx = fmaxf(mx, fmaxf(p0[r], p1[r]));
            mx = fmaxf(mx, shx(mx, 32));
            const float mnew = fmaxf(mrun, mx), alpha = __builtin_amdgcn_exp2f(mrun - mnew);
            mrun = mnew;
            float ps = 0.f;
#pragma unroll
            for (int r = 0; r < 16; ++r) { p0[r] = __builtin_amdgcn_exp2f(p0[r] - mnew); p1[r] = __builtin_amdgcn_exp2f(p1[r] - mnew); ps += p0[r] + p1[r]; }
            lrun = lrun * alpha + ps;
#pragma unroll
            for (int r = 0; r < 16; ++r) { o0[r] *= alpha; o1[r] *= alpha; }
            bf16x8 pf[4];
#pragma unroll
            for (int ks = 0; ks < 4; ++ks) {
                u32x4 w;
                if (ks < 2) { w.x = pk2(p0[8 * ks + 0], p0[8 * ks + 1]); w.y = pk2(p0[8 * ks + 2], p0[8 * ks + 3]); w.z = pk2(p0[8 * ks + 4], p0[8 * ks + 5]); w.w = pk2(p0[8 * ks + 6], p0[8 * ks + 7]); }
                else { const int k2 = ks - 2; w.x = pk2(p1[8 * k2 + 0], p1[8 * k2 + 1]); w.y = pk2(p1[8 * k2 + 2], p1[8 * k2 + 3]); w.z = pk2(p1[8 * k2 + 4], p1[8 * k2 + 5]); w.w = pk2(p1[8 * k2 + 6], p1[8 * k2 + 7]); }
                pf[ks] = __builtin_bit_cast(bf16x8, w);
            }
            const LAS unsigned char* Vb = lds + AT_V0 + cur * AT_VBUF + r32 * AT_VROW + hi * 8;
#pragma unroll
            for (int ks = 0; ks < 4; ++ks) {
                const s16x4 a0 = *(const LAS s16x4*)(Vb + ks * 32), a1 = *(const LAS s16x4*)(Vb + ks * 32 + 16);
                const s16x4 c0 = *(const LAS s16x4*)(Vb + 32 * AT_VROW + ks * 32), c1 = *(const LAS s16x4*)(Vb + 32 * AT_VROW + ks * 32 + 16);
                const bf16x8 vf0 = (bf16x8){a0[0], a0[1], a0[2], a0[3], a1[0], a1[1], a1[2], a1[3]}, vf1 = (bf16x8){c0[0], c0[1], c0[2], c0[3], c1[0], c1[1], c1[2], c1[3]};
                o0 = __builtin_amdgcn_mfma_f32_32x32x16_bf16(vf0, pf[ks], o0, 0, 0, 0);
                o1 = __builtin_amdgcn_mfma_f32_32x32x16_bf16(vf1, pf[ks], o1, 0, 0, 0);
            }
        }
        if (t + 1 < NT) { if (tp == 0) AT_WRITE(0, 1); else AT_WRITE(1, 0); }
        __syncthreads();
    }
#undef AT_WRITE
#undef AT_LOAD
    const float ltot = lrun + shx(lrun, 32), inv = 1.0f / ltot;
    bf16_t* orow = O + (rowb + qw0 + r32) * 512 + h * 64 + 4 * hi;
#pragma unroll
    for (int g = 0; g < 4; ++g) {
        *(u32x2*)(orow + 8 * g) = (u32x2){pk2(o0[4 * g] * inv, o0[4 * g + 1] * inv), pk2(o0[4 * g + 2] * inv, o0[4 * g + 3] * inv)};
        *(u32x2*)(orow + 32 + 8 * g) = (u32x2){pk2(o1[4 * g] * inv, o1[4 * g + 1] * inv), pk2(o1[4 * g + 2] * inv, o1[4 * g + 3] * inv)};
    }
}


__device__ __forceinline__ void attn_unit_naive(ArgsP a, int bh, int qb, LAS unsigned char* lds) {
    a = args_ptr();
    const int tid = vtid(), lane = tid & 63, wid = tid >> 6;
    const int b = bh >> 3, h = bh & 7; const size_t rowb = (size_t)b * SEQ;
    const bf16_t* Qn = (const bf16_t*)(a->ws + A_QN); const bf16_t* Qp = (const bf16_t*)(a->ws + A_QP); const bf16_t* Kn = (const bf16_t*)(a->ws + A_KN);
    const bf16_t* KPE = (const bf16_t*)(a->ws + A_KPE); const bf16_t* Vt = (const bf16_t*)(a->ws + A_VT); bf16_t* O = (bf16_t*)(a->ws + A_QN);
    LAS float* sc = (LAS float*)(lds + wid * 16384);
    for (int i = 0; i < 32; ++i) {
        const int q = qb * 256 + wid * 32 + i; const size_t qrow = rowb + q;
        float mx = -INFINITY;
        for (int k0 = 0; k0 <= q; k0 += 64) {
            const int key = k0 + lane; float sv = -INFINITY;
            if (key <= q) { sv = 0.f;
                for (int d = 0; d < 64; ++d) sv += bf2f(Qn[qrow * 512 + h * 64 + d]) * bf2f(Kn[(rowb + key) * 512 + h * 64 + d]);
                for (int d = 0; d < 32; ++d) sv += bf2f(Qp[qrow * 256 + h * 32 + d]) * bf2f(KPE[(rowb + key) * 32 + d]); }
            sc[key] = sv; mx = fmaxf(mx, sv);
        }
        for (int o = 1; o < 64; o <<= 1) mx = fmaxf(mx, shx(mx, o));
        float sum = 0.f;
        for (int k0 = 0; k0 <= q; k0 += 64) { const int key = k0 + lane; const float p = key <= q ? exp2f(sc[key] - mx) : 0.f; sc[key] = p; sum += p; }
        for (int o = 1; o < 64; o <<= 1) sum += shx(sum, o);
        asm volatile("s_waitcnt lgkmcnt(0)" ::: "memory");
        float acc = 0.f;
        const bf16_t* vp = Vt + ((size_t)(bh * 64 + lane) << 12);
        for (int key = 0; key <= q; ++key) acc += sc[key] * bf2f(vp[key]);
        asm volatile("s_waitcnt lgkmcnt(0)" ::: "memory");
        O[qrow * 512 + h * 64 + lane] = (bf16_t)f2bf(acc / sum);
    }
}
template <int NG> __device__ __forceinline__ void ya_item(ArgsP a, int l, int bh, int g0) {
    a = args_ptr();
    const int tid = ltid();
    if (tid < 64) {
        unsigned* fl = (unsigned*)(a->ws + WS_CTL) + CW_YFLAG + l * 1024 + bh * 32 + g0; unsigned* tmo = (unsigned*)(a->ws + WS_CTL) + CW_BAR + XB_TMO; unsigned sp_ = 0;
        for (;;) { unsigned f_ = __hip_atomic_load(fl, __ATOMIC_RELAXED, __HIP_MEMORY_SCOPE_AGENT);
            if (NG == 4) f_ &= __hip_atomic_load(fl + 1, __ATOMIC_RELAXED, __HIP_MEMORY_SCOPE_AGENT) & __hip_atomic_load(fl + 2, __ATOMIC_RELAXED, __HIP_MEMORY_SCOPE_AGENT) & __hip_atomic_load(fl + 3, __ATOMIC_RELAXED, __HIP_MEMORY_SCOPE_AGENT);
            if ((unsigned)__builtin_amdgcn_readfirstlane(f_) != 0u) break;
            __builtin_amdgcn_s_sleep(2);
            if ((++sp_ & 255u) == 0u) { if (xb_ld(tmo)) break; if (sp_ > XB_SPIN_CAP) { atomicAdd(tmo, 1u); break; } } }
        __builtin_amdgcn_fence(__ATOMIC_ACQUIRE, "agent");
    }
    __syncthreads();
    const int h = bh & 7, c = h * 64 + (tid & 7) * 8; const size_t r0 = (size_t)(bh >> 3) * SEQ + (size_t)g0 * 128 + (tid >> 3);
    constexpr int NR = 2 * NG;
    const bf16_t* Y = (const bf16_t*)(a->ws + A_Y); const bf16_t* RKV = (const bf16_t*)(a->ws + A_RKV); const bf16_t* GATE = (const bf16_t*)(a->ws + A_GATE);
    const float* SCAL = (const float*)(a->ws + WS_SCAL); bf16_t* YA = (bf16_t*)(a->ws + A_YA);
    const float* lw = a->in[I_LNXW] + l * 512 + c; const float* lb = a->in[I_LNXB] + l * 512 + c;
    const f32x4 w0 = *(const f32x4*)lw, w1 = *(const f32x4*)(lw + 4), b0 = *(const f32x4*)lb, b1 = *(const f32x4*)(lb + 4);
    u32x4 yu[NR], vu[NR], gu[NR]; float sc[NR];
#pragma unroll
    for (int k = 0; k < NR; ++k) { const size_t row = r0 + 64 * k;
        yu[k] = *(const u32x4*)(Y + row * 512 + c); vu[k] = *(const u32x4*)(RKV + row * 1536 + 1024 + c);
        gu[k] = *(const u32x4*)(GATE + row * 512 + c); sc[k] = SCAL[row * 8 + h]; }
#pragma unroll
    for (int k = 0; k < NR; ++k) {
        const f32x4 ya0 = up4((u32x2){yu[k].x, yu[k].y}), ya1 = up4((u32x2){yu[k].z, yu[k].w});
        float sm = ((ya0.x + ya0.y) + (ya0.z + ya0.w)) + ((ya1.x + ya1.y) + (ya1.z + ya1.w));
        sm += shx(sm, 1); sm += shx(sm, 2); sm += shx(sm, 4);
        const float mean = sm * (1.0f / 64.0f);
        const f32x4 d0 = ya0 - mean, d1 = ya1 - mean;
        float qv = dot4(d0, d0) + dot4(d1, d1);
        qv += shx(qv, 1); qv += shx(qv, 2); qv += shx(qv, 4);
        const float rstd = rsqrtf(qv * (1.0f / 64.0f) + LNX_EPS);
        const f32x4 vv0 = up4((u32x2){vu[k].x, vu[k].y}), vv1 = up4((u32x2){vu[k].z, vu[k].w});
        const f32x4 g0 = up4((u32x2){gu[k].x, gu[k].y}), g1 = up4((u32x2){gu[k].z, gu[k].w});
        const f32x4 o0 = (d0 * rstd * w0 + b0 + vv0 * sc[k]) * g0, o1 = (d1 * rstd * w1 + b1 + vv1 * sc[k]) * g1;
        const u32x2 p0 = dn4(o0), p1 = dn4(o1);
        *(u32x4*)(YA + (r0 + 64 * k) * 512 + c) = (u32x4){p0.x, p0.y, p1.x, p1.y};
    }
}
#if NAIVE_ATTN
#define ATTN_UNIT attn_unit_naive
#else
#define ATTN_UNIT attn_unit
#endif
__device__ __forceinline__ void phase_ya(ArgsP a, int l) {
    a = args_ptr();
    const unsigned gt = blockIdx.x * NTHREADS + ltid(), NGT = gridDim.x * NTHREADS;
    const bf16_t* Y = (const bf16_t*)(a->ws + A_Y); const bf16_t* RKV = (const bf16_t*)(a->ws + A_RKV); const bf16_t* GATE = (const bf16_t*)(a->ws + A_GATE);
    const float* SCAL = (const float*)(a->ws + WS_SCAL); bf16_t* YA = (bf16_t*)(a->ws + A_YA);
    const int c = (gt & 63) * 8, h = c >> 6;
    const float* muv = a->in[I_MU] + (size_t)l * 1792 + 1024 + c; const float* lw = a->in[I_LNXW] + l * 512 + c; const float* lb = a->in[I_LNXB] + l * 512 + c;
    const f32x4 m0 = *(const f32x4*)muv, m1 = *(const f32x4*)(muv + 4), w0 = *(const f32x4*)lw, w1 = *(const f32x4*)(lw + 4), b0 = *(const f32x4*)lb, b1 = *(const f32x4*)(lb + 4);
    for (unsigned i = gt; i < (unsigned)M * 64; i += 2 * NGT) {
        u32x4 yu[2], v2u[2], v1u[2], gu[2]; float sc[2]; unsigned rowv[2];
#pragma unroll
        for (int k = 0; k < 2; ++k) { const unsigned row = (i + k * NGT) >> 6; const int t = row & 4095; rowv[k] = row;
            yu[k] = *(const u32x4*)(Y + (size_t)row * 512 + c); v2u[k] = *(const u32x4*)(RKV + (size_t)row * 1536 + 1024 + c);
            v1u[k] = WKV_STREAM ? v2u[k] : (t ? *(const u32x4*)(RKV + (size_t)(row - 1) * 1536 + 1024 + c) : (u32x4){0u, 0u, 0u, 0u});
            gu[k] = *(const u32x4*)(GATE + (size_t)row * 512 + c); sc[k] = SCAL[(size_t)row * 8 + h]; }
#pragma unroll
        for (int k = 0; k < 2; ++k) {
            const f32x4 ya0 = up4((u32x2){yu[k].x, yu[k].y}), ya1 = up4((u32x2){yu[k].z, yu[k].w});
            float sm = ((ya0.x + ya0.y) + (ya0.z + ya0.w)) + ((ya1.x + ya1.y) + (ya1.z + ya1.w));
            sm += shx(sm, 1); sm += shx(sm, 2); sm += shx(sm, 4);
            const float mean = sm * (1.0f / 64.0f);
            const f32x4 d0 = ya0 - mean, d1 = ya1 - mean;
            float qv = dot4(d0, d0) + dot4(d1, d1);
            qv += shx(qv, 1); qv += shx(qv, 2); qv += shx(qv, 4);
            const float rstd = rsqrtf(qv * (1.0f / 64.0f) + LNX_EPS);
            const f32x4 v20 = up4((u32x2){v2u[k].x, v2u[k].y}), v21 = up4((u32x2){v2u[k].z, v2u[k].w}), v10 = up4((u32x2){v1u[k].x, v1u[k].y}), v11 = up4((u32x2){v1u[k].z, v1u[k].w});
            const f32x4 vv0 = v20 + (v10 - v20) * m0, vv1 = v21 + (v11 - v21) * m1;
            const f32x4 g0 = up4((u32x2){gu[k].x, gu[k].y}), g1 = up4((u32x2){gu[k].z, gu[k].w});
            const f32x4 o0 = (d0 * rstd * w0 + b0 + vv0 * sc[k]) * g0, o1 = (d1 * rstd * w1 + b1 + vv1 * sc[k]) * g1;
            const u32x2 p0 = dn4(o0), p1 = dn4(o1);
            *(u32x4*)(YA + (size_t)rowv[k] * 512 + c) = (u32x4){p0.x, p0.y, p1.x, p1.y};
        }
    }
}


__device__ __forceinline__ void phase_gconv(ArgsP a, int l) {
    a = args_ptr();
    const unsigned gt = blockIdx.x * NTHREADS + ltid();
    constexpr unsigned NCHK = FF / 8, NSEG = 372, SEGR = (M + NSEG - 1) / NSEG;
    if (gt >= NCHK * NSEG) return;
    const unsigned chk = gt % NCHK, seg = gt / NCHK; const int c = chk * 8;
    const bf16_t* UG = (const bf16_t*)(a->ws + A_UG); bf16_t* GC = (bf16_t*)(a->ws + A_ACT);
    const float* cw = a->in[I_CONVW] + (size_t)l * 3 * FF + c; const float* cb = a->in[I_CONVB] + (size_t)l * FF + c;
    const f32x4 w0a = *(const f32x4*)cw, w0b = *(const f32x4*)(cw + 4), w1a = *(const f32x4*)(cw + FF), w1b = *(const f32x4*)(cw + FF + 4), w2a = *(const f32x4*)(cw + 2 * FF), w2b = *(const f32x4*)(cw + 2 * FF + 4);
    const f32x4 ba = *(const f32x4*)cb, bb = *(const f32x4*)(cb + 4);
    const unsigned r0 = seg * SEGR, r1 = (r0 + SEGR < (unsigned)M) ? r0 + SEGR : (unsigned)M;
    const u32x4 z = (u32x4){0u, 0u, 0u, 0u};
    u32x4 p1 = ((r0 & 4095u) >= 1u) ? *(const u32x4*)(UG + (size_t)(r0 - 1) * FF + c) : z, p2 = ((r0 & 4095u) >= 2u) ? *(const u32x4*)(UG + (size_t)(r0 - 2) * FF + c) : z;
    u32x4 nx = *(const u32x4*)(UG + (size_t)r0 * FF + c);
    for (unsigned r = r0; r < r1; ++r) {
        const u32x4 cur = nx;
        if (r + 1 < r1) nx = *(const u32x4*)(UG + (size_t)(r + 1) * FF + c);
        if ((r & 4095u) == 0u) { p1 = z; p2 = z; }
        const f32x4 x2a = up4((u32x2){cur.x, cur.y}), x2b = up4((u32x2){cur.z, cur.w}), x1a = up4((u32x2){p1.x, p1.y}), x1b = up4((u32x2){p1.z, p1.w}), x0a = up4((u32x2){p2.x, p2.y}), x0b = up4((u32x2){p2.z, p2.w});
        const f32x4 ca = ba + w0a * x0a + w1a * x1a + w2a * x2a, cc = bb + w0b * x0b + w1b * x1b + w2b * x2b;
        const pg8::f32x2 g0 = pg8::gelu_pk2((pg8::f32x2){ca.x, ca.y}), g1 = pg8::gelu_pk2((pg8::f32x2){ca.z, ca.w}), g2 = pg8::gelu_pk2((pg8::f32x2){cc.x, cc.y}), g3 = pg8::gelu_pk2((pg8::f32x2){cc.z, cc.w});
        *(u32x4*)(GC + (size_t)r * FF + c) = (u32x4){pk2(g0.x, g0.y), pk2(g1.x, g1.y), pk2(g2.x, g2.y), pk2(g3.x, g3.y)};
        p2 = p1; p1 = cur;
    }
}
__device__ __forceinline__ void ffn_halo_fix(ArgsP a, int l, int pm) {
    a = args_ptr();
    const int tid = ltid();
    const bf16_t* RAWH = (const bf16_t*)(a->ws + A_UG); bf16_t* ACT = (bf16_t*)(a->ws + A_ACT);
    const float* cw = a->in[I_CONVW] + (size_t)l * 3 * FF; const float* cb = a->in[I_CONVB] + (size_t)l * FF;
    for (int i = tid; i < 8 * (FF / 8); i += NTHREADS) {
        const int hr = i / (FF / 8), c = (i % (FF / 8)) * 8, blk = pm * 4 + (hr >> 1), fr = hr & 1, row = blk * 64 + fr;
        const bool first = (row & 4095) < 2; const bf16_t* hb = RAWH + (size_t)blk * 6 * FF + c; const u32x4 z = (u32x4){0u, 0u, 0u, 0u};
        const u32x4 cur = *(const u32x4*)(hb + (2 + fr) * FF), val = *(const u32x4*)(hb + (4 + fr) * FF);
        const u32x4 p1 = (fr == 0) ? (first ? z : *(const u32x4*)(hb - 5 * FF)) : *(const u32x4*)(hb + 2 * FF);
        const u32x4 p2 = first ? z : *(const u32x4*)(hb - (fr == 0 ? 6 : 5) * FF);
        const f32x4 w0a = *(const f32x4*)(cw + c), w0b = *(const f32x4*)(cw + c + 4), w1a = *(const f32x4*)(cw + FF + c), w1b = *(const f32x4*)(cw + FF + c + 4);
        const f32x4 w2a = *(const f32x4*)(cw + 2 * FF + c), w2b = *(const f32x4*)(cw + 2 * FF + c + 4), ba = *(const f32x4*)(cb + c), bb = *(const f32x4*)(cb + c + 4);
        const f32x4 ga = pg8::gelu4(ba + w0a * up4((u32x2){p2.x, p2.y}) + w1a * up4((u32x2){p1.x, p1.y}) + w2a * up4((u32x2){cur.x, cur.y}));
        const f32x4 gb = pg8::gelu4(bb + w0b * up4((u32x2){p2.z, p2.w}) + w1b * up4((u32x2){p1.z, p1.w}) + w2b * up4((u32x2){cur.z, cur.w}));
        *(u32x4*)(ACT + (size_t)row * FF + c) = pg8::pack8(ga * up4((u32x2){val.x, val.y}), gb * up4((u32x2){val.z, val.w}));
    }
    asm volatile("s_waitcnt vmcnt(0)" ::: "memory");
    __syncthreads();
}
__device__ __forceinline__ void phase_final(ArgsP a) {
    a = args_ptr();
    const int tid = ltid(), lane = tid & 63, gw = blockIdx.x * NWAVES + (tid >> 6), NGW = gridDim.x * NWAVES;
    const float* SS4 = (const float*)(a->ws + WS_SSP) + (size_t)4 * M * 16; const f32x4* g = (const f32x4*)a->in[I_FINAL] + lane; const bf16_t* HB = (const bf16_t*)(a->ws + A_HB);
    for (int m = gw; m < M; m += NGW) {
        const float rs = rsqrtf(pg8::sum16(SS4 + (size_t)m * 16) * (1.0f / 1024.0f) + NORM_EPS);
        f32x4* o = (f32x4*)(a->out + (size_t)m * DM) + lane; const u32x2* hb = (const u32x2*)(HB + (size_t)m * DM) + lane;
#pragma unroll
        for (int j = 0; j < 4; ++j) o[64 * j] = up4(hb[64 * j]) * rs * g[64 * j];
    }
}


#ifndef DUMP_MIB
#define DUMP_MIB 0
#endif
#ifndef DUMP_OFF_MIB
#define DUMP_OFF_MIB 0
#endif
__device__ __forceinline__ void phase_dump(ArgsP a) {
    a = args_ptr();
    const size_t n16 = (size_t)DUMP_MIB * 1024 * 512, nout = (size_t)M * DM;
    const unsigned short* src = (const unsigned short*)(a->ws + (size_t)DUMP_OFF_MIB * 1024 * 1024);
    for (size_t i = (size_t)blockIdx.x * NTHREADS + vtid(); i < nout; i += (size_t)gridDim.x * NTHREADS) {
        float sacc = 0.f; for (size_t j = i; j < n16; j += nout) sacc += (float)src[j] * (1.0f / 65536.0f);
        a->out[i] = sacc; }
}

#ifndef CHK_ONLY
#define CHK_ONLY 0
#endif
#ifdef CHKSUM_PROBE
__device__ __forceinline__ void phase_chk_sum(ArgsP a) {
    a = args_ptr(); unsigned* ctl = (unsigned*)(a->ws + WS_CTL) + 32768;
    const size_t offs[4] = {A_Y, A_QN, WS_SCAL, A_YA}; const unsigned n16[4] = {(unsigned)M * 512u, (unsigned)M * 512u, (unsigned)M * 16u, 0u};
    for (int k = 0; k < 3; ++k) { const unsigned short* p = (const unsigned short*)(a->ws + offs[k]); unsigned acc = 0;
        for (unsigned i = blockIdx.x * NTHREADS + vtid(); i < n16[k]; i += gridDim.x * NTHREADS) acc += p[i];
        for (int o = 1; o < 64; o <<= 1) acc += shx(acc, o);
        if ((vtid() & 63) == 0) atomicAdd(ctl + 64 * k, acc); }
}
__device__ __forceinline__ void phase_chk_out(ArgsP a) {
    a = args_ptr(); const unsigned* ctl = (const unsigned*)(a->ws + WS_CTL) + 32768;
    for (unsigned i = blockIdx.x * NTHREADS + vtid(); i < (unsigned)(M * DM); i += gridDim.x * NTHREADS) {
        float v = 0.f; if (i == CHK_ONLY) v = (float)(__hip_atomic_load(ctl + 64 * i, __ATOMIC_RELAXED, __HIP_MEMORY_SCOPE_AGENT) % CHKSUM_PROBE) * 100.0f; a->out[i] = v; }
}
#endif

#ifdef CMPY_PROBE
__device__ __forceinline__ void phase_cmp_y(ArgsP a) {
    a = args_ptr(); unsigned long long* ctl = (unsigned long long*)(a->ws + WS_CTL) + 20000;
    const unsigned short* y1 = (const unsigned short*)(a->ws + A_Y); const unsigned short* y2 = (const unsigned short*)(a->ws + A_GATE);
    float sd = 0.f, sy = 0.f;
    for (unsigned i = blockIdx.x * NTHREADS + vtid(); i < (unsigned)M * 512u; i += gridDim.x * NTHREADS) { const float p = bf2f(y1[i]), r = bf2f(y2[i]); sd += (p - r) * (p - r); sy += r * r; }
    atomicAdd(ctl, (unsigned long long)(sd * 1024.0f)); atomicAdd(ctl + 8, (unsigned long long)(sy * 1024.0f));
}
__device__ __forceinline__ void phase_cmp_out(ArgsP a) {
    a = args_ptr(); const unsigned long long* ctl = (const unsigned long long*)(a->ws + WS_CTL) + 20000;
    const float rel = sqrtf((float)__hip_atomic_load(ctl, __ATOMIC_RELAXED, __HIP_MEMORY_SCOPE_AGENT) / (float)__hip_atomic_load(ctl + 8, __ATOMIC_RELAXED, __HIP_MEMORY_SCOPE_AGENT));
    for (unsigned i = blockIdx.x * NTHREADS + vtid(); i < (unsigned)(M * DM); i += gridDim.x * NTHREADS) a->out[i] = (i == 0) ? floorf(rel * 10000.0f) : 0.f;
}
#endif

#ifdef CK_TIME
__device__ __forceinline__ void phase_time_out(ArgsP a) {
    a = args_ptr(); const unsigned long long* tw = (const unsigned long long*)(a->ws + WS_CTL) + 24000;
#ifdef CK_TIME_TOTAL
    const float frac = (float)__hip_atomic_load(tw + 8, __ATOMIC_RELAXED, __HIP_MEMORY_SCOPE_AGENT) * (1.0f / 100000.0f);
    for (unsigned i = blockIdx.x * NTHREADS + vtid(); i < (unsigned)(M * DM); i += gridDim.x * NTHREADS) a->out[i] = (i == 0) ? floorf(frac) * 100.0f : 0.f;
#else
    const float frac = (float)__hip_atomic_load(tw + CK_TIME, __ATOMIC_RELAXED, __HIP_MEMORY_SCOPE_AGENT) / (float)__hip_atomic_load(tw + 8, __ATOMIC_RELAXED, __HIP_MEMORY_SCOPE_AGENT);
    for (unsigned i = blockIdx.x * NTHREADS + vtid(); i < (unsigned)(M * DM); i += gridDim.x * NTHREADS) a->out[i] = (i == 0) ? floorf(frac * 8.0f + 0.5f) * 1000.0f : 0.f;
#endif
}
#endif

#ifdef PH_TIME
__device__ __forceinline__ void phase_phtime_out(ArgsP a) {
    a = args_ptr(); const unsigned long long* tw = (const unsigned long long*)(a->ws + WS_CTL) + 26000;
    const float us = (float)(__hip_atomic_load(tw + PH_TIME + 1, __ATOMIC_RELAXED, __HIP_MEMORY_SCOPE_AGENT) - __hip_atomic_load(tw + PH_TIME, __ATOMIC_RELAXED, __HIP_MEMORY_SCOPE_AGENT)) * 0.01f;
    for (unsigned i = blockIdx.x * NTHREADS + vtid(); i < (unsigned)(M * DM); i += gridDim.x * NTHREADS) a->out[i] = (i == 0) ? floorf(us / (float)PH_Q + 0.5f) * 100.0f : 0.f;
}
#endif
#ifdef SPLIT_SCAN_ATTN
constexpr int PH_EXTRA = 1;
#else
constexpr int PH_EXTRA = 0;
#endif
constexpr int PH_PER_LAYER = 9 + PH_EXTRA, N_PHASES = 2 * PH_PER_LAYER + 1;
__global__ void __launch_bounds__(NTHREADS, 2) mk_fwd(Args a_unused) {
    LAS unsigned char* lds = (LAS unsigned char*)lds_raw;
    { const unsigned t0_ = threadIdx.x; if ((t0_ & 63u) == 0u) *(volatile LAS unsigned*)(lds + WTAB_OFF + hw_wave_key() * 4u) = t0_ >> 6; }
    __syncthreads();
#if !MK_MULTI
    if (args_ptr()->ph_lo > 1000000) cg::this_grid().sync();
    volatile LAS unsigned* MISC = (volatile LAS unsigned*)(lds + MISC_OFF);
    if (vtid() < 32) MISC[vtid()] = 0u;
    __syncthreads();
    (void)xcd_barrier_post((unsigned*)(args_ptr()->ws + WS_CTL) + CW_BAR, MISC + 8);
#endif
    int ph = 0;
#ifdef PH_TIME
    if (blockIdx.x == 0 && vtid() == 0) ((unsigned long long*)(args_ptr()->ws + WS_CTL) + 26000)[0] = __builtin_amdgcn_s_memrealtime();
#endif
#define lo (args_ptr()->ph_lo)
#define hi (args_ptr()->ph_hi)
#if MK_MULTI
#define SEAM() do {} while (0)
#define SEAM1() do {} while (0)
#else
#define SEAM1() do { XcdBarrier b_; b_.bar = (unsigned*)(args_ptr()->ws + WS_CTL) + CW_BAR; b_.x = xb_xcc_id(); b_.st = (volatile LAS unsigned*)(lds + MISC_OFF) + 8; xcd_barrier(b_); } while (0)
#define SEAM() do { if (ph + 1 < hi) { XcdBarrier b_; b_.bar = (unsigned*)(args_ptr()->ws + WS_CTL) + CW_BAR; b_.x = xb_xcc_id(); b_.st = (volatile LAS unsigned*)(lds + MISC_OFF) + 8; xcd_barrier(b_); } } while (0)
#endif
#ifndef PH3SUB
#define PH3SUB 7
#endif
#ifndef PHMASK
#define PHMASK 0xFFFF
#endif
#ifndef SCAN_CHUNKED
#define SCAN_CHUNKED 1
#endif
#ifndef SCAN_REPS
#define SCAN_REPS 1
#endif
#ifndef REPEAT_PHASE
#define REPEAT_PHASE (-1)
#endif
#ifndef REPEAT_LAYER
#define REPEAT_LAYER (-1)
#endif
#ifdef PH_TIME
#define PH_STAMP() do { if (blockIdx.x == 0 && vtid() == 0) ((unsigned long long*)(args_ptr()->ws + WS_CTL) + 26000)[ph + 1] = __builtin_amdgcn_s_memrealtime(); } while (0)
#elif defined(PH_SPIN)
#ifdef PH_SUB
#define PH_SUBSEL() do { const unsigned long long* ts_ = st_ + 100; d_ = PH_SUB == 1 ? ts_[1] - ts_[0] : (PH_SUB == 2 ? ts_[2] - ts_[1] : (PH_SUB == 3 ? t1_ - ts_[2] : (PH_SUB == 4 ? __hip_atomic_load((unsigned long long*)ts_ + 4, __ATOMIC_RELAXED, __HIP_MEMORY_SCOPE_AGENT) - ts_[0] : ts_[0] - st_[ph]))); } while (0)
#else
#define PH_SUBSEL() do {} while (0)
#endif
#define PH_STAMP() do { if (ph + 1 == PH_SPIN || ph == PH_SPIN) { if (blockIdx.x == 0 && vtid() == 0) { unsigned long long* st_ = (unsigned long long*)(args_ptr()->ws + WS_CTL) + 26000; \
        const unsigned long long t1_ = __builtin_amdgcn_s_memrealtime(); st_[ph + 1] = t1_; st_[103] = t1_; \
        if (ph == PH_SPIN) { unsigned long long d_ = t1_ - st_[ph]; PH_SUBSEL(); if (d_ > 100000ull) d_ = 100000ull; while (__builtin_amdgcn_s_memrealtime() - t1_ < d_) __builtin_amdgcn_s_sleep(8); } } \
        if (ph == PH_SPIN) { SEAM1(); } } } while (0)
#else
#define PH_STAMP() do {} while (0)
#endif
#define RUN(K, ...) do { if (((PHMASK >> (K)) & 1) && lo <= ph && ph < hi) { const int nrep_ = ((K) == REPEAT_PHASE && (REPEAT_LAYER < 0 || REPEAT_LAYER == l_)) ? 2 : 1; \
    for (int rep_ = 0; rep_ < nrep_; ++rep_) { __VA_ARGS__; if (rep_ + 1 < nrep_) { SEAM1(); } } SEAM(); PH_STAMP(); } ++ph; } while (0)
#define LOCALS() ArgsP a = args_ptr(); unsigned char* ws = a->ws; unsigned char* wb = ws + WS_W; float* SSP = (float*)(ws + WS_SSP); float* SSQP = (float*)(ws + WS_SSQP); bf16_t* HB = (bf16_t*)(ws + A_HB); \
    const int G = gridDim.x, bid = blockIdx.x; (void)wb; (void)SSP; (void)SSQP; (void)HB; (void)G; (void)bid
#define WT(off) ((const pg8::bf16_t*)(wb + (off)))
    int l_ = 0;
    for (int l = 0; l < DEPTH; ++l) {
        l_ = l;
        RUN(0, phase_weights(nullptr, l, lds));
        RUN(1, { LOCALS(); pg8::Gemm g{HB, WT(W_IN), M, PC - 256, 1024, 1024}; pg8::StaticOrder S; S.init(M, PC - 256, G, bid);
              pg8::EpiP E{(bf16_t*)(ws + A_RKV), (bf16_t*)(ws + A_LORAC), (bf16_t*)(ws + A_PM), (unsigned char*)a->out, SSP + (size_t)(2 * l) * M * 16, SSQP + (size_t)l * M * 4, SSQP + (size_t)(2 + l) * M * 4, (bf16_t*)((unsigned char*)a->out + DO_HALO), (LAS float*)(lds + pg8::RS_OFF), 0};
              GEMM_PHASE(pg8::EpiP, lds, g, S, E); });
        RUN(2, phase_prep(nullptr, l));
        RUN(3, { if (PH3SUB & 1) { LOCALS(); pg8::Gemm g{(const bf16_t*)(ws + A_LIN), WT(W_LORA), M, 1536, 256, 256}; pg8::StaticOrder S; S.init(M, 1536, G, bid);
                pg8::EpiLora E{(bf16_t*)(ws + A_LW), (bf16_t*)(ws + A_ICLR), (bf16_t*)(ws + A_GATE), a->in[I_DBASE] + l * 512, a->in[I_IBASE] + l * 512};
                GEMM_PHASE(pg8::EpiLora, lds, g, S, E); }
              if (gridDim.x == 256 && blockIdx.x >= 192) {
                LOCALS(); pg8::Gemm g{HB, WT(W_IN) + (size_t)(PC - 256) * 1024, M, 256, 1024, 1024}; pg8::StaticOrder S; S.init(M, 256, 64, bid - 192);
                pg8::EpiP E{(bf16_t*)(ws + A_RKV), (bf16_t*)(ws + A_LORAC), (bf16_t*)(ws + A_PM), (unsigned char*)a->out, SSP + (size_t)(2 * l) * M * 16, SSQP + (size_t)l * M * 4, SSQP + (size_t)(2 + l) * M * 4, (bf16_t*)((unsigned char*)a->out + DO_HALO), (LAS float*)(lds + pg8::RS_OFF), 16};
                GEMM_PHASE(pg8::EpiP, lds, g, S, E); }
              else if (gridDim.x != 256) {
                LOCALS(); pg8::Gemm g{HB, WT(W_IN) + (size_t)(PC - 256) * 1024, M, 256, 1024, 1024}; pg8::StaticOrder S; S.init(M, 256, G, bid);
                pg8::EpiP E{(bf16_t*)(ws + A_RKV), (bf16_t*)(ws + A_LORAC), (bf16_t*)(ws + A_PM), (unsigned char*)a->out, SSP + (size_t)(2 * l) * M * 16, SSQP + (size_t)l * M * 4, SSQP + (size_t)(2 + l) * M * 4, (bf16_t*)((unsigned char*)a->out + DO_HALO), (LAS float*)(lds + pg8::RS_OFF), 16};
                GEMM_PHASE(pg8::EpiP, lds, g, S, E); }
              if (PH3SUB & 2) { LOCALS(); pg8::Gemm g{(const bf16_t*)(ws + A_PM), WT(W_Q), M, 768, 256, 512}; pg8::StaticOrder S; S.init(M, 768, G, bid);
                pg8::EpiQ E{(bf16_t*)(ws + A_QN), (bf16_t*)(ws + A_QP), SSQP + (size_t)l * M * 4, (const float*)(ws + WS_CS), (LAS float*)(lds + pg8::RS_OFF)};
                GEMM_PHASE(pg8::EpiQ, lds, g, S, E); }
              if (PH3SUB & 4) { LOCALS(); pg8::Gemm g{(const bf16_t*)(ws + A_PM) + 256, WT(W_KV), M, 1024, 256, 512}; pg8::StaticOrder S; S.init(M, 1024, G, bid);
                pg8::EpiKV E{(bf16_t*)(ws + A_KN), (bf16_t*)(ws + A_VT), SSQP + (size_t)(2 + l) * M * 4, (LAS float*)(lds + pg8::RS_OFF)};
                GEMM_PHASE(pg8::EpiKV, lds, g, S, E); } });
#if WKV_STREAM
        RUN(4, { if (gridDim.x >= 64) { if (blockIdx.x >= 32) phase_wkvprep(nullptr, l, lds, (int)blockIdx.x - 32, (int)gridDim.x - 32); }
                 else { phase_wkvprep(nullptr, l, lds, (int)blockIdx.x, (int)gridDim.x); SEAM1(); }
                 if (blockIdx.x < 32) { for (int sr_ = 0; sr_ < SCAN_REPS; ++sr_) scan_unit_stream(nullptr, l, blockIdx.x, lds); }
#ifdef PH_SUB
                 if (blockIdx.x == 0 && vtid() == 0) { unsigned long long* ts_ = (unsigned long long*)(args_ptr()->ws + WS_CTL) + 26100; ts_[0] = ts_[3]; ts_[1] = __builtin_amdgcn_s_memrealtime(); }
#endif
                 unsigned* qctr = (unsigned*)(args_ptr()->ws + WS_CTL) + CW_QUEUE + 64 * (2 * l);
                 volatile LAS unsigned* qslot = (volatile LAS unsigned*)(lds + MISC_OFF) + 16;
                 for (;;) { if (vtid() == 0) qslot[0] = __hip_atomic_fetch_add(qctr, 1u, __ATOMIC_RELAXED, __HIP_MEMORY_SCOPE_AGENT);
                            __syncthreads(); const unsigned u = qslot[0]; __syncthreads();
                            if (u >= 512u) break;
                            attn_unit(nullptr, (int)(u & 31u), 15 - (int)(u >> 5), lds, A_QN); }
                 { unsigned* yctr = (unsigned*)(args_ptr()->ws + WS_CTL) + CW_QUEUE + 64 * (2 * l + 1);
                   for (;;) { if (vtid() == 0) qslot[0] = __hip_atomic_fetch_add(yctr, 1u, __ATOMIC_RELAXED, __HIP_MEMORY_SCOPE_AGENT);
                              __syncthreads(); const unsigned u = qslot[0]; __syncthreads();
                              if (u >= 352u) break;
                              if (u < 224u) ya_item<4>(nullptr, l, (int)(u & 31u), 4 * (int)(u >> 5)); else ya_item<1>(nullptr, l, (int)(u & 31u), 28 + (int)((u - 224u) >> 5)); } }
#ifdef PH_SUB
                 if (blockIdx.x == 0 && vtid() == 0) { unsigned long long* ts_ = (unsigned long long*)(args_ptr()->ws + WS_CTL) + 26100; ts_[2] = __builtin_amdgcn_s_memrealtime(); }
                 if (blockIdx.x == 255 && vtid() == 0) { unsigned long long* ts_ = (unsigned long long*)(args_ptr()->ws + WS_CTL) + 26100; __hip_atomic_store(ts_ + 4, (unsigned long long)__builtin_amdgcn_s_memrealtime(), __ATOMIC_RELAXED, __HIP_MEMORY_SCOPE_AGENT); }
#endif
                 });
#else
#ifdef SPLIT_SCAN_ATTN
        RUN(4, { if (blockIdx.x < 128) scan_unit_chunked(nullptr, l, blockIdx.x >> 2, blockIdx.x & 3, lds); });
        RUN(5, { for (int c = blockIdx.x; c < 256; c += gridDim.x) { attn_unit(nullptr, c >> 3, 15 - (c & 7), lds); attn_unit(nullptr, c >> 3, c & 7, lds); } });
#else
        RUN(4, { if (blockIdx.x < 128) { for (int sr_ = 0; sr_ < SCAN_REPS; ++sr_) { if (SCAN_CHUNKED) scan_unit_chunked(nullptr, l, blockIdx.x >> 2, blockIdx.x & 3, lds); else scan_unit(nullptr, l, blockIdx.x >> 2, blockIdx.x & 3, lds); } }
                 const size_t oo_ = (rep_ + 1 < nrep_) ? A_LW : A_QN;
                 unsigned* qctr = (unsigned*)(args_ptr()->ws + WS_CTL) + CW_QUEUE + 64 * (2 * l + rep_);
                 volatile LAS unsigned* qslot = (volatile LAS unsigned*)(lds + MISC_OFF) + 16;
                 for (;;) { if (vtid() == 0) qslot[0] = __hip_atomic_fetch_add(qctr, 1u, __ATOMIC_RELAXED, __HIP_MEMORY_SCOPE_AGENT);
                            __syncthreads(); const unsigned u = qslot[0]; __syncthreads();
                            if (u >= 512u) break;
                            attn_unit(nullptr, (int)(u & 31u), 15 - (int)(u >> 5), lds, oo_); } });
#endif
#endif
#ifdef CK_TIME
        if (l == 0) { phase_time_out(nullptr); return; }
#endif
#ifdef CMPY_PROBE
        if (l == 0) { if (blockIdx.x < 128) scan_unit(nullptr, l, blockIdx.x >> 2, blockIdx.x & 3, lds, A_GATE); SEAM1(); phase_cmp_y(nullptr); SEAM1(); phase_cmp_out(nullptr); return; }
#endif
#ifdef CHKSUM_PROBE
        if (l == 0) { phase_chk_sum(nullptr); SEAM1(); phase_chk_out(nullptr); return; }
#endif
        RUN(7, { { LOCALS(); pg8::Gemm g{(const bf16_t*)(ws + A_YA), WT(W_OA), M, 1024, 512, 512}; pg8::StaticOrder S; S.init(M, 1024, G, bid);
                pg8::EpiMix<1> E{(float*)(ws + A_TMP), (bf16_t*)(ws + A_MERGED), (const unsigned char*)a->out};
                GEMM_PHASE(pg8::EpiMix<1>, lds, g, S, E); }
              asm volatile("s_waitcnt vmcnt(0)" ::: "memory"); __syncthreads();
              { LOCALS(); pg8::Gemm g{(const bf16_t*)(ws + A_QN), WT(W_OB), M, 1024, 512, 512}; pg8::StaticOrder S; S.init(M, 1024, G, bid);
                pg8::EpiMix<2> E{(float*)(ws + A_TMP), (bf16_t*)(ws + A_MERGED), (const unsigned char*)a->out};
                GEMM_PHASE(pg8::EpiMix<2>, lds, g, S, E); } });
        RUN(8, { LOCALS(); pg8::Gemm g{(const bf16_t*)(ws + A_MERGED), WT(W_OUT), M, 1024, 1024, 1024}; pg8::StaticOrder S; S.init(M, 1024, G, bid);
#ifdef PH_SUB
              g.ts = (unsigned long long*)(ws + WS_CTL) + 26100;
#endif
              pg8::EpiRes E{HB, SSP + (size_t)(2 * l + 1) * M * 16};
              GEMM_PHASE(pg8::EpiRes, lds, g, S, E); });
        RUN(9, { LOCALS(); pg8::Gemm g{HB, WT(W_UP), M, 2 * FF, 1024, 1024}; pg8::StaticOrder S; S.init(M, 2 * FF, G, bid);
              pg8::EpiUp E{(bf16_t*)(ws + A_ACT), (bf16_t*)(ws + A_UG), SSP + (size_t)(2 * l + 1) * M * 16, a->in[I_CONVW] + (size_t)l * 3 * FF, a->in[I_CONVB] + (size_t)l * FF, (LAS float*)(lds + pg8::RS_OFF)};
              GEMM_PHASE(pg8::EpiUp, lds, g, S, E); });
        RUN(11, { LOCALS(); pg8::Gemm g{(const bf16_t*)(ws + A_ACT), WT(W_DOWN), M, 1024, FF, FF}; pg8::StaticOrder S; S.init(M, 1024, G, bid);
              { pg8::Unit hu_; for (int hi_ = 0; S.next(hi_, hu_); ++hi_) ffn_halo_fix(nullptr, l, hu_.pm); }
              pg8::EpiRes E{HB, SSP + (size_t)(2 * l + 2) * M * 16};
              GEMM_PHASE(pg8::EpiRes, lds, g, S, E); });
    }
    RUN(12, phase_final(nullptr));
#ifdef PH_TIME
    SEAM1(); phase_phtime_out(nullptr);
#endif
#if DUMP_MIB
    if (lo == 100) phase_dump(nullptr);
#endif
#ifdef CLOCKJUNK
    if (lo == 103 && blockIdx.x == 0) { args_ptr()->out[vtid()] += (float)(__builtin_amdgcn_s_memrealtime() & 1023); }
#endif
}

#undef lo
#undef hi
extern "C" void kernel_launch(void* const* d_in, const int* in_sizes, int n_in, void* d_out, int out_size, void* d_ws, size_t ws_size, hipStream_t stream) {
    static int grid = 0;
    if (grid == 0) {
        if (n_in != 28 || out_size != M * DM || ws_size < WS_END) { fprintf(stderr, "kernel_launch: unexpected shapes: n_in %d out %d ws %zu (need %zu)\n", n_in, out_size, ws_size, (size_t)WS_END); grid = -1; return; }
        int dev = 0, cus = 0, per_cu = 0;
        if (hipGetDevice(&dev) != hipSuccess || hipDeviceGetAttribute(&cus, hipDeviceAttributeMultiprocessorCount, dev) != hipSuccess) { grid = -1; return; }
        if (hipFuncSetAttribute((const void*)mk_fwd, hipFuncAttributeMaxDynamicSharedMemorySize, LDS_BYTES) != hipSuccess) { fprintf(stderr, "kernel_launch: hipFuncSetAttribute failed\n"); grid = -1; return; }
        if (hipOccupancyMaxActiveBlocksPerMultiprocessor(&per_cu, (const void*)mk_fwd, NTHREADS, LDS_BYTES) != hipSuccess || per_cu < 1) { fprintf(stderr, "kernel_launch: occupancy query says %d\n", per_cu); per_cu = 1; }
        (void)hipGetLastError();
        grid = cus * 1;
        if (grid > cus * per_cu) grid = cus * per_cu;
    }
    if (grid < 0) return;
    if (hipMemsetAsync((char*)d_ws + WS_CTL, 0, CTL_ZERO_BYTES, stream) != hipSuccess) { fprintf(stderr, "kernel_launch: memset failed\n"); return; }
    Args a{};
    for (int i = 0; i < 28; ++i) a.in[i] = (const float*)d_in[i];
    a.out = (float*)d_out; a.ws = (unsigned char*)d_ws;
#if MK_MULTI
#ifndef STOP_AFTER
#define STOP_AFTER (N_PHASES - 1)
#endif
    for (int p = 0; p <= STOP_AFTER; ++p) {
        a.ph_lo = p; a.ph_hi = p + 1;
        hipLaunchKernelGGL(mk_fwd, dim3(grid), dim3(NTHREADS), LDS_BYTES, stream, a);
    }
#ifdef CLOCKJUNK
    a.ph_lo = 103; a.ph_hi = 104;
    hipLaunchKernelGGL(mk_fwd, dim3(grid), dim3(NTHREADS), LDS_BYTES, stream, a);
#endif
#if DUMP_MIB
    a.ph_lo = 100; a.ph_hi = 101;
    hipLaunchKernelGGL(mk_fwd, dim3(grid), dim3(NTHREADS), LDS_BYTES, stream, a);
#endif
#else
    a.ph_lo = 0; a.ph_hi = N_PHASES;
    void* kargs[] = {&a};
    hipError_t e = hipLaunchCooperativeKernel((const void*)mk_fwd, dim3(grid), dim3(NTHREADS), kargs, LDS_BYTES, stream);
    if (e != hipSuccess) fprintf(stderr, "kernel_launch: cooperative launch failed: %s (grid %d)\n", hipGetErrorString(e), grid);
#endif
}
```
